# Optimizing an MI355X kernel written in HIP

```python
import math
import jax, jax.numpy as jnp
from jax import lax
import numpy as np

D_MODEL = 1024
BATCH = 32
SEQ = 2048
DEPTH = 2

CTX_LEN = 256
GRID_W = 64
HEAD_DIM = 64
A_HEADS = 8
A_KV_HEADS = 2
A_GROUP = A_HEADS // A_KV_HEADS
WINDOW = 128
A_BLOCK = 128
B_HEADS = 8
NA_ROWS = 8
NA_COLS = 16
C_WIDTH = 512
HY_ORDER = 2
HY_DIRS = 2
HY_BANDS = 16
HY_EMB = 1 + 2 * HY_BANDS
HY_HIDDEN = 64
HY_TARGET = 1e-2
HY_FAST = 0.3
HY_SLOW = 1.5
N_BRANCH = 3
BRANCH_W = 512
D_FF = 2816
N_EXPERTS = 8
TOP_K = 2
D_FF_E = 3584
N_DENSE = (DEPTH + 1) // 2
N_MOE = DEPTH // 2

ROPE_BASE = 10000.0
EPS = 1e-6
NEG = -1e30

A_KV_W = A_KV_HEADS * HEAD_DIM
A_Q_W = A_HEADS * HEAD_DIM
B_W = B_HEADS * HEAD_DIM
KV_COLS = 2 * A_KV_W + 2 * B_W
IN_COLS = KV_COLS + A_Q_W + B_W + 3 * C_WIDTH + N_BRANCH * D_MODEL
SPLITS = (A_KV_W, 2 * A_KV_W, 2 * A_KV_W + B_W, KV_COLS,
          KV_COLS + A_Q_W, KV_COLS + A_Q_W + B_W,
          KV_COLS + A_Q_W + B_W + 3 * C_WIDTH)

kernel_name = "hybrid_gated_mixer_diffusion_block"


def rmsnorm(x, g):
    xf = x.astype(jnp.float32)
    y = xf * lax.rsqrt(jnp.mean(xf * xf, axis=-1, keepdims=True) + EPS)
    return (y * g.astype(jnp.float32)).astype(x.dtype)


def rope_axis(x, pos):
    half = x.shape[-1] // 2
    inv = ROPE_BASE ** (-jnp.arange(half, dtype=jnp.float32) / half)
    ang = pos.astype(jnp.float32)[:, None] * inv
    cos = jnp.cos(ang)[None, :, None, :].astype(x.dtype)
    sin = jnp.sin(ang)[None, :, None, :].astype(x.dtype)
    a, b = x[..., :half], x[..., half:]
    return jnp.concatenate([a * cos - b * sin, a * sin + b * cos], axis=-1)


def rope_2d(x, rows, cols):
    h = x.shape[-1] // 2
    return jnp.concatenate([rope_axis(x[..., :h], rows), rope_axis(x[..., h:], cols)], axis=-1)


def softmax_with_sink(s, sink):
    m = jnp.maximum(jnp.max(s, axis=-1, keepdims=True), sink)
    p = jnp.exp(s - m)
    return p / (jnp.sum(p, axis=-1, keepdims=True) + jnp.exp(sink - m))


def window_attn_latent(q, k, v, kc, vc, sink):
    B, L = q.shape[0], q.shape[1]
    nb = L // A_BLOCK
    span = A_BLOCK + 2 * WINDOW
    scale = HEAD_DIM ** -0.5
    pad = ((0, 0), (WINDOW, WINDOW), (0, 0), (0, 0))
    kp, vp = jnp.pad(k, pad), jnp.pad(v, pad)
    qg = q.reshape(B, L, A_KV_HEADS, A_GROUP, HEAD_DIM)
    sink_g = sink.astype(jnp.float32).reshape(1, A_KV_HEADS, A_GROUP, 1, 1)

    def block(i):
        q0 = i * A_BLOCK
        qb = lax.dynamic_slice_in_dim(qg, q0, A_BLOCK, axis=1)
        kb = lax.dynamic_slice_in_dim(kp, q0, span, axis=1)
        vb = lax.dynamic_slice_in_dim(vp, q0, span, axis=1)
        s_loc = jnp.einsum('bqgrd,bkgd->bgrqk', qb, kb).astype(jnp.float32) * scale
        s_ctx = jnp.einsum('bqgrd,bcgd->bgrqc', qb, kc).astype(jnp.float32) * scale
        qpos = q0 + jnp.arange(A_BLOCK)
        kpos = q0 - WINDOW + jnp.arange(span)
        valid = ((kpos[None, :] >= 0) & (kpos[None, :] < L)
                 & (jnp.abs(qpos[:, None] - kpos[None, :]) <= WINDOW))
        s_loc = jnp.where(valid, s_loc, NEG)
        p = softmax_with_sink(jnp.concatenate([s_loc, s_ctx], axis=-1), sink_g).astype(v.dtype)
        o = (jnp.einsum('bgrqk,bkgd->bqgrd', p[..., :span], vb)
             + jnp.einsum('bgrqc,bcgd->bqgrd', p[..., span:], vc))
        return o.reshape(B, A_BLOCK, A_Q_W)

    out = lax.map(block, jnp.arange(nb))
    return out.transpose(1, 0, 2, 3).reshape(B, L, A_Q_W)


def ctx_attn_a(qc, kc, vc, sink):
    B, Lc = qc.shape[0], qc.shape[1]
    qg = qc.reshape(B, Lc, A_KV_HEADS, A_GROUP, HEAD_DIM)
    s = jnp.einsum('bqgrd,bkgd->bgrqk', qg, kc).astype(jnp.float32) * HEAD_DIM ** -0.5
    sink_g = sink.astype(jnp.float32).reshape(1, A_KV_HEADS, A_GROUP, 1, 1)
    p = softmax_with_sink(s, sink_g).astype(vc.dtype)
    return jnp.einsum('bgrqk,bkgd->bqgrd', p, vc).reshape(B, Lc, A_Q_W)


def neighbourhood_attn_latent(q, k, v, kc, vc, rpb):
    B, L = q.shape[0], q.shape[1]
    rows = L // GRID_W
    wr = min(NA_ROWS, rows)
    scale = HEAD_DIM ** -0.5
    qg = q.reshape(B, rows, GRID_W, B_HEADS, HEAD_DIM)
    kg = k.reshape(B, rows, GRID_W, B_HEADS, HEAD_DIM)
    vg = v.reshape(B, rows, GRID_W, B_HEADS, HEAD_DIM)
    col = jnp.arange(GRID_W)
    col_start = jnp.clip(col - NA_COLS // 2, 0, GRID_W - NA_COLS)
    col_ok = (col[None, :] >= col_start[:, None]) & (col[None, :] < col_start[:, None] + NA_COLS)
    dc_idx = jnp.clip(col[None, :] - col[:, None] + NA_COLS - 1, 0, 2 * NA_COLS - 2)
    rpb_f = rpb.astype(jnp.float32)
    nloc = wr * GRID_W

    def row(r):
        rs = jnp.clip(r - wr // 2, 0, rows - wr)
        qr = lax.dynamic_index_in_dim(qg, r, axis=1, keepdims=False)
        kr = lax.dynamic_slice_in_dim(kg, rs, wr, axis=1)
        vr = lax.dynamic_slice_in_dim(vg, rs, wr, axis=1)
        dr_idx = rs + jnp.arange(wr) - r + NA_ROWS - 1
        bias = rpb_f[:, dr_idx[None, :, None], dc_idx[:, None, :]]
        s_loc = jnp.einsum('bqhd,bjkhd->bhqjk', qr, kr).astype(jnp.float32) * scale + bias
        s_loc = jnp.where(col_ok[:, None, :], s_loc, NEG).reshape(B, B_HEADS, GRID_W, nloc)
        s_ctx = jnp.einsum('bqhd,bchd->bhqc', qr, kc).astype(jnp.float32) * scale
        p = jax.nn.softmax(jnp.concatenate([s_loc, s_ctx], axis=-1), axis=-1).astype(v.dtype)
        p_loc = p[..., :nloc].reshape(B, B_HEADS, GRID_W, wr, GRID_W)
        o = (jnp.einsum('bhqjk,bjkhd->bqhd', p_loc, vr)
             + jnp.einsum('bhqc,bchd->bqhd', p[..., nloc:], vc))
        return o.reshape(B, GRID_W, B_W)

    out = lax.map(row, jnp.arange(rows))
    return out.transpose(1, 0, 2, 3).reshape(B, L, B_W)


def ctx_attn_b(qc, kc, vc):
    B, Lc = qc.shape[0], qc.shape[1]
    s = jnp.einsum('bqhd,bkhd->bhqk', qc, kc).astype(jnp.float32) * HEAD_DIM ** -0.5
    p = jax.nn.softmax(s, axis=-1).astype(vc.dtype)
    return jnp.einsum('bhqk,bkhd->bqhd', p, vc).reshape(B, Lc, B_W)


def short_conv(u, w, b):
    L = u.shape[1]
    up = jnp.pad(u, ((0, 0), (1, 1), (0, 0)))
    return up[:, :L] * w[0] + up[:, 1:L + 1] * w[1] + up[:, 2:] * w[2] + b


def hyena_filters(L, w1, b1, w2, b2, w3, freq):
    t = jnp.linspace(0.0, 1.0, L, dtype=jnp.float32)[:, None]
    omega = 2.0 * math.pi * jnp.arange(L, dtype=jnp.float32)[:, None] / L
    f = jnp.linspace(1e-4, HY_BANDS - 1, HY_BANDS, dtype=jnp.float32)[None, :]
    z = jnp.concatenate([t, jnp.cos(f * omega), -jnp.sin(f * omega)], axis=-1).astype(w1.dtype)
    h = jnp.sin(freq * (z @ w1 + b1))
    h = jnp.sin(freq * (h @ w2 + b2))
    h = (h @ w3).astype(jnp.float32).reshape(L, HY_DIRS, HY_ORDER, C_WIDTH)
    deltas = jnp.abs(jnp.linspace(math.log(HY_TARGET) / HY_SLOW, math.log(HY_TARGET) / HY_FAST,
                                  C_WIDTH, dtype=jnp.float32))
    h = h * jnp.exp(-t[:, :, None, None] * deltas)
    return h / jnp.sqrt(jnp.sum(h * h, axis=0, keepdims=True) + EPS)


def fft_conv(u, h):
    L = u.shape[1]
    n = 2 * L
    U = jnp.fft.rfft(u, n=n, axis=1)
    H = jnp.fft.rfft(h, n=n, axis=0)
    return jnp.fft.irfft(U * H[None], n=n, axis=1)[:, :L]


def bidir_long_conv(u, h, bias):
    return fft_conv(u, h[:, 0]) + fft_conv(u[:, ::-1], h[:, 1])[:, ::-1] + u * bias


def hyena(p, conv_w, conv_b, filt, hy_bias):
    v, x1, x2 = jnp.split(short_conv(p, conv_w, conv_b), 3, axis=-1)
    z = v.astype(jnp.float32)
    for o, gate in enumerate((x1, x2)):
        z = gate.astype(jnp.float32) * bidir_long_conv(z, filt[:, :, o], hy_bias[o].astype(jnp.float32))
    return z.astype(p.dtype)


def merge_branches(ya, yb, yc, gates, w_branch, w_out):
    g = jax.nn.sigmoid(gates.astype(jnp.float32)).astype(ya.dtype)
    ga, gb, gc = jnp.split(g, N_BRANCH, axis=-1)
    m = ga * (ya @ w_branch[0]) + gb * (yb @ w_branch[1]) + gc * (yc @ w_branch[2])
    return m @ w_out


def mixer_block(h, hc, lp, last):
    B, L, _ = h.shape
    Lc = hc.shape[1]
    t = jnp.arange(L)
    pos_r, pos_c = t // GRID_W, t % GRID_W
    ak, av, bk, bv, aq, bq, cin, gates = jnp.split(h @ lp['w_in'], SPLITS, axis=-1)
    aq = rope_2d(aq.reshape(B, L, A_HEADS, HEAD_DIM), pos_r, pos_c)
    ak = rope_2d(ak.reshape(B, L, A_KV_HEADS, HEAD_DIM), pos_r, pos_c)
    av = av.reshape(B, L, A_KV_HEADS, HEAD_DIM)
    bq = bq.reshape(B, L, B_HEADS, HEAD_DIM)
    bk = bk.reshape(B, L, B_HEADS, HEAD_DIM)
    bv = bv.reshape(B, L, B_HEADS, HEAD_DIM)
    w_in_c = lp['w_in'][:, :KV_COLS] if last else lp['w_in']
    parts_c = jnp.split(hc @ w_in_c, SPLITS[:3] if last else SPLITS, axis=-1)
    akc = parts_c[0].reshape(B, Lc, A_KV_HEADS, HEAD_DIM)
    avc = parts_c[1].reshape(B, Lc, A_KV_HEADS, HEAD_DIM)
    bkc = parts_c[2].reshape(B, Lc, B_HEADS, HEAD_DIM)
    bvc = parts_c[3].reshape(B, Lc, B_HEADS, HEAD_DIM)

    ya = window_attn_latent(aq, ak, av, akc, avc, lp['sink_a'])
    yb = neighbourhood_attn_latent(bq, bk, bv, bkc, bvc, lp['rpb_b'])
    filt = hyena_filters(L, lp['hy_w1'], lp['hy_b1'], lp['hy_w2'], lp['hy_b2'], lp['hy_w3'], lp['hy_freq'])
    yc = hyena(cin, lp['conv_c_w'], lp['conv_c_b'], filt, lp['hy_bias'])
    y = merge_branches(ya, yb, yc, gates, lp['w_branch'], lp['w_out'])
    if last:
        return y, None
    aqc = parts_c[4].reshape(B, Lc, A_HEADS, HEAD_DIM)
    bqc = parts_c[5].reshape(B, Lc, B_HEADS, HEAD_DIM)
    yac = ctx_attn_a(aqc, akc, avc, lp['sink_a'])
    ybc = ctx_attn_b(bqc, bkc, bvc)
    filt_c = hyena_filters(Lc, lp['hy_w1'], lp['hy_b1'], lp['hy_w2'], lp['hy_b2'], lp['hy_w3'], lp['hy_freq'])
    ycc = hyena(parts_c[6], lp['conv_c_w'], lp['conv_c_b'], filt_c, lp['hy_bias'])
    yctx = merge_branches(yac, ybc, ycc, parts_c[7], lp['w_branch'], lp['w_out'])
    return y, yctx


def swiglu(h, w1, w3, w2):
    return (jax.nn.silu(h @ w1) * (h @ w3)) @ w2


def moe_top2(h, router, w1, w3, w2):
    logits = (h @ router).astype(jnp.float32)
    top_v, top_i = lax.top_k(logits, TOP_K)
    top_w = jax.nn.softmax(top_v, axis=-1)
    combine = jnp.sum(jax.nn.one_hot(top_i, N_EXPERTS, dtype=jnp.float32) * top_w[..., None],
                      axis=-2).astype(h.dtype)

    def per_sample(args):
        hs, cs = args
        a = jnp.einsum('ld,edf->lef', hs, w1)
        b = jnp.einsum('ld,edf->lef', hs, w3)
        return jnp.einsum('lef,efd->ld', jax.nn.silu(a) * b * cs[:, :, None], w2)

    return lax.map(per_sample, (h, combine))


def setup_inputs(seed: int = 0) -> dict:
    key = jax.random.key(seed)
    ks = iter(jax.random.split(key, 40))
    f32 = jnp.float32

    def nrm(shape, scale):
        return jax.random.normal(next(ks), shape, f32) * scale

    def gain(shape):
        return 1.0 + nrm(shape, 0.02)

    D = D_MODEL
    return {
        "x": nrm((BATCH, SEQ, D), 1.0),
        "c": nrm((BATCH, D), 1.0),
        "ctx": nrm((BATCH, CTX_LEN, D), 1.0),
        "c_ctx": nrm((D,), 1.0),
        "w_mod": nrm((DEPTH, D, 6 * D), 0.5 * D ** -0.5),
        "b_mod": nrm((DEPTH, 6 * D), 0.02),
        "g_mix_pre": gain((DEPTH, D)),
        "g_mix_post": gain((DEPTH, D)),
        "g_ffn_pre": gain((DEPTH, D)),
        "g_ffn_post": gain((DEPTH, D)),
        "w_in": nrm((DEPTH, D, IN_COLS), D ** -0.5),
        "sink_a": nrm((DEPTH, A_HEADS), 0.5),
        "rpb_b": nrm((DEPTH, B_HEADS, 2 * NA_ROWS - 1, 2 * NA_COLS - 1), 0.5),
        "conv_c_w": nrm((DEPTH, 3, 3 * C_WIDTH), 3 ** -0.5),
        "conv_c_b": nrm((DEPTH, 3 * C_WIDTH), 0.02),
        "hy_w1": nrm((DEPTH, HY_EMB, HY_HIDDEN), HY_EMB ** -0.5),
        "hy_b1": nrm((DEPTH, HY_HIDDEN), 0.02),
        "hy_w2": nrm((DEPTH, HY_HIDDEN, HY_HIDDEN), HY_HIDDEN ** -0.5),
        "hy_b2": nrm((DEPTH, HY_HIDDEN), 0.02),
        "hy_w3": nrm((DEPTH, HY_HIDDEN, HY_DIRS * HY_ORDER * C_WIDTH), HY_HIDDEN ** -0.5),
        "hy_freq": gain((DEPTH, HY_HIDDEN)),
        "hy_bias": nrm((DEPTH, HY_ORDER, C_WIDTH), 1.0),
        "w_branch": nrm((DEPTH, N_BRANCH, BRANCH_W, D), BRANCH_W ** -0.5),
        "w_out": nrm((DEPTH, D, D), D ** -0.5),
        "ffn_w1": nrm((N_DENSE, D, D_FF), D ** -0.5),
        "ffn_w3": nrm((N_DENSE, D, D_FF), D ** -0.5),
        "ffn_w2": nrm((N_DENSE, D_FF, D), D_FF ** -0.5),
        "moe_router": nrm((N_MOE, D, N_EXPERTS), D ** -0.5),
        "moe_w1": nrm((N_MOE, N_EXPERTS, D, D_FF_E), D ** -0.5),
        "moe_w3": nrm((N_MOE, N_EXPERTS, D, D_FF_E), D ** -0.5),
        "moe_w2": nrm((N_MOE, N_EXPERTS, D_FF_E, D), D_FF_E ** -0.5),
    }


def reference(x, c, ctx, c_ctx, w_mod, b_mod, g_mix_pre, g_mix_post, g_ffn_pre, g_ffn_post,
              w_in, sink_a, rpb_b, conv_c_w, conv_c_b, hy_w1, hy_b1, hy_w2, hy_b2, hy_w3,
              hy_freq, hy_bias, w_branch, w_out, ffn_w1, ffn_w3, ffn_w2,
              moe_router, moe_w1, moe_w3, moe_w2):
    silu_c = jax.nn.silu(c)
    silu_cc = jax.nn.silu(c_ctx)
    for l in range(DEPTH):
        last = l == DEPTH - 1
        mod = (silu_c @ w_mod[l] + b_mod[l])[:, None, :]
        modc = (silu_cc @ w_mod[l] + b_mod[l])[None, None, :]
        sh_m, sc_m, gt_m, sh_f, sc_f, gt_f = jnp.split(mod, 6, axis=-1)
        shc_m, scc_m, gtc_m, shc_f, scc_f, gtc_f = jnp.split(modc, 6, axis=-1)
        lp = dict(w_in=w_in[l], sink_a=sink_a[l], rpb_b=rpb_b[l], conv_c_w=conv_c_w[l],
                  conv_c_b=conv_c_b[l], hy_w1=hy_w1[l], hy_b1=hy_b1[l], hy_w2=hy_w2[l],
                  hy_b2=hy_b2[l], hy_w3=hy_w3[l], hy_freq=hy_freq[l], hy_bias=hy_bias[l],
                  w_branch=w_branch[l], w_out=w_out[l])
        h = rmsnorm(x, g_mix_pre[l]) * (1.0 + sc_m) + sh_m
        hc = rmsnorm(ctx, g_mix_pre[l]) * (1.0 + scc_m) + shc_m
        y, yctx = mixer_block(h, hc, lp, last)
        x = x + gt_m * rmsnorm(y, g_mix_post[l])
        if not last:
            ctx = ctx + gtc_m * rmsnorm(yctx, g_mix_post[l])
        h = rmsnorm(x, g_ffn_pre[l]) * (1.0 + sc_f) + sh_f
        j = l // 2
        if l % 2 == 0:
            y = swiglu(h, ffn_w1[j], ffn_w3[j], ffn_w2[j])
        else:
            y = moe_top2(h, moe_router[j], moe_w1[j], moe_w3[j], moe_w2[j])
        x = x + gt_f * rmsnorm(y, g_ffn_post[l])
        if not last:
            hc = rmsnorm(ctx, g_ffn_pre[l]) * (1.0 + scc_f) + shc_f
            if l % 2 == 0:
                yc = swiglu(hc, ffn_w1[j], ffn_w3[j], ffn_w2[j])
            else:
                yc = moe_top2(hc, moe_router[j], moe_w1[j], moe_w3[j], moe_w2[j])
            ctx = ctx + gtc_f * rmsnorm(yc, g_ffn_post[l])
    return x
```

```cpp
#include <hip/hip_runtime.h>
#include <cstdio>
#include <cstdint>
namespace pg8 {
#define PG8_LAS __attribute__((address_space(3)))
typedef unsigned short bf16_t;
typedef short bf16x8 __attribute__((ext_vector_type(8)));
typedef float f32x4 __attribute__((ext_vector_type(4)));
typedef unsigned u32x4 __attribute__((ext_vector_type(4)));
constexpr int BM = 256, BK = 64, HALF = 128, HTB = HALF * BK * 2  , STAGE_BYTES = 8 * HTB, NXCD = 8, WGM = 8;

__host__ __device__ __forceinline__ int lds_byte(int r, int c) { const int st = (r >> 4) * 2 + (c >> 5), rr = r & 15, cc = c & 31, ob = rr * 64 + cc * 2; return st * 1024 + (ob ^ (((ob >> 9) & 1) << 5)); }
__host__ __device__ __forceinline__ void stage_rc(int b, int& R, int& C) { const int st = b / 1024, sb = b % 1024, swz = sb ^ (((sb >> 9) & 1) << 5); R = (st >> 1) * 16 + swz / 64; C = (st & 1) * 32 + (swz % 64) / 2; }
__host__ __device__ __forceinline__ int perm32(int rho) { const int n = rho >> 4, i = rho & 15; return 8 * (i >> 2) + 4 * n + (i & 3); }

struct Unit { int pm, pn; };
struct Gemm { const bf16_t* A; const bf16_t* Bt; int M, N, K; };

struct StaticOrder {
    int nM, nN, nwg, G, c;
    __host__ __device__ void init(int M, int N, int G_, int c_) { nM = M / BM; nN = N / BM; nwg = nM * nN; G = G_; c = c_; }
    __host__ __device__ bool next(int i, Unit& u) const {
        const long L = (long)i * G + c; if (L >= nwg) return false;
        int wgid = (int)L; { const int q = nwg / NXCD, r = nwg % NXCD, xcd = wgid % NXCD, off = wgid / NXCD; wgid = (xcd < r ? xcd * (q + 1) : r * (q + 1) + (xcd - r) * q) + off; }
        const int nig = WGM * nN, gid = wgid / nig, fm = gid * WGM, gsz = (nM - fm) < WGM ? (nM - fm) : WGM;
        u.pm = fm + ((wgid % nig) % gsz); u.pn = (wgid % nig) / gsz; return true;
    }
    __device__ __forceinline__ void a_ready(const Unit&) const {}
    __device__ __forceinline__ void done(const Unit&) const {}
};

typedef float f32x2_t __attribute__((ext_vector_type(2)));
typedef __bf16 bf16x2_t __attribute__((ext_vector_type(2)));
__device__ __forceinline__ unsigned cvt_pk_bf16(float lo, float hi) { const f32x2_t v = {lo, hi}; const bf16x2_t b = __builtin_convertvector(v, bf16x2_t); return __builtin_bit_cast(unsigned, b); }
__device__ __forceinline__ u32x4 pack8(f32x4 a, f32x4 b) { u32x4 w; w.x = cvt_pk_bf16(a[0], a[1]); w.y = cvt_pk_bf16(a[2], a[3]); w.z = cvt_pk_bf16(b[0], b[1]); w.w = cvt_pk_bf16(b[2], b[3]); return w; }
__device__ __forceinline__ float bf_lo(unsigned w) { return __builtin_bit_cast(float, w << 16); }
__device__ __forceinline__ float bf_hi(unsigned w) { return __builtin_bit_cast(float, w & 0xffff0000u); }
__device__ __forceinline__ void unpack8(u32x4 w, f32x4& a, f32x4& b) { a = (f32x4){bf_lo(w.x), bf_hi(w.x), bf_lo(w.y), bf_hi(w.y)}; b = (f32x4){bf_lo(w.z), bf_hi(w.z), bf_lo(w.w), bf_hi(w.w)}; }
__device__ __forceinline__ float fast_sigmoid(float x) { return __builtin_amdgcn_rcpf(1.0f + __builtin_amdgcn_exp2f(-1.4426950408889634f * x)); }

struct EpiPlain {
    static constexpr bool PERM = true, AFTER_DRAIN = false;
    bf16_t* O; int ldc; int pn_mod; int accum;
    __device__ __forceinline__ void operator()(const f32x4 (&acc)[2][2][4][2], const Unit& u, int wr, int wc, int fr, int fq) const {
        const int pn = pn_mod ? (u.pn % pn_mod) : u.pn;
        const int row0 = u.pm * BM + wr * 64 + fr, col0 = pn * BM + wc * 32 + 8 * fq;
#pragma unroll
        for (int ai = 0; ai < 2; ++ai)
#pragma unroll
            for (int m = 0; m < 4; ++m) { bf16_t* rowp = O + (size_t)(row0 + ai * HALF + m * 16) * ldc + col0;
#pragma unroll
                for (int bj = 0; bj < 2; ++bj) { f32x4 v0 = acc[ai][bj][m][0], v1 = acc[ai][bj][m][1];
                    if (accum) { f32x4 p0, p1; unpack8(*(const u32x4*)(rowp + bj * HALF), p0, p1); v0 = v0 + p0; v1 = v1 + p1; }
                    *(u32x4*)(rowp + bj * HALF) = pack8(v0, v1); } }
    }
};
struct EpiSig {
    static constexpr bool PERM = true, AFTER_DRAIN = false;
    bf16_t* O; int ldc;
    __device__ __forceinline__ void operator()(const f32x4 (&acc)[2][2][4][2], const Unit& u, int wr, int wc, int fr, int fq) const {
        const int row0 = u.pm * BM + wr * 64 + fr, col0 = u.pn * BM + wc * 32 + 8 * fq;
#pragma unroll
        for (int ai = 0; ai < 2; ++ai)
#pragma unroll
            for (int m = 0; m < 4; ++m) { bf16_t* rowp = O + (size_t)(row0 + ai * HALF + m * 16) * ldc + col0;
#pragma unroll
                for (int bj = 0; bj < 2; ++bj) { f32x4 v0 = acc[ai][bj][m][0], v1 = acc[ai][bj][m][1];
#pragma unroll
                    for (int e = 0; e < 4; ++e) { v0[e] = fast_sigmoid(v0[e]); v1[e] = fast_sigmoid(v1[e]); }
                    *(u32x4*)(rowp + bj * HALF) = pack8(v0, v1); } }
    }
};
struct EpiSwiGLU {
    static constexpr bool PERM = true, AFTER_DRAIN = false;
    bf16_t* O; int ldc; int pn_mod;
    __device__ __forceinline__ void operator()(const f32x4 (&acc)[2][2][4][2], const Unit& u, int wr, int wc, int fr, int fq) const {
        const int pn = pn_mod ? (u.pn % pn_mod) : u.pn;
        const int row0 = u.pm * BM + wr * 64 + fr, col0 = pn * HALF + wc * 32 + 8 * fq;
#pragma unroll
        for (int ai = 0; ai < 2; ++ai)
#pragma unroll
            for (int m = 0; m < 4; ++m) { bf16_t* rowp = O + (size_t)(row0 + ai * HALF + m * 16) * ldc + col0;
                f32x4 v0 = acc[ai][0][m][0], v1 = acc[ai][0][m][1]; const f32x4 g0 = acc[ai][1][m][0], g1 = acc[ai][1][m][1];
#pragma unroll
                for (int e = 0; e < 4; ++e) { v0[e] = v0[e] * fast_sigmoid(v0[e]) * g0[e]; v1[e] = v1[e] * fast_sigmoid(v1[e]) * g1[e]; }
                *(u32x4*)rowp = pack8(v0, v1); }
    }
};
struct EpiMerge {
    static constexpr bool PERM = true, AFTER_DRAIN = false;
    bf16_t* Mo; const bf16_t* Gt; int pms;
    __device__ __forceinline__ void operator()(const f32x4 (&acc)[2][2][4][2], const Unit& u, int wr, int wc, int fr, int fq) const {
        const int br = u.pn >> 2, pn = u.pn & 3, pm = u.pm - br * pms;
        const int row0 = pm * BM + wr * 64 + fr, col0 = pn * BM + wc * 32 + 8 * fq;
#pragma unroll
        for (int ai = 0; ai < 2; ++ai)
#pragma unroll
            for (int m = 0; m < 4; ++m) { const size_t row = (size_t)(row0 + ai * HALF + m * 16); bf16_t* rowp = Mo + row * 1024 + col0; const bf16_t* gp = Gt + row * 3072 + br * 1024 + col0;
#pragma unroll
                for (int bj = 0; bj < 2; ++bj) { f32x4 g0, g1; unpack8(*(const u32x4*)(gp + bj * HALF), g0, g1);
                    f32x4 v0 = acc[ai][bj][m][0] * g0, v1 = acc[ai][bj][m][1] * g1;
                    if (br) { f32x4 p0, p1; unpack8(*(const u32x4*)(rowp + bj * HALF), p0, p1); v0 = v0 + p0; v1 = v1 + p1; }
                    *(u32x4*)(rowp + bj * HALF) = pack8(v0, v1); } }
    }
};
struct EpiQKV {
    static constexpr bool PERM = true, AFTER_DRAIN = false;
    bf16_t* O; const float* rope; int row_base; float qscale;
    __device__ __forceinline__ void operator()(const f32x4 (&acc)[2][2][4][2], const Unit& u, int wr, int wc, int fr, int fq) const {
        const int rowt = row_base + u.pm * BM;
        const bool latent = rowt < 65536;
        const int row0 = rowt + wr * 64 + fr, col0 = u.pn * BM + wc * 32 + 8 * fq;
#pragma unroll
        for (int bj = 0; bj < 2; ++bj) {
            const int cb = 2 * u.pn + bj;
            const bool do_rope = latent && (cb == 0 || (cb >= 10 && cb < 14));
            const float sc = (cb >= 10) ? qscale : 1.0f;
#pragma unroll
            for (int ai = 0; ai < 2; ++ai)
#pragma unroll
                for (int m = 0; m < 4; ++m) {
                    const int row = row0 + ai * HALF + m * 16;
                    f32x4 v0 = acc[ai][bj][m][0], v1 = acc[ai][bj][m][1];
                    if (do_rope) {
                        const int t = row & 2047, pos = (wc & 1) ? (t & 63) : (t >> 6);
                        const float* cp = rope + pos * 16 + 8 * (fq & 1);
                        const f32x4 c0 = *(const f32x4*)cp, c1 = *(const f32x4*)(cp + 4), s0 = *(const f32x4*)(cp + 1024), s1 = *(const f32x4*)(cp + 1028);
                        const float sg = (fq >= 2) ? 1.0f : -1.0f;
                        f32x4 o0, o1;
#pragma unroll
                        for (int e = 0; e < 4; ++e) { o0[e] = __shfl_xor(v0[e], 32); o1[e] = __shfl_xor(v1[e], 32); }
                        v0 = v0 * c0 + (o0 * sg) * s0; v1 = v1 * c1 + (o1 * sg) * s1;
                    }
                    v0 = v0 * sc; v1 = v1 * sc;
                    *(u32x4*)(O + (size_t)row * 2304 + col0 + bj * HALF) = pack8(v0, v1);
                }
        }
    }
};
__device__ __forceinline__ void tile_of(int L, int nM, int nN, int& pm, int& pn) {
    const int nwg = nM * nN; int wgid = L; { const int q = nwg / NXCD, r = nwg % NXCD, xcd = wgid % NXCD, off = wgid / NXCD; wgid = (xcd < r ? xcd * (q + 1) : r * (q + 1) + (xcd - r) * q) + off; }
    const int nig = WGM * nN, gid = wgid / nig, fm = gid * WGM, gsz = (nM - fm) < WGM ? (nM - fm) : WGM;
    pm = fm + ((wgid % nig) % gsz); pn = (wgid % nig) / gsz;
}
struct MergeOrder {
    int nM, G, c, pms;
    __device__ bool next(int i, Unit& u) const {
        const int t = i / 3, br = i - 3 * t; const long L = (long)t * G + c; if (L >= (long)nM * 4) return false;
        int pm, pn; tile_of((int)L, nM, 4, pm, pn); u.pm = br * pms + pm; u.pn = br * 4 + pn; return true;
    }
    __device__ __forceinline__ void a_ready(const Unit&) const {}
    __device__ __forceinline__ void done(const Unit&) const {}
};
struct GroupOrder {
    int nM, nN, G, c; int toff[9];
    __device__ bool next(int i, Unit& u) const {
        const long L = (long)i * G + c; if (L >= (long)nM * nN) return false;
        int pm, pn; tile_of((int)L, nM, nN, pm, pn); int e = 0;
#pragma unroll
        for (int k = 1; k < 8; ++k) e += (pm >= toff[k]) ? 1 : 0;
        u.pm = pm; u.pn = e * nN + pn; return true;
    }
    __device__ __forceinline__ void a_ready(const Unit&) const {}
    __device__ __forceinline__ void done(const Unit&) const {}
};
template <class Epi, class Sched, bool ALIGN_EPI = false, bool SP2 = false>
__device__ __forceinline__ void gemm_phase(PG8_LAS unsigned char* lds, const Gemm g, const Sched& S, const Epi& E, const int tid) {
    const int wid = __builtin_amdgcn_readfirstlane(tid >> 6), lane = tid & 63, wr = wid >> 2, wc = wid & 3, fr = lane & 15, fq = lane >> 4;
    const int K = g.K, nt = K / BK;
    unsigned voffA[2], voffB[2];
#pragma unroll
    for (int i = 0; i < 2; ++i) { int R, C; stage_rc(tid * 16 + i * 8192, R, C); const int Rb = Epi::PERM ? ((R & ~31) + perm32(R & 31)) : R;
        voffA[i] = (unsigned)(R * K + C) * 2u; voffB[i] = (unsigned)(Rb * K + C) * 2u; }
    const size_t kstep = (size_t)(BK * 2);
    const size_t hstep = (size_t)HALF * K * 2;
    const size_t tstep = 2 * hstep;
    const unsigned ldsw = (unsigned)wid * 1024u;
    const int aoff = lds_byte(wr * 64 + fr, fq * 8), boff = lds_byte(wc * 32 + fr, fq * 8);
#define PG8_SA(b, h) (((b) * 2 + (h)) * HTB)
#define PG8_SB(b, h) ((4 + (b) * 2 + (h)) * HTB)
#define PG8_STAGE(bufoff, gbase, voff) do { _Pragma("unroll") for (int _i = 0; _i < 2; ++_i) \
        __builtin_amdgcn_global_load_lds((const unsigned*)((const char*)(gbase) + (voff)[_i]), (PG8_LAS unsigned*)(lds + (bufoff) + ldsw + _i * 8192), 16, 0, 0); } while (0)
#define PG8_LDA(dst, b, h) do { _Pragma("unroll") for (int m = 0; m < 4; ++m) _Pragma("unroll") for (int k = 0; k < 2; ++k) dst[m][k] = *(const PG8_LAS bf16x8*)(lds + PG8_SA(b, h) + aoff + m * 2048 + k * 1024); } while (0)
#define PG8_LDB(dst, b, h) do { _Pragma("unroll") for (int n = 0; n < 2; ++n) _Pragma("unroll") for (int k = 0; k < 2; ++k) dst[n][k] = *(const PG8_LAS bf16x8*)(lds + PG8_SB(b, h) + boff + n * 2048 + k * 1024); } while (0)
#define PG8_MMA(ai, bj, At, Bt) do { __builtin_amdgcn_s_setprio(1); _Pragma("unroll") for (int m = 0; m < 4; ++m) _Pragma("unroll") for (int n = 0; n < 2; ++n) _Pragma("unroll") for (int k = 0; k < 2; ++k) \
        acc[ai][bj][m][n] = __builtin_amdgcn_mfma_f32_16x16x32_bf16(Bt[n][k], At[m][k], acc[ai][bj][m][n], 0, 0, 0); __builtin_amdgcn_s_setprio(0); } while (0)
#define PG8_WAIT_V(n) asm volatile("s_waitcnt vmcnt(" #n ")" ::: "memory")
#define PG8_WAIT_L(n) asm volatile("s_waitcnt lgkmcnt(" #n ")" ::: "memory")
#define PG8_BAR __builtin_amdgcn_s_barrier()
#define PG8_SCHED __builtin_amdgcn_sched_barrier(0)
    Unit cur, nxt; int ui = 0;
    if (!S.next(0, cur)) return;
    f32x4 acc[2][2][4][2];
#pragma unroll
    for (int a = 0; a < 2; ++a)
#pragma unroll
        for (int b = 0; b < 2; ++b)
#pragma unroll
            for (int m = 0; m < 4; ++m)
#pragma unroll
                for (int n = 0; n < 2; ++n) acc[a][b][m][n] = (f32x4){0.f, 0.f, 0.f, 0.f};
    bf16x8 At[4][2], B0[2][2], B1[2][2];
    const char* cA = (const char*)g.A + (size_t)cur.pm * tstep; const char* cB = (const char*)g.Bt + (size_t)cur.pn * tstep;
    S.a_ready(cur);
    if constexpr (SP2) {
        PG8_STAGE(PG8_SB(0, 0), cB, voffB); PG8_STAGE(PG8_SB(0, 1), cB + hstep, voffB); PG8_STAGE(PG8_SA(0, 0), cA, voffA); PG8_STAGE(PG8_SA(0, 1), cA + hstep, voffA);
        if (wr == 1) PG8_BAR;
        PG8_WAIT_V(2); PG8_BAR;
        PG8_STAGE(PG8_SB(1, 0), cB + kstep, voffB); PG8_STAGE(PG8_SA(1, 0), cA + kstep, voffA); PG8_STAGE(PG8_SB(1, 1), cB + hstep + kstep, voffB);
        PG8_WAIT_V(6); PG8_BAR;
    } else {
        PG8_STAGE(PG8_SB(0, 0), cB, voffB); PG8_STAGE(PG8_SA(0, 0), cA, voffA); PG8_STAGE(PG8_SB(0, 1), cB + hstep, voffB); PG8_STAGE(PG8_SA(0, 1), cA + hstep, voffA);
        if (wr == 1) PG8_BAR;
        PG8_WAIT_V(4); PG8_BAR;
        PG8_STAGE(PG8_SB(1, 0), cB + kstep, voffB); PG8_STAGE(PG8_SA(1, 0), cA + kstep, voffA); PG8_STAGE(PG8_SB(1, 1), cB + hstep + kstep, voffB);
        PG8_WAIT_V(6); PG8_BAR;
    }
    for (;;) {
        const bool has_next = S.next(ui + 1, nxt);
        const char* nA = has_next ? (const char*)g.A + (size_t)nxt.pm * tstep : cA; const char* nB = has_next ? (const char*)g.Bt + (size_t)nxt.pn * tstep : cB;
        for (int t = 0; t < nt; t += 2) {
            const bool last = (t == nt - 2);
            const char* a1 = cA + (size_t)(t + 1) * kstep;
            const char* a2 = last ? nA : cA + (size_t)(t + 2) * kstep; const char* b2 = last ? nB : cB + (size_t)(t + 2) * kstep;
            const char* a3 = a2 + kstep; const char* b3 = b2 + kstep;
            if (last && has_next) S.a_ready(nxt);
            if constexpr (SP2) {
            PG8_LDB(B0, 0, 0); PG8_LDB(B1, 0, 1); PG8_SCHED; PG8_LDA(At, 0, 0); PG8_STAGE(PG8_SA(1, 1), a1 + hstep, voffA);
            PG8_WAIT_V(8); PG8_WAIT_L(0); PG8_BAR; PG8_MMA(0, 0, At, B0); PG8_MMA(0, 1, At, B1); PG8_BAR; PG8_SCHED;
            PG8_LDA(At, 0, 1); PG8_STAGE(PG8_SB(0, 0), b2, voffB); PG8_STAGE(PG8_SB(0, 1), b2 + hstep, voffB); PG8_STAGE(PG8_SA(0, 0), a2, voffA);
            PG8_WAIT_V(8); PG8_WAIT_L(0); PG8_BAR; PG8_MMA(1, 0, At, B0); PG8_MMA(1, 1, At, B1); PG8_BAR; PG8_SCHED;
            PG8_LDB(B0, 1, 0); PG8_LDB(B1, 1, 1); PG8_SCHED; PG8_LDA(At, 1, 0); PG8_STAGE(PG8_SA(0, 1), a2 + hstep, voffA);
            PG8_WAIT_V(8); PG8_WAIT_L(0); PG8_BAR; PG8_MMA(0, 0, At, B0); PG8_MMA(0, 1, At, B1); PG8_BAR; PG8_SCHED;
            PG8_LDA(At, 1, 1); PG8_STAGE(PG8_SB(1, 0), b3, voffB); PG8_STAGE(PG8_SB(1, 1), b3 + hstep, voffB); PG8_STAGE(PG8_SA(1, 0), a3, voffA);
            PG8_WAIT_V(8); PG8_WAIT_L(0); PG8_BAR; PG8_MMA(1, 0, At, B0); PG8_MMA(1, 1, At, B1); PG8_BAR; PG8_SCHED;
            } else {
            PG8_LDB(B0, 0, 0); PG8_SCHED; PG8_LDA(At, 0, 0); PG8_STAGE(PG8_SA(1, 1), a1 + hstep, voffA);
            PG8_WAIT_L(8); PG8_BAR; PG8_WAIT_L(0); PG8_MMA(0, 0, At, B0); PG8_BAR; PG8_SCHED;
            PG8_LDB(B1, 0, 1); PG8_STAGE(PG8_SB(0, 0), b2, voffB);
            PG8_BAR; PG8_WAIT_L(0); PG8_MMA(0, 1, At, B1); PG8_BAR;
            PG8_LDA(At, 0, 1); PG8_STAGE(PG8_SA(0, 0), a2, voffA);
            PG8_BAR; PG8_WAIT_L(0); PG8_MMA(1, 0, At, B0); PG8_BAR; PG8_SCHED;
            PG8_STAGE(PG8_SB(0, 1), b2 + hstep, voffB);
            PG8_WAIT_V(6); PG8_BAR; PG8_MMA(1, 1, At, B1); PG8_BAR;
            PG8_LDB(B0, 1, 0); PG8_SCHED; PG8_LDA(At, 1, 0); PG8_STAGE(PG8_SA(0, 1), a2 + hstep, voffA);
            PG8_WAIT_L(8); PG8_BAR; PG8_WAIT_L(0); PG8_MMA(0, 0, At, B0); PG8_BAR; PG8_SCHED;
            PG8_LDB(B1, 1, 1); PG8_STAGE(PG8_SB(1, 0), b3, voffB);
            PG8_BAR; PG8_WAIT_L(0); PG8_MMA(0, 1, At, B1); PG8_BAR;
            PG8_LDA(At, 1, 1); PG8_STAGE(PG8_SA(1, 0), a3, voffA);
            PG8_BAR; PG8_WAIT_L(0); PG8_MMA(1, 0, At, B0); PG8_BAR; PG8_SCHED;
            PG8_STAGE(PG8_SB(1, 1), b3 + hstep, voffB);
            PG8_WAIT_V(6); PG8_BAR; PG8_MMA(1, 1, At, B1); PG8_BAR;
            }
        }
        if constexpr (ALIGN_EPI) { if (wr == 0) PG8_BAR; }
        if constexpr (!Epi::AFTER_DRAIN) { E(acc, cur, wr, wc, fr, fq); S.done(cur); }
        if (!has_next) break;
#pragma unroll
        for (int a = 0; a < 2; ++a)
#pragma unroll
            for (int b = 0; b < 2; ++b)
#pragma unroll
                for (int m = 0; m < 4; ++m)
#pragma unroll
                    for (int n = 0; n < 2; ++n) acc[a][b][m][n] = (f32x4){0.f, 0.f, 0.f, 0.f};
        cur = nxt; cA = nA; cB = nB; ++ui;
        if constexpr (ALIGN_EPI) { if (wr == 1) PG8_BAR; }
    }
    PG8_WAIT_V(0);
    if constexpr (!ALIGN_EPI) { if (wr == 0) PG8_BAR; }
    PG8_BAR;
    if constexpr (Epi::AFTER_DRAIN) { E.fused(acc, cur, wr, wc, fr, fq, lds, wid, lane); S.done(cur); }
#undef PG8_SA
#undef PG8_SB
#undef PG8_STAGE
#undef PG8_LDA
#undef PG8_LDB
#undef PG8_MMA
#undef PG8_WAIT_V
#undef PG8_WAIT_L
#undef PG8_BAR
#undef PG8_SCHED
}
}
#define GAS __attribute__((address_space(1)))
#define LAS __attribute__((address_space(3)))
typedef unsigned short bf16;
typedef unsigned v4u __attribute__((ext_vector_type(4)));
typedef float f32x4 __attribute__((ext_vector_type(4)));
typedef short bf16x8 __attribute__((ext_vector_type(8)));
typedef GAS unsigned gu32;
typedef GAS unsigned long long gu64;
#define RLX_AGENT __ATOMIC_RELAXED, __HIP_MEMORY_SCOPE_AGENT
#define LDS_WAIT() asm volatile("s_waitcnt lgkmcnt(0)" ::: "memory")
#define VM_WAIT() asm volatile("s_waitcnt vmcnt(0)" ::: "memory")
__device__ __forceinline__ unsigned long long rt() { return __builtin_amdgcn_s_memrealtime(); }
__device__ __forceinline__ unsigned f2bf(float f) { unsigned u = __builtin_bit_cast(unsigned, f); return (u + 0x7fffu + ((u >> 16) & 1u)) >> 16; }
__device__ __forceinline__ unsigned pk2(float lo, float hi) { return pg8::cvt_pk_bf16(lo, hi); }

#define XB_TMO      128
#define XB_XCNT(j)  (256  + 64 * (j))
#define XB_XSUB(j)  (1280 + 64 * (j))
#define XB_XGEN(j)  (2304 + 64 * (j))
#define XB_TOP      3328
#define XB_TOPGEN   3392
#define XCD_BAR_WORDS 3456
#define XB_SPIN_CAP (1u << 18)

__device__ __forceinline__ unsigned xb_ld(unsigned* p)              { return __hip_atomic_load(p, __ATOMIC_RELAXED, __HIP_MEMORY_SCOPE_AGENT); }
__device__ __forceinline__ unsigned xb_add(unsigned* p, unsigned v) { return __hip_atomic_fetch_add(p, v, __ATOMIC_RELAXED, __HIP_MEMORY_SCOPE_AGENT); }
__device__ __forceinline__ unsigned xb_xcc_id() { return (unsigned)__builtin_amdgcn_s_getreg((3 << 11) | 20) & 0xFu; }
#define XB_SPIN(cond, bar) do { unsigned _sp = 0; while (cond) { __builtin_amdgcn_s_sleep(1); \
    if ((++_sp & 255u) == 0u) { if (xb_ld(&(bar)[XB_TMO])) break; if (_sp > XB_SPIN_CAP) { atomicAdd(&(bar)[XB_TMO], 1u); break; } } } } while (0)

struct XcdBarrier {
    unsigned* bar; unsigned x;
    volatile LAS unsigned* st;
};

__device__ __forceinline__ XcdBarrier xcd_barrier_post(unsigned* bar, volatile LAS unsigned* st) {
    XcdBarrier b; b.bar = bar; b.x = xb_xcc_id(); b.st = st;
    if (threadIdx.x == 0) (void)xb_add(&bar[XB_XCNT(b.x)], 1u);
    return b;
}
__device__ __forceinline__ void xcd_barrier_complete(unsigned* bar, unsigned x, unsigned& nloc, unsigned& nx) {
    const unsigned G = gridDim.x * gridDim.y * gridDim.z;
    unsigned sum, cnt, mine, sp = 0u;
    for (;;) {
        sum = 0u; cnt = 0u; mine = 0u;
#pragma unroll
        for (unsigned j = 0; j < 16; ++j) { const unsigned c = xb_ld(&bar[XB_XCNT(j)]); sum += c; cnt += (c > 0u) ? 1u : 0u; mine = (j == x) ? c : mine; }
        if (sum == G) break;
        __builtin_amdgcn_s_sleep(1);
        if ((++sp & 255u) == 0u) { if (xb_ld(&bar[XB_TMO])) break; if (sp > XB_SPIN_CAP) { atomicAdd(&bar[XB_TMO], 1u); break; } }
    }
    nloc = mine > 0u ? mine : 1u; nx = cnt > 0u ? cnt : 1u;
}

__device__ __forceinline__ void xcd_barrier(const XcdBarrier& b) {
    asm volatile("s_waitcnt vmcnt(0)" ::: "memory");
    __syncthreads();
    if (threadIdx.x == 0) {
        unsigned* bar = b.bar;
        __builtin_amdgcn_s_waitcnt(0);
        unsigned nloc = b.st[0], nx = b.st[1];
        if (nloc == 0u) { xcd_barrier_complete(bar, b.x, nloc, nx); b.st[0] = nloc; b.st[1] = nx; }
        const unsigned old = xb_add(&bar[XB_XSUB(b.x)], 1u);
        const unsigned gen = old / nloc;
        if (old + 1u == (gen + 1u) * nloc) {
            __builtin_amdgcn_fence(__ATOMIC_RELEASE, "agent");
            asm volatile("s_waitcnt vmcnt(0)" ::: "memory");
            const unsigned og = xb_add(&bar[XB_TOP], 1u);
            const unsigned tg = og / nx;
            if (og + 1u == (tg + 1u) * nx) xb_add(&bar[XB_TOPGEN], 1u);
            else XB_SPIN(xb_ld(&bar[XB_TOPGEN]) == tg, bar);
            __builtin_amdgcn_fence(__ATOMIC_ACQUIRE, "agent");
            xb_add(&bar[XB_XGEN(b.x)], 1u);
            asm volatile("s_waitcnt vmcnt(0)" ::: "memory");
        } else {
            XB_SPIN(xb_ld(&bar[XB_XGEN(b.x)]) == gen, bar);
            __builtin_amdgcn_fence(__ATOMIC_ACQUIRE, "agent");
            asm volatile("s_waitcnt vmcnt(0)" ::: "memory");
        }
    }
    __syncthreads();
}

typedef float f32x16 __attribute__((ext_vector_type(16)));
typedef short s16x4 __attribute__((ext_vector_type(4)));
typedef unsigned v2u __attribute__((ext_vector_type(2)));
#define MFMA32(a, b, c) __builtin_amdgcn_mfma_f32_32x32x16_bf16((a), (b), (c), 0, 0, 0)

constexpr int NWAVES = 8, NTHREADS = 512;
constexpr int D = 1024, NB = 32, SEQ = 2048, LC = 256, NTOK = NB * SEQ, NCTX = NB * LC, NROW = NTOK + NCTX;
constexpr int INC = 6912, QKVC = 2304, CINC = 1536, GATEC = 3072, DFF = 2816, NEXP = 8, DFFE = 3584, FCH = 1792;
constexpr float LOG2E = 1.4426950408889634f, QSCALE = 0.125f * LOG2E, EPS = 1e-6f;
constexpr int PCAP = 32768 * 2 + 8 * 256;

constexpr size_t MiB = 1u << 20;
constexpr size_t WS_CTL = 0, CTL_ZERO_BYTES = 1 * MiB;
constexpr size_t WS_MODV = 1 * MiB;
constexpr size_t WS_ROPE = 3 * MiB;
constexpr size_t WS_ROUTE = 4 * MiB;
constexpr size_t WS_LIST = 5 * MiB;
constexpr size_t WS_INV = 7 * MiB;
constexpr size_t WS_GF = 8 * MiB;
constexpr size_t WS_GFC = 24 * MiB;
constexpr size_t WS_W = 26 * MiB;
constexpr size_t W_IN = WS_W;
constexpr size_t W_BR = W_IN + (size_t)2 * INC * D * 2;
constexpr size_t W_OUT = W_BR + (size_t)2 * 3 * D * 512 * 2;
constexpr size_t W_F13 = W_OUT + (size_t)2 * D * D * 2;
constexpr size_t W_F2 = W_F13 + (size_t)2 * DFF * D * 2;
constexpr size_t W_END = W_F2 + (size_t)D * DFF * 2;
constexpr size_t WS_CTXRES = 80 * MiB;
constexpr size_t WS_H = 112 * MiB;
constexpr size_t WS_BIG = 256 * MiB;
constexpr size_t BIG_CINT = WS_BIG;
constexpr size_t BIG_QKV = WS_BIG + 216 * MiB;
constexpr size_t BIG_GATE = WS_BIG + 108 * MiB;
constexpr size_t BIG_HID = WS_BIG;
constexpr size_t BIG_RAW = WS_BIG;
constexpr size_t BIG_AS = WS_BIG;
constexpr size_t BIG_MH = WS_BIG + 132 * MiB;
constexpr size_t BIG_Y2S = WS_BIG + 364 * MiB;
constexpr size_t WS_Y3 = 796 * MiB;
constexpr size_t WM_13 = WS_Y3;
constexpr size_t WM_2 = WS_Y3 + 112 * MiB;
constexpr size_t WS_END = 1012 * MiB;
static_assert(W_END <= WS_CTXRES && BIG_Y2S + (size_t)PCAP * D * 2 <= WS_Y3 && BIG_QKV + (size_t)NROW * QKVC * 2 <= WS_Y3 && BIG_GATE + (size_t)NROW * GATEC * 2 <= WS_Y3, "ws map");
static_assert(BIG_MH + (size_t)PCAP * FCH * 2 <= BIG_Y2S && BIG_AS + (size_t)PCAP * D * 2 <= BIG_MH && WM_2 + (size_t)2 * 8 * D * FCH * 2 <= WS_END, "ws map 2");

constexpr int CW_BAR = 4096;
constexpr int CW_CNT = 16384;

constexpr int LDS_BYTES = 150528, MISC_OFF = 147456;


struct Args {
    const float* in[31];
    float* out; unsigned char* ws;
    int ph_lo, ph_hi;
};
enum { I_X = 0, I_C, I_CTX, I_CCTX, I_WMOD, I_BMOD, I_GMIXPRE, I_GMIXPOST, I_GFFNPRE, I_GFFNPOST, I_WIN, I_SINK, I_RPB, I_CONVW, I_CONVB, I_HW1, I_HB1, I_HW2, I_HB2, I_HW3,
       I_HFREQ, I_HBIAS, I_WBR, I_WOUT, I_FW1, I_FW3, I_FW2, I_ROUTER, I_MW1, I_MW3, I_MW2 };

struct Frame {
    LAS unsigned char* lds;
    int tid, lane, wave, vcu, G;
    unsigned char* ws;
};

__device__ __forceinline__ float wave_sum(float v) {
#pragma unroll
    for (int o = 1; o < 64; o <<= 1) v += __shfl_xor(v, o);
    return v;
}
__device__ __forceinline__ float bf2f(bf16 b) { return __builtin_bit_cast(float, ((unsigned)b) << 16); }
__device__ __forceinline__ float silu_f(float x) { return x / (1.0f + __expf(-x)); }

__device__ __forceinline__ void transpose_item(const float* W, int N, bf16* WT, int Kp, int k0, int n0, int drow0, LAS float* scr, int lane) {
#pragma unroll 8
    for (int i = 0; i < 32; ++i) { const int kk = 2 * i + (lane >> 5); scr[kk * 33 + (lane & 31)] = W[(size_t)(k0 + kk) * N + n0 + (lane & 31)]; }
    LDS_WAIT(); asm volatile("" ::: "memory");
    const int c = lane & 7;
#pragma unroll
    for (int j = 0; j < 4; ++j) { const int n = (lane >> 3) + 8 * j; const LAS float* s = scr + (8 * c) * 33 + n;
        v4u o; o.x = pk2(s[0 * 33], s[1 * 33]); o.y = pk2(s[2 * 33], s[3 * 33]); o.z = pk2(s[4 * 33], s[5 * 33]); o.w = pk2(s[6 * 33], s[7 * 33]);
        *(GAS v4u*)(WT + (size_t)(drow0 + n) * Kp + k0 + 8 * c) = o; }
    LDS_WAIT(); asm volatile("" ::: "memory");
}
__device__ __forceinline__ bool conv_job(int& r, const float* W, int K, int N, bf16* WT, int Kp, int rowoff, int mode, int which, LAS float* scr, int lane) {
    const int nblk = N / 32, items = (K / 64) * nblk;
    if (r >= items) { r -= items; return false; }
    const int kb = r / nblk, nb = r % nblk, n0 = 32 * nb;
    const int drow0 = mode ? rowoff + (n0 / 128) * 256 + which * 128 + (n0 % 128) : rowoff + n0;
    transpose_item(W, N, WT, Kp, 64 * kb, n0, drow0, scr, lane);
    return true;
}

__device__ __forceinline__ void ld_row_f32(const float* p, int lane, f32x4 (&v)[4]) {
    const GAS f32x4* q = (const GAS f32x4*)p + lane;
#pragma unroll
    for (int j = 0; j < 4; ++j) v[j] = q[64 * j];
}
__device__ __forceinline__ void st_row_f32(float* p, int lane, const f32x4 (&v)[4]) {
    GAS f32x4* q = (GAS f32x4*)p + lane;
#pragma unroll
    for (int j = 0; j < 4; ++j) q[64 * j] = v[j];
}
__device__ __forceinline__ void ld_row_bf16(const bf16* p, int lane, f32x4 (&v)[4]) {
    const GAS v2u* q = (const GAS v2u*)p + lane;
#pragma unroll
    for (int j = 0; j < 4; ++j) { const v2u w = q[64 * j]; v[j] = (f32x4){pg8::bf_lo(w.x), pg8::bf_hi(w.x), pg8::bf_lo(w.y), pg8::bf_hi(w.y)}; }
}
__device__ __forceinline__ void st_row_bf16(bf16* p, int lane, const f32x4 (&v)[4]) {
    GAS v2u* q = (GAS v2u*)p + lane;
#pragma unroll
    for (int j = 0; j < 4; ++j) { v2u w; w.x = pk2(v[j].x, v[j].y); w.y = pk2(v[j].z, v[j].w); q[64 * j] = w; }
}
__device__ __forceinline__ float row_rms_scale(const f32x4 (&v)[4]) {
    float s = 0.f;
#pragma unroll
    for (int j = 0; j < 4; ++j) s += (v[j].x * v[j].x + v[j].y * v[j].y) + (v[j].z * v[j].z + v[j].w * v[j].w);
    return __builtin_amdgcn_rsqf(wave_sum(s) * (1.0f / D) + EPS);
}
__device__ __forceinline__ void norm_mod(const f32x4 (&x)[4], const float* g, const float* sc, const float* sh, int lane, f32x4 (&h)[4]) {
    const float rs = row_rms_scale(x);
    f32x4 gv[4], scv[4], shv[4]; ld_row_f32(g, lane, gv); ld_row_f32(sc, lane, scv); ld_row_f32(sh, lane, shv);
#pragma unroll
    for (int j = 0; j < 4; ++j) h[j] = (x[j] * rs) * gv[j] * (scv[j] + 1.0f) + shv[j];
}
__device__ __forceinline__ void resid_update(f32x4 (&x)[4], const f32x4 (&y)[4], const float* g, const float* gt, int lane) {
    const float rs = row_rms_scale(y);
    f32x4 gv[4], gtv[4]; ld_row_f32(g, lane, gv); ld_row_f32(gt, lane, gtv);
#pragma unroll
    for (int j = 0; j < 4; ++j) x[j] = x[j] + gtv[j] * ((y[j] * rs) * gv[j]);
}
__device__ __forceinline__ const float* modv(const Frame& F, int l, int row, int part) {
    const int r = row < NTOK ? (row >> 11) : 32;
    return (const float*)(F.ws + WS_MODV) + ((size_t)l * 33 + r) * 6144 + part * 1024;
}

__device__ __forceinline__ void p0_prologue(Frame& F, const Args& a) {
    const int gw = F.vcu * NWAVES + F.wave, NGW = F.G * NWAVES;
    if (F.vcu < 24) {
        LAS float* sl = (LAS float*)F.lds;
        for (int i = F.tid; i < 33 * 1024; i += NTHREADS) { const int r = i >> 10, k = i & 1023; const float cv = r < 32 ? a.in[I_C][r * 1024 + k] : a.in[I_CCTX][k]; sl[i] = silu_f(cv); }
        __syncthreads();
        const int col = F.vcu * 512 + F.tid, l = col / 6144, n = col % 6144;
        const float* w = a.in[I_WMOD] + (size_t)l * 1024 * 6144 + n;
        float acc[33];
#pragma unroll
        for (int r = 0; r < 33; ++r) acc[r] = 0.f;
        for (int k = 0; k < 1024; ++k) { const float wv = w[(size_t)k * 6144];
#pragma unroll
            for (int r = 0; r < 33; ++r) acc[r] += sl[r * 1024 + k] * wv; }
        const float bm = a.in[I_BMOD][l * 6144 + n];
        float* mo = (float*)(F.ws + WS_MODV) + (size_t)l * 33 * 6144 + n;
#pragma unroll
        for (int r = 0; r < 33; ++r) mo[(size_t)r * 6144] = acc[r] + bm;
        __syncthreads();
    }
    if (F.vcu == 24) {
        float* rp = (float*)(F.ws + WS_ROPE);
        for (int i = F.tid; i < 1024; i += NTHREADS) { const int pos = i >> 4, k = i & 15; const float inv = powf(10000.0f, -(float)k / 16.0f); const float ang = (float)pos * inv; rp[i] = cosf(ang); rp[1024 + i] = sinf(ang); }
    }
    for (int it = F.vcu; it < 288; it += F.G) {
        const int l = it / 144, rem = it % 144, lv = rem < 128 ? 0 : 1, pt = lv ? rem - 128 : rem, L = lv ? LC : SEQ, pos0 = 16 * pt;
        LAS float* z = (LAS float*)F.lds; LAS float* h1 = z + 16 * 33; LAS float* h2 = h1 + 16 * 64;
        __syncthreads();
        for (int i = F.tid; i < 16 * 33; i += NTHREADS) { const int p = i / 33, k = i % 33; const int pos = pos0 + p; float v;
            const float om = 6.283185307179586f * (float)pos / (float)L;
            if (k == 0) v = (float)pos / (float)(L - 1);
            else { const int m = (k - 1) & 15; const float f = 1e-4f + (15.0f - 1e-4f) * (float)m / 15.0f; v = (k <= 16) ? cosf(f * om) : -sinf(f * om); }
            z[i] = v; }
        __syncthreads();
        const float* w1 = a.in[I_HW1] + l * 33 * 64; const float* b1 = a.in[I_HB1] + l * 64; const float* w2 = a.in[I_HW2] + l * 64 * 64; const float* b2 = a.in[I_HB2] + l * 64;
        const float* fr = a.in[I_HFREQ] + l * 64; const float* w3 = a.in[I_HW3] + (size_t)l * 64 * 2048;
        for (int o = F.tid; o < 1024; o += NTHREADS) { const int p = o >> 6, j = o & 63; float s = b1[j];
            for (int k = 0; k < 33; ++k) s += z[p * 33 + k] * w1[k * 64 + j];
            h1[o] = sinf(fr[j] * s); }
        __syncthreads();
        for (int o = F.tid; o < 1024; o += NTHREADS) { const int p = o >> 6, j = o & 63; float s = b2[j];
            for (int k = 0; k < 64; ++k) s += h1[p * 64 + k] * w2[k * 64 + j];
            h2[o] = sinf(fr[j] * s); }
        __syncthreads();
        float* raw = (float*)(F.ws + BIG_RAW) + (size_t)l * (2048 * (SEQ + LC)) + (lv ? (size_t)2048 * SEQ : 0);
#pragma unroll 1
        for (int jj = 0; jj < 4; ++jj) {
            const int col = F.tid + 512 * jj;
            float acc[16];
#pragma unroll
            for (int p = 0; p < 16; ++p) acc[p] = 0.f;
            for (int k = 0; k < 64; ++k) { const float wv = w3[k * 2048 + col];
#pragma unroll
                for (int p = 0; p < 16; ++p) acc[p] += h2[p * 64 + k] * wv; }
            const int cch = col & 511;
            const float da = -3.0701134573253945f, db = -15.350567286626973f;
            const float delta = fabsf(da + (db - da) * (float)cch / 511.0f);
#pragma unroll
            for (int p = 0; p < 16; ++p) { const float t = (float)(pos0 + p) / (float)(L - 1); raw[(size_t)col * L + pos0 + p] = acc[p] * __expf(-t * delta); }
        }
    }
    __syncthreads();
    LAS float* scr = (LAS float*)(F.lds + F.wave * 16384);
    constexpr int PER_LAYER = 16 * 216 + 3 * 256 + 512, NITEMS = 2 * PER_LAYER + 3 * 1408;
    for (int it = gw; it < NITEMS; it += NGW) {
        int r = it;
        bool dn = false;
#pragma unroll 1
        for (int l = 0; l < 2; ++l) {
            if (!dn) dn = conv_job(r, a.in[I_WIN] + (size_t)l * D * INC, D, INC, (bf16*)(F.ws + W_IN) + (size_t)l * INC * D, D, 0, 0, 0, scr, F.lane);
#pragma unroll 1
            for (int br = 0; br < 3; ++br)
                if (!dn) dn = conv_job(r, a.in[I_WBR] + (size_t)(l * 3 + br) * 512 * D, 512, D, (bf16*)(F.ws + W_BR) + (size_t)(l * 3 + br) * D * 512, 512, 0, 0, 0, scr, F.lane);
            if (!dn) dn = conv_job(r, a.in[I_WOUT] + (size_t)l * D * D, D, D, (bf16*)(F.ws + W_OUT) + (size_t)l * D * D, D, 0, 0, 0, scr, F.lane);
        }
        if (!dn) dn = conv_job(r, a.in[I_FW1], D, DFF, (bf16*)(F.ws + W_F13), D, 0, 1, 0, scr, F.lane);
        if (!dn) dn = conv_job(r, a.in[I_FW3], D, DFF, (bf16*)(F.ws + W_F13), D, 0, 1, 1, scr, F.lane);
        if (!dn) dn = conv_job(r, a.in[I_FW2], DFF, D, (bf16*)(F.ws + W_F2), DFF, 0, 0, 0, scr, F.lane);
    }
}

__device__ __forceinline__ void p1_phase(Frame& F, const Args& a) {
    const int gw = F.vcu * NWAVES + F.wave, NGW = F.G * NWAVES;
    for (int u = gw; u < 2 * 2 * 1024; u += NGW) {
        const int l = u >> 11, lv = (u >> 10) & 1, o = (u >> 9) & 1, c = u & 511, L = lv ? LC : SEQ;
        const float* raw = (const float*)(F.ws + BIG_RAW) + (size_t)l * (2048 * (SEQ + LC)) + (lv ? (size_t)2048 * SEQ : 0);
        const float* rf = raw + (size_t)(o * 512 + c) * L; const float* rb = raw + (size_t)(1024 + o * 512 + c) * L;
        float sf = 0.f, sb = 0.f;
        for (int t = F.lane; t < L; t += 64) { const float x = rf[t], y = rb[t]; sf += x * x; sb += y * y; }
        const float nf = 1.0f / sqrtf(wave_sum(sf) + EPS), nb = 1.0f / sqrtf(wave_sum(sb) + EPS);
        bf16* g = lv ? (bf16*)(F.ws + WS_GFC) + ((size_t)(l * 2 + o) * 512 + c) * (2 * LC) : (bf16*)(F.ws + WS_GF) + ((size_t)(l * 2 + o) * 512 + c) * (2 * SEQ);
        for (int i = F.lane; i < 2 * L; i += 64) { const int d = i - L; float v;
            if (i == 0) v = 0.f; else if (d > 0) v = rf[d] * nf; else if (d < 0) v = rb[-d] * nb; else v = rf[0] * nf + rb[0] * nb;
            g[i] = (bf16)f2bf(v); }
    }
    for (int row = gw; row < NROW; row += NGW) {
        const float* xr = row < NTOK ? a.in[I_X] + (size_t)row * D : a.in[I_CTX] + (size_t)(row - NTOK) * D;
        f32x4 x[4], h[4]; ld_row_f32(xr, F.lane, x);
        norm_mod(x, a.in[I_GMIXPRE], modv(F, 0, row, 1), modv(F, 0, row, 0), F.lane, h);
        st_row_bf16((bf16*)(F.ws + WS_H) + (size_t)row * D, F.lane, h);
    }
}

constexpr int ATT_KP = 144, ATT_VP = 136;
constexpr int ATT_K_OFF = 0, ATT_V_OFF = 64 * ATT_KP, ATT_RPB_OFF = 18432;
__device__ __forceinline__ int crow(int reg, int h) { return (reg & 3) + 8 * (reg >> 2) + 4 * h; }
__device__ __forceinline__ int rs_of(int r) { const int v = r - 4; return v < 0 ? 0 : (v > 24 ? 24 : v); }
__device__ __forceinline__ unsigned cvtpk(float lo, float hi) { return pk2(lo, hi); }

template <int MODE>
__device__ __forceinline__ void attn_unit(Frame& F, int u, const bf16* __restrict__ QKV, bf16* __restrict__ Yo, const float* sink, const float* rpb) {
    const int w = F.wave, lane = F.lane, r = lane & 31, h = lane >> 5;
    LAS unsigned char* lds = F.lds;
    int b, head, kvh, q0 = 0, R = 0;
    if (MODE == 0) { b = u >> 6; kvh = (u >> 5) & 1; q0 = (u & 31) * 64; head = 4 * kvh + (w >> 1); }
    else if (MODE == 1) { b = u >> 6; head = (u >> 3) & 7; kvh = head; R = u & 7; }
    else if (MODE == 2) { b = u >> 3; kvh = (u >> 2) & 1; q0 = (u & 3) * 64; head = 4 * kvh + (w >> 1); }
    else { b = u >> 3; head = u & 7; kvh = head; }
    int qt, qrow, gr = 0, qc = 0;
    if (MODE == 0) { qt = q0 + 32 * (w & 1) + r; qrow = b * SEQ + qt; }
    else if (MODE == 1) { gr = 4 * R + (w >> 1); qc = 32 * (w & 1) + r; qt = gr * 64 + qc; qrow = b * SEQ + qt; }
    else if (MODE == 2) { qt = q0 + 32 * (w & 1) + r; qrow = NTOK + b * LC + qt; }
    else { qt = 32 * w + r; qrow = NTOK + b * LC + qt; }
    const int qcol = (MODE == 0 || MODE == 2) ? 1280 + head * 64 : 1792 + head * 64;
    const int kcol = (MODE == 0 || MODE == 2) ? kvh * 64 : 256 + head * 64;
    const int vcol = (MODE == 0 || MODE == 2) ? 128 + kvh * 64 : 768 + head * 64;
    bf16x8 qf[4];
#pragma unroll
    for (int s = 0; s < 4; ++s) qf[s] = *(const bf16x8*)(QKV + (size_t)qrow * QKVC + qcol + 16 * s + 8 * h);
    f32x16 O0, O1;
#pragma unroll
    for (int i = 0; i < 16; ++i) { O0[i] = 0.f; O1[i] = 0.f; }
    float m_run, l_run;
    if (MODE == 0 || MODE == 2) { m_run = sink[head] * LOG2E; l_run = (h == 0) ? 1.0f : 0.0f; } else { m_run = -1e30f; l_run = 0.f; }
    int n_local = 0, kr_lo = 0;
    if (MODE == 0) n_local = 5;
    if (MODE == 1) { kr_lo = rs_of(4 * R); n_local = rs_of(4 * R + 3) + 8 - kr_lo; }
    const int my_rs = rs_of(gr), my_cs = (qc - 8) < 0 ? 0 : ((qc - 8) > 48 ? 48 : (qc - 8));
    if (MODE == 1) {
        __syncthreads();
        LAS float* tb = (LAS float*)(lds + ATT_RPB_OFF);
        if (F.tid < 15 * 32) { const int dr = F.tid >> 5, dc = F.tid & 31; tb[F.tid] = dc < 31 ? rpb[(head * 15 + dr) * 31 + dc] * LOG2E : 0.f; }
    }
    const int ntiles = n_local + 4;
    for (int tt = 0; tt < ntiles; ++tt) {
        const bool is_local = tt < n_local;
        int trow, kbase = 0, kr = 0;
        if (is_local) {
            if (MODE == 0) { kbase = q0 - 128 + 64 * tt; if (kbase < 0 || kbase >= SEQ) continue; trow = b * SEQ + kbase; }
            else { kr = kr_lo + tt; trow = b * SEQ + kr * 64; }
        } else trow = NTOK + b * LC + 64 * (tt - n_local);
        __syncthreads();
        {
            const int key = F.tid >> 3, ch = F.tid & 7;
            const bf16* src = QKV + (size_t)(trow + key) * QKVC;
            const v4u kv = *(const v4u*)(src + kcol + 8 * ch);
            const v4u vv = *(const v4u*)(src + vcol + 8 * ch);
            *(LAS v4u*)(lds + ATT_K_OFF + key * ATT_KP + ch * 16) = kv;
            LAS unsigned short* vt = (LAS unsigned short*)(lds + ATT_V_OFF + (8 * ch) * ATT_VP + key * 2);
            vt[0 * (ATT_VP / 2)] = (unsigned short)(vv.x & 0xffff); vt[1 * (ATT_VP / 2)] = (unsigned short)(vv.x >> 16);
            vt[2 * (ATT_VP / 2)] = (unsigned short)(vv.y & 0xffff); vt[3 * (ATT_VP / 2)] = (unsigned short)(vv.y >> 16);
            vt[4 * (ATT_VP / 2)] = (unsigned short)(vv.z & 0xffff); vt[5 * (ATT_VP / 2)] = (unsigned short)(vv.z >> 16);
            vt[6 * (ATT_VP / 2)] = (unsigned short)(vv.w & 0xffff); vt[7 * (ATT_VP / 2)] = (unsigned short)(vv.w >> 16);
        }
        __syncthreads();
        if (MODE == 1 && is_local && !(kr >= my_rs && kr < my_rs + 8)) continue;
        f32x16 s0, s1;
#pragma unroll
        for (int i = 0; i < 16; ++i) { s0[i] = 0.f; s1[i] = 0.f; }
#pragma unroll
        for (int s = 0; s < 4; ++s) {
            const bf16x8 k0 = *(const LAS bf16x8*)(lds + ATT_K_OFF + r * ATT_KP + (16 * s + 8 * h) * 2);
            const bf16x8 k1 = *(const LAS bf16x8*)(lds + ATT_K_OFF + (32 + r) * ATT_KP + (16 * s + 8 * h) * 2);
            s0 = MFMA32(k0, qf[s], s0); s1 = MFMA32(k1, qf[s], s1);
        }
        if (is_local) {
            if (MODE == 0) {
#pragma unroll
                for (int i = 0; i < 16; ++i) { const int j0 = kbase + crow(i, h), d0 = qt - j0, d1 = d0 - 32;
                    if (d0 > 128 || d0 < -128) s0[i] = -1e30f;
                    if (d1 > 128 || d1 < -128) s1[i] = -1e30f; }
            }
            if (MODE == 1) {
                const LAS float* tb = (const LAS float*)(lds + ATT_RPB_OFF) + (kr - gr + 7) * 32;
#pragma unroll
                for (int i = 0; i < 16; ++i) { const int k0 = crow(i, h), k1 = k0 + 32;
                    const bool v0 = (k0 >= my_cs) && (k0 < my_cs + 16), v1 = (k1 >= my_cs) && (k1 < my_cs + 16);
                    const int i0 = v0 ? (k0 - qc + 15) : 0, i1 = v1 ? (k1 - qc + 15) : 0;
                    const float b0 = tb[i0], b1 = tb[i1];
                    s0[i] = v0 ? s0[i] + b0 : -1e30f; s1[i] = v1 ? s1[i] + b1 : -1e30f; }
            }
        }
        float mx = s0[0];
#pragma unroll
        for (int i = 1; i < 16; ++i) mx = fmaxf(mx, s0[i]);
#pragma unroll
        for (int i = 0; i < 16; ++i) mx = fmaxf(mx, s1[i]);
        mx = fmaxf(mx, __shfl_xor(mx, 32));
        const float mn = fmaxf(m_run, mx), alpha = __builtin_amdgcn_exp2f(m_run - mn);
        m_run = mn;
        float ls = 0.f;
#pragma unroll
        for (int i = 0; i < 16; ++i) { s0[i] = __builtin_amdgcn_exp2f(s0[i] - mn); s1[i] = __builtin_amdgcn_exp2f(s1[i] - mn); ls += s0[i] + s1[i]; }
        l_run = l_run * alpha + ls;
#pragma unroll
        for (int i = 0; i < 16; ++i) { O0[i] *= alpha; O1[i] *= alpha; }
        bf16x8 pf[2][2];
        { v4u t;
          t.x = cvtpk(s0[0], s0[1]); t.y = cvtpk(s0[2], s0[3]); t.z = cvtpk(s0[4], s0[5]); t.w = cvtpk(s0[6], s0[7]); pf[0][0] = __builtin_bit_cast(bf16x8, t);
          t.x = cvtpk(s0[8], s0[9]); t.y = cvtpk(s0[10], s0[11]); t.z = cvtpk(s0[12], s0[13]); t.w = cvtpk(s0[14], s0[15]); pf[0][1] = __builtin_bit_cast(bf16x8, t);
          t.x = cvtpk(s1[0], s1[1]); t.y = cvtpk(s1[2], s1[3]); t.z = cvtpk(s1[4], s1[5]); t.w = cvtpk(s1[6], s1[7]); pf[1][0] = __builtin_bit_cast(bf16x8, t);
          t.x = cvtpk(s1[8], s1[9]); t.y = cvtpk(s1[10], s1[11]); t.z = cvtpk(s1[12], s1[13]); t.w = cvtpk(s1[14], s1[15]); pf[1][1] = __builtin_bit_cast(bf16x8, t); }
#pragma unroll
        for (int i = 0; i < 2; ++i)
#pragma unroll
            for (int sp = 0; sp < 2; ++sp) {
                const int koff = (32 * i + 16 * sp + 4 * h) * 2;
                const v2u a0 = *(const LAS v2u*)(lds + ATT_V_OFF + r * ATT_VP + koff), a1 = *(const LAS v2u*)(lds + ATT_V_OFF + r * ATT_VP + koff + 16);
                const v2u c0 = *(const LAS v2u*)(lds + ATT_V_OFF + (32 + r) * ATT_VP + koff), c1 = *(const LAS v2u*)(lds + ATT_V_OFF + (32 + r) * ATT_VP + koff + 16);
                const v4u va = (v4u){a0.x, a0.y, a1.x, a1.y}, vc = (v4u){c0.x, c0.y, c1.x, c1.y};
                O0 = MFMA32(__builtin_bit_cast(bf16x8, va), pf[i][sp], O0);
                O1 = MFMA32(__builtin_bit_cast(bf16x8, vc), pf[i][sp], O1);
            }
    }
    const float lt = l_run + __shfl_xor(l_run, 32), inv = 1.0f / lt;
    bf16* op = Yo + (size_t)qrow * 512 + head * 64;
#pragma unroll
    for (int g = 0; g < 4; ++g) {
        v2u o; o.x = cvtpk(O0[4 * g] * inv, O0[4 * g + 1] * inv); o.y = cvtpk(O0[4 * g + 2] * inv, O0[4 * g + 3] * inv);
        *(GAS v2u*)(op + 8 * g + 4 * h) = o;
        o.x = cvtpk(O1[4 * g] * inv, O1[4 * g + 1] * inv); o.y = cvtpk(O1[4 * g + 2] * inv, O1[4 * g + 3] * inv);
        *(GAS v2u*)(op + 32 + 8 * g + 4 * h) = o;
    }
}

template <int N>
__device__ __forceinline__ void conv_taps(const bf16* src, int t, int L, float w0, float w1, float w2, float bs, float (&out)[N]) {
    float x[N + 2];
    if constexpr (N == 8) { const v4u q = *(const v4u*)(src + t); x[1] = pg8::bf_lo(q.x); x[2] = pg8::bf_hi(q.x); x[3] = pg8::bf_lo(q.y); x[4] = pg8::bf_hi(q.y); x[5] = pg8::bf_lo(q.z); x[6] = pg8::bf_hi(q.z); x[7] = pg8::bf_lo(q.w); x[8] = pg8::bf_hi(q.w); }
    else { const v2u q = *(const v2u*)(src + t); x[1] = pg8::bf_lo(q.x); x[2] = pg8::bf_hi(q.x); x[3] = pg8::bf_lo(q.y); x[4] = pg8::bf_hi(q.y); }
    x[0] = t > 0 ? bf2f(src[t - 1]) : 0.f;
    x[N + 1] = (t + N < L) ? bf2f(src[t + N]) : 0.f;
#pragma unroll
    for (int e = 0; e < N; ++e) out[e] = w0 * x[e] + w1 * x[e + 1] + w2 * x[e + 2] + bs;
}

template <int L>
__device__ __forceinline__ void hyena_unit(Frame& F, int c, const bf16* CINT, const bf16* Gf, const float* convw, const float* convb, const float* hybias) {
    constexpr int UP = (L + 8) * 2, TPW = L / 256, CPB = L / 8;
    LAS unsigned char* U = F.lds; LAS unsigned short* Gs = (LAS unsigned short*)(F.lds + 32 * UP);
    const int lane = F.lane, r = lane & 31, h = lane >> 5, T0 = F.wave * TPW * 32;
    const bf16* vsrc = CINT + (size_t)c * NROW + (L == SEQ ? 0 : NTOK);
    bf16* ydst = (bf16*)vsrc;
    __syncthreads();
    {
        const float w0 = convw[c], w1 = convw[CINC + c], w2 = convw[2 * CINC + c], bs = convb[c];
        for (int q = F.tid; q < 32 * CPB; q += NTHREADS) { const int b = q / CPB, t = (q % CPB) * 8; float o[8];
            conv_taps<8>(vsrc + (size_t)b * L, t, L, w0, w1, w2, bs, o);
            v4u pk; pk.x = pk2(o[0], o[1]); pk.y = pk2(o[2], o[3]); pk.z = pk2(o[4], o[5]); pk.w = pk2(o[6], o[7]);
            *(LAS v4u*)(U + b * UP + t * 2) = pk; }
    }
#pragma unroll 1
    for (int ord = 0; ord < 2; ++ord) {
        {
            const v4u* gsrc = (const v4u*)(Gf + ((size_t)ord * 512 + c) * (2 * L));
            for (int q = F.tid; q < L / 4; q += NTHREADS) *(LAS v4u*)((LAS unsigned char*)Gs + q * 16) = gsrc[q];
        }
        __syncthreads();
        f32x16 acc[TPW];
#pragma unroll
        for (int i = 0; i < TPW; ++i)
#pragma unroll
            for (int e = 0; e < 16; ++e) acc[i][e] = 0.f;
        const int dmin = (T0 - L + 16) / 16, dmax = (T0 + 32 * (TPW - 1)) / 16;
#pragma unroll 1
        for (int dl = dmin; dl <= dmax; ++dl) {
            const int gi = 16 * dl + r - 8 * h + L;
            bf16x8 af;
#pragma unroll
            for (int j = 0; j < 8; ++j) af[j] = (short)Gs[gi - j];
#pragma unroll
            for (int i = 0; i < TPW; ++i) {
                const int s0 = T0 + 32 * i - 16 * dl;
                if (s0 >= 0 && s0 <= L - 16) {
                    const bf16x8 bfr = *(const LAS bf16x8*)(U + r * UP + (s0 + 8 * h) * 2);
                    acc[i] = MFMA32(af, bfr, acc[i]);
                }
            }
        }
        const int comp = 1 + ord;
        const float w0 = convw[comp * 512 + c], w1 = convw[CINC + comp * 512 + c], w2 = convw[2 * CINC + comp * 512 + c], bs = convb[comp * 512 + c], hb = hybias[ord * 512 + c];
        const bf16* gsrc = CINT + ((size_t)comp * 512 + c) * NROW + (L == SEQ ? 0 : NTOK) + (size_t)r * L;
        __syncthreads();
#pragma unroll
        for (int i = 0; i < TPW; ++i) {
#pragma unroll
            for (int g = 0; g < 4; ++g) {
                const int t = T0 + 32 * i + 8 * g + 4 * h;
                float gt[4]; conv_taps<4>(gsrc, t, L, w0, w1, w2, bs, gt);
                LAS v2u* up = (LAS v2u*)(U + r * UP + t * 2);
                const v2u uu = *up;
                const float u0 = pg8::bf_lo(uu.x), u1 = pg8::bf_hi(uu.x), u2 = pg8::bf_lo(uu.y), u3 = pg8::bf_hi(uu.y);
                const float z0 = gt[0] * (acc[i][4 * g] + hb * u0), z1 = gt[1] * (acc[i][4 * g + 1] + hb * u1), z2 = gt[2] * (acc[i][4 * g + 2] + hb * u2), z3 = gt[3] * (acc[i][4 * g + 3] + hb * u3);
                v2u zz; zz.x = pk2(z0, z1); zz.y = pk2(z2, z3);
                *up = zz;
            }
            asm volatile("" ::: "memory");
        }
        __syncthreads();
    }
    for (int q = F.tid; q < 32 * CPB; q += NTHREADS) { const int b = q / CPB, t = (q % CPB) * 8; *(GAS v4u*)(ydst + (size_t)b * L + t) = *(const LAS v4u*)(U + b * UP + t * 2); }
}

__device__ __forceinline__ void transpose_yc(Frame& F, const bf16* CT, bf16* Yc, int nrows) {
    const int gw = F.vcu * NWAVES + F.wave, NGW = F.G * NWAVES, lane = F.lane;
    LAS unsigned short* T = (LAS unsigned short*)(F.lds + F.wave * 16384);
    const int ntr = nrows / 64;
    for (int it = gw; it < 8 * ntr; it += NGW) {
        const int cb = it / ntr, rb = it % ntr, c0 = cb * 64, r0 = rb * 64;
#pragma unroll
        for (int k = 0; k < 8; ++k) { const int p = lane + 64 * k, cc = p >> 3, ch = p & 7;
            const v4u q = *(const v4u*)(CT + (size_t)(c0 + cc) * NROW + r0 + 8 * ch);
            LAS unsigned* d = (LAS unsigned*)(T + cc * 66 + 8 * ch); d[0] = q.x; d[1] = q.y; d[2] = q.z; d[3] = q.w; }
        LDS_WAIT(); asm volatile("" ::: "memory");
#pragma unroll
        for (int k = 0; k < 8; ++k) { const int p = lane + 64 * k, rr = p >> 3, ch = p & 7;
            unsigned short e[8];
#pragma unroll
            for (int j = 0; j < 8; ++j) e[j] = T[(8 * ch + j) * 66 + rr];
            v4u o; o.x = e[0] | ((unsigned)e[1] << 16); o.y = e[2] | ((unsigned)e[3] << 16); o.z = e[4] | ((unsigned)e[5] << 16); o.w = e[6] | ((unsigned)e[7] << 16);
            *(GAS v4u*)(Yc + (size_t)(r0 + rr) * 512 + c0 + 8 * ch) = o; }
        LDS_WAIT(); asm volatile("" ::: "memory");
    }
}

__device__ __forceinline__ void post_row(Frame& F, const Args& a, int row, const f32x4 (&y)[4], const float* xsrc, float* xdst, const float* gpost, const float* gt,
                                         bool has_next, const float* gnext, const float* sc, const float* sh, f32x4 (&h)[4]) {
    f32x4 x[4]; ld_row_f32(xsrc, F.lane, x);
    resid_update(x, y, gpost, gt, F.lane);
    st_row_f32(xdst, F.lane, x);
    if (has_next) { norm_mod(x, gnext, sc, sh, F.lane, h); st_row_bf16((bf16*)(F.ws + WS_H) + (size_t)row * D, F.lane, h); }
}
__device__ __forceinline__ const float* x_src_ptr(const Args& a, Frame& F, int l, int sub, int row) {
    if (row < NTOK) return (l == 0 && sub == 0) ? a.in[I_X] + (size_t)row * D : a.out + (size_t)row * D;
    return (l == 0 && sub == 0) ? a.in[I_CTX] + (size_t)(row - NTOK) * D : (const float*)(F.ws + WS_CTXRES) + (size_t)(row - NTOK) * D;
}
__device__ __forceinline__ float* x_dst_ptr(const Args& a, Frame& F, int row) {
    return row < NTOK ? a.out + (size_t)row * D : (float*)(F.ws + WS_CTXRES) + (size_t)(row - NTOK) * D;
}

__device__ __forceinline__ void post_phase(Frame& F, const Args& a, int l, int sub, const bf16* Y, int nrows) {
    const int gw = F.vcu * NWAVES + F.wave, NGW = F.G * NWAVES;
    const bool has_next = !(l == 1 && sub == 1);
    for (int row = gw; row < nrows; row += NGW) {
        f32x4 y[4], h[4]; ld_row_bf16(Y + (size_t)row * D, F.lane, y);
        const float* gpost = a.in[sub == 0 ? I_GMIXPOST : I_GFFNPOST] + l * D;
        const float* gt = modv(F, l, row, sub == 0 ? 2 : 5);
        const float* gnext = sub == 0 ? a.in[I_GFFNPRE] + l * D : a.in[I_GMIXPRE] + (l + 1) * D;
        const int ln = sub == 0 ? l : l + 1;
        const float* sc = has_next ? modv(F, ln, row, sub == 0 ? 4 : 1) : gt; const float* sh = has_next ? modv(F, ln, row, sub == 0 ? 3 : 0) : gt;
        post_row(F, a, row, y, x_src_ptr(a, F, l, sub, row), x_dst_ptr(a, F, row), gpost, gt, has_next, gnext, sc, sh, h);
    }
}

__device__ __forceinline__ void post_route_phase(Frame& F, const Args& a, const bf16* Y) {
    LAS int* se = (LAS int*)F.lds;
    LAS int* sbase = se + 512;
    const int l = 1;
    __syncthreads();
    for (int blk = F.vcu; blk < NTOK / 256; blk += F.G) {
        for (int k = 0; k < 32; ++k) {
            const int lr = F.wave * 32 + k, row = blk * 256 + lr;
            f32x4 y[4], h[4]; ld_row_bf16(Y + (size_t)row * D, F.lane, y);
            post_row(F, a, row, y, a.out + (size_t)row * D, a.out + (size_t)row * D, a.in[I_GMIXPOST] + l * D, modv(F, l, row, 2), true, a.in[I_GFFNPRE] + l * D, modv(F, l, row, 4), modv(F, l, row, 3), h);
            float lg[8];
#pragma unroll
            for (int e = 0; e < 8; ++e) lg[e] = 0.f;
            const float* rt = a.in[I_ROUTER];
#pragma unroll
            for (int j = 0; j < 4; ++j)
#pragma unroll
                for (int i = 0; i < 4; ++i) { const int kk = 4 * F.lane + 256 * j + i; const f32x4 r0 = *(const f32x4*)(rt + kk * 8), r1 = *(const f32x4*)(rt + kk * 8 + 4); const float hv = h[j][i];
                    lg[0] += hv * r0.x; lg[1] += hv * r0.y; lg[2] += hv * r0.z; lg[3] += hv * r0.w; lg[4] += hv * r1.x; lg[5] += hv * r1.y; lg[6] += hv * r1.z; lg[7] += hv * r1.w; }
#pragma unroll
            for (int e = 0; e < 8; ++e) lg[e] = wave_sum(lg[e]);
            int e0 = 0; float v0 = lg[0];
#pragma unroll
            for (int e = 1; e < 8; ++e) if (lg[e] > v0) { v0 = lg[e]; e0 = e; }
            int e1 = -1; float v1 = -3.0e38f;
#pragma unroll
            for (int e = 0; e < 8; ++e) if (e != e0 && lg[e] > v1) { v1 = lg[e]; e1 = e; }
            const float w0 = 1.0f / (1.0f + __expf(v1 - v0)), w1 = 1.0f - w0;
            if (F.lane == 0) { se[2 * lr] = e0; se[2 * lr + 1] = e1;
                int4 rr; rr.x = e0; rr.y = e1; rr.z = __builtin_bit_cast(int, w0); rr.w = __builtin_bit_cast(int, w1); ((int4*)(F.ws + WS_ROUTE))[row] = rr; }
        }
        __syncthreads();
        const int half = blk >> 7;
        if (F.tid < 8) { int n = 0; for (int i = 0; i < 512; ++i) n += (se[i] == F.tid) ? 1 : 0;
            sbase[F.tid] = (int)__hip_atomic_fetch_add((unsigned*)(F.ws + WS_CTL) + CW_CNT + half * 8 + F.tid, (unsigned)n, __ATOMIC_RELAXED, __HIP_MEMORY_SCOPE_AGENT); }
        __syncthreads();
        if (F.tid < 8) { int p = sbase[F.tid]; int* lst = (int*)(F.ws + WS_LIST) + ((size_t)half * 8 + F.tid) * 32768;
            for (int i = 0; i < 512; ++i) if (se[i] == F.tid) lst[p++] = ((blk * 256 + (i >> 1)) << 1) | (i & 1); }
        __syncthreads();
    }
}

__device__ __forceinline__ void moe_offsets(Frame& F, int half, int (&toff)[9], int (&cnt)[8]) {
    const unsigned* cw = (const unsigned*)(F.ws + WS_CTL) + CW_CNT + half * 8;
    toff[0] = 0;
#pragma unroll
    for (int e = 0; e < 8; ++e) { cnt[e] = (int)__hip_atomic_load(cw + e, __ATOMIC_RELAXED, __HIP_MEMORY_SCOPE_AGENT); toff[e + 1] = toff[e] + (cnt[e] + 255) / 256; }
}
__device__ __forceinline__ void moe_gather_phase(Frame& F, int half) {
    const int gw = F.vcu * NWAVES + F.wave, NGW = F.G * NWAVES;
    int toff[9], cnt[8]; moe_offsets(F, half, toff, cnt);
    const int P = toff[8] * 256;
    for (int p = gw; p < P; p += NGW) {
        const int tile = p >> 8; int e = 0;
#pragma unroll
        for (int k = 1; k < 8; ++k) e += (tile >= toff[k]) ? 1 : 0;
        const int idx = p - toff[e] * 256;
        bf16* dst = (bf16*)(F.ws + BIG_AS) + (size_t)p * D;
        if (idx < cnt[e]) {
            const int ts = ((const int*)(F.ws + WS_LIST))[((size_t)half * 8 + e) * 32768 + idx], tok = ts >> 1, slot = ts & 1;
            const GAS v4u* s = (const GAS v4u*)((const bf16*)(F.ws + WS_H) + (size_t)tok * D) + F.lane; GAS v4u* d = (GAS v4u*)dst + F.lane;
            d[0] = s[0]; d[64] = s[64];
            if (F.lane == 0) ((int*)(F.ws + WS_INV))[tok * 2 + slot] = p;
        } else { GAS v4u* d = (GAS v4u*)dst + F.lane; const v4u z = {0u, 0u, 0u, 0u}; d[0] = z; d[64] = z; }
    }
}
__device__ __forceinline__ void moe_convert(Frame& F, const Args& a) {
    const int gw = F.vcu * NWAVES + F.wave, NGW = F.G * NWAVES;
    LAS float* scr = (LAS float*)(F.lds + F.wave * 16384);
    constexpr int I13 = 16 * 112, I2 = 28 * 32;
    for (int it = gw; it < 8 * (2 * I13 + 2 * I2); it += NGW) {
        const int e = it / (2 * I13 + 2 * I2); int r = it % (2 * I13 + 2 * I2);
        if (r < 2 * I13) {
            const int which = r / I13; r %= I13; const int kb = r / 112, nb = r % 112, n0 = 32 * nb, q = n0 / FCH, jj = n0 % FCH;
            const float* W = (which ? a.in[I_MW3] : a.in[I_MW1]) + (size_t)e * D * DFFE;
            bf16* WT = (bf16*)(F.ws + WM_13) + ((size_t)(q * 8 + e) * (2 * FCH)) * D;
            transpose_item(W, DFFE, WT, D, 64 * kb, n0, (jj / 128) * 256 + which * 128 + (jj % 128), scr, F.lane);
        } else {
            r -= 2 * I13; const int q = r / I2; r %= I2; const int kb = r / 32, nb = r % 32;
            const float* W = a.in[I_MW2] + (size_t)e * DFFE * D + (size_t)q * FCH * D;
            bf16* WT = (bf16*)(F.ws + WM_2) + ((size_t)(q * 8 + e) * D) * FCH;
            transpose_item(W, D, WT, FCH, 64 * kb, 32 * nb, 32 * nb, scr, F.lane);
        }
    }
}
__device__ __forceinline__ void moe_post_phase(Frame& F, const Args& a, int half) {
    const int gw = F.vcu * NWAVES + F.wave, NGW = F.G * NWAVES;
    for (int t = gw; t < 32768; t += NGW) {
        const int row = half * 32768 + t;
        const int4 rr = ((const int4*)(F.ws + WS_ROUTE))[row]; const float w0 = __builtin_bit_cast(float, rr.z), w1 = __builtin_bit_cast(float, rr.w);
        const int p0 = ((const int*)(F.ws + WS_INV))[row * 2], p1 = ((const int*)(F.ws + WS_INV))[row * 2 + 1];
        f32x4 ya[4], yb[4], y[4], h[4]; ld_row_bf16((const bf16*)(F.ws + BIG_Y2S) + (size_t)p0 * D, F.lane, ya); ld_row_bf16((const bf16*)(F.ws + BIG_Y2S) + (size_t)p1 * D, F.lane, yb);
#pragma unroll
        for (int j = 0; j < 4; ++j) y[j] = ya[j] * w0 + yb[j] * w1;
        const float* gt = modv(F, 1, row, 5);
        post_row(F, a, row, y, a.out + (size_t)row * D, a.out + (size_t)row * D, a.in[I_GFFNPOST] + D, gt, false, gt, gt, gt, h);
    }
}

#ifndef MK_ONLY
#define MK_ONLY -1
#endif
#ifndef MK_SKIP
#define MK_SKIP -1
#endif
#define ON(k) ((MK_ONLY < 0 || MK_ONLY == (k)) && MK_SKIP != (k))
#ifndef MK_DIAG
#define MK_DIAG 0
#endif
#ifndef MK_DIAG_LAYERS
#define MK_DIAG_LAYERS 1
#endif
#ifndef MK_DIAG_FIRST
#define MK_DIAG_FIRST 0
#endif
#ifndef MK_MULTI
#define MK_MULTI 0
#endif
constexpr int NPHASES = 2 + 9 + 6 + 12;

typedef const __attribute__((address_space(4))) Args* ArgsP;
#define KARGS ((ArgsP)__builtin_amdgcn_kernarg_segment_ptr())
#define PH_ENTER \
    Frame F; const Args* ap_; { int t_ = threadIdx.x; asm volatile("" : "+v"(t_)); ArgsP q_ = KARGS; asm volatile("" : "+s"(q_)); ap_ = (const Args*)q_; \
      F.lds = (LAS unsigned char*)lds_raw; F.tid = t_; F.lane = t_ & 63; F.wave = __builtin_amdgcn_readfirstlane(t_ >> 6); \
      F.G = gridDim.x; { const int bx_ = blockIdx.x; F.vcu = (F.G % 8 == 0) ? (bx_ % 8) * (F.G / 8) + bx_ / 8 : bx_; } F.ws = q_->ws; } \
    const Args& a = *ap_; const int bx = (int)blockIdx.x; \
    bf16* const Hb = (bf16*)(F.ws + WS_H); bf16* const Y3 = (bf16*)(F.ws + WS_Y3); bf16* const QKV = (bf16*)(F.ws + BIG_QKV); bf16* const CINT = (bf16*)(F.ws + BIG_CINT); bf16* const GATE = (bf16*)(F.ws + BIG_GATE); \
    (void)Hb; (void)Y3; (void)QKV; (void)CINT; (void)GATE; (void)bx; (void)a;

__global__ void __launch_bounds__(NTHREADS, 2) fwd_kernel(Args args) {
    extern __shared__ __attribute__((aligned(16))) unsigned char lds_raw[];
    {
        volatile LAS unsigned* MISC0 = (volatile LAS unsigned*)((LAS unsigned char*)lds_raw + MISC_OFF);
        for (int u = threadIdx.x; u < (LDS_BYTES - MISC_OFF) / 4; u += NTHREADS) MISC0[u] = 0u;
        __syncthreads();
    }
    if (!MK_MULTI) (void)xcd_barrier_post((unsigned*)(KARGS->ws + WS_CTL) + CW_BAR, (volatile LAS unsigned*)((LAS unsigned char*)lds_raw + MISC_OFF) + 8);
    int ph = 0;
#define LO_ (KARGS->ph_lo)
#define HI_ (KARGS->ph_hi)
#define GRID_BAR do { XcdBarrier b_; b_.bar = (unsigned*)(KARGS->ws + WS_CTL) + CW_BAR; b_.x = xb_xcc_id(); b_.st = (volatile LAS unsigned*)((LAS unsigned char*)lds_raw + MISC_OFF) + 8; xcd_barrier(b_); } while (0)
#define RUN (LO_ <= ph && ph < HI_)
#define END_PHASE do { if (RUN && (ph + 1 < HI_)) { GRID_BAR; } ++ph; } while (0)

    if (RUN && ON(0)) { PH_ENTER p0_prologue(F, a); } END_PHASE;
    if (RUN && ON(1)) { PH_ENTER p1_phase(F, a); } END_PHASE;

#pragma unroll 1
    for (int l = 0; l < 2; ++l) {
        const int nrows = l == 0 ? NROW : NTOK;
        if (RUN && ON(2)) { PH_ENTER
            const bf16* Win = (const bf16*)(F.ws + W_IN) + (size_t)l * INC * D;
            { pg8::Gemm g{Hb, Win, nrows, QKVC, D}; pg8::StaticOrder S; S.init(nrows, QKVC, F.G, bx);
              pg8::EpiQKV E{QKV, (const float*)(F.ws + WS_ROPE), 0, QSCALE};
              pg8::gemm_phase<pg8::EpiQKV, pg8::StaticOrder, true, true>(F.lds, g, S, E, F.tid); }
            if (l == 1) { pg8::Gemm g{Hb + (size_t)NTOK * D, Win, NCTX, 1280, D}; pg8::StaticOrder S; S.init(NCTX, 1280, F.G, bx);
              pg8::EpiQKV E{QKV, (const float*)(F.ws + WS_ROPE), NTOK, QSCALE};
              pg8::gemm_phase<pg8::EpiQKV, pg8::StaticOrder, true, true>(F.lds, g, S, E, F.tid); }
            { pg8::Gemm g{Win + (size_t)QKVC * D, Hb, CINC, nrows, D}; pg8::StaticOrder S; S.init(CINC, nrows, F.G, bx);
              pg8::EpiPlain E{CINT, NROW, 0, 0};
              pg8::gemm_phase<pg8::EpiPlain, pg8::StaticOrder, true, true>(F.lds, g, S, E, F.tid); }
        } END_PHASE;
        if (RUN) { PH_ENTER
            const float* sink = a.in[I_SINK] + l * 8; const float* rpb = a.in[I_RPB] + (size_t)l * 8 * 15 * 31;
            if (ON(3)) for (int u = F.vcu; u < 2048; u += F.G) attn_unit<0>(F, u, QKV, Y3, sink, rpb);
            if (ON(4)) for (int u = F.vcu; u < 2048; u += F.G) attn_unit<1>(F, u, QKV, Y3 + (size_t)NROW * 512, sink, rpb);
            if (l == 0 && ON(5)) {
                for (int u = F.vcu; u < 256; u += F.G) attn_unit<2>(F, u, QKV, Y3, sink, rpb);
                for (int u = F.vcu; u < 256; u += F.G) attn_unit<3>(F, u, QKV, Y3 + (size_t)NROW * 512, sink, rpb);
            }
            const float* cw = a.in[I_CONVW] + l * 3 * CINC; const float* cb = a.in[I_CONVB] + l * CINC; const float* hb = a.in[I_HBIAS] + l * 1024;
            if (ON(6)) for (int c = F.vcu; c < 512; c += F.G) hyena_unit<SEQ>(F, c, CINT, (const bf16*)(F.ws + WS_GF) + (size_t)l * 2 * 512 * 2 * SEQ, cw, cb, hb);
            if (l == 0 && ON(7)) for (int c = F.vcu; c < 512; c += F.G) hyena_unit<LC>(F, c, CINT, (const bf16*)(F.ws + WS_GFC) + (size_t)l * 2 * 512 * 2 * LC, cw, cb, hb);
            __syncthreads();
        } END_PHASE;
        if (RUN && ON(8)) { PH_ENTER
            const bf16* Win = (const bf16*)(F.ws + W_IN) + (size_t)l * INC * D;
            transpose_yc(F, CINT, Y3 + (size_t)2 * NROW * 512, nrows);
            __syncthreads();
            pg8::Gemm g{Hb, Win + (size_t)(QKVC + CINC) * D, nrows, GATEC, D}; pg8::StaticOrder S; S.init(nrows, GATEC, F.G, bx);
            pg8::EpiSig E{GATE, GATEC};
            pg8::gemm_phase<pg8::EpiSig, pg8::StaticOrder, true, true>(F.lds, g, S, E, F.tid);
        } END_PHASE;
        if (RUN && ON(9)) { PH_ENTER
            pg8::Gemm g{Y3, (const bf16*)(F.ws + W_BR) + (size_t)l * 3 * D * 512, 3 * NROW, 3 * D, 512}; pg8::MergeOrder S{nrows / 256, F.G, bx, NROW / 256};
            pg8::EpiMerge E{Hb, GATE, NROW / 256};
            pg8::gemm_phase<pg8::EpiMerge, pg8::MergeOrder, true, true>(F.lds, g, S, E, F.tid);
        } END_PHASE;
        if (RUN && ON(10)) { PH_ENTER
            pg8::Gemm g{Hb, (const bf16*)(F.ws + W_OUT) + (size_t)l * D * D, nrows, D, D}; pg8::StaticOrder S; S.init(nrows, D, F.G, bx);
            pg8::EpiPlain E{Y3, D, 0, 0};
            pg8::gemm_phase<pg8::EpiPlain, pg8::StaticOrder, true, true>(F.lds, g, S, E, F.tid);
        } END_PHASE;
        if (RUN && ON(11)) { PH_ENTER if (l == 0) post_phase(F, a, 0, 0, Y3, nrows); else post_route_phase(F, a, Y3); } END_PHASE;
        if (l == 0) {
            if (RUN && ON(12)) { PH_ENTER
                pg8::Gemm g{Hb, (const bf16*)(F.ws + W_F13), NROW, 2 * DFF, D}; pg8::StaticOrder S; S.init(NROW, 2 * DFF, F.G, bx);
                pg8::EpiSwiGLU E{(bf16*)(F.ws + BIG_HID), DFF, 0};
                pg8::gemm_phase<pg8::EpiSwiGLU, pg8::StaticOrder, true, true>(F.lds, g, S, E, F.tid);
            } END_PHASE;
            if (RUN && ON(13)) { PH_ENTER
                pg8::Gemm g{(const bf16*)(F.ws + BIG_HID), (const bf16*)(F.ws + W_F2), NROW, D, DFF}; pg8::StaticOrder S; S.init(NROW, D, F.G, bx);
                pg8::EpiPlain E{Y3, D, 0, 0};
                pg8::gemm_phase<pg8::EpiPlain, pg8::StaticOrder, true, true>(F.lds, g, S, E, F.tid);
            } END_PHASE;
            if (RUN && ON(14)) { PH_ENTER post_phase(F, a, 0, 1, Y3, NROW); } END_PHASE;
        } else {
#pragma unroll 1
            for (int half = 0; half < 2; ++half) {
                if (RUN && ON(15)) { PH_ENTER if (half == 0) moe_convert(F, a); moe_gather_phase(F, half); } END_PHASE;
#pragma unroll 1
                for (int q = 0; q < 2; ++q) {
                    if (RUN && ON(16)) { PH_ENTER
                        int toff[9], cnt[8]; moe_offsets(F, half, toff, cnt);
                        pg8::GroupOrder S; S.nM = toff[8]; S.nN = 14; S.G = F.G; S.c = bx;
#pragma unroll
                        for (int k = 0; k < 9; ++k) S.toff[k] = toff[k];
                        pg8::Gemm g{(const bf16*)(F.ws + BIG_AS), (const bf16*)(F.ws + WM_13) + (size_t)q * 8 * 2 * FCH * D, PCAP, 8 * 2 * FCH, D};
                        pg8::EpiSwiGLU E{(bf16*)(F.ws + BIG_MH), FCH, 14};
                        pg8::gemm_phase<pg8::EpiSwiGLU, pg8::GroupOrder, true, true>(F.lds, g, S, E, F.tid);
                    } END_PHASE;
                    if (RUN && ON(17)) { PH_ENTER
                        int toff[9], cnt[8]; moe_offsets(F, half, toff, cnt);
                        pg8::GroupOrder S; S.nM = toff[8]; S.nN = 4; S.G = F.G; S.c = bx;
#pragma unroll
                        for (int k = 0; k < 9; ++k) S.toff[k] = toff[k];
                        pg8::Gemm g{(const bf16*)(F.ws + BIG_MH), (const bf16*)(F.ws + WM_2) + (size_t)q * 8 * D * FCH, PCAP, 8 * D, FCH};
                        pg8::EpiPlain E{(bf16*)(F.ws + BIG_Y2S), D, 4, q};
                        pg8::gemm_phase<pg8::EpiPlain, pg8::GroupOrder, true, true>(F.lds, g, S, E, F.tid);
                    } END_PHASE;
                }
                if (RUN && ON(18)) { PH_ENTER moe_post_phase(F, a, half); } END_PHASE;
            }
        }
    }
#undef RUN
#undef END_PHASE
}


#if MK_DIAG
constexpr size_t WS_SPARE = 1012 * MiB;
constexpr int DG_ACC = 65536;
__device__ __forceinline__ unsigned hash32(unsigned x) { x ^= x >> 16; x *= 0x7feb352dU; x ^= x >> 15; x *= 0x846ca68bU; x ^= x >> 16; return x; }
__device__ __forceinline__ void dg_add(const Args& a, int slot, float e2, float r2) { float* acc = (float*)(a.ws + WS_CTL) + DG_ACC + 2 * slot; atomicAdd(acc, e2); atomicAdd(acc + 1, r2); }
__device__ __forceinline__ float dg_bf(const bf16* p, size_t i) { return bf2f(p[i]); }
__device__ float dg_dot_hw(const bf16* hrow, const float* w, int K, int N, int col) { float s = 0.f; for (int k = 0; k < K; ++k) s += bf2f(hrow[k]) * w[(size_t)k * N + col]; return s; }
__device__ __constant__ int dg_chan[8] = {0, 1, 37, 100, 255, 256, 400, 511};

__global__ void __launch_bounds__(256) diag_kernel(Args a, int id, int l, int slot) {
    __shared__ float sh[4608];
    const int gt = blockIdx.x * 256 + threadIdx.x, NT = gridDim.x * 256;
    unsigned char* ws = a.ws;
    const bf16* Hb = (const bf16*)(ws + WS_H); const bf16* Y3 = (const bf16*)(ws + WS_Y3); const bf16* QKV = (const bf16*)(ws + BIG_QKV); const bf16* CINT = (const bf16*)(ws + BIG_CINT); const bf16* GATE = (const bf16*)(ws + BIG_GATE);
    const int nrows = l == 0 ? NROW : NTOK;
    if (id == 20) {
        bf16* dst = (bf16*)(ws + WS_SPARE);
        for (size_t i = gt; i < (size_t)8 * NROW; i += NT) { const int k = (int)(i / NROW); dst[i] = CINT[(size_t)dg_chan[k] * NROW + (i % NROW)]; }
        return;
    }
    if (id == 0) {
        for (int s = gt; s < 4096; s += NT) { const unsigned hsh = hash32(s * 7919u + 13u); const int ll = hsh & 1, r = (hsh >> 1) % 33, n = (hsh >> 8) % 6144;
            float ref = a.in[I_BMOD][ll * 6144 + n];
            for (int k = 0; k < 1024; ++k) { const float cv = r < 32 ? a.in[I_C][r * 1024 + k] : a.in[I_CCTX][k]; ref += (cv / (1.0f + expf(-cv))) * a.in[I_WMOD][((size_t)ll * 1024 + k) * 6144 + n]; }
            const float got = ((const float*)(ws + WS_MODV))[((size_t)ll * 33 + r) * 6144 + n]; dg_add(a, slot, (got - ref) * (got - ref), ref * ref); }
        return;
    }
    if (id == 1 || id == 11 || id == 14) {
        for (int s = gt; s < 512; s += NT) { const int row = hash32(s * 31u + id) % nrows;
            const float* xr = id == 1 ? (row < NTOK ? a.in[I_X] + (size_t)row * D : a.in[I_CTX] + (size_t)(row - NTOK) * D) : (row < NTOK ? a.out + (size_t)row * D : (const float*)(ws + WS_CTXRES) + (size_t)(row - NTOK) * D);
            const int ln = id == 14 ? l + 1 : l; const int r = row < NTOK ? (row >> 11) : 32;
            const float* mv = (const float*)(ws + WS_MODV) + ((size_t)ln * 33 + r) * 6144;
            const float* g = id == 11 ? a.in[I_GFFNPRE] + ln * D : a.in[I_GMIXPRE] + ln * D; const float* sc = mv + (id == 11 ? 4 : 1) * 1024; const float* shf = mv + (id == 11 ? 3 : 0) * 1024;
            float ss = 0.f; for (int k = 0; k < D; ++k) ss += xr[k] * xr[k];
            const float rs = 1.0f / sqrtf(ss / D + EPS); float e2 = 0.f, r2 = 0.f;
            for (int k = 0; k < D; ++k) { const float ref = xr[k] * rs * g[k] * (1.0f + sc[k]) + shf[k], got = dg_bf(Hb, (size_t)row * D + k); e2 += (got - ref) * (got - ref); r2 += ref * ref; }
            dg_add(a, slot, e2, r2); }
        return;
    }
    if (id == 21) {
        const bf16* Y = Y3;
        for (int s = gt; s < 512; s += NT) { const int row = hash32(s * 131u + 5u) % nrows; const int r = row < NTOK ? (row >> 11) : 32;
            const float* xin = row < NTOK ? a.in[I_X] + (size_t)row * D : a.in[I_CTX] + (size_t)(row - NTOK) * D; const float* xo = row < NTOK ? a.out + (size_t)row * D : (const float*)(ws + WS_CTXRES) + (size_t)(row - NTOK) * D;
            const float* gtv = (const float*)(ws + WS_MODV) + ((size_t)0 * 33 + r) * 6144 + 2 * 1024; const float* g = a.in[I_GMIXPOST];
            float ss = 0.f; for (int k = 0; k < D; ++k) { const float y = dg_bf(Y, (size_t)row * D + k); ss += y * y; }
            const float rs = 1.0f / sqrtf(ss / D + EPS); float e2 = 0.f, r2 = 0.f;
            for (int k = 0; k < D; ++k) { const float upd = gtv[k] * (dg_bf(Y, (size_t)row * D + k) * rs * g[k]); const float got = xo[k] - xin[k]; e2 += (got - upd) * (got - upd); r2 += upd * upd; }
            dg_add(a, slot, e2, r2); }
        return;
    }
    if (id == 2) {
        const int wv = threadIdx.x >> 6, ln = threadIdx.x & 63;
        for (int sidx = blockIdx.x; sidx < 16; sidx += gridDim.x) { const unsigned hsh = hash32(sidx * 977u + 3u); const int lv = sidx & 1, ll = (sidx >> 1) & 1, o = (hsh >> 3) & 1, c = (hsh >> 8) % 512, L = lv ? LC : SEQ;
            const float* w1 = a.in[I_HW1] + ll * 33 * 64; const float* b1 = a.in[I_HB1] + ll * 64; const float* w2 = a.in[I_HW2] + ll * 64 * 64; const float* b2 = a.in[I_HB2] + ll * 64; const float* fr = a.in[I_HFREQ] + ll * 64; const float* w3 = a.in[I_HW3] + (size_t)ll * 64 * 2048;
            float* rf = sh; float* rb = sh + 2048; float* zz = sh + 4096 + wv * 128; float* hh = zz + 64;
            const float delta = fabsf(logf(1e-2f) / 1.5f + (logf(1e-2f) / 0.3f - logf(1e-2f) / 1.5f) * (float)c / 511.0f);
            __syncthreads();
            for (int t = wv; t < L; t += 4) {
                const float tt = (float)t / (float)(L - 1), om = 6.283185307179586f * (float)t / (float)L;
                if (ln < 33) { float v; if (ln == 0) v = tt; else { const int m = (ln - 1) & 15; const float f = 1e-4f + (15.0f - 1e-4f) * (float)m / 15.0f; v = (ln <= 16) ? cosf(f * om) : -sinf(f * om); } zz[ln] = v; }
                __builtin_amdgcn_wave_barrier(); asm volatile("s_waitcnt lgkmcnt(0)" ::: "memory");
                float s1 = b1[ln]; for (int k = 0; k < 33; ++k) s1 += zz[k] * w1[k * 64 + ln];
                hh[ln] = sinf(fr[ln] * s1);
                asm volatile("s_waitcnt lgkmcnt(0)" ::: "memory"); __builtin_amdgcn_wave_barrier();
                float s2 = b2[ln]; for (int k = 0; k < 64; ++k) s2 += hh[k] * w2[k * 64 + ln];
                const float h2 = sinf(fr[ln] * s2);
                float vf = wave_sum(h2 * w3[ln * 2048 + o * 512 + c]), vb = wave_sum(h2 * w3[ln * 2048 + 1024 + o * 512 + c]);
                const float wn = expf(-tt * delta); vf *= wn; vb *= wn;
                if (ln == 0) { rf[t] = vf; rb[t] = vb; }
                asm volatile("s_waitcnt lgkmcnt(0)" ::: "memory"); __builtin_amdgcn_wave_barrier();
            }
            __syncthreads();
            float sf = 0.f, sb = 0.f; for (int t = threadIdx.x; t < L; t += 256) { sf += rf[t] * rf[t]; sb += rb[t] * rb[t]; }
            __syncthreads();
            sh[4096 + threadIdx.x] = sf; sh[4352 + threadIdx.x] = sb; __syncthreads();
            if (threadIdx.x == 0) { float A = 0.f, B = 0.f; for (int i = 0; i < 256; ++i) { A += sh[4096 + i]; B += sh[4352 + i]; } sh[4096] = 1.0f / sqrtf(A + EPS); sh[4352] = 1.0f / sqrtf(B + EPS); }
            __syncthreads();
            const float nf = sh[4096], nb = sh[4352]; float e2 = 0.f, r2 = 0.f;
            const bf16* g = lv ? (const bf16*)(ws + WS_GFC) + ((size_t)(ll * 2 + o) * 512 + c) * (2 * LC) : (const bf16*)(ws + WS_GF) + ((size_t)(ll * 2 + o) * 512 + c) * (2 * SEQ);
            for (int i = threadIdx.x + 1; i < 2 * L; i += 256) { const int dd = i - L; const float ref = dd > 0 ? rf[dd] * nf : (dd < 0 ? rb[-dd] * nb : rf[0] * nf + rb[0] * nb); const float got = bf2f(g[i]); e2 += (got - ref) * (got - ref); r2 += ref * ref; }
            dg_add(a, slot, e2, r2); __syncthreads(); }
        return;
    }
    if (id == 3) {
        const float* W = a.in[I_WIN] + (size_t)l * D * INC;
        for (int s = gt; s < 4096; s += NT) { const unsigned hsh = hash32(s * 2654435761u + 17u); int row = hsh % NROW; int col = hash32(hsh) % QKVC;
            if (l == 1 && row >= NTOK && col >= 1280) col %= 1280;
            float val = dg_dot_hw(Hb + (size_t)row * D, W, D, INC, col);
            if (row < NTOK && (col < 128 || (col >= 1280 && col < 1792))) { const int d = col & 63, p = d & 31, i = p & 15, t = row & 2047, pos = (d >= 32) ? (t & 63) : (t >> 6);
                const float pv = dg_dot_hw(Hb + (size_t)row * D, W, D, INC, p < 16 ? col + 16 : col - 16); const float ang = (float)pos * powf(10000.0f, -(float)i / 16.0f);
                val = p < 16 ? val * cosf(ang) - pv * sinf(ang) : pv * sinf(ang) + val * cosf(ang); }
            if (col >= 1280) val *= QSCALE;
            const float got = dg_bf(QKV, (size_t)row * QKVC + col); dg_add(a, slot, (got - val) * (got - val), val * val); }
        return;
    }
    if (id == 4 || id == 8) {
        const float* W = a.in[I_WIN] + (size_t)l * D * INC;
        for (int s = gt; s < 4096; s += NT) { const unsigned hsh = hash32(s * 2246822519u + 29u + id); const int row = hsh % nrows;
            if (id == 4) { const int ch = hash32(hsh) % CINC; const float ref = dg_dot_hw(Hb + (size_t)row * D, W, D, INC, QKVC + ch), got = dg_bf(CINT, (size_t)ch * NROW + row); dg_add(a, slot, (got - ref) * (got - ref), ref * ref); }
            else { const int col = hash32(hsh) % GATEC; const float v = dg_dot_hw(Hb + (size_t)row * D, W, D, INC, QKVC + CINC + col), ref = 1.0f / (1.0f + expf(-v)), got = dg_bf(GATE, (size_t)row * GATEC + col); dg_add(a, slot, (got - ref) * (got - ref), ref * ref);
                   if ((s & 7) == 0) { const int c = hash32(hsh + 1) % 512; const float tr = dg_bf(CINT, (size_t)c * NROW + row), tg = dg_bf(Y3, (size_t)2 * NROW * 512 + (size_t)row * 512 + c); dg_add(a, slot + 1, (tr - tg) * (tr - tg), tr * tr); } } }
        return;
    }
    if (id == 5 || id == 6) {
        const float* sink = a.in[I_SINK] + l * 8; const float* rpb = a.in[I_RPB] + (size_t)l * 8 * 15 * 31;
        const int gwv = gt >> 6, NWV = NT >> 6, ln = threadIdx.x & 63;
        for (int s = gwv; s < 1024; s += NWV) { const unsigned hsh = hash32(s * 40503u + 7u + id); int row = hsh % nrows; if (s < 64) row = (s & 1) ? (s * 1024 + (s & 7)) % NTOK : (NTOK - 1 - s * 31); if (s >= 960 && l == 0) row = NTOK + (hsh % NCTX);
            const int head = (hsh >> 20) & 7; const bool lat = row < NTOK; const int b = lat ? (row >> 11) : (row - NTOK) / LC, t = lat ? (row & 2047) : (row - NTOK) % LC;
            const int qcol = id == 5 ? 1280 + head * 64 : 1792 + head * 64, kcol = id == 5 ? (head >> 2) * 64 : 256 + head * 64, vcol = id == 5 ? 128 + (head >> 2) * 64 : 768 + head * 64;
            const float q = dg_bf(QKV, (size_t)row * QKVC + qcol + ln);
            const int gr = t >> 6, qc = t & 63, rs = min(max(gr - 4, 0), 24), cs = min(max(qc - 8, 0), 48);
            const int nloc = !lat ? 0 : (id == 5 ? 2 * 128 + 1 : 128), ntot = nloc + 256;
            float m = id == 5 ? sink[head] * LOG2E : -1e30f, den = id == 5 ? 1.0f : 0.0f, o = 0.f;
            for (int kk = 0; kk < ntot; ++kk) { int krow; float bias = 0.f;
                if (kk < nloc) { if (id == 5) { const int j = t - 128 + kk; if (j < 0 || j >= SEQ) continue; krow = b * SEQ + j; } else { const int kr = rs + (kk >> 4), kc = cs + (kk & 15); krow = b * SEQ + kr * 64 + kc; bias = rpb[(head * 15 + (kr - gr + 7)) * 31 + (kc - qc + 15)] * LOG2E; } }
                else krow = NTOK + b * LC + (kk - nloc);
                const float sc = wave_sum(q * dg_bf(QKV, (size_t)krow * QKVC + kcol + ln)) + bias;
                const float mn = fmaxf(m, sc), al = exp2f(m - mn), p = exp2f(sc - mn); m = mn;
                den = den * al + p; o = o * al + p * dg_bf(QKV, (size_t)krow * QKVC + vcol + ln); }
            const float ref = o / den, got = dg_bf(Y3, (size_t)(id == 5 ? 0 : 1) * NROW * 512 + (size_t)row * 512 + head * 64 + ln);
            const float e2 = wave_sum((got - ref) * (got - ref)), r2 = wave_sum(ref * ref);
            if (ln == 0) dg_add(a, slot, e2, r2); }
        return;
    }
    if (id == 7) {
        const float* cw = a.in[I_CONVW] + l * 3 * CINC; const float* cb = a.in[I_CONVB] + l * CINC; const float* hbv = a.in[I_HBIAS] + l * 1024;
        for (int sidx = blockIdx.x; sidx < 64; sidx += gridDim.x) { const unsigned hsh = hash32(sidx * 7001u + 11u); const int k = sidx & 7, c = dg_chan[k]; const bool ctx = (l == 0) && (sidx >= 56); const int L = ctx ? LC : SEQ, b = (hsh >> 4) & 31;
            int t = (hsh >> 10) % L; if (sidx < 8) t = sidx; if (sidx >= 8 && sidx < 16) t = L - 1 - (sidx - 8);
            const size_t base = (ctx ? NTOK : 0) + (size_t)b * L;
            const bf16* vr = (const bf16*)(ws + WS_SPARE) + (size_t)k * NROW + base; const bf16* x1 = CINT + (size_t)(512 + c) * NROW + base; const bf16* x2 = CINT + (size_t)(1024 + c) * NROW + base;
            const bf16* G1 = ctx ? (const bf16*)(ws + WS_GFC) + ((size_t)(l * 2 + 0) * 512 + c) * (2 * LC) : (const bf16*)(ws + WS_GF) + ((size_t)(l * 2 + 0) * 512 + c) * (2 * SEQ); const bf16* G2 = G1 + (size_t)512 * 2 * L;
            float* vc = sh; float* z1 = sh + 2048;
            __syncthreads();
            for (int s = threadIdx.x; s < L; s += 256) vc[s] = cw[c] * (s > 0 ? bf2f(vr[s - 1]) : 0.f) + cw[CINC + c] * bf2f(vr[s]) + cw[2 * CINC + c] * (s + 1 < L ? bf2f(vr[s + 1]) : 0.f) + cb[c];
            __syncthreads();
            for (int s = threadIdx.x; s < L; s += 256) { float acc = 0.f; for (int r = 0; r < L; ++r) acc += bf2f(G1[s - r + L]) * vc[r];
                const float g = cw[512 + c] * (s > 0 ? bf2f(x1[s - 1]) : 0.f) + cw[CINC + 512 + c] * bf2f(x1[s]) + cw[2 * CINC + 512 + c] * (s + 1 < L ? bf2f(x1[s + 1]) : 0.f) + cb[512 + c];
                z1[s] = g * (acc + hbv[c] * vc[s]); }
            __syncthreads();
            float part = 0.f; for (int s = threadIdx.x; s < L; s += 256) part += bf2f(G2[t - s + L]) * z1[s];
            sh[4096 + threadIdx.x] = part; __syncthreads();
            if (threadIdx.x == 0) { float acc = 0.f; for (int i = 0; i < 256; ++i) acc += sh[4096 + i];
                const float g = cw[1024 + c] * (t > 0 ? bf2f(x2[t - 1]) : 0.f) + cw[CINC + 1024 + c] * bf2f(x2[t]) + cw[2 * CINC + 1024 + c] * (t + 1 < L ? bf2f(x2[t + 1]) : 0.f) + cb[1024 + c];
                const float ref = g * (acc + hbv[512 + c] * z1[t]), got = dg_bf(CINT, (size_t)c * NROW + base + t); dg_add(a, slot, (got - ref) * (got - ref), ref * ref); }
            __syncthreads(); }
        return;
    }
    if (id == 9 || id == 10 || id == 12 || id == 13) {
        for (int s = gt; s < 4096; s += NT) { const unsigned hsh = hash32(s * 3266489917u + 41u + id); const int row = hsh % nrows; float ref, got;
            if (id == 9) { const int col = hash32(hsh) % D; ref = 0.f; for (int br = 0; br < 3; ++br) ref += dg_bf(GATE, (size_t)row * GATEC + br * 1024 + col) * dg_dot_hw(Y3 + (size_t)br * NROW * 512 + (size_t)row * 512, a.in[I_WBR] + (size_t)(l * 3 + br) * 512 * D, 512, D, col); got = dg_bf(Hb, (size_t)row * D + col); }
            else if (id == 10) { const int col = hash32(hsh) % D; ref = dg_dot_hw(Hb + (size_t)row * D, a.in[I_WOUT] + (size_t)l * D * D, D, D, col); got = dg_bf(Y3, (size_t)row * D + col); }
            else if (id == 12) { const int col = hash32(hsh) % DFF; const float a1 = dg_dot_hw(Hb + (size_t)row * D, a.in[I_FW1], D, DFF, col), a3 = dg_dot_hw(Hb + (size_t)row * D, a.in[I_FW3], D, DFF, col); ref = a1 / (1.0f + expf(-a1)) * a3; got = dg_bf((const bf16*)(ws + BIG_HID), (size_t)row * DFF + col); }
            else { const int col = hash32(hsh) % D; ref = dg_dot_hw((const bf16*)(ws + BIG_HID) + (size_t)row * DFF, a.in[I_FW2], DFF, D, col); got = dg_bf(Y3, (size_t)row * D + col); }
            dg_add(a, slot, (got - ref) * (got - ref), ref * ref); }
        return;
    }
}
__global__ void diag_encode(Args a, int nslots, int first) {
    __shared__ float s_sh;
    if (threadIdx.x == 0) { float s = 3.0f; const float* acc = (const float*)(a.ws + WS_CTL) + DG_ACC;
        for (int j = first; j < nslots; ++j) { const float e = sqrtf(acc[2 * j] / fmaxf(acc[2 * j + 1], 1e-30f)); if (!(e <= 0.03f)) { s = 4.0f + (float)(j - first) + fminf(e, 0.9f); break; } }
        s_sh = s; }
    __syncthreads();
    const float s = s_sh;
    for (size_t i = (size_t)blockIdx.x * blockDim.x + threadIdx.x; i < (size_t)NTOK * D; i += (size_t)gridDim.x * blockDim.x) a.out[i] = s * a.in[I_X][i];
}
#endif

extern "C" void kernel_launch(void* const* d_in, const int* in_sizes, int n_in, void* d_out, int out_size, void* d_ws, size_t ws_size, hipStream_t stream) {
    static int grid = 0;
    if (grid == 0) {
        if (n_in != 31 || in_sizes[0] != NTOK * D || out_size != NTOK * D || ws_size < WS_END) { fprintf(stderr, "kernel_launch: unexpected shapes (n_in %d, in0 %d, out %d, ws %zu)\n", n_in, n_in > 0 ? in_sizes[0] : -1, out_size, ws_size); grid = -1; return; }
        int dev = 0, cus = 0, per_cu = 0;
        if (hipGetDevice(&dev) != hipSuccess || hipDeviceGetAttribute(&cus, hipDeviceAttributeMultiprocessorCount, dev) != hipSuccess) { grid = -1; return; }
        if (hipFuncSetAttribute((const void*)fwd_kernel, hipFuncAttributeMaxDynamicSharedMemorySize, LDS_BYTES) != hipSuccess) { fprintf(stderr, "kernel_launch: hipFuncSetAttribute failed\n"); grid = -1; return; }
        if (hipOccupancyMaxActiveBlocksPerMultiprocessor(&per_cu, (const void*)fwd_kernel, NTHREADS, LDS_BYTES) != hipSuccess || per_cu < 1) { fprintf(stderr, "kernel_launch: occupancy query says %d\n", per_cu); }
        (void)hipGetLastError();
        grid = cus;
    }
    if (grid < 0) return;
    if (hipMemsetAsync((char*)d_ws + WS_CTL, 0, CTL_ZERO_BYTES, stream) != hipSuccess) return;
    Args a{};
    for (int i = 0; i < 31; ++i) a.in[i] = (const float*)d_in[i];
    a.out = (float*)d_out; a.ws = (unsigned char*)d_ws;
#if MK_DIAG
    auto run = [&](int lo, int hi) { a.ph_lo = lo; a.ph_hi = hi; hipLaunchKernelGGL(fwd_kernel, dim3(grid), dim3(NTHREADS), LDS_BYTES, stream, a); };
    int slot = 0;
    auto chk = [&](int id, int l, int nsl) { hipLaunchKernelGGL(diag_kernel, dim3(256), dim3(256), 0, stream, a, id, l, slot); slot += nsl; };
    run(0, 2); chk(0, 0, 1); chk(1, 0, 1); chk(2, 0, 1);
    for (int l = 0; l < MK_DIAG_LAYERS; ++l) { const int p0 = l == 0 ? 2 : 11;
        run(p0, p0 + 1); chk(3, l, 1); chk(4, l, 1); chk(20, l, 0);
        run(p0 + 1, p0 + 2); chk(5, l, 1); chk(6, l, 1); chk(7, l, 1);
        run(p0 + 2, p0 + 3); chk(8, l, 2);
        run(p0 + 3, p0 + 4); chk(9, l, 1);
        run(p0 + 4, p0 + 5); chk(10, l, 1);
        run(p0 + 5, p0 + 6); chk(11, l, 1); if (l == 0) chk(21, l, 1);
        if (l == 0) { run(8, 9); chk(12, 0, 1); run(9, 10); chk(13, 0, 1); run(10, 11); chk(14, 0, 1); }
    }
    hipLaunchKernelGGL(diag_encode, dim3(1024), dim3(256), 0, stream, a, slot, MK_DIAG_FIRST);
#elif MK_MULTI
    for (int p = 0; p < NPHASES; ++p) { a.ph_lo = p; a.ph_hi = p + 1; hipLaunchKernelGGL(fwd_kernel, dim3(grid), dim3(NTHREADS), LDS_BYTES, stream, a); }
#else
    a.ph_lo = 0; a.ph_hi = NPHASES;
    hipLaunchKernelGGL(fwd_kernel, dim3(grid), dim3(NTHREADS), LDS_BYTES, stream, a);
#endif
    const hipError_t le = hipPeekAtLastError();
    if (le != hipSuccess) fprintf(stderr, "kernel_launch: launch failed: %s\n", hipGetErrorName(le));
}
```

```cpp
#include <hip/hip_runtime.h>
#include <cstdio>
#include <cstdint>
namespace pg8 {
#define PG8_LAS __attribute__((address_space(3)))
typedef unsigned short bf16_t;
typedef short bf16x8 __attribute__((ext_vector_type(8)));
typedef float f32x4 __attribute__((ext_vector_type(4)));
typedef unsigned u32x4 __attribute__((ext_vector_type(4)));
constexpr int BM = 256, BK = 64, HALF = 128, HTB = HALF * BK * 2  , STAGE_BYTES = 8 * HTB, NXCD = 8, WGM = 8;

__host__ __device__ __forceinline__ int lds_byte(int r, int c) { const int st = (r >> 4) * 2 + (c >> 5), rr = r & 15, cc = c & 31, ob = rr * 64 + cc * 2; return st * 1024 + (ob ^ (((ob >> 9) & 1) << 5)); }
__host__ __device__ __forceinline__ void stage_rc(int b, int& R, int& C) { const int st = b / 1024, sb = b % 1024, swz = sb ^ (((sb >> 9) & 1) << 5); R = (st >> 1) * 16 + swz / 64; C = (st & 1) * 32 + (swz % 64) / 2; }
__host__ __device__ __forceinline__ int perm32(int rho) { const int n = rho >> 4, i = rho & 15; return 8 * (i >> 2) + 4 * n + (i & 3); }

struct Unit { int pm, pn; };
struct Gemm { const bf16_t* A; const bf16_t* Bt; int M, N, K; };

struct StaticOrder {
    int nM, nN, nwg, G, c;
    __host__ __device__ void init(int M, int N, int G_, int c_) { nM = M / BM; nN = N / BM; nwg = nM * nN; G = G_; c = c_; }
    __host__ __device__ bool next(int i, Unit& u) const {
        const long L = (long)i * G + c; if (L >= nwg) return false;
        int wgid = (int)L; { const int q = nwg / NXCD, r = nwg % NXCD, xcd = wgid % NXCD, off = wgid / NXCD; wgid = (xcd < r ? xcd * (q + 1) : r * (q + 1) + (xcd - r) * q) + off; }
        const int nig = WGM * nN, gid = wgid / nig, fm = gid * WGM, gsz = (nM - fm) < WGM ? (nM - fm) : WGM;
        u.pm = fm + ((wgid % nig) % gsz); u.pn = (wgid % nig) / gsz; return true;
    }
    __device__ __forceinline__ void a_ready(const Unit&) const {}
    __device__ __forceinline__ void done(const Unit&) const {}
};

typedef float f32x2_t __attribute__((ext_vector_type(2)));
typedef __bf16 bf16x2_t __attribute__((ext_vector_type(2)));
__device__ __forceinline__ unsigned cvt_pk_bf16(float lo, float hi) { const f32x2_t v = {lo, hi}; const bf16x2_t b = __builtin_convertvector(v, bf16x2_t); return __builtin_bit_cast(unsigned, b); }
__device__ __forceinline__ u32x4 pack8(f32x4 a, f32x4 b) { u32x4 w; w.x = cvt_pk_bf16(a[0], a[1]); w.y = cvt_pk_bf16(a[2], a[3]); w.z = cvt_pk_bf16(b[0], b[1]); w.w = cvt_pk_bf16(b[2], b[3]); return w; }
__device__ __forceinline__ float bf_lo(unsigned w) { return __builtin_bit_cast(float, w << 16); }
__device__ __forceinline__ float bf_hi(unsigned w) { return __builtin_bit_cast(float, w & 0xffff0000u); }
__device__ __forceinline__ void unpack8(u32x4 w, f32x4& a, f32x4& b) { a = (f32x4){bf_lo(w.x), bf_hi(w.x), bf_lo(w.y), bf_hi(w.y)}; b = (f32x4){bf_lo(w.z), bf_hi(w.z), bf_lo(w.w), bf_hi(w.w)}; }
__device__ __forceinline__ float fast_sigmoid(float x) { return __builtin_amdgcn_rcpf(1.0f + __builtin_amdgcn_exp2f(-1.4426950408889634f * x)); }

struct EpiPlain {
    static constexpr bool PERM = true, AFTER_DRAIN = false, INPLACE = false;
    bf16_t* O; int ldc; int pn_mod; int accum; float scale;
    __device__ __forceinline__ void operator()(const f32x4 (&acc)[2][2][4][2], const Unit& u, int wr, int wc, int fr, int fq) const {
        asm volatile("" : "+v"(fr), "+v"(fq));
        const int pn = pn_mod ? (u.pn % pn_mod) : u.pn;
        const int row0 = u.pm * BM + wr * 64 + fr, col0 = pn * BM + wc * 32 + 8 * fq;
#pragma unroll
        for (int ai = 0; ai < 2; ++ai)
#pragma unroll
            for (int m = 0; m < 4; ++m) { bf16_t* rowp = O + (size_t)(row0 + ai * HALF + m * 16) * ldc + col0;
#pragma unroll
                for (int bj = 0; bj < 2; ++bj) { f32x4 v0 = acc[ai][bj][m][0] * scale, v1 = acc[ai][bj][m][1] * scale;
                    if (accum) { f32x4 p0, p1; unpack8(*(const u32x4*)(rowp + bj * HALF), p0, p1); v0 = v0 + p0; v1 = v1 + p1; }
                    *(u32x4*)(rowp + bj * HALF) = pack8(v0, v1); } }
    }
};
__device__ __forceinline__ unsigned pack_u8x4(float a, float b, float c, float d) {
    unsigned w = 0; w = __builtin_amdgcn_cvt_pk_u8_f32(a, 0, w); w = __builtin_amdgcn_cvt_pk_u8_f32(b, 1, w); w = __builtin_amdgcn_cvt_pk_u8_f32(c, 2, w); w = __builtin_amdgcn_cvt_pk_u8_f32(d, 3, w); return w; }
struct EpiSig {
    static constexpr bool PERM = true, AFTER_DRAIN = false, INPLACE = false;
    unsigned char* O; int ldc; float in_scale;
    __device__ __forceinline__ void operator()(const f32x4 (&acc)[2][2][4][2], const Unit& u, int wr, int wc, int fr, int fq) const {
        const int row0 = u.pm * BM + wr * 64 + fr, col0 = u.pn * BM + wc * 32 + 8 * fq;
        typedef unsigned u32x2_ __attribute__((ext_vector_type(2)));
#pragma unroll
        for (int ai = 0; ai < 2; ++ai)
#pragma unroll
            for (int m = 0; m < 4; ++m) { unsigned char* rowp = O + (size_t)(row0 + ai * HALF + m * 16) * ldc + col0;
#pragma unroll
                for (int bj = 0; bj < 2; ++bj) { f32x4 v0 = acc[ai][bj][m][0] * in_scale, v1 = acc[ai][bj][m][1] * in_scale;
#pragma unroll
                    for (int e = 0; e < 4; ++e) { v0[e] = 255.0f * fast_sigmoid(v0[e]); v1[e] = 255.0f * fast_sigmoid(v1[e]); }
                    u32x2_ w; w.x = pack_u8x4(v0[0], v0[1], v0[2], v0[3]); w.y = pack_u8x4(v1[0], v1[1], v1[2], v1[3]);
                    *(u32x2_*)(rowp + bj * HALF) = w; } }
    }
};
struct EpiSwiGLU {
    static constexpr bool PERM = true, AFTER_DRAIN = false, INPLACE = false;
    bf16_t* O; int ldc; int pn_mod;
    __device__ __forceinline__ void operator()(const f32x4 (&acc)[2][2][4][2], const Unit& u, int wr, int wc, int fr, int fq) const {
        const int pn = pn_mod ? (u.pn % pn_mod) : u.pn;
        const int row0 = u.pm * BM + wr * 64 + fr, col0 = pn * HALF + wc * 32 + 8 * fq;
#pragma unroll
        for (int ai = 0; ai < 2; ++ai)
#pragma unroll
            for (int m = 0; m < 4; ++m) { bf16_t* rowp = O + (size_t)(row0 + ai * HALF + m * 16) * ldc + col0;
                f32x4 v0 = acc[ai][0][m][0], v1 = acc[ai][0][m][1]; const f32x4 g0 = acc[ai][1][m][0], g1 = acc[ai][1][m][1];
#pragma unroll
                for (int e = 0; e < 4; ++e) { v0[e] = v0[e] * fast_sigmoid(v0[e]) * g0[e]; v1[e] = v1[e] * fast_sigmoid(v1[e]) * g1[e]; }
                *(u32x4*)rowp = pack8(v0, v1); }
    }
};
__device__ __forceinline__ unsigned pack_fp8x4(float a, float b, float c, float d) {
    a = __builtin_amdgcn_fmed3f(a, -448.f, 448.f); b = __builtin_amdgcn_fmed3f(b, -448.f, 448.f); c = __builtin_amdgcn_fmed3f(c, -448.f, 448.f); d = __builtin_amdgcn_fmed3f(d, -448.f, 448.f);
    int w = 0; w = __builtin_amdgcn_cvt_pk_fp8_f32(a, b, w, false); w = __builtin_amdgcn_cvt_pk_fp8_f32(c, d, w, true); return (unsigned)w; }
struct EpiSwiGLU8 {
    static constexpr bool PERM = true, AFTER_DRAIN = false, INPLACE = false;
    unsigned char* O; int ldc; int pn_mod; float in_scale, out_scale;
    __device__ __forceinline__ void operator()(const f32x4 (&acc)[2][2][4][2], const Unit& u, int wr, int wc, int fr, int fq) const {
        asm volatile("" : "+v"(fr), "+v"(fq));
        const int pn = pn_mod ? (u.pn % pn_mod) : u.pn;
        const int row0 = u.pm * BM + wr * 64 + fr, col0 = pn * HALF + wc * 32 + 8 * fq;
#pragma unroll
        for (int ai = 0; ai < 2; ++ai)
#pragma unroll
            for (int m = 0; m < 4; ++m) { unsigned char* rowp = O + (size_t)(row0 + ai * HALF + m * 16) * ldc + col0;
                f32x4 v0 = acc[ai][0][m][0] * in_scale, v1 = acc[ai][0][m][1] * in_scale; const f32x4 g0 = acc[ai][1][m][0] * (in_scale * out_scale), g1 = acc[ai][1][m][1] * (in_scale * out_scale);
#pragma unroll
                for (int e = 0; e < 4; ++e) { v0[e] = v0[e] * fast_sigmoid(v0[e]) * g0[e]; v1[e] = v1[e] * fast_sigmoid(v1[e]) * g1[e]; }
                typedef unsigned u32x2_ __attribute__((ext_vector_type(2)));
                u32x2_ w; w.x = pack_fp8x4(v0[0], v0[1], v0[2], v0[3]); w.y = pack_fp8x4(v1[0], v1[1], v1[2], v1[3]);
                *(u32x2_*)rowp = w; }
    }
};
struct EpiMerge {
    static constexpr bool PERM = true, AFTER_DRAIN = false, INPLACE = true;
    bf16_t* Mo; const unsigned char* Gt; int off0, off1, off2;
    __device__ __forceinline__ static void ub4(unsigned w, f32x4& v) { v = (f32x4){(float)(w & 0xffu), (float)((w >> 8) & 0xffu), (float)((w >> 16) & 0xffu), (float)(w >> 24)}; }
    __device__ __forceinline__ bool inplace(f32x4 (&acc)[2][2][4][2], const Unit& u, int wr, int wc, int fr, int fq) const {
        typedef unsigned u32x2_ __attribute__((ext_vector_type(2)));
        const int br = u.pn >> 2, pn = u.pn & 3, pm = u.pm - (br < 2 ? off0 + br * (off1 - off0) : off2);
        const int row0 = pm * BM + wr * 64 + fr, col0 = pn * BM + wc * 32 + 8 * fq;
#pragma unroll
        for (int ai = 0; ai < 2; ++ai)
#pragma unroll
            for (int m = 0; m < 4; ++m) { const size_t row = (size_t)(row0 + ai * HALF + m * 16); const unsigned char* gp = Gt + row * 3072 + br * 1024 + col0;
#pragma unroll
                for (int bj = 0; bj < 2; ++bj) { const u32x2_ gw = *(const u32x2_*)(gp + bj * HALF); f32x4 g0, g1; ub4(gw.x, g0); ub4(gw.y, g1);
                    if (br < 2) { const u32x2_ nw = *(const u32x2_*)(gp + 1024 + bj * HALF); f32x4 n0, n1; ub4(nw.x, n0); ub4(nw.y, n1);
#pragma unroll
                        for (int e = 0; e < 4; ++e) { g0[e] = fmaxf(g0[e], 0.5f) * __builtin_amdgcn_rcpf(fmaxf(n0[e], 0.5f)); g1[e] = fmaxf(g1[e], 0.5f) * __builtin_amdgcn_rcpf(fmaxf(n1[e], 0.5f)); }
                        acc[ai][bj][m][0] = acc[ai][bj][m][0] * g0; acc[ai][bj][m][1] = acc[ai][bj][m][1] * g1;
                    } else {
#pragma unroll
                        for (int e = 0; e < 4; ++e) { g0[e] = fmaxf(g0[e], 0.5f) * (1.0f / 255.0f); g1[e] = fmaxf(g1[e], 0.5f) * (1.0f / 255.0f); }
                        *(u32x4*)(Mo + row * 1024 + col0 + bj * HALF) = pack8(acc[ai][bj][m][0] * g0, acc[ai][bj][m][1] * g1); }
                } }
        return br < 2;
    }
};
struct EpiQKV {
    static constexpr bool PERM = true, AFTER_DRAIN = false, INPLACE = false;
    bf16_t* O; const float* rope; int row_base; float qscale; float in_scale;
    __device__ __forceinline__ void operator()(const f32x4 (&acc)[2][2][4][2], const Unit& u, int wr, int wc, int fr, int fq) const {
        const int rowt = row_base + u.pm * BM;
        const bool latent = rowt < 65536;
        const int row0 = rowt + wr * 64 + fr, col0 = u.pn * BM + wc * 32 + 8 * fq;
#pragma unroll
        for (int bj = 0; bj < 2; ++bj) {
            const int cb = 2 * u.pn + bj;
            const bool do_rope = latent && (cb == 0 || (cb >= 10 && cb < 14));
            const float sc = (cb >= 10) ? qscale * in_scale : in_scale;
#pragma unroll
            for (int ai = 0; ai < 2; ++ai)
#pragma unroll
                for (int m = 0; m < 4; ++m) {
                    const int row = row0 + ai * HALF + m * 16;
                    f32x4 v0 = acc[ai][bj][m][0], v1 = acc[ai][bj][m][1];
                    if (do_rope) {
                        const int t = row & 2047, pos = (wc & 1) ? (t & 63) : (t >> 6);
                        const float* cp = rope + pos * 16 + 8 * (fq & 1);
                        const f32x4 c0 = *(const f32x4*)cp, c1 = *(const f32x4*)(cp + 4), s0 = *(const f32x4*)(cp + 1024), s1 = *(const f32x4*)(cp + 1028);
                        const float sg = (fq >= 2) ? 1.0f : -1.0f;
                        f32x4 o0, o1;
#pragma unroll
                        for (int e = 0; e < 4; ++e) { o0[e] = __shfl_xor(v0[e], 32); o1[e] = __shfl_xor(v1[e], 32); }
                        v0 = v0 * c0 + (o0 * sg) * s0; v1 = v1 * c1 + (o1 * sg) * s1;
                    }
                    v0 = v0 * sc; v1 = v1 * sc;
                    *(u32x4*)(O + (size_t)row * 2304 + col0 + bj * HALF) = pack8(v0, v1);
                }
        }
    }
};
__device__ __forceinline__ void tile_of(int L, int nM, int nN, int& pm, int& pn) {
    const int nwg = nM * nN; int wgid = L; { const int q = nwg / NXCD, r = nwg % NXCD, xcd = wgid % NXCD, off = wgid / NXCD; wgid = (xcd < r ? xcd * (q + 1) : r * (q + 1) + (xcd - r) * q) + off; }
    const int nig = WGM * nN, gid = wgid / nig, fm = gid * WGM, gsz = (nM - fm) < WGM ? (nM - fm) : WGM;
    pm = fm + ((wgid % nig) % gsz); pn = (wgid % nig) / gsz;
}
struct MergeOrder {
    int nM, G, c, off0, off1, off2;
    __device__ bool next(int i, Unit& u) const {
        const int t = i / 3, br = i - 3 * t; const long L = (long)t * G + c; if (L >= (long)nM * 4) return false;
        int pm, pn; tile_of((int)L, nM, 4, pm, pn); u.pm = (br < 2 ? off0 + br * (off1 - off0) : off2) + pm; u.pn = br * 4 + pn; return true;
    }
    __device__ __forceinline__ void a_ready(const Unit&) const {}
    __device__ __forceinline__ void done(const Unit&) const {}
};
struct GroupOrder {
    int nM, nN, G, c; int toff[9];
    __device__ bool next(int i, Unit& u) const {
        const long L = (long)i * G + c; if (L >= (long)nM * nN) return false;
        int pm, pn; tile_of((int)L, nM, nN, pm, pn); int e = 0;
#pragma unroll
        for (int k = 1; k < 8; ++k) e += (pm >= toff[k]) ? 1 : 0;
        u.pm = pm; u.pn = e * nN + pn; return true;
    }
    __device__ __forceinline__ void a_ready(const Unit&) const {}
    __device__ __forceinline__ void done(const Unit&) const {}
};
template <class Epi, class Sched, bool ALIGN_EPI = false, bool SP2 = false, bool F8 = false>
__device__ __forceinline__ void gemm_phase(PG8_LAS unsigned char* lds, const Gemm g, const Sched& S, const Epi& E, const int tid) {
    const int wid = __builtin_amdgcn_readfirstlane(tid >> 6), lane = tid & 63, wr = wid >> 2, wc = wid & 3, fr = lane & 15, fq = lane >> 4;
    const int K = g.K, nt = K / BK;
    unsigned voffA[2], voffB[2];
#pragma unroll
    for (int i = 0; i < 2; ++i) { int R, C; stage_rc(tid * 16 + i * 8192, R, C); const int Rb = Epi::PERM ? ((R & ~31) + perm32(R & 31)) : R;
        voffA[i] = (unsigned)(R * K + C) * 2u; voffB[i] = (unsigned)(Rb * K + C) * 2u; }
    const size_t kstep = (size_t)(BK * 2);
    const size_t hstep = (size_t)HALF * K * 2;
    const size_t tstep = 2 * hstep;
    const unsigned ldsw = (unsigned)wid * 1024u;
    const int aoff = lds_byte(wr * 64 + fr, fq * 8), boff = lds_byte(wc * 32 + fr, fq * 8);
#define PG8_SA(b, h) (((b) * 2 + (h)) * HTB)
#define PG8_SB(b, h) ((4 + (b) * 2 + (h)) * HTB)
#define PG8_STAGE(bufoff, gbase, voff) do { _Pragma("unroll") for (int _i = 0; _i < 2; ++_i) \
        __builtin_amdgcn_global_load_lds((const unsigned*)((const char*)(gbase) + (voff)[_i]), (PG8_LAS unsigned*)(lds + (bufoff) + ldsw + _i * 8192), 16, 0, 0); } while (0)
#define PG8_LDA(dst, b, h) do { _Pragma("unroll") for (int m = 0; m < 4; ++m) _Pragma("unroll") for (int k = 0; k < 2; ++k) dst[m][k] = *(const PG8_LAS bf16x8*)(lds + PG8_SA(b, h) + aoff + m * 2048 + k * 1024); } while (0)
#define PG8_LDB(dst, b, h) do { _Pragma("unroll") for (int n = 0; n < 2; ++n) _Pragma("unroll") for (int k = 0; k < 2; ++k) dst[n][k] = *(const PG8_LAS bf16x8*)(lds + PG8_SB(b, h) + boff + n * 2048 + k * 1024); } while (0)
#define PG8_MMA(ai, bj, At, Bt) do { __builtin_amdgcn_s_setprio(1); _Pragma("unroll") for (int m = 0; m < 4; ++m) _Pragma("unroll") for (int n = 0; n < 2; ++n) { \
        if constexpr (F8) { typedef int v8i_ __attribute__((ext_vector_type(8))); typedef int v4i_ __attribute__((ext_vector_type(4))); \
            const v4i_ b0_ = __builtin_bit_cast(v4i_, Bt[n][0]), b1_ = __builtin_bit_cast(v4i_, Bt[n][1]), a0_ = __builtin_bit_cast(v4i_, At[m][0]), a1_ = __builtin_bit_cast(v4i_, At[m][1]); \
            const v8i_ bb_ = __builtin_shufflevector(b0_, b1_, 0, 1, 2, 3, 4, 5, 6, 7), aa_ = __builtin_shufflevector(a0_, a1_, 0, 1, 2, 3, 4, 5, 6, 7); \
            asm volatile("v_mfma_scale_f32_16x16x128_f8f6f4 %0, %1, %2, %0, %3, %3 op_sel_hi:[0,0,0]" : "+v"(acc[ai][bj][m][n]) : "v"(bb_), "v"(aa_), "v"(f8_scale_)); } \
        else { _Pragma("unroll") for (int k = 0; k < 2; ++k) acc[ai][bj][m][n] = __builtin_amdgcn_mfma_f32_16x16x32_bf16(Bt[n][k], At[m][k], acc[ai][bj][m][n], 0, 0, 0); } } \
        __builtin_amdgcn_s_setprio(0); } while (0)
#define PG8_WAIT_V(n) asm volatile("s_waitcnt vmcnt(" #n ")" ::: "memory")
#define PG8_WAIT_L(n) asm volatile("s_waitcnt lgkmcnt(" #n ")" ::: "memory")
#define PG8_BAR __builtin_amdgcn_s_barrier()
#define PG8_SCHED __builtin_amdgcn_sched_barrier(0)
    int f8_scale_ = 0x7f7f7f7f; (void)f8_scale_;
    Unit cur, nxt; int ui = 0;
    if (!S.next(0, cur)) return;
    f32x4 acc[2][2][4][2];
#pragma unroll
    for (int a = 0; a < 2; ++a)
#pragma unroll
        for (int b = 0; b < 2; ++b)
#pragma unroll
            for (int m = 0; m < 4; ++m)
#pragma unroll
                for (int n = 0; n < 2; ++n) acc[a][b][m][n] = (f32x4){0.f, 0.f, 0.f, 0.f};
    bf16x8 At[4][2], B0[2][2], B1[2][2];
    const char* cA = (const char*)g.A + (size_t)cur.pm * tstep; const char* cB = (const char*)g.Bt + (size_t)cur.pn * tstep;
    S.a_ready(cur);
    if constexpr (SP2) {
        PG8_STAGE(PG8_SB(0, 0), cB, voffB); PG8_STAGE(PG8_SB(0, 1), cB + hstep, voffB); PG8_STAGE(PG8_SA(0, 0), cA, voffA); PG8_STAGE(PG8_SA(0, 1), cA + hstep, voffA);
        if (wr == 1) PG8_BAR;
        PG8_WAIT_V(2); PG8_BAR;
        PG8_STAGE(PG8_SB(1, 0), cB + kstep, voffB); PG8_STAGE(PG8_SA(1, 0), cA + kstep, voffA); PG8_STAGE(PG8_SB(1, 1), cB + hstep + kstep, voffB);
        PG8_WAIT_V(6); PG8_BAR;
    } else {
        PG8_STAGE(PG8_SB(0, 0), cB, voffB); PG8_STAGE(PG8_SA(0, 0), cA, voffA); PG8_STAGE(PG8_SB(0, 1), cB + hstep, voffB); PG8_STAGE(PG8_SA(0, 1), cA + hstep, voffA);
        if (wr == 1) PG8_BAR;
        PG8_WAIT_V(4); PG8_BAR;
        PG8_STAGE(PG8_SB(1, 0), cB + kstep, voffB); PG8_STAGE(PG8_SA(1, 0), cA + kstep, voffA); PG8_STAGE(PG8_SB(1, 1), cB + hstep + kstep, voffB);
        PG8_WAIT_V(6); PG8_BAR;
    }
    for (;;) {
        const bool has_next = S.next(ui + 1, nxt);
        const char* nA = has_next ? (const char*)g.A + (size_t)nxt.pm * tstep : cA; const char* nB = has_next ? (const char*)g.Bt + (size_t)nxt.pn * tstep : cB;
#pragma unroll 1
        for (int t = 0; t < nt; t += 2) {
            const bool last = (t == nt - 2);
            const char* a1 = cA + (size_t)(t + 1) * kstep;
            const char* a2 = last ? nA : cA + (size_t)(t + 2) * kstep; const char* b2 = last ? nB : cB + (size_t)(t + 2) * kstep;
            const char* a3 = a2 + kstep; const char* b3 = b2 + kstep;
            if (last && has_next) S.a_ready(nxt);
            if constexpr (SP2) {
            PG8_LDB(B0, 0, 0); PG8_LDB(B1, 0, 1); PG8_SCHED; PG8_LDA(At, 0, 0); PG8_STAGE(PG8_SA(1, 1), a1 + hstep, voffA);
            PG8_WAIT_V(8); PG8_WAIT_L(0); PG8_BAR; PG8_MMA(0, 0, At, B0); PG8_MMA(0, 1, At, B1); PG8_BAR; PG8_SCHED;
            PG8_LDA(At, 0, 1); PG8_STAGE(PG8_SB(0, 0), b2, voffB); PG8_STAGE(PG8_SB(0, 1), b2 + hstep, voffB); PG8_STAGE(PG8_SA(0, 0), a2, voffA);
            PG8_WAIT_V(8); PG8_WAIT_L(0); PG8_BAR; PG8_MMA(1, 0, At, B0); PG8_MMA(1, 1, At, B1); PG8_BAR; PG8_SCHED;
            PG8_LDB(B0, 1, 0); PG8_LDB(B1, 1, 1); PG8_SCHED; PG8_LDA(At, 1, 0); PG8_STAGE(PG8_SA(0, 1), a2 + hstep, voffA);
            PG8_WAIT_V(8); PG8_WAIT_L(0); PG8_BAR; PG8_MMA(0, 0, At, B0); PG8_MMA(0, 1, At, B1); PG8_BAR; PG8_SCHED;
            PG8_LDA(At, 1, 1); PG8_STAGE(PG8_SB(1, 0), b3, voffB); PG8_STAGE(PG8_SB(1, 1), b3 + hstep, voffB); PG8_STAGE(PG8_SA(1, 0), a3, voffA);
            PG8_WAIT_V(8); PG8_WAIT_L(0); PG8_BAR; PG8_MMA(1, 0, At, B0); PG8_MMA(1, 1, At, B1); PG8_BAR; PG8_SCHED;
            } else {
            PG8_LDB(B0, 0, 0); PG8_SCHED; PG8_LDA(At, 0, 0); PG8_STAGE(PG8_SA(1, 1), a1 + hstep, voffA);
            PG8_WAIT_L(8); PG8_BAR; PG8_WAIT_L(0); PG8_MMA(0, 0, At, B0); PG8_BAR; PG8_SCHED;
            PG8_LDB(B1, 0, 1); PG8_STAGE(PG8_SB(0, 0), b2, voffB);
            PG8_BAR; PG8_WAIT_L(0); PG8_MMA(0, 1, At, B1); PG8_BAR;
            PG8_LDA(At, 0, 1); PG8_STAGE(PG8_SA(0, 0), a2, voffA);
            PG8_BAR; PG8_WAIT_L(0); PG8_MMA(1, 0, At, B0); PG8_BAR; PG8_SCHED;
            PG8_STAGE(PG8_SB(0, 1), b2 + hstep, voffB);
            PG8_WAIT_V(6); PG8_BAR; PG8_MMA(1, 1, At, B1); PG8_BAR;
            PG8_LDB(B0, 1, 0); PG8_SCHED; PG8_LDA(At, 1, 0); PG8_STAGE(PG8_SA(0, 1), a2 + hstep, voffA);
            PG8_WAIT_L(8); PG8_BAR; PG8_WAIT_L(0); PG8_MMA(0, 0, At, B0); PG8_BAR; PG8_SCHED;
            PG8_LDB(B1, 1, 1); PG8_STAGE(PG8_SB(1, 0), b3, voffB);
            PG8_BAR; PG8_WAIT_L(0); PG8_MMA(0, 1, At, B1); PG8_BAR;
            PG8_LDA(At, 1, 1); PG8_STAGE(PG8_SA(1, 0), a3, voffA);
            PG8_BAR; PG8_WAIT_L(0); PG8_MMA(1, 0, At, B0); PG8_BAR; PG8_SCHED;
            PG8_STAGE(PG8_SB(1, 1), b3 + hstep, voffB);
            PG8_WAIT_V(6); PG8_BAR; PG8_MMA(1, 1, At, B1); PG8_BAR;
            }
        }
        if constexpr (ALIGN_EPI) { if (wr == 0) PG8_BAR; }
        if constexpr (F8) asm volatile("s_nop 15\n\ts_nop 15" ::: "memory");
        bool keep_acc = false;
        if constexpr (Epi::INPLACE) { keep_acc = E.inplace(acc, cur, wr, wc, fr, fq); S.done(cur); }
        else if constexpr (!Epi::AFTER_DRAIN) { E(acc, cur, wr, wc, fr, fq); S.done(cur); }
        if (!has_next) break;
        if (!keep_acc)
#pragma unroll
        for (int a = 0; a < 2; ++a)
#pragma unroll
            for (int b = 0; b < 2; ++b)
#pragma unroll
                for (int m = 0; m < 4; ++m)
#pragma unroll
                    for (int n = 0; n < 2; ++n) acc[a][b][m][n] = (f32x4){0.f, 0.f, 0.f, 0.f};
        cur = nxt; cA = nA; cB = nB; ++ui;
        if constexpr (ALIGN_EPI) { if (wr == 1) PG8_BAR; }
    }
    PG8_WAIT_V(0);
    if constexpr (!ALIGN_EPI) { if (wr == 0) PG8_BAR; }
    PG8_BAR;
    if constexpr (Epi::AFTER_DRAIN) { E.fused(acc, cur, wr, wc, fr, fq, lds, wid, lane); S.done(cur); }
#undef PG8_SA
#undef PG8_SB
#undef PG8_STAGE
#undef PG8_LDA
#undef PG8_LDB
#undef PG8_MMA
#undef PG8_WAIT_V
#undef PG8_WAIT_L
#undef PG8_BAR
#undef PG8_SCHED
}
}
#define GAS __attribute__((address_space(1)))
#define LAS __attribute__((address_space(3)))
typedef unsigned short bf16;
typedef unsigned v4u __attribute__((ext_vector_type(4)));
typedef float f32x4 __attribute__((ext_vector_type(4)));
typedef short bf16x8 __attribute__((ext_vector_type(8)));
typedef GAS unsigned gu32;
typedef GAS unsigned long long gu64;
#define RLX_AGENT __ATOMIC_RELAXED, __HIP_MEMORY_SCOPE_AGENT
#define LDS_WAIT() asm volatile("s_waitcnt lgkmcnt(0)" ::: "memory")
#define VM_WAIT() asm volatile("s_waitcnt vmcnt(0)" ::: "memory")
__device__ __forceinline__ unsigned long long rt() { return __builtin_amdgcn_s_memrealtime(); }
__device__ __forceinline__ unsigned f2bf(float f) { unsigned u = __builtin_bit_cast(unsigned, f); return (u + 0x7fffu + ((u >> 16) & 1u)) >> 16; }
__device__ __forceinline__ unsigned pk2(float lo, float hi) { return pg8::cvt_pk_bf16(lo, hi); }

#define XB_TMO      128
#define XB_XCNT(j)  (256  + 64 * (j))
#define XB_XSUB(j)  (1280 + 64 * (j))
#define XB_XGEN(j)  (2304 + 64 * (j))
#define XB_TOP      3328
#define XB_TOPGEN   3392
#define XCD_BAR_WORDS 3456
#define XB_SPIN_CAP (1u << 18)

__device__ __forceinline__ unsigned xb_ld(unsigned* p)              { return __hip_atomic_load(p, __ATOMIC_RELAXED, __HIP_MEMORY_SCOPE_AGENT); }
__device__ __forceinline__ unsigned xb_add(unsigned* p, unsigned v) { return __hip_atomic_fetch_add(p, v, __ATOMIC_RELAXED, __HIP_MEMORY_SCOPE_AGENT); }
__device__ __forceinline__ unsigned xb_xcc_id() { return (unsigned)__builtin_amdgcn_s_getreg((3 << 11) | 20) & 0xFu; }
#define XB_SPIN(cond, bar) do { unsigned _sp = 0; while (cond) { __builtin_amdgcn_s_sleep(1); \
    if ((++_sp & 255u) == 0u) { if (xb_ld(&(bar)[XB_TMO])) break; if (_sp > XB_SPIN_CAP) { atomicAdd(&(bar)[XB_TMO], 1u); break; } } } } while (0)

struct XcdBarrier {
    unsigned* bar; unsigned x;
    volatile LAS unsigned* st;
};

__device__ __forceinline__ XcdBarrier xcd_barrier_post(unsigned* bar, volatile LAS unsigned* st) {
    XcdBarrier b; b.bar = bar; b.x = xb_xcc_id(); b.st = st;
    if (threadIdx.x == 0) (void)xb_add(&bar[XB_XCNT(b.x)], 1u);
    return b;
}
__device__ __forceinline__ void xcd_barrier_complete(unsigned* bar, unsigned x, unsigned& nloc, unsigned& nx) {
    const unsigned G = gridDim.x * gridDim.y * gridDim.z;
    unsigned sum, cnt, mine, sp = 0u;
    for (;;) {
        sum = 0u; cnt = 0u; mine = 0u;
#pragma unroll
        for (unsigned j = 0; j < 16; ++j) { const unsigned c = xb_ld(&bar[XB_XCNT(j)]); sum += c; cnt += (c > 0u) ? 1u : 0u; mine = (j == x) ? c : mine; }
        if (sum == G) break;
        __builtin_amdgcn_s_sleep(1);
        if ((++sp & 255u) == 0u) { if (xb_ld(&bar[XB_TMO])) break; if (sp > XB_SPIN_CAP) { atomicAdd(&bar[XB_TMO], 1u); break; } }
    }
    nloc = mine > 0u ? mine : 1u; nx = cnt > 0u ? cnt : 1u;
}

__device__ __forceinline__ void xcd_barrier(const XcdBarrier& b) {
    asm volatile("s_waitcnt vmcnt(0)" ::: "memory");
    __syncthreads();
    if (threadIdx.x == 0) {
        unsigned* bar = b.bar;
        __builtin_amdgcn_s_waitcnt(0);
        unsigned nloc = b.st[0], nx = b.st[1];
        if (nloc == 0u) { xcd_barrier_complete(bar, b.x, nloc, nx); b.st[0] = nloc; b.st[1] = nx; }
        const unsigned old = xb_add(&bar[XB_XSUB(b.x)], 1u);
        const unsigned gen = old / nloc;
        if (old + 1u == (gen + 1u) * nloc) {
            __builtin_amdgcn_fence(__ATOMIC_RELEASE, "agent");
            asm volatile("s_waitcnt vmcnt(0)" ::: "memory");
            const unsigned og = xb_add(&bar[XB_TOP], 1u);
            const unsigned tg = og / nx;
            if (og + 1u == (tg + 1u) * nx) xb_add(&bar[XB_TOPGEN], 1u);
            else XB_SPIN(xb_ld(&bar[XB_TOPGEN]) == tg, bar);
            __builtin_amdgcn_fence(__ATOMIC_ACQUIRE, "agent");
            xb_add(&bar[XB_XGEN(b.x)], 1u);
            asm volatile("s_waitcnt vmcnt(0)" ::: "memory");
        } else {
            XB_SPIN(xb_ld(&bar[XB_XGEN(b.x)]) == gen, bar);
            __builtin_amdgcn_fence(__ATOMIC_ACQUIRE, "agent");
            asm volatile("s_waitcnt vmcnt(0)" ::: "memory");
        }
    }
    __syncthreads();
}

typedef float f32x16 __attribute__((ext_vector_type(16)));
typedef short s16x4 __attribute__((ext_vector_type(4)));
typedef unsigned v2u __attribute__((ext_vector_type(2)));
#define MFMA32(a, b, c) __builtin_amdgcn_mfma_f32_32x32x16_bf16((a), (b), (c), 0, 0, 0)

constexpr int NWAVES = 8, NTHREADS = 512;
constexpr int D = 1024, NB = 32, SEQ = 2048, LC = 256, NTOK = NB * SEQ, NCTX = NB * LC, NROW = NTOK + NCTX;
constexpr int INC = 6912, QKVC = 2304, CINC = 1536, GATEC = 3072, DFF = 2816, NEXP = 8, DFFE = 3584, FCH = 1792;
constexpr float W13_SCALE = 32.f, W2_SCALE = 64.f, HID_SCALE = 4.f;
constexpr float LOG2E = 1.4426950408889634f, QSCALE = 0.125f * LOG2E, EPS = 1e-6f;
constexpr int PCAP = 32768 * 2 + 8 * 256;

constexpr size_t MiB = 1u << 20;
constexpr size_t WS_CTL = 0, CTL_ZERO_BYTES = 1 * MiB;
constexpr size_t WS_MODV = 1 * MiB;
constexpr size_t WS_ROPE = 3 * MiB;
constexpr size_t WS_ROUTE = 4 * MiB;
constexpr size_t WS_LIST = 5 * MiB;
constexpr size_t WS_INV = 7 * MiB;
constexpr size_t WS_GF = 8 * MiB;
constexpr size_t WS_GFC = 24 * MiB;
constexpr size_t WS_W = 26 * MiB;
constexpr size_t W_IN = WS_W;
constexpr size_t W_CB = W_IN + (size_t)2 * INC * D;
constexpr size_t W_BR = W_IN + (size_t)2 * INC * D * 2;
constexpr size_t W_OUT = W_BR + (size_t)2 * 3 * D * 512 * 2;
constexpr size_t W_F13 = W_OUT + (size_t)2 * D * D * 2;
constexpr size_t W_F2 = W_F13 + (size_t)2 * DFF * D * 2;
constexpr size_t W_END = W_F2 + (size_t)D * DFF * 2;
constexpr size_t WS_CTXRES = 80 * MiB;
constexpr size_t WS_H = 112 * MiB;
constexpr size_t WS_BIG = 256 * MiB;
constexpr size_t BIG_CINT = WS_BIG;
constexpr size_t BIG_QKV = WS_BIG + 216 * MiB;
constexpr size_t BIG_GATE = WS_BIG + 72 * MiB;
constexpr size_t BIG_YCT = WS_BIG + 288 * MiB;
constexpr size_t BIG_HID = WS_BIG;
constexpr size_t BIG_RAW = WS_BIG;
constexpr size_t BIG_AS = WS_BIG;
constexpr size_t BIG_MH = WS_BIG + 68 * MiB;
constexpr size_t BIG_Y2S = WS_BIG + 300 * MiB;
constexpr size_t WS_Y3 = 796 * MiB;
constexpr size_t WM_13 = WS_Y3;
constexpr size_t WM_2 = WS_Y3 + 56 * MiB;
constexpr size_t WS_H8 = WS_Y3 + 144 * MiB;
constexpr size_t WS_END = 1012 * MiB;
static_assert(W_END <= WS_CTXRES && BIG_Y2S + (size_t)PCAP * D * 2 <= WS_Y3 && BIG_QKV + (size_t)NROW * QKVC * 2 <= WS_Y3 && BIG_GATE + (size_t)NROW * GATEC <= WS_Y3, "ws map");
static_assert(BIG_MH + (size_t)PCAP * DFFE <= BIG_Y2S && BIG_AS + (size_t)PCAP * D <= BIG_MH && WM_13 + (size_t)8 * 2 * DFFE * D <= WM_2 && WM_2 + (size_t)8 * D * DFFE <= WS_END, "ws map 2");

constexpr int CW_BAR = 4096;
constexpr int CW_CNT = 16384;

constexpr int LDS_BYTES = 150528, MISC_OFF = 147456;


struct Args {
    const float* in[31];
    float* out; unsigned char* ws;
    int ph_lo, ph_hi, sub_mask, pad;
};
enum { I_X = 0, I_C, I_CTX, I_CCTX, I_WMOD, I_BMOD, I_GMIXPRE, I_GMIXPOST, I_GFFNPRE, I_GFFNPOST, I_WIN, I_SINK, I_RPB, I_CONVW, I_CONVB, I_HW1, I_HB1, I_HW2, I_HB2, I_HW3,
       I_HFREQ, I_HBIAS, I_WBR, I_WOUT, I_FW1, I_FW3, I_FW2, I_ROUTER, I_MW1, I_MW3, I_MW2 };

struct Frame {
    LAS unsigned char* lds;
    int tid, lane, wave, vcu, G;
    unsigned char* ws;
};

__device__ __forceinline__ float wave_sum(float v) {
#pragma unroll
    for (int o = 1; o < 64; o <<= 1) v += __shfl_xor(v, o);
    return v;
}
__device__ __forceinline__ float bf2f(bf16 b) { return __builtin_bit_cast(float, ((unsigned)b) << 16); }
__device__ __forceinline__ float silu_f(float x) { return x / (1.0f + __expf(-x)); }

__device__ __forceinline__ void transpose_item(const float* W, int N, bf16* WT, int Kp, int k0, int n0, int drow0, LAS float* scr, int lane) {
    { const int c4 = 4 * (lane & 7);
#pragma unroll
      for (int i = 0; i < 8; ++i) { const int kk = (lane >> 3) + 8 * i; const f32x4 v = *(const f32x4*)(W + (size_t)(k0 + kk) * N + n0 + c4); LAS float* d = scr + kk * 33 + c4; d[0] = v.x; d[1] = v.y; d[2] = v.z; d[3] = v.w; } }
    LDS_WAIT(); asm volatile("" ::: "memory");
    const int c = lane & 7;
#pragma unroll
    for (int j = 0; j < 4; ++j) { const int n = (lane >> 3) + 8 * j; const LAS float* s = scr + (8 * c) * 33 + n;
        v4u o; o.x = pk2(s[0 * 33], s[1 * 33]); o.y = pk2(s[2 * 33], s[3 * 33]); o.z = pk2(s[4 * 33], s[5 * 33]); o.w = pk2(s[6 * 33], s[7 * 33]);
        *(GAS v4u*)(WT + (size_t)(drow0 + n) * Kp + k0 + 8 * c) = o; }
    LDS_WAIT(); asm volatile("" ::: "memory");
}
__device__ __forceinline__ bool conv_job(int& r, const float* W, int K, int N, bf16* WT, int Kp, int rowoff, int mode, int which, LAS float* scr, int lane) {
    const int nblk = N / 32, items = (K / 64) * nblk;
    if (r >= items) { r -= items; return false; }
    const int kb = r / nblk, nb = r % nblk, n0 = 32 * nb;
    const int drow0 = mode ? rowoff + (n0 / 128) * 256 + which * 128 + (n0 % 128) : rowoff + n0;
    transpose_item(W, N, WT, Kp, 64 * kb, n0, drow0, scr, lane);
    return true;
}

__device__ __forceinline__ void transpose_item_f8(const float* W, int N, unsigned char* WT, int Kp, int k0, int n0, int drow0, float scale, LAS float* scr, int lane) {
    { const int c4 = 4 * (lane & 7);
#pragma unroll
      for (int i = 0; i < 8; ++i) { const int kk = (lane >> 3) + 8 * i; const f32x4 v = *(const f32x4*)(W + (size_t)(k0 + kk) * N + n0 + c4) * scale; LAS float* d = scr + kk * 33 + c4; d[0] = v.x; d[1] = v.y; d[2] = v.z; d[3] = v.w; } }
    LDS_WAIT(); asm volatile("" ::: "memory");
    const int c = lane & 7;
#pragma unroll
    for (int j = 0; j < 4; ++j) { const int n = (lane >> 3) + 8 * j; const LAS float* s = scr + (8 * c) * 33 + n;
        v2u o; o.x = pg8::pack_fp8x4(s[0 * 33], s[1 * 33], s[2 * 33], s[3 * 33]); o.y = pg8::pack_fp8x4(s[4 * 33], s[5 * 33], s[6 * 33], s[7 * 33]);
        *(GAS v2u*)(WT + (size_t)(drow0 + n) * Kp + k0 + 8 * c) = o; }
    LDS_WAIT(); asm volatile("" ::: "memory");
}
__device__ __forceinline__ bool conv_job_f8(int& r, const float* W, int K, int N, unsigned char* WT, int Kp, int mode, int which, float scale, LAS float* scr, int lane) {
    const int nblk = N / 32, items = (K / 64) * nblk;
    if (r >= items) { r -= items; return false; }
    const int kb = r / nblk, nb = r % nblk, n0 = 32 * nb;
    const int drow0 = mode ? (n0 / 128) * 256 + which * 128 + (n0 % 128) : n0;
    transpose_item_f8(W, N, WT, Kp, 64 * kb, n0, drow0, scale, scr, lane);
    return true;
}

__device__ __forceinline__ void ld_row_f32(const float* p, int lane, f32x4 (&v)[4]) {
    const GAS f32x4* q = (const GAS f32x4*)p + lane;
#pragma unroll
    for (int j = 0; j < 4; ++j) v[j] = q[64 * j];
}
__device__ __forceinline__ void st_row_f32(float* p, int lane, const f32x4 (&v)[4]) {
    GAS f32x4* q = (GAS f32x4*)p + lane;
#pragma unroll
    for (int j = 0; j < 4; ++j) q[64 * j] = v[j];
}
__device__ __forceinline__ void ld_row_bf16(const bf16* p, int lane, f32x4 (&v)[4]) {
    const GAS v2u* q = (const GAS v2u*)p + lane;
#pragma unroll
    for (int j = 0; j < 4; ++j) { const v2u w = q[64 * j]; v[j] = (f32x4){pg8::bf_lo(w.x), pg8::bf_hi(w.x), pg8::bf_lo(w.y), pg8::bf_hi(w.y)}; }
}
__device__ __forceinline__ void st_row_bf16(bf16* p, int lane, const f32x4 (&v)[4]) {
    GAS v2u* q = (GAS v2u*)p + lane;
#pragma unroll
    for (int j = 0; j < 4; ++j) { v2u w; w.x = pk2(v[j].x, v[j].y); w.y = pk2(v[j].z, v[j].w); q[64 * j] = w; }
}
__device__ __forceinline__ float row_rms_scale(const f32x4 (&v)[4]) {
    float s = 0.f;
#pragma unroll
    for (int j = 0; j < 4; ++j) s += (v[j].x * v[j].x + v[j].y * v[j].y) + (v[j].z * v[j].z + v[j].w * v[j].w);
    return __builtin_amdgcn_rsqf(wave_sum(s) * (1.0f / D) + EPS);
}
__device__ __forceinline__ void norm_mod(const f32x4 (&x)[4], const float* g, const float* sc, const float* sh, int lane, f32x4 (&h)[4]) {
    const float rs = row_rms_scale(x);
    f32x4 gv[4], scv[4], shv[4]; ld_row_f32(g, lane, gv); ld_row_f32(sc, lane, scv); ld_row_f32(sh, lane, shv);
#pragma unroll
    for (int j = 0; j < 4; ++j) h[j] = (x[j] * rs) * gv[j] * (scv[j] + 1.0f) + shv[j];
}
__device__ __forceinline__ void resid_update(f32x4 (&x)[4], const f32x4 (&y)[4], const float* g, const float* gt, int lane) {
    const float rs = row_rms_scale(y);
    f32x4 gv[4], gtv[4]; ld_row_f32(g, lane, gv); ld_row_f32(gt, lane, gtv);
#pragma unroll
    for (int j = 0; j < 4; ++j) x[j] = x[j] + gtv[j] * ((y[j] * rs) * gv[j]);
}
__device__ __forceinline__ const float* modv(const Frame& F, int l, int row, int part) {
    const int r = row < NTOK ? (row >> 11) : 32;
    return (const float*)(F.ws + WS_MODV) + ((size_t)l * 33 + r) * 6144 + part * 1024;
}

__device__ __forceinline__ void p0_prologue(Frame& F, const Args& a) {
    const int gw = F.vcu * NWAVES + F.wave, NGW = F.G * NWAVES;
    if (F.vcu < 192) {
        LAS float* sl = (LAS float*)F.lds;
        for (int i = F.tid; i < 33 * 1024; i += NTHREADS) { const int r = i >> 10, k = i & 1023; const float cv = r < 32 ? a.in[I_C][r * 1024 + k] : a.in[I_CCTX][k]; sl[k * 33 + r] = silu_f(cv); }
        __syncthreads();
        const int col = F.vcu * 64 + F.lane, l = col / 6144, n = col % 6144, k0 = F.wave * 128;
        const float* w = a.in[I_WMOD] + ((size_t)l * 1024 + k0) * 6144 + n;
        float acc[33];
#pragma unroll
        for (int r = 0; r < 33; ++r) acc[r] = 0.f;
#pragma unroll 4
        for (int k = 0; k < 128; ++k) { const float wv = w[(size_t)k * 6144]; const LAS float* sr = sl + (k0 + k) * 33;
#pragma unroll
            for (int r = 0; r < 33; ++r) acc[r] += sr[r] * wv; }
        __syncthreads();
#pragma unroll
        for (int r = 0; r < 33; ++r) sl[(F.wave * 33 + r) * 64 + F.lane] = acc[r];
        __syncthreads();
        const float* bmod = a.in[I_BMOD]; float* mo = (float*)(F.ws + WS_MODV);
        for (int o = F.tid; o < 33 * 64; o += NTHREADS) { const int r = o >> 6, j = o & 63; float s = 0.f;
#pragma unroll
            for (int wv = 0; wv < 8; ++wv) s += sl[(wv * 33 + r) * 64 + j];
            const int cc = F.vcu * 64 + j, ll = cc / 6144, nn = cc % 6144; mo[((size_t)ll * 33 + r) * 6144 + nn] = s + bmod[ll * 6144 + nn]; }
        __syncthreads();
    }
    if (F.vcu == 200) {
        float* rp = (float*)(F.ws + WS_ROPE);
        for (int i = F.tid; i < 1024; i += NTHREADS) { const int pos = i >> 4, k = i & 15; const float inv = powf(10000.0f, -(float)k / 16.0f); const float ang = (float)pos * inv; rp[i] = cosf(ang); rp[1024 + i] = sinf(ang); }
    }
    for (int it = F.vcu; it < 512; it += F.G) {
        const int lv = it >> 8, l = lv ? 0 : ((it >> 7) & 1), L = lv ? LC : SEQ, pos0 = lv ? (it & 255) : 16 * (it & 127), npos = lv ? 1 : 16;
        LAS float* z = (LAS float*)F.lds; LAS float* h1 = z + 16 * 33; LAS float* h2 = h1 + 16 * 64;
        __syncthreads();
        for (int i = F.tid; i < 16 * 33; i += NTHREADS) { const int p = i / 33, k = i % 33; const int pos = pos0 + p; float v;
            const float om = 6.283185307179586f * (float)pos / (float)L;
            if (k == 0) v = (float)pos / (float)(L - 1);
            else { const int m = (k - 1) & 15; const float f = 1e-4f + (15.0f - 1e-4f) * (float)m / 15.0f; v = (k <= 16) ? cosf(f * om) : -sinf(f * om); }
            z[i] = v; }
        __syncthreads();
        const float* w1 = a.in[I_HW1] + l * 33 * 64; const float* b1 = a.in[I_HB1] + l * 64; const float* w2 = a.in[I_HW2] + l * 64 * 64; const float* b2 = a.in[I_HB2] + l * 64;
        const float* fr = a.in[I_HFREQ] + l * 64; const float* w3 = a.in[I_HW3] + (size_t)l * 64 * 2048;
        for (int o = F.tid; o < 1024; o += NTHREADS) { const int p = o >> 6, j = o & 63; float s = b1[j];
            for (int k = 0; k < 33; ++k) s += z[p * 33 + k] * w1[k * 64 + j];
            h1[o] = sinf(fr[j] * s); }
        __syncthreads();
        for (int o = F.tid; o < 1024; o += NTHREADS) { const int p = o >> 6, j = o & 63; float s = b2[j];
            for (int k = 0; k < 64; ++k) s += h1[p * 64 + k] * w2[k * 64 + j];
            h2[o] = sinf(fr[j] * s); }
        __syncthreads();
        float* raw = (float*)(F.ws + BIG_RAW) + (size_t)l * (2048 * (SEQ + LC)) + (lv ? (size_t)2048 * SEQ : 0);
        {
            const int col0 = 4 * F.tid;
            float acc[4][16];
#pragma unroll
            for (int c4 = 0; c4 < 4; ++c4)
#pragma unroll
                for (int p = 0; p < 16; ++p) acc[c4][p] = 0.f;
#pragma unroll 4
            for (int k = 0; k < 64; ++k) { const f32x4 wv = *(const f32x4*)(w3 + k * 2048 + col0);
#pragma unroll
                for (int p = 0; p < 16; ++p) { const float hv = h2[p * 64 + k]; acc[0][p] += hv * wv.x; acc[1][p] += hv * wv.y; acc[2][p] += hv * wv.z; acc[3][p] += hv * wv.w; } }
            const float da = -3.0701134573253945f, db = -15.350567286626973f;
#pragma unroll
            for (int c4 = 0; c4 < 4; ++c4) { const int col = col0 + c4, cch = col & 511;
                const float delta = fabsf(da + (db - da) * (float)cch / 511.0f);
#pragma unroll
                for (int p = 0; p < 16; ++p) if (p < npos) { const float t = (float)(pos0 + p) / (float)(L - 1); raw[(size_t)col * L + pos0 + p] = acc[c4][p] * __expf(-t * delta); } }
        }
    }
    __syncthreads();
    LAS float* scr = (LAS float*)(F.lds + F.wave * 16384);
    constexpr int PER_LAYER = 16 * 216 + 16 * 48 + 3 * 256 + 512, NITEMS = 2 * PER_LAYER + 3 * 1408;
    for (int it = gw; it < NITEMS; it += NGW) {
        int r = it;
        bool dn = false;
#pragma unroll 1
        for (int l = 0; l < 2; ++l) {
            if (!dn) dn = conv_job_f8(r, a.in[I_WIN] + (size_t)l * D * INC, D, INC, F.ws + W_IN + (size_t)l * INC * D, D, 0, 0, W13_SCALE, scr, F.lane);
            if (!dn) { const int items = 16 * 48;
                if (r < items) { const int kb = r / 48, nb = r % 48; transpose_item(a.in[I_WIN] + (size_t)l * D * INC + QKVC, INC, (bf16*)(F.ws + W_CB) + (size_t)l * CINC * D, D, 64 * kb, 32 * nb, 32 * nb, scr, F.lane); dn = true; } else r -= items; }
#pragma unroll 1
            for (int br = 0; br < 3; ++br)
                if (!dn) dn = conv_job(r, a.in[I_WBR] + (size_t)(l * 3 + br) * 512 * D, 512, D, (bf16*)(F.ws + W_BR) + (size_t)(l * 3 + br) * D * 512, 512, 0, 0, 0, scr, F.lane);
            if (!dn) dn = conv_job(r, a.in[I_WOUT] + (size_t)l * D * D, D, D, (bf16*)(F.ws + W_OUT) + (size_t)l * D * D, D, 0, 0, 0, scr, F.lane);
        }
        if (!dn) dn = conv_job(r, a.in[I_FW1], D, DFF, (bf16*)(F.ws + W_F13), D, 0, 1, 0, scr, F.lane);
        if (!dn) dn = conv_job(r, a.in[I_FW3], D, DFF, (bf16*)(F.ws + W_F13), D, 0, 1, 1, scr, F.lane);
        if (!dn) dn = conv_job(r, a.in[I_FW2], DFF, D, (bf16*)(F.ws + W_F2), DFF, 0, 0, 0, scr, F.lane);
    }
}

__device__ __forceinline__ void p1_phase(Frame& F, const Args& a) {
    const int gw = F.vcu * NWAVES + F.wave, NGW = F.G * NWAVES;
    for (int u = gw; u < 2 * 2 * 1024; u += NGW) {
        const int l = u >> 11, lv = (u >> 10) & 1, o = (u >> 9) & 1, c = u & 511, L = lv ? LC : SEQ;
        if (l == 1 && lv == 1) continue;
        const float* raw = (const float*)(F.ws + BIG_RAW) + (size_t)l * (2048 * (SEQ + LC)) + (lv ? (size_t)2048 * SEQ : 0);
        const float* rf = raw + (size_t)(o * 512 + c) * L; const float* rb = raw + (size_t)(1024 + o * 512 + c) * L;
        float sf = 0.f, sb = 0.f;
        for (int t = F.lane; t < L; t += 64) { const float x = rf[t], y = rb[t]; sf += x * x; sb += y * y; }
        const float nf = 1.0f / sqrtf(wave_sum(sf) + EPS), nb = 1.0f / sqrtf(wave_sum(sb) + EPS);
        bf16* g = lv ? (bf16*)(F.ws + WS_GFC) + ((size_t)(l * 2 + o) * 512 + c) * (2 * LC) : (bf16*)(F.ws + WS_GF) + ((size_t)(l * 2 + o) * 512 + c) * (2 * SEQ);
        for (int i = F.lane; i < 2 * L; i += 64) { const int d = i - L; float v;
            if (i == 0) v = 0.f; else if (d > 0) v = rf[d] * nf; else if (d < 0) v = rb[-d] * nb; else v = rf[0] * nf + rb[0] * nb;
            g[i] = (bf16)f2bf(v); }
    }
}

constexpr float ATT_THR = 8.0f;
constexpr int ATT_KP = 144, ATT_VP = 136;
constexpr int ATT_K_OFF = 0, ATT_V_OFF = 64 * ATT_KP, ATT_BUF = 17920, ATT_RPB_OFF = 2 * ATT_BUF;
__device__ __forceinline__ int crow(int reg, int h) { return (reg & 3) + 8 * (reg >> 2) + 4 * h; }
__device__ __forceinline__ int rs_of(int r) { const int v = r - 4; return v < 0 ? 0 : (v > 24 ? 24 : v); }
__device__ __forceinline__ unsigned cvtpk(float lo, float hi) { return pk2(lo, hi); }

template <int MODE, int SUB>
__device__ __forceinline__ void att_tile(LAS unsigned char* lds, int boff, const bf16x8 (&qf)[4], f32x16& negm, f32x16& O0, f32x16& O1, float& m_run, float& l_run,
                                         bool is_local, bool edge_mask, int kbase, int qt, int kr, int gr, int qc, int my_cs, int r, int h) {
#define A0(i) (SUB != 2 || (i) >= 12)
#define A1(i) (SUB != 1 || (i) < 4)
    f32x16 s0 = negm, s1 = negm;
#pragma unroll
    for (int s = 0; s < 4; ++s) {
        const bf16x8 k0 = *(const LAS bf16x8*)(lds + boff + ATT_K_OFF + r * ATT_KP + (16 * s + 8 * h) * 2);
        const bf16x8 k1 = *(const LAS bf16x8*)(lds + boff + ATT_K_OFF + (32 + r) * ATT_KP + (16 * s + 8 * h) * 2);
        s0 = MFMA32(k0, qf[s], s0); s1 = MFMA32(k1, qf[s], s1);
    }
    if (MODE == 0 && edge_mask) {
#pragma unroll
        for (int i = 0; i < 16; ++i) { const int j0 = kbase + crow(i, h), d0 = qt - j0, d1 = d0 - 32;
            if (d0 > 128 || d0 < -128) s0[i] = -1e30f;
            if (d1 > 128 || d1 < -128) s1[i] = -1e30f; }
    }
    if (MODE == 1 && is_local) {
        const LAS float* tb = (const LAS float*)(lds + ATT_RPB_OFF) + (kr - gr + 7) * 32 + (4 * h - qc + 15);
        const int cb = 4 * h - my_cs;
#pragma unroll
        for (int i = 0; i < 16; ++i) { const int c = (i & 3) + 8 * (i >> 2);
            if (A0(i)) { const float b0 = tb[c]; s0[i] = ((unsigned)(cb + c) < 16u) ? s0[i] + b0 : -1e30f; }
            if (A1(i)) { const float b1 = tb[c + 32]; s1[i] = ((unsigned)(cb + c + 32) < 16u) ? s1[i] + b1 : -1e30f; } }
    }
    float mx = -1e30f;
#pragma unroll
    for (int i = 0; i < 16; ++i) { if (A0(i)) mx = fmaxf(mx, s0[i]); if (A1(i)) mx = fmaxf(mx, s1[i]); }
    mx = fmaxf(mx, __shfl_xor(mx, 32));
    if (!__all(mx <= ATT_THR)) {
        const float delta = fmaxf(mx, 0.f), alpha = __builtin_amdgcn_exp2f(-delta);
        m_run += delta; l_run *= alpha;
#pragma unroll
        for (int i = 0; i < 16; ++i) { O0[i] *= alpha; O1[i] *= alpha; s0[i] -= delta; s1[i] -= delta; negm[i] = -m_run; }
    }
    float ls = 0.f;
#pragma unroll
    for (int i = 0; i < 16; ++i) { if (A0(i)) { s0[i] = __builtin_amdgcn_exp2f(s0[i]); ls += s0[i]; } else s0[i] = 0.f;
                                   if (A1(i)) { s1[i] = __builtin_amdgcn_exp2f(s1[i]); ls += s1[i]; } else s1[i] = 0.f; }
    l_run += ls;
    bf16x8 pf[2][2];
    { v4u t;
      t.x = cvtpk(s0[0], s0[1]); t.y = cvtpk(s0[2], s0[3]); t.z = cvtpk(s0[4], s0[5]); t.w = cvtpk(s0[6], s0[7]); pf[0][0] = __builtin_bit_cast(bf16x8, t);
      t.x = cvtpk(s0[8], s0[9]); t.y = cvtpk(s0[10], s0[11]); t.z = cvtpk(s0[12], s0[13]); t.w = cvtpk(s0[14], s0[15]); pf[0][1] = __builtin_bit_cast(bf16x8, t);
      t.x = cvtpk(s1[0], s1[1]); t.y = cvtpk(s1[2], s1[3]); t.z = cvtpk(s1[4], s1[5]); t.w = cvtpk(s1[6], s1[7]); pf[1][0] = __builtin_bit_cast(bf16x8, t);
      t.x = cvtpk(s1[8], s1[9]); t.y = cvtpk(s1[10], s1[11]); t.z = cvtpk(s1[12], s1[13]); t.w = cvtpk(s1[14], s1[15]); pf[1][1] = __builtin_bit_cast(bf16x8, t); }
#pragma unroll
    for (int i = 0; i < 2; ++i)
#pragma unroll
        for (int sp = 0; sp < 2; ++sp) {
            if ((SUB == 1 && i == 1 && sp == 1) || (SUB == 2 && i == 0 && sp == 0)) continue;
            const int koff = (32 * i + 16 * sp + 4 * h) * 2;
            const v2u a0 = *(const LAS v2u*)(lds + boff + ATT_V_OFF + r * ATT_VP + koff), a1 = *(const LAS v2u*)(lds + boff + ATT_V_OFF + r * ATT_VP + koff + 16);
            const v2u c0 = *(const LAS v2u*)(lds + boff + ATT_V_OFF + (32 + r) * ATT_VP + koff), c1 = *(const LAS v2u*)(lds + boff + ATT_V_OFF + (32 + r) * ATT_VP + koff + 16);
            const v4u va = (v4u){a0.x, a0.y, a1.x, a1.y}, vc = (v4u){c0.x, c0.y, c1.x, c1.y};
            O0 = MFMA32(__builtin_bit_cast(bf16x8, va), pf[i][sp], O0);
            O1 = MFMA32(__builtin_bit_cast(bf16x8, vc), pf[i][sp], O1);
        }
#undef A0
#undef A1
}

struct AttPre { v4u k, v; int valid; };
template <int MODE>
__device__ __forceinline__ void att_start(int u, int w, int r, int& qrow, int& qcol, int& kcol, int& vcol, int& trow0) {
    int b, head, kvh, q0 = 0, R = 0;
    if (MODE == 0) { b = u >> 6; kvh = (u >> 5) & 1; q0 = (u & 31) * 64; head = 4 * kvh + (w >> 1); }
    else if (MODE == 1) { b = u >> 6; head = (u >> 3) & 7; kvh = head; R = u & 7; }
    else if (MODE == 2) { b = u >> 3; kvh = (u >> 2) & 1; q0 = (u & 3) * 64; head = 4 * kvh + (w >> 1); }
    else { b = u >> 3; head = u & 7; kvh = head; }
    if (MODE == 0) qrow = b * SEQ + q0 + 32 * (w & 1) + r;
    else if (MODE == 1) qrow = b * SEQ + (4 * R + (w >> 1)) * 64 + 32 * (w & 1) + r;
    else if (MODE == 2) qrow = NTOK + b * LC + q0 + 32 * (w & 1) + r;
    else qrow = NTOK + b * LC + 32 * w + r;
    qcol = (MODE == 0 || MODE == 2) ? 1280 + head * 64 : 1792 + head * 64;
    kcol = (MODE == 0 || MODE == 2) ? kvh * 64 : 256 + head * 64;
    vcol = (MODE == 0 || MODE == 2) ? 128 + kvh * 64 : 768 + head * 64;
    if (MODE == 0) { const int lo = q0 < 128 ? (128 - q0) / 64 : 0; trow0 = b * SEQ + q0 - 128 + 64 * lo; }
    else if (MODE == 1) trow0 = b * SEQ + rs_of(4 * R) * 64;
    else trow0 = NTOK + b * LC;
}
template <int MODE>
__device__ __forceinline__ void attn_unit(Frame& F, int u, int u_next, const bf16* __restrict__ QKV, bf16* __restrict__ Yo, const float* sink, const float* rpb, AttPre& P) {
    const int w = F.wave, lane = F.lane, r = lane & 31, h = lane >> 5;
    LAS unsigned char* lds = F.lds;
    int b, head, kvh, q0 = 0, R = 0;
    if (MODE == 0) { b = u >> 6; kvh = (u >> 5) & 1; q0 = (u & 31) * 64; head = 4 * kvh + (w >> 1); }
    else if (MODE == 1) { b = u >> 6; head = (u >> 3) & 7; kvh = head; R = u & 7; }
    else if (MODE == 2) { b = u >> 3; kvh = (u >> 2) & 1; q0 = (u & 3) * 64; head = 4 * kvh + (w >> 1); }
    else { b = u >> 3; head = u & 7; kvh = head; }
    int qt, qrow, gr = 0, qc = 0;
    if (MODE == 0) { qt = q0 + 32 * (w & 1) + r; qrow = b * SEQ + qt; }
    else if (MODE == 1) { gr = 4 * R + (w >> 1); qc = 32 * (w & 1) + r; qt = gr * 64 + qc; qrow = b * SEQ + qt; }
    else if (MODE == 2) { qt = q0 + 32 * (w & 1) + r; qrow = NTOK + b * LC + qt; }
    else { qt = 32 * w + r; qrow = NTOK + b * LC + qt; }
    const int qcol = (MODE == 0 || MODE == 2) ? 1280 + head * 64 : 1792 + head * 64;
    const int kcol = (MODE == 0 || MODE == 2) ? kvh * 64 : 256 + head * 64;
    const int vcol = (MODE == 0 || MODE == 2) ? 128 + kvh * 64 : 768 + head * 64;
    bf16x8 qf[4];
#pragma unroll
    for (int s = 0; s < 4; ++s) qf[s] = *(const bf16x8*)(QKV + (size_t)qrow * QKVC + qcol + 16 * s + 8 * h);
    f32x16 O0, O1;
#pragma unroll
    for (int i = 0; i < 16; ++i) { O0[i] = 0.f; O1[i] = 0.f; }
    float m_run, l_run;
    if (MODE == 0 || MODE == 2) { m_run = sink[head] * LOG2E; l_run = (h == 0) ? 1.0f : 0.0f; } else { m_run = 0.f; l_run = 0.f; }
    f32x16 negm;
#pragma unroll
    for (int i = 0; i < 16; ++i) negm[i] = -m_run;
    int lo = 0, ntl = 0, kr_lo = 0;
    if (MODE == 0) { lo = q0 < 128 ? (128 - q0) / 64 : 0; const int hi = (SEQ - q0 + 128) / 64 < 5 ? (SEQ - q0 + 128) / 64 : 5; ntl = hi - lo; }
    if (MODE == 1) { kr_lo = rs_of(4 * R); ntl = rs_of(4 * R + 3) + 8 - kr_lo; }
    const int my_rs = rs_of(gr), my_cs = (qc - 8) < 0 ? 0 : ((qc - 8) > 48 ? 48 : (qc - 8));
    const int ntiles = ntl + 4;
    const int skey = F.tid >> 3, sch = F.tid & 7, vkey = F.tid & 63, vch = F.tid >> 6;
#define ATT_TROW(tt) ((tt) < ntl ? (MODE == 0 ? b * SEQ + q0 - 128 + 64 * (lo + (tt)) : b * SEQ + (kr_lo + (tt)) * 64) : NTOK + b * LC + 64 * ((tt) - ntl))
#define ATT_LOAD(tt) do { const int tr_ = ATT_TROW(tt); kreg = *(const v4u*)(QKV + (size_t)(tr_ + skey) * QKVC + kcol + 8 * sch); vreg = *(const v4u*)(QKV + (size_t)(tr_ + vkey) * QKVC + vcol + 8 * vch); } while (0)
#define ATT_STORE(bufoff) do { *(LAS v4u*)(lds + (bufoff) + ATT_K_OFF + skey * ATT_KP + sch * 16) = kreg; \
        LAS unsigned short* vt_ = (LAS unsigned short*)(lds + (bufoff) + ATT_V_OFF + (8 * vch) * ATT_VP + vkey * 2); \
        vt_[0 * (ATT_VP / 2)] = (unsigned short)(vreg.x & 0xffff); vt_[1 * (ATT_VP / 2)] = (unsigned short)(vreg.x >> 16); vt_[2 * (ATT_VP / 2)] = (unsigned short)(vreg.y & 0xffff); vt_[3 * (ATT_VP / 2)] = (unsigned short)(vreg.y >> 16); \
        vt_[4 * (ATT_VP / 2)] = (unsigned short)(vreg.z & 0xffff); vt_[5 * (ATT_VP / 2)] = (unsigned short)(vreg.z >> 16); vt_[6 * (ATT_VP / 2)] = (unsigned short)(vreg.w & 0xffff); vt_[7 * (ATT_VP / 2)] = (unsigned short)(vreg.w >> 16); } while (0)
    v4u& kreg = P.k; v4u& vreg = P.v;
    if (!P.valid) ATT_LOAD(0);
    P.valid = 0;
    __syncthreads();
    if (MODE == 1) {
        LAS float* tb = (LAS float*)(lds + ATT_RPB_OFF);
        if (F.tid < 15 * 32) { const int dr = F.tid >> 5, dc = F.tid & 31; tb[F.tid] = dc < 31 ? rpb[(head * 15 + dr) * 31 + dc] * LOG2E : 0.f; }
    }
    ATT_STORE(0);
    __syncthreads();
#pragma unroll 1
    for (int tt = 0; tt < ntiles; ++tt) {
        const bool is_local = tt < ntl;
        const int kbase = q0 - 128 + 64 * (lo + tt), kr = kr_lo + tt;
        const int boff = (tt & 1) * ATT_BUF;
        if (tt + 1 < ntiles) ATT_LOAD(tt + 1);
        else if (u_next >= 0) {
            int nq, nqc, nkc, nvc, ntr; att_start<MODE>(u_next, w, r, nq, nqc, nkc, nvc, ntr);
            kreg = *(const v4u*)(QKV + (size_t)(ntr + skey) * QKVC + nkc + 8 * sch); vreg = *(const v4u*)(QKV + (size_t)(ntr + vkey) * QKVC + nvc + 8 * vch);
            P.valid = 1;
        }
        if (!(MODE == 1 && is_local && !(kr >= my_rs && kr < my_rs + 8))) {
            att_tile<MODE, 0>(lds, boff, qf, negm, O0, O1, m_run, l_run, is_local, MODE == 0 && is_local && (lo + tt == 0 || lo + tt == 4), kbase, qt, kr, gr, qc, my_cs, r, h);
        }
        if (tt + 1 < ntiles) ATT_STORE(((tt + 1) & 1) * ATT_BUF);
        __syncthreads();
    }
#undef ATT_TROW
#undef ATT_LOAD
#undef ATT_STORE
    const float lt = l_run + __shfl_xor(l_run, 32), inv = 1.0f / lt;
    LAS unsigned char* ot = lds + w * 4608;
#pragma unroll
    for (int g = 0; g < 4; ++g) {
        v2u o; o.x = cvtpk(O0[4 * g] * inv, O0[4 * g + 1] * inv); o.y = cvtpk(O0[4 * g + 2] * inv, O0[4 * g + 3] * inv);
        *(LAS v2u*)(ot + r * 144 + (8 * g + 4 * h) * 2) = o;
        o.x = cvtpk(O1[4 * g] * inv, O1[4 * g + 1] * inv); o.y = cvtpk(O1[4 * g + 2] * inv, O1[4 * g + 3] * inv);
        *(LAS v2u*)(ot + r * 144 + (32 + 8 * g + 4 * h) * 2) = o;
    }
    LDS_WAIT(); asm volatile("" ::: "memory");
    bf16* op = Yo + (size_t)(qrow - r) * 512 + head * 64;
#pragma unroll
    for (int k = 0; k < 4; ++k) { const int p = lane + 64 * k, row = p >> 3, chk = p & 7;
        *(GAS v4u*)(op + (size_t)row * 512 + 8 * chk) = *(const LAS v4u*)(ot + row * 144 + chk * 16); }
    LDS_WAIT(); asm volatile("" ::: "memory");
}

template <int N>
__device__ __forceinline__ void conv_taps(const bf16* src, int t, int L, float w0, float w1, float w2, float bs, float (&out)[N]) {
    float x[N + 2];
    if constexpr (N == 8) { const v4u q = *(const v4u*)(src + t); x[1] = pg8::bf_lo(q.x); x[2] = pg8::bf_hi(q.x); x[3] = pg8::bf_lo(q.y); x[4] = pg8::bf_hi(q.y); x[5] = pg8::bf_lo(q.z); x[6] = pg8::bf_hi(q.z); x[7] = pg8::bf_lo(q.w); x[8] = pg8::bf_hi(q.w); }
    else { const v2u q = *(const v2u*)(src + t); x[1] = pg8::bf_lo(q.x); x[2] = pg8::bf_hi(q.x); x[3] = pg8::bf_lo(q.y); x[4] = pg8::bf_hi(q.y); }
    x[0] = t > 0 ? bf2f(src[t - 1]) : 0.f;
    x[N + 1] = (t + N < L) ? bf2f(src[t + N]) : 0.f;
#pragma unroll
    for (int e = 0; e < N; ++e) out[e] = w0 * x[e] + w1 * x[e + 1] + w2 * x[e + 2] + bs;
}

template <int L, int VAR = 0>
__device__ __forceinline__ void hyena_unit(Frame& F, int c, const bf16* CINT, bf16* DST, const bf16* Gf, const float* convw, const float* convb, const float* hybias) {
    constexpr int UP = (L + 8) * 2, TPW = L / 256, CPB = L / 8;
    LAS unsigned char* U = F.lds; LAS unsigned short* Gs = (LAS unsigned short*)(F.lds + 32 * UP);
    const int lane = F.lane, r = lane & 31, h = lane >> 5, T0 = F.wave * TPW * 32;
    const bf16* vsrc = CINT + (size_t)c * NROW + (L == SEQ ? 0 : NTOK);
    bf16* ydst = DST + (size_t)c * NROW + (L == SEQ ? 0 : NTOK);
    __syncthreads();
    if (!(VAR & 8)) {
        const float w0 = convw[c], w1 = convw[CINC + c], w2 = convw[2 * CINC + c], bs = convb[c];
        static_assert(CPB % 32 == 0, "a wave's 64 lanes hold consecutive chunks of at most two rows, split at lane 32");
#pragma unroll 4
        for (int q = F.tid; q < 32 * CPB; q += NTHREADS) { const int b = q / CPB, t = (q % CPB) * 8;
            const bf16* src = vsrc + (size_t)b * L;
            const v4u ch = *(const v4u*)(src + t);
            float x[10];
            x[1] = pg8::bf_lo(ch.x); x[2] = pg8::bf_hi(ch.x); x[3] = pg8::bf_lo(ch.y); x[4] = pg8::bf_hi(ch.y); x[5] = pg8::bf_lo(ch.z); x[6] = pg8::bf_hi(ch.z); x[7] = pg8::bf_lo(ch.w); x[8] = pg8::bf_hi(ch.w);
            const float up = __shfl_up(x[8], 1), dn = __shfl_down(x[1], 1);
            const int lr = lane & 31;
            x[0] = (lr == 0) ? (t > 0 ? bf2f(src[t - 1]) : 0.f) : up;
            x[9] = (lr == 31) ? (t + 8 < L ? bf2f(src[t + 8]) : 0.f) : dn;
            float o[8];
#pragma unroll
            for (int e = 0; e < 8; ++e) o[e] = w0 * x[e] + w1 * x[e + 1] + w2 * x[e + 2] + bs;
            v4u pk; pk.x = pk2(o[0], o[1]); pk.y = pk2(o[2], o[3]); pk.z = pk2(o[4], o[5]); pk.w = pk2(o[6], o[7]);
            *(LAS v4u*)(U + b * UP + t * 2) = pk; }
    }
#pragma unroll 1
    for (int ord = 0; ord < 2; ++ord) {
        {
            const v4u* gsrc = (const v4u*)(Gf + ((size_t)ord * 512 + c) * (2 * L));
            for (int q = F.tid; q < L / 4; q += NTHREADS) *(LAS v4u*)((LAS unsigned char*)Gs + q * 16) = gsrc[q];
        }
        __syncthreads();
        f32x16 acc[TPW];
#pragma unroll
        for (int i = 0; i < TPW; ++i)
#pragma unroll
            for (int e = 0; e < 16; ++e) acc[i][e] = 0.f;
        const int gbase = T0 + r - 8 * h + L;
#define HY_AF(dst, sgi, ti) do { const int gi_ = gbase + 32 * (ti) - 16 * (sgi); _Pragma("unroll") for (int j_ = 0; j_ < 8; ++j_) dst[j_] = (short)Gs[gi_ - j_]; } while (0)
#define HY_BF(sgi) (*(const LAS bf16x8*)(U + r * UP + (16 * (sgi) + 8 * h) * 2))
        if constexpr (TPW == 8 && !(VAR & 2)) {
            constexpr int NS = L / 16;
#pragma unroll 1
            for (int p = 0; p < 2; ++p) {
                bf16x8 W[8];
#pragma unroll
                for (int i = 1; i < 8; ++i) HY_AF(W[i], p, i);
                bf16x8 nf, nb; HY_AF(nf, p, 0); nb = HY_BF(p);
#pragma unroll 1
                for (int sb = p; sb < NS; sb += 16) {
#pragma unroll
                    for (int k = 0; k < 8; ++k) {
                        const int sg = sb + 2 * k; const bf16x8 cb = nb; W[(8 - k) & 7] = nf;
                        const int sn = sg + 2 < NS ? sg + 2 : sg;
                        HY_AF(nf, sn, 0); nb = HY_BF(sn);
#pragma unroll
                        for (int i = 0; i < 8; ++i) acc[i] = MFMA32(W[(i - k) & 7], cb, acc[i]);
                    }
                }
            }
        } else if constexpr (!(VAR & 2)) {
#pragma unroll 1
            for (int sg = 0; sg < L / 16; ++sg) { bf16x8 af; HY_AF(af, sg, 0); acc[0] = MFMA32(af, HY_BF(sg), acc[0]); }
        }
#undef HY_AF
#undef HY_BF
        const int comp = 1 + ord;
        const float w0 = convw[comp * 512 + c], w1 = convw[CINC + comp * 512 + c], w2 = convw[2 * CINC + comp * 512 + c], bs = convb[comp * 512 + c], hb = hybias[ord * 512 + c];
        const bf16* gsrc = CINT + ((size_t)comp * 512 + c) * NROW + (L == SEQ ? 0 : NTOK) + (size_t)r * L;
        __syncthreads();
        {
            constexpr int NCH = TPW * 4, BS = NCH < 8 ? NCH : 8;
#pragma unroll
            for (int bt = 0; bt < NCH / BS; ++bt) {
                const int tb = T0 + 8 * BS * bt;
                v4u ch[BS];
#pragma unroll
                for (int k = 0; k < BS; ++k) { if constexpr (VAR & 4) ch[k] = (v4u){0u, 0u, 0u, 0u}; else ch[k] = *(const v4u*)(gsrc + tb + 8 * k); }
                float xl = 0.f, xr = 0.f;
                if constexpr (!(VAR & 4)) { if (tb > 0) xl = bf2f(gsrc[tb - 1]); if (tb + 8 * BS < L) xr = bf2f(gsrc[tb + 8 * BS]); }
#pragma unroll
                for (int k = 0; k < BS; ++k) {
                    const int kk = BS * bt + k, i = kk >> 2, g = kk & 3, t = T0 + 32 * i + 8 * g + 4 * h;
                    float xs[10];
                    xs[0] = k == 0 ? xl : pg8::bf_hi(ch[k > 0 ? k - 1 : 0].w);
                    xs[1] = pg8::bf_lo(ch[k].x); xs[2] = pg8::bf_hi(ch[k].x); xs[3] = pg8::bf_lo(ch[k].y); xs[4] = pg8::bf_hi(ch[k].y); xs[5] = pg8::bf_lo(ch[k].z); xs[6] = pg8::bf_hi(ch[k].z); xs[7] = pg8::bf_lo(ch[k].w); xs[8] = pg8::bf_hi(ch[k].w);
                    xs[9] = k == BS - 1 ? xr : pg8::bf_lo(ch[k < BS - 1 ? k + 1 : k].x);
                    float gt[4];
#pragma unroll
                    for (int e2 = 0; e2 < 4; ++e2) { const float lo = w0 * xs[e2] + w1 * xs[e2 + 1] + w2 * xs[e2 + 2] + bs, hi = w0 * xs[e2 + 4] + w1 * xs[e2 + 5] + w2 * xs[e2 + 6] + bs; gt[e2] = h ? hi : lo; }
                    LAS v2u* up = (LAS v2u*)(U + r * UP + t * 2);
                    const v2u uu = *up;
                    const float u0 = pg8::bf_lo(uu.x), u1 = pg8::bf_hi(uu.x), u2 = pg8::bf_lo(uu.y), u3 = pg8::bf_hi(uu.y);
                    const float z0 = gt[0] * (acc[i][4 * g] + hb * u0), z1 = gt[1] * (acc[i][4 * g + 1] + hb * u1), z2 = gt[2] * (acc[i][4 * g + 2] + hb * u2), z3 = gt[3] * (acc[i][4 * g + 3] + hb * u3);
                    v2u zz; zz.x = pk2(z0, z1); zz.y = pk2(z2, z3);
                    *up = zz;
                }
                asm volatile("" ::: "memory");
            }
        }
        __syncthreads();
    }
    if (!(VAR & 1)) for (int q = F.tid; q < 32 * CPB; q += NTHREADS) { const int b = q / CPB, t = (q % CPB) * 8; *(GAS v4u*)(ydst + (size_t)b * L + t) = *(const LAS v4u*)(U + b * UP + t * 2); }
}

__device__ __forceinline__ void transpose_yc(Frame& F, const bf16* CT, bf16* Yc, int nrows) {
    const int gw = F.vcu * NWAVES + F.wave, NGW = F.G * NWAVES, lane = F.lane;
    LAS unsigned short* T = (LAS unsigned short*)(F.lds + F.wave * 16384);
    const int ntr = nrows / 64;
    for (int it = gw; it < 8 * ntr; it += NGW) {
        const int cb = it / ntr, rb = it % ntr, c0 = cb * 64, r0 = rb * 64;
#pragma unroll
        for (int k = 0; k < 8; ++k) { const int p = lane + 64 * k, cc = p >> 3, ch = p & 7;
            const v4u q = *(const v4u*)(CT + (size_t)(c0 + cc) * NROW + r0 + 8 * ch);
            LAS unsigned* d = (LAS unsigned*)(T + cc * 66 + 8 * ch); d[0] = q.x; d[1] = q.y; d[2] = q.z; d[3] = q.w; }
        LDS_WAIT(); asm volatile("" ::: "memory");
#pragma unroll
        for (int k = 0; k < 8; ++k) { const int p = lane + 64 * k, rr = p >> 3, ch = p & 7;
            unsigned short e[8];
#pragma unroll
            for (int j = 0; j < 8; ++j) e[j] = T[(8 * ch + j) * 66 + rr];
            v4u o; o.x = e[0] | ((unsigned)e[1] << 16); o.y = e[2] | ((unsigned)e[3] << 16); o.z = e[4] | ((unsigned)e[5] << 16); o.w = e[6] | ((unsigned)e[7] << 16);
            *(GAS v4u*)(Yc + (size_t)(r0 + rr) * 512 + c0 + 8 * ch) = o; }
        LDS_WAIT(); asm volatile("" ::: "memory");
    }
}

struct RowVecs { f32x4 gA[4], gt[4], gB[4], sc1[4], sh[4]; };
__device__ __forceinline__ float ssq16(const f32x4 (&v)[4]) { float s = 0.f;
#pragma unroll
    for (int j = 0; j < 4; ++j) s += (v[j].x * v[j].x + v[j].y * v[j].y) + (v[j].z * v[j].z + v[j].w * v[j].w);
    return s; }
__device__ __forceinline__ void ld_mod(const Frame& F, int l, int b, int part, int lane, f32x4 (&v)[4], float add) {
    ld_row_f32((const float*)(F.ws + WS_MODV) + ((size_t)l * 33 + b) * 6144 + part * 1024, lane, v);
#pragma unroll
    for (int j = 0; j < 4; ++j) v[j] = v[j] + add;
}
__device__ __forceinline__ void row_pair(const RowVecs& V, const f32x4 (&y0)[4], const f32x4 (&y1)[4], f32x4 (&x0)[4], f32x4 (&x1)[4], bool has_y, bool has_next, f32x4 (&h0)[4], f32x4 (&h1)[4]) {
    if (has_y) {
        float a0 = ssq16(y0), a1 = ssq16(y1);
#pragma unroll
        for (int o = 1; o < 64; o <<= 1) { a0 += __shfl_xor(a0, o); a1 += __shfl_xor(a1, o); }
        const float r0 = __builtin_amdgcn_rsqf(a0 * (1.0f / D) + EPS), r1 = __builtin_amdgcn_rsqf(a1 * (1.0f / D) + EPS);
#pragma unroll
        for (int j = 0; j < 4; ++j) { x0[j] = x0[j] + V.gt[j] * ((y0[j] * r0) * V.gA[j]); x1[j] = x1[j] + V.gt[j] * ((y1[j] * r1) * V.gA[j]); }
    }
    if (has_next) {
        float a0 = ssq16(x0), a1 = ssq16(x1);
#pragma unroll
        for (int o = 1; o < 64; o <<= 1) { a0 += __shfl_xor(a0, o); a1 += __shfl_xor(a1, o); }
        const float r0 = __builtin_amdgcn_rsqf(a0 * (1.0f / D) + EPS), r1 = __builtin_amdgcn_rsqf(a1 * (1.0f / D) + EPS);
#pragma unroll
        for (int j = 0; j < 4; ++j) { h0[j] = (x0[j] * r0) * V.gB[j] * V.sc1[j] + V.sh[j]; h1[j] = (x1[j] * r1) * V.gB[j] * V.sc1[j] + V.sh[j]; }
    }
}
__device__ __forceinline__ const float* x_src_ptr(const Args& a, Frame& F, int l, int sub, int row) {
    if (row < NTOK) return (l == 0 && sub == 0) ? a.in[I_X] + (size_t)row * D : a.out + (size_t)row * D;
    return (l == 0 && sub == 0) ? a.in[I_CTX] + (size_t)(row - NTOK) * D : (const float*)(F.ws + WS_CTXRES) + (size_t)(row - NTOK) * D;
}
__device__ __forceinline__ float* x_dst_ptr(const Args& a, Frame& F, int row) {
    return row < NTOK ? a.out + (size_t)row * D : (float*)(F.ws + WS_CTXRES) + (size_t)(row - NTOK) * D;
}

__device__ __forceinline__ void rows_phase(Frame& F, const Args& a, int mode, int l, int sub, const bf16* Y, int nrows) {
    const int gw = F.vcu * NWAVES + F.wave, NGW = F.G * NWAVES;
    const int R = (((nrows + NGW - 1) / NGW) + 1) & ~1, r0 = gw * R, r1 = (r0 + R) < nrows ? (r0 + R) : nrows;
    const bool has_y = mode == 1, has_next = (mode == 0) || !(l == 1 && sub == 1);
    const int ln = (mode == 0) ? 0 : (sub == 0 ? l : l + 1);
    const bool next_is_ffn = (mode == 1 && sub == 0);
    RowVecs V;
    if (has_y) ld_row_f32(a.in[sub == 0 ? I_GMIXPOST : I_GFFNPOST] + l * D, F.lane, V.gA);
    if (has_next) ld_row_f32(a.in[next_is_ffn ? I_GFFNPRE : I_GMIXPRE] + ln * D, F.lane, V.gB);
    int bcur = -2;
    bf16* const Hb = (bf16*)(F.ws + WS_H);
#pragma unroll 1
    for (int row = r0; row < r1; row += 2) {
        const int b = row < NTOK ? (row >> 11) : 32;
        if (b != bcur) { bcur = b;
            if (has_y) ld_mod(F, l, b, sub == 0 ? 2 : 5, F.lane, V.gt, 0.f);
            if (has_next) { ld_mod(F, ln, b, next_is_ffn ? 4 : 1, F.lane, V.sc1, 1.0f); ld_mod(F, ln, b, next_is_ffn ? 3 : 0, F.lane, V.sh, 0.f); } }
        f32x4 y0[4], y1[4], x0[4], x1[4], h0[4], h1[4];
        const float* xs = mode == 0 ? (row < NTOK ? a.in[I_X] + (size_t)row * D : a.in[I_CTX] + (size_t)(row - NTOK) * D) : x_src_ptr(a, F, l, sub, row);
        if (has_y) { ld_row_bf16(Y + (size_t)row * D, F.lane, y0); ld_row_bf16(Y + (size_t)(row + 1) * D, F.lane, y1); }
        ld_row_f32(xs, F.lane, x0); ld_row_f32(xs + D, F.lane, x1);
        row_pair(V, y0, y1, x0, x1, has_y, has_next, h0, h1);
        if (has_y) { float* xd = x_dst_ptr(a, F, row); st_row_f32(xd, F.lane, x0); st_row_f32(xd + D, F.lane, x1); }
        if (has_next) { st_row_bf16(Hb + (size_t)row * D, F.lane, h0); st_row_bf16(Hb + (size_t)(row + 1) * D, F.lane, h1);
            if (!next_is_ffn) { GAS unsigned* q = (GAS unsigned*)(F.ws + WS_H8 + (size_t)row * D) + F.lane;
#pragma unroll
                for (int j = 0; j < 4; ++j) { q[64 * j] = pg8::pack_fp8x4(h0[j].x, h0[j].y, h0[j].z, h0[j].w); q[256 + 64 * j] = pg8::pack_fp8x4(h1[j].x, h1[j].y, h1[j].z, h1[j].w); } } }
    }
}

__device__ __forceinline__ void route_row(const f32x4 (&h)[4], const LAS float* rl, int lane, int& e0, int& e1, float& w0, float& w1) {
    float lg[8];
#pragma unroll
    for (int e = 0; e < 8; ++e) lg[e] = 0.f;
#pragma unroll
    for (int j = 0; j < 4; ++j)
#pragma unroll
        for (int i = 0; i < 4; ++i) { const LAS f32x4* rp = (const LAS f32x4*)(rl + ((j * 4 + i) * 64 + lane) * 8); const f32x4 q0 = rp[0], q1 = rp[1]; const float hv = h[j][i];
            lg[0] += hv * q0.x; lg[1] += hv * q0.y; lg[2] += hv * q0.z; lg[3] += hv * q0.w; lg[4] += hv * q1.x; lg[5] += hv * q1.y; lg[6] += hv * q1.z; lg[7] += hv * q1.w; }
#pragma unroll
    for (int o = 1; o < 64; o <<= 1)
#pragma unroll
        for (int e = 0; e < 8; ++e) lg[e] += __shfl_xor(lg[e], o);
    e0 = 0; float v0 = lg[0];
#pragma unroll
    for (int e = 1; e < 8; ++e) if (lg[e] > v0) { v0 = lg[e]; e0 = e; }
    e1 = -1; float v1 = -3.0e38f;
#pragma unroll
    for (int e = 0; e < 8; ++e) if (e != e0 && lg[e] > v1) { v1 = lg[e]; e1 = e; }
    w0 = 1.0f / (1.0f + __expf(v1 - v0)); w1 = 1.0f - w0;
}
__device__ __forceinline__ void post_route_phase(Frame& F, const Args& a, const bf16* Y) {
    LAS int* se = (LAS int*)F.lds;
    LAS int* sbase = se + 512;
    LAS float* rl = (LAS float*)(F.lds + 4096);
    const int l = 1;
    __syncthreads();
    for (int i = F.tid; i < 1024 * 8; i += NTHREADS) { const int k = i >> 3, e = i & 7, jj = k >> 8, ln = (k & 255) >> 2, ii = k & 3; rl[((jj * 4 + ii) * 64 + ln) * 8 + e] = a.in[I_ROUTER][i]; }
    __syncthreads();
    RowVecs V;
    ld_row_f32(a.in[I_GMIXPOST] + l * D, F.lane, V.gA); ld_row_f32(a.in[I_GFFNPRE] + l * D, F.lane, V.gB);
    bf16* const Hb = (bf16*)(F.ws + WS_H);
    for (int blk = F.vcu; blk < NTOK / 256; blk += F.G) {
        const int b = blk >> 3;
        ld_mod(F, l, b, 2, F.lane, V.gt, 0.f); ld_mod(F, l, b, 4, F.lane, V.sc1, 1.0f); ld_mod(F, l, b, 3, F.lane, V.sh, 0.f);
#pragma unroll 1
        for (int k = 0; k < 32; ++k) {
            const int lr = F.wave * 32 + k, row = blk * 256 + lr;
            f32x4 y0[4], x0[4], h0[4];
            ld_row_bf16(Y + (size_t)row * D, F.lane, y0);
            float* xp = a.out + (size_t)row * D; ld_row_f32(xp, F.lane, x0);
            { const float r0 = __builtin_amdgcn_rsqf(wave_sum(ssq16(y0)) * (1.0f / D) + EPS);
#pragma unroll
              for (int j = 0; j < 4; ++j) x0[j] = x0[j] + V.gt[j] * ((y0[j] * r0) * V.gA[j]); }
            st_row_f32(xp, F.lane, x0);
            { const float r0 = __builtin_amdgcn_rsqf(wave_sum(ssq16(x0)) * (1.0f / D) + EPS);
#pragma unroll
              for (int j = 0; j < 4; ++j) h0[j] = (x0[j] * r0) * V.gB[j] * V.sc1[j] + V.sh[j]; }
            st_row_bf16(Hb + (size_t)row * D, F.lane, h0);
            int e0, e1; float w0, w1;
            route_row(h0, rl, F.lane, e0, e1, w0, w1);
            if (F.lane == 0) { se[2 * lr] = e0; se[2 * lr + 1] = e1;
                int4 rr; rr.x = e0; rr.y = e1; rr.z = __builtin_bit_cast(int, w0); rr.w = __builtin_bit_cast(int, w1); ((int4*)(F.ws + WS_ROUTE))[row] = rr; }
        }
        __syncthreads();
        const int half = blk >> 7;
        if (F.tid < 8) { int n = 0; for (int i = 0; i < 512; ++i) n += (se[i] == F.tid) ? 1 : 0;
            sbase[F.tid] = (int)__hip_atomic_fetch_add((unsigned*)(F.ws + WS_CTL) + CW_CNT + half * 8 + F.tid, (unsigned)n, __ATOMIC_RELAXED, __HIP_MEMORY_SCOPE_AGENT); }
        __syncthreads();
        if (F.tid < 8) { int p = sbase[F.tid]; int* lst = (int*)(F.ws + WS_LIST) + ((size_t)half * 8 + F.tid) * 32768;
            for (int i = 0; i < 512; ++i) if (se[i] == F.tid) lst[p++] = ((blk * 256 + (i >> 1)) << 1) | (i & 1); }
        __syncthreads();
    }
}

__device__ __forceinline__ void moe_offsets(Frame& F, int half, int (&toff)[9], int (&cnt)[8]) {
    const unsigned* cw = (const unsigned*)(F.ws + WS_CTL) + CW_CNT + half * 8;
    toff[0] = 0;
#pragma unroll
    for (int e = 0; e < 8; ++e) { cnt[e] = __builtin_amdgcn_readfirstlane((int)__hip_atomic_load(cw + e, __ATOMIC_RELAXED, __HIP_MEMORY_SCOPE_AGENT)); toff[e + 1] = toff[e] + (cnt[e] + 255) / 256; }
}
__device__ __forceinline__ void moe_gather_phase(Frame& F, int half, int skip_first = 0) {
    if (skip_first < 0 || skip_first >= F.G) skip_first = 0;
    const int bxw = (int)blockIdx.x - skip_first; if (bxw < 0) return;
    const int gw = bxw * NWAVES + F.wave, NGW = (F.G - skip_first) * NWAVES;
    int toff[9], cnt[8]; moe_offsets(F, half, toff, cnt);
    const int P = toff[8] * 256;
    for (int p = gw; p < P; p += NGW) {
        const int tile = p >> 8; int e = 0;
#pragma unroll
        for (int k = 1; k < 8; ++k) e += (tile >= toff[k]) ? 1 : 0;
        const int idx = p - toff[e] * 256;
        unsigned char* dst = F.ws + BIG_AS + (size_t)p * D;
        v4u o = {0u, 0u, 0u, 0u};
        if (idx < cnt[e]) {
            const int ts = ((const int*)(F.ws + WS_LIST))[((size_t)half * 8 + e) * 32768 + idx], tok = ts >> 1, slot = ts & 1;
            const GAS v4u* s = (const GAS v4u*)((const bf16*)(F.ws + WS_H) + (size_t)tok * D) + 2 * F.lane;
            const v4u q0 = s[0], q1 = s[1];
            o.x = pg8::pack_fp8x4(pg8::bf_lo(q0.x), pg8::bf_hi(q0.x), pg8::bf_lo(q0.y), pg8::bf_hi(q0.y)); o.y = pg8::pack_fp8x4(pg8::bf_lo(q0.z), pg8::bf_hi(q0.z), pg8::bf_lo(q0.w), pg8::bf_hi(q0.w));
            o.z = pg8::pack_fp8x4(pg8::bf_lo(q1.x), pg8::bf_hi(q1.x), pg8::bf_lo(q1.y), pg8::bf_hi(q1.y)); o.w = pg8::pack_fp8x4(pg8::bf_lo(q1.z), pg8::bf_hi(q1.z), pg8::bf_lo(q1.w), pg8::bf_hi(q1.w));
            if (F.lane == 0) ((int*)(F.ws + WS_INV))[tok * 2 + slot] = p;
        }
        *((GAS v4u*)dst + F.lane) = o;
    }
}
__device__ __forceinline__ void moe_convert(Frame& F, const Args& a) {
    const int gw = F.vcu * NWAVES + F.wave, NGW = F.G * NWAVES;
    LAS float* scr = (LAS float*)(F.lds + F.wave * 16384);
    constexpr int I13 = 16 * 112, I2 = 56 * 32;
    for (int it = gw; it < 8 * (2 * I13 + I2); it += NGW) {
        const int e = it / (2 * I13 + I2); int r = it % (2 * I13 + I2);
        if (r < 2 * I13) {
            const int which = r / I13; r %= I13; const int kb = r / 112, nb = r % 112, n0 = 32 * nb;
            const float* W = (which ? a.in[I_MW3] : a.in[I_MW1]) + (size_t)e * D * DFFE;
            transpose_item_f8(W, DFFE, F.ws + WM_13 + (size_t)e * 2 * DFFE * D, D, 64 * kb, n0, (n0 / 128) * 256 + which * 128 + (n0 % 128), W13_SCALE, scr, F.lane);
        } else {
            r -= 2 * I13; const int kb = r / 32, nb = r % 32;
            transpose_item_f8(a.in[I_MW2] + (size_t)e * DFFE * D, D, F.ws + WM_2 + (size_t)e * D * DFFE, DFFE, 64 * kb, 32 * nb, 32 * nb, W2_SCALE, scr, F.lane);
        }
    }
}
__device__ __forceinline__ void moe_post_phase(Frame& F, const Args& a, int half) {
    const int gw = F.vcu * NWAVES + F.wave, NGW = F.G * NWAVES;
    const int R = (((32768 + NGW - 1) / NGW) + 1) & ~1, t0 = gw * R, t1 = (t0 + R) < 32768 ? (t0 + R) : 32768;
    RowVecs V; ld_row_f32(a.in[I_GFFNPOST] + D, F.lane, V.gA);
    int bcur = -2;
    const bf16* Y2 = (const bf16*)(F.ws + BIG_Y2S); const int* inv = (const int*)(F.ws + WS_INV); const int4* rt = (const int4*)(F.ws + WS_ROUTE);
#pragma unroll 1
    for (int t = t0; t < t1; t += 2) {
        const int row = half * 32768 + t, b = row >> 11;
        if (b != bcur) { bcur = b; ld_mod(F, 1, b, 5, F.lane, V.gt, 0.f); }
        const int4 ra = rt[row], rb = rt[row + 1];
        const int p00 = inv[row * 2], p01 = inv[row * 2 + 1], p10 = inv[row * 2 + 2], p11 = inv[row * 2 + 3];
        f32x4 ya[4], yb[4], yc[4], yd[4], y0[4], y1[4], x0[4], x1[4], h0[4], h1[4];
        ld_row_bf16(Y2 + (size_t)p00 * D, F.lane, ya); ld_row_bf16(Y2 + (size_t)p01 * D, F.lane, yb); ld_row_bf16(Y2 + (size_t)p10 * D, F.lane, yc); ld_row_bf16(Y2 + (size_t)p11 * D, F.lane, yd);
        float* xp = a.out + (size_t)row * D; ld_row_f32(xp, F.lane, x0); ld_row_f32(xp + D, F.lane, x1);
        const float w0 = __builtin_bit_cast(float, ra.z), w1 = __builtin_bit_cast(float, ra.w), u0 = __builtin_bit_cast(float, rb.z), u1 = __builtin_bit_cast(float, rb.w);
#pragma unroll
        for (int j = 0; j < 4; ++j) { y0[j] = ya[j] * w0 + yb[j] * w1; y1[j] = yc[j] * u0 + yd[j] * u1; }
        row_pair(V, y0, y1, x0, x1, true, false, h0, h1);
        st_row_f32(xp, F.lane, x0); st_row_f32(xp + D, F.lane, x1);
    }
}

#ifndef MK_ONLY
#define MK_ONLY -1
#endif
#ifndef MK_SKIP
#define MK_SKIP -1
#endif
#define ON(k) ((MK_ONLY < 0 || MK_ONLY == (k)) && MK_SKIP != (k))
#ifndef MK_REPMASK
#define MK_REPMASK 0
#endif
#ifndef MK_REPSUB
#define MK_REPSUB 0
#endif
#ifndef MK_HYVAR
#define MK_HYVAR 0
#endif
#ifndef MK_MULTI
#define MK_MULTI 0
#endif
constexpr int NPHASES = 2 + 9 + 6 + 6;

typedef const __attribute__((address_space(4))) Args* ArgsP;
#define KARGS ((ArgsP)__builtin_amdgcn_kernarg_segment_ptr())
#define PH_ENTER \
    Frame F; const Args* ap_; { int t_ = threadIdx.x; asm volatile("" : "+v"(t_)); ArgsP q_ = KARGS; asm volatile("" : "+s"(q_)); ap_ = (const Args*)q_; \
      F.lds = (LAS unsigned char*)lds_raw; F.tid = t_; F.lane = t_ & 63; F.wave = __builtin_amdgcn_readfirstlane(t_ >> 6); \
      F.G = gridDim.x; { const int bx_ = blockIdx.x; F.vcu = (F.G % 8 == 0) ? (bx_ % 8) * (F.G / 8) + bx_ / 8 : bx_; } F.ws = q_->ws; } \
    const Args& a = *ap_; const int bx = (int)blockIdx.x; \
    bf16* const Hb = (bf16*)(F.ws + WS_H); bf16* const Y3 = (bf16*)(F.ws + WS_Y3); bf16* const QKV = (bf16*)(F.ws + BIG_QKV); bf16* const CINT = (bf16*)(F.ws + BIG_CINT); unsigned char* const GATE = F.ws + BIG_GATE; \
    (void)Hb; (void)Y3; (void)QKV; (void)CINT; (void)GATE; (void)bx; (void)a;

__global__ void __launch_bounds__(NTHREADS, 2) fwd_kernel(Args args) {
    extern __shared__ __attribute__((aligned(16))) unsigned char lds_raw[];
    {
        volatile LAS unsigned* MISC0 = (volatile LAS unsigned*)((LAS unsigned char*)lds_raw + MISC_OFF);
        for (int u = threadIdx.x; u < (LDS_BYTES - MISC_OFF) / 4; u += NTHREADS) MISC0[u] = 0u;
        __syncthreads();
    }
    if (!MK_MULTI) (void)xcd_barrier_post((unsigned*)(KARGS->ws + WS_CTL) + CW_BAR, (volatile LAS unsigned*)((LAS unsigned char*)lds_raw + MISC_OFF) + 8);
    int ph = 0;
#define LO_ (KARGS->ph_lo)
#define HI_ (KARGS->ph_hi)
#define GRID_BAR do { XcdBarrier b_; b_.bar = (unsigned*)(KARGS->ws + WS_CTL) + CW_BAR; b_.x = xb_xcc_id(); b_.st = (volatile LAS unsigned*)((LAS unsigned char*)lds_raw + MISC_OFF) + 8; xcd_barrier(b_); } while (0)
#define RUN (LO_ <= ph && ph < HI_)
#define END_PHASE do { if (RUN && (ph + 1 < HI_)) { GRID_BAR; } ++ph; } while (0)

    if (RUN && ON(0)) { PH_ENTER p0_prologue(F, a); } END_PHASE;
    if (RUN && ON(1)) { PH_ENTER p1_phase(F, a); rows_phase(F, a, 0, 0, 0, nullptr, NROW); } END_PHASE;

#pragma unroll 1
    for (int l = 0; l < 2; ++l) {
        const int nrows = l == 0 ? NROW : NTOK;
        if (RUN && ON(2)) { PH_ENTER
            const bf16* Wq8 = (const bf16*)(F.ws + W_IN + (size_t)l * INC * D);
            { pg8::Gemm g{(const bf16*)(F.ws + WS_H8), Wq8, nrows, QKVC, D / 2}; pg8::StaticOrder S; S.init(nrows, QKVC, F.G, bx);
              pg8::EpiQKV E{QKV, (const float*)(F.ws + WS_ROPE), 0, QSCALE, 1.0f / W13_SCALE};
              pg8::gemm_phase<pg8::EpiQKV, pg8::StaticOrder, true, true, true>(F.lds, g, S, E, F.tid); }
            int tid2 = threadIdx.x; asm volatile("" : "+v"(tid2));
            if (l == 1) { pg8::Gemm g{(const bf16*)(F.ws + WS_H8 + (size_t)NTOK * D), Wq8, NCTX, 1280, D / 2}; pg8::StaticOrder S; S.init(NCTX, 1280, F.G, bx);
              pg8::EpiQKV E{QKV, (const float*)(F.ws + WS_ROPE), NTOK, QSCALE, 1.0f / W13_SCALE};
              pg8::gemm_phase<pg8::EpiQKV, pg8::StaticOrder, true, true, true>(F.lds, g, S, E, tid2); }
            int tid3 = threadIdx.x; asm volatile("" : "+v"(tid3));
            { pg8::Gemm g{(const bf16*)(F.ws + W_CB) + (size_t)l * CINC * D, Hb, CINC, nrows, D}; pg8::StaticOrder S; S.init(CINC, nrows, F.G, bx);
              pg8::EpiPlain E{CINT, NROW, 0, 0, 1.0f};
              pg8::gemm_phase<pg8::EpiPlain, pg8::StaticOrder, true, true>(F.lds, g, S, E, tid3); }
        } END_PHASE;
        if (RUN) { PH_ENTER
            const float* sink = a.in[I_SINK] + l * 8; const float* rpb = a.in[I_RPB] + (size_t)l * 8 * 15 * 31;
            const int sm = a.sub_mask;
            if (ON(3) && (sm & 1)) { AttPre P; P.valid = 0; for (int u = F.vcu; u < 2048; u += F.G) attn_unit<0>(F, u, u + F.G < 2048 ? u + F.G : -1, QKV, Y3, sink, rpb, P); }
            if (ON(4) && (sm & 2)) { AttPre P; P.valid = 0; for (int u = F.vcu; u < 2048; u += F.G) attn_unit<1>(F, u, u + F.G < 2048 ? u + F.G : -1, QKV, Y3 + (size_t)NROW * 512, sink, rpb, P); }
            if (l == 0 && ON(5) && (sm & 4)) {
                { AttPre P; P.valid = 0; for (int u = F.vcu; u < 256; u += F.G) attn_unit<2>(F, u, -1, QKV, Y3, sink, rpb, P); }
                { AttPre P; P.valid = 0; for (int u = F.vcu; u < 256; u += F.G) attn_unit<3>(F, u, -1, QKV, Y3 + (size_t)NROW * 512, sink, rpb, P); }
            }
            const float* cw = a.in[I_CONVW] + l * 3 * CINC; const float* cb = a.in[I_CONVB] + l * CINC; const float* hb = a.in[I_HBIAS] + l * 1024;
#if MK_HYVAR
            if (ON(6) && (sm & 32)) for (int c = F.vcu; c < 512; c += F.G) hyena_unit<SEQ, MK_HYVAR>(F, c, CINT, CINT, (const bf16*)(F.ws + WS_GF) + (size_t)l * 2 * 512 * 2 * SEQ, cw, cb, hb);
#endif
            if (ON(6) && (sm & 8)) for (int c = F.vcu; c < 512; c += F.G) hyena_unit<SEQ>(F, c, CINT, CINT, (const bf16*)(F.ws + WS_GF) + (size_t)l * 2 * 512 * 2 * SEQ, cw, cb, hb);
            if (l == 0 && ON(7) && (sm & 16)) for (int c = F.vcu; c < 512; c += F.G) hyena_unit<LC>(F, c, CINT, CINT, (const bf16*)(F.ws + WS_GFC) + (size_t)l * 2 * 512 * 2 * LC, cw, cb, hb);
            __syncthreads();
        } END_PHASE;
        if (RUN && ON(8)) { PH_ENTER
            transpose_yc(F, CINT, (bf16*)(F.ws + BIG_YCT), nrows);
            __syncthreads();
            pg8::Gemm g{(const bf16*)(F.ws + WS_H8), (const bf16*)(F.ws + W_IN + (size_t)l * INC * D + (size_t)(QKVC + CINC) * D), nrows, GATEC, D / 2}; pg8::StaticOrder S; S.init(nrows, GATEC, F.G, bx);
            pg8::EpiSig E{GATE, GATEC, 1.0f / W13_SCALE};
            pg8::gemm_phase<pg8::EpiSig, pg8::StaticOrder, true, true, true>(F.lds, g, S, E, F.tid);
        } END_PHASE;
        if (RUN && ON(9)) { PH_ENTER
            constexpr int TB = 256 * 512 * 2;
            static_assert((WS_Y3 - BIG_YCT) % TB == 0, "merge tile offsets");
            constexpr int OA = (int)((WS_Y3 - BIG_YCT) / TB), OB = OA + NROW / 256;
            pg8::Gemm g{(const bf16*)(F.ws + BIG_YCT), (const bf16*)(F.ws + W_BR) + (size_t)l * 3 * D * 512, 3 * NROW, 3 * D, 512}; pg8::MergeOrder S{nrows / 256, F.G, bx, OA, OB, 0};
            pg8::EpiMerge E{Hb, GATE, OA, OB, 0};
            pg8::gemm_phase<pg8::EpiMerge, pg8::MergeOrder, true, true>(F.lds, g, S, E, F.tid);
        } END_PHASE;
        if (RUN && ON(10)) { PH_ENTER
            pg8::Gemm g{Hb, (const bf16*)(F.ws + W_OUT) + (size_t)l * D * D, nrows, D, D}; pg8::StaticOrder S; S.init(nrows, D, F.G, bx);
            pg8::EpiPlain E{Y3, D, 0, 0, 1.0f};
            pg8::gemm_phase<pg8::EpiPlain, pg8::StaticOrder, true, true>(F.lds, g, S, E, F.tid);
        } END_PHASE;
        if (RUN && ON(11)) { PH_ENTER if (l == 0) rows_phase(F, a, 1, 0, 0, Y3, nrows); else post_route_phase(F, a, Y3); } END_PHASE;
        if (l == 0) {
            if (RUN && ON(12)) { PH_ENTER
                pg8::Gemm g{Hb, (const bf16*)(F.ws + W_F13), NROW, 2 * DFF, D}; pg8::StaticOrder S; S.init(NROW, 2 * DFF, F.G, bx);
                pg8::EpiSwiGLU E{(bf16*)(F.ws + BIG_HID), DFF, 0};
                pg8::gemm_phase<pg8::EpiSwiGLU, pg8::StaticOrder, true, true>(F.lds, g, S, E, F.tid);
            } END_PHASE;
            if (RUN && ON(13)) { PH_ENTER
                pg8::Gemm g{(const bf16*)(F.ws + BIG_HID), (const bf16*)(F.ws + W_F2), NROW, D, DFF}; pg8::StaticOrder S; S.init(NROW, D, F.G, bx);
                pg8::EpiPlain E{Y3, D, 0, 0, 1.0f};
                pg8::gemm_phase<pg8::EpiPlain, pg8::StaticOrder, true, true>(F.lds, g, S, E, F.tid);
            } END_PHASE;
            if (RUN && ON(14)) { PH_ENTER rows_phase(F, a, 1, 0, 1, Y3, NROW); } END_PHASE;
        } else {
#pragma unroll 1
            for (int half = 0; half < 2; ++half) {
                if (half == 0) { if (RUN && ON(15)) { PH_ENTER moe_convert(F, a); moe_gather_phase(F, 0); } END_PHASE; }
                if (RUN && ON(16)) { PH_ENTER
                    int toff[9], cnt[8]; moe_offsets(F, half, toff, cnt);
                    pg8::GroupOrder S; S.nM = toff[8]; S.nN = 28; S.G = F.G; S.c = bx;
#pragma unroll
                    for (int k = 0; k < 9; ++k) S.toff[k] = toff[k];
                    pg8::Gemm g{(const bf16*)(F.ws + BIG_AS), (const bf16*)(F.ws + WM_13), PCAP, 8 * 2 * DFFE, D / 2};
                    pg8::EpiSwiGLU8 E{F.ws + BIG_MH, DFFE, 28, 1.0f / W13_SCALE, HID_SCALE};
                    pg8::gemm_phase<pg8::EpiSwiGLU8, pg8::GroupOrder, true, true, true>(F.lds, g, S, E, F.tid);
                    if (half == 1) moe_post_phase(F, a, 0);
                } END_PHASE;
                if (RUN && ON(17)) { PH_ENTER
                    int toff[9], cnt[8]; moe_offsets(F, half, toff, cnt);
                    pg8::GroupOrder S; S.nM = toff[8]; S.nN = 4; S.G = F.G; S.c = bx;
#pragma unroll
                    for (int k = 0; k < 9; ++k) S.toff[k] = toff[k];
                    pg8::Gemm g{(const bf16*)(F.ws + BIG_MH), (const bf16*)(F.ws + WM_2), PCAP, 8 * D, DFFE / 2};
                    pg8::EpiPlain E{(bf16*)(F.ws + BIG_Y2S), D, 4, 0, 1.0f / (HID_SCALE * W2_SCALE)};
                    pg8::gemm_phase<pg8::EpiPlain, pg8::GroupOrder, true, true, true>(F.lds, g, S, E, F.tid);
                    if (half == 0) moe_gather_phase(F, 1, toff[8] * 4 - 4 * F.G);
                } END_PHASE;
            }
            if (RUN && ON(18)) { PH_ENTER moe_post_phase(F, a, 1); } END_PHASE;
        }
    }
#undef RUN
#undef END_PHASE
}

extern "C" void kernel_launch(void* const* d_in, const int* in_sizes, int n_in, void* d_out, int out_size, void* d_ws, size_t ws_size, hipStream_t stream) {
    static int grid = 0;
    if (grid == 0) {
        if (n_in != 31 || in_sizes[0] != NTOK * D || out_size != NTOK * D || ws_size < WS_END) { fprintf(stderr, "kernel_launch: unexpected shapes (n_in %d, in0 %d, out %d, ws %zu)\n", n_in, n_in > 0 ? in_sizes[0] : -1, out_size, ws_size); grid = -1; return; }
        int dev = 0, cus = 0, per_cu = 0;
        if (hipGetDevice(&dev) != hipSuccess || hipDeviceGetAttribute(&cus, hipDeviceAttributeMultiprocessorCount, dev) != hipSuccess) { grid = -1; return; }
        if (hipFuncSetAttribute((const void*)fwd_kernel, hipFuncAttributeMaxDynamicSharedMemorySize, LDS_BYTES) != hipSuccess) { fprintf(stderr, "kernel_launch: hipFuncSetAttribute failed\n"); grid = -1; return; }
        if (hipOccupancyMaxActiveBlocksPerMultiprocessor(&per_cu, (const void*)fwd_kernel, NTHREADS, LDS_BYTES) != hipSuccess || per_cu < 1) { fprintf(stderr, "kernel_launch: occupancy query says %d\n", per_cu); }
        (void)hipGetLastError();
        grid = cus;
    }
    if (grid < 0) return;
    if (hipMemsetAsync((char*)d_ws + WS_CTL, 0, CTL_ZERO_BYTES, stream) != hipSuccess) return;
    Args a{};
    for (int i = 0; i < 31; ++i) a.in[i] = (const float*)d_in[i];
    a.out = (float*)d_out; a.ws = (unsigned char*)d_ws;
#if MK_MULTI
    for (int p = 0; p < NPHASES; ++p) { a.ph_lo = p; a.ph_hi = p + 1; a.sub_mask = 31;
        const bool mix = (p == 3 || p == 12);
        if (((MK_REPMASK >> p) & 1) && !mix) { a.sub_mask = 31 | MK_REPSUB; hipLaunchKernelGGL(fwd_kernel, dim3(grid), dim3(NTHREADS), LDS_BYTES, stream, a); a.sub_mask = 31; }
        if (((MK_REPMASK >> p) & 1) && mix) { a.sub_mask = MK_REPSUB; hipLaunchKernelGGL(fwd_kernel, dim3(grid), dim3(NTHREADS), LDS_BYTES, stream, a); a.sub_mask = 31; }
        hipLaunchKernelGGL(fwd_kernel, dim3(grid), dim3(NTHREADS), LDS_BYTES, stream, a); }
#else
    a.ph_lo = 0; a.ph_hi = NPHASES; a.sub_mask = 31;
    hipLaunchKernelGGL(fwd_kernel, dim3(grid), dim3(NTHREADS), LDS_BYTES, stream, a);
#endif
    const hipError_t le = hipPeekAtLastError();
    if (le != hipSuccess) fprintf(stderr, "kernel_launch: launch failed: %s\n", hipGetErrorName(le));
}
```

```cpp
#include <hip/hip_runtime.h>
#include <cstdio>
#include <cstdint>
namespace pg8 {
#define PG8_LAS __attribute__((address_space(3)))
typedef unsigned short bf16_t;
typedef short bf16x8 __attribute__((ext_vector_type(8)));
typedef float f32x4 __attribute__((ext_vector_type(4)));
typedef unsigned u32x4 __attribute__((ext_vector_type(4)));
constexpr int BM = 256, BK = 64, HALF = 128, HTB = HALF * BK * 2  , STAGE_BYTES = 8 * HTB, NXCD = 8, WGM = 8;

__host__ __device__ __forceinline__ int lds_byte(int r, int c) { const int st = (r >> 4) * 2 + (c >> 5), rr = r & 15, cc = c & 31, ob = rr * 64 + cc * 2; return st * 1024 + (ob ^ (((ob >> 9) & 1) << 5)); }
__host__ __device__ __forceinline__ void stage_rc(int b, int& R, int& C) { const int st = b / 1024, sb = b % 1024, swz = sb ^ (((sb >> 9) & 1) << 5); R = (st >> 1) * 16 + swz / 64; C = (st & 1) * 32 + (swz % 64) / 2; }
__host__ __device__ __forceinline__ int perm32(int rho) { const int n = rho >> 4, i = rho & 15; return 8 * (i >> 2) + 4 * n + (i & 3); }

struct Unit { int pm, pn; };
struct Gemm { const bf16_t* A; const bf16_t* Bt; int M, N, K; };

struct StaticOrder {
    int nM, nN, nwg, G, c;
    __host__ __device__ void init(int M, int N, int G_, int c_) { nM = M / BM; nN = N / BM; nwg = nM * nN; G = G_; c = c_; }
    __host__ __device__ bool next(int i, Unit& u) const {
        const long L = (long)i * G + c; if (L >= nwg) return false;
        int wgid = (int)L; { const int q = nwg / NXCD, r = nwg % NXCD, xcd = wgid % NXCD, off = wgid / NXCD; wgid = (xcd < r ? xcd * (q + 1) : r * (q + 1) + (xcd - r) * q) + off; }
        const int nig = WGM * nN, gid = wgid / nig, fm = gid * WGM, gsz = (nM - fm) < WGM ? (nM - fm) : WGM;
        u.pm = fm + ((wgid % nig) % gsz); u.pn = (wgid % nig) / gsz; return true;
    }
    __device__ __forceinline__ void a_ready(const Unit&) const {}
    __device__ __forceinline__ void done(const Unit&) const {}
};

typedef float f32x2_t __attribute__((ext_vector_type(2)));
typedef __bf16 bf16x2_t __attribute__((ext_vector_type(2)));
__device__ __forceinline__ unsigned cvt_pk_bf16(float lo, float hi) { const f32x2_t v = {lo, hi}; const bf16x2_t b = __builtin_convertvector(v, bf16x2_t); return __builtin_bit_cast(unsigned, b); }
__device__ __forceinline__ u32x4 pack8(f32x4 a, f32x4 b) { u32x4 w; w.x = cvt_pk_bf16(a[0], a[1]); w.y = cvt_pk_bf16(a[2], a[3]); w.z = cvt_pk_bf16(b[0], b[1]); w.w = cvt_pk_bf16(b[2], b[3]); return w; }
__device__ __forceinline__ float bf_lo(unsigned w) { return __builtin_bit_cast(float, w << 16); }
__device__ __forceinline__ float bf_hi(unsigned w) { return __builtin_bit_cast(float, w & 0xffff0000u); }
__device__ __forceinline__ void unpack8(u32x4 w, f32x4& a, f32x4& b) { a = (f32x4){bf_lo(w.x), bf_hi(w.x), bf_lo(w.y), bf_hi(w.y)}; b = (f32x4){bf_lo(w.z), bf_hi(w.z), bf_lo(w.w), bf_hi(w.w)}; }
__device__ __forceinline__ float fast_sigmoid(float x) { return __builtin_amdgcn_rcpf(1.0f + __builtin_amdgcn_exp2f(-1.4426950408889634f * x)); }

__device__ __forceinline__ f32x4 vexp2(f32x4 x) { return (f32x4){__builtin_amdgcn_exp2f(x[0]), __builtin_amdgcn_exp2f(x[1]), __builtin_amdgcn_exp2f(x[2]), __builtin_amdgcn_exp2f(x[3])}; }
__device__ __forceinline__ f32x4 vrcp(f32x4 x) { return (f32x4){__builtin_amdgcn_rcpf(x[0]), __builtin_amdgcn_rcpf(x[1]), __builtin_amdgcn_rcpf(x[2]), __builtin_amdgcn_rcpf(x[3])}; }
__device__ __forceinline__ f32x4 vsigmoid(f32x4 x, float k) { return vrcp(vexp2(x * k) + 1.0f); }
struct EpiPlain {
    static constexpr bool PERM = true, AFTER_DRAIN = false, INPLACE = false;
    bf16_t* O; int ldc; int pn_mod; int accum; float scale;
    __device__ __forceinline__ void operator()(const f32x4 (&acc)[2][2][4][2], const Unit& u, int wr, int wc, int fr, int fq) const {
        asm volatile("" : "+v"(fr), "+v"(fq));
        const int pn = pn_mod ? (u.pn % pn_mod) : u.pn;
        const int row0 = u.pm * BM + wr * 64 + fr, col0 = pn * BM + wc * 32 + 8 * fq;
#pragma unroll
        for (int ai = 0; ai < 2; ++ai)
#pragma unroll
            for (int m = 0; m < 4; ++m) { bf16_t* rowp = O + (size_t)(row0 + ai * HALF + m * 16) * ldc + col0;
#pragma unroll
                for (int bj = 0; bj < 2; ++bj) { f32x4 v0 = acc[ai][bj][m][0] * scale, v1 = acc[ai][bj][m][1] * scale;
                    if (accum) { f32x4 p0, p1; unpack8(*(const u32x4*)(rowp + bj * HALF), p0, p1); v0 = v0 + p0; v1 = v1 + p1; }
                    *(u32x4*)(rowp + bj * HALF) = pack8(v0, v1); } }
    }
};
__device__ __forceinline__ unsigned pack_u8x4(float a, float b, float c, float d) {
    unsigned w = 0; w = __builtin_amdgcn_cvt_pk_u8_f32(a, 0, w); w = __builtin_amdgcn_cvt_pk_u8_f32(b, 1, w); w = __builtin_amdgcn_cvt_pk_u8_f32(c, 2, w); w = __builtin_amdgcn_cvt_pk_u8_f32(d, 3, w); return w; }
struct EpiSig {
    static constexpr bool PERM = true, AFTER_DRAIN = false, INPLACE = false;
    unsigned char* O; int ldc; float in_scale;
    __device__ __forceinline__ void operator()(const f32x4 (&acc)[2][2][4][2], const Unit& u, int wr, int wc, int fr, int fq) const {
        const int row0 = u.pm * BM + wr * 64 + fr, col0 = u.pn * BM + wc * 32 + 8 * fq;
        typedef unsigned u32x2_ __attribute__((ext_vector_type(2)));
#pragma unroll
        for (int ai = 0; ai < 2; ++ai)
#pragma unroll
            for (int m = 0; m < 4; ++m) { unsigned char* rowp = O + (size_t)(row0 + ai * HALF + m * 16) * ldc + col0;
#pragma unroll
                for (int bj = 0; bj < 2; ++bj) { const float k = -1.4426950408889634f * in_scale;
                    const f32x4 v0 = vsigmoid(acc[ai][bj][m][0], k) * 255.0f, v1 = vsigmoid(acc[ai][bj][m][1], k) * 255.0f;
                    u32x2_ w; w.x = pack_u8x4(v0[0], v0[1], v0[2], v0[3]); w.y = pack_u8x4(v1[0], v1[1], v1[2], v1[3]);
                    *(u32x2_*)(rowp + bj * HALF) = w; } }
    }
};
struct EpiSwiGLU {
    static constexpr bool PERM = true, AFTER_DRAIN = false, INPLACE = false;
    bf16_t* O; int ldc; int pn_mod;
    __device__ __forceinline__ void operator()(const f32x4 (&acc)[2][2][4][2], const Unit& u, int wr, int wc, int fr, int fq) const {
        const int pn = pn_mod ? (u.pn % pn_mod) : u.pn;
        const int row0 = u.pm * BM + wr * 64 + fr, col0 = pn * HALF + wc * 32 + 8 * fq;
#pragma unroll
        for (int ai = 0; ai < 2; ++ai)
#pragma unroll
            for (int m = 0; m < 4; ++m) { bf16_t* rowp = O + (size_t)(row0 + ai * HALF + m * 16) * ldc + col0;
                const f32x4 a0 = acc[ai][0][m][0], a1 = acc[ai][0][m][1], g0 = acc[ai][1][m][0], g1 = acc[ai][1][m][1];
                const f32x4 v0 = (a0 * g0) * vsigmoid(a0, -1.4426950408889634f), v1 = (a1 * g1) * vsigmoid(a1, -1.4426950408889634f);
                *(u32x4*)rowp = pack8(v0, v1); }
    }
};
__device__ __forceinline__ unsigned pack_fp8x4(float a, float b, float c, float d) {
    a = __builtin_amdgcn_fmed3f(a, -448.f, 448.f); b = __builtin_amdgcn_fmed3f(b, -448.f, 448.f); c = __builtin_amdgcn_fmed3f(c, -448.f, 448.f); d = __builtin_amdgcn_fmed3f(d, -448.f, 448.f);
    int w = 0; w = __builtin_amdgcn_cvt_pk_fp8_f32(a, b, w, false); w = __builtin_amdgcn_cvt_pk_fp8_f32(c, d, w, true); return (unsigned)w; }
struct EpiSwiGLU8 {
    static constexpr bool PERM = true, AFTER_DRAIN = false, INPLACE = false;
    unsigned char* O; int ldc; int pn_mod; float in_scale, out_scale;
    __device__ __forceinline__ void operator()(const f32x4 (&acc)[2][2][4][2], const Unit& u, int wr, int wc, int fr, int fq) const {
        asm volatile("" : "+v"(fr), "+v"(fq));
        const int pn = pn_mod ? (u.pn % pn_mod) : u.pn;
        const int row0 = u.pm * BM + wr * 64 + fr, col0 = pn * HALF + wc * 32 + 8 * fq;
#pragma unroll
        for (int ai = 0; ai < 2; ++ai)
#pragma unroll
            for (int m = 0; m < 4; ++m) { unsigned char* rowp = O + (size_t)(row0 + ai * HALF + m * 16) * ldc + col0;
                const f32x4 a0 = acc[ai][0][m][0], a1 = acc[ai][0][m][1], g0 = acc[ai][1][m][0], g1 = acc[ai][1][m][1];
                const float k1 = -1.4426950408889634f * in_scale, k2 = in_scale * in_scale * out_scale;
                const f32x4 v0 = ((a0 * g0) * vsigmoid(a0, k1)) * k2, v1 = ((a1 * g1) * vsigmoid(a1, k1)) * k2;
                typedef unsigned u32x2_ __attribute__((ext_vector_type(2)));
                u32x2_ w; w.x = pack_fp8x4(v0[0], v0[1], v0[2], v0[3]); w.y = pack_fp8x4(v1[0], v1[1], v1[2], v1[3]);
                *(u32x2_*)rowp = w; }
    }
};
struct EpiMerge {
    static constexpr bool PERM = true, AFTER_DRAIN = false, INPLACE = true;
    bf16_t* Mo; const unsigned char* Gt; int off0, off1, off2;
    __device__ __forceinline__ static void ub4(unsigned w, f32x4& v) { v = (f32x4){(float)(w & 0xffu), (float)((w >> 8) & 0xffu), (float)((w >> 16) & 0xffu), (float)(w >> 24)}; }
    __device__ __forceinline__ bool inplace(f32x4 (&acc)[2][2][4][2], const Unit& u, int wr, int wc, int fr, int fq) const {
        typedef unsigned u32x2_ __attribute__((ext_vector_type(2)));
        const int br = u.pn >> 2, pn = u.pn & 3, pm = u.pm - (br < 2 ? off0 + br * (off1 - off0) : off2);
        const int row0 = pm * BM + wr * 64 + fr, col0 = pn * BM + wc * 32 + 8 * fq;
#pragma unroll
        for (int ai = 0; ai < 2; ++ai)
#pragma unroll
            for (int m = 0; m < 4; ++m) { const size_t row = (size_t)(row0 + ai * HALF + m * 16); const unsigned char* gp = Gt + row * 3072 + br * 1024 + col0;
#pragma unroll
                for (int bj = 0; bj < 2; ++bj) { const u32x2_ gw = *(const u32x2_*)(gp + bj * HALF); f32x4 g0, g1; ub4(gw.x, g0); ub4(gw.y, g1);
                    if (br < 2) { const u32x2_ nw = *(const u32x2_*)(gp + 1024 + bj * HALF); f32x4 n0, n1; ub4(nw.x, n0); ub4(nw.y, n1);
#pragma unroll
                        for (int e = 0; e < 4; ++e) { g0[e] = fmaxf(g0[e], 0.5f) * __builtin_amdgcn_rcpf(fmaxf(n0[e], 0.5f)); g1[e] = fmaxf(g1[e], 0.5f) * __builtin_amdgcn_rcpf(fmaxf(n1[e], 0.5f)); }
                        acc[ai][bj][m][0] = acc[ai][bj][m][0] * g0; acc[ai][bj][m][1] = acc[ai][bj][m][1] * g1;
                    } else {
#pragma unroll
                        for (int e = 0; e < 4; ++e) { g0[e] = fmaxf(g0[e], 0.5f) * (1.0f / 255.0f); g1[e] = fmaxf(g1[e], 0.5f) * (1.0f / 255.0f); }
                        *(u32x4*)(Mo + row * 1024 + col0 + bj * HALF) = pack8(acc[ai][bj][m][0] * g0, acc[ai][bj][m][1] * g1); }
                } }
        return br < 2;
    }
};
struct EpiQKV {
    static constexpr bool PERM = true, AFTER_DRAIN = false, INPLACE = false;
    bf16_t* O; const float* rope; int row_base; float qscale; float in_scale;
    __device__ __forceinline__ void operator()(const f32x4 (&acc)[2][2][4][2], const Unit& u, int wr, int wc, int fr, int fq) const {
        const int rowt = row_base + u.pm * BM;
        const bool latent = rowt < 65536;
        const int row0 = rowt + wr * 64 + fr, col0 = u.pn * BM + wc * 32 + 8 * fq;
#pragma unroll
        for (int bj = 0; bj < 2; ++bj) {
            const int cb = 2 * u.pn + bj;
            const bool do_rope = latent && (cb == 0 || (cb >= 10 && cb < 14));
            const float sc = (cb >= 10) ? qscale * in_scale : in_scale;
#pragma unroll
            for (int ai = 0; ai < 2; ++ai)
#pragma unroll
                for (int m = 0; m < 4; ++m) {
                    const int row = row0 + ai * HALF + m * 16;
                    f32x4 v0 = acc[ai][bj][m][0], v1 = acc[ai][bj][m][1];
                    if (do_rope) {
                        const int t = row & 2047, pos = (wc & 1) ? (t & 63) : (t >> 6);
                        const float* cp = rope + pos * 16 + 8 * (fq & 1);
                        const f32x4 c0 = *(const f32x4*)cp, c1 = *(const f32x4*)(cp + 4), s0 = *(const f32x4*)(cp + 1024), s1 = *(const f32x4*)(cp + 1028);
                        const float sg = (fq >= 2) ? 1.0f : -1.0f;
                        f32x4 o0, o1;
#pragma unroll
                        for (int e = 0; e < 4; ++e) { o0[e] = __shfl_xor(v0[e], 32); o1[e] = __shfl_xor(v1[e], 32); }
                        v0 = v0 * c0 + (o0 * sg) * s0; v1 = v1 * c1 + (o1 * sg) * s1;
                    }
                    v0 = v0 * sc; v1 = v1 * sc;
                    *(u32x4*)(O + (size_t)row * 2304 + col0 + bj * HALF) = pack8(v0, v1);
                }
        }
    }
};
__device__ __forceinline__ void tile_of(int L, int nM, int nN, int& pm, int& pn) {
    const int nwg = nM * nN; int wgid = L; { const int q = nwg / NXCD, r = nwg % NXCD, xcd = wgid % NXCD, off = wgid / NXCD; wgid = (xcd < r ? xcd * (q + 1) : r * (q + 1) + (xcd - r) * q) + off; }
    const int nig = WGM * nN, gid = wgid / nig, fm = gid * WGM, gsz = (nM - fm) < WGM ? (nM - fm) : WGM;
    pm = fm + ((wgid % nig) % gsz); pn = (wgid % nig) / gsz;
}
struct MergeOrder {
    int nM, G, c, off0, off1, off2;
    __device__ bool next(int i, Unit& u) const {
        const int t = i / 3, br = i - 3 * t; const long L = (long)t * G + c; if (L >= (long)nM * 4) return false;
        int pm, pn; tile_of((int)L, nM, 4, pm, pn); u.pm = (br < 2 ? off0 + br * (off1 - off0) : off2) + pm; u.pn = br * 4 + pn; return true;
    }
    __device__ __forceinline__ void a_ready(const Unit&) const {}
    __device__ __forceinline__ void done(const Unit&) const {}
};
struct GroupOrder {
    int nM, nN, G, c; int toff[9];
    __device__ bool next(int i, Unit& u) const {
        const long L = (long)i * G + c; if (L >= (long)nM * nN) return false;
        int pm, pn; tile_of((int)L, nM, nN, pm, pn); int e = 0;
#pragma unroll
        for (int k = 1; k < 8; ++k) e += (pm >= toff[k]) ? 1 : 0;
        u.pm = pm; u.pn = e * nN + pn; return true;
    }
    __device__ __forceinline__ void a_ready(const Unit&) const {}
    __device__ __forceinline__ void done(const Unit&) const {}
};
template <class Epi, class Sched, bool ALIGN_EPI = false, bool SP2 = false, bool F8 = false>
__device__ __forceinline__ void gemm_phase(PG8_LAS unsigned char* lds, const Gemm g, const Sched& S, const Epi& E, const int tid) {
    const int wid = __builtin_amdgcn_readfirstlane(tid >> 6), lane = tid & 63, wr = wid >> 2, wc = wid & 3, fr = lane & 15, fq = lane >> 4;
    const int K = g.K, nt = K / BK;
    unsigned voffA[2], voffB[2];
#pragma unroll
    for (int i = 0; i < 2; ++i) { int R, C; stage_rc(tid * 16 + i * 8192, R, C); const int Rb = Epi::PERM ? ((R & ~31) + perm32(R & 31)) : R;
        voffA[i] = (unsigned)(R * K + C) * 2u; voffB[i] = (unsigned)(Rb * K + C) * 2u; }
    const size_t kstep = (size_t)(BK * 2);
    const size_t hstep = (size_t)HALF * K * 2;
    const size_t tstep = 2 * hstep;
    const unsigned ldsw = (unsigned)wid * 1024u;
    const int aoff = lds_byte(wr * 64 + fr, fq * 8), boff = lds_byte(wc * 32 + fr, fq * 8);
#define PG8_SA(b, h) (((b) * 2 + (h)) * HTB)
#define PG8_SB(b, h) ((4 + (b) * 2 + (h)) * HTB)
#define PG8_STAGE(bufoff, gbase, voff) do { _Pragma("unroll") for (int _i = 0; _i < 2; ++_i) \
        __builtin_amdgcn_global_load_lds((const unsigned*)((const char*)(gbase) + (voff)[_i]), (PG8_LAS unsigned*)(lds + (bufoff) + ldsw + _i * 8192), 16, 0, 0); } while (0)
#define PG8_LDA(dst, b, h) do { _Pragma("unroll") for (int m = 0; m < 4; ++m) _Pragma("unroll") for (int k = 0; k < 2; ++k) dst[m][k] = *(const PG8_LAS bf16x8*)(lds + PG8_SA(b, h) + aoff + m * 2048 + k * 1024); } while (0)
#define PG8_LDB(dst, b, h) do { _Pragma("unroll") for (int n = 0; n < 2; ++n) _Pragma("unroll") for (int k = 0; k < 2; ++k) dst[n][k] = *(const PG8_LAS bf16x8*)(lds + PG8_SB(b, h) + boff + n * 2048 + k * 1024); } while (0)
#define PG8_MMA(ai, bj, At, Bt) do { __builtin_amdgcn_s_setprio(1); _Pragma("unroll") for (int m = 0; m < 4; ++m) _Pragma("unroll") for (int n = 0; n < 2; ++n) { \
        if constexpr (F8) { typedef int v8i_ __attribute__((ext_vector_type(8))); typedef int v4i_ __attribute__((ext_vector_type(4))); \
            const v4i_ b0_ = __builtin_bit_cast(v4i_, Bt[n][0]), b1_ = __builtin_bit_cast(v4i_, Bt[n][1]), a0_ = __builtin_bit_cast(v4i_, At[m][0]), a1_ = __builtin_bit_cast(v4i_, At[m][1]); \
            const v8i_ bb_ = __builtin_shufflevector(b0_, b1_, 0, 1, 2, 3, 4, 5, 6, 7), aa_ = __builtin_shufflevector(a0_, a1_, 0, 1, 2, 3, 4, 5, 6, 7); \
            asm volatile("v_mfma_scale_f32_16x16x128_f8f6f4 %0, %1, %2, %0, %3, %3 op_sel_hi:[0,0,0]" : "+v"(acc[ai][bj][m][n]) : "v"(bb_), "v"(aa_), "v"(f8_scale_)); } \
        else { _Pragma("unroll") for (int k = 0; k < 2; ++k) acc[ai][bj][m][n] = __builtin_amdgcn_mfma_f32_16x16x32_bf16(Bt[n][k], At[m][k], acc[ai][bj][m][n], 0, 0, 0); } } \
        __builtin_amdgcn_s_setprio(0); } while (0)
#define PG8_WAIT_V(n) asm volatile("s_waitcnt vmcnt(" #n ")" ::: "memory")
#define PG8_WAIT_L(n) asm volatile("s_waitcnt lgkmcnt(" #n ")" ::: "memory")
#define PG8_BAR __builtin_amdgcn_s_barrier()
#define PG8_SCHED __builtin_amdgcn_sched_barrier(0)
    int f8_scale_ = 0x7f7f7f7f; (void)f8_scale_;
    Unit cur, nxt; int ui = 0;
    if (!S.next(0, cur)) return;
    f32x4 acc[2][2][4][2];
#pragma unroll
    for (int a = 0; a < 2; ++a)
#pragma unroll
        for (int b = 0; b < 2; ++b)
#pragma unroll
            for (int m = 0; m < 4; ++m)
#pragma unroll
                for (int n = 0; n < 2; ++n) acc[a][b][m][n] = (f32x4){0.f, 0.f, 0.f, 0.f};
    bf16x8 At[4][2], B0[2][2], B1[2][2];
    const char* cA = (const char*)g.A + (size_t)cur.pm * tstep; const char* cB = (const char*)g.Bt + (size_t)cur.pn * tstep;
    S.a_ready(cur);
    if constexpr (SP2) {
        PG8_STAGE(PG8_SB(0, 0), cB, voffB); PG8_STAGE(PG8_SB(0, 1), cB + hstep, voffB); PG8_STAGE(PG8_SA(0, 0), cA, voffA); PG8_STAGE(PG8_SA(0, 1), cA + hstep, voffA);
        if (wr == 1) PG8_BAR;
        PG8_WAIT_V(2); PG8_BAR;
        PG8_STAGE(PG8_SB(1, 0), cB + kstep, voffB); PG8_STAGE(PG8_SA(1, 0), cA + kstep, voffA); PG8_STAGE(PG8_SB(1, 1), cB + hstep + kstep, voffB);
        PG8_WAIT_V(6); PG8_BAR;
    } else {
        PG8_STAGE(PG8_SB(0, 0), cB, voffB); PG8_STAGE(PG8_SA(0, 0), cA, voffA); PG8_STAGE(PG8_SB(0, 1), cB + hstep, voffB); PG8_STAGE(PG8_SA(0, 1), cA + hstep, voffA);
        if (wr == 1) PG8_BAR;
        PG8_WAIT_V(4); PG8_BAR;
        PG8_STAGE(PG8_SB(1, 0), cB + kstep, voffB); PG8_STAGE(PG8_SA(1, 0), cA + kstep, voffA); PG8_STAGE(PG8_SB(1, 1), cB + hstep + kstep, voffB);
        PG8_WAIT_V(6); PG8_BAR;
    }
    for (;;) {
        const bool has_next = S.next(ui + 1, nxt);
        const char* nA = has_next ? (const char*)g.A + (size_t)nxt.pm * tstep : cA; const char* nB = has_next ? (const char*)g.Bt + (size_t)nxt.pn * tstep : cB;
#pragma unroll 1
        for (int t = 0; t < nt; t += 2) {
            const bool last = (t == nt - 2);
            const char* a1 = cA + (size_t)(t + 1) * kstep;
            const char* a2 = last ? nA : cA + (size_t)(t + 2) * kstep; const char* b2 = last ? nB : cB + (size_t)(t + 2) * kstep;
            const char* a3 = a2 + kstep; const char* b3 = b2 + kstep;
            if (last && has_next) S.a_ready(nxt);
            if constexpr (SP2) {
            PG8_LDB(B0, 0, 0); PG8_LDB(B1, 0, 1); PG8_SCHED; PG8_LDA(At, 0, 0); PG8_STAGE(PG8_SA(1, 1), a1 + hstep, voffA);
            PG8_WAIT_V(8); PG8_WAIT_L(0); PG8_BAR; PG8_MMA(0, 0, At, B0); PG8_MMA(0, 1, At, B1); PG8_BAR; PG8_SCHED;
            PG8_LDA(At, 0, 1); PG8_STAGE(PG8_SB(0, 0), b2, voffB); PG8_STAGE(PG8_SB(0, 1), b2 + hstep, voffB); PG8_STAGE(PG8_SA(0, 0), a2, voffA);
            PG8_WAIT_V(8); PG8_WAIT_L(0); PG8_BAR; PG8_MMA(1, 0, At, B0); PG8_MMA(1, 1, At, B1); PG8_BAR; PG8_SCHED;
            PG8_LDB(B0, 1, 0); PG8_LDB(B1, 1, 1); PG8_SCHED; PG8_LDA(At, 1, 0); PG8_STAGE(PG8_SA(0, 1), a2 + hstep, voffA);
            PG8_WAIT_V(8); PG8_WAIT_L(0); PG8_BAR; PG8_MMA(0, 0, At, B0); PG8_MMA(0, 1, At, B1); PG8_BAR; PG8_SCHED;
            PG8_LDA(At, 1, 1); PG8_STAGE(PG8_SB(1, 0), b3, voffB); PG8_STAGE(PG8_SB(1, 1), b3 + hstep, voffB); PG8_STAGE(PG8_SA(1, 0), a3, voffA);
            PG8_WAIT_V(8); PG8_WAIT_L(0); PG8_BAR; PG8_MMA(1, 0, At, B0); PG8_MMA(1, 1, At, B1); PG8_BAR; PG8_SCHED;
            } else {
            PG8_LDB(B0, 0, 0); PG8_SCHED; PG8_LDA(At, 0, 0); PG8_STAGE(PG8_SA(1, 1), a1 + hstep, voffA);
            PG8_WAIT_L(8); PG8_BAR; PG8_WAIT_L(0); PG8_MMA(0, 0, At, B0); PG8_BAR; PG8_SCHED;
            PG8_LDB(B1, 0, 1); PG8_STAGE(PG8_SB(0, 0), b2, voffB);
            PG8_BAR; PG8_WAIT_L(0); PG8_MMA(0, 1, At, B1); PG8_BAR;
            PG8_LDA(At, 0, 1); PG8_STAGE(PG8_SA(0, 0), a2, voffA);
            PG8_BAR; PG8_WAIT_L(0); PG8_MMA(1, 0, At, B0); PG8_BAR; PG8_SCHED;
            PG8_STAGE(PG8_SB(0, 1), b2 + hstep, voffB);
            PG8_WAIT_V(6); PG8_BAR; PG8_MMA(1, 1, At, B1); PG8_BAR;
            PG8_LDB(B0, 1, 0); PG8_SCHED; PG8_LDA(At, 1, 0); PG8_STAGE(PG8_SA(0, 1), a2 + hstep, voffA);
            PG8_WAIT_L(8); PG8_BAR; PG8_WAIT_L(0); PG8_MMA(0, 0, At, B0); PG8_BAR; PG8_SCHED;
            PG8_LDB(B1, 1, 1); PG8_STAGE(PG8_SB(1, 0), b3, voffB);
            PG8_BAR; PG8_WAIT_L(0); PG8_MMA(0, 1, At, B1); PG8_BAR;
            PG8_LDA(At, 1, 1); PG8_STAGE(PG8_SA(1, 0), a3, voffA);
            PG8_BAR; PG8_WAIT_L(0); PG8_MMA(1, 0, At, B0); PG8_BAR; PG8_SCHED;
            PG8_STAGE(PG8_SB(1, 1), b3 + hstep, voffB);
            PG8_WAIT_V(6); PG8_BAR; PG8_MMA(1, 1, At, B1); PG8_BAR;
            }
        }
        if constexpr (ALIGN_EPI) { if (wr == 0) PG8_BAR; }
        if constexpr (F8) asm volatile("s_nop 15\n\ts_nop 15" ::: "memory");
        bool keep_acc = false;
        if constexpr (Epi::INPLACE) { keep_acc = E.inplace(acc, cur, wr, wc, fr, fq); S.done(cur); }
        else if constexpr (!Epi::AFTER_DRAIN) { E(acc, cur, wr, wc, fr, fq); S.done(cur); }
        if (!has_next) break;
        if (!keep_acc)
#pragma unroll
        for (int a = 0; a < 2; ++a)
#pragma unroll
            for (int b = 0; b < 2; ++b)
#pragma unroll
                for (int m = 0; m < 4; ++m)
#pragma unroll
                    for (int n = 0; n < 2; ++n) acc[a][b][m][n] = (f32x4){0.f, 0.f, 0.f, 0.f};
        cur = nxt; cA = nA; cB = nB; ++ui;
        if constexpr (ALIGN_EPI) { if (wr == 1) PG8_BAR; }
    }
    PG8_WAIT_V(0);
    if constexpr (!ALIGN_EPI) { if (wr == 0) PG8_BAR; }
    PG8_BAR;
    if constexpr (Epi::AFTER_DRAIN) { E.fused(acc, cur, wr, wc, fr, fq, lds, wid, lane); S.done(cur); }
#undef PG8_SA
#undef PG8_SB
#undef PG8_STAGE
#undef PG8_LDA
#undef PG8_LDB
#undef PG8_MMA
#undef PG8_WAIT_V
#undef PG8_WAIT_L
#undef PG8_BAR
#undef PG8_SCHED
}
}
#define GAS __attribute__((address_space(1)))
#define LAS __attribute__((address_space(3)))
typedef unsigned short bf16;
typedef unsigned v4u __attribute__((ext_vector_type(4)));
typedef float f32x4 __attribute__((ext_vector_type(4)));
typedef short bf16x8 __attribute__((ext_vector_type(8)));
typedef GAS unsigned gu32;
typedef GAS unsigned long long gu64;
#define RLX_AGENT __ATOMIC_RELAXED, __HIP_MEMORY_SCOPE_AGENT
#define LDS_WAIT() asm volatile("s_waitcnt lgkmcnt(0)" ::: "memory")
#define VM_WAIT() asm volatile("s_waitcnt vmcnt(0)" ::: "memory")
__device__ __forceinline__ unsigned long long rt() { return __builtin_amdgcn_s_memrealtime(); }
__device__ __forceinline__ unsigned f2bf(float f) { unsigned u = __builtin_bit_cast(unsigned, f); return (u + 0x7fffu + ((u >> 16) & 1u)) >> 16; }
__device__ __forceinline__ unsigned pk2(float lo, float hi) { return pg8::cvt_pk_bf16(lo, hi); }

#define XB_TMO      128
#define XB_XCNT(j)  (256  + 64 * (j))
#define XB_XSUB(j)  (1280 + 64 * (j))
#define XB_XGEN(j)  (2304 + 64 * (j))
#define XB_TOP      3328
#define XB_TOPGEN   3392
#define XCD_BAR_WORDS 3456
#define XB_SPIN_CAP (1u << 18)

__device__ __forceinline__ unsigned xb_ld(unsigned* p)              { return __hip_atomic_load(p, __ATOMIC_RELAXED, __HIP_MEMORY_SCOPE_AGENT); }
__device__ __forceinline__ unsigned xb_add(unsigned* p, unsigned v) { return __hip_atomic_fetch_add(p, v, __ATOMIC_RELAXED, __HIP_MEMORY_SCOPE_AGENT); }
__device__ __forceinline__ unsigned xb_xcc_id() { return (unsigned)__builtin_amdgcn_s_getreg((3 << 11) | 20) & 0xFu; }
#define XB_SPIN(cond, bar) do { unsigned _sp = 0; while (cond) { __builtin_amdgcn_s_sleep(1); \
    if ((++_sp & 255u) == 0u) { if (xb_ld(&(bar)[XB_TMO])) break; if (_sp > XB_SPIN_CAP) { atomicAdd(&(bar)[XB_TMO], 1u); break; } } } } while (0)

struct XcdBarrier {
    unsigned* bar; unsigned x;
    volatile LAS unsigned* st;
};

__device__ __forceinline__ XcdBarrier xcd_barrier_post(unsigned* bar, volatile LAS unsigned* st) {
    XcdBarrier b; b.bar = bar; b.x = xb_xcc_id(); b.st = st;
    if (threadIdx.x == 0) (void)xb_add(&bar[XB_XCNT(b.x)], 1u);
    return b;
}
__device__ __forceinline__ void xcd_barrier_complete(unsigned* bar, unsigned x, unsigned& nloc, unsigned& nx) {
    const unsigned G = gridDim.x * gridDim.y * gridDim.z;
    unsigned sum, cnt, mine, sp = 0u;
    for (;;) {
        sum = 0u; cnt = 0u; mine = 0u;
#pragma unroll
        for (unsigned j = 0; j < 16; ++j) { const unsigned c = xb_ld(&bar[XB_XCNT(j)]); sum += c; cnt += (c > 0u) ? 1u : 0u; mine = (j == x) ? c : mine; }
        if (sum == G) break;
        __builtin_amdgcn_s_sleep(1);
        if ((++sp & 255u) == 0u) { if (xb_ld(&bar[XB_TMO])) break; if (sp > XB_SPIN_CAP) { atomicAdd(&bar[XB_TMO], 1u); break; } }
    }
    nloc = mine > 0u ? mine : 1u; nx = cnt > 0u ? cnt : 1u;
}

__device__ __forceinline__ void xcd_barrier(const XcdBarrier& b) {
    asm volatile("s_waitcnt vmcnt(0)" ::: "memory");
    __syncthreads();
    if (threadIdx.x == 0) {
        unsigned* bar = b.bar;
        __builtin_amdgcn_s_waitcnt(0);
        unsigned nloc = b.st[0], nx = b.st[1];
        if (nloc == 0u) { xcd_barrier_complete(bar, b.x, nloc, nx); b.st[0] = nloc; b.st[1] = nx; }
        const unsigned old = xb_add(&bar[XB_XSUB(b.x)], 1u);
        const unsigned gen = old / nloc;
        if (old + 1u == (gen + 1u) * nloc) {
            __builtin_amdgcn_fence(__ATOMIC_RELEASE, "agent");
            asm volatile("s_waitcnt vmcnt(0)" ::: "memory");
            const unsigned og = xb_add(&bar[XB_TOP], 1u);
            const unsigned tg = og / nx;
            if (og + 1u == (tg + 1u) * nx) xb_add(&bar[XB_TOPGEN], 1u);
            else XB_SPIN(xb_ld(&bar[XB_TOPGEN]) == tg, bar);
            __builtin_amdgcn_fence(__ATOMIC_ACQUIRE, "agent");
            xb_add(&bar[XB_XGEN(b.x)], 1u);
            asm volatile("s_waitcnt vmcnt(0)" ::: "memory");
        } else {
            XB_SPIN(xb_ld(&bar[XB_XGEN(b.x)]) == gen, bar);
            __builtin_amdgcn_fence(__ATOMIC_ACQUIRE, "agent");
            asm volatile("s_waitcnt vmcnt(0)" ::: "memory");
        }
    }
    __syncthreads();
}

typedef float f32x16 __attribute__((ext_vector_type(16)));
typedef short s16x4 __attribute__((ext_vector_type(4)));
typedef unsigned v2u __attribute__((ext_vector_type(2)));
#define MFMA32(a, b, c) __builtin_amdgcn_mfma_f32_32x32x16_bf16((a), (b), (c), 0, 0, 0)

constexpr int NWAVES = 8, NTHREADS = 512;
constexpr int D = 1024, NB = 32, SEQ = 2048, LC = 256, NTOK = NB * SEQ, NCTX = NB * LC, NROW = NTOK + NCTX;
constexpr int INC = 6912, QKVC = 2304, CINC = 1536, GATEC = 3072, DFF = 2816, NEXP = 8, DFFE = 3584, FCH = 1792;
constexpr float W13_SCALE = 32.f, W2_SCALE = 64.f, HID_SCALE = 4.f;
constexpr float LOG2E = 1.4426950408889634f, QSCALE = 0.125f * LOG2E, EPS = 1e-6f;
constexpr int PCAP = 32768 * 2 + 8 * 256;

constexpr size_t MiB = 1u << 20;
constexpr size_t WS_CTL = 0, CTL_ZERO_BYTES = 1 * MiB;
constexpr size_t WS_MODV = 1 * MiB;
constexpr size_t WS_ROPE = 3 * MiB;
constexpr size_t WS_ROUTE = 4 * MiB;
constexpr size_t WS_LIST = 5 * MiB;
constexpr size_t WS_INV = 7 * MiB;
constexpr size_t WS_GF = 8 * MiB;
constexpr size_t WS_GFC = 24 * MiB;
constexpr size_t WS_W = 26 * MiB;
constexpr size_t W_IN = WS_W;
constexpr size_t W_CB = W_IN + (size_t)2 * INC * D;
constexpr size_t W_BR = W_IN + (size_t)2 * INC * D * 2;
constexpr size_t W_OUT = W_BR + (size_t)2 * 3 * D * 512 * 2;
constexpr size_t W_F13 = W_OUT + (size_t)2 * D * D * 2;
constexpr size_t W_F2 = W_F13 + (size_t)2 * DFF * D * 2;
constexpr size_t W_END = W_F2 + (size_t)D * DFF * 2;
constexpr size_t WS_CTXRES = 80 * MiB;
constexpr size_t WS_H = 112 * MiB;
constexpr size_t WS_BIG = 256 * MiB;
constexpr size_t BIG_CINT = WS_BIG;
constexpr size_t BIG_QKV = WS_BIG + 216 * MiB;
constexpr size_t BIG_GATE = WS_BIG + 72 * MiB;
constexpr size_t BIG_YCT = WS_BIG + 288 * MiB;
constexpr size_t BIG_HID = WS_BIG;
constexpr size_t BIG_RAW = WS_BIG;
constexpr size_t BIG_AS = WS_BIG;
constexpr size_t BIG_MH = WS_BIG + 68 * MiB;
constexpr size_t BIG_Y2S = WS_BIG + 300 * MiB;
constexpr size_t WS_Y3 = 796 * MiB;
constexpr size_t WM_13 = WS_Y3;
constexpr size_t WM_2 = WS_Y3 + 56 * MiB;
constexpr size_t WS_H8 = WS_Y3 + 144 * MiB;
constexpr size_t WS_END = 1012 * MiB;
static_assert(W_END <= WS_CTXRES && BIG_Y2S + (size_t)PCAP * D * 2 <= WS_Y3 && BIG_QKV + (size_t)NROW * QKVC * 2 <= WS_Y3 && BIG_GATE + (size_t)NROW * GATEC <= WS_Y3, "ws map");
static_assert(BIG_MH + (size_t)PCAP * DFFE <= BIG_Y2S && BIG_AS + (size_t)PCAP * D <= BIG_MH && WM_13 + (size_t)8 * 2 * DFFE * D <= WM_2 && WM_2 + (size_t)8 * D * DFFE <= WS_END, "ws map 2");

constexpr int CW_BAR = 4096;
constexpr int CW_CNT = 16384;

constexpr int LDS_BYTES = 150528, MISC_OFF = 147456;


struct Args {
    const float* in[31];
    float* out; unsigned char* ws;
    int ph_lo, ph_hi, sub_mask, pad;
};
enum { I_X = 0, I_C, I_CTX, I_CCTX, I_WMOD, I_BMOD, I_GMIXPRE, I_GMIXPOST, I_GFFNPRE, I_GFFNPOST, I_WIN, I_SINK, I_RPB, I_CONVW, I_CONVB, I_HW1, I_HB1, I_HW2, I_HB2, I_HW3,
       I_HFREQ, I_HBIAS, I_WBR, I_WOUT, I_FW1, I_FW3, I_FW2, I_ROUTER, I_MW1, I_MW3, I_MW2 };

struct Frame {
    LAS unsigned char* lds;
    int tid, lane, wave, vcu, G;
    unsigned char* ws;
};

__device__ __forceinline__ float wave_sum(float v) {
#pragma unroll
    for (int o = 1; o < 64; o <<= 1) v += __shfl_xor(v, o);
    return v;
}
__device__ __forceinline__ float bf2f(bf16 b) { return __builtin_bit_cast(float, ((unsigned)b) << 16); }
__device__ __forceinline__ float silu_f(float x) { return x / (1.0f + __expf(-x)); }

__device__ __forceinline__ void transpose_item(const float* W, int N, bf16* WT, int Kp, int k0, int n0, int drow0, LAS float* scr, int lane) {
    { const int c4 = 4 * (lane & 7);
#pragma unroll
      for (int i = 0; i < 8; ++i) { const int kk = (lane >> 3) + 8 * i; const f32x4 v = *(const f32x4*)(W + (size_t)(k0 + kk) * N + n0 + c4); LAS float* d = scr + kk * 33 + c4; d[0] = v.x; d[1] = v.y; d[2] = v.z; d[3] = v.w; } }
    LDS_WAIT(); asm volatile("" ::: "memory");
    const int c = lane & 7;
#pragma unroll
    for (int j = 0; j < 4; ++j) { const int n = (lane >> 3) + 8 * j; const LAS float* s = scr + (8 * c) * 33 + n;
        v4u o; o.x = pk2(s[0 * 33], s[1 * 33]); o.y = pk2(s[2 * 33], s[3 * 33]); o.z = pk2(s[4 * 33], s[5 * 33]); o.w = pk2(s[6 * 33], s[7 * 33]);
        *(GAS v4u*)(WT + (size_t)(drow0 + n) * Kp + k0 + 8 * c) = o; }
    LDS_WAIT(); asm volatile("" ::: "memory");
}
__device__ __forceinline__ bool conv_job(int& r, const float* W, int K, int N, bf16* WT, int Kp, int rowoff, int mode, int which, LAS float* scr, int lane) {
    const int nblk = N / 32, items = (K / 64) * nblk;
    if (r >= items) { r -= items; return false; }
    const int kb = r / nblk, nb = r % nblk, n0 = 32 * nb;
    const int drow0 = mode ? rowoff + (n0 / 128) * 256 + which * 128 + (n0 % 128) : rowoff + n0;
    transpose_item(W, N, WT, Kp, 64 * kb, n0, drow0, scr, lane);
    return true;
}

__device__ __forceinline__ void transpose_item_f8(const float* W, int N, unsigned char* WT, int Kp, int k0, int n0, int drow0, float scale, LAS float* scr, int lane) {
    { const int c4 = 4 * (lane & 7);
#pragma unroll
      for (int i = 0; i < 8; ++i) { const int kk = (lane >> 3) + 8 * i; const f32x4 v = *(const f32x4*)(W + (size_t)(k0 + kk) * N + n0 + c4) * scale; LAS float* d = scr + kk * 33 + c4; d[0] = v.x; d[1] = v.y; d[2] = v.z; d[3] = v.w; } }
    LDS_WAIT(); asm volatile("" ::: "memory");
    const int c = lane & 7;
#pragma unroll
    for (int j = 0; j < 4; ++j) { const int n = (lane >> 3) + 8 * j; const LAS float* s = scr + (8 * c) * 33 + n;
        v2u o; o.x = pg8::pack_fp8x4(s[0 * 33], s[1 * 33], s[2 * 33], s[3 * 33]); o.y = pg8::pack_fp8x4(s[4 * 33], s[5 * 33], s[6 * 33], s[7 * 33]);
        *(GAS v2u*)(WT + (size_t)(drow0 + n) * Kp + k0 + 8 * c) = o; }
    LDS_WAIT(); asm volatile("" ::: "memory");
}
__device__ __forceinline__ bool conv_job_f8(int& r, const float* W, int K, int N, unsigned char* WT, int Kp, int mode, int which, float scale, LAS float* scr, int lane) {
    const int nblk = N / 32, items = (K / 64) * nblk;
    if (r >= items) { r -= items; return false; }
    const int kb = r / nblk, nb = r % nblk, n0 = 32 * nb;
    const int drow0 = mode ? (n0 / 128) * 256 + which * 128 + (n0 % 128) : n0;
    transpose_item_f8(W, N, WT, Kp, 64 * kb, n0, drow0, scale, scr, lane);
    return true;
}

__device__ __forceinline__ void ld_row_f32(const float* p, int lane, f32x4 (&v)[4]) {
    const GAS f32x4* q = (const GAS f32x4*)p + lane;
#pragma unroll
    for (int j = 0; j < 4; ++j) v[j] = q[64 * j];
}
__device__ __forceinline__ void st_row_f32(float* p, int lane, const f32x4 (&v)[4]) {
    GAS f32x4* q = (GAS f32x4*)p + lane;
#pragma unroll
    for (int j = 0; j < 4; ++j) q[64 * j] = v[j];
}
__device__ __forceinline__ void ld_row_bf16(const bf16* p, int lane, f32x4 (&v)[4]) {
    const GAS v2u* q = (const GAS v2u*)p + lane;
#pragma unroll
    for (int j = 0; j < 4; ++j) { const v2u w = q[64 * j]; v[j] = (f32x4){pg8::bf_lo(w.x), pg8::bf_hi(w.x), pg8::bf_lo(w.y), pg8::bf_hi(w.y)}; }
}
__device__ __forceinline__ void ld_row_f32_nt(const float* p, int lane, f32x4 (&v)[4]) {
    const GAS f32x4* q = (const GAS f32x4*)p + lane;
#pragma unroll
    for (int j = 0; j < 4; ++j) v[j] = __builtin_nontemporal_load(q + 64 * j);
}
__device__ __forceinline__ void st_row_f32_nt(float* p, int lane, const f32x4 (&v)[4]) {
    GAS f32x4* q = (GAS f32x4*)p + lane;
#pragma unroll
    for (int j = 0; j < 4; ++j) __builtin_nontemporal_store(v[j], q + 64 * j);
}
__device__ __forceinline__ void ld_raw_bf16_nt(const bf16* p, int lane, v2u (&v)[4]) {
    const GAS v2u* q = (const GAS v2u*)p + lane;
#pragma unroll
    for (int j = 0; j < 4; ++j) v[j] = __builtin_nontemporal_load(q + 64 * j);
}
__device__ __forceinline__ void ld_raw_bf16(const bf16* p, int lane, v2u (&v)[4]) {
    const GAS v2u* q = (const GAS v2u*)p + lane;
#pragma unroll
    for (int j = 0; j < 4; ++j) v[j] = q[64 * j];
}
__device__ __forceinline__ f32x4 cvt_raw_bf16(v2u w) { return (f32x4){pg8::bf_lo(w.x), pg8::bf_hi(w.x), pg8::bf_lo(w.y), pg8::bf_hi(w.y)}; }
__device__ __forceinline__ void st_row_bf16(bf16* p, int lane, const f32x4 (&v)[4]) {
    GAS v2u* q = (GAS v2u*)p + lane;
#pragma unroll
    for (int j = 0; j < 4; ++j) { v2u w; w.x = pk2(v[j].x, v[j].y); w.y = pk2(v[j].z, v[j].w); q[64 * j] = w; }
}
__device__ __forceinline__ float row_rms_scale(const f32x4 (&v)[4]) {
    float s = 0.f;
#pragma unroll
    for (int j = 0; j < 4; ++j) s += (v[j].x * v[j].x + v[j].y * v[j].y) + (v[j].z * v[j].z + v[j].w * v[j].w);
    return __builtin_amdgcn_rsqf(wave_sum(s) * (1.0f / D) + EPS);
}
__device__ __forceinline__ void norm_mod(const f32x4 (&x)[4], const float* g, const float* sc, const float* sh, int lane, f32x4 (&h)[4]) {
    const float rs = row_rms_scale(x);
    f32x4 gv[4], scv[4], shv[4]; ld_row_f32(g, lane, gv); ld_row_f32(sc, lane, scv); ld_row_f32(sh, lane, shv);
#pragma unroll
    for (int j = 0; j < 4; ++j) h[j] = (x[j] * rs) * gv[j] * (scv[j] + 1.0f) + shv[j];
}
__device__ __forceinline__ void resid_update(f32x4 (&x)[4], const f32x4 (&y)[4], const float* g, const float* gt, int lane) {
    const float rs = row_rms_scale(y);
    f32x4 gv[4], gtv[4]; ld_row_f32(g, lane, gv); ld_row_f32(gt, lane, gtv);
#pragma unroll
    for (int j = 0; j < 4; ++j) x[j] = x[j] + gtv[j] * ((y[j] * rs) * gv[j]);
}
__device__ __forceinline__ const float* modv(const Frame& F, int l, int row, int part) {
    const int r = row < NTOK ? (row >> 11) : 32;
    return (const float*)(F.ws + WS_MODV) + ((size_t)l * 33 + r) * 6144 + part * 1024;
}

__device__ __forceinline__ void p0_prologue(Frame& F, const Args& a) {
    const int gw = F.vcu * NWAVES + F.wave, NGW = F.G * NWAVES;
    if (F.vcu < 192) {
        LAS float* sl = (LAS float*)F.lds;
        for (int i = F.tid; i < 33 * 1024; i += NTHREADS) { const int r = i >> 10, k = i & 1023; const float cv = r < 32 ? a.in[I_C][r * 1024 + k] : a.in[I_CCTX][k]; sl[k * 33 + r] = silu_f(cv); }
        __syncthreads();
        const int col = F.vcu * 64 + F.lane, l = col / 6144, n = col % 6144, k0 = F.wave * 128;
        const float* w = a.in[I_WMOD] + ((size_t)l * 1024 + k0) * 6144 + n;
        float acc[33];
#pragma unroll
        for (int r = 0; r < 33; ++r) acc[r] = 0.f;
#pragma unroll 4
        for (int k = 0; k < 128; ++k) { const float wv = w[(size_t)k * 6144]; const LAS float* sr = sl + (k0 + k) * 33;
#pragma unroll
            for (int r = 0; r < 33; ++r) acc[r] += sr[r] * wv; }
        __syncthreads();
#pragma unroll
        for (int r = 0; r < 33; ++r) sl[(F.wave * 33 + r) * 64 + F.lane] = acc[r];
        __syncthreads();
        const float* bmod = a.in[I_BMOD]; float* mo = (float*)(F.ws + WS_MODV);
        for (int o = F.tid; o < 33 * 64; o += NTHREADS) { const int r = o >> 6, j = o & 63; float s = 0.f;
#pragma unroll
            for (int wv = 0; wv < 8; ++wv) s += sl[(wv * 33 + r) * 64 + j];
            const int cc = F.vcu * 64 + j, ll = cc / 6144, nn = cc % 6144; mo[((size_t)ll * 33 + r) * 6144 + nn] = s + bmod[ll * 6144 + nn]; }
        __syncthreads();
    }
    if (F.vcu == 200) {
        float* rp = (float*)(F.ws + WS_ROPE);
        for (int i = F.tid; i < 1024; i += NTHREADS) { const int pos = i >> 4, k = i & 15; const float inv = powf(10000.0f, -(float)k / 16.0f); const float ang = (float)pos * inv; rp[i] = cosf(ang); rp[1024 + i] = sinf(ang); }
    }
    for (int it = F.vcu; it < 512; it += F.G) {
        const int lv = it >> 8, l = lv ? 0 : ((it >> 7) & 1), L = lv ? LC : SEQ, pos0 = lv ? (it & 255) : 16 * (it & 127), npos = lv ? 1 : 16;
        LAS float* z = (LAS float*)F.lds; LAS float* h1 = z + 16 * 33; LAS float* h2 = h1 + 16 * 64;
        __syncthreads();
        for (int i = F.tid; i < 16 * 33; i += NTHREADS) { const int p = i / 33, k = i % 33; const int pos = pos0 + p; float v;
            const float om = 6.283185307179586f * (float)pos / (float)L;
            if (k == 0) v = (float)pos / (float)(L - 1);
            else { const int m = (k - 1) & 15; const float f = 1e-4f + (15.0f - 1e-4f) * (float)m / 15.0f; v = (k <= 16) ? cosf(f * om) : -sinf(f * om); }
            z[i] = v; }
        __syncthreads();
        const float* w1 = a.in[I_HW1] + l * 33 * 64; const float* b1 = a.in[I_HB1] + l * 64; const float* w2 = a.in[I_HW2] + l * 64 * 64; const float* b2 = a.in[I_HB2] + l * 64;
        const float* fr = a.in[I_HFREQ] + l * 64; const float* w3 = a.in[I_HW3] + (size_t)l * 64 * 2048;
        for (int o = F.tid; o < 1024; o += NTHREADS) { const int p = o >> 6, j = o & 63; float s = b1[j];
            for (int k = 0; k < 33; ++k) s += z[p * 33 + k] * w1[k * 64 + j];
            h1[o] = sinf(fr[j] * s); }
        __syncthreads();
        for (int o = F.tid; o < 1024; o += NTHREADS) { const int p = o >> 6, j = o & 63; float s = b2[j];
            for (int k = 0; k < 64; ++k) s += h1[p * 64 + k] * w2[k * 64 + j];
            h2[o] = sinf(fr[j] * s); }
        __syncthreads();
        float* raw = (float*)(F.ws + BIG_RAW) + (size_t)l * (2048 * (SEQ + LC)) + (lv ? (size_t)2048 * SEQ : 0);
        {
            const int col0 = 4 * F.tid;
            float acc[4][16];
#pragma unroll
            for (int c4 = 0; c4 < 4; ++c4)
#pragma unroll
                for (int p = 0; p < 16; ++p) acc[c4][p] = 0.f;
#pragma unroll 4
            for (int k = 0; k < 64; ++k) { const f32x4 wv = *(const f32x4*)(w3 + k * 2048 + col0);
#pragma unroll
                for (int p = 0; p < 16; ++p) { const float hv = h2[p * 64 + k]; acc[0][p] += hv * wv.x; acc[1][p] += hv * wv.y; acc[2][p] += hv * wv.z; acc[3][p] += hv * wv.w; } }
            const float da = -3.0701134573253945f, db = -15.350567286626973f;
#pragma unroll
            for (int c4 = 0; c4 < 4; ++c4) { const int col = col0 + c4, cch = col & 511;
                const float delta = fabsf(da + (db - da) * (float)cch / 511.0f);
#pragma unroll
                for (int p = 0; p < 16; ++p) if (p < npos) { const float t = (float)(pos0 + p) / (float)(L - 1); raw[(size_t)col * L + pos0 + p] = acc[c4][p] * __expf(-t * delta); } }
        }
    }
    __syncthreads();
    LAS float* scr = (LAS float*)(F.lds + F.wave * 16384);
    constexpr int PER_LAYER = 16 * 216 + 16 * 48 + 3 * 256 + 512, NITEMS = 2 * PER_LAYER + 3 * 1408;
    for (int it = gw; it < NITEMS; it += NGW) {
        int r = it;
        bool dn = false;
#pragma unroll 1
        for (int l = 0; l < 2; ++l) {
            if (!dn) dn = conv_job_f8(r, a.in[I_WIN] + (size_t)l * D * INC, D, INC, F.ws + W_IN + (size_t)l * INC * D, D, 0, 0, W13_SCALE, scr, F.lane);
            if (!dn) { const int items = 16 * 48;
                if (r < items) { const int kb = r / 48, nb = r % 48; transpose_item(a.in[I_WIN] + (size_t)l * D * INC + QKVC, INC, (bf16*)(F.ws + W_CB) + (size_t)l * CINC * D, D, 64 * kb, 32 * nb, 32 * nb, scr, F.lane); dn = true; } else r -= items; }
#pragma unroll 1
            for (int br = 0; br < 3; ++br)
                if (!dn) dn = conv_job(r, a.in[I_WBR] + (size_t)(l * 3 + br) * 512 * D, 512, D, (bf16*)(F.ws + W_BR) + (size_t)(l * 3 + br) * D * 512, 512, 0, 0, 0, scr, F.lane);
            if (!dn) dn = conv_job(r, a.in[I_WOUT] + (size_t)l * D * D, D, D, (bf16*)(F.ws + W_OUT) + (size_t)l * D * D, D, 0, 0, 0, scr, F.lane);
        }
        if (!dn) dn = conv_job(r, a.in[I_FW1], D, DFF, (bf16*)(F.ws + W_F13), D, 0, 1, 0, scr, F.lane);
        if (!dn) dn = conv_job(r, a.in[I_FW3], D, DFF, (bf16*)(F.ws + W_F13), D, 0, 1, 1, scr, F.lane);
        if (!dn) dn = conv_job(r, a.in[I_FW2], DFF, D, (bf16*)(F.ws + W_F2), DFF, 0, 0, 0, scr, F.lane);
    }
}

__device__ __forceinline__ void p1_phase(Frame& F, const Args& a) {
    const int gw = F.vcu * NWAVES + F.wave, NGW = F.G * NWAVES;
    for (int u = gw; u < 2 * 2 * 1024; u += NGW) {
        const int l = u >> 11, lv = (u >> 10) & 1, o = (u >> 9) & 1, c = u & 511, L = lv ? LC : SEQ;
        if (l == 1 && lv == 1) continue;
        const float* raw = (const float*)(F.ws + BIG_RAW) + (size_t)l * (2048 * (SEQ + LC)) + (lv ? (size_t)2048 * SEQ : 0);
        const float* rf = raw + (size_t)(o * 512 + c) * L; const float* rb = raw + (size_t)(1024 + o * 512 + c) * L;
        float sf = 0.f, sb = 0.f;
        for (int t = F.lane; t < L; t += 64) { const float x = rf[t], y = rb[t]; sf += x * x; sb += y * y; }
        const float nf = 1.0f / sqrtf(wave_sum(sf) + EPS), nb = 1.0f / sqrtf(wave_sum(sb) + EPS);
        bf16* g = lv ? (bf16*)(F.ws + WS_GFC) + ((size_t)(l * 2 + o) * 512 + c) * (2 * LC) : (bf16*)(F.ws + WS_GF) + ((size_t)(l * 2 + o) * 512 + c) * (2 * SEQ);
        for (int i = F.lane; i < 2 * L; i += 64) { const int d = i - L; float v;
            if (i == 0) v = 0.f; else if (d > 0) v = rf[d] * nf; else if (d < 0) v = rb[-d] * nb; else v = rf[0] * nf + rb[0] * nb;
            g[i] = (bf16)f2bf(v); }
    }
}

constexpr float ATT_THR = 8.0f;
constexpr int ATT_KP = 144, ATT_VP = 136;
constexpr int ATT_K_OFF = 0, ATT_V_OFF = 64 * ATT_KP, ATT_BUF = 17920, ATT_RPB_OFF = 36864;
constexpr int ATT_T0_BYTES = 15 * 128 * 4, ATT_E_OFF = ATT_RPB_OFF + ATT_T0_BYTES, ATT_TBL_FLOATS = 15 * 128 + 15 * 15 * 64;
__device__ __forceinline__ int crow(int reg, int h) { return (reg & 3) + 8 * (reg >> 2) + 4 * h; }
__device__ __forceinline__ int rs_of(int r) { const int v = r - 4; return v < 0 ? 0 : (v > 24 ? 24 : v); }
__device__ __forceinline__ unsigned cvtpk(float lo, float hi) { return pk2(lo, hi); }

template <int MODE, int SUB>
__device__ __forceinline__ void att_tile(LAS unsigned char* lds, int boff, const bf16x8 (&qf)[4], f32x16& negm, f32x16& O0, f32x16& O1, float& m_run, float& l_run,
                                         bool is_local, bool edge_mask, int kbase, int qt, int kr, int gr, int tb_base, int tb_pitch, int r, int h) {
#define A0(i) (SUB != 2 || (i) >= 12)
#define A1(i) (SUB != 1 || (i) < 4)
    f32x16 s0 = negm, s1 = negm;
#pragma unroll
    for (int s = 0; s < 4; ++s) {
        const bf16x8 k0 = *(const LAS bf16x8*)(lds + boff + ATT_K_OFF + r * ATT_KP + (16 * s + 8 * h) * 2);
        const bf16x8 k1 = *(const LAS bf16x8*)(lds + boff + ATT_K_OFF + (32 + r) * ATT_KP + (16 * s + 8 * h) * 2);
        s0 = MFMA32(k0, qf[s], s0); s1 = MFMA32(k1, qf[s], s1);
    }
    if (MODE == 0 && edge_mask) {
#pragma unroll
        for (int i = 0; i < 16; ++i) { const int j0 = kbase + crow(i, h), d0 = qt - j0, d1 = d0 - 32;
            if (d0 > 128 || d0 < -128) s0[i] = -1e30f;
            if (d1 > 128 || d1 < -128) s1[i] = -1e30f; }
    }
    if (MODE == 1 && is_local) {
        const LAS float* tb = (const LAS float*)(lds + tb_base + (kr - gr + 7) * tb_pitch);
        float b0[16], b1[16];
#pragma unroll
        for (int i = 0; i < 16; ++i) { const int c = (i & 3) + 8 * (i >> 2); b0[i] = tb[c]; b1[i] = tb[c + 32]; }
#pragma unroll
        for (int i = 0; i < 16; ++i) { s0[i] += b0[i]; s1[i] += b1[i]; }
    }
    float mx = -1e30f;
#pragma unroll
    for (int i = 0; i < 16; ++i) { if (A0(i)) mx = fmaxf(mx, s0[i]); if (A1(i)) mx = fmaxf(mx, s1[i]); }
    mx = fmaxf(mx, __shfl_xor(mx, 32));
    if (!__all(mx <= ATT_THR)) {
        const float delta = fmaxf(mx, 0.f), alpha = __builtin_amdgcn_exp2f(-delta);
        m_run += delta; l_run *= alpha;
#pragma unroll
        for (int i = 0; i < 16; ++i) { O0[i] *= alpha; O1[i] *= alpha; s0[i] -= delta; s1[i] -= delta; negm[i] = -m_run; }
    }
    float ls = 0.f;
#pragma unroll
    for (int i = 0; i < 16; ++i) { if (A0(i)) { s0[i] = __builtin_amdgcn_exp2f(s0[i]); ls += s0[i]; } else s0[i] = 0.f;
                                   if (A1(i)) { s1[i] = __builtin_amdgcn_exp2f(s1[i]); ls += s1[i]; } else s1[i] = 0.f; }
    l_run += ls;
    bf16x8 pf[2][2];
    { v4u t;
      t.x = cvtpk(s0[0], s0[1]); t.y = cvtpk(s0[2], s0[3]); t.z = cvtpk(s0[4], s0[5]); t.w = cvtpk(s0[6], s0[7]); pf[0][0] = __builtin_bit_cast(bf16x8, t);
      t.x = cvtpk(s0[8], s0[9]); t.y = cvtpk(s0[10], s0[11]); t.z = cvtpk(s0[12], s0[13]); t.w = cvtpk(s0[14], s0[15]); pf[0][1] = __builtin_bit_cast(bf16x8, t);
      t.x = cvtpk(s1[0], s1[1]); t.y = cvtpk(s1[2], s1[3]); t.z = cvtpk(s1[4], s1[5]); t.w = cvtpk(s1[6], s1[7]); pf[1][0] = __builtin_bit_cast(bf16x8, t);
      t.x = cvtpk(s1[8], s1[9]); t.y = cvtpk(s1[10], s1[11]); t.z = cvtpk(s1[12], s1[13]); t.w = cvtpk(s1[14], s1[15]); pf[1][1] = __builtin_bit_cast(bf16x8, t); }
#pragma unroll
    for (int i = 0; i < 2; ++i)
#pragma unroll
        for (int sp = 0; sp < 2; ++sp) {
            if ((SUB == 1 && i == 1 && sp == 1) || (SUB == 2 && i == 0 && sp == 0)) continue;
            const int koff = (32 * i + 16 * sp + 4 * h) * 2;
            const v2u a0 = *(const LAS v2u*)(lds + boff + ATT_V_OFF + r * ATT_VP + koff), a1 = *(const LAS v2u*)(lds + boff + ATT_V_OFF + r * ATT_VP + koff + 16);
            const v2u c0 = *(const LAS v2u*)(lds + boff + ATT_V_OFF + (32 + r) * ATT_VP + koff), c1 = *(const LAS v2u*)(lds + boff + ATT_V_OFF + (32 + r) * ATT_VP + koff + 16);
            const v4u va = (v4u){a0.x, a0.y, a1.x, a1.y}, vc = (v4u){c0.x, c0.y, c1.x, c1.y};
            O0 = MFMA32(__builtin_bit_cast(bf16x8, va), pf[i][sp], O0);
            O1 = MFMA32(__builtin_bit_cast(bf16x8, vc), pf[i][sp], O1);
        }
#undef A0
#undef A1
}

struct AttPre { v4u k, v; int valid; };
template <int MODE>
__device__ __forceinline__ void att_start(int u, int w, int r, int& qrow, int& qcol, int& kcol, int& vcol, int& trow0) {
    int b, head, kvh, q0 = 0, R = 0;
    if (MODE == 0) { b = u >> 6; kvh = (u >> 5) & 1; q0 = (u & 31) * 64; head = 4 * kvh + (w >> 1); }
    else if (MODE == 1) { b = u >> 6; head = (u >> 3) & 7; kvh = head; R = u & 7; }
    else if (MODE == 2) { b = u >> 3; kvh = (u >> 2) & 1; q0 = (u & 3) * 64; head = 4 * kvh + (w >> 1); }
    else { b = u >> 3; head = u & 7; kvh = head; }
    if (MODE == 0) qrow = b * SEQ + q0 + 32 * (w & 1) + r;
    else if (MODE == 1) qrow = b * SEQ + (4 * R + (w >> 1)) * 64 + 32 * (w & 1) + r;
    else if (MODE == 2) qrow = NTOK + b * LC + q0 + 32 * (w & 1) + r;
    else qrow = NTOK + b * LC + 32 * w + r;
    qcol = (MODE == 0 || MODE == 2) ? 1280 + head * 64 : 1792 + head * 64;
    kcol = (MODE == 0 || MODE == 2) ? kvh * 64 : 256 + head * 64;
    vcol = (MODE == 0 || MODE == 2) ? 128 + kvh * 64 : 768 + head * 64;
    if (MODE == 0) { const int lo = q0 < 128 ? (128 - q0) / 64 : 0; trow0 = b * SEQ + q0 - 128 + 64 * lo; }
    else if (MODE == 1) trow0 = b * SEQ + rs_of(4 * R) * 64;
    else trow0 = NTOK + b * LC;
}
template <int MODE>
__device__ __forceinline__ void attn_unit(Frame& F, int u, int u_next, const bf16* __restrict__ QKV, bf16* __restrict__ Yo, const float* sink, const float* rpb, AttPre& P, int& tbl_head, int var = 0) {
    const int w = F.wave, lane = F.lane, r = lane & 31, h = lane >> 5;
    LAS unsigned char* lds = F.lds;
    int b, head, kvh, q0 = 0, R = 0;
    if (MODE == 0) { b = u >> 6; kvh = (u >> 5) & 1; q0 = (u & 31) * 64; head = 4 * kvh + (w >> 1); }
    else if (MODE == 1) { b = u >> 6; head = (u >> 3) & 7; kvh = head; R = u & 7; }
    else if (MODE == 2) { b = u >> 3; kvh = (u >> 2) & 1; q0 = (u & 3) * 64; head = 4 * kvh + (w >> 1); }
    else { b = u >> 3; head = u & 7; kvh = head; }
    int qt, qrow, gr = 0, qc = 0;
    if (MODE == 0) { qt = q0 + 32 * (w & 1) + r; qrow = b * SEQ + qt; }
    else if (MODE == 1) { gr = 4 * R + (w >> 1); qc = 32 * (w & 1) + r; qt = gr * 64 + qc; qrow = b * SEQ + qt; }
    else if (MODE == 2) { qt = q0 + 32 * (w & 1) + r; qrow = NTOK + b * LC + qt; }
    else { qt = 32 * w + r; qrow = NTOK + b * LC + qt; }
    const int qcol = (MODE == 0 || MODE == 2) ? 1280 + head * 64 : 1792 + head * 64;
    const int kcol = (MODE == 0 || MODE == 2) ? kvh * 64 : 256 + head * 64;
    const int vcol = (MODE == 0 || MODE == 2) ? 128 + kvh * 64 : 768 + head * 64;
    bf16x8 qf[4];
#pragma unroll
    for (int s = 0; s < 4; ++s) qf[s] = *(const bf16x8*)(QKV + (size_t)qrow * QKVC + qcol + 16 * s + 8 * h);
    f32x16 O0, O1;
#pragma unroll
    for (int i = 0; i < 16; ++i) { O0[i] = 0.f; O1[i] = 0.f; }
    float m_run, l_run;
    if (MODE == 0 || MODE == 2) { m_run = sink[head] * LOG2E; l_run = (h == 0) ? 1.0f : 0.0f; } else { m_run = 0.f; l_run = 0.f; }
    f32x16 negm;
#pragma unroll
    for (int i = 0; i < 16; ++i) negm[i] = -m_run;
    int lo = 0, ntl = 0, kr_lo = 0;
    if (MODE == 0) { lo = q0 < 128 ? (128 - q0) / 64 : 0; const int hi = (SEQ - q0 + 128) / 64 < 5 ? (SEQ - q0 + 128) / 64 : 5; ntl = hi - lo; }
    if (MODE == 1) { kr_lo = rs_of(4 * R); ntl = rs_of(4 * R + 3) + 8 - kr_lo; }
    const int my_rs = rs_of(gr), my_cs = (qc - 8) < 0 ? 0 : ((qc - 8) > 48 ? 48 : (qc - 8));
    const int ntiles = ntl + 4;
    int tb_base = 0, tb_pitch = 0;
    if (MODE == 1) { const bool edge = qc < 8 || qc > 56; const int ev = qc < 8 ? qc : qc - 49;
        tb_base = edge ? ATT_E_OFF + ev * (15 * 256) + 16 * h : ATT_RPB_OFF + 4 * (63 - qc + 4 * h); tb_pitch = edge ? 256 : 512; }
    const int skey = F.tid >> 3, sch = F.tid & 7, vkey = F.tid & 63, vch = F.tid >> 6;
#define ATT_TROW(tt) ((tt) < ntl ? (MODE == 0 ? b * SEQ + q0 - 128 + 64 * (lo + (tt)) : b * SEQ + (kr_lo + (tt)) * 64) : NTOK + b * LC + 64 * ((tt) - ntl))
#define ATT_LOAD(tt) do { const int tr_ = ATT_TROW(tt); kreg = *(const v4u*)(QKV + (size_t)(tr_ + skey) * QKVC + kcol + 8 * sch); vreg = *(const v4u*)(QKV + (size_t)(tr_ + vkey) * QKVC + vcol + 8 * vch); } while (0)
#define ATT_STORE(bufoff) do { *(LAS v4u*)(lds + (bufoff) + ATT_K_OFF + skey * ATT_KP + sch * 16) = kreg; \
        LAS unsigned short* vt_ = (LAS unsigned short*)(lds + (bufoff) + ATT_V_OFF + (8 * vch) * ATT_VP + vkey * 2); \
        vt_[0 * (ATT_VP / 2)] = (unsigned short)(vreg.x & 0xffff); vt_[1 * (ATT_VP / 2)] = (unsigned short)(vreg.x >> 16); vt_[2 * (ATT_VP / 2)] = (unsigned short)(vreg.y & 0xffff); vt_[3 * (ATT_VP / 2)] = (unsigned short)(vreg.y >> 16); \
        vt_[4 * (ATT_VP / 2)] = (unsigned short)(vreg.z & 0xffff); vt_[5 * (ATT_VP / 2)] = (unsigned short)(vreg.z >> 16); vt_[6 * (ATT_VP / 2)] = (unsigned short)(vreg.w & 0xffff); vt_[7 * (ATT_VP / 2)] = (unsigned short)(vreg.w >> 16); } while (0)
    v4u& kreg = P.k; v4u& vreg = P.v;
    if (!P.valid) ATT_LOAD(0);
    P.valid = 0;
    __syncthreads();
    if (MODE == 1 && head != tbl_head) {
        tbl_head = head;
        LAS float* tb = (LAS float*)(lds + ATT_RPB_OFF);
        for (int i = F.tid; i < ATT_TBL_FLOATS; i += NTHREADS) {
            int dr, off; bool ok;
            if (i < 15 * 128) { dr = i >> 7; off = (i & 127) - 63; ok = off >= -8 && off <= 7; }
            else { const int j = i - 15 * 128, ev = j / (15 * 64), dr_ = (j >> 6) % 15, kc = j & 63, q = ev < 8 ? ev : ev + 49; dr = dr_; off = kc - q; ok = ev < 8 ? kc < 16 : kc >= 48; }
            tb[i] = ok ? rpb[(head * 15 + dr) * 31 + off + 15] * LOG2E : -1e30f;
        }
    }
    ATT_STORE(0);
    __syncthreads();
#pragma unroll 1
    for (int tt = 0; tt < ntiles; ++tt) {
        const bool is_local = tt < ntl;
        const int kbase = q0 - 128 + 64 * (lo + tt), kr = kr_lo + tt;
        const int boff = (tt & 1) * ATT_BUF;
        if (tt + 1 < ntiles) { if (!(var & 2)) ATT_LOAD(tt + 1); }
        else if (u_next >= 0) {
            int nq, nqc, nkc, nvc, ntr; att_start<MODE>(u_next, w, r, nq, nqc, nkc, nvc, ntr);
            kreg = *(const v4u*)(QKV + (size_t)(ntr + skey) * QKVC + nkc + 8 * sch); vreg = *(const v4u*)(QKV + (size_t)(ntr + vkey) * QKVC + nvc + 8 * vch);
            P.valid = 1;
        }
        if (!(var & 1) && !(MODE == 1 && is_local && !(kr >= my_rs && kr < my_rs + 8))) {
            att_tile<MODE, 0>(lds, boff, qf, negm, O0, O1, m_run, l_run, is_local, MODE == 0 && is_local && (lo + tt == 0 || lo + tt == 4), kbase, qt, kr, gr, tb_base, tb_pitch, r, h);
        }
        if (tt + 1 < ntiles && !(var & 2)) ATT_STORE(((tt + 1) & 1) * ATT_BUF);
        __syncthreads();
    }
#undef ATT_TROW
#undef ATT_LOAD
#undef ATT_STORE
    const float lt = l_run + __shfl_xor(l_run, 32), inv = 1.0f / lt;
    LAS unsigned char* ot = lds + w * 4608;
#pragma unroll
    for (int g = 0; g < 4; ++g) {
        v2u o; o.x = cvtpk(O0[4 * g] * inv, O0[4 * g + 1] * inv); o.y = cvtpk(O0[4 * g + 2] * inv, O0[4 * g + 3] * inv);
        *(LAS v2u*)(ot + r * 144 + (8 * g + 4 * h) * 2) = o;
        o.x = cvtpk(O1[4 * g] * inv, O1[4 * g + 1] * inv); o.y = cvtpk(O1[4 * g + 2] * inv, O1[4 * g + 3] * inv);
        *(LAS v2u*)(ot + r * 144 + (32 + 8 * g + 4 * h) * 2) = o;
    }
    LDS_WAIT(); asm volatile("" ::: "memory");
    bf16* op = Yo + (size_t)(qrow - r) * 512 + head * 64;
#pragma unroll
    for (int k = 0; k < 4; ++k) { const int p = lane + 64 * k, row = p >> 3, chk = p & 7;
        *(GAS v4u*)(op + (size_t)row * 512 + 8 * chk) = *(const LAS v4u*)(ot + row * 144 + chk * 16); }
    LDS_WAIT(); asm volatile("" ::: "memory");
}

template <int N>
__device__ __forceinline__ void conv_taps(const bf16* src, int t, int L, float w0, float w1, float w2, float bs, float (&out)[N]) {
    float x[N + 2];
    if constexpr (N == 8) { const v4u q = *(const v4u*)(src + t); x[1] = pg8::bf_lo(q.x); x[2] = pg8::bf_hi(q.x); x[3] = pg8::bf_lo(q.y); x[4] = pg8::bf_hi(q.y); x[5] = pg8::bf_lo(q.z); x[6] = pg8::bf_hi(q.z); x[7] = pg8::bf_lo(q.w); x[8] = pg8::bf_hi(q.w); }
    else { const v2u q = *(const v2u*)(src + t); x[1] = pg8::bf_lo(q.x); x[2] = pg8::bf_hi(q.x); x[3] = pg8::bf_lo(q.y); x[4] = pg8::bf_hi(q.y); }
    x[0] = t > 0 ? bf2f(src[t - 1]) : 0.f;
    x[N + 1] = (t + N < L) ? bf2f(src[t + N]) : 0.f;
#pragma unroll
    for (int e = 0; e < N; ++e) out[e] = w0 * x[e] + w1 * x[e + 1] + w2 * x[e + 2] + bs;
}

template <int L, int VAR = 0>
__device__ __forceinline__ void hyena_unit(Frame& F, int c, const bf16* CINT, bf16* DST, const bf16* Gf, const float* convw, const float* convb, const float* hybias) {
    constexpr int UP = (L + 8) * 2, TPW = L / 256, CPB = L / 8;
    LAS unsigned char* U = F.lds; LAS unsigned short* Gs = (LAS unsigned short*)(F.lds + 32 * UP);
    const int lane = F.lane, r = lane & 31, h = lane >> 5, T0 = F.wave * TPW * 32;
    const bf16* vsrc = CINT + (size_t)c * NROW + (L == SEQ ? 0 : NTOK);
    bf16* ydst = DST + (size_t)c * NROW + (L == SEQ ? 0 : NTOK);
    __syncthreads();
    if (!(VAR & 8)) {
        const float w0 = convw[c], w1 = convw[CINC + c], w2 = convw[2 * CINC + c], bs = convb[c];
        static_assert(CPB % 32 == 0, "a wave's 64 lanes hold consecutive chunks of at most two rows, split at lane 32");
#pragma unroll 4
        for (int q = F.tid; q < 32 * CPB; q += NTHREADS) { const int b = q / CPB, t = (q % CPB) * 8;
            const bf16* src = vsrc + (size_t)b * L;
            const v4u ch = *(const v4u*)(src + t);
            float x[10];
            x[1] = pg8::bf_lo(ch.x); x[2] = pg8::bf_hi(ch.x); x[3] = pg8::bf_lo(ch.y); x[4] = pg8::bf_hi(ch.y); x[5] = pg8::bf_lo(ch.z); x[6] = pg8::bf_hi(ch.z); x[7] = pg8::bf_lo(ch.w); x[8] = pg8::bf_hi(ch.w);
            const float up = __shfl_up(x[8], 1), dn = __shfl_down(x[1], 1);
            const int lr = lane & 31;
            x[0] = (lr == 0) ? (t > 0 ? bf2f(src[t - 1]) : 0.f) : up;
            x[9] = (lr == 31) ? (t + 8 < L ? bf2f(src[t + 8]) : 0.f) : dn;
            float o[8];
#pragma unroll
            for (int e = 0; e < 8; ++e) o[e] = w0 * x[e] + w1 * x[e + 1] + w2 * x[e + 2] + bs;
            v4u pk; pk.x = pk2(o[0], o[1]); pk.y = pk2(o[2], o[3]); pk.z = pk2(o[4], o[5]); pk.w = pk2(o[6], o[7]);
            *(LAS v4u*)(U + b * UP + t * 2) = pk; }
    }
#pragma unroll 1
    for (int ord = 0; ord < 2; ++ord) {
        {
            const v4u* gsrc = (const v4u*)(Gf + ((size_t)ord * 512 + c) * (2 * L));
            for (int q = F.tid; q < L / 4; q += NTHREADS) *(LAS v4u*)((LAS unsigned char*)Gs + q * 16) = gsrc[q];
        }
        __syncthreads();
        f32x16 acc[TPW];
#pragma unroll
        for (int i = 0; i < TPW; ++i)
#pragma unroll
            for (int e = 0; e < 16; ++e) acc[i][e] = 0.f;
        const int gbase = T0 + r - 8 * h + L;
#define HY_AF(dst, sgi, ti) do { const int gi_ = gbase + 32 * (ti) - 16 * (sgi); _Pragma("unroll") for (int j_ = 0; j_ < 8; ++j_) dst[j_] = (short)Gs[gi_ - j_]; } while (0)
#define HY_BF(sgi) (*(const LAS bf16x8*)(U + r * UP + (16 * (sgi) + 8 * h) * 2))
        if constexpr (TPW == 8 && !(VAR & 2)) {
            constexpr int NS = L / 16;
#pragma unroll 1
            for (int p = 0; p < 2; ++p) {
                bf16x8 W[8];
#pragma unroll
                for (int i = 1; i < 8; ++i) HY_AF(W[i], p, i);
                bf16x8 nf, nb; HY_AF(nf, p, 0); nb = HY_BF(p);
#pragma unroll 1
                for (int sb = p; sb < NS; sb += 16) {
#pragma unroll
                    for (int k = 0; k < 8; ++k) {
                        const int sg = sb + 2 * k; const bf16x8 cb = nb; W[(8 - k) & 7] = nf;
                        const int sn = sg + 2 < NS ? sg + 2 : sg;
                        HY_AF(nf, sn, 0); nb = HY_BF(sn);
#pragma unroll
                        for (int i = 0; i < 8; ++i) acc[i] = MFMA32(W[(i - k) & 7], cb, acc[i]);
                    }
                }
            }
        } else if constexpr (!(VAR & 2)) {
#pragma unroll 1
            for (int sg = 0; sg < L / 16; ++sg) { bf16x8 af; HY_AF(af, sg, 0); acc[0] = MFMA32(af, HY_BF(sg), acc[0]); }
        }
#undef HY_AF
#undef HY_BF
        const int comp = 1 + ord;
        const float w0 = convw[comp * 512 + c], w1 = convw[CINC + comp * 512 + c], w2 = convw[2 * CINC + comp * 512 + c], bs = convb[comp * 512 + c], hb = hybias[ord * 512 + c];
        const bf16* gsrc = CINT + ((size_t)comp * 512 + c) * NROW + (L == SEQ ? 0 : NTOK) + (size_t)r * L;
        __syncthreads();
        {
            constexpr int NCH = TPW * 4, BS = NCH < 8 ? NCH : 8;
#pragma unroll
            for (int bt = 0; bt < NCH / BS; ++bt) {
                const int tb = T0 + 8 * BS * bt;
                v4u ch[BS];
#pragma unroll
                for (int k = 0; k < BS; ++k) { if constexpr (VAR & 4) ch[k] = (v4u){0u, 0u, 0u, 0u}; else ch[k] = *(const v4u*)(gsrc + tb + 8 * k); }
                float xl = 0.f, xr = 0.f;
                if constexpr (!(VAR & 4)) { if (tb > 0) xl = bf2f(gsrc[tb - 1]); if (tb + 8 * BS < L) xr = bf2f(gsrc[tb + 8 * BS]); }
#pragma unroll
                for (int k = 0; k < BS; ++k) {
                    const int kk = BS * bt + k, i = kk >> 2, g = kk & 3, t = T0 + 32 * i + 8 * g + 4 * h;
                    float xs[10];
                    xs[0] = k == 0 ? xl : pg8::bf_hi(ch[k > 0 ? k - 1 : 0].w);
                    xs[1] = pg8::bf_lo(ch[k].x); xs[2] = pg8::bf_hi(ch[k].x); xs[3] = pg8::bf_lo(ch[k].y); xs[4] = pg8::bf_hi(ch[k].y); xs[5] = pg8::bf_lo(ch[k].z); xs[6] = pg8::bf_hi(ch[k].z); xs[7] = pg8::bf_lo(ch[k].w); xs[8] = pg8::bf_hi(ch[k].w);
                    xs[9] = k == BS - 1 ? xr : pg8::bf_lo(ch[k < BS - 1 ? k + 1 : k].x);
                    float gt[4];
#pragma unroll
                    for (int e2 = 0; e2 < 4; ++e2) { const float lo = w0 * xs[e2] + w1 * xs[e2 + 1] + w2 * xs[e2 + 2] + bs, hi = w0 * xs[e2 + 4] + w1 * xs[e2 + 5] + w2 * xs[e2 + 6] + bs; gt[e2] = h ? hi : lo; }
                    LAS v2u* up = (LAS v2u*)(U + r * UP + t * 2);
                    const v2u uu = *up;
                    const float u0 = pg8::bf_lo(uu.x), u1 = pg8::bf_hi(uu.x), u2 = pg8::bf_lo(uu.y), u3 = pg8::bf_hi(uu.y);
                    const float z0 = gt[0] * (acc[i][4 * g] + hb * u0), z1 = gt[1] * (acc[i][4 * g + 1] + hb * u1), z2 = gt[2] * (acc[i][4 * g + 2] + hb * u2), z3 = gt[3] * (acc[i][4 * g + 3] + hb * u3);
                    v2u zz; zz.x = pk2(z0, z1); zz.y = pk2(z2, z3);
                    *up = zz;
                }
                asm volatile("" ::: "memory");
            }
        }
        __syncthreads();
    }
    if (!(VAR & 1)) for (int q = F.tid; q < 32 * CPB; q += NTHREADS) { const int b = q / CPB, t = (q % CPB) * 8; *(GAS v4u*)(ydst + (size_t)b * L + t) = *(const LAS v4u*)(U + b * UP + t * 2); }
}

__device__ __forceinline__ void transpose_yc(Frame& F, const bf16* CT, bf16* Yc, int nrows) {
    const int gw = F.vcu * NWAVES + F.wave, NGW = F.G * NWAVES, lane = F.lane;
    LAS unsigned short* T = (LAS unsigned short*)(F.lds + F.wave * 16384);
    const int ntr = nrows / 64;
    for (int it = gw; it < 8 * ntr; it += NGW) {
        const int cb = it / ntr, rb = it % ntr, c0 = cb * 64, r0 = rb * 64;
#pragma unroll
        for (int k = 0; k < 8; ++k) { const int p = lane + 64 * k, cc = p >> 3, ch = p & 7;
            const v4u q = *(const v4u*)(CT + (size_t)(c0 + cc) * NROW + r0 + 8 * ch);
            LAS unsigned* d = (LAS unsigned*)(T + cc * 66 + 8 * ch); d[0] = q.x; d[1] = q.y; d[2] = q.z; d[3] = q.w; }
        LDS_WAIT(); asm volatile("" ::: "memory");
#pragma unroll
        for (int k = 0; k < 8; ++k) { const int p = lane + 64 * k, rr = p >> 3, ch = p & 7;
            unsigned short e[8];
#pragma unroll
            for (int j = 0; j < 8; ++j) e[j] = T[(8 * ch + j) * 66 + rr];
            v4u o; o.x = e[0] | ((unsigned)e[1] << 16); o.y = e[2] | ((unsigned)e[3] << 16); o.z = e[4] | ((unsigned)e[5] << 16); o.w = e[6] | ((unsigned)e[7] << 16);
            *(GAS v4u*)(Yc + (size_t)(r0 + rr) * 512 + c0 + 8 * ch) = o; }
        LDS_WAIT(); asm volatile("" ::: "memory");
    }
}

struct RowVecs { f32x4 gA[4], gt[4], gB[4], sc1[4], sh[4]; };
__device__ __forceinline__ float ssq16(const f32x4 (&v)[4]) { float s = 0.f;
#pragma unroll
    for (int j = 0; j < 4; ++j) s += (v[j].x * v[j].x + v[j].y * v[j].y) + (v[j].z * v[j].z + v[j].w * v[j].w);
    return s; }
__device__ __forceinline__ void ld_mod(const Frame& F, int l, int b, int part, int lane, f32x4 (&v)[4], float add) {
    ld_row_f32((const float*)(F.ws + WS_MODV) + ((size_t)l * 33 + b) * 6144 + part * 1024, lane, v);
#pragma unroll
    for (int j = 0; j < 4; ++j) v[j] = v[j] + add;
}
__device__ __forceinline__ void row_pair(const RowVecs& V, const f32x4 (&y0)[4], const f32x4 (&y1)[4], f32x4 (&x0)[4], f32x4 (&x1)[4], bool has_y, bool has_next, f32x4 (&h0)[4], f32x4 (&h1)[4]) {
    if (has_y) {
        float a0 = ssq16(y0), a1 = ssq16(y1);
#pragma unroll
        for (int o = 1; o < 64; o <<= 1) { a0 += __shfl_xor(a0, o); a1 += __shfl_xor(a1, o); }
        const float r0 = __builtin_amdgcn_rsqf(a0 * (1.0f / D) + EPS), r1 = __builtin_amdgcn_rsqf(a1 * (1.0f / D) + EPS);
#pragma unroll
        for (int j = 0; j < 4; ++j) { x0[j] = x0[j] + V.gt[j] * ((y0[j] * r0) * V.gA[j]); x1[j] = x1[j] + V.gt[j] * ((y1[j] * r1) * V.gA[j]); }
    }
    if (has_next) {
        float a0 = ssq16(x0), a1 = ssq16(x1);
#pragma unroll
        for (int o = 1; o < 64; o <<= 1) { a0 += __shfl_xor(a0, o); a1 += __shfl_xor(a1, o); }
        const float r0 = __builtin_amdgcn_rsqf(a0 * (1.0f / D) + EPS), r1 = __builtin_amdgcn_rsqf(a1 * (1.0f / D) + EPS);
#pragma unroll
        for (int j = 0; j < 4; ++j) { h0[j] = (x0[j] * r0) * V.gB[j] * V.sc1[j] + V.sh[j]; h1[j] = (x1[j] * r1) * V.gB[j] * V.sc1[j] + V.sh[j]; }
    }
}
__device__ __forceinline__ const float* x_src_ptr(const Args& a, Frame& F, int l, int sub, int row) {
    if (row < NTOK) return (l == 0 && sub == 0) ? a.in[I_X] + (size_t)row * D : a.out + (size_t)row * D;
    return (l == 0 && sub == 0) ? a.in[I_CTX] + (size_t)(row - NTOK) * D : (const float*)(F.ws + WS_CTXRES) + (size_t)(row - NTOK) * D;
}
__device__ __forceinline__ float* x_dst_ptr(const Args& a, Frame& F, int row) {
    return row < NTOK ? a.out + (size_t)row * D : (float*)(F.ws + WS_CTXRES) + (size_t)(row - NTOK) * D;
}

__device__ __forceinline__ void rows_phase(Frame& F, const Args& a, int mode, int l, int sub, const bf16* Y, int nrows) {
    const int gw = F.vcu * NWAVES + F.wave, NGW = F.G * NWAVES;
    const int R = (((nrows + NGW - 1) / NGW) + 1) & ~1, r0 = gw * R, r1 = (r0 + R) < nrows ? (r0 + R) : nrows;
    const bool has_y = mode == 1, has_next = (mode == 0) || !(l == 1 && sub == 1);
    const int ln = (mode == 0) ? 0 : (sub == 0 ? l : l + 1);
    const bool next_is_ffn = (mode == 1 && sub == 0);
    RowVecs V;
    if (has_y) ld_row_f32(a.in[sub == 0 ? I_GMIXPOST : I_GFFNPOST] + l * D, F.lane, V.gA);
    if (has_next) ld_row_f32(a.in[next_is_ffn ? I_GFFNPRE : I_GMIXPRE] + ln * D, F.lane, V.gB);
    int bcur = -2;
    bf16* const Hb = (bf16*)(F.ws + WS_H);
    f32x4 nx0[4], nx1[4]; v2u ny0[4], ny1[4];
#define ROWS_ISSUE(row_) do { const int rr_ = (row_); \
        const float* xs_ = mode == 0 ? (rr_ < NTOK ? a.in[I_X] + (size_t)rr_ * D : a.in[I_CTX] + (size_t)(rr_ - NTOK) * D) : x_src_ptr(a, F, l, sub, rr_); \
        if (has_y) { ld_raw_bf16_nt(Y + (size_t)rr_ * D, F.lane, ny0); ld_raw_bf16_nt(Y + (size_t)(rr_ + 1) * D, F.lane, ny1); } \
        ld_row_f32_nt(xs_, F.lane, nx0); ld_row_f32_nt(xs_ + D, F.lane, nx1); } while (0)
    if (r0 < r1) ROWS_ISSUE(r0);
#pragma unroll 1
    for (int row = r0; row < r1; row += 2) {
        const int b = row < NTOK ? (row >> 11) : 32;
        if (b != bcur) { bcur = b;
            if (has_y) ld_mod(F, l, b, sub == 0 ? 2 : 5, F.lane, V.gt, 0.f);
            if (has_next) { ld_mod(F, ln, b, next_is_ffn ? 4 : 1, F.lane, V.sc1, 1.0f); ld_mod(F, ln, b, next_is_ffn ? 3 : 0, F.lane, V.sh, 0.f); } }
        f32x4 y0[4], y1[4], x0[4], x1[4], h0[4], h1[4];
#pragma unroll
        for (int j = 0; j < 4; ++j) { x0[j] = nx0[j]; x1[j] = nx1[j]; if (has_y) { y0[j] = cvt_raw_bf16(ny0[j]); y1[j] = cvt_raw_bf16(ny1[j]); } }
        if (row + 2 < r1) ROWS_ISSUE(row + 2);
        row_pair(V, y0, y1, x0, x1, has_y, has_next, h0, h1);
        if (has_y) { float* xd = x_dst_ptr(a, F, row); st_row_f32_nt(xd, F.lane, x0); st_row_f32_nt(xd + D, F.lane, x1); }
        if (has_next) { st_row_bf16(Hb + (size_t)row * D, F.lane, h0); st_row_bf16(Hb + (size_t)(row + 1) * D, F.lane, h1);
            if (!next_is_ffn) { GAS unsigned* q = (GAS unsigned*)(F.ws + WS_H8 + (size_t)row * D) + F.lane;
#pragma unroll
                for (int j = 0; j < 4; ++j) { q[64 * j] = pg8::pack_fp8x4(h0[j].x, h0[j].y, h0[j].z, h0[j].w); q[256 + 64 * j] = pg8::pack_fp8x4(h1[j].x, h1[j].y, h1[j].z, h1[j].w); } } }
    }
#undef ROWS_ISSUE
}

__device__ __forceinline__ void route_row(const f32x4 (&h)[4], const LAS float* rl, int lane, int& e0, int& e1, float& w0, float& w1) {
    float lg[8];
#pragma unroll
    for (int e = 0; e < 8; ++e) lg[e] = 0.f;
#pragma unroll
    for (int j = 0; j < 4; ++j)
#pragma unroll
        for (int i = 0; i < 4; ++i) { const LAS f32x4* rp = (const LAS f32x4*)(rl + ((j * 4 + i) * 64 + lane) * 8); const f32x4 q0 = rp[0], q1 = rp[1]; const float hv = h[j][i];
            lg[0] += hv * q0.x; lg[1] += hv * q0.y; lg[2] += hv * q0.z; lg[3] += hv * q0.w; lg[4] += hv * q1.x; lg[5] += hv * q1.y; lg[6] += hv * q1.z; lg[7] += hv * q1.w; }
#pragma unroll
    for (int o = 1; o < 64; o <<= 1)
#pragma unroll
        for (int e = 0; e < 8; ++e) lg[e] += __shfl_xor(lg[e], o);
    e0 = 0; float v0 = lg[0];
#pragma unroll
    for (int e = 1; e < 8; ++e) if (lg[e] > v0) { v0 = lg[e]; e0 = e; }
    e1 = -1; float v1 = -3.0e38f;
#pragma unroll
    for (int e = 0; e < 8; ++e) if (e != e0 && lg[e] > v1) { v1 = lg[e]; e1 = e; }
    w0 = 1.0f / (1.0f + __expf(v1 - v0)); w1 = 1.0f - w0;
}
__device__ __forceinline__ void post_route_phase(Frame& F, const Args& a, const bf16* Y) {
    LAS int* se = (LAS int*)F.lds;
    LAS int* sbase = se + 512;
    LAS float* rl = (LAS float*)(F.lds + 4096);
    const int l = 1;
    __syncthreads();
    for (int i = F.tid; i < 1024 * 8; i += NTHREADS) { const int k = i >> 3, e = i & 7, jj = k >> 8, ln = (k & 255) >> 2, ii = k & 3; rl[((jj * 4 + ii) * 64 + ln) * 8 + e] = a.in[I_ROUTER][i]; }
    __syncthreads();
    RowVecs V;
    ld_row_f32(a.in[I_GMIXPOST] + l * D, F.lane, V.gA); ld_row_f32(a.in[I_GFFNPRE] + l * D, F.lane, V.gB);
    bf16* const Hb = (bf16*)(F.ws + WS_H);
    for (int blk = F.vcu; blk < NTOK / 256; blk += F.G) {
        const int b = blk >> 3;
        ld_mod(F, l, b, 2, F.lane, V.gt, 0.f); ld_mod(F, l, b, 4, F.lane, V.sc1, 1.0f); ld_mod(F, l, b, 3, F.lane, V.sh, 0.f);
#pragma unroll 1
        for (int k = 0; k < 32; ++k) {
            const int lr = F.wave * 32 + k, row = blk * 256 + lr;
            f32x4 y0[4], x0[4], h0[4];
            ld_row_bf16(Y + (size_t)row * D, F.lane, y0);
            float* xp = a.out + (size_t)row * D; ld_row_f32_nt(xp, F.lane, x0);
            { const float r0 = __builtin_amdgcn_rsqf(wave_sum(ssq16(y0)) * (1.0f / D) + EPS);
#pragma unroll
              for (int j = 0; j < 4; ++j) x0[j] = x0[j] + V.gt[j] * ((y0[j] * r0) * V.gA[j]); }
            st_row_f32_nt(xp, F.lane, x0);
            { const float r0 = __builtin_amdgcn_rsqf(wave_sum(ssq16(x0)) * (1.0f / D) + EPS);
#pragma unroll
              for (int j = 0; j < 4; ++j) h0[j] = (x0[j] * r0) * V.gB[j] * V.sc1[j] + V.sh[j]; }
            st_row_bf16(Hb + (size_t)row * D, F.lane, h0);
            int e0, e1; float w0, w1;
            route_row(h0, rl, F.lane, e0, e1, w0, w1);
            if (F.lane == 0) { se[2 * lr] = e0; se[2 * lr + 1] = e1;
                int4 rr; rr.x = e0; rr.y = e1; rr.z = __builtin_bit_cast(int, w0); rr.w = __builtin_bit_cast(int, w1); ((int4*)(F.ws + WS_ROUTE))[row] = rr; }
        }
        __syncthreads();
        const int half = blk >> 7;
        if (F.tid < 8) { int n = 0; for (int i = 0; i < 512; ++i) n += (se[i] == F.tid) ? 1 : 0;
            sbase[F.tid] = (int)__hip_atomic_fetch_add((unsigned*)(F.ws + WS_CTL) + CW_CNT + half * 8 + F.tid, (unsigned)n, __ATOMIC_RELAXED, __HIP_MEMORY_SCOPE_AGENT); }
        __syncthreads();
        if (F.tid < 8) { int p = sbase[F.tid]; int* lst = (int*)(F.ws + WS_LIST) + ((size_t)half * 8 + F.tid) * 32768;
            for (int i = 0; i < 512; ++i) if (se[i] == F.tid) lst[p++] = ((blk * 256 + (i >> 1)) << 1) | (i & 1); }
        __syncthreads();
    }
}

__device__ __forceinline__ void moe_offsets(Frame& F, int half, int (&toff)[9], int (&cnt)[8]) {
    const unsigned* cw = (const unsigned*)(F.ws + WS_CTL) + CW_CNT + half * 8;
    toff[0] = 0;
#pragma unroll
    for (int e = 0; e < 8; ++e) { cnt[e] = __builtin_amdgcn_readfirstlane((int)__hip_atomic_load(cw + e, __ATOMIC_RELAXED, __HIP_MEMORY_SCOPE_AGENT)); toff[e + 1] = toff[e] + (cnt[e] + 255) / 256; }
}
__device__ __forceinline__ void moe_gather_phase(Frame& F, int half, int skip_first = 0) {
    if (skip_first < 0 || skip_first >= F.G) skip_first = 0;
    const int bxw = (int)blockIdx.x - skip_first; if (bxw < 0) return;
    const int gw = bxw * NWAVES + F.wave, NGW = (F.G - skip_first) * NWAVES;
    int toff[9], cnt[8]; moe_offsets(F, half, toff, cnt);
    const int P = toff[8] * 256;
    for (int p = gw; p < P; p += NGW) {
        const int tile = p >> 8; int e = 0;
#pragma unroll
        for (int k = 1; k < 8; ++k) e += (tile >= toff[k]) ? 1 : 0;
        const int idx = p - toff[e] * 256;
        unsigned char* dst = F.ws + BIG_AS + (size_t)p * D;
        v4u o = {0u, 0u, 0u, 0u};
        if (idx < cnt[e]) {
            const int ts = ((const int*)(F.ws + WS_LIST))[((size_t)half * 8 + e) * 32768 + idx], tok = ts >> 1, slot = ts & 1;
            const GAS v4u* s = (const GAS v4u*)((const bf16*)(F.ws + WS_H) + (size_t)tok * D) + 2 * F.lane;
            const v4u q0 = s[0], q1 = s[1];
            o.x = pg8::pack_fp8x4(pg8::bf_lo(q0.x), pg8::bf_hi(q0.x), pg8::bf_lo(q0.y), pg8::bf_hi(q0.y)); o.y = pg8::pack_fp8x4(pg8::bf_lo(q0.z), pg8::bf_hi(q0.z), pg8::bf_lo(q0.w), pg8::bf_hi(q0.w));
            o.z = pg8::pack_fp8x4(pg8::bf_lo(q1.x), pg8::bf_hi(q1.x), pg8::bf_lo(q1.y), pg8::bf_hi(q1.y)); o.w = pg8::pack_fp8x4(pg8::bf_lo(q1.z), pg8::bf_hi(q1.z), pg8::bf_lo(q1.w), pg8::bf_hi(q1.w));
            if (F.lane == 0) ((int*)(F.ws + WS_INV))[tok * 2 + slot] = p;
        }
        *((GAS v4u*)dst + F.lane) = o;
    }
}
__device__ __forceinline__ void moe_convert(Frame& F, const Args& a) {
    const int gw = F.vcu * NWAVES + F.wave, NGW = F.G * NWAVES;
    LAS float* scr = (LAS float*)(F.lds + F.wave * 16384);
    constexpr int I13 = 16 * 112, I2 = 56 * 32;
    for (int it = gw; it < 8 * (2 * I13 + I2); it += NGW) {
        const int e = it / (2 * I13 + I2); int r = it % (2 * I13 + I2);
        if (r < 2 * I13) {
            const int which = r / I13; r %= I13; const int kb = r / 112, nb = r % 112, n0 = 32 * nb;
            const float* W = (which ? a.in[I_MW3] : a.in[I_MW1]) + (size_t)e * D * DFFE;
            transpose_item_f8(W, DFFE, F.ws + WM_13 + (size_t)e * 2 * DFFE * D, D, 64 * kb, n0, (n0 / 128) * 256 + which * 128 + (n0 % 128), W13_SCALE, scr, F.lane);
        } else {
            r -= 2 * I13; const int kb = r / 32, nb = r % 32;
            transpose_item_f8(a.in[I_MW2] + (size_t)e * DFFE * D, D, F.ws + WM_2 + (size_t)e * D * DFFE, DFFE, 64 * kb, 32 * nb, 32 * nb, W2_SCALE, scr, F.lane);
        }
    }
}
__device__ __forceinline__ void moe_post_phase(Frame& F, const Args& a, int half) {
    const int gw = F.vcu * NWAVES + F.wave, NGW = F.G * NWAVES;
    const int R = (((32768 + NGW - 1) / NGW) + 1) & ~1, t0 = gw * R, t1 = (t0 + R) < 32768 ? (t0 + R) : 32768;
    RowVecs V; ld_row_f32(a.in[I_GFFNPOST] + D, F.lane, V.gA);
    int bcur = -2;
    const bf16* Y2 = (const bf16*)(F.ws + BIG_Y2S); const int* inv = (const int*)(F.ws + WS_INV); const int4* rt = (const int4*)(F.ws + WS_ROUTE);
    int4 ira, irb; int ip00, ip01, ip10, ip11;
    v2u nya[4], nyb[4], nyc[4], nyd[4]; f32x4 nx0[4], nx1[4]; float nw0 = 0.f, nw1 = 0.f, nu0 = 0.f, nu1 = 0.f;
#define MP_IDX(t_) do { const int rw_ = half * 32768 + (t_); ira = rt[rw_]; irb = rt[rw_ + 1]; ip00 = inv[rw_ * 2]; ip01 = inv[rw_ * 2 + 1]; ip10 = inv[rw_ * 2 + 2]; ip11 = inv[rw_ * 2 + 3]; } while (0)
#define MP_DATA(t_) do { const int rw_ = half * 32768 + (t_); \
        ld_raw_bf16_nt(Y2 + (size_t)ip00 * D, F.lane, nya); ld_raw_bf16_nt(Y2 + (size_t)ip01 * D, F.lane, nyb); ld_raw_bf16_nt(Y2 + (size_t)ip10 * D, F.lane, nyc); ld_raw_bf16_nt(Y2 + (size_t)ip11 * D, F.lane, nyd); \
        const float* xq_ = a.out + (size_t)rw_ * D; ld_row_f32_nt(xq_, F.lane, nx0); ld_row_f32_nt(xq_ + D, F.lane, nx1); \
        nw0 = __builtin_bit_cast(float, ira.z); nw1 = __builtin_bit_cast(float, ira.w); nu0 = __builtin_bit_cast(float, irb.z); nu1 = __builtin_bit_cast(float, irb.w); } while (0)
    if (t0 < t1) { MP_IDX(t0); MP_DATA(t0); if (t0 + 2 < t1) MP_IDX(t0 + 2); }
#pragma unroll 1
    for (int t = t0; t < t1; t += 2) {
        const int row = half * 32768 + t, b = row >> 11;
        if (b != bcur) { bcur = b; ld_mod(F, 1, b, 5, F.lane, V.gt, 0.f); }
        f32x4 y0[4], y1[4], x0[4], x1[4], h0[4], h1[4];
        float* xp = a.out + (size_t)row * D;
#pragma unroll
        for (int j = 0; j < 4; ++j) { x0[j] = nx0[j]; x1[j] = nx1[j]; y0[j] = cvt_raw_bf16(nya[j]) * nw0 + cvt_raw_bf16(nyb[j]) * nw1; y1[j] = cvt_raw_bf16(nyc[j]) * nu0 + cvt_raw_bf16(nyd[j]) * nu1; }
        if (t + 2 < t1) { MP_DATA(t + 2); if (t + 4 < t1) MP_IDX(t + 4); }
        row_pair(V, y0, y1, x0, x1, true, false, h0, h1);
        st_row_f32_nt(xp, F.lane, x0); st_row_f32_nt(xp + D, F.lane, x1);
    }
#undef MP_IDX
#undef MP_DATA
}

#ifndef MK_ONLY
#define MK_ONLY -1
#endif
#ifndef MK_SKIP
#define MK_SKIP -1
#endif
#define ON(k) ((MK_ONLY < 0 || MK_ONLY == (k)) && MK_SKIP != (k))
#ifndef MK_REPMASK
#define MK_REPMASK 0
#endif
#ifndef MK_REPSUB
#define MK_REPSUB 0
#endif
#ifndef MK_HYVAR
#define MK_HYVAR 0
#endif
#ifndef MK_PROBE
#define MK_PROBE -1
#endif
#ifndef MK_PROBE_END
#define MK_PROBE_END MK_PROBE
#endif
#ifndef MK_PROBE_DIV
#define MK_PROBE_DIV 10
#endif
#ifndef MK_MULTI
#define MK_MULTI 0
#endif
constexpr int NPHASES = 2 + 9 + 6 + 6;

typedef const __attribute__((address_space(4))) Args* ArgsP;
#define KARGS ((ArgsP)__builtin_amdgcn_kernarg_segment_ptr())
#define PH_ENTER \
    Frame F; const Args* ap_; { int t_ = threadIdx.x; asm volatile("" : "+v"(t_)); ArgsP q_ = KARGS; asm volatile("" : "+s"(q_)); ap_ = (const Args*)q_; \
      F.lds = (LAS unsigned char*)lds_raw; F.tid = t_; F.lane = t_ & 63; F.wave = __builtin_amdgcn_readfirstlane(t_ >> 6); \
      F.G = gridDim.x; { const int bx_ = blockIdx.x; F.vcu = (F.G % 8 == 0) ? (bx_ % 8) * (F.G / 8) + bx_ / 8 : bx_; } F.ws = q_->ws; } \
    const Args& a = *ap_; const int bx = (int)blockIdx.x; \
    bf16* const Hb = (bf16*)(F.ws + WS_H); bf16* const Y3 = (bf16*)(F.ws + WS_Y3); bf16* const QKV = (bf16*)(F.ws + BIG_QKV); bf16* const CINT = (bf16*)(F.ws + BIG_CINT); unsigned char* const GATE = F.ws + BIG_GATE; \
    (void)Hb; (void)Y3; (void)QKV; (void)CINT; (void)GATE; (void)bx; (void)a;

__global__ void __launch_bounds__(NTHREADS, 2) fwd_kernel(Args args) {
    extern __shared__ __attribute__((aligned(16))) unsigned char lds_raw[];
    {
        volatile LAS unsigned* MISC0 = (volatile LAS unsigned*)((LAS unsigned char*)lds_raw + MISC_OFF);
        for (int u = threadIdx.x; u < (LDS_BYTES - MISC_OFF) / 4; u += NTHREADS) MISC0[u] = 0u;
        __syncthreads();
    }
    if (!MK_MULTI) (void)xcd_barrier_post((unsigned*)(KARGS->ws + WS_CTL) + CW_BAR, (volatile LAS unsigned*)((LAS unsigned char*)lds_raw + MISC_OFF) + 8);
    int ph = 0;
#define PROBE_STAMP(which) do { if (MK_PROBE >= 0 && blockIdx.x == 0 && __builtin_amdgcn_readfirstlane((int)threadIdx.x) == 0) { volatile unsigned* pw_ = (volatile unsigned*)(KARGS->ws + WS_CTL) + 20000; const unsigned t_ = (unsigned)__builtin_amdgcn_s_memrealtime(); if ((which) == 0) pw_[0] = t_; else pw_[1] = t_ - pw_[0]; } } while (0)
    if (MK_PROBE == 0) PROBE_STAMP(0);
#define LO_ (KARGS->ph_lo)
#define HI_ (KARGS->ph_hi)
#define GRID_BAR do { XcdBarrier b_; b_.bar = (unsigned*)(KARGS->ws + WS_CTL) + CW_BAR; b_.x = xb_xcc_id(); b_.st = (volatile LAS unsigned*)((LAS unsigned char*)lds_raw + MISC_OFF) + 8; xcd_barrier(b_); } while (0)
#define RUN (LO_ <= ph && ph < HI_)
#define END_PHASE do { if (RUN && (ph + 1 < HI_)) { GRID_BAR; } if (MK_PROBE > 0 && ph + 1 == MK_PROBE) PROBE_STAMP(0); if (MK_PROBE >= 0 && ph == MK_PROBE_END) PROBE_STAMP(1); ++ph; } while (0)

    if (RUN && ON(0)) { PH_ENTER p0_prologue(F, a); } END_PHASE;
    if (RUN && ON(1)) { PH_ENTER p1_phase(F, a); rows_phase(F, a, 0, 0, 0, nullptr, NROW); } END_PHASE;

#pragma unroll 1
    for (int l = 0; l < 2; ++l) {
        const int nrows = l == 0 ? NROW : NTOK;
        if (RUN && ON(2)) { PH_ENTER
            const bf16* Wq8 = (const bf16*)(F.ws + W_IN + (size_t)l * INC * D);
            { pg8::Gemm g{(const bf16*)(F.ws + WS_H8), Wq8, nrows, QKVC, D / 2}; pg8::StaticOrder S; S.init(nrows, QKVC, F.G, bx);
              pg8::EpiQKV E{QKV, (const float*)(F.ws + WS_ROPE), 0, QSCALE, 1.0f / W13_SCALE};
              pg8::gemm_phase<pg8::EpiQKV, pg8::StaticOrder, true, true, true>(F.lds, g, S, E, F.tid); }
            int tid2 = threadIdx.x; asm volatile("" : "+v"(tid2));
            if (l == 1) { pg8::Gemm g{(const bf16*)(F.ws + WS_H8 + (size_t)NTOK * D), Wq8, NCTX, 1280, D / 2}; pg8::StaticOrder S; S.init(NCTX, 1280, F.G, bx);
              pg8::EpiQKV E{QKV, (const float*)(F.ws + WS_ROPE), NTOK, QSCALE, 1.0f / W13_SCALE};
              pg8::gemm_phase<pg8::EpiQKV, pg8::StaticOrder, true, true, true>(F.lds, g, S, E, tid2); }
            int tid3 = threadIdx.x; asm volatile("" : "+v"(tid3));
            { pg8::Gemm g{(const bf16*)(F.ws + W_CB) + (size_t)l * CINC * D, Hb, CINC, nrows, D}; pg8::StaticOrder S; S.init(CINC, nrows, F.G, bx);
              pg8::EpiPlain E{CINT, NROW, 0, 0, 1.0f};
              pg8::gemm_phase<pg8::EpiPlain, pg8::StaticOrder, true, true>(F.lds, g, S, E, tid3); }
        } END_PHASE;
        if (RUN) {
            { PH_ENTER const float* sink = a.in[I_SINK] + l * 8; const float* rpb = a.in[I_RPB] + (size_t)l * 8 * 15 * 31; const int sm = a.sub_mask;
              if (ON(3) && (sm & 1)) { AttPre P; P.valid = 0; int th = -1; for (int u = F.vcu; u < 2048; u += F.G) attn_unit<0>(F, u, u + F.G < 2048 ? u + F.G : -1, QKV, Y3, sink, rpb, P, th, (sm >> 6) & 3); } }
            { PH_ENTER const float* sink = a.in[I_SINK] + l * 8; const float* rpb = a.in[I_RPB] + (size_t)l * 8 * 15 * 31; const int sm = a.sub_mask;
              if (ON(4) && (sm & 2)) { AttPre P; P.valid = 0; int th = -1; for (int u = F.vcu; u < 2048; u += F.G) attn_unit<1>(F, u, u + F.G < 2048 ? u + F.G : -1, QKV, Y3 + (size_t)NROW * 512, sink, rpb, P, th, (sm >> 6) & 3); } }
            { PH_ENTER const float* sink = a.in[I_SINK] + l * 8; const float* rpb = a.in[I_RPB] + (size_t)l * 8 * 15 * 31; const int sm = a.sub_mask;
              if (l == 0 && ON(5) && (sm & 4)) {
                { AttPre P; P.valid = 0; int th = -1; for (int u = F.vcu; u < 256; u += F.G) attn_unit<2>(F, u, -1, QKV, Y3, sink, rpb, P, th); }
                { AttPre P; P.valid = 0; int th = -1; for (int u = F.vcu; u < 256; u += F.G) attn_unit<3>(F, u, -1, QKV, Y3 + (size_t)NROW * 512, sink, rpb, P, th); }
              } }
            { PH_ENTER const int sm = a.sub_mask;
              const float* cw = a.in[I_CONVW] + l * 3 * CINC; const float* cb = a.in[I_CONVB] + l * CINC; const float* hb = a.in[I_HBIAS] + l * 1024;
#if MK_HYVAR
              if (ON(6) && (sm & 32)) for (int c = F.vcu; c < 512; c += F.G) hyena_unit<SEQ, MK_HYVAR>(F, c, CINT, CINT, (const bf16*)(F.ws + WS_GF) + (size_t)l * 2 * 512 * 2 * SEQ, cw, cb, hb);
#endif
              if (ON(6) && (sm & 8)) for (int c = F.vcu; c < 512; c += F.G) hyena_unit<SEQ>(F, c, CINT, CINT, (const bf16*)(F.ws + WS_GF) + (size_t)l * 2 * 512 * 2 * SEQ, cw, cb, hb);
              if (l == 0 && ON(7) && (sm & 16)) for (int c = F.vcu; c < 512; c += F.G) hyena_unit<LC>(F, c, CINT, CINT, (const bf16*)(F.ws + WS_GFC) + (size_t)l * 2 * 512 * 2 * LC, cw, cb, hb);
              __syncthreads(); }
        } END_PHASE;
        if (RUN && ON(8)) { PH_ENTER
            transpose_yc(F, CINT, (bf16*)(F.ws + BIG_YCT), nrows);
            __syncthreads();
            pg8::Gemm g{(const bf16*)(F.ws + WS_H8), (const bf16*)(F.ws + W_IN + (size_t)l * INC * D + (size_t)(QKVC + CINC) * D), nrows, GATEC, D / 2}; pg8::StaticOrder S; S.init(nrows, GATEC, F.G, bx);
            pg8::EpiSig E{GATE, GATEC, 1.0f / W13_SCALE};
            pg8::gemm_phase<pg8::EpiSig, pg8::StaticOrder, true, true, true>(F.lds, g, S, E, F.tid);
        } END_PHASE;
        if (RUN && ON(9)) { PH_ENTER
            constexpr int TB = 256 * 512 * 2;
            static_assert((WS_Y3 - BIG_YCT) % TB == 0, "merge tile offsets");
            constexpr int OA = (int)((WS_Y3 - BIG_YCT) / TB), OB = OA + NROW / 256;
            pg8::Gemm g{(const bf16*)(F.ws + BIG_YCT), (const bf16*)(F.ws + W_BR) + (size_t)l * 3 * D * 512, 3 * NROW, 3 * D, 512}; pg8::MergeOrder S{nrows / 256, F.G, bx, OA, OB, 0};
            pg8::EpiMerge E{Hb, GATE, OA, OB, 0};
            pg8::gemm_phase<pg8::EpiMerge, pg8::MergeOrder, true, true>(F.lds, g, S, E, F.tid);
        } END_PHASE;
        if (RUN && ON(10)) { PH_ENTER
            pg8::Gemm g{Hb, (const bf16*)(F.ws + W_OUT) + (size_t)l * D * D, nrows, D, D}; pg8::StaticOrder S; S.init(nrows, D, F.G, bx);
            pg8::EpiPlain E{Y3, D, 0, 0, 1.0f};
            pg8::gemm_phase<pg8::EpiPlain, pg8::StaticOrder, true, true>(F.lds, g, S, E, F.tid);
        } END_PHASE;
        if (RUN && ON(11)) { PH_ENTER if (l == 0) rows_phase(F, a, 1, 0, 0, Y3, nrows); else post_route_phase(F, a, Y3); } END_PHASE;
        if (l == 0) {
            if (RUN && ON(12)) { PH_ENTER
                pg8::Gemm g{Hb, (const bf16*)(F.ws + W_F13), NROW, 2 * DFF, D}; pg8::StaticOrder S; S.init(NROW, 2 * DFF, F.G, bx);
                pg8::EpiSwiGLU E{(bf16*)(F.ws + BIG_HID), DFF, 0};
                pg8::gemm_phase<pg8::EpiSwiGLU, pg8::StaticOrder, true, true>(F.lds, g, S, E, F.tid);
            } END_PHASE;
            if (RUN && ON(13)) { PH_ENTER
                pg8::Gemm g{(const bf16*)(F.ws + BIG_HID), (const bf16*)(F.ws + W_F2), NROW, D, DFF}; pg8::StaticOrder S; S.init(NROW, D, F.G, bx);
                pg8::EpiPlain E{Y3, D, 0, 0, 1.0f};
                pg8::gemm_phase<pg8::EpiPlain, pg8::StaticOrder, true, true>(F.lds, g, S, E, F.tid);
            } END_PHASE;
            if (RUN && ON(14)) { PH_ENTER rows_phase(F, a, 1, 0, 1, Y3, NROW); } END_PHASE;
        } else {
#pragma unroll 1
            for (int half = 0; half < 2; ++half) {
                if (half == 0) { if (RUN && ON(15)) { PH_ENTER moe_convert(F, a); moe_gather_phase(F, 0); } END_PHASE; }
                if (RUN && ON(16)) { PH_ENTER
                    int toff[9], cnt[8]; moe_offsets(F, half, toff, cnt);
                    pg8::GroupOrder S; S.nM = toff[8]; S.nN = 28; S.G = F.G; S.c = bx;
#pragma unroll
                    for (int k = 0; k < 9; ++k) S.toff[k] = toff[k];
                    pg8::Gemm g{(const bf16*)(F.ws + BIG_AS), (const bf16*)(F.ws + WM_13), PCAP, 8 * 2 * DFFE, D / 2};
                    pg8::EpiSwiGLU8 E{F.ws + BIG_MH, DFFE, 28, 1.0f / W13_SCALE, HID_SCALE};
                    pg8::gemm_phase<pg8::EpiSwiGLU8, pg8::GroupOrder, true, true, true>(F.lds, g, S, E, F.tid);
                    if (half == 1) moe_post_phase(F, a, 0);
                } END_PHASE;
                if (RUN && ON(17)) { PH_ENTER
                    int toff[9], cnt[8]; moe_offsets(F, half, toff, cnt);
                    pg8::GroupOrder S; S.nM = toff[8]; S.nN = 4; S.G = F.G; S.c = bx;
#pragma unroll
                    for (int k = 0; k < 9; ++k) S.toff[k] = toff[k];
                    pg8::Gemm g{(const bf16*)(F.ws + BIG_MH), (const bf16*)(F.ws + WM_2), PCAP, 8 * D, DFFE / 2};
                    pg8::EpiPlain E{(bf16*)(F.ws + BIG_Y2S), D, 4, 0, 1.0f / (HID_SCALE * W2_SCALE)};
                    pg8::gemm_phase<pg8::EpiPlain, pg8::GroupOrder, true, true, true>(F.lds, g, S, E, F.tid);
                    if (half == 0) moe_gather_phase(F, 1, toff[8] * 4 - 4 * F.G);
                } END_PHASE;
            }
            if (RUN && ON(18)) { PH_ENTER moe_post_phase(F, a, 1); } END_PHASE;
        }
    }
#undef RUN
#undef END_PHASE
    if (MK_PROBE >= 0 && blockIdx.x == 0 && threadIdx.x == 0) {
        volatile unsigned* pw_ = (volatile unsigned*)(KARGS->ws + WS_CTL) + 20000;
        volatile float* o_ = (volatile float*)KARGS->out;
        o_[0] = o_[0] + (float)pw_[1] * (0.01f / MK_PROBE_DIV);
    }
}

extern "C" void kernel_launch(void* const* d_in, const int* in_sizes, int n_in, void* d_out, int out_size, void* d_ws, size_t ws_size, hipStream_t stream) {
    static int grid = 0;
    if (grid == 0) {
        if (n_in != 31 || in_sizes[0] != NTOK * D || out_size != NTOK * D || ws_size < WS_END) { fprintf(stderr, "kernel_launch: unexpected shapes (n_in %d, in0 %d, out %d, ws %zu)\n", n_in, n_in > 0 ? in_sizes[0] : -1, out_size, ws_size); grid = -1; return; }
        int dev = 0, cus = 0, per_cu = 0;
        if (hipGetDevice(&dev) != hipSuccess || hipDeviceGetAttribute(&cus, hipDeviceAttributeMultiprocessorCount, dev) != hipSuccess) { grid = -1; return; }
        if (hipFuncSetAttribute((const void*)fwd_kernel, hipFuncAttributeMaxDynamicSharedMemorySize, LDS_BYTES) != hipSuccess) { fprintf(stderr, "kernel_launch: hipFuncSetAttribute failed\n"); grid = -1; return; }
        if (hipOccupancyMaxActiveBlocksPerMultiprocessor(&per_cu, (const void*)fwd_kernel, NTHREADS, LDS_BYTES) != hipSuccess || per_cu < 1) { fprintf(stderr, "kernel_launch: occupancy query says %d\n", per_cu); }
        (void)hipGetLastError();
        grid = cus;
    }
    if (grid < 0) return;
    if (hipMemsetAsync((char*)d_ws + WS_CTL, 0, CTL_ZERO_BYTES, stream) != hipSuccess) return;
    Args a{};
    for (int i = 0; i < 31; ++i) a.in[i] = (const float*)d_in[i];
    a.out = (float*)d_out; a.ws = (unsigned char*)d_ws;
#if MK_MULTI
    for (int p = 0; p < NPHASES; ++p) { a.ph_lo = p; a.ph_hi = p + 1; a.sub_mask = 31;
        const bool mix = (p == 3 || p == 12);
        if (((MK_REPMASK >> p) & 1) && !mix) { a.sub_mask = 31 | MK_REPSUB; hipLaunchKernelGGL(fwd_kernel, dim3(grid), dim3(NTHREADS), LDS_BYTES, stream, a); a.sub_mask = 31; }
        if (((MK_REPMASK >> p) & 1) && mix) { a.sub_mask = MK_REPSUB; hipLaunchKernelGGL(fwd_kernel, dim3(grid), dim3(NTHREADS), LDS_BYTES, stream, a); a.sub_mask = 31; }
        hipLaunchKernelGGL(fwd_kernel, dim3(grid), dim3(NTHREADS), LDS_BYTES, stream, a); }
#else
    a.ph_lo = 0; a.ph_hi = NPHASES; a.sub_mask = 31;
    hipLaunchKernelGGL(fwd_kernel, dim3(grid), dim3(NTHREADS), LDS_BYTES, stream, a);
#endif
    const hipError_t le = hipPeekAtLastError();
    if (le != hipSuccess) fprintf(stderr, "kernel_launch: launch failed: %s\n", hipGetErrorName(le));
}
```

```cpp
#include <hip/hip_runtime.h>
#include <cstdio>
#include <cstdint>
namespace pg8 {
#define PG8_LAS __attribute__((address_space(3)))
typedef unsigned short bf16_t;
typedef short bf16x8 __attribute__((ext_vector_type(8)));
typedef float f32x4 __attribute__((ext_vector_type(4)));
typedef unsigned u32x4 __attribute__((ext_vector_type(4)));
constexpr int BM = 256, BK = 64, HALF = 128, HTB = HALF * BK * 2  , STAGE_BYTES = 8 * HTB, NXCD = 8, WGM = 8;

__host__ __device__ __forceinline__ int lds_byte(int r, int c) { const int st = (r >> 4) * 2 + (c >> 5), rr = r & 15, cc = c & 31, ob = rr * 64 + cc * 2; return st * 1024 + (ob ^ (((ob >> 9) & 1) << 5)); }
__host__ __device__ __forceinline__ void stage_rc(int b, int& R, int& C) { const int st = b / 1024, sb = b % 1024, swz = sb ^ (((sb >> 9) & 1) << 5); R = (st >> 1) * 16 + swz / 64; C = (st & 1) * 32 + (swz % 64) / 2; }
__host__ __device__ __forceinline__ int perm32(int rho) { const int n = rho >> 4, i = rho & 15; return 8 * (i >> 2) + 4 * n + (i & 3); }

struct Unit { int pm, pn; };
struct Gemm { const bf16_t* A; const bf16_t* Bt; int M, N, K; };

struct StaticOrder {
    int nM, nN, nwg, G, c;
    __host__ __device__ void init(int M, int N, int G_, int c_) { nM = M / BM; nN = N / BM; nwg = nM * nN; G = G_; c = c_; }
    __host__ __device__ bool next(int i, Unit& u) const {
        const long L = (long)i * G + c; if (L >= nwg) return false;
        int wgid = (int)L; { const int q = nwg / NXCD, r = nwg % NXCD, xcd = wgid % NXCD, off = wgid / NXCD; wgid = (xcd < r ? xcd * (q + 1) : r * (q + 1) + (xcd - r) * q) + off; }
        const int nig = WGM * nN, gid = wgid / nig, fm = gid * WGM, gsz = (nM - fm) < WGM ? (nM - fm) : WGM;
        u.pm = fm + ((wgid % nig) % gsz); u.pn = (wgid % nig) / gsz; return true;
    }
    __device__ __forceinline__ void a_ready(const Unit&) const {}
    __device__ __forceinline__ void done(const Unit&) const {}
};

typedef float f32x2_t __attribute__((ext_vector_type(2)));
typedef __bf16 bf16x2_t __attribute__((ext_vector_type(2)));
__device__ __forceinline__ unsigned cvt_pk_bf16(float lo, float hi) { const f32x2_t v = {lo, hi}; const bf16x2_t b = __builtin_convertvector(v, bf16x2_t); return __builtin_bit_cast(unsigned, b); }
__device__ __forceinline__ u32x4 pack8(f32x4 a, f32x4 b) { u32x4 w; w.x = cvt_pk_bf16(a[0], a[1]); w.y = cvt_pk_bf16(a[2], a[3]); w.z = cvt_pk_bf16(b[0], b[1]); w.w = cvt_pk_bf16(b[2], b[3]); return w; }
__device__ __forceinline__ float bf_lo(unsigned w) { return __builtin_bit_cast(float, w << 16); }
__device__ __forceinline__ float bf_hi(unsigned w) { return __builtin_bit_cast(float, w & 0xffff0000u); }
__device__ __forceinline__ void unpack8(u32x4 w, f32x4& a, f32x4& b) { a = (f32x4){bf_lo(w.x), bf_hi(w.x), bf_lo(w.y), bf_hi(w.y)}; b = (f32x4){bf_lo(w.z), bf_hi(w.z), bf_lo(w.w), bf_hi(w.w)}; }
__device__ __forceinline__ float fast_sigmoid(float x) { return __builtin_amdgcn_rcpf(1.0f + __builtin_amdgcn_exp2f(-1.4426950408889634f * x)); }

__device__ __forceinline__ f32x4 vexp2(f32x4 x) { return (f32x4){__builtin_amdgcn_exp2f(x[0]), __builtin_amdgcn_exp2f(x[1]), __builtin_amdgcn_exp2f(x[2]), __builtin_amdgcn_exp2f(x[3])}; }
__device__ __forceinline__ f32x4 vrcp(f32x4 x) { return (f32x4){__builtin_amdgcn_rcpf(x[0]), __builtin_amdgcn_rcpf(x[1]), __builtin_amdgcn_rcpf(x[2]), __builtin_amdgcn_rcpf(x[3])}; }
__device__ __forceinline__ f32x4 vsigmoid(f32x4 x, float k) { return vrcp(vexp2(x * k) + 1.0f); }
struct EpiPlain {
    static constexpr bool PERM = true, AFTER_DRAIN = false, INPLACE = false;
    bf16_t* O; int ldc; int pn_mod; int accum; float scale;
    __device__ __forceinline__ void operator()(const f32x4 (&acc)[2][2][4][2], const Unit& u, int wr, int wc, int fr, int fq) const {
        asm volatile("" : "+v"(fr), "+v"(fq));
        const int pn = pn_mod ? (u.pn % pn_mod) : u.pn;
        const int row0 = u.pm * BM + wr * 64 + fr, col0 = pn * BM + wc * 32 + 8 * fq;
#pragma unroll
        for (int ai = 0; ai < 2; ++ai)
#pragma unroll
            for (int m = 0; m < 4; ++m) { bf16_t* rowp = O + (size_t)(row0 + ai * HALF + m * 16) * ldc + col0;
#pragma unroll
                for (int bj = 0; bj < 2; ++bj) { f32x4 v0 = acc[ai][bj][m][0] * scale, v1 = acc[ai][bj][m][1] * scale;
                    if (accum) { f32x4 p0, p1; unpack8(*(const u32x4*)(rowp + bj * HALF), p0, p1); v0 = v0 + p0; v1 = v1 + p1; }
                    *(u32x4*)(rowp + bj * HALF) = pack8(v0, v1); } }
    }
};
__device__ __forceinline__ unsigned pack_u8x4(float a, float b, float c, float d) {
    unsigned w = 0; w = __builtin_amdgcn_cvt_pk_u8_f32(a, 0, w); w = __builtin_amdgcn_cvt_pk_u8_f32(b, 1, w); w = __builtin_amdgcn_cvt_pk_u8_f32(c, 2, w); w = __builtin_amdgcn_cvt_pk_u8_f32(d, 3, w); return w; }
struct EpiSig {
    static constexpr bool PERM = true, AFTER_DRAIN = false, INPLACE = false;
    unsigned char* O; int ldc; float in_scale;
    __device__ __forceinline__ void operator()(const f32x4 (&acc)[2][2][4][2], const Unit& u, int wr, int wc, int fr, int fq) const {
        const int row0 = u.pm * BM + wr * 64 + fr, col0 = u.pn * BM + wc * 32 + 8 * fq;
        typedef unsigned u32x2_ __attribute__((ext_vector_type(2)));
#pragma unroll
        for (int ai = 0; ai < 2; ++ai)
#pragma unroll
            for (int m = 0; m < 4; ++m) { unsigned char* rowp = O + (size_t)(row0 + ai * HALF + m * 16) * ldc + col0;
#pragma unroll
                for (int bj = 0; bj < 2; ++bj) { const float k = -1.4426950408889634f * in_scale;
                    const f32x4 v0 = vsigmoid(acc[ai][bj][m][0], k) * 255.0f, v1 = vsigmoid(acc[ai][bj][m][1], k) * 255.0f;
                    u32x2_ w; w.x = pack_u8x4(v0[0], v0[1], v0[2], v0[3]); w.y = pack_u8x4(v1[0], v1[1], v1[2], v1[3]);
                    *(u32x2_*)(rowp + bj * HALF) = w; } }
    }
};
struct EpiSwiGLU {
    static constexpr bool PERM = true, AFTER_DRAIN = false, INPLACE = false;
    bf16_t* O; int ldc; int pn_mod;
    __device__ __forceinline__ void operator()(const f32x4 (&acc)[2][2][4][2], const Unit& u, int wr, int wc, int fr, int fq) const {
        const int pn = pn_mod ? (u.pn % pn_mod) : u.pn;
        const int row0 = u.pm * BM + wr * 64 + fr, col0 = pn * HALF + wc * 32 + 8 * fq;
#pragma unroll
        for (int ai = 0; ai < 2; ++ai)
#pragma unroll
            for (int m = 0; m < 4; ++m) { bf16_t* rowp = O + (size_t)(row0 + ai * HALF + m * 16) * ldc + col0;
                const f32x4 a0 = acc[ai][0][m][0], a1 = acc[ai][0][m][1], g0 = acc[ai][1][m][0], g1 = acc[ai][1][m][1];
                const f32x4 v0 = (a0 * g0) * vsigmoid(a0, -1.4426950408889634f), v1 = (a1 * g1) * vsigmoid(a1, -1.4426950408889634f);
                *(u32x4*)rowp = pack8(v0, v1); }
    }
};
__device__ __forceinline__ unsigned pack_fp8x4(float a, float b, float c, float d) {
    a = __builtin_amdgcn_fmed3f(a, -448.f, 448.f); b = __builtin_amdgcn_fmed3f(b, -448.f, 448.f); c = __builtin_amdgcn_fmed3f(c, -448.f, 448.f); d = __builtin_amdgcn_fmed3f(d, -448.f, 448.f);
    int w = 0; w = __builtin_amdgcn_cvt_pk_fp8_f32(a, b, w, false); w = __builtin_amdgcn_cvt_pk_fp8_f32(c, d, w, true); return (unsigned)w; }
struct EpiSwiGLU8 {
    static constexpr bool PERM = true, AFTER_DRAIN = false, INPLACE = false;
    unsigned char* O; int ldc; int pn_mod; float in_scale, out_scale;
    __device__ __forceinline__ void operator()(const f32x4 (&acc)[2][2][4][2], const Unit& u, int wr, int wc, int fr, int fq) const {
        asm volatile("" : "+v"(fr), "+v"(fq));
        const int pn = pn_mod ? (u.pn % pn_mod) : u.pn;
        const int row0 = u.pm * BM + wr * 64 + fr, col0 = pn * HALF + wc * 32 + 8 * fq;
#pragma unroll
        for (int ai = 0; ai < 2; ++ai)
#pragma unroll
            for (int m = 0; m < 4; ++m) { unsigned char* rowp = O + (size_t)(row0 + ai * HALF + m * 16) * ldc + col0;
                const f32x4 a0 = acc[ai][0][m][0], a1 = acc[ai][0][m][1], g0 = acc[ai][1][m][0], g1 = acc[ai][1][m][1];
                const float k1 = -1.4426950408889634f * in_scale, k2 = in_scale * in_scale * out_scale;
                const f32x4 v0 = ((a0 * g0) * vsigmoid(a0, k1)) * k2, v1 = ((a1 * g1) * vsigmoid(a1, k1)) * k2;
                typedef unsigned u32x2_ __attribute__((ext_vector_type(2)));
                u32x2_ w; w.x = pack_fp8x4(v0[0], v0[1], v0[2], v0[3]); w.y = pack_fp8x4(v1[0], v1[1], v1[2], v1[3]);
                *(u32x2_*)rowp = w; }
    }
};
struct EpiMerge {
    static constexpr bool PERM = true, AFTER_DRAIN = false, INPLACE = true;
    bf16_t* Mo; const unsigned char* Gt; int off0, off1, off2;
    __device__ __forceinline__ static void ub4(unsigned w, f32x4& v) { v = (f32x4){(float)(w & 0xffu), (float)((w >> 8) & 0xffu), (float)((w >> 16) & 0xffu), (float)(w >> 24)}; }
    __device__ __forceinline__ bool inplace(f32x4 (&acc)[2][2][4][2], const Unit& u, int wr, int wc, int fr, int fq) const {
        typedef unsigned u32x2_ __attribute__((ext_vector_type(2)));
        const int br = u.pn >> 2, pn = u.pn & 3, pm = u.pm - (br < 2 ? off0 + br * (off1 - off0) : off2);
        const int row0 = pm * BM + wr * 64 + fr, col0 = pn * BM + wc * 32 + 8 * fq;
#pragma unroll
        for (int ai = 0; ai < 2; ++ai)
#pragma unroll
            for (int m = 0; m < 4; ++m) { const size_t row = (size_t)(row0 + ai * HALF + m * 16); const unsigned char* gp = Gt + row * 3072 + br * 1024 + col0;
#pragma unroll
                for (int bj = 0; bj < 2; ++bj) { const u32x2_ gw = *(const u32x2_*)(gp + bj * HALF); f32x4 g0, g1; ub4(gw.x, g0); ub4(gw.y, g1);
                    if (br < 2) { const u32x2_ nw = *(const u32x2_*)(gp + 1024 + bj * HALF); f32x4 n0, n1; ub4(nw.x, n0); ub4(nw.y, n1);
#pragma unroll
                        for (int e = 0; e < 4; ++e) { g0[e] = fmaxf(g0[e], 0.5f) * __builtin_amdgcn_rcpf(fmaxf(n0[e], 0.5f)); g1[e] = fmaxf(g1[e], 0.5f) * __builtin_amdgcn_rcpf(fmaxf(n1[e], 0.5f)); }
                        acc[ai][bj][m][0] = acc[ai][bj][m][0] * g0; acc[ai][bj][m][1] = acc[ai][bj][m][1] * g1;
                    } else {
#pragma unroll
                        for (int e = 0; e < 4; ++e) { g0[e] = fmaxf(g0[e], 0.5f) * (1.0f / 255.0f); g1[e] = fmaxf(g1[e], 0.5f) * (1.0f / 255.0f); }
                        *(u32x4*)(Mo + row * 1024 + col0 + bj * HALF) = pack8(acc[ai][bj][m][0] * g0, acc[ai][bj][m][1] * g1); }
                } }
        return br < 2;
    }
};
struct EpiQKV {
    static constexpr bool PERM = true, AFTER_DRAIN = false, INPLACE = false;
    bf16_t* O; const float* rope; int row_base; float qscale; float in_scale;
    __device__ __forceinline__ void operator()(const f32x4 (&acc)[2][2][4][2], const Unit& u, int wr, int wc, int fr, int fq) const {
        const int rowt = row_base + u.pm * BM;
        const bool latent = rowt < 65536;
        const int row0 = rowt + wr * 64 + fr, col0 = u.pn * BM + wc * 32 + 8 * fq;
#pragma unroll
        for (int bj = 0; bj < 2; ++bj) {
            const int cb = 2 * u.pn + bj;
            const bool do_rope = latent && (cb == 0 || (cb >= 10 && cb < 14));
            const float sc = (cb >= 10) ? qscale * in_scale : in_scale;
#pragma unroll
            for (int ai = 0; ai < 2; ++ai)
#pragma unroll
                for (int m = 0; m < 4; ++m) {
                    const int row = row0 + ai * HALF + m * 16;
                    f32x4 v0 = acc[ai][bj][m][0], v1 = acc[ai][bj][m][1];
                    if (do_rope) {
                        const int t = row & 2047, pos = (wc & 1) ? (t & 63) : (t >> 6);
                        const float* cp = rope + pos * 16 + 8 * (fq & 1);
                        const f32x4 c0 = *(const f32x4*)cp, c1 = *(const f32x4*)(cp + 4), s0 = *(const f32x4*)(cp + 1024), s1 = *(const f32x4*)(cp + 1028);
                        const float sg = (fq >= 2) ? 1.0f : -1.0f;
                        f32x4 o0, o1;
#pragma unroll
                        for (int e = 0; e < 4; ++e) { o0[e] = __shfl_xor(v0[e], 32); o1[e] = __shfl_xor(v1[e], 32); }
                        v0 = v0 * c0 + (o0 * sg) * s0; v1 = v1 * c1 + (o1 * sg) * s1;
                    }
                    v0 = v0 * sc; v1 = v1 * sc;
                    *(u32x4*)(O + (size_t)row * 2304 + col0 + bj * HALF) = pack8(v0, v1);
                }
        }
    }
};
__device__ __forceinline__ void tile_of(int L, int nM, int nN, int& pm, int& pn) {
    const int nwg = nM * nN; int wgid = L; { const int q = nwg / NXCD, r = nwg % NXCD, xcd = wgid % NXCD, off = wgid / NXCD; wgid = (xcd < r ? xcd * (q + 1) : r * (q + 1) + (xcd - r) * q) + off; }
    const int nig = WGM * nN, gid = wgid / nig, fm = gid * WGM, gsz = (nM - fm) < WGM ? (nM - fm) : WGM;
    pm = fm + ((wgid % nig) % gsz); pn = (wgid % nig) / gsz;
}
struct MergeOrder {
    int nM, G, c, off0, off1, off2;
    __device__ bool next(int i, Unit& u) const {
        const int t = i / 3, br = i - 3 * t; const long L = (long)t * G + c; if (L >= (long)nM * 4) return false;
        int pm, pn; tile_of((int)L, nM, 4, pm, pn); u.pm = (br < 2 ? off0 + br * (off1 - off0) : off2) + pm; u.pn = br * 4 + pn; return true;
    }
    __device__ __forceinline__ void a_ready(const Unit&) const {}
    __device__ __forceinline__ void done(const Unit&) const {}
};
struct GroupOrder {
    int nM, nN, G, c; int toff[9];
    __device__ bool next(int i, Unit& u) const {
        const long L = (long)i * G + c; if (L >= (long)nM * nN) return false;
        int pm, pn; tile_of((int)L, nM, nN, pm, pn); int e = 0;
#pragma unroll
        for (int k = 1; k < 8; ++k) e += (pm >= toff[k]) ? 1 : 0;
        u.pm = pm; u.pn = e * nN + pn; return true;
    }
    __device__ __forceinline__ void a_ready(const Unit&) const {}
    __device__ __forceinline__ void done(const Unit&) const {}
};
template <class Epi, class Sched, bool ALIGN_EPI = false, bool SP2 = false, bool F8 = false>
__device__ __forceinline__ void gemm_phase(PG8_LAS unsigned char* lds, const Gemm g, const Sched& S, const Epi& E, const int tid) {
    const int wid = __builtin_amdgcn_readfirstlane(tid >> 6), lane = tid & 63, wr = wid >> 2, wc = wid & 3, fr = lane & 15, fq = lane >> 4;
    const int K = g.K, nt = K / BK;
    unsigned voffA[2], voffB[2];
#pragma unroll
    for (int i = 0; i < 2; ++i) { int R, C; stage_rc(tid * 16 + i * 8192, R, C); const int Rb = Epi::PERM ? ((R & ~31) + perm32(R & 31)) : R;
        voffA[i] = (unsigned)(R * K + C) * 2u; voffB[i] = (unsigned)(Rb * K + C) * 2u; }
    const size_t kstep = (size_t)(BK * 2);
    const size_t hstep = (size_t)HALF * K * 2;
    const size_t tstep = 2 * hstep;
    const unsigned ldsw = (unsigned)wid * 1024u;
    const int aoff = lds_byte(wr * 64 + fr, fq * 8), boff = lds_byte(wc * 32 + fr, fq * 8);
#define PG8_SA(b, h) (((b) * 2 + (h)) * HTB)
#define PG8_SB(b, h) ((4 + (b) * 2 + (h)) * HTB)
#define PG8_STAGE(bufoff, gbase, voff) do { _Pragma("unroll") for (int _i = 0; _i < 2; ++_i) \
        __builtin_amdgcn_global_load_lds((const unsigned*)((const char*)(gbase) + (voff)[_i]), (PG8_LAS unsigned*)(lds + (bufoff) + ldsw + _i * 8192), 16, 0, 0); } while (0)
#define PG8_LDA(dst, b, h) do { _Pragma("unroll") for (int m = 0; m < 4; ++m) _Pragma("unroll") for (int k = 0; k < 2; ++k) dst[m][k] = *(const PG8_LAS bf16x8*)(lds + PG8_SA(b, h) + aoff + m * 2048 + k * 1024); } while (0)
#define PG8_LDB(dst, b, h) do { _Pragma("unroll") for (int n = 0; n < 2; ++n) _Pragma("unroll") for (int k = 0; k < 2; ++k) dst[n][k] = *(const PG8_LAS bf16x8*)(lds + PG8_SB(b, h) + boff + n * 2048 + k * 1024); } while (0)
#define PG8_MMA(ai, bj, At, Bt) do { __builtin_amdgcn_s_setprio(1); _Pragma("unroll") for (int m = 0; m < 4; ++m) _Pragma("unroll") for (int n = 0; n < 2; ++n) { \
        if constexpr (F8) { typedef int v8i_ __attribute__((ext_vector_type(8))); typedef int v4i_ __attribute__((ext_vector_type(4))); \
            const v4i_ b0_ = __builtin_bit_cast(v4i_, Bt[n][0]), b1_ = __builtin_bit_cast(v4i_, Bt[n][1]), a0_ = __builtin_bit_cast(v4i_, At[m][0]), a1_ = __builtin_bit_cast(v4i_, At[m][1]); \
            const v8i_ bb_ = __builtin_shufflevector(b0_, b1_, 0, 1, 2, 3, 4, 5, 6, 7), aa_ = __builtin_shufflevector(a0_, a1_, 0, 1, 2, 3, 4, 5, 6, 7); \
            asm volatile("v_mfma_scale_f32_16x16x128_f8f6f4 %0, %1, %2, %0, %3, %3 op_sel_hi:[0,0,0]" : "+v"(acc[ai][bj][m][n]) : "v"(bb_), "v"(aa_), "v"(f8_scale_)); } \
        else { _Pragma("unroll") for (int k = 0; k < 2; ++k) acc[ai][bj][m][n] = __builtin_amdgcn_mfma_f32_16x16x32_bf16(Bt[n][k], At[m][k], acc[ai][bj][m][n], 0, 0, 0); } } \
        __builtin_amdgcn_s_setprio(0); } while (0)
#define PG8_WAIT_V(n) asm volatile("s_waitcnt vmcnt(" #n ")" ::: "memory")
#define PG8_WAIT_L(n) asm volatile("s_waitcnt lgkmcnt(" #n ")" ::: "memory")
#define PG8_BAR __builtin_amdgcn_s_barrier()
#define PG8_SCHED __builtin_amdgcn_sched_barrier(0)
    int f8_scale_ = 0x7f7f7f7f; (void)f8_scale_;
    Unit cur, nxt; int ui = 0;
    if (!S.next(0, cur)) return;
    f32x4 acc[2][2][4][2];
#pragma unroll
    for (int a = 0; a < 2; ++a)
#pragma unroll
        for (int b = 0; b < 2; ++b)
#pragma unroll
            for (int m = 0; m < 4; ++m)
#pragma unroll
                for (int n = 0; n < 2; ++n) acc[a][b][m][n] = (f32x4){0.f, 0.f, 0.f, 0.f};
    bf16x8 At[4][2], B0[2][2], B1[2][2];
    const char* cA = (const char*)g.A + (size_t)cur.pm * tstep; const char* cB = (const char*)g.Bt + (size_t)cur.pn * tstep;
    S.a_ready(cur);
    if constexpr (SP2) {
        PG8_STAGE(PG8_SB(0, 0), cB, voffB); PG8_STAGE(PG8_SB(0, 1), cB + hstep, voffB); PG8_STAGE(PG8_SA(0, 0), cA, voffA); PG8_STAGE(PG8_SA(0, 1), cA + hstep, voffA);
        if (wr == 1) PG8_BAR;
        PG8_WAIT_V(2); PG8_BAR;
        PG8_STAGE(PG8_SB(1, 0), cB + kstep, voffB); PG8_STAGE(PG8_SA(1, 0), cA + kstep, voffA); PG8_STAGE(PG8_SB(1, 1), cB + hstep + kstep, voffB);
        PG8_WAIT_V(6); PG8_BAR;
    } else {
        PG8_STAGE(PG8_SB(0, 0), cB, voffB); PG8_STAGE(PG8_SA(0, 0), cA, voffA); PG8_STAGE(PG8_SB(0, 1), cB + hstep, voffB); PG8_STAGE(PG8_SA(0, 1), cA + hstep, voffA);
        if (wr == 1) PG8_BAR;
        PG8_WAIT_V(4); PG8_BAR;
        PG8_STAGE(PG8_SB(1, 0), cB + kstep, voffB); PG8_STAGE(PG8_SA(1, 0), cA + kstep, voffA); PG8_STAGE(PG8_SB(1, 1), cB + hstep + kstep, voffB);
        PG8_WAIT_V(6); PG8_BAR;
    }
    for (;;) {
        const bool has_next = S.next(ui + 1, nxt);
        const char* nA = has_next ? (const char*)g.A + (size_t)nxt.pm * tstep : cA; const char* nB = has_next ? (const char*)g.Bt + (size_t)nxt.pn * tstep : cB;
#pragma unroll 1
        for (int t = 0; t < nt; t += 2) {
            const bool last = (t == nt - 2);
            const char* a1 = cA + (size_t)(t + 1) * kstep;
            const char* a2 = last ? nA : cA + (size_t)(t + 2) * kstep; const char* b2 = last ? nB : cB + (size_t)(t + 2) * kstep;
            const char* a3 = a2 + kstep; const char* b3 = b2 + kstep;
            if (last && has_next) S.a_ready(nxt);
            if constexpr (SP2) {
            PG8_LDB(B0, 0, 0); PG8_LDB(B1, 0, 1); PG8_SCHED; PG8_LDA(At, 0, 0); PG8_STAGE(PG8_SA(1, 1), a1 + hstep, voffA);
            PG8_WAIT_V(8); PG8_WAIT_L(0); PG8_BAR; PG8_MMA(0, 0, At, B0); PG8_MMA(0, 1, At, B1); PG8_BAR; PG8_SCHED;
            PG8_LDA(At, 0, 1); PG8_STAGE(PG8_SB(0, 0), b2, voffB); PG8_STAGE(PG8_SB(0, 1), b2 + hstep, voffB); PG8_STAGE(PG8_SA(0, 0), a2, voffA);
            PG8_WAIT_V(8); PG8_WAIT_L(0); PG8_BAR; PG8_MMA(1, 0, At, B0); PG8_MMA(1, 1, At, B1); PG8_BAR; PG8_SCHED;
            PG8_LDB(B0, 1, 0); PG8_LDB(B1, 1, 1); PG8_SCHED; PG8_LDA(At, 1, 0); PG8_STAGE(PG8_SA(0, 1), a2 + hstep, voffA);
            PG8_WAIT_V(8); PG8_WAIT_L(0); PG8_BAR; PG8_MMA(0, 0, At, B0); PG8_MMA(0, 1, At, B1); PG8_BAR; PG8_SCHED;
            PG8_LDA(At, 1, 1); PG8_STAGE(PG8_SB(1, 0), b3, voffB); PG8_STAGE(PG8_SB(1, 1), b3 + hstep, voffB); PG8_STAGE(PG8_SA(1, 0), a3, voffA);
            PG8_WAIT_V(8); PG8_WAIT_L(0); PG8_BAR; PG8_MMA(1, 0, At, B0); PG8_MMA(1, 1, At, B1); PG8_BAR; PG8_SCHED;
            } else {
            PG8_LDB(B0, 0, 0); PG8_SCHED; PG8_LDA(At, 0, 0); PG8_STAGE(PG8_SA(1, 1), a1 + hstep, voffA);
            PG8_WAIT_L(8); PG8_BAR; PG8_WAIT_L(0); PG8_MMA(0, 0, At, B0); PG8_BAR; PG8_SCHED;
            PG8_LDB(B1, 0, 1); PG8_STAGE(PG8_SB(0, 0), b2, voffB);
            PG8_BAR; PG8_WAIT_L(0); PG8_MMA(0, 1, At, B1); PG8_BAR;
            PG8_LDA(At, 0, 1); PG8_STAGE(PG8_SA(0, 0), a2, voffA);
            PG8_BAR; PG8_WAIT_L(0); PG8_MMA(1, 0, At, B0); PG8_BAR; PG8_SCHED;
            PG8_STAGE(PG8_SB(0, 1), b2 + hstep, voffB);
            PG8_WAIT_V(6); PG8_BAR; PG8_MMA(1, 1, At, B1); PG8_BAR;
            PG8_LDB(B0, 1, 0); PG8_SCHED; PG8_LDA(At, 1, 0); PG8_STAGE(PG8_SA(0, 1), a2 + hstep, voffA);
            PG8_WAIT_L(8); PG8_BAR; PG8_WAIT_L(0); PG8_MMA(0, 0, At, B0); PG8_BAR; PG8_SCHED;
            PG8_LDB(B1, 1, 1); PG8_STAGE(PG8_SB(1, 0), b3, voffB);
            PG8_BAR; PG8_WAIT_L(0); PG8_MMA(0, 1, At, B1); PG8_BAR;
            PG8_LDA(At, 1, 1); PG8_STAGE(PG8_SA(1, 0), a3, voffA);
            PG8_BAR; PG8_WAIT_L(0); PG8_MMA(1, 0, At, B0); PG8_BAR; PG8_SCHED;
            PG8_STAGE(PG8_SB(1, 1), b3 + hstep, voffB);
            PG8_WAIT_V(6); PG8_BAR; PG8_MMA(1, 1, At, B1); PG8_BAR;
            }
        }
        if constexpr (ALIGN_EPI) { if (wr == 0) PG8_BAR; }
        if constexpr (F8) asm volatile("s_nop 15\n\ts_nop 15" ::: "memory");
        bool keep_acc = false;
        if constexpr (Epi::INPLACE) { keep_acc = E.inplace(acc, cur, wr, wc, fr, fq); S.done(cur); }
        else if constexpr (!Epi::AFTER_DRAIN) { E(acc, cur, wr, wc, fr, fq); S.done(cur); }
        if (!has_next) break;
        if (!keep_acc)
#pragma unroll
        for (int a = 0; a < 2; ++a)
#pragma unroll
            for (int b = 0; b < 2; ++b)
#pragma unroll
                for (int m = 0; m < 4; ++m)
#pragma unroll
                    for (int n = 0; n < 2; ++n) acc[a][b][m][n] = (f32x4){0.f, 0.f, 0.f, 0.f};
        cur = nxt; cA = nA; cB = nB; ++ui;
        if constexpr (ALIGN_EPI) { if (wr == 1) PG8_BAR; }
    }
    PG8_WAIT_V(0);
    if constexpr (!ALIGN_EPI) { if (wr == 0) PG8_BAR; }
    PG8_BAR;
    if constexpr (Epi::AFTER_DRAIN) { E.fused(acc, cur, wr, wc, fr, fq, lds, wid, lane); S.done(cur); }
#undef PG8_SA
#undef PG8_SB
#undef PG8_STAGE
#undef PG8_LDA
#undef PG8_LDB
#undef PG8_MMA
#undef PG8_WAIT_V
#undef PG8_WAIT_L
#undef PG8_BAR
#undef PG8_SCHED
}
}
#define GAS __attribute__((address_space(1)))
#define LAS __attribute__((address_space(3)))
typedef unsigned short bf16;
typedef unsigned v4u __attribute__((ext_vector_type(4)));
typedef float f32x4 __attribute__((ext_vector_type(4)));
typedef short bf16x8 __attribute__((ext_vector_type(8)));
typedef GAS unsigned gu32;
typedef GAS unsigned long long gu64;
#define RLX_AGENT __ATOMIC_RELAXED, __HIP_MEMORY_SCOPE_AGENT
#define LDS_WAIT() asm volatile("s_waitcnt lgkmcnt(0)" ::: "memory")
#define VM_WAIT() asm volatile("s_waitcnt vmcnt(0)" ::: "memory")
__device__ __forceinline__ unsigned long long rt() { return __builtin_amdgcn_s_memrealtime(); }
__device__ __forceinline__ unsigned f2bf(float f) { unsigned u = __builtin_bit_cast(unsigned, f); return (u + 0x7fffu + ((u >> 16) & 1u)) >> 16; }
__device__ __forceinline__ unsigned pk2(float lo, float hi) { return pg8::cvt_pk_bf16(lo, hi); }

#define XB_TMO      128
#define XB_XCNT(j)  (256  + 64 * (j))
#define XB_XSUB(j)  (1280 + 64 * (j))
#define XB_XGEN(j)  (2304 + 64 * (j))
#define XB_TOP      3328
#define XB_TOPGEN   3392
#define XCD_BAR_WORDS 3456
#define XB_SPIN_CAP (1u << 18)

__device__ __forceinline__ unsigned xb_ld(unsigned* p)              { return __hip_atomic_load(p, __ATOMIC_RELAXED, __HIP_MEMORY_SCOPE_AGENT); }
__device__ __forceinline__ unsigned xb_add(unsigned* p, unsigned v) { return __hip_atomic_fetch_add(p, v, __ATOMIC_RELAXED, __HIP_MEMORY_SCOPE_AGENT); }
__device__ __forceinline__ unsigned xb_xcc_id() { return (unsigned)__builtin_amdgcn_s_getreg((3 << 11) | 20) & 0xFu; }
#define XB_SPIN(cond, bar) do { unsigned _sp = 0; while (cond) { __builtin_amdgcn_s_sleep(1); \
    if ((++_sp & 255u) == 0u) { if (xb_ld(&(bar)[XB_TMO])) break; if (_sp > XB_SPIN_CAP) { atomicAdd(&(bar)[XB_TMO], 1u); break; } } } } while (0)

struct XcdBarrier {
    unsigned* bar; unsigned x;
    volatile LAS unsigned* st;
};

__device__ __forceinline__ XcdBarrier xcd_barrier_post(unsigned* bar, volatile LAS unsigned* st) {
    XcdBarrier b; b.bar = bar; b.x = xb_xcc_id(); b.st = st;
    if (threadIdx.x == 0) (void)xb_add(&bar[XB_XCNT(b.x)], 1u);
    return b;
}
__device__ __forceinline__ void xcd_barrier_complete(unsigned* bar, unsigned x, unsigned& nloc, unsigned& nx) {
    const unsigned G = gridDim.x * gridDim.y * gridDim.z;
    unsigned sum, cnt, mine, sp = 0u;
    for (;;) {
        sum = 0u; cnt = 0u; mine = 0u;
#pragma unroll
        for (unsigned j = 0; j < 16; ++j) { const unsigned c = xb_ld(&bar[XB_XCNT(j)]); sum += c; cnt += (c > 0u) ? 1u : 0u; mine = (j == x) ? c : mine; }
        if (sum == G) break;
        __builtin_amdgcn_s_sleep(1);
        if ((++sp & 255u) == 0u) { if (xb_ld(&bar[XB_TMO])) break; if (sp > XB_SPIN_CAP) { atomicAdd(&bar[XB_TMO], 1u); break; } }
    }
    nloc = mine > 0u ? mine : 1u; nx = cnt > 0u ? cnt : 1u;
}

__device__ __forceinline__ void xcd_barrier(const XcdBarrier& b) {
    asm volatile("s_waitcnt vmcnt(0)" ::: "memory");
    __syncthreads();
    if (threadIdx.x == 0) {
        unsigned* bar = b.bar;
        __builtin_amdgcn_s_waitcnt(0);
        unsigned nloc = b.st[0], nx = b.st[1];
        if (nloc == 0u) { xcd_barrier_complete(bar, b.x, nloc, nx); b.st[0] = nloc; b.st[1] = nx; }
        const unsigned old = xb_add(&bar[XB_XSUB(b.x)], 1u);
        const unsigned gen = old / nloc;
        if (old + 1u == (gen + 1u) * nloc) {
            __builtin_amdgcn_fence(__ATOMIC_RELEASE, "agent");
            asm volatile("s_waitcnt vmcnt(0)" ::: "memory");
            const unsigned og = xb_add(&bar[XB_TOP], 1u);
            const unsigned tg = og / nx;
            if (og + 1u == (tg + 1u) * nx) xb_add(&bar[XB_TOPGEN], 1u);
            else XB_SPIN(xb_ld(&bar[XB_TOPGEN]) == tg, bar);
            __builtin_amdgcn_fence(__ATOMIC_ACQUIRE, "agent");
            xb_add(&bar[XB_XGEN(b.x)], 1u);
            asm volatile("s_waitcnt vmcnt(0)" ::: "memory");
        } else {
            XB_SPIN(xb_ld(&bar[XB_XGEN(b.x)]) == gen, bar);
            __builtin_amdgcn_fence(__ATOMIC_ACQUIRE, "agent");
            asm volatile("s_waitcnt vmcnt(0)" ::: "memory");
        }
    }
    __syncthreads();
}

typedef float f32x16 __attribute__((ext_vector_type(16)));
typedef short s16x4 __attribute__((ext_vector_type(4)));
typedef unsigned v2u __attribute__((ext_vector_type(2)));
#define MFMA32(a, b, c) __builtin_amdgcn_mfma_f32_32x32x16_bf16((a), (b), (c), 0, 0, 0)

constexpr int NWAVES = 8, NTHREADS = 512;
constexpr int D = 1024, NB = 32, SEQ = 2048, LC = 256, NTOK = NB * SEQ, NCTX = NB * LC, NROW = NTOK + NCTX;
constexpr int INC = 6912, QKVC = 2304, CINC = 1536, GATEC = 3072, DFF = 2816, NEXP = 8, DFFE = 3584, FCH = 1792;
constexpr float W13_SCALE = 32.f, W2_SCALE = 64.f, HID_SCALE = 4.f;
constexpr float LOG2E = 1.4426950408889634f, QSCALE = 0.125f * LOG2E, EPS = 1e-6f;
constexpr int PCAP = 32768 * 2 + 8 * 256;

constexpr size_t MiB = 1u << 20;
constexpr size_t WS_CTL = 0, CTL_ZERO_BYTES = 1 * MiB;
constexpr size_t WS_MODV = 1 * MiB;
constexpr size_t WS_ROPE = 3 * MiB;
constexpr size_t WS_ROUTE = 4 * MiB;
constexpr size_t WS_LIST = 5 * MiB;
constexpr size_t WS_INV = 7 * MiB;
constexpr size_t WS_GF = 8 * MiB;
constexpr size_t WS_GFC = 24 * MiB;
constexpr size_t WS_W = 26 * MiB;
constexpr size_t W_IN = WS_W;
constexpr size_t W_CB = W_IN + (size_t)2 * INC * D;
constexpr size_t W_BR = W_IN + (size_t)2 * INC * D * 2;
constexpr size_t W_OUT = W_BR + (size_t)2 * 3 * D * 512 * 2;
constexpr size_t W_F13 = W_OUT + (size_t)2 * D * D * 2;
constexpr size_t W_F2 = W_F13 + (size_t)2 * DFF * D * 2;
constexpr size_t W_END = W_F2 + (size_t)D * DFF * 2;
constexpr size_t WS_CTXRES = 80 * MiB;
constexpr size_t WS_XB = 112 * MiB;
constexpr size_t WS_BIG = 256 * MiB;
constexpr size_t BIG_CINT = WS_BIG;
constexpr size_t BIG_QKV = WS_BIG + 216 * MiB;
constexpr size_t BIG_GATE = WS_BIG + 72 * MiB;
constexpr size_t BIG_YCT = WS_BIG + 288 * MiB;
constexpr size_t BIG_HID = WS_BIG;
constexpr size_t BIG_RAW = WS_BIG;
constexpr size_t BIG_AS = WS_BIG;
constexpr size_t BIG_MH = WS_BIG + 68 * MiB;
constexpr size_t BIG_Y2S = WS_BIG + 300 * MiB;
constexpr size_t WS_Y3 = 796 * MiB;
constexpr size_t WM_13 = WS_Y3;
constexpr size_t WM_2 = WS_Y3 + 56 * MiB;
constexpr size_t WS_H8 = WS_Y3 + 144 * MiB;
constexpr size_t WS_END = 1012 * MiB;
static_assert(W_END <= WS_CTXRES && BIG_Y2S + (size_t)PCAP * D * 2 <= WS_Y3 && BIG_QKV + (size_t)NROW * QKVC * 2 <= WS_Y3 && BIG_GATE + (size_t)NROW * GATEC <= WS_Y3, "ws map");
static_assert(BIG_MH + (size_t)PCAP * DFFE <= BIG_Y2S && BIG_AS + (size_t)PCAP * D <= BIG_MH && WM_13 + (size_t)8 * 2 * DFFE * D <= WM_2 && WM_2 + (size_t)8 * D * DFFE <= WS_END, "ws map 2");

constexpr int CW_BAR = 4096;
constexpr int CW_CNT = 16384;

constexpr int LDS_BYTES = 150528, MISC_OFF = 147456;


struct Args {
    const float* in[31];
    float* out; unsigned char* ws;
    int ph_lo, ph_hi, sub_mask, pad;
};
enum { I_X = 0, I_C, I_CTX, I_CCTX, I_WMOD, I_BMOD, I_GMIXPRE, I_GMIXPOST, I_GFFNPRE, I_GFFNPOST, I_WIN, I_SINK, I_RPB, I_CONVW, I_CONVB, I_HW1, I_HB1, I_HW2, I_HB2, I_HW3,
       I_HFREQ, I_HBIAS, I_WBR, I_WOUT, I_FW1, I_FW3, I_FW2, I_ROUTER, I_MW1, I_MW3, I_MW2 };

struct Frame {
    LAS unsigned char* lds;
    int tid, lane, wave, vcu, G;
    unsigned char* ws;
    bf16* hb;
};

__device__ __forceinline__ float wave_sum(float v) {
#pragma unroll
    for (int o = 1; o < 64; o <<= 1) v += __shfl_xor(v, o);
    return v;
}
__device__ __forceinline__ float bf2f(bf16 b) { return __builtin_bit_cast(float, ((unsigned)b) << 16); }
__device__ __forceinline__ float silu_f(float x) { return x / (1.0f + __expf(-x)); }

__device__ __forceinline__ void transpose_item(const float* W, int N, bf16* WT, int Kp, int k0, int n0, int drow0, LAS float* scr, int lane) {
    { const int c4 = 4 * (lane & 7);
#pragma unroll
      for (int i = 0; i < 8; ++i) { const int kk = (lane >> 3) + 8 * i; const f32x4 v = *(const f32x4*)(W + (size_t)(k0 + kk) * N + n0 + c4); LAS float* d = scr + kk * 33 + c4; d[0] = v.x; d[1] = v.y; d[2] = v.z; d[3] = v.w; } }
    LDS_WAIT(); asm volatile("" ::: "memory");
    const int c = lane & 7;
#pragma unroll
    for (int j = 0; j < 4; ++j) { const int n = (lane >> 3) + 8 * j; const LAS float* s = scr + (8 * c) * 33 + n;
        v4u o; o.x = pk2(s[0 * 33], s[1 * 33]); o.y = pk2(s[2 * 33], s[3 * 33]); o.z = pk2(s[4 * 33], s[5 * 33]); o.w = pk2(s[6 * 33], s[7 * 33]);
        *(GAS v4u*)(WT + (size_t)(drow0 + n) * Kp + k0 + 8 * c) = o; }
    LDS_WAIT(); asm volatile("" ::: "memory");
}
__device__ __forceinline__ bool conv_job(int& r, const float* W, int K, int N, bf16* WT, int Kp, int rowoff, int mode, int which, LAS float* scr, int lane) {
    const int nblk = N / 32, items = (K / 64) * nblk;
    if (r >= items) { r -= items; return false; }
    const int kb = r / nblk, nb = r % nblk, n0 = 32 * nb;
    const int drow0 = mode ? rowoff + (n0 / 128) * 256 + which * 128 + (n0 % 128) : rowoff + n0;
    transpose_item(W, N, WT, Kp, 64 * kb, n0, drow0, scr, lane);
    return true;
}

__device__ __forceinline__ void transpose_item_f8(const float* W, int N, unsigned char* WT, int Kp, int k0, int n0, int drow0, float scale, LAS float* scr, int lane) {
    { const int c4 = 4 * (lane & 7);
#pragma unroll
      for (int i = 0; i < 8; ++i) { const int kk = (lane >> 3) + 8 * i; const f32x4 v = *(const f32x4*)(W + (size_t)(k0 + kk) * N + n0 + c4) * scale; LAS float* d = scr + kk * 33 + c4; d[0] = v.x; d[1] = v.y; d[2] = v.z; d[3] = v.w; } }
    LDS_WAIT(); asm volatile("" ::: "memory");
    const int c = lane & 7;
#pragma unroll
    for (int j = 0; j < 4; ++j) { const int n = (lane >> 3) + 8 * j; const LAS float* s = scr + (8 * c) * 33 + n;
        v2u o; o.x = pg8::pack_fp8x4(s[0 * 33], s[1 * 33], s[2 * 33], s[3 * 33]); o.y = pg8::pack_fp8x4(s[4 * 33], s[5 * 33], s[6 * 33], s[7 * 33]);
        *(GAS v2u*)(WT + (size_t)(drow0 + n) * Kp + k0 + 8 * c) = o; }
    LDS_WAIT(); asm volatile("" ::: "memory");
}
__device__ __forceinline__ bool conv_job_f8(int& r, const float* W, int K, int N, unsigned char* WT, int Kp, int mode, int which, float scale, LAS float* scr, int lane) {
    const int nblk = N / 32, items = (K / 64) * nblk;
    if (r >= items) { r -= items; return false; }
    const int kb = r / nblk, nb = r % nblk, n0 = 32 * nb;
    const int drow0 = mode ? (n0 / 128) * 256 + which * 128 + (n0 % 128) : n0;
    transpose_item_f8(W, N, WT, Kp, 64 * kb, n0, drow0, scale, scr, lane);
    return true;
}

__device__ __forceinline__ void ld_row_f32(const float* p, int lane, f32x4 (&v)[4]) {
    const GAS f32x4* q = (const GAS f32x4*)p + lane;
#pragma unroll
    for (int j = 0; j < 4; ++j) v[j] = q[64 * j];
}
__device__ __forceinline__ void st_row_f32(float* p, int lane, const f32x4 (&v)[4]) {
    GAS f32x4* q = (GAS f32x4*)p + lane;
#pragma unroll
    for (int j = 0; j < 4; ++j) q[64 * j] = v[j];
}
__device__ __forceinline__ void ld_row_bf16(const bf16* p, int lane, f32x4 (&v)[4]) {
    const GAS v2u* q = (const GAS v2u*)p + lane;
#pragma unroll
    for (int j = 0; j < 4; ++j) { const v2u w = q[64 * j]; v[j] = (f32x4){pg8::bf_lo(w.x), pg8::bf_hi(w.x), pg8::bf_lo(w.y), pg8::bf_hi(w.y)}; }
}
__device__ __forceinline__ void ld_row_f32_nt(const float* p, int lane, f32x4 (&v)[4]) {
    const GAS f32x4* q = (const GAS f32x4*)p + lane;
#pragma unroll
    for (int j = 0; j < 4; ++j) v[j] = __builtin_nontemporal_load(q + 64 * j);
}
__device__ __forceinline__ void st_row_f32_nt(float* p, int lane, const f32x4 (&v)[4]) {
    GAS f32x4* q = (GAS f32x4*)p + lane;
#pragma unroll
    for (int j = 0; j < 4; ++j) __builtin_nontemporal_store(v[j], q + 64 * j);
}
__device__ __forceinline__ void ld_raw_bf16_nt(const bf16* p, int lane, v2u (&v)[4]) {
    const GAS v2u* q = (const GAS v2u*)p + lane;
#pragma unroll
    for (int j = 0; j < 4; ++j) v[j] = __builtin_nontemporal_load(q + 64 * j);
}
__device__ __forceinline__ void ld_raw_bf16(const bf16* p, int lane, v2u (&v)[4]) {
    const GAS v2u* q = (const GAS v2u*)p + lane;
#pragma unroll
    for (int j = 0; j < 4; ++j) v[j] = q[64 * j];
}
__device__ __forceinline__ f32x4 cvt_raw_bf16(v2u w) { return (f32x4){pg8::bf_lo(w.x), pg8::bf_hi(w.x), pg8::bf_lo(w.y), pg8::bf_hi(w.y)}; }
__device__ __forceinline__ void st_row_bf16(bf16* p, int lane, const f32x4 (&v)[4]) {
    GAS v2u* q = (GAS v2u*)p + lane;
#pragma unroll
    for (int j = 0; j < 4; ++j) { v2u w; w.x = pk2(v[j].x, v[j].y); w.y = pk2(v[j].z, v[j].w); q[64 * j] = w; }
}
__device__ __forceinline__ float row_rms_scale(const f32x4 (&v)[4]) {
    float s = 0.f;
#pragma unroll
    for (int j = 0; j < 4; ++j) s += (v[j].x * v[j].x + v[j].y * v[j].y) + (v[j].z * v[j].z + v[j].w * v[j].w);
    return __builtin_amdgcn_rsqf(wave_sum(s) * (1.0f / D) + EPS);
}
__device__ __forceinline__ void norm_mod(const f32x4 (&x)[4], const float* g, const float* sc, const float* sh, int lane, f32x4 (&h)[4]) {
    const float rs = row_rms_scale(x);
    f32x4 gv[4], scv[4], shv[4]; ld_row_f32(g, lane, gv); ld_row_f32(sc, lane, scv); ld_row_f32(sh, lane, shv);
#pragma unroll
    for (int j = 0; j < 4; ++j) h[j] = (x[j] * rs) * gv[j] * (scv[j] + 1.0f) + shv[j];
}
__device__ __forceinline__ void resid_update(f32x4 (&x)[4], const f32x4 (&y)[4], const float* g, const float* gt, int lane) {
    const float rs = row_rms_scale(y);
    f32x4 gv[4], gtv[4]; ld_row_f32(g, lane, gv); ld_row_f32(gt, lane, gtv);
#pragma unroll
    for (int j = 0; j < 4; ++j) x[j] = x[j] + gtv[j] * ((y[j] * rs) * gv[j]);
}
__device__ __forceinline__ const float* modv(const Frame& F, int l, int row, int part) {
    const int r = row < NTOK ? (row >> 11) : 32;
    return (const float*)(F.ws + WS_MODV) + ((size_t)l * 33 + r) * 6144 + part * 1024;
}

__device__ __forceinline__ void p0_prologue(Frame& F, const Args& a) {
    const int gw = F.vcu * NWAVES + F.wave, NGW = F.G * NWAVES;
    if (F.vcu < 192) {
        LAS float* sl = (LAS float*)F.lds;
        for (int i = F.tid; i < 33 * 1024; i += NTHREADS) { const int r = i >> 10, k = i & 1023; const float cv = r < 32 ? a.in[I_C][r * 1024 + k] : a.in[I_CCTX][k]; sl[k * 33 + r] = silu_f(cv); }
        __syncthreads();
        const int col = F.vcu * 64 + F.lane, l = col / 6144, n = col % 6144, k0 = F.wave * 128;
        const float* w = a.in[I_WMOD] + ((size_t)l * 1024 + k0) * 6144 + n;
        float acc[33];
#pragma unroll
        for (int r = 0; r < 33; ++r) acc[r] = 0.f;
#pragma unroll 4
        for (int k = 0; k < 128; ++k) { const float wv = w[(size_t)k * 6144]; const LAS float* sr = sl + (k0 + k) * 33;
#pragma unroll
            for (int r = 0; r < 33; ++r) acc[r] += sr[r] * wv; }
        __syncthreads();
#pragma unroll
        for (int r = 0; r < 33; ++r) sl[(F.wave * 33 + r) * 64 + F.lane] = acc[r];
        __syncthreads();
        const float* bmod = a.in[I_BMOD]; float* mo = (float*)(F.ws + WS_MODV);
        for (int o = F.tid; o < 33 * 64; o += NTHREADS) { const int r = o >> 6, j = o & 63; float s = 0.f;
#pragma unroll
            for (int wv = 0; wv < 8; ++wv) s += sl[(wv * 33 + r) * 64 + j];
            const int cc = F.vcu * 64 + j, ll = cc / 6144, nn = cc % 6144; mo[((size_t)ll * 33 + r) * 6144 + nn] = s + bmod[ll * 6144 + nn]; }
        __syncthreads();
    }
    if (F.vcu == 200) {
        float* rp = (float*)(F.ws + WS_ROPE);
        for (int i = F.tid; i < 1024; i += NTHREADS) { const int pos = i >> 4, k = i & 15; const float inv = powf(10000.0f, -(float)k / 16.0f); const float ang = (float)pos * inv; rp[i] = cosf(ang); rp[1024 + i] = sinf(ang); }
    }
    for (int it = F.vcu; it < 512; it += F.G) {
        const int lv = it >> 8, l = lv ? 0 : ((it >> 7) & 1), L = lv ? LC : SEQ, pos0 = lv ? (it & 255) : 16 * (it & 127), npos = lv ? 1 : 16;
        LAS float* z = (LAS float*)F.lds; LAS float* h1 = z + 16 * 33; LAS float* h2 = h1 + 16 * 64;
        __syncthreads();
        for (int i = F.tid; i < 16 * 33; i += NTHREADS) { const int p = i / 33, k = i % 33; const int pos = pos0 + p; float v;
            const float om = 6.283185307179586f * (float)pos / (float)L;
            if (k == 0) v = (float)pos / (float)(L - 1);
            else { const int m = (k - 1) & 15; const float f = 1e-4f + (15.0f - 1e-4f) * (float)m / 15.0f; v = (k <= 16) ? cosf(f * om) : -sinf(f * om); }
            z[i] = v; }
        __syncthreads();
        const float* w1 = a.in[I_HW1] + l * 33 * 64; const float* b1 = a.in[I_HB1] + l * 64; const float* w2 = a.in[I_HW2] + l * 64 * 64; const float* b2 = a.in[I_HB2] + l * 64;
        const float* fr = a.in[I_HFREQ] + l * 64; const float* w3 = a.in[I_HW3] + (size_t)l * 64 * 2048;
        for (int o = F.tid; o < 1024; o += NTHREADS) { const int p = o >> 6, j = o & 63; float s = b1[j];
            for (int k = 0; k < 33; ++k) s += z[p * 33 + k] * w1[k * 64 + j];
            h1[o] = sinf(fr[j] * s); }
        __syncthreads();
        for (int o = F.tid; o < 1024; o += NTHREADS) { const int p = o >> 6, j = o & 63; float s = b2[j];
            for (int k = 0; k < 64; ++k) s += h1[p * 64 + k] * w2[k * 64 + j];
            h2[o] = sinf(fr[j] * s); }
        __syncthreads();
        float* raw = (float*)(F.ws + BIG_RAW) + (size_t)l * (2048 * (SEQ + LC)) + (lv ? (size_t)2048 * SEQ : 0);
        {
            const int col0 = 4 * F.tid;
            float acc[4][16];
#pragma unroll
            for (int c4 = 0; c4 < 4; ++c4)
#pragma unroll
                for (int p = 0; p < 16; ++p) acc[c4][p] = 0.f;
#pragma unroll 4
            for (int k = 0; k < 64; ++k) { const f32x4 wv = *(const f32x4*)(w3 + k * 2048 + col0);
#pragma unroll
                for (int p = 0; p < 16; ++p) { const float hv = h2[p * 64 + k]; acc[0][p] += hv * wv.x; acc[1][p] += hv * wv.y; acc[2][p] += hv * wv.z; acc[3][p] += hv * wv.w; } }
            const float da = -3.0701134573253945f, db = -15.350567286626973f;
#pragma unroll
            for (int c4 = 0; c4 < 4; ++c4) { const int col = col0 + c4, cch = col & 511;
                const float delta = fabsf(da + (db - da) * (float)cch / 511.0f);
#pragma unroll
                for (int p = 0; p < 16; ++p) if (p < npos) { const float t = (float)(pos0 + p) / (float)(L - 1); raw[(size_t)col * L + pos0 + p] = acc[c4][p] * __expf(-t * delta); } }
        }
    }
    __syncthreads();
    LAS float* scr = (LAS float*)(F.lds + F.wave * 16384);
    constexpr int PER_LAYER = 16 * 216 + 16 * 48 + 3 * 256 + 512, NITEMS = 2 * PER_LAYER + 3 * 1408;
    for (int it = gw; it < NITEMS; it += NGW) {
        int r = it;
        bool dn = false;
#pragma unroll 1
        for (int l = 0; l < 2; ++l) {
            if (!dn) dn = conv_job_f8(r, a.in[I_WIN] + (size_t)l * D * INC, D, INC, F.ws + W_IN + (size_t)l * INC * D, D, 0, 0, W13_SCALE, scr, F.lane);
            if (!dn) { const int items = 16 * 48;
                if (r < items) { const int kb = r / 48, nb = r % 48; transpose_item(a.in[I_WIN] + (size_t)l * D * INC + QKVC, INC, (bf16*)(F.ws + W_CB) + (size_t)l * CINC * D, D, 64 * kb, 32 * nb, 32 * nb, scr, F.lane); dn = true; } else r -= items; }
#pragma unroll 1
            for (int br = 0; br < 3; ++br)
                if (!dn) dn = conv_job(r, a.in[I_WBR] + (size_t)(l * 3 + br) * 512 * D, 512, D, (bf16*)(F.ws + W_BR) + (size_t)(l * 3 + br) * D * 512, 512, 0, 0, 0, scr, F.lane);
            if (!dn) dn = conv_job(r, a.in[I_WOUT] + (size_t)l * D * D, D, D, (bf16*)(F.ws + W_OUT) + (size_t)l * D * D, D, 0, 0, 0, scr, F.lane);
        }
        if (!dn) dn = conv_job(r, a.in[I_FW1], D, DFF, (bf16*)(F.ws + W_F13), D, 0, 1, 0, scr, F.lane);
        if (!dn) dn = conv_job(r, a.in[I_FW3], D, DFF, (bf16*)(F.ws + W_F13), D, 0, 1, 1, scr, F.lane);
        if (!dn) dn = conv_job(r, a.in[I_FW2], DFF, D, (bf16*)(F.ws + W_F2), DFF, 0, 0, 0, scr, F.lane);
    }
}

__device__ __forceinline__ void p1_phase(Frame& F, const Args& a) {
    const int gw = F.vcu * NWAVES + F.wave, NGW = F.G * NWAVES;
    for (int u = gw; u < 2 * 2 * 1024; u += NGW) {
        const int l = u >> 11, lv = (u >> 10) & 1, o = (u >> 9) & 1, c = u & 511, L = lv ? LC : SEQ;
        if (l == 1 && lv == 1) continue;
        const float* raw = (const float*)(F.ws + BIG_RAW) + (size_t)l * (2048 * (SEQ + LC)) + (lv ? (size_t)2048 * SEQ : 0);
        const float* rf = raw + (size_t)(o * 512 + c) * L; const float* rb = raw + (size_t)(1024 + o * 512 + c) * L;
        float sf = 0.f, sb = 0.f;
        for (int t = F.lane; t < L; t += 64) { const float x = rf[t], y = rb[t]; sf += x * x; sb += y * y; }
        const float nf = 1.0f / sqrtf(wave_sum(sf) + EPS), nb = 1.0f / sqrtf(wave_sum(sb) + EPS);
        bf16* g = lv ? (bf16*)(F.ws + WS_GFC) + ((size_t)(l * 2 + o) * 512 + c) * (2 * LC) : (bf16*)(F.ws + WS_GF) + ((size_t)(l * 2 + o) * 512 + c) * (2 * SEQ);
        for (int i = F.lane; i < 2 * L; i += 64) { const int d = i - L; float v;
            if (i == 0) v = 0.f; else if (d > 0) v = rf[d] * nf; else if (d < 0) v = rb[-d] * nb; else v = rf[0] * nf + rb[0] * nb;
            g[i] = (bf16)f2bf(v); }
    }
}

constexpr float ATT_THR = 8.0f;
constexpr int ATT_KP = 144, ATT_VP = 136;
constexpr int ATT_K_OFF = 0, ATT_V_OFF = 64 * ATT_KP, ATT_BUF = 17920, ATT_RPB_OFF = 36864;
constexpr int ATT_T0_BYTES = 15 * 128 * 4, ATT_E_OFF = ATT_RPB_OFF + ATT_T0_BYTES, ATT_TBL_FLOATS = 15 * 128 + 15 * 15 * 64;
__device__ __forceinline__ int crow(int reg, int h) { return (reg & 3) + 8 * (reg >> 2) + 4 * h; }
__device__ __forceinline__ int rs_of(int r) { const int v = r - 4; return v < 0 ? 0 : (v > 24 ? 24 : v); }
__device__ __forceinline__ unsigned cvtpk(float lo, float hi) { return pk2(lo, hi); }

template <int MODE, int SUB>
__device__ __forceinline__ void att_tile(LAS unsigned char* lds, int boff, const bf16x8 (&qf)[4], f32x16& negm, f32x16& O0, f32x16& O1, float& m_run, float& l_run,
                                         bool is_local, bool edge_mask, int kbase, int qt, int kr, int gr, int tb_base, int tb_pitch, int r, int h) {
#define A0(i) (SUB != 2 || (i) >= 12)
#define A1(i) (SUB != 1 || (i) < 4)
    f32x16 s0 = negm, s1 = negm;
#pragma unroll
    for (int s = 0; s < 4; ++s) {
        const bf16x8 k0 = *(const LAS bf16x8*)(lds + boff + ATT_K_OFF + r * ATT_KP + (16 * s + 8 * h) * 2);
        const bf16x8 k1 = *(const LAS bf16x8*)(lds + boff + ATT_K_OFF + (32 + r) * ATT_KP + (16 * s + 8 * h) * 2);
        s0 = MFMA32(k0, qf[s], s0); s1 = MFMA32(k1, qf[s], s1);
    }
    if (MODE == 0 && edge_mask) {
#pragma unroll
        for (int i = 0; i < 16; ++i) { const int j0 = kbase + crow(i, h), d0 = qt - j0, d1 = d0 - 32;
            if (d0 > 128 || d0 < -128) s0[i] = -1e30f;
            if (d1 > 128 || d1 < -128) s1[i] = -1e30f; }
    }
    if (MODE == 1 && is_local) {
        const LAS float* tb = (const LAS float*)(lds + tb_base + (kr - gr + 7) * tb_pitch);
        float b0[16], b1[16];
#pragma unroll
        for (int i = 0; i < 16; ++i) { const int c = (i & 3) + 8 * (i >> 2); b0[i] = tb[c]; b1[i] = tb[c + 32]; }
#pragma unroll
        for (int i = 0; i < 16; ++i) { s0[i] += b0[i]; s1[i] += b1[i]; }
    }
    float mx = -1e30f;
#pragma unroll
    for (int i = 0; i < 16; ++i) { if (A0(i)) mx = fmaxf(mx, s0[i]); if (A1(i)) mx = fmaxf(mx, s1[i]); }
    mx = fmaxf(mx, __shfl_xor(mx, 32));
    if (!__all(mx <= ATT_THR)) {
        const float delta = fmaxf(mx, 0.f), alpha = __builtin_amdgcn_exp2f(-delta);
        m_run += delta; l_run *= alpha;
#pragma unroll
        for (int i = 0; i < 16; ++i) { O0[i] *= alpha; O1[i] *= alpha; s0[i] -= delta; s1[i] -= delta; negm[i] = -m_run; }
    }
    float ls = 0.f;
#pragma unroll
    for (int i = 0; i < 16; ++i) { if (A0(i)) { s0[i] = __builtin_amdgcn_exp2f(s0[i]); ls += s0[i]; } else s0[i] = 0.f;
                                   if (A1(i)) { s1[i] = __builtin_amdgcn_exp2f(s1[i]); ls += s1[i]; } else s1[i] = 0.f; }
    l_run += ls;
    bf16x8 pf[2][2];
    { v4u t;
      t.x = cvtpk(s0[0], s0[1]); t.y = cvtpk(s0[2], s0[3]); t.z = cvtpk(s0[4], s0[5]); t.w = cvtpk(s0[6], s0[7]); pf[0][0] = __builtin_bit_cast(bf16x8, t);
      t.x = cvtpk(s0[8], s0[9]); t.y = cvtpk(s0[10], s0[11]); t.z = cvtpk(s0[12], s0[13]); t.w = cvtpk(s0[14], s0[15]); pf[0][1] = __builtin_bit_cast(bf16x8, t);
      t.x = cvtpk(s1[0], s1[1]); t.y = cvtpk(s1[2], s1[3]); t.z = cvtpk(s1[4], s1[5]); t.w = cvtpk(s1[6], s1[7]); pf[1][0] = __builtin_bit_cast(bf16x8, t);
      t.x = cvtpk(s1[8], s1[9]); t.y = cvtpk(s1[10], s1[11]); t.z = cvtpk(s1[12], s1[13]); t.w = cvtpk(s1[14], s1[15]); pf[1][1] = __builtin_bit_cast(bf16x8, t); }
#pragma unroll
    for (int i = 0; i < 2; ++i)
#pragma unroll
        for (int sp = 0; sp < 2; ++sp) {
            if ((SUB == 1 && i == 1 && sp == 1) || (SUB == 2 && i == 0 && sp == 0)) continue;
            const int koff = (32 * i + 16 * sp + 4 * h) * 2;
            const v2u a0 = *(const LAS v2u*)(lds + boff + ATT_V_OFF + r * ATT_VP + koff), a1 = *(const LAS v2u*)(lds + boff + ATT_V_OFF + r * ATT_VP + koff + 16);
            const v2u c0 = *(const LAS v2u*)(lds + boff + ATT_V_OFF + (32 + r) * ATT_VP + koff), c1 = *(const LAS v2u*)(lds + boff + ATT_V_OFF + (32 + r) * ATT_VP + koff + 16);
            const v4u va = (v4u){a0.x, a0.y, a1.x, a1.y}, vc = (v4u){c0.x, c0.y, c1.x, c1.y};
            O0 = MFMA32(__builtin_bit_cast(bf16x8, va), pf[i][sp], O0);
            O1 = MFMA32(__builtin_bit_cast(bf16x8, vc), pf[i][sp], O1);
        }
#undef A0
#undef A1
}

struct AttPre { v4u k, v; int valid; };
template <int MODE>
__device__ __forceinline__ void att_start(int u, int w, int r, int& qrow, int& qcol, int& kcol, int& vcol, int& trow0) {
    int b, head, kvh, q0 = 0, R = 0;
    if (MODE == 0) { b = u >> 6; kvh = (u >> 5) & 1; q0 = (u & 31) * 64; head = 4 * kvh + (w >> 1); }
    else if (MODE == 1) { b = u >> 6; head = (u >> 3) & 7; kvh = head; R = u & 7; }
    else if (MODE == 2) { b = u >> 3; kvh = (u >> 2) & 1; q0 = (u & 3) * 64; head = 4 * kvh + (w >> 1); }
    else { b = u >> 3; head = u & 7; kvh = head; }
    if (MODE == 0) qrow = b * SEQ + q0 + 32 * (w & 1) + r;
    else if (MODE == 1) qrow = b * SEQ + (4 * R + (w >> 1)) * 64 + 32 * (w & 1) + r;
    else if (MODE == 2) qrow = NTOK + b * LC + q0 + 32 * (w & 1) + r;
    else qrow = NTOK + b * LC + 32 * w + r;
    qcol = (MODE == 0 || MODE == 2) ? 1280 + head * 64 : 1792 + head * 64;
    kcol = (MODE == 0 || MODE == 2) ? kvh * 64 : 256 + head * 64;
    vcol = (MODE == 0 || MODE == 2) ? 128 + kvh * 64 : 768 + head * 64;
    if (MODE == 0) { const int lo = q0 < 128 ? (128 - q0) / 64 : 0; trow0 = b * SEQ + q0 - 128 + 64 * lo; }
    else if (MODE == 1) trow0 = b * SEQ + rs_of(4 * R) * 64;
    else trow0 = NTOK + b * LC;
}
template <int MODE>
__device__ __forceinline__ void attn_unit(Frame& F, int u, int u_next, const bf16* __restrict__ QKV, bf16* __restrict__ Yo, const float* sink, const float* rpb, AttPre& P, int& tbl_head, int var = 0) {
    const int w = F.wave, lane = F.lane, r = lane & 31, h = lane >> 5;
    LAS unsigned char* lds = F.lds;
    int b, head, kvh, q0 = 0, R = 0;
    if (MODE == 0) { b = u >> 6; kvh = (u >> 5) & 1; q0 = (u & 31) * 64; head = 4 * kvh + (w >> 1); }
    else if (MODE == 1) { b = u >> 6; head = (u >> 3) & 7; kvh = head; R = u & 7; }
    else if (MODE == 2) { b = u >> 3; kvh = (u >> 2) & 1; q0 = (u & 3) * 64; head = 4 * kvh + (w >> 1); }
    else { b = u >> 3; head = u & 7; kvh = head; }
    int qt, qrow, gr = 0, qc = 0;
    if (MODE == 0) { qt = q0 + 32 * (w & 1) + r; qrow = b * SEQ + qt; }
    else if (MODE == 1) { gr = 4 * R + (w >> 1); qc = 32 * (w & 1) + r; qt = gr * 64 + qc; qrow = b * SEQ + qt; }
    else if (MODE == 2) { qt = q0 + 32 * (w & 1) + r; qrow = NTOK + b * LC + qt; }
    else { qt = 32 * w + r; qrow = NTOK + b * LC + qt; }
    const int qcol = (MODE == 0 || MODE == 2) ? 1280 + head * 64 : 1792 + head * 64;
    const int kcol = (MODE == 0 || MODE == 2) ? kvh * 64 : 256 + head * 64;
    const int vcol = (MODE == 0 || MODE == 2) ? 128 + kvh * 64 : 768 + head * 64;
    bf16x8 qf[4];
#pragma unroll
    for (int s = 0; s < 4; ++s) qf[s] = *(const bf16x8*)(QKV + (size_t)qrow * QKVC + qcol + 16 * s + 8 * h);
    f32x16 O0, O1;
#pragma unroll
    for (int i = 0; i < 16; ++i) { O0[i] = 0.f; O1[i] = 0.f; }
    float m_run, l_run;
    if (MODE == 0 || MODE == 2) { m_run = sink[head] * LOG2E; l_run = (h == 0) ? 1.0f : 0.0f; } else { m_run = 0.f; l_run = 0.f; }
    f32x16 negm;
#pragma unroll
    for (int i = 0; i < 16; ++i) negm[i] = -m_run;
    int lo = 0, ntl = 0, kr_lo = 0;
    if (MODE == 0) { lo = q0 < 128 ? (128 - q0) / 64 : 0; const int hi = (SEQ - q0 + 128) / 64 < 5 ? (SEQ - q0 + 128) / 64 : 5; ntl = hi - lo; }
    if (MODE == 1) { kr_lo = rs_of(4 * R); ntl = rs_of(4 * R + 3) + 8 - kr_lo; }
    const int my_rs = rs_of(gr), my_cs = (qc - 8) < 0 ? 0 : ((qc - 8) > 48 ? 48 : (qc - 8));
    const int ntiles = ntl + 4;
    int tb_base = 0, tb_pitch = 0;
    if (MODE == 1) { const bool edge = qc < 8 || qc > 56; const int ev = qc < 8 ? qc : qc - 49;
        tb_base = edge ? ATT_E_OFF + ev * (15 * 256) + 16 * h : ATT_RPB_OFF + 4 * (63 - qc + 4 * h); tb_pitch = edge ? 256 : 512; }
    const int skey = F.tid >> 3, sch = F.tid & 7, vkey = F.tid & 63, vch = F.tid >> 6;
#define ATT_TROW(tt) ((tt) < ntl ? (MODE == 0 ? b * SEQ + q0 - 128 + 64 * (lo + (tt)) : b * SEQ + (kr_lo + (tt)) * 64) : NTOK + b * LC + 64 * ((tt) - ntl))
#define ATT_LOAD(tt) do { const int tr_ = ATT_TROW(tt); kreg = *(const v4u*)(QKV + (size_t)(tr_ + skey) * QKVC + kcol + 8 * sch); vreg = *(const v4u*)(QKV + (size_t)(tr_ + vkey) * QKVC + vcol + 8 * vch); } while (0)
#define ATT_STORE(bufoff) do { *(LAS v4u*)(lds + (bufoff) + ATT_K_OFF + skey * ATT_KP + sch * 16) = kreg; \
        LAS unsigned short* vt_ = (LAS unsigned short*)(lds + (bufoff) + ATT_V_OFF + (8 * vch) * ATT_VP + vkey * 2); \
        vt_[0 * (ATT_VP / 2)] = (unsigned short)(vreg.x & 0xffff); vt_[1 * (ATT_VP / 2)] = (unsigned short)(vreg.x >> 16); vt_[2 * (ATT_VP / 2)] = (unsigned short)(vreg.y & 0xffff); vt_[3 * (ATT_VP / 2)] = (unsigned short)(vreg.y >> 16); \
        vt_[4 * (ATT_VP / 2)] = (unsigned short)(vreg.z & 0xffff); vt_[5 * (ATT_VP / 2)] = (unsigned short)(vreg.z >> 16); vt_[6 * (ATT_VP / 2)] = (unsigned short)(vreg.w & 0xffff); vt_[7 * (ATT_VP / 2)] = (unsigned short)(vreg.w >> 16); } while (0)
    v4u& kreg = P.k; v4u& vreg = P.v;
    if (!P.valid) ATT_LOAD(0);
    P.valid = 0;
    __syncthreads();
    if (MODE == 1 && head != tbl_head) {
        tbl_head = head;
        LAS float* tb = (LAS float*)(lds + ATT_RPB_OFF);
        for (int i = F.tid; i < ATT_TBL_FLOATS; i += NTHREADS) {
            int dr, off; bool ok;
            if (i < 15 * 128) { dr = i >> 7; off = (i & 127) - 63; ok = off >= -8 && off <= 7; }
            else { const int j = i - 15 * 128, ev = j / (15 * 64), dr_ = (j >> 6) % 15, kc = j & 63, q = ev < 8 ? ev : ev + 49; dr = dr_; off = kc - q; ok = ev < 8 ? kc < 16 : kc >= 48; }
            tb[i] = ok ? rpb[(head * 15 + dr) * 31 + off + 15] * LOG2E : -1e30f;
        }
    }
    ATT_STORE(0);
    __syncthreads();
#pragma unroll 1
    for (int tt = 0; tt < ntiles; ++tt) {
        const bool is_local = tt < ntl;
        const int kbase = q0 - 128 + 64 * (lo + tt), kr = kr_lo + tt;
        const int boff = (tt & 1) * ATT_BUF;
        if (tt + 1 < ntiles) { if (!(var & 2)) ATT_LOAD(tt + 1); }
        else if (u_next >= 0) {
            int nq, nqc, nkc, nvc, ntr; att_start<MODE>(u_next, w, r, nq, nqc, nkc, nvc, ntr);
            kreg = *(const v4u*)(QKV + (size_t)(ntr + skey) * QKVC + nkc + 8 * sch); vreg = *(const v4u*)(QKV + (size_t)(ntr + vkey) * QKVC + nvc + 8 * vch);
            P.valid = 1;
        }
        if (!(var & 1) && !(MODE == 1 && is_local && !(kr >= my_rs && kr < my_rs + 8))) {
            att_tile<MODE, 0>(lds, boff, qf, negm, O0, O1, m_run, l_run, is_local, MODE == 0 && is_local && (lo + tt == 0 || lo + tt == 4), kbase, qt, kr, gr, tb_base, tb_pitch, r, h);
        }
        if (tt + 1 < ntiles && !(var & 2)) ATT_STORE(((tt + 1) & 1) * ATT_BUF);
        __syncthreads();
    }
#undef ATT_TROW
#undef ATT_LOAD
#undef ATT_STORE
    const float lt = l_run + __shfl_xor(l_run, 32), inv = 1.0f / lt;
    LAS unsigned char* ot = lds + w * 4608;
#pragma unroll
    for (int g = 0; g < 4; ++g) {
        v2u o; o.x = cvtpk(O0[4 * g] * inv, O0[4 * g + 1] * inv); o.y = cvtpk(O0[4 * g + 2] * inv, O0[4 * g + 3] * inv);
        *(LAS v2u*)(ot + r * 144 + (8 * g + 4 * h) * 2) = o;
        o.x = cvtpk(O1[4 * g] * inv, O1[4 * g + 1] * inv); o.y = cvtpk(O1[4 * g + 2] * inv, O1[4 * g + 3] * inv);
        *(LAS v2u*)(ot + r * 144 + (32 + 8 * g + 4 * h) * 2) = o;
    }
    LDS_WAIT(); asm volatile("" ::: "memory");
    bf16* op = Yo + (size_t)(qrow - r) * 512 + head * 64;
#pragma unroll
    for (int k = 0; k < 4; ++k) { const int p = lane + 64 * k, row = p >> 3, chk = p & 7;
        *(GAS v4u*)(op + (size_t)row * 512 + 8 * chk) = *(const LAS v4u*)(ot + row * 144 + chk * 16); }
    LDS_WAIT(); asm volatile("" ::: "memory");
}

template <int N>
__device__ __forceinline__ void conv_taps(const bf16* src, int t, int L, float w0, float w1, float w2, float bs, float (&out)[N]) {
    float x[N + 2];
    if constexpr (N == 8) { const v4u q = *(const v4u*)(src + t); x[1] = pg8::bf_lo(q.x); x[2] = pg8::bf_hi(q.x); x[3] = pg8::bf_lo(q.y); x[4] = pg8::bf_hi(q.y); x[5] = pg8::bf_lo(q.z); x[6] = pg8::bf_hi(q.z); x[7] = pg8::bf_lo(q.w); x[8] = pg8::bf_hi(q.w); }
    else { const v2u q = *(const v2u*)(src + t); x[1] = pg8::bf_lo(q.x); x[2] = pg8::bf_hi(q.x); x[3] = pg8::bf_lo(q.y); x[4] = pg8::bf_hi(q.y); }
    x[0] = t > 0 ? bf2f(src[t - 1]) : 0.f;
    x[N + 1] = (t + N < L) ? bf2f(src[t + N]) : 0.f;
#pragma unroll
    for (int e = 0; e < N; ++e) out[e] = w0 * x[e] + w1 * x[e + 1] + w2 * x[e + 2] + bs;
}

template <int L, int VAR = 0>
__device__ __forceinline__ void hyena_unit(Frame& F, int c, const bf16* CINT, bf16* DST, const bf16* Gf, const float* convw, const float* convb, const float* hybias) {
    constexpr int UP = (L + 8) * 2, TPW = L / 256, CPB = L / 8;
    LAS unsigned char* U = F.lds; LAS unsigned short* Gs = (LAS unsigned short*)(F.lds + 32 * UP);
    const int lane = F.lane, r = lane & 31, h = lane >> 5, T0 = F.wave * TPW * 32;
    const bf16* vsrc = CINT + (size_t)c * NROW + (L == SEQ ? 0 : NTOK);
    bf16* ydst = DST + (size_t)c * NROW + (L == SEQ ? 0 : NTOK);
    __syncthreads();
    if (!(VAR & 8)) {
        const float w0 = convw[c], w1 = convw[CINC + c], w2 = convw[2 * CINC + c], bs = convb[c];
        static_assert(CPB % 32 == 0, "a wave's 64 lanes hold consecutive chunks of at most two rows, split at lane 32");
#pragma unroll 4
        for (int q = F.tid; q < 32 * CPB; q += NTHREADS) { const int b = q / CPB, t = (q % CPB) * 8;
            const bf16* src = vsrc + (size_t)b * L;
            const v4u ch = *(const v4u*)(src + t);
            float x[10];
            x[1] = pg8::bf_lo(ch.x); x[2] = pg8::bf_hi(ch.x); x[3] = pg8::bf_lo(ch.y); x[4] = pg8::bf_hi(ch.y); x[5] = pg8::bf_lo(ch.z); x[6] = pg8::bf_hi(ch.z); x[7] = pg8::bf_lo(ch.w); x[8] = pg8::bf_hi(ch.w);
            const float up = __shfl_up(x[8], 1), dn = __shfl_down(x[1], 1);
            const int lr = lane & 31;
            x[0] = (lr == 0) ? (t > 0 ? bf2f(src[t - 1]) : 0.f) : up;
            x[9] = (lr == 31) ? (t + 8 < L ? bf2f(src[t + 8]) : 0.f) : dn;
            float o[8];
#pragma unroll
            for (int e = 0; e < 8; ++e) o[e] = w0 * x[e] + w1 * x[e + 1] + w2 * x[e + 2] + bs;
            v4u pk; pk.x = pk2(o[0], o[1]); pk.y = pk2(o[2], o[3]); pk.z = pk2(o[4], o[5]); pk.w = pk2(o[6], o[7]);
            *(LAS v4u*)(U + b * UP + t * 2) = pk; }
    }
#pragma unroll 1
    for (int ord = 0; ord < 2; ++ord) {
        {
            const v4u* gsrc = (const v4u*)(Gf + ((size_t)ord * 512 + c) * (2 * L));
            for (int q = F.tid; q < L / 4; q += NTHREADS) *(LAS v4u*)((LAS unsigned char*)Gs + q * 16) = gsrc[q];
        }
        __syncthreads();
        f32x16 acc[TPW];
#pragma unroll
        for (int i = 0; i < TPW; ++i)
#pragma unroll
            for (int e = 0; e < 16; ++e) acc[i][e] = 0.f;
        const int gbase = T0 + r - 8 * h + L;
#define HY_AF(dst, sgi, ti) do { const int gi_ = gbase + 32 * (ti) - 16 * (sgi); _Pragma("unroll") for (int j_ = 0; j_ < 8; ++j_) dst[j_] = (short)Gs[gi_ - j_]; } while (0)
#define HY_BF(sgi) (*(const LAS bf16x8*)(U + r * UP + (16 * (sgi) + 8 * h) * 2))
        if constexpr (TPW == 8 && !(VAR & 2)) {
            constexpr int NS = L / 16;
#pragma unroll 1
            for (int p = 0; p < 2; ++p) {
                bf16x8 W[8];
#pragma unroll
                for (int i = 1; i < 8; ++i) HY_AF(W[i], p, i);
                bf16x8 nf, nb; HY_AF(nf, p, 0); nb = HY_BF(p);
#pragma unroll 1
                for (int sb = p; sb < NS; sb += 16) {
#pragma unroll
                    for (int k = 0; k < 8; ++k) {
                        const int sg = sb + 2 * k; const bf16x8 cb = nb; W[(8 - k) & 7] = nf;
                        const int sn = sg + 2 < NS ? sg + 2 : sg;
                        HY_AF(nf, sn, 0); nb = HY_BF(sn);
#pragma unroll
                        for (int i = 0; i < 8; ++i) acc[i] = MFMA32(W[(i - k) & 7], cb, acc[i]);
                    }
                }
            }
        } else if constexpr (!(VAR & 2)) {
#pragma unroll 1
            for (int sg = 0; sg < L / 16; ++sg) { bf16x8 af; HY_AF(af, sg, 0); acc[0] = MFMA32(af, HY_BF(sg), acc[0]); }
        }
#undef HY_AF
#undef HY_BF
        const int comp = 1 + ord;
        const float w0 = convw[comp * 512 + c], w1 = convw[CINC + comp * 512 + c], w2 = convw[2 * CINC + comp * 512 + c], bs = convb[comp * 512 + c], hb = hybias[ord * 512 + c];
        const bf16* gsrc = CINT + ((size_t)comp * 512 + c) * NROW + (L == SEQ ? 0 : NTOK) + (size_t)r * L;
        __syncthreads();
        {
            constexpr int NCH = TPW * 4, BS = NCH < 8 ? NCH : 8;
#pragma unroll
            for (int bt = 0; bt < NCH / BS; ++bt) {
                const int tb = T0 + 8 * BS * bt;
                v4u ch[BS];
#pragma unroll
                for (int k = 0; k < BS; ++k) { if constexpr (VAR & 4) ch[k] = (v4u){0u, 0u, 0u, 0u}; else ch[k] = *(const v4u*)(gsrc + tb + 8 * k); }
                float xl = 0.f, xr = 0.f;
                if constexpr (!(VAR & 4)) { if (tb > 0) xl = bf2f(gsrc[tb - 1]); if (tb + 8 * BS < L) xr = bf2f(gsrc[tb + 8 * BS]); }
#pragma unroll
                for (int k = 0; k < BS; ++k) {
                    const int kk = BS * bt + k, i = kk >> 2, g = kk & 3, t = T0 + 32 * i + 8 * g + 4 * h;
                    float xs[10];
                    xs[0] = k == 0 ? xl : pg8::bf_hi(ch[k > 0 ? k - 1 : 0].w);
                    xs[1] = pg8::bf_lo(ch[k].x); xs[2] = pg8::bf_hi(ch[k].x); xs[3] = pg8::bf_lo(ch[k].y); xs[4] = pg8::bf_hi(ch[k].y); xs[5] = pg8::bf_lo(ch[k].z); xs[6] = pg8::bf_hi(ch[k].z); xs[7] = pg8::bf_lo(ch[k].w); xs[8] = pg8::bf_hi(ch[k].w);
                    xs[9] = k == BS - 1 ? xr : pg8::bf_lo(ch[k < BS - 1 ? k + 1 : k].x);
                    float gt[4];
#pragma unroll
                    for (int e2 = 0; e2 < 4; ++e2) { const float lo = w0 * xs[e2] + w1 * xs[e2 + 1] + w2 * xs[e2 + 2] + bs, hi = w0 * xs[e2 + 4] + w1 * xs[e2 + 5] + w2 * xs[e2 + 6] + bs; gt[e2] = h ? hi : lo; }
                    LAS v2u* up = (LAS v2u*)(U + r * UP + t * 2);
                    const v2u uu = *up;
                    const float u0 = pg8::bf_lo(uu.x), u1 = pg8::bf_hi(uu.x), u2 = pg8::bf_lo(uu.y), u3 = pg8::bf_hi(uu.y);
                    const float z0 = gt[0] * (acc[i][4 * g] + hb * u0), z1 = gt[1] * (acc[i][4 * g + 1] + hb * u1), z2 = gt[2] * (acc[i][4 * g + 2] + hb * u2), z3 = gt[3] * (acc[i][4 * g + 3] + hb * u3);
                    v2u zz; zz.x = pk2(z0, z1); zz.y = pk2(z2, z3);
                    *up = zz;
                }
                asm volatile("" ::: "memory");
            }
        }
        __syncthreads();
    }
    if (!(VAR & 1)) for (int q = F.tid; q < 32 * CPB; q += NTHREADS) { const int b = q / CPB, t = (q % CPB) * 8; *(GAS v4u*)(ydst + (size_t)b * L + t) = *(const LAS v4u*)(U + b * UP + t * 2); }
}

__device__ __forceinline__ void transpose_yc(Frame& F, const bf16* CT, bf16* Yc, int nrows) {
    const int gw = F.vcu * NWAVES + F.wave, NGW = F.G * NWAVES, lane = F.lane;
    LAS unsigned short* T = (LAS unsigned short*)(F.lds + F.wave * 16384);
    const int ntr = nrows / 64;
    for (int it = gw; it < 8 * ntr; it += NGW) {
        const int cb = it / ntr, rb = it % ntr, c0 = cb * 64, r0 = rb * 64;
#pragma unroll
        for (int k = 0; k < 8; ++k) { const int p = lane + 64 * k, cc = p >> 3, ch = p & 7;
            const v4u q = *(const v4u*)(CT + (size_t)(c0 + cc) * NROW + r0 + 8 * ch);
            LAS unsigned* d = (LAS unsigned*)(T + cc * 66 + 8 * ch); d[0] = q.x; d[1] = q.y; d[2] = q.z; d[3] = q.w; }
        LDS_WAIT(); asm volatile("" ::: "memory");
#pragma unroll
        for (int k = 0; k < 8; ++k) { const int p = lane + 64 * k, rr = p >> 3, ch = p & 7;
            unsigned short e[8];
#pragma unroll
            for (int j = 0; j < 8; ++j) e[j] = T[(8 * ch + j) * 66 + rr];
            v4u o; o.x = e[0] | ((unsigned)e[1] << 16); o.y = e[2] | ((unsigned)e[3] << 16); o.z = e[4] | ((unsigned)e[5] << 16); o.w = e[6] | ((unsigned)e[7] << 16);
            *(GAS v4u*)(Yc + (size_t)(r0 + rr) * 512 + c0 + 8 * ch) = o; }
        LDS_WAIT(); asm volatile("" ::: "memory");
    }
}

struct RowVecs { f32x4 gA[4], gt[4], gB[4], sc1[4], sh[4]; };
__device__ __forceinline__ float ssq16(const f32x4 (&v)[4]) { float s = 0.f;
#pragma unroll
    for (int j = 0; j < 4; ++j) s += (v[j].x * v[j].x + v[j].y * v[j].y) + (v[j].z * v[j].z + v[j].w * v[j].w);
    return s; }
__device__ __forceinline__ void ld_mod(const Frame& F, int l, int b, int part, int lane, f32x4 (&v)[4], float add) {
    ld_row_f32((const float*)(F.ws + WS_MODV) + ((size_t)l * 33 + b) * 6144 + part * 1024, lane, v);
#pragma unroll
    for (int j = 0; j < 4; ++j) v[j] = v[j] + add;
}
__device__ __forceinline__ void row_pair(const RowVecs& V, const f32x4 (&y0)[4], const f32x4 (&y1)[4], f32x4 (&x0)[4], f32x4 (&x1)[4], bool has_y, bool has_next, f32x4 (&h0)[4], f32x4 (&h1)[4]) {
    if (has_y) {
        float a0 = ssq16(y0), a1 = ssq16(y1);
#pragma unroll
        for (int o = 1; o < 64; o <<= 1) { a0 += __shfl_xor(a0, o); a1 += __shfl_xor(a1, o); }
        const float r0 = __builtin_amdgcn_rsqf(a0 * (1.0f / D) + EPS), r1 = __builtin_amdgcn_rsqf(a1 * (1.0f / D) + EPS);
#pragma unroll
        for (int j = 0; j < 4; ++j) { x0[j] = x0[j] + V.gt[j] * ((y0[j] * r0) * V.gA[j]); x1[j] = x1[j] + V.gt[j] * ((y1[j] * r1) * V.gA[j]); }
    }
    if (has_next) {
        float a0 = ssq16(x0), a1 = ssq16(x1);
#pragma unroll
        for (int o = 1; o < 64; o <<= 1) { a0 += __shfl_xor(a0, o); a1 += __shfl_xor(a1, o); }
        const float r0 = __builtin_amdgcn_rsqf(a0 * (1.0f / D) + EPS), r1 = __builtin_amdgcn_rsqf(a1 * (1.0f / D) + EPS);
#pragma unroll
        for (int j = 0; j < 4; ++j) { h0[j] = (x0[j] * r0) * V.gB[j] * V.sc1[j] + V.sh[j]; h1[j] = (x1[j] * r1) * V.gB[j] * V.sc1[j] + V.sh[j]; }
    }
}
template <bool XB16>
__device__ __forceinline__ void rows_phase(Frame& F, const Args& a, int mode, int l, int sub, const bf16* Y, int nrows) {
    const int gw = F.vcu * NWAVES + F.wave, NGW = F.G * NWAVES;
    const int R = (((nrows + NGW - 1) / NGW) + 1) & ~1, r0 = gw * R, r1 = (r0 + R) < nrows ? (r0 + R) : nrows;
    const bool has_y = mode == 1, has_next = (mode == 0) || !(l == 1 && sub == 1);
    const int ln = (mode == 0) ? 0 : (sub == 0 ? l : l + 1);
    const bool next_is_ffn = (mode == 1 && sub == 0);
    RowVecs V;
    if (has_y) ld_row_f32(a.in[sub == 0 ? I_GMIXPOST : I_GFFNPOST] + l * D, F.lane, V.gA);
    if (has_next) ld_row_f32(a.in[next_is_ffn ? I_GFFNPRE : I_GMIXPRE] + ln * D, F.lane, V.gB);
    int bcur = -2;
    bf16* const Hb = F.hb; bf16* const XB = (bf16*)(F.ws + WS_XB);
    f32x4 nx0[4], nx1[4]; v2u nxr0[4], nxr1[4], ny0[4], ny1[4];
#define ROWS_ISSUE(row_) do { const int rr_ = (row_); \
        if (has_y) { ld_raw_bf16_nt(Y + (size_t)rr_ * D, F.lane, ny0); ld_raw_bf16_nt(Y + (size_t)(rr_ + 1) * D, F.lane, ny1); } \
        if (XB16) { ld_raw_bf16_nt(XB + (size_t)rr_ * D, F.lane, nxr0); ld_raw_bf16_nt(XB + (size_t)(rr_ + 1) * D, F.lane, nxr1); } \
        else { const float* xs_ = rr_ < NTOK ? a.in[I_X] + (size_t)rr_ * D : a.in[I_CTX] + (size_t)(rr_ - NTOK) * D; ld_row_f32_nt(xs_, F.lane, nx0); ld_row_f32_nt(xs_ + D, F.lane, nx1); } } while (0)
    if (r0 < r1) ROWS_ISSUE(r0);
#pragma unroll 1
    for (int row = r0; row < r1; row += 2) {
        const int b = row < NTOK ? (row >> 11) : 32;
        if (b != bcur) { bcur = b;
            if (has_y) ld_mod(F, l, b, sub == 0 ? 2 : 5, F.lane, V.gt, 0.f);
            if (has_next) { ld_mod(F, ln, b, next_is_ffn ? 4 : 1, F.lane, V.sc1, 1.0f); ld_mod(F, ln, b, next_is_ffn ? 3 : 0, F.lane, V.sh, 0.f); } }
        f32x4 y0[4], y1[4], x0[4], x1[4], h0[4], h1[4];
#pragma unroll
        for (int j = 0; j < 4; ++j) { if (XB16) { x0[j] = cvt_raw_bf16(nxr0[j]); x1[j] = cvt_raw_bf16(nxr1[j]); } else { x0[j] = nx0[j]; x1[j] = nx1[j]; }
            if (has_y) { y0[j] = cvt_raw_bf16(ny0[j]); y1[j] = cvt_raw_bf16(ny1[j]); } }
        if (row + 2 < r1) ROWS_ISSUE(row + 2);
        row_pair(V, y0, y1, x0, x1, has_y, has_next, h0, h1);
        if (has_y) { st_row_bf16(XB + (size_t)row * D, F.lane, x0); st_row_bf16(XB + (size_t)(row + 1) * D, F.lane, x1); }
        if (has_next) { st_row_bf16(Hb + (size_t)row * D, F.lane, h0); st_row_bf16(Hb + (size_t)(row + 1) * D, F.lane, h1);
            if (!next_is_ffn) { GAS unsigned* q = (GAS unsigned*)(F.ws + WS_H8 + (size_t)row * D) + F.lane;
#pragma unroll
                for (int j = 0; j < 4; ++j) { q[64 * j] = pg8::pack_fp8x4(h0[j].x, h0[j].y, h0[j].z, h0[j].w); q[256 + 64 * j] = pg8::pack_fp8x4(h1[j].x, h1[j].y, h1[j].z, h1[j].w); } } }
    }
#undef ROWS_ISSUE
}

__device__ __forceinline__ void route_row(const f32x4 (&h)[4], const LAS float* rl, int lane, int& e0, int& e1, float& w0, float& w1) {
    float lg[8];
#pragma unroll
    for (int e = 0; e < 8; ++e) lg[e] = 0.f;
#pragma unroll
    for (int j = 0; j < 4; ++j)
#pragma unroll
        for (int i = 0; i < 4; ++i) { const LAS f32x4* rp = (const LAS f32x4*)(rl + ((j * 4 + i) * 64 + lane) * 8); const f32x4 q0 = rp[0], q1 = rp[1]; const float hv = h[j][i];
            lg[0] += hv * q0.x; lg[1] += hv * q0.y; lg[2] += hv * q0.z; lg[3] += hv * q0.w; lg[4] += hv * q1.x; lg[5] += hv * q1.y; lg[6] += hv * q1.z; lg[7] += hv * q1.w; }
#pragma unroll
    for (int o = 1; o < 64; o <<= 1)
#pragma unroll
        for (int e = 0; e < 8; ++e) lg[e] += __shfl_xor(lg[e], o);
    e0 = 0; float v0 = lg[0];
#pragma unroll
    for (int e = 1; e < 8; ++e) if (lg[e] > v0) { v0 = lg[e]; e0 = e; }
    e1 = -1; float v1 = -3.0e38f;
#pragma unroll
    for (int e = 0; e < 8; ++e) if (e != e0 && lg[e] > v1) { v1 = lg[e]; e1 = e; }
    w0 = 1.0f / (1.0f + __expf(v1 - v0)); w1 = 1.0f - w0;
}
__device__ __forceinline__ void post_route_phase(Frame& F, const Args& a, const bf16* Y) {
    LAS int* se = (LAS int*)F.lds;
    LAS int* sbase = se + 512;
    LAS float* rl = (LAS float*)(F.lds + 4096);
    const int l = 1;
    __syncthreads();
    for (int i = F.tid; i < 1024 * 8; i += NTHREADS) { const int k = i >> 3, e = i & 7, jj = k >> 8, ln = (k & 255) >> 2, ii = k & 3; rl[((jj * 4 + ii) * 64 + ln) * 8 + e] = a.in[I_ROUTER][i]; }
    __syncthreads();
    RowVecs V;
    ld_row_f32(a.in[I_GMIXPOST] + l * D, F.lane, V.gA); ld_row_f32(a.in[I_GFFNPRE] + l * D, F.lane, V.gB);
    bf16* const Hb = F.hb; bf16* const XB = (bf16*)(F.ws + WS_XB);
    for (int blk = F.vcu; blk < NTOK / 256; blk += F.G) {
        const int b = blk >> 3;
        ld_mod(F, l, b, 2, F.lane, V.gt, 0.f); ld_mod(F, l, b, 4, F.lane, V.sc1, 1.0f); ld_mod(F, l, b, 3, F.lane, V.sh, 0.f);
#pragma unroll 1
        for (int k = 0; k < 32; ++k) {
            const int lr = F.wave * 32 + k, row = blk * 256 + lr;
            f32x4 y0[4], x0[4], h0[4];
            ld_row_bf16(Y + (size_t)row * D, F.lane, y0);
            bf16* xp = XB + (size_t)row * D; ld_row_bf16(xp, F.lane, x0);
            { const float r0 = __builtin_amdgcn_rsqf(wave_sum(ssq16(y0)) * (1.0f / D) + EPS);
#pragma unroll
              for (int j = 0; j < 4; ++j) x0[j] = x0[j] + V.gt[j] * ((y0[j] * r0) * V.gA[j]); }
            st_row_bf16(xp, F.lane, x0);
            { const float r0 = __builtin_amdgcn_rsqf(wave_sum(ssq16(x0)) * (1.0f / D) + EPS);
#pragma unroll
              for (int j = 0; j < 4; ++j) h0[j] = (x0[j] * r0) * V.gB[j] * V.sc1[j] + V.sh[j]; }
            st_row_bf16(Hb + (size_t)row * D, F.lane, h0);
            int e0, e1; float w0, w1;
            route_row(h0, rl, F.lane, e0, e1, w0, w1);
            if (F.lane == 0) { se[2 * lr] = e0; se[2 * lr + 1] = e1;
                int4 rr; rr.x = e0; rr.y = e1; rr.z = __builtin_bit_cast(int, w0); rr.w = __builtin_bit_cast(int, w1); ((int4*)(F.ws + WS_ROUTE))[row] = rr; }
        }
        __syncthreads();
        const int half = blk >> 7;
        if (F.tid < 8) { int n = 0; for (int i = 0; i < 512; ++i) n += (se[i] == F.tid) ? 1 : 0;
            sbase[F.tid] = (int)__hip_atomic_fetch_add((unsigned*)(F.ws + WS_CTL) + CW_CNT + half * 8 + F.tid, (unsigned)n, __ATOMIC_RELAXED, __HIP_MEMORY_SCOPE_AGENT); }
        __syncthreads();
        if (F.tid < 8) { int p = sbase[F.tid]; int* lst = (int*)(F.ws + WS_LIST) + ((size_t)half * 8 + F.tid) * 32768;
            for (int i = 0; i < 512; ++i) if (se[i] == F.tid) lst[p++] = ((blk * 256 + (i >> 1)) << 1) | (i & 1); }
        __syncthreads();
    }
}

__device__ __forceinline__ void moe_offsets(Frame& F, int half, int (&toff)[9], int (&cnt)[8]) {
    const unsigned* cw = (const unsigned*)(F.ws + WS_CTL) + CW_CNT + half * 8;
    toff[0] = 0;
#pragma unroll
    for (int e = 0; e < 8; ++e) { cnt[e] = __builtin_amdgcn_readfirstlane((int)__hip_atomic_load(cw + e, __ATOMIC_RELAXED, __HIP_MEMORY_SCOPE_AGENT)); toff[e + 1] = toff[e] + (cnt[e] + 255) / 256; }
}
__device__ __forceinline__ void moe_gather_phase(Frame& F, int half, int skip_first = 0) {
    if (skip_first < 0 || skip_first >= F.G) skip_first = 0;
    const int bxw = (int)blockIdx.x - skip_first; if (bxw < 0) return;
    const int gw = bxw * NWAVES + F.wave, NGW = (F.G - skip_first) * NWAVES;
    int toff[9], cnt[8]; moe_offsets(F, half, toff, cnt);
    const int P = toff[8] * 256;
    for (int p = gw; p < P; p += NGW) {
        const int tile = p >> 8; int e = 0;
#pragma unroll
        for (int k = 1; k < 8; ++k) e += (tile >= toff[k]) ? 1 : 0;
        const int idx = p - toff[e] * 256;
        unsigned char* dst = F.ws + BIG_AS + (size_t)p * D;
        v4u o = {0u, 0u, 0u, 0u};
        if (idx < cnt[e]) {
            const int ts = ((const int*)(F.ws + WS_LIST))[((size_t)half * 8 + e) * 32768 + idx], tok = ts >> 1, slot = ts & 1;
            const GAS v4u* s = (const GAS v4u*)((const bf16*)F.hb + (size_t)tok * D) + 2 * F.lane;
            const v4u q0 = s[0], q1 = s[1];
            o.x = pg8::pack_fp8x4(pg8::bf_lo(q0.x), pg8::bf_hi(q0.x), pg8::bf_lo(q0.y), pg8::bf_hi(q0.y)); o.y = pg8::pack_fp8x4(pg8::bf_lo(q0.z), pg8::bf_hi(q0.z), pg8::bf_lo(q0.w), pg8::bf_hi(q0.w));
            o.z = pg8::pack_fp8x4(pg8::bf_lo(q1.x), pg8::bf_hi(q1.x), pg8::bf_lo(q1.y), pg8::bf_hi(q1.y)); o.w = pg8::pack_fp8x4(pg8::bf_lo(q1.z), pg8::bf_hi(q1.z), pg8::bf_lo(q1.w), pg8::bf_hi(q1.w));
            if (F.lane == 0) ((int*)(F.ws + WS_INV))[tok * 2 + slot] = p;
        }
        *((GAS v4u*)dst + F.lane) = o;
    }
}
__device__ __forceinline__ void moe_convert(Frame& F, const Args& a) {
    const int gw = F.vcu * NWAVES + F.wave, NGW = F.G * NWAVES;
    LAS float* scr = (LAS float*)(F.lds + F.wave * 16384);
    constexpr int I13 = 16 * 112, I2 = 56 * 32;
    for (int it = gw; it < 8 * (2 * I13 + I2); it += NGW) {
        const int e = it / (2 * I13 + I2); int r = it % (2 * I13 + I2);
        if (r < 2 * I13) {
            const int which = r / I13; r %= I13; const int kb = r / 112, nb = r % 112, n0 = 32 * nb;
            const float* W = (which ? a.in[I_MW3] : a.in[I_MW1]) + (size_t)e * D * DFFE;
            transpose_item_f8(W, DFFE, F.ws + WM_13 + (size_t)e * 2 * DFFE * D, D, 64 * kb, n0, (n0 / 128) * 256 + which * 128 + (n0 % 128), W13_SCALE, scr, F.lane);
        } else {
            r -= 2 * I13; const int kb = r / 32, nb = r % 32;
            transpose_item_f8(a.in[I_MW2] + (size_t)e * DFFE * D, D, F.ws + WM_2 + (size_t)e * D * DFFE, DFFE, 64 * kb, 32 * nb, 32 * nb, W2_SCALE, scr, F.lane);
        }
    }
}
__device__ __forceinline__ void moe_post_phase(Frame& F, const Args& a, int half) {
    const int gw = F.vcu * NWAVES + F.wave, NGW = F.G * NWAVES;
    const int R = (((32768 + NGW - 1) / NGW) + 1) & ~1, t0 = gw * R, t1 = (t0 + R) < 32768 ? (t0 + R) : 32768;
    RowVecs V; ld_row_f32(a.in[I_GFFNPOST] + D, F.lane, V.gA);
    int bcur = -2;
    const bf16* Y2 = (const bf16*)(F.ws + BIG_Y2S); const int* inv = (const int*)(F.ws + WS_INV); const int4* rt = (const int4*)(F.ws + WS_ROUTE);
    int4 ira, irb; int ip00, ip01, ip10, ip11;
    v2u nya[4], nyb[4], nyc[4], nyd[4], nxr0[4], nxr1[4]; const bf16* XB = (const bf16*)(F.ws + WS_XB); float nw0 = 0.f, nw1 = 0.f, nu0 = 0.f, nu1 = 0.f;
#define MP_IDX(t_) do { const int rw_ = half * 32768 + (t_); ira = rt[rw_]; irb = rt[rw_ + 1]; ip00 = inv[rw_ * 2]; ip01 = inv[rw_ * 2 + 1]; ip10 = inv[rw_ * 2 + 2]; ip11 = inv[rw_ * 2 + 3]; } while (0)
#define MP_DATA(t_) do { const int rw_ = half * 32768 + (t_); \
        ld_raw_bf16_nt(Y2 + (size_t)ip00 * D, F.lane, nya); ld_raw_bf16_nt(Y2 + (size_t)ip01 * D, F.lane, nyb); ld_raw_bf16_nt(Y2 + (size_t)ip10 * D, F.lane, nyc); ld_raw_bf16_nt(Y2 + (size_t)ip11 * D, F.lane, nyd); \
        const bf16* xq_ = XB + (size_t)rw_ * D; ld_raw_bf16_nt(xq_, F.lane, nxr0); ld_raw_bf16_nt(xq_ + D, F.lane, nxr1); \
        nw0 = __builtin_bit_cast(float, ira.z); nw1 = __builtin_bit_cast(float, ira.w); nu0 = __builtin_bit_cast(float, irb.z); nu1 = __builtin_bit_cast(float, irb.w); } while (0)
    if (t0 < t1) { MP_IDX(t0); MP_DATA(t0); if (t0 + 2 < t1) MP_IDX(t0 + 2); }
#pragma unroll 1
    for (int t = t0; t < t1; t += 2) {
        const int row = half * 32768 + t, b = row >> 11;
        if (b != bcur) { bcur = b; ld_mod(F, 1, b, 5, F.lane, V.gt, 0.f); }
        f32x4 y0[4], y1[4], x0[4], x1[4], h0[4], h1[4];
        float* xp = a.out + (size_t)row * D;
#pragma unroll
        for (int j = 0; j < 4; ++j) { x0[j] = cvt_raw_bf16(nxr0[j]); x1[j] = cvt_raw_bf16(nxr1[j]); y0[j] = cvt_raw_bf16(nya[j]) * nw0 + cvt_raw_bf16(nyb[j]) * nw1; y1[j] = cvt_raw_bf16(nyc[j]) * nu0 + cvt_raw_bf16(nyd[j]) * nu1; }
        if (t + 2 < t1) { MP_DATA(t + 2); if (t + 4 < t1) MP_IDX(t + 4); }
        row_pair(V, y0, y1, x0, x1, true, false, h0, h1);
        st_row_f32_nt(xp, F.lane, x0); st_row_f32_nt(xp + D, F.lane, x1);
    }
#undef MP_IDX
#undef MP_DATA
}

#ifndef MK_ONLY
#define MK_ONLY -1
#endif
#ifndef MK_SKIP
#define MK_SKIP -1
#endif
#define ON(k) ((MK_ONLY < 0 || MK_ONLY == (k)) && MK_SKIP != (k))
#ifndef MK_REPMASK
#define MK_REPMASK 0
#endif
#ifndef MK_REPSUB
#define MK_REPSUB 0
#endif
#ifndef MK_HYVAR
#define MK_HYVAR 0
#endif
#ifndef MK_PROBE
#define MK_PROBE -1
#endif
#ifndef MK_PROBE_END
#define MK_PROBE_END MK_PROBE
#endif
#ifndef MK_PROBE_DIV
#define MK_PROBE_DIV 10
#endif
#ifndef MK_MULTI
#define MK_MULTI 0
#endif
constexpr int NPHASES = 2 + 9 + 6 + 6;

typedef const __attribute__((address_space(4))) Args* ArgsP;
#define KARGS ((ArgsP)__builtin_amdgcn_kernarg_segment_ptr())
#define PH_ENTER \
    Frame F; const Args* ap_; { int t_ = threadIdx.x; asm volatile("" : "+v"(t_)); ArgsP q_ = KARGS; asm volatile("" : "+s"(q_)); ap_ = (const Args*)q_; \
      F.lds = (LAS unsigned char*)lds_raw; F.tid = t_; F.lane = t_ & 63; F.wave = __builtin_amdgcn_readfirstlane(t_ >> 6); \
      F.G = gridDim.x; { const int bx_ = blockIdx.x; F.vcu = (F.G % 8 == 0) ? (bx_ % 8) * (F.G / 8) + bx_ / 8 : bx_; } F.ws = q_->ws; F.hb = (bf16*)q_->out; } \
    const Args& a = *ap_; const int bx = (int)blockIdx.x; \
    bf16* const Hb = F.hb; bf16* const Y3 = (bf16*)(F.ws + WS_Y3); bf16* const QKV = (bf16*)(F.ws + BIG_QKV); bf16* const CINT = (bf16*)(F.ws + BIG_CINT); unsigned char* const GATE = F.ws + BIG_GATE; \
    (void)Hb; (void)Y3; (void)QKV; (void)CINT; (void)GATE; (void)bx; (void)a;

__global__ void __launch_bounds__(NTHREADS, 2) fwd_kernel(Args args) {
    extern __shared__ __attribute__((aligned(16))) unsigned char lds_raw[];
    {
        volatile LAS unsigned* MISC0 = (volatile LAS unsigned*)((LAS unsigned char*)lds_raw + MISC_OFF);
        for (int u = threadIdx.x; u < (LDS_BYTES - MISC_OFF) / 4; u += NTHREADS) MISC0[u] = 0u;
        __syncthreads();
    }
    if (!MK_MULTI) (void)xcd_barrier_post((unsigned*)(KARGS->ws + WS_CTL) + CW_BAR, (volatile LAS unsigned*)((LAS unsigned char*)lds_raw + MISC_OFF) + 8);
    int ph = 0;
#define PROBE_STAMP(which) do { if (MK_PROBE >= 0 && blockIdx.x == 0 && __builtin_amdgcn_readfirstlane((int)threadIdx.x) == 0) { volatile unsigned* pw_ = (volatile unsigned*)(KARGS->ws + WS_CTL) + 20000; const unsigned t_ = (unsigned)__builtin_amdgcn_s_memrealtime(); if ((which) == 0) pw_[0] = t_; else pw_[1] = t_ - pw_[0]; } } while (0)
    if (MK_PROBE == 0) PROBE_STAMP(0);
#define LO_ (KARGS->ph_lo)
#define HI_ (KARGS->ph_hi)
#define GRID_BAR do { XcdBarrier b_; b_.bar = (unsigned*)(KARGS->ws + WS_CTL) + CW_BAR; b_.x = xb_xcc_id(); b_.st = (volatile LAS unsigned*)((LAS unsigned char*)lds_raw + MISC_OFF) + 8; xcd_barrier(b_); } while (0)
#define RUN (LO_ <= ph && ph < HI_)
#define END_PHASE do { if (RUN && (ph + 1 < HI_)) { GRID_BAR; } if (MK_PROBE > 0 && ph + 1 == MK_PROBE) PROBE_STAMP(0); if (MK_PROBE >= 0 && ph == MK_PROBE_END) PROBE_STAMP(1); ++ph; } while (0)

    if (RUN && ON(0)) { PH_ENTER p0_prologue(F, a); } END_PHASE;
    if (RUN && ON(1)) { PH_ENTER p1_phase(F, a); rows_phase<false>(F, a, 0, 0, 0, nullptr, NROW); } END_PHASE;

#pragma unroll 1
    for (int l = 0; l < 2; ++l) {
        const int nrows = l == 0 ? NROW : NTOK;
        if (RUN && ON(2)) { PH_ENTER
            const bf16* Wq8 = (const bf16*)(F.ws + W_IN + (size_t)l * INC * D);
            { pg8::Gemm g{(const bf16*)(F.ws + WS_H8), Wq8, nrows, QKVC, D / 2}; pg8::StaticOrder S; S.init(nrows, QKVC, F.G, bx);
              pg8::EpiQKV E{QKV, (const float*)(F.ws + WS_ROPE), 0, QSCALE, 1.0f / W13_SCALE};
              pg8::gemm_phase<pg8::EpiQKV, pg8::StaticOrder, true, true, true>(F.lds, g, S, E, F.tid); }
            int tid2 = threadIdx.x; asm volatile("" : "+v"(tid2));
            if (l == 1) { pg8::Gemm g{(const bf16*)(F.ws + WS_H8 + (size_t)NTOK * D), Wq8, NCTX, 1280, D / 2}; pg8::StaticOrder S; S.init(NCTX, 1280, F.G, bx);
              pg8::EpiQKV E{QKV, (const float*)(F.ws + WS_ROPE), NTOK, QSCALE, 1.0f / W13_SCALE};
              pg8::gemm_phase<pg8::EpiQKV, pg8::StaticOrder, true, true, true>(F.lds, g, S, E, tid2); }
            int tid3 = threadIdx.x; asm volatile("" : "+v"(tid3));
            { pg8::Gemm g{(const bf16*)(F.ws + W_CB) + (size_t)l * CINC * D, Hb, CINC, nrows, D}; pg8::StaticOrder S; S.init(CINC, nrows, F.G, bx);
              pg8::EpiPlain E{CINT, NROW, 0, 0, 1.0f};
              pg8::gemm_phase<pg8::EpiPlain, pg8::StaticOrder, true, true>(F.lds, g, S, E, tid3); }
        } END_PHASE;
        if (RUN) {
            { PH_ENTER const float* sink = a.in[I_SINK] + l * 8; const float* rpb = a.in[I_RPB] + (size_t)l * 8 * 15 * 31; const int sm = a.sub_mask;
              if (ON(3) && (sm & 1)) { AttPre P; P.valid = 0; int th = -1; for (int u = F.vcu; u < 2048; u += F.G) attn_unit<0>(F, u, u + F.G < 2048 ? u + F.G : -1, QKV, Y3, sink, rpb, P, th, (sm >> 6) & 3); } }
            { PH_ENTER const float* sink = a.in[I_SINK] + l * 8; const float* rpb = a.in[I_RPB] + (size_t)l * 8 * 15 * 31; const int sm = a.sub_mask;
              if (ON(4) && (sm & 2)) { AttPre P; P.valid = 0; int th = -1; for (int u = F.vcu; u < 2048; u += F.G) attn_unit<1>(F, u, u + F.G < 2048 ? u + F.G : -1, QKV, Y3 + (size_t)NROW * 512, sink, rpb, P, th, (sm >> 6) & 3); } }
            { PH_ENTER const float* sink = a.in[I_SINK] + l * 8; const float* rpb = a.in[I_RPB] + (size_t)l * 8 * 15 * 31; const int sm = a.sub_mask;
              if (l == 0 && ON(5) && (sm & 4)) {
                { AttPre P; P.valid = 0; int th = -1; for (int u = F.vcu; u < 256; u += F.G) attn_unit<2>(F, u, -1, QKV, Y3, sink, rpb, P, th); }
                { AttPre P; P.valid = 0; int th = -1; for (int u = F.vcu; u < 256; u += F.G) attn_unit<3>(F, u, -1, QKV, Y3 + (size_t)NROW * 512, sink, rpb, P, th); }
              } }
            { PH_ENTER const int sm = a.sub_mask;
              const float* cw = a.in[I_CONVW] + l * 3 * CINC; const float* cb = a.in[I_CONVB] + l * CINC; const float* hb = a.in[I_HBIAS] + l * 1024;
#if MK_HYVAR
              if (ON(6) && (sm & 32)) for (int c = F.vcu; c < 512; c += F.G) hyena_unit<SEQ, MK_HYVAR>(F, c, CINT, CINT, (const bf16*)(F.ws + WS_GF) + (size_t)l * 2 * 512 * 2 * SEQ, cw, cb, hb);
#endif
              if (ON(6) && (sm & 8)) for (int c = F.vcu; c < 512; c += F.G) hyena_unit<SEQ>(F, c, CINT, CINT, (const bf16*)(F.ws + WS_GF) + (size_t)l * 2 * 512 * 2 * SEQ, cw, cb, hb);
              if (l == 0 && ON(7) && (sm & 16)) for (int c = F.vcu; c < 512; c += F.G) hyena_unit<LC>(F, c, CINT, CINT, (const bf16*)(F.ws + WS_GFC) + (size_t)l * 2 * 512 * 2 * LC, cw, cb, hb);
              __syncthreads(); }
        } END_PHASE;
        if (RUN && ON(8)) { PH_ENTER
            transpose_yc(F, CINT, (bf16*)(F.ws + BIG_YCT), nrows);
            __syncthreads();
            pg8::Gemm g{(const bf16*)(F.ws + WS_H8), (const bf16*)(F.ws + W_IN + (size_t)l * INC * D + (size_t)(QKVC + CINC) * D), nrows, GATEC, D / 2}; pg8::StaticOrder S; S.init(nrows, GATEC, F.G, bx);
            pg8::EpiSig E{GATE, GATEC, 1.0f / W13_SCALE};
            pg8::gemm_phase<pg8::EpiSig, pg8::StaticOrder, true, true, true>(F.lds, g, S, E, F.tid);
        } END_PHASE;
        if (RUN && ON(9)) { PH_ENTER
            constexpr int TB = 256 * 512 * 2;
            static_assert((WS_Y3 - BIG_YCT) % TB == 0, "merge tile offsets");
            constexpr int OA = (int)((WS_Y3 - BIG_YCT) / TB), OB = OA + NROW / 256;
            pg8::Gemm g{(const bf16*)(F.ws + BIG_YCT), (const bf16*)(F.ws + W_BR) + (size_t)l * 3 * D * 512, 3 * NROW, 3 * D, 512}; pg8::MergeOrder S{nrows / 256, F.G, bx, OA, OB, 0};
            pg8::EpiMerge E{Hb, GATE, OA, OB, 0};
            pg8::gemm_phase<pg8::EpiMerge, pg8::MergeOrder, true, true>(F.lds, g, S, E, F.tid);
        } END_PHASE;
        if (RUN && ON(10)) { PH_ENTER
            pg8::Gemm g{Hb, (const bf16*)(F.ws + W_OUT) + (size_t)l * D * D, nrows, D, D}; pg8::StaticOrder S; S.init(nrows, D, F.G, bx);
            pg8::EpiPlain E{Y3, D, 0, 0, 1.0f};
            pg8::gemm_phase<pg8::EpiPlain, pg8::StaticOrder, true, true>(F.lds, g, S, E, F.tid);
        } END_PHASE;
        if (RUN && ON(11)) { PH_ENTER if (l == 0) rows_phase<false>(F, a, 1, 0, 0, Y3, nrows); else post_route_phase(F, a, Y3); } END_PHASE;
        if (l == 0) {
            if (RUN && ON(12)) { PH_ENTER
                pg8::Gemm g{Hb, (const bf16*)(F.ws + W_F13), NROW, 2 * DFF, D}; pg8::StaticOrder S; S.init(NROW, 2 * DFF, F.G, bx);
                pg8::EpiSwiGLU E{(bf16*)(F.ws + BIG_HID), DFF, 0};
                pg8::gemm_phase<pg8::EpiSwiGLU, pg8::StaticOrder, true, true>(F.lds, g, S, E, F.tid);
            } END_PHASE;
            if (RUN && ON(13)) { PH_ENTER
                pg8::Gemm g{(const bf16*)(F.ws + BIG_HID), (const bf16*)(F.ws + W_F2), NROW, D, DFF}; pg8::StaticOrder S; S.init(NROW, D, F.G, bx);
                pg8::EpiPlain E{Y3, D, 0, 0, 1.0f};
                pg8::gemm_phase<pg8::EpiPlain, pg8::StaticOrder, true, true>(F.lds, g, S, E, F.tid);
            } END_PHASE;
            if (RUN && ON(14)) { PH_ENTER rows_phase<true>(F, a, 1, 0, 1, Y3, NROW); } END_PHASE;
        } else {
#pragma unroll 1
            for (int half = 0; half < 2; ++half) {
                if (half == 0) { if (RUN && ON(15)) { PH_ENTER moe_convert(F, a); moe_gather_phase(F, 0); } END_PHASE; }
                if (RUN && ON(16)) { PH_ENTER
                    int toff[9], cnt[8]; moe_offsets(F, half, toff, cnt);
                    pg8::GroupOrder S; S.nM = toff[8]; S.nN = 28; S.G = F.G; S.c = bx;
#pragma unroll
                    for (int k = 0; k < 9; ++k) S.toff[k] = toff[k];
                    pg8::Gemm g{(const bf16*)(F.ws + BIG_AS), (const bf16*)(F.ws + WM_13), PCAP, 8 * 2 * DFFE, D / 2};
                    pg8::EpiSwiGLU8 E{F.ws + BIG_MH, DFFE, 28, 1.0f / W13_SCALE, HID_SCALE};
                    pg8::gemm_phase<pg8::EpiSwiGLU8, pg8::GroupOrder, true, true, true>(F.lds, g, S, E, F.tid);
                    if (half == 1) moe_post_phase(F, a, 0);
                } END_PHASE;
                if (RUN && ON(17)) { PH_ENTER
                    int toff[9], cnt[8]; moe_offsets(F, half, toff, cnt);
                    pg8::GroupOrder S; S.nM = toff[8]; S.nN = 4; S.G = F.G; S.c = bx;
#pragma unroll
                    for (int k = 0; k < 9; ++k) S.toff[k] = toff[k];
                    pg8::Gemm g{(const bf16*)(F.ws + BIG_MH), (const bf16*)(F.ws + WM_2), PCAP, 8 * D, DFFE / 2};
                    pg8::EpiPlain E{(bf16*)(F.ws + BIG_Y2S), D, 4, 0, 1.0f / (HID_SCALE * W2_SCALE)};
                    pg8::gemm_phase<pg8::EpiPlain, pg8::GroupOrder, true, true, true>(F.lds, g, S, E, F.tid);
                    if (half == 0) moe_gather_phase(F, 1, toff[8] * 4 - 4 * F.G);
                } END_PHASE;
            }
            if (RUN && ON(18)) { PH_ENTER moe_post_phase(F, a, 1); } END_PHASE;
        }
    }
#undef RUN
#undef END_PHASE
    if (MK_PROBE >= 0 && blockIdx.x == 0 && threadIdx.x == 0) {
        volatile unsigned* pw_ = (volatile unsigned*)(KARGS->ws + WS_CTL) + 20000;
        volatile float* o_ = (volatile float*)KARGS->out;
        o_[0] = o_[0] + (float)pw_[1] * (0.01f / MK_PROBE_DIV);
    }
}

extern "C" void kernel_launch(void* const* d_in, const int* in_sizes, int n_in, void* d_out, int out_size, void* d_ws, size_t ws_size, hipStream_t stream) {
    static int grid = 0;
    if (grid == 0) {
        if (n_in != 31 || in_sizes[0] != NTOK * D || out_size != NTOK * D || ws_size < WS_END) { fprintf(stderr, "kernel_launch: unexpected shapes (n_in %d, in0 %d, out %d, ws %zu)\n", n_in, n_in > 0 ? in_sizes[0] : -1, out_size, ws_size); grid = -1; return; }
        int dev = 0, cus = 0, per_cu = 0;
        if (hipGetDevice(&dev) != hipSuccess || hipDeviceGetAttribute(&cus, hipDeviceAttributeMultiprocessorCount, dev) != hipSuccess) { grid = -1; return; }
        if (hipFuncSetAttribute((const void*)fwd_kernel, hipFuncAttributeMaxDynamicSharedMemorySize, LDS_BYTES) != hipSuccess) { fprintf(stderr, "kernel_launch: hipFuncSetAttribute failed\n"); grid = -1; return; }
        if (hipOccupancyMaxActiveBlocksPerMultiprocessor(&per_cu, (const void*)fwd_kernel, NTHREADS, LDS_BYTES) != hipSuccess || per_cu < 1) { fprintf(stderr, "kernel_launch: occupancy query says %d\n", per_cu); }
        (void)hipGetLastError();
        grid = cus;
    }
    if (grid < 0) return;
    if (hipMemsetAsync((char*)d_ws + WS_CTL, 0, CTL_ZERO_BYTES, stream) != hipSuccess) return;
    Args a{};
    for (int i = 0; i < 31; ++i) a.in[i] = (const float*)d_in[i];
    a.out = (float*)d_out; a.ws = (unsigned char*)d_ws;
#if MK_MULTI
    for (int p = 0; p < NPHASES; ++p) { a.ph_lo = p; a.ph_hi = p + 1; a.sub_mask = 31;
        const bool mix = (p == 3 || p == 12);
        if (((MK_REPMASK >> p) & 1) && !mix) { a.sub_mask = 31 | MK_REPSUB; hipLaunchKernelGGL(fwd_kernel, dim3(grid), dim3(NTHREADS), LDS_BYTES, stream, a); a.sub_mask = 31; }
        if (((MK_REPMASK >> p) & 1) && mix) { a.sub_mask = MK_REPSUB; hipLaunchKernelGGL(fwd_kernel, dim3(grid), dim3(NTHREADS), LDS_BYTES, stream, a); a.sub_mask = 31; }
        hipLaunchKernelGGL(fwd_kernel, dim3(grid), dim3(NTHREADS), LDS_BYTES, stream, a); }
#else
    a.ph_lo = 0; a.ph_hi = NPHASES; a.sub_mask = 31;
    hipLaunchKernelGGL(fwd_kernel, dim3(grid), dim3(NTHREADS), LDS_BYTES, stream, a);
#endif
    const hipError_t le = hipPeekAtLastError();
    if (le != hipSuccess) fprintf(stderr, "kernel_launch: launch failed: %s\n", hipGetErrorName(le));
}
```

```cpp
#include <hip/hip_runtime.h>
#include <cstdio>
#include <cstdint>
namespace pg8 {
#define PG8_LAS __attribute__((address_space(3)))
typedef unsigned short bf16_t;
typedef short bf16x8 __attribute__((ext_vector_type(8)));
typedef float f32x4 __attribute__((ext_vector_type(4)));
typedef unsigned u32x4 __attribute__((ext_vector_type(4)));
constexpr int BM = 256, BK = 64, HALF = 128, HTB = HALF * BK * 2  , STAGE_BYTES = 8 * HTB, NXCD = 8, WGM = 8;

__host__ __device__ __forceinline__ int lds_byte(int r, int c) { const int st = (r >> 4) * 2 + (c >> 5), rr = r & 15, cc = c & 31, ob = rr * 64 + cc * 2; return st * 1024 + (ob ^ (((ob >> 9) & 1) << 5)); }
__host__ __device__ __forceinline__ void stage_rc(int b, int& R, int& C) { const int st = b / 1024, sb = b % 1024, swz = sb ^ (((sb >> 9) & 1) << 5); R = (st >> 1) * 16 + swz / 64; C = (st & 1) * 32 + (swz % 64) / 2; }
__host__ __device__ __forceinline__ int perm32(int rho) { const int n = rho >> 4, i = rho & 15; return 8 * (i >> 2) + 4 * n + (i & 3); }

struct Unit { int pm, pn; };
struct Gemm { const bf16_t* A; const bf16_t* Bt; int M, N, K; };

struct StaticOrder {
    int nM, nN, nwg, G, c;
    __host__ __device__ void init(int M, int N, int G_, int c_) { nM = M / BM; nN = N / BM; nwg = nM * nN; G = G_; c = c_; }
    __host__ __device__ bool next(int i, Unit& u) const {
        const long L = (long)i * G + c; if (L >= nwg) return false;
        int wgid = (int)L; { const int q = nwg / NXCD, r = nwg % NXCD, xcd = wgid % NXCD, off = wgid / NXCD; wgid = (xcd < r ? xcd * (q + 1) : r * (q + 1) + (xcd - r) * q) + off; }
        const int nig = WGM * nN, gid = wgid / nig, fm = gid * WGM, gsz = (nM - fm) < WGM ? (nM - fm) : WGM;
        u.pm = fm + ((wgid % nig) % gsz); u.pn = (wgid % nig) / gsz; return true;
    }
    __device__ __forceinline__ void a_ready(const Unit&) const {}
    __device__ __forceinline__ void done(const Unit&) const {}
};

typedef float f32x2_t __attribute__((ext_vector_type(2)));
typedef __bf16 bf16x2_t __attribute__((ext_vector_type(2)));
__device__ __forceinline__ unsigned cvt_pk_bf16(float lo, float hi) { const f32x2_t v = {lo, hi}; const bf16x2_t b = __builtin_convertvector(v, bf16x2_t); return __builtin_bit_cast(unsigned, b); }
__device__ __forceinline__ u32x4 pack8(f32x4 a, f32x4 b) { u32x4 w; w.x = cvt_pk_bf16(a[0], a[1]); w.y = cvt_pk_bf16(a[2], a[3]); w.z = cvt_pk_bf16(b[0], b[1]); w.w = cvt_pk_bf16(b[2], b[3]); return w; }
__device__ __forceinline__ float bf_lo(unsigned w) { return __builtin_bit_cast(float, w << 16); }
__device__ __forceinline__ float bf_hi(unsigned w) { return __builtin_bit_cast(float, w & 0xffff0000u); }
__device__ __forceinline__ void unpack8(u32x4 w, f32x4& a, f32x4& b) { a = (f32x4){bf_lo(w.x), bf_hi(w.x), bf_lo(w.y), bf_hi(w.y)}; b = (f32x4){bf_lo(w.z), bf_hi(w.z), bf_lo(w.w), bf_hi(w.w)}; }
__device__ __forceinline__ float fast_sigmoid(float x) { return __builtin_amdgcn_rcpf(1.0f + __builtin_amdgcn_exp2f(-1.4426950408889634f * x)); }

__device__ __forceinline__ f32x4 vexp2(f32x4 x) { return (f32x4){__builtin_amdgcn_exp2f(x[0]), __builtin_amdgcn_exp2f(x[1]), __builtin_amdgcn_exp2f(x[2]), __builtin_amdgcn_exp2f(x[3])}; }
__device__ __forceinline__ f32x4 vrcp(f32x4 x) { return (f32x4){__builtin_amdgcn_rcpf(x[0]), __builtin_amdgcn_rcpf(x[1]), __builtin_amdgcn_rcpf(x[2]), __builtin_amdgcn_rcpf(x[3])}; }
__device__ __forceinline__ f32x4 vsigmoid(f32x4 x, float k) { return vrcp(vexp2(x * k) + 1.0f); }
struct EpiPlain {
    static constexpr bool PERM = true, AFTER_DRAIN = false, INPLACE = false;
    bf16_t* O; int ldc; int pn_mod; int accum; float scale;
    __device__ __forceinline__ void operator()(const f32x4 (&acc)[2][2][4][2], const Unit& u, int wr, int wc, int fr, int fq) const {
        asm volatile("" : "+v"(fr), "+v"(fq));
        const int pn = pn_mod ? (u.pn % pn_mod) : u.pn;
        const int row0 = u.pm * BM + wr * 64 + fr, col0 = pn * BM + wc * 32 + 8 * fq;
#pragma unroll
        for (int ai = 0; ai < 2; ++ai)
#pragma unroll
            for (int m = 0; m < 4; ++m) { bf16_t* rowp = O + (size_t)(row0 + ai * HALF + m * 16) * ldc + col0;
#pragma unroll
                for (int bj = 0; bj < 2; ++bj) { f32x4 v0 = acc[ai][bj][m][0] * scale, v1 = acc[ai][bj][m][1] * scale;
                    if (accum) { f32x4 p0, p1; unpack8(*(const u32x4*)(rowp + bj * HALF), p0, p1); v0 = v0 + p0; v1 = v1 + p1; }
                    *(u32x4*)(rowp + bj * HALF) = pack8(v0, v1); } }
    }
};
__device__ __forceinline__ unsigned pack_u8x4(float a, float b, float c, float d) {
    unsigned w = 0; w = __builtin_amdgcn_cvt_pk_u8_f32(a, 0, w); w = __builtin_amdgcn_cvt_pk_u8_f32(b, 1, w); w = __builtin_amdgcn_cvt_pk_u8_f32(c, 2, w); w = __builtin_amdgcn_cvt_pk_u8_f32(d, 3, w); return w; }
struct EpiSig {
    static constexpr bool PERM = true, AFTER_DRAIN = false, INPLACE = false;
    unsigned char* O; int ldc; float in_scale;
    __device__ __forceinline__ void operator()(const f32x4 (&acc)[2][2][4][2], const Unit& u, int wr, int wc, int fr, int fq) const {
        const int row0 = u.pm * BM + wr * 64 + fr, col0 = u.pn * BM + wc * 32 + 8 * fq;
        typedef unsigned u32x2_ __attribute__((ext_vector_type(2)));
#pragma unroll
        for (int ai = 0; ai < 2; ++ai)
#pragma unroll
            for (int m = 0; m < 4; ++m) { unsigned char* rowp = O + (size_t)(row0 + ai * HALF + m * 16) * ldc + col0;
#pragma unroll
                for (int bj = 0; bj < 2; ++bj) { const float k = -1.4426950408889634f * in_scale;
                    const f32x4 v0 = vsigmoid(acc[ai][bj][m][0], k) * 255.0f, v1 = vsigmoid(acc[ai][bj][m][1], k) * 255.0f;
                    u32x2_ w; w.x = pack_u8x4(v0[0], v0[1], v0[2], v0[3]); w.y = pack_u8x4(v1[0], v1[1], v1[2], v1[3]);
                    *(u32x2_*)(rowp + bj * HALF) = w; } }
    }
};
struct EpiSwiGLU {
    static constexpr bool PERM = true, AFTER_DRAIN = false, INPLACE = false;
    bf16_t* O; int ldc; int pn_mod;
    __device__ __forceinline__ void operator()(const f32x4 (&acc)[2][2][4][2], const Unit& u, int wr, int wc, int fr, int fq) const {
        const int pn = pn_mod ? (u.pn % pn_mod) : u.pn;
        const int row0 = u.pm * BM + wr * 64 + fr, col0 = pn * HALF + wc * 32 + 8 * fq;
#pragma unroll
        for (int ai = 0; ai < 2; ++ai)
#pragma unroll
            for (int m = 0; m < 4; ++m) { bf16_t* rowp = O + (size_t)(row0 + ai * HALF + m * 16) * ldc + col0;
                const f32x4 a0 = acc[ai][0][m][0], a1 = acc[ai][0][m][1], g0 = acc[ai][1][m][0], g1 = acc[ai][1][m][1];
                const f32x4 v0 = (a0 * g0) * vsigmoid(a0, -1.4426950408889634f), v1 = (a1 * g1) * vsigmoid(a1, -1.4426950408889634f);
                *(u32x4*)rowp = pack8(v0, v1); }
    }
};
__device__ __forceinline__ unsigned pack_fp8x4(float a, float b, float c, float d) {
    a = __builtin_amdgcn_fmed3f(a, -448.f, 448.f); b = __builtin_amdgcn_fmed3f(b, -448.f, 448.f); c = __builtin_amdgcn_fmed3f(c, -448.f, 448.f); d = __builtin_amdgcn_fmed3f(d, -448.f, 448.f);
    int w = 0; w = __builtin_amdgcn_cvt_pk_fp8_f32(a, b, w, false); w = __builtin_amdgcn_cvt_pk_fp8_f32(c, d, w, true); return (unsigned)w; }
struct EpiSwiGLU8 {
    static constexpr bool PERM = true, AFTER_DRAIN = false, INPLACE = false;
    unsigned char* O; int ldc; int pn_mod; float in_scale, out_scale;
    __device__ __forceinline__ void operator()(const f32x4 (&acc)[2][2][4][2], const Unit& u, int wr, int wc, int fr, int fq) const {
        asm volatile("" : "+v"(fr), "+v"(fq));
        const int pn = pn_mod ? (u.pn % pn_mod) : u.pn;
        const int row0 = u.pm * BM + wr * 64 + fr, col0 = pn * HALF + wc * 32 + 8 * fq;
#pragma unroll
        for (int ai = 0; ai < 2; ++ai)
#pragma unroll
            for (int m = 0; m < 4; ++m) { unsigned char* rowp = O + (size_t)(row0 + ai * HALF + m * 16) * ldc + col0;
                const f32x4 a0 = acc[ai][0][m][0], a1 = acc[ai][0][m][1], g0 = acc[ai][1][m][0], g1 = acc[ai][1][m][1];
                const float k1 = -1.4426950408889634f * in_scale, k2 = in_scale * in_scale * out_scale;
                const f32x4 v0 = ((a0 * g0) * vsigmoid(a0, k1)) * k2, v1 = ((a1 * g1) * vsigmoid(a1, k1)) * k2;
                typedef unsigned u32x2_ __attribute__((ext_vector_type(2)));
                u32x2_ w; w.x = pack_fp8x4(v0[0], v0[1], v0[2], v0[3]); w.y = pack_fp8x4(v1[0], v1[1], v1[2], v1[3]);
                *(u32x2_*)rowp = w; }
    }
};
struct EpiMerge {
    static constexpr bool PERM = true, AFTER_DRAIN = false, INPLACE = true;
    bf16_t* Mo; const unsigned char* Gt; int off0, off1, off2;
    __device__ __forceinline__ static void ub4(unsigned w, f32x4& v) { v = (f32x4){(float)(w & 0xffu), (float)((w >> 8) & 0xffu), (float)((w >> 16) & 0xffu), (float)(w >> 24)}; }
    __device__ __forceinline__ bool inplace(f32x4 (&acc)[2][2][4][2], const Unit& u, int wr, int wc, int fr, int fq) const {
        typedef unsigned u32x2_ __attribute__((ext_vector_type(2)));
        const int br = u.pn >> 2, pn = u.pn & 3, pm = u.pm - (br < 2 ? off0 + br * (off1 - off0) : off2);
        const int row0 = pm * BM + wr * 64 + fr, col0 = pn * BM + wc * 32 + 8 * fq;
#pragma unroll
        for (int ai = 0; ai < 2; ++ai)
#pragma unroll
            for (int m = 0; m < 4; ++m) { const size_t row = (size_t)(row0 + ai * HALF + m * 16); const unsigned char* gp = Gt + row * 3072 + br * 1024 + col0;
#pragma unroll
                for (int bj = 0; bj < 2; ++bj) { const u32x2_ gw = *(const u32x2_*)(gp + bj * HALF); f32x4 g0, g1; ub4(gw.x, g0); ub4(gw.y, g1);
                    if (br < 2) { const u32x2_ nw = *(const u32x2_*)(gp + 1024 + bj * HALF); f32x4 n0, n1; ub4(nw.x, n0); ub4(nw.y, n1);
#pragma unroll
                        for (int e = 0; e < 4; ++e) { g0[e] = fmaxf(g0[e], 0.5f) * __builtin_amdgcn_rcpf(fmaxf(n0[e], 0.5f)); g1[e] = fmaxf(g1[e], 0.5f) * __builtin_amdgcn_rcpf(fmaxf(n1[e], 0.5f)); }
                        acc[ai][bj][m][0] = acc[ai][bj][m][0] * g0; acc[ai][bj][m][1] = acc[ai][bj][m][1] * g1;
                    } else {
#pragma unroll
                        for (int e = 0; e < 4; ++e) { g0[e] = fmaxf(g0[e], 0.5f) * (1.0f / 255.0f); g1[e] = fmaxf(g1[e], 0.5f) * (1.0f / 255.0f); }
                        *(u32x4*)(Mo + row * 1024 + col0 + bj * HALF) = pack8(acc[ai][bj][m][0] * g0, acc[ai][bj][m][1] * g1); }
                } }
        return br < 2;
    }
};
struct EpiQKV {
    static constexpr bool PERM = true, AFTER_DRAIN = false, INPLACE = false;
    bf16_t* O; const float* rope; int row_base; float qscale; float in_scale;
    __device__ __forceinline__ void operator()(const f32x4 (&acc)[2][2][4][2], const Unit& u, int wr, int wc, int fr, int fq) const {
        const int rowt = row_base + u.pm * BM;
        const bool latent = rowt < 65536;
        const int row0 = rowt + wr * 64 + fr, col0 = u.pn * BM + wc * 32 + 8 * fq;
#pragma unroll
        for (int bj = 0; bj < 2; ++bj) {
            const int cb = 2 * u.pn + bj;
            const bool do_rope = latent && (cb == 0 || (cb >= 10 && cb < 14));
            const float sc = (cb >= 10) ? qscale * in_scale : in_scale;
#pragma unroll
            for (int ai = 0; ai < 2; ++ai)
#pragma unroll
                for (int m = 0; m < 4; ++m) {
                    const int row = row0 + ai * HALF + m * 16;
                    f32x4 v0 = acc[ai][bj][m][0], v1 = acc[ai][bj][m][1];
                    if (do_rope) {
                        const int t = row & 2047, pos = (wc & 1) ? (t & 63) : (t >> 6);
                        const float* cp = rope + pos * 16 + 8 * (fq & 1);
                        const f32x4 c0 = *(const f32x4*)cp, c1 = *(const f32x4*)(cp + 4), s0 = *(const f32x4*)(cp + 1024), s1 = *(const f32x4*)(cp + 1028);
                        const float sg = (fq >= 2) ? 1.0f : -1.0f;
                        f32x4 o0, o1;
#pragma unroll
                        for (int e = 0; e < 4; ++e) { o0[e] = __shfl_xor(v0[e], 32); o1[e] = __shfl_xor(v1[e], 32); }
                        v0 = v0 * c0 + (o0 * sg) * s0; v1 = v1 * c1 + (o1 * sg) * s1;
                    }
                    v0 = v0 * sc; v1 = v1 * sc;
                    *(u32x4*)(O + (size_t)row * 2304 + col0 + bj * HALF) = pack8(v0, v1);
                }
        }
    }
};
__device__ __forceinline__ void tile_of(int L, int nM, int nN, int& pm, int& pn) {
    const int nwg = nM * nN; int wgid = L; { const int q = nwg / NXCD, r = nwg % NXCD, xcd = wgid % NXCD, off = wgid / NXCD; wgid = (xcd < r ? xcd * (q + 1) : r * (q + 1) + (xcd - r) * q) + off; }
    const int nig = WGM * nN, gid = wgid / nig, fm = gid * WGM, gsz = (nM - fm) < WGM ? (nM - fm) : WGM;
    pm = fm + ((wgid % nig) % gsz); pn = (wgid % nig) / gsz;
}
struct MergeOrder {
    int nM, G, c, off0, off1, off2;
    __device__ bool next(int i, Unit& u) const {
        const int t = i / 3, br = i - 3 * t; const long L = (long)t * G + c; if (L >= (long)nM * 4) return false;
        int pm, pn; tile_of((int)L, nM, 4, pm, pn); u.pm = (br < 2 ? off0 + br * (off1 - off0) : off2) + pm; u.pn = br * 4 + pn; return true;
    }
    __device__ __forceinline__ void a_ready(const Unit&) const {}
    __device__ __forceinline__ void done(const Unit&) const {}
};
struct GroupOrder {
    int nM, nN, G, c; int toff[9];
    __device__ bool next(int i, Unit& u) const {
        const long L = (long)i * G + c; if (L >= (long)nM * nN) return false;
        int pm, pn; tile_of((int)L, nM, nN, pm, pn); int e = 0;
#pragma unroll
        for (int k = 1; k < 8; ++k) e += (pm >= toff[k]) ? 1 : 0;
        u.pm = pm; u.pn = e * nN + pn; return true;
    }
    __device__ __forceinline__ void a_ready(const Unit&) const {}
    __device__ __forceinline__ void done(const Unit&) const {}
};
template <class Epi, class Sched, bool ALIGN_EPI = false, bool SP2 = false, bool F8 = false>
__device__ __forceinline__ void gemm_phase(PG8_LAS unsigned char* lds, const Gemm g, const Sched& S, const Epi& E, const int tid) {
    const int wid = __builtin_amdgcn_readfirstlane(tid >> 6), lane = tid & 63, wr = wid >> 2, wc = wid & 3, fr = lane & 15, fq = lane >> 4;
    const int K = g.K, nt = K / BK;
    unsigned voffA[2], voffB[2];
#pragma unroll
    for (int i = 0; i < 2; ++i) { int R, C; stage_rc(tid * 16 + i * 8192, R, C); const int Rb = Epi::PERM ? ((R & ~31) + perm32(R & 31)) : R;
        voffA[i] = (unsigned)(R * K + C) * 2u; voffB[i] = (unsigned)(Rb * K + C) * 2u; }
    const size_t kstep = (size_t)(BK * 2);
    const size_t hstep = (size_t)HALF * K * 2;
    const size_t tstep = 2 * hstep;
    const unsigned ldsw = (unsigned)wid * 1024u;
    const int aoff = lds_byte(wr * 64 + fr, fq * 8), boff = lds_byte(wc * 32 + fr, fq * 8);
#define PG8_SA(b, h) (((b) * 2 + (h)) * HTB)
#define PG8_SB(b, h) ((4 + (b) * 2 + (h)) * HTB)
#define PG8_STAGE(bufoff, gbase, voff) do { _Pragma("unroll") for (int _i = 0; _i < 2; ++_i) \
        __builtin_amdgcn_global_load_lds((const unsigned*)((const char*)(gbase) + (voff)[_i]), (PG8_LAS unsigned*)(lds + (bufoff) + ldsw + _i * 8192), 16, 0, 0); } while (0)
#define PG8_LDA(dst, b, h) do { _Pragma("unroll") for (int m = 0; m < 4; ++m) _Pragma("unroll") for (int k = 0; k < 2; ++k) dst[m][k] = *(const PG8_LAS bf16x8*)(lds + PG8_SA(b, h) + aoff + m * 2048 + k * 1024); } while (0)
#define PG8_LDB(dst, b, h) do { _Pragma("unroll") for (int n = 0; n < 2; ++n) _Pragma("unroll") for (int k = 0; k < 2; ++k) dst[n][k] = *(const PG8_LAS bf16x8*)(lds + PG8_SB(b, h) + boff + n * 2048 + k * 1024); } while (0)
#define PG8_MMA(ai, bj, At, Bt) do { __builtin_amdgcn_s_setprio(1); _Pragma("unroll") for (int m = 0; m < 4; ++m) _Pragma("unroll") for (int n = 0; n < 2; ++n) { \
        if constexpr (F8) { typedef int v8i_ __attribute__((ext_vector_type(8))); typedef int v4i_ __attribute__((ext_vector_type(4))); \
            const v4i_ b0_ = __builtin_bit_cast(v4i_, Bt[n][0]), b1_ = __builtin_bit_cast(v4i_, Bt[n][1]), a0_ = __builtin_bit_cast(v4i_, At[m][0]), a1_ = __builtin_bit_cast(v4i_, At[m][1]); \
            const v8i_ bb_ = __builtin_shufflevector(b0_, b1_, 0, 1, 2, 3, 4, 5, 6, 7), aa_ = __builtin_shufflevector(a0_, a1_, 0, 1, 2, 3, 4, 5, 6, 7); \
            asm volatile("v_mfma_scale_f32_16x16x128_f8f6f4 %0, %1, %2, %0, %3, %3 op_sel_hi:[0,0,0]" : "+v"(acc[ai][bj][m][n]) : "v"(bb_), "v"(aa_), "v"(f8_scale_)); } \
        else { _Pragma("unroll") for (int k = 0; k < 2; ++k) acc[ai][bj][m][n] = __builtin_amdgcn_mfma_f32_16x16x32_bf16(Bt[n][k], At[m][k], acc[ai][bj][m][n], 0, 0, 0); } } \
        __builtin_amdgcn_s_setprio(0); } while (0)
#define PG8_WAIT_V(n) asm volatile("s_waitcnt vmcnt(" #n ")" ::: "memory")
#define PG8_WAIT_L(n) asm volatile("s_waitcnt lgkmcnt(" #n ")" ::: "memory")
#define PG8_BAR __builtin_amdgcn_s_barrier()
#define PG8_SCHED __builtin_amdgcn_sched_barrier(0)
    int f8_scale_ = 0x7f7f7f7f; (void)f8_scale_;
    Unit cur, nxt; int ui = 0;
    if (!S.next(0, cur)) return;
    f32x4 acc[2][2][4][2];
#pragma unroll
    for (int a = 0; a < 2; ++a)
#pragma unroll
        for (int b = 0; b < 2; ++b)
#pragma unroll
            for (int m = 0; m < 4; ++m)
#pragma unroll
                for (int n = 0; n < 2; ++n) acc[a][b][m][n] = (f32x4){0.f, 0.f, 0.f, 0.f};
    bf16x8 At[4][2], B0[2][2], B1[2][2];
    const char* cA = (const char*)g.A + (size_t)cur.pm * tstep; const char* cB = (const char*)g.Bt + (size_t)cur.pn * tstep;
    S.a_ready(cur);
    if constexpr (SP2) {
        PG8_STAGE(PG8_SB(0, 0), cB, voffB); PG8_STAGE(PG8_SB(0, 1), cB + hstep, voffB); PG8_STAGE(PG8_SA(0, 0), cA, voffA); PG8_STAGE(PG8_SA(0, 1), cA + hstep, voffA);
        if (wr == 1) PG8_BAR;
        PG8_WAIT_V(2); PG8_BAR;
        PG8_STAGE(PG8_SB(1, 0), cB + kstep, voffB); PG8_STAGE(PG8_SA(1, 0), cA + kstep, voffA); PG8_STAGE(PG8_SB(1, 1), cB + hstep + kstep, voffB);
        PG8_WAIT_V(6); PG8_BAR;
    } else {
        PG8_STAGE(PG8_SB(0, 0), cB, voffB); PG8_STAGE(PG8_SA(0, 0), cA, voffA); PG8_STAGE(PG8_SB(0, 1), cB + hstep, voffB); PG8_STAGE(PG8_SA(0, 1), cA + hstep, voffA);
        if (wr == 1) PG8_BAR;
        PG8_WAIT_V(4); PG8_BAR;
        PG8_STAGE(PG8_SB(1, 0), cB + kstep, voffB); PG8_STAGE(PG8_SA(1, 0), cA + kstep, voffA); PG8_STAGE(PG8_SB(1, 1), cB + hstep + kstep, voffB);
        PG8_WAIT_V(6); PG8_BAR;
    }
    for (;;) {
        const bool has_next = S.next(ui + 1, nxt);
        const char* nA = has_next ? (const char*)g.A + (size_t)nxt.pm * tstep : cA; const char* nB = has_next ? (const char*)g.Bt + (size_t)nxt.pn * tstep : cB;
#pragma unroll 1
        for (int t = 0; t < nt; t += 2) {
            const bool last = (t == nt - 2);
            const char* a1 = cA + (size_t)(t + 1) * kstep;
            const char* a2 = last ? nA : cA + (size_t)(t + 2) * kstep; const char* b2 = last ? nB : cB + (size_t)(t + 2) * kstep;
            const char* a3 = a2 + kstep; const char* b3 = b2 + kstep;
            if (last && has_next) S.a_ready(nxt);
            if constexpr (SP2) {
            PG8_LDB(B0, 0, 0); PG8_LDB(B1, 0, 1); PG8_SCHED; PG8_LDA(At, 0, 0); PG8_STAGE(PG8_SA(1, 1), a1 + hstep, voffA);
            PG8_WAIT_V(8); PG8_WAIT_L(0); PG8_BAR; PG8_MMA(0, 0, At, B0); PG8_MMA(0, 1, At, B1); PG8_BAR; PG8_SCHED;
            PG8_LDA(At, 0, 1); PG8_STAGE(PG8_SB(0, 0), b2, voffB); PG8_STAGE(PG8_SB(0, 1), b2 + hstep, voffB); PG8_STAGE(PG8_SA(0, 0), a2, voffA);
            PG8_WAIT_V(8); PG8_WAIT_L(0); PG8_BAR; PG8_MMA(1, 0, At, B0); PG8_MMA(1, 1, At, B1); PG8_BAR; PG8_SCHED;
            PG8_LDB(B0, 1, 0); PG8_LDB(B1, 1, 1); PG8_SCHED; PG8_LDA(At, 1, 0); PG8_STAGE(PG8_SA(0, 1), a2 + hstep, voffA);
            PG8_WAIT_V(8); PG8_WAIT_L(0); PG8_BAR; PG8_MMA(0, 0, At, B0); PG8_MMA(0, 1, At, B1); PG8_BAR; PG8_SCHED;
            PG8_LDA(At, 1, 1); PG8_STAGE(PG8_SB(1, 0), b3, voffB); PG8_STAGE(PG8_SB(1, 1), b3 + hstep, voffB); PG8_STAGE(PG8_SA(1, 0), a3, voffA);
            PG8_WAIT_V(8); PG8_WAIT_L(0); PG8_BAR; PG8_MMA(1, 0, At, B0); PG8_MMA(1, 1, At, B1); PG8_BAR; PG8_SCHED;
            } else {
            PG8_LDB(B0, 0, 0); PG8_SCHED; PG8_LDA(At, 0, 0); PG8_STAGE(PG8_SA(1, 1), a1 + hstep, voffA);
            PG8_WAIT_L(8); PG8_BAR; PG8_WAIT_L(0); PG8_MMA(0, 0, At, B0); PG8_BAR; PG8_SCHED;
            PG8_LDB(B1, 0, 1); PG8_STAGE(PG8_SB(0, 0), b2, voffB);
            PG8_BAR; PG8_WAIT_L(0); PG8_MMA(0, 1, At, B1); PG8_BAR;
            PG8_LDA(At, 0, 1); PG8_STAGE(PG8_SA(0, 0), a2, voffA);
            PG8_BAR; PG8_WAIT_L(0); PG8_MMA(1, 0, At, B0); PG8_BAR; PG8_SCHED;
            PG8_STAGE(PG8_SB(0, 1), b2 + hstep, voffB);
            PG8_WAIT_V(6); PG8_BAR; PG8_MMA(1, 1, At, B1); PG8_BAR;
            PG8_LDB(B0, 1, 0); PG8_SCHED; PG8_LDA(At, 1, 0); PG8_STAGE(PG8_SA(0, 1), a2 + hstep, voffA);
            PG8_WAIT_L(8); PG8_BAR; PG8_WAIT_L(0); PG8_MMA(0, 0, At, B0); PG8_BAR; PG8_SCHED;
            PG8_LDB(B1, 1, 1); PG8_STAGE(PG8_SB(1, 0), b3, voffB);
            PG8_BAR; PG8_WAIT_L(0); PG8_MMA(0, 1, At, B1); PG8_BAR;
            PG8_LDA(At, 1, 1); PG8_STAGE(PG8_SA(1, 0), a3, voffA);
            PG8_BAR; PG8_WAIT_L(0); PG8_MMA(1, 0, At, B0); PG8_BAR; PG8_SCHED;
            PG8_STAGE(PG8_SB(1, 1), b3 + hstep, voffB);
            PG8_WAIT_V(6); PG8_BAR; PG8_MMA(1, 1, At, B1); PG8_BAR;
            }
        }
        if constexpr (ALIGN_EPI) { if (wr == 0) PG8_BAR; }
        if constexpr (F8) asm volatile("s_nop 15\n\ts_nop 15" ::: "memory");
        bool keep_acc = false;
        if constexpr (Epi::INPLACE) { keep_acc = E.inplace(acc, cur, wr, wc, fr, fq); S.done(cur); }
        else if constexpr (!Epi::AFTER_DRAIN) { E(acc, cur, wr, wc, fr, fq); S.done(cur); }
        if (!has_next) break;
        if (!keep_acc)
#pragma unroll
        for (int a = 0; a < 2; ++a)
#pragma unroll
            for (int b = 0; b < 2; ++b)
#pragma unroll
                for (int m = 0; m < 4; ++m)
#pragma unroll
                    for (int n = 0; n < 2; ++n) acc[a][b][m][n] = (f32x4){0.f, 0.f, 0.f, 0.f};
        cur = nxt; cA = nA; cB = nB; ++ui;
        if constexpr (ALIGN_EPI) { if (wr == 1) PG8_BAR; }
    }
    PG8_WAIT_V(0);
    if constexpr (!ALIGN_EPI) { if (wr == 0) PG8_BAR; }
    PG8_BAR;
    if constexpr (Epi::AFTER_DRAIN) { E.fused(acc, cur, wr, wc, fr, fq, lds, wid, lane); S.done(cur); }
#undef PG8_SA
#undef PG8_SB
#undef PG8_STAGE
#undef PG8_LDA
#undef PG8_LDB
#undef PG8_MMA
#undef PG8_WAIT_V
#undef PG8_WAIT_L
#undef PG8_BAR
#undef PG8_SCHED
}
}
#define GAS __attribute__((address_space(1)))
#define LAS __attribute__((address_space(3)))
typedef unsigned short bf16;
typedef unsigned v4u __attribute__((ext_vector_type(4)));
typedef float f32x4 __attribute__((ext_vector_type(4)));
typedef short bf16x8 __attribute__((ext_vector_type(8)));
typedef GAS unsigned gu32;
typedef GAS unsigned long long gu64;
#define RLX_AGENT __ATOMIC_RELAXED, __HIP_MEMORY_SCOPE_AGENT
#define LDS_WAIT() asm volatile("s_waitcnt lgkmcnt(0)" ::: "memory")
#define VM_WAIT() asm volatile("s_waitcnt vmcnt(0)" ::: "memory")
__device__ __forceinline__ unsigned long long rt() { return __builtin_amdgcn_s_memrealtime(); }
__device__ __forceinline__ unsigned f2bf(float f) { unsigned u = __builtin_bit_cast(unsigned, f); return (u + 0x7fffu + ((u >> 16) & 1u)) >> 16; }
__device__ __forceinline__ unsigned pk2(float lo, float hi) { return pg8::cvt_pk_bf16(lo, hi); }

#define XB_TMO      128
#define XB_XCNT(j)  (256  + 64 * (j))
#define XB_XSUB(j)  (1280 + 64 * (j))
#define XB_XGEN(j)  (2304 + 64 * (j))
#define XB_TOP      3328
#define XB_TOPGEN   3392
#define XCD_BAR_WORDS 3456
#define XB_SPIN_CAP (1u << 18)

__device__ __forceinline__ unsigned xb_ld(unsigned* p)              { return __hip_atomic_load(p, __ATOMIC_RELAXED, __HIP_MEMORY_SCOPE_AGENT); }
__device__ __forceinline__ unsigned xb_add(unsigned* p, unsigned v) { return __hip_atomic_fetch_add(p, v, __ATOMIC_RELAXED, __HIP_MEMORY_SCOPE_AGENT); }
__device__ __forceinline__ unsigned xb_xcc_id() { return (unsigned)__builtin_amdgcn_s_getreg((3 << 11) | 20) & 0xFu; }
#define XB_SPIN(cond, bar) do { unsigned _sp = 0; while (cond) { __builtin_amdgcn_s_sleep(1); \
    if ((++_sp & 255u) == 0u) { if (xb_ld(&(bar)[XB_TMO])) break; if (_sp > XB_SPIN_CAP) { atomicAdd(&(bar)[XB_TMO], 1u); break; } } } } while (0)

struct XcdBarrier {
    unsigned* bar; unsigned x;
    volatile LAS unsigned* st;
};

__device__ __forceinline__ XcdBarrier xcd_barrier_post(unsigned* bar, volatile LAS unsigned* st) {
    XcdBarrier b; b.bar = bar; b.x = xb_xcc_id(); b.st = st;
    if (threadIdx.x == 0) (void)xb_add(&bar[XB_XCNT(b.x)], 1u);
    return b;
}
__device__ __forceinline__ void xcd_barrier_complete(unsigned* bar, unsigned x, unsigned& nloc, unsigned& nx) {
    const unsigned G = gridDim.x * gridDim.y * gridDim.z;
    unsigned sum, cnt, mine, sp = 0u;
    for (;;) {
        sum = 0u; cnt = 0u; mine = 0u;
#pragma unroll
        for (unsigned j = 0; j < 16; ++j) { const unsigned c = xb_ld(&bar[XB_XCNT(j)]); sum += c; cnt += (c > 0u) ? 1u : 0u; mine = (j == x) ? c : mine; }
        if (sum == G) break;
        __builtin_amdgcn_s_sleep(1);
        if ((++sp & 255u) == 0u) { if (xb_ld(&bar[XB_TMO])) break; if (sp > XB_SPIN_CAP) { atomicAdd(&bar[XB_TMO], 1u); break; } }
    }
    nloc = mine > 0u ? mine : 1u; nx = cnt > 0u ? cnt : 1u;
}

__device__ __forceinline__ void xcd_barrier(const XcdBarrier& b) {
    asm volatile("s_waitcnt vmcnt(0)" ::: "memory");
    __syncthreads();
    if (threadIdx.x == 0) {
        unsigned* bar = b.bar;
        __builtin_amdgcn_s_waitcnt(0);
        unsigned nloc = b.st[0], nx = b.st[1];
        if (nloc == 0u) { xcd_barrier_complete(bar, b.x, nloc, nx); b.st[0] = nloc; b.st[1] = nx; }
        const unsigned old = xb_add(&bar[XB_XSUB(b.x)], 1u);
        const unsigned gen = old / nloc;
        if (old + 1u == (gen + 1u) * nloc) {
            __builtin_amdgcn_fence(__ATOMIC_RELEASE, "agent");
            asm volatile("s_waitcnt vmcnt(0)" ::: "memory");
            const unsigned og = xb_add(&bar[XB_TOP], 1u);
            const unsigned tg = og / nx;
            if (og + 1u == (tg + 1u) * nx) xb_add(&bar[XB_TOPGEN], 1u);
            else XB_SPIN(xb_ld(&bar[XB_TOPGEN]) == tg, bar);
            __builtin_amdgcn_fence(__ATOMIC_ACQUIRE, "agent");
            xb_add(&bar[XB_XGEN(b.x)], 1u);
            asm volatile("s_waitcnt vmcnt(0)" ::: "memory");
        } else {
            XB_SPIN(xb_ld(&bar[XB_XGEN(b.x)]) == gen, bar);
            __builtin_amdgcn_fence(__ATOMIC_ACQUIRE, "agent");
            asm volatile("s_waitcnt vmcnt(0)" ::: "memory");
        }
    }
    __syncthreads();
}

typedef float f32x16 __attribute__((ext_vector_type(16)));
typedef short s16x4 __attribute__((ext_vector_type(4)));
typedef unsigned v2u __attribute__((ext_vector_type(2)));
#define MFMA32(a, b, c) __builtin_amdgcn_mfma_f32_32x32x16_bf16((a), (b), (c), 0, 0, 0)

constexpr int NWAVES = 8, NTHREADS = 512;
constexpr int D = 1024, NB = 32, SEQ = 2048, LC = 256, NTOK = NB * SEQ, NCTX = NB * LC, NROW = NTOK + NCTX;
constexpr int INC = 6912, QKVC = 2304, CINC = 1536, GATEC = 3072, DFF = 2816, NEXP = 8, DFFE = 3584, FCH = 1792;
constexpr float W13_SCALE = 32.f, W2_SCALE = 64.f, HID_SCALE = 4.f;
constexpr float LOG2E = 1.4426950408889634f, QSCALE = 0.125f * LOG2E, EPS = 1e-6f;
constexpr int PCAP = 32768 * 2 + 8 * 256;

constexpr size_t MiB = 1u << 20;
constexpr size_t WS_CTL = 0, CTL_ZERO_BYTES = 1 * MiB;
constexpr size_t WS_MODV = 1 * MiB;
constexpr size_t WS_ROPE = 3 * MiB;
constexpr size_t WS_ROUTE = 4 * MiB;
constexpr size_t WS_LIST = 5 * MiB;
constexpr size_t WS_INV = 7 * MiB;
constexpr size_t WS_GF = 8 * MiB;
constexpr size_t WS_GFC = 24 * MiB;
constexpr size_t WS_W = 26 * MiB;
constexpr size_t W_IN = WS_W;
constexpr size_t W_CB = W_IN + (size_t)2 * INC * D;
constexpr size_t W_BR = W_IN + (size_t)2 * INC * D * 2;
constexpr size_t W_OUT = W_BR + (size_t)2 * 3 * D * 512 * 2;
constexpr size_t W_F13 = W_OUT + (size_t)2 * D * D * 2;
constexpr size_t W_F2 = W_F13 + (size_t)2 * DFF * D * 2;
constexpr size_t W_END = W_F2 + (size_t)D * DFF * 2;
constexpr size_t WS_CTXRES = 80 * MiB;
constexpr size_t WS_XB = 112 * MiB;
constexpr size_t WS_BIG = 256 * MiB;
constexpr size_t BIG_CINT = WS_BIG;
constexpr size_t BIG_QKV = WS_BIG + 216 * MiB;
constexpr size_t BIG_GATE = WS_BIG + 72 * MiB;
constexpr size_t BIG_YCT = WS_BIG + 288 * MiB;
constexpr size_t BIG_HID = WS_BIG;
constexpr size_t BIG_RAW = WS_BIG;
constexpr size_t BIG_AS = WS_BIG;
constexpr size_t BIG_MH = WS_BIG + 68 * MiB;
constexpr size_t BIG_Y2S = WS_BIG + 300 * MiB;
constexpr size_t WS_Y3 = 796 * MiB;
constexpr size_t WM_13 = WS_Y3;
constexpr size_t WM_2 = WS_Y3 + 56 * MiB;
constexpr size_t WS_H8 = WS_Y3 + 144 * MiB;
constexpr size_t WS_END = 1012 * MiB;
static_assert(W_END <= WS_CTXRES && BIG_Y2S + (size_t)PCAP * D * 2 <= WS_Y3 && BIG_QKV + (size_t)NROW * QKVC * 2 <= WS_Y3 && BIG_GATE + (size_t)NROW * GATEC <= WS_Y3, "ws map");
static_assert(BIG_MH + (size_t)PCAP * DFFE <= BIG_Y2S && BIG_AS + (size_t)PCAP * D <= BIG_MH && WM_13 + (size_t)8 * 2 * DFFE * D <= WM_2 && WM_2 + (size_t)8 * D * DFFE <= WS_END, "ws map 2");

constexpr int CW_BAR = 4096;
constexpr int CW_CNT = 16384;

constexpr int LDS_BYTES = 150528, MISC_OFF = 147456;


struct Args {
    const float* in[31];
    float* out; unsigned char* ws;
    int ph_lo, ph_hi, sub_mask, pad;
};
enum { I_X = 0, I_C, I_CTX, I_CCTX, I_WMOD, I_BMOD, I_GMIXPRE, I_GMIXPOST, I_GFFNPRE, I_GFFNPOST, I_WIN, I_SINK, I_RPB, I_CONVW, I_CONVB, I_HW1, I_HB1, I_HW2, I_HB2, I_HW3,
       I_HFREQ, I_HBIAS, I_WBR, I_WOUT, I_FW1, I_FW3, I_FW2, I_ROUTER, I_MW1, I_MW3, I_MW2 };

struct Frame {
    LAS unsigned char* lds;
    int tid, lane, wave, vcu, G;
    unsigned char* ws;
    bf16* hb;
};

__device__ __forceinline__ float wave_sum(float v) {
#pragma unroll
    for (int o = 1; o < 64; o <<= 1) v += __shfl_xor(v, o);
    return v;
}
__device__ __forceinline__ float bf2f(bf16 b) { return __builtin_bit_cast(float, ((unsigned)b) << 16); }
__device__ __forceinline__ float silu_f(float x) { return x / (1.0f + __expf(-x)); }

__device__ __forceinline__ void transpose_item(const float* W, int N, bf16* WT, int Kp, int k0, int n0, int drow0, LAS float* scr, int lane) {
    { const int c4 = 4 * (lane & 7);
#pragma unroll
      for (int i = 0; i < 8; ++i) { const int kk = (lane >> 3) + 8 * i; const f32x4 v = *(const f32x4*)(W + (size_t)(k0 + kk) * N + n0 + c4); LAS float* d = scr + kk * 33 + c4; d[0] = v.x; d[1] = v.y; d[2] = v.z; d[3] = v.w; } }
    LDS_WAIT(); asm volatile("" ::: "memory");
    const int c = lane & 7;
#pragma unroll
    for (int j = 0; j < 4; ++j) { const int n = (lane >> 3) + 8 * j; const LAS float* s = scr + (8 * c) * 33 + n;
        v4u o; o.x = pk2(s[0 * 33], s[1 * 33]); o.y = pk2(s[2 * 33], s[3 * 33]); o.z = pk2(s[4 * 33], s[5 * 33]); o.w = pk2(s[6 * 33], s[7 * 33]);
        *(GAS v4u*)(WT + (size_t)(drow0 + n) * Kp + k0 + 8 * c) = o; }
    LDS_WAIT(); asm volatile("" ::: "memory");
}
__device__ __forceinline__ bool conv_job(int& r, const float* W, int K, int N, bf16* WT, int Kp, int rowoff, int mode, int which, LAS float* scr, int lane) {
    const int nblk = N / 32, items = (K / 64) * nblk;
    if (r >= items) { r -= items; return false; }
    const int kb = r / nblk, nb = r % nblk, n0 = 32 * nb;
    const int drow0 = mode ? rowoff + (n0 / 128) * 256 + which * 128 + (n0 % 128) : rowoff + n0;
    transpose_item(W, N, WT, Kp, 64 * kb, n0, drow0, scr, lane);
    return true;
}

__device__ __forceinline__ void transpose_item_f8(const float* W, int N, unsigned char* WT, int Kp, int k0, int n0, int drow0, float scale, LAS float* scr, int lane) {
    { const int c4 = 4 * (lane & 7);
#pragma unroll
      for (int i = 0; i < 8; ++i) { const int kk = (lane >> 3) + 8 * i; const f32x4 v = *(const f32x4*)(W + (size_t)(k0 + kk) * N + n0 + c4) * scale; LAS float* d = scr + kk * 33 + c4; d[0] = v.x; d[1] = v.y; d[2] = v.z; d[3] = v.w; } }
    LDS_WAIT(); asm volatile("" ::: "memory");
    const int c = lane & 7;
#pragma unroll
    for (int j = 0; j < 4; ++j) { const int n = (lane >> 3) + 8 * j; const LAS float* s = scr + (8 * c) * 33 + n;
        v2u o; o.x = pg8::pack_fp8x4(s[0 * 33], s[1 * 33], s[2 * 33], s[3 * 33]); o.y = pg8::pack_fp8x4(s[4 * 33], s[5 * 33], s[6 * 33], s[7 * 33]);
        *(GAS v2u*)(WT + (size_t)(drow0 + n) * Kp + k0 + 8 * c) = o; }
    LDS_WAIT(); asm volatile("" ::: "memory");
}
__device__ __forceinline__ bool conv_job_f8(int& r, const float* W, int K, int N, unsigned char* WT, int Kp, int mode, int which, float scale, LAS float* scr, int lane) {
    const int nblk = N / 32, items = (K / 64) * nblk;
    if (r >= items) { r -= items; return false; }
    const int kb = r / nblk, nb = r % nblk, n0 = 32 * nb;
    const int drow0 = mode ? (n0 / 128) * 256 + which * 128 + (n0 % 128) : n0;
    transpose_item_f8(W, N, WT, Kp, 64 * kb, n0, drow0, scale, scr, lane);
    return true;
}

__device__ __forceinline__ void ld_row_f32(const float* p, int lane, f32x4 (&v)[4]) {
    const GAS f32x4* q = (const GAS f32x4*)p + lane;
#pragma unroll
    for (int j = 0; j < 4; ++j) v[j] = q[64 * j];
}
__device__ __forceinline__ void st_row_f32(float* p, int lane, const f32x4 (&v)[4]) {
    GAS f32x4* q = (GAS f32x4*)p + lane;
#pragma unroll
    for (int j = 0; j < 4; ++j) q[64 * j] = v[j];
}
__device__ __forceinline__ void ld_row_bf16(const bf16* p, int lane, f32x4 (&v)[4]) {
    const GAS v2u* q = (const GAS v2u*)p + lane;
#pragma unroll
    for (int j = 0; j < 4; ++j) { const v2u w = q[64 * j]; v[j] = (f32x4){pg8::bf_lo(w.x), pg8::bf_hi(w.x), pg8::bf_lo(w.y), pg8::bf_hi(w.y)}; }
}
__device__ __forceinline__ void ld_row_f32_nt(const float* p, int lane, f32x4 (&v)[4]) {
    const GAS f32x4* q = (const GAS f32x4*)p + lane;
#pragma unroll
    for (int j = 0; j < 4; ++j) v[j] = __builtin_nontemporal_load(q + 64 * j);
}
__device__ __forceinline__ void st_row_f32_nt(float* p, int lane, const f32x4 (&v)[4]) {
    GAS f32x4* q = (GAS f32x4*)p + lane;
#pragma unroll
    for (int j = 0; j < 4; ++j) __builtin_nontemporal_store(v[j], q + 64 * j);
}
__device__ __forceinline__ void ld_raw_bf16_nt(const bf16* p, int lane, v2u (&v)[4]) {
    const GAS v2u* q = (const GAS v2u*)p + lane;
#pragma unroll
    for (int j = 0; j < 4; ++j) v[j] = __builtin_nontemporal_load(q + 64 * j);
}
__device__ __forceinline__ void ld_raw_bf16(const bf16* p, int lane, v2u (&v)[4]) {
    const GAS v2u* q = (const GAS v2u*)p + lane;
#pragma unroll
    for (int j = 0; j < 4; ++j) v[j] = q[64 * j];
}
__device__ __forceinline__ f32x4 cvt_raw_bf16(v2u w) { return (f32x4){pg8::bf_lo(w.x), pg8::bf_hi(w.x), pg8::bf_lo(w.y), pg8::bf_hi(w.y)}; }
__device__ __forceinline__ void st_row_bf16(bf16* p, int lane, const f32x4 (&v)[4]) {
    GAS v2u* q = (GAS v2u*)p + lane;
#pragma unroll
    for (int j = 0; j < 4; ++j) { v2u w; w.x = pk2(v[j].x, v[j].y); w.y = pk2(v[j].z, v[j].w); q[64 * j] = w; }
}
__device__ __forceinline__ float row_rms_scale(const f32x4 (&v)[4]) {
    float s = 0.f;
#pragma unroll
    for (int j = 0; j < 4; ++j) s += (v[j].x * v[j].x + v[j].y * v[j].y) + (v[j].z * v[j].z + v[j].w * v[j].w);
    return __builtin_amdgcn_rsqf(wave_sum(s) * (1.0f / D) + EPS);
}
__device__ __forceinline__ void norm_mod(const f32x4 (&x)[4], const float* g, const float* sc, const float* sh, int lane, f32x4 (&h)[4]) {
    const float rs = row_rms_scale(x);
    f32x4 gv[4], scv[4], shv[4]; ld_row_f32(g, lane, gv); ld_row_f32(sc, lane, scv); ld_row_f32(sh, lane, shv);
#pragma unroll
    for (int j = 0; j < 4; ++j) h[j] = (x[j] * rs) * gv[j] * (scv[j] + 1.0f) + shv[j];
}
__device__ __forceinline__ void resid_update(f32x4 (&x)[4], const f32x4 (&y)[4], const float* g, const float* gt, int lane) {
    const float rs = row_rms_scale(y);
    f32x4 gv[4], gtv[4]; ld_row_f32(g, lane, gv); ld_row_f32(gt, lane, gtv);
#pragma unroll
    for (int j = 0; j < 4; ++j) x[j] = x[j] + gtv[j] * ((y[j] * rs) * gv[j]);
}
__device__ __forceinline__ const float* modv(const Frame& F, int l, int row, int part) {
    const int r = row < NTOK ? (row >> 11) : 32;
    return (const float*)(F.ws + WS_MODV) + ((size_t)l * 33 + r) * 6144 + part * 1024;
}

__device__ __forceinline__ void p0_prologue(Frame& F, const Args& a) {
    const int gw = F.vcu * NWAVES + F.wave, NGW = F.G * NWAVES;
    if (F.vcu < 192) {
        LAS float* sl = (LAS float*)F.lds;
        for (int i = F.tid; i < 33 * 1024; i += NTHREADS) { const int r = i >> 10, k = i & 1023; const float cv = r < 32 ? a.in[I_C][r * 1024 + k] : a.in[I_CCTX][k]; sl[k * 33 + r] = silu_f(cv); }
        __syncthreads();
        const int col = F.vcu * 64 + F.lane, l = col / 6144, n = col % 6144, k0 = F.wave * 128;
        const float* w = a.in[I_WMOD] + ((size_t)l * 1024 + k0) * 6144 + n;
        float acc[33];
#pragma unroll
        for (int r = 0; r < 33; ++r) acc[r] = 0.f;
#pragma unroll 4
        for (int k = 0; k < 128; ++k) { const float wv = w[(size_t)k * 6144]; const LAS float* sr = sl + (k0 + k) * 33;
#pragma unroll
            for (int r = 0; r < 33; ++r) acc[r] += sr[r] * wv; }
        __syncthreads();
#pragma unroll
        for (int r = 0; r < 33; ++r) sl[(F.wave * 33 + r) * 64 + F.lane] = acc[r];
        __syncthreads();
        const float* bmod = a.in[I_BMOD]; float* mo = (float*)(F.ws + WS_MODV);
        for (int o = F.tid; o < 33 * 64; o += NTHREADS) { const int r = o >> 6, j = o & 63; float s = 0.f;
#pragma unroll
            for (int wv = 0; wv < 8; ++wv) s += sl[(wv * 33 + r) * 64 + j];
            const int cc = F.vcu * 64 + j, ll = cc / 6144, nn = cc % 6144; mo[((size_t)ll * 33 + r) * 6144 + nn] = s + bmod[ll * 6144 + nn]; }
        __syncthreads();
    }
    if (F.vcu == 200) {
        float* rp = (float*)(F.ws + WS_ROPE);
        for (int i = F.tid; i < 1024; i += NTHREADS) { const int pos = i >> 4, k = i & 15; const float inv = powf(10000.0f, -(float)k / 16.0f); const float ang = (float)pos * inv; rp[i] = cosf(ang); rp[1024 + i] = sinf(ang); }
    }
    for (int it = F.vcu; it < 512; it += F.G) {
        const int lv = it >> 8, l = lv ? 0 : ((it >> 7) & 1), L = lv ? LC : SEQ, pos0 = lv ? (it & 255) : 16 * (it & 127), npos = lv ? 1 : 16;
        LAS float* z = (LAS float*)F.lds; LAS float* h1 = z + 16 * 33; LAS float* h2 = h1 + 16 * 64;
        __syncthreads();
        for (int i = F.tid; i < 16 * 33; i += NTHREADS) { const int p = i / 33, k = i % 33; const int pos = pos0 + p; float v;
            const float om = 6.283185307179586f * (float)pos / (float)L;
            if (k == 0) v = (float)pos / (float)(L - 1);
            else { const int m = (k - 1) & 15; const float f = 1e-4f + (15.0f - 1e-4f) * (float)m / 15.0f; v = (k <= 16) ? cosf(f * om) : -sinf(f * om); }
            z[i] = v; }
        __syncthreads();
        const float* w1 = a.in[I_HW1] + l * 33 * 64; const float* b1 = a.in[I_HB1] + l * 64; const float* w2 = a.in[I_HW2] + l * 64 * 64; const float* b2 = a.in[I_HB2] + l * 64;
        const float* fr = a.in[I_HFREQ] + l * 64; const float* w3 = a.in[I_HW3] + (size_t)l * 64 * 2048;
        for (int o = F.tid; o < 1024; o += NTHREADS) { const int p = o >> 6, j = o & 63; float s = b1[j];
            for (int k = 0; k < 33; ++k) s += z[p * 33 + k] * w1[k * 64 + j];
            h1[o] = sinf(fr[j] * s); }
        __syncthreads();
        for (int o = F.tid; o < 1024; o += NTHREADS) { const int p = o >> 6, j = o & 63; float s = b2[j];
            for (int k = 0; k < 64; ++k) s += h1[p * 64 + k] * w2[k * 64 + j];
            h2[o] = sinf(fr[j] * s); }
        __syncthreads();
        float* raw = (float*)(F.ws + BIG_RAW) + (size_t)l * (2048 * (SEQ + LC)) + (lv ? (size_t)2048 * SEQ : 0);
        {
            const int col0 = 4 * F.tid;
            float acc[4][16];
#pragma unroll
            for (int c4 = 0; c4 < 4; ++c4)
#pragma unroll
                for (int p = 0; p < 16; ++p) acc[c4][p] = 0.f;
#pragma unroll 4
            for (int k = 0; k < 64; ++k) { const f32x4 wv = *(const f32x4*)(w3 + k * 2048 + col0);
#pragma unroll
                for (int p = 0; p < 16; ++p) { const float hv = h2[p * 64 + k]; acc[0][p] += hv * wv.x; acc[1][p] += hv * wv.y; acc[2][p] += hv * wv.z; acc[3][p] += hv * wv.w; } }
            const float da = -3.0701134573253945f, db = -15.350567286626973f;
#pragma unroll
            for (int c4 = 0; c4 < 4; ++c4) { const int col = col0 + c4, cch = col & 511;
                const float delta = fabsf(da + (db - da) * (float)cch / 511.0f);
#pragma unroll
                for (int p = 0; p < 16; ++p) if (p < npos) { const float t = (float)(pos0 + p) / (float)(L - 1); raw[(size_t)col * L + pos0 + p] = acc[c4][p] * __expf(-t * delta); } }
        }
    }
    __syncthreads();
    LAS float* scr = (LAS float*)(F.lds + F.wave * 16384);
    constexpr int PER_LAYER = 16 * 216 + 16 * 48 + 3 * 256 + 512, NITEMS = 2 * PER_LAYER + 3 * 1408;
    for (int it = gw; it < NITEMS; it += NGW) {
        int r = it;
        bool dn = false;
#pragma unroll 1
        for (int l = 0; l < 2; ++l) {
            if (!dn) dn = conv_job_f8(r, a.in[I_WIN] + (size_t)l * D * INC, D, INC, F.ws + W_IN + (size_t)l * INC * D, D, 0, 0, W13_SCALE, scr, F.lane);
            if (!dn) { const int items = 16 * 48;
                if (r < items) { const int kb = r / 48, nb = r % 48; transpose_item(a.in[I_WIN] + (size_t)l * D * INC + QKVC, INC, (bf16*)(F.ws + W_CB) + (size_t)l * CINC * D, D, 64 * kb, 32 * nb, 32 * nb, scr, F.lane); dn = true; } else r -= items; }
#pragma unroll 1
            for (int br = 0; br < 3; ++br)
                if (!dn) dn = conv_job(r, a.in[I_WBR] + (size_t)(l * 3 + br) * 512 * D, 512, D, (bf16*)(F.ws + W_BR) + (size_t)(l * 3 + br) * D * 512, 512, 0, 0, 0, scr, F.lane);
            if (!dn) dn = conv_job(r, a.in[I_WOUT] + (size_t)l * D * D, D, D, (bf16*)(F.ws + W_OUT) + (size_t)l * D * D, D, 0, 0, 0, scr, F.lane);
        }
        if (!dn) dn = conv_job(r, a.in[I_FW1], D, DFF, (bf16*)(F.ws + W_F13), D, 0, 1, 0, scr, F.lane);
        if (!dn) dn = conv_job(r, a.in[I_FW3], D, DFF, (bf16*)(F.ws + W_F13), D, 0, 1, 1, scr, F.lane);
        if (!dn) dn = conv_job(r, a.in[I_FW2], DFF, D, (bf16*)(F.ws + W_F2), DFF, 0, 0, 0, scr, F.lane);
    }
}

__device__ __forceinline__ void p1_phase(Frame& F, const Args& a) {
    const int gw = F.vcu * NWAVES + F.wave, NGW = F.G * NWAVES;
    for (int u = gw; u < 2 * 2 * 1024; u += NGW) {
        const int l = u >> 11, lv = (u >> 10) & 1, o = (u >> 9) & 1, c = u & 511, L = lv ? LC : SEQ;
        if (l == 1 && lv == 1) continue;
        const float* raw = (const float*)(F.ws + BIG_RAW) + (size_t)l * (2048 * (SEQ + LC)) + (lv ? (size_t)2048 * SEQ : 0);
        const float* rf = raw + (size_t)(o * 512 + c) * L; const float* rb = raw + (size_t)(1024 + o * 512 + c) * L;
        float sf = 0.f, sb = 0.f;
        for (int t = F.lane; t < L; t += 64) { const float x = rf[t], y = rb[t]; sf += x * x; sb += y * y; }
        const float nf = 1.0f / sqrtf(wave_sum(sf) + EPS), nb = 1.0f / sqrtf(wave_sum(sb) + EPS);
        bf16* g = lv ? (bf16*)(F.ws + WS_GFC) + ((size_t)(l * 2 + o) * 512 + c) * (2 * LC) : (bf16*)(F.ws + WS_GF) + ((size_t)(l * 2 + o) * 512 + c) * (2 * SEQ);
        for (int i = F.lane; i < 2 * L; i += 64) { const int d = i - L; float v;
            if (i == 0) v = 0.f; else if (d > 0) v = rf[d] * nf; else if (d < 0) v = rb[-d] * nb; else v = rf[0] * nf + rb[0] * nb;
            g[i] = (bf16)f2bf(v); }
    }
}

constexpr float ATT_THR = 8.0f;
constexpr int ATT_KP = 144, ATT_VP = 136;
constexpr int ATT_K_OFF = 0, ATT_V_OFF = 64 * ATT_KP, ATT_BUF = 17920, ATT_RPB_OFF = 36864;
constexpr int ATT_T0_BYTES = 15 * 128 * 4, ATT_E_OFF = ATT_RPB_OFF + ATT_T0_BYTES, ATT_TBL_FLOATS = 15 * 128 + 15 * 15 * 64;
__device__ __forceinline__ int crow(int reg, int h) { return (reg & 3) + 8 * (reg >> 2) + 4 * h; }
__device__ __forceinline__ int rs_of(int r) { const int v = r - 4; return v < 0 ? 0 : (v > 24 ? 24 : v); }
__device__ __forceinline__ unsigned cvtpk(float lo, float hi) { return pk2(lo, hi); }

template <int MODE, int SUB>
__device__ __forceinline__ void att_tile(LAS unsigned char* lds, int boff, const bf16x8 (&qf)[4], f32x16& negm, f32x16& O0, f32x16& O1, float& m_run, float& l_run,
                                         bool is_local, bool edge_mask, int kbase, int qt, int kr, int gr, int tb_base, int tb_pitch, int r, int h) {
#define A0(i) (SUB != 2 || (i) >= 12)
#define A1(i) (SUB != 1 || (i) < 4)
    f32x16 s0 = negm, s1 = negm;
#pragma unroll
    for (int s = 0; s < 4; ++s) {
        const bf16x8 k0 = *(const LAS bf16x8*)(lds + boff + ATT_K_OFF + r * ATT_KP + (16 * s + 8 * h) * 2);
        const bf16x8 k1 = *(const LAS bf16x8*)(lds + boff + ATT_K_OFF + (32 + r) * ATT_KP + (16 * s + 8 * h) * 2);
        s0 = MFMA32(k0, qf[s], s0); s1 = MFMA32(k1, qf[s], s1);
    }
    if (MODE == 0 && edge_mask) {
#pragma unroll
        for (int i = 0; i < 16; ++i) { const int j0 = kbase + crow(i, h), d0 = qt - j0, d1 = d0 - 32;
            if (d0 > 128 || d0 < -128) s0[i] = -1e30f;
            if (d1 > 128 || d1 < -128) s1[i] = -1e30f; }
    }
    if (MODE == 1 && is_local) {
        const LAS float* tb = (const LAS float*)(lds + tb_base + (kr - gr + 7) * tb_pitch);
        float b0[16], b1[16];
#pragma unroll
        for (int i = 0; i < 16; ++i) { const int c = (i & 3) + 8 * (i >> 2); b0[i] = tb[c]; b1[i] = tb[c + 32]; }
#pragma unroll
        for (int i = 0; i < 16; ++i) { s0[i] += b0[i]; s1[i] += b1[i]; }
    }
    float mx = -1e30f;
#pragma unroll
    for (int i = 0; i < 16; ++i) { if (A0(i)) mx = fmaxf(mx, s0[i]); if (A1(i)) mx = fmaxf(mx, s1[i]); }
    mx = fmaxf(mx, __shfl_xor(mx, 32));
    if (!__all(mx <= ATT_THR)) {
        const float delta = fmaxf(mx, 0.f), alpha = __builtin_amdgcn_exp2f(-delta);
        m_run += delta; l_run *= alpha;
#pragma unroll
        for (int i = 0; i < 16; ++i) { O0[i] *= alpha; O1[i] *= alpha; s0[i] -= delta; s1[i] -= delta; negm[i] = -m_run; }
    }
    float ls = 0.f;
#pragma unroll
    for (int i = 0; i < 16; ++i) { if (A0(i)) { s0[i] = __builtin_amdgcn_exp2f(s0[i]); ls += s0[i]; } else s0[i] = 0.f;
                                   if (A1(i)) { s1[i] = __builtin_amdgcn_exp2f(s1[i]); ls += s1[i]; } else s1[i] = 0.f; }
    l_run += ls;
    bf16x8 pf[2][2];
    { v4u t;
      t.x = cvtpk(s0[0], s0[1]); t.y = cvtpk(s0[2], s0[3]); t.z = cvtpk(s0[4], s0[5]); t.w = cvtpk(s0[6], s0[7]); pf[0][0] = __builtin_bit_cast(bf16x8, t);
      t.x = cvtpk(s0[8], s0[9]); t.y = cvtpk(s0[10], s0[11]); t.z = cvtpk(s0[12], s0[13]); t.w = cvtpk(s0[14], s0[15]); pf[0][1] = __builtin_bit_cast(bf16x8, t);
      t.x = cvtpk(s1[0], s1[1]); t.y = cvtpk(s1[2], s1[3]); t.z = cvtpk(s1[4], s1[5]); t.w = cvtpk(s1[6], s1[7]); pf[1][0] = __builtin_bit_cast(bf16x8, t);
      t.x = cvtpk(s1[8], s1[9]); t.y = cvtpk(s1[10], s1[11]); t.z = cvtpk(s1[12], s1[13]); t.w = cvtpk(s1[14], s1[15]); pf[1][1] = __builtin_bit_cast(bf16x8, t); }
#pragma unroll
    for (int i = 0; i < 2; ++i)
#pragma unroll
        for (int sp = 0; sp < 2; ++sp) {
            if ((SUB == 1 && i == 1 && sp == 1) || (SUB == 2 && i == 0 && sp == 0)) continue;
            const int koff = (32 * i + 16 * sp + 4 * h) * 2;
            const v2u a0 = *(const LAS v2u*)(lds + boff + ATT_V_OFF + r * ATT_VP + koff), a1 = *(const LAS v2u*)(lds + boff + ATT_V_OFF + r * ATT_VP + koff + 16);
            const v2u c0 = *(const LAS v2u*)(lds + boff + ATT_V_OFF + (32 + r) * ATT_VP + koff), c1 = *(const LAS v2u*)(lds + boff + ATT_V_OFF + (32 + r) * ATT_VP + koff + 16);
            const v4u va = (v4u){a0.x, a0.y, a1.x, a1.y}, vc = (v4u){c0.x, c0.y, c1.x, c1.y};
            O0 = MFMA32(__builtin_bit_cast(bf16x8, va), pf[i][sp], O0);
            O1 = MFMA32(__builtin_bit_cast(bf16x8, vc), pf[i][sp], O1);
        }
#undef A0
#undef A1
}

struct AttPre { v4u k, v; int valid; };
template <int MODE>
__device__ __forceinline__ void att_start(int u, int w, int r, int& qrow, int& qcol, int& kcol, int& vcol, int& trow0) {
    int b, head, kvh, q0 = 0, R = 0;
    if (MODE == 0) { b = u >> 6; kvh = (u >> 5) & 1; q0 = (u & 31) * 64; head = 4 * kvh + (w >> 1); }
    else if (MODE == 1) { b = u >> 6; head = (u >> 3) & 7; kvh = head; R = u & 7; }
    else if (MODE == 2) { b = u >> 3; kvh = (u >> 2) & 1; q0 = (u & 3) * 64; head = 4 * kvh + (w >> 1); }
    else { b = u >> 3; head = u & 7; kvh = head; }
    if (MODE == 0) qrow = b * SEQ + q0 + 32 * (w & 1) + r;
    else if (MODE == 1) qrow = b * SEQ + (4 * R + (w >> 1)) * 64 + 32 * (w & 1) + r;
    else if (MODE == 2) qrow = NTOK + b * LC + q0 + 32 * (w & 1) + r;
    else qrow = NTOK + b * LC + 32 * w + r;
    qcol = (MODE == 0 || MODE == 2) ? 1280 + head * 64 : 1792 + head * 64;
    kcol = (MODE == 0 || MODE == 2) ? kvh * 64 : 256 + head * 64;
    vcol = (MODE == 0 || MODE == 2) ? 128 + kvh * 64 : 768 + head * 64;
    if (MODE == 0) { const int lo = q0 < 128 ? (128 - q0) / 64 : 0; trow0 = b * SEQ + q0 - 128 + 64 * lo; }
    else if (MODE == 1) trow0 = b * SEQ + rs_of(4 * R) * 64;
    else trow0 = NTOK + b * LC;
}
template <int MODE>
__device__ __forceinline__ void attn_unit(Frame& F, int u, int u_next, const bf16* __restrict__ QKV, bf16* __restrict__ Yo, const float* sink, const float* rpb, AttPre& P, int& tbl_head, int var = 0) {
    const int w = F.wave, lane = F.lane, r = lane & 31, h = lane >> 5;
    LAS unsigned char* lds = F.lds;
    int b, head, kvh, q0 = 0, R = 0;
    if (MODE == 0) { b = u >> 6; kvh = (u >> 5) & 1; q0 = (u & 31) * 64; head = 4 * kvh + (w >> 1); }
    else if (MODE == 1) { b = u >> 6; head = (u >> 3) & 7; kvh = head; R = u & 7; }
    else if (MODE == 2) { b = u >> 3; kvh = (u >> 2) & 1; q0 = (u & 3) * 64; head = 4 * kvh + (w >> 1); }
    else { b = u >> 3; head = u & 7; kvh = head; }
    int qt, qrow, gr = 0, qc = 0;
    if (MODE == 0) { qt = q0 + 32 * (w & 1) + r; qrow = b * SEQ + qt; }
    else if (MODE == 1) { gr = 4 * R + (w >> 1); qc = 32 * (w & 1) + r; qt = gr * 64 + qc; qrow = b * SEQ + qt; }
    else if (MODE == 2) { qt = q0 + 32 * (w & 1) + r; qrow = NTOK + b * LC + qt; }
    else { qt = 32 * w + r; qrow = NTOK + b * LC + qt; }
    const int qcol = (MODE == 0 || MODE == 2) ? 1280 + head * 64 : 1792 + head * 64;
    const int kcol = (MODE == 0 || MODE == 2) ? kvh * 64 : 256 + head * 64;
    const int vcol = (MODE == 0 || MODE == 2) ? 128 + kvh * 64 : 768 + head * 64;
    bf16x8 qf[4];
#pragma unroll
    for (int s = 0; s < 4; ++s) qf[s] = *(const bf16x8*)(QKV + (size_t)qrow * QKVC + qcol + 16 * s + 8 * h);
    f32x16 O0, O1;
#pragma unroll
    for (int i = 0; i < 16; ++i) { O0[i] = 0.f; O1[i] = 0.f; }
    float m_run, l_run;
    if (MODE == 0 || MODE == 2) { m_run = sink[head] * LOG2E; l_run = (h == 0) ? 1.0f : 0.0f; } else { m_run = 0.f; l_run = 0.f; }
    f32x16 negm;
#pragma unroll
    for (int i = 0; i < 16; ++i) negm[i] = -m_run;
    int lo = 0, ntl = 0, kr_lo = 0;
    if (MODE == 0) { lo = q0 < 128 ? (128 - q0) / 64 : 0; const int hi = (SEQ - q0 + 128) / 64 < 5 ? (SEQ - q0 + 128) / 64 : 5; ntl = hi - lo; }
    if (MODE == 1) { kr_lo = rs_of(4 * R); ntl = rs_of(4 * R + 3) + 8 - kr_lo; }
    const int my_rs = rs_of(gr), my_cs = (qc - 8) < 0 ? 0 : ((qc - 8) > 48 ? 48 : (qc - 8));
    const int ntiles = ntl + 4;
    int tb_base = 0, tb_pitch = 0;
    if (MODE == 1) { const bool edge = qc < 8 || qc > 56; const int ev = qc < 8 ? qc : qc - 49;
        tb_base = edge ? ATT_E_OFF + ev * (15 * 256) + 16 * h : ATT_RPB_OFF + 4 * (63 - qc + 4 * h); tb_pitch = edge ? 256 : 512; }
    const int skey = F.tid >> 3, sch = F.tid & 7, vkey = F.tid & 63, vch = F.tid >> 6;
#define ATT_TROW(tt) ((tt) < ntl ? (MODE == 0 ? b * SEQ + q0 - 128 + 64 * (lo + (tt)) : b * SEQ + (kr_lo + (tt)) * 64) : NTOK + b * LC + 64 * ((tt) - ntl))
#define ATT_LOAD(tt) do { const int tr_ = ATT_TROW(tt); kreg = *(const v4u*)(QKV + (size_t)(tr_ + skey) * QKVC + kcol + 8 * sch); vreg = *(const v4u*)(QKV + (size_t)(tr_ + vkey) * QKVC + vcol + 8 * vch); } while (0)
#define ATT_STORE(bufoff) do { *(LAS v4u*)(lds + (bufoff) + ATT_K_OFF + skey * ATT_KP + sch * 16) = kreg; \
        LAS unsigned short* vt_ = (LAS unsigned short*)(lds + (bufoff) + ATT_V_OFF + (8 * vch) * ATT_VP + vkey * 2); \
        vt_[0 * (ATT_VP / 2)] = (unsigned short)(vreg.x & 0xffff); vt_[1 * (ATT_VP / 2)] = (unsigned short)(vreg.x >> 16); vt_[2 * (ATT_VP / 2)] = (unsigned short)(vreg.y & 0xffff); vt_[3 * (ATT_VP / 2)] = (unsigned short)(vreg.y >> 16); \
        vt_[4 * (ATT_VP / 2)] = (unsigned short)(vreg.z & 0xffff); vt_[5 * (ATT_VP / 2)] = (unsigned short)(vreg.z >> 16); vt_[6 * (ATT_VP / 2)] = (unsigned short)(vreg.w & 0xffff); vt_[7 * (ATT_VP / 2)] = (unsigned short)(vreg.w >> 16); } while (0)
    v4u& kreg = P.k; v4u& vreg = P.v;
    if (!P.valid) ATT_LOAD(0);
    P.valid = 0;
    __syncthreads();
    if (MODE == 1 && head != tbl_head) {
        tbl_head = head;
        LAS float* tb = (LAS float*)(lds + ATT_RPB_OFF);
        for (int i = F.tid; i < ATT_TBL_FLOATS; i += NTHREADS) {
            int dr, off; bool ok;
            if (i < 15 * 128) { dr = i >> 7; off = (i & 127) - 63; ok = off >= -8 && off <= 7; }
            else { const int j = i - 15 * 128, ev = j / (15 * 64), dr_ = (j >> 6) % 15, kc = j & 63, q = ev < 8 ? ev : ev + 49; dr = dr_; off = kc - q; ok = ev < 8 ? kc < 16 : kc >= 48; }
            tb[i] = ok ? rpb[(head * 15 + dr) * 31 + off + 15] * LOG2E : -1e30f;
        }
    }
    ATT_STORE(0);
    __syncthreads();
#pragma unroll 1
    for (int tt = 0; tt < ntiles; ++tt) {
        const bool is_local = tt < ntl;
        const int kbase = q0 - 128 + 64 * (lo + tt), kr = kr_lo + tt;
        const int boff = (tt & 1) * ATT_BUF;
        if (tt + 1 < ntiles) { if (!(var & 2)) ATT_LOAD(tt + 1); }
        else if (u_next >= 0) {
            int nq, nqc, nkc, nvc, ntr; att_start<MODE>(u_next, w, r, nq, nqc, nkc, nvc, ntr);
            kreg = *(const v4u*)(QKV + (size_t)(ntr + skey) * QKVC + nkc + 8 * sch); vreg = *(const v4u*)(QKV + (size_t)(ntr + vkey) * QKVC + nvc + 8 * vch);
            P.valid = 1;
        }
        if (!(var & 1) && !(MODE == 1 && is_local && !(kr >= my_rs && kr < my_rs + 8))) {
            att_tile<MODE, 0>(lds, boff, qf, negm, O0, O1, m_run, l_run, is_local, MODE == 0 && is_local && (lo + tt == 0 || lo + tt == 4), kbase, qt, kr, gr, tb_base, tb_pitch, r, h);
        }
        if (tt + 1 < ntiles && !(var & 2)) ATT_STORE(((tt + 1) & 1) * ATT_BUF);
        __syncthreads();
    }
#undef ATT_TROW
#undef ATT_LOAD
#undef ATT_STORE
    const float lt = l_run + __shfl_xor(l_run, 32), inv = 1.0f / lt;
    LAS unsigned char* ot = lds + w * 4608;
#pragma unroll
    for (int g = 0; g < 4; ++g) {
        v2u o; o.x = cvtpk(O0[4 * g] * inv, O0[4 * g + 1] * inv); o.y = cvtpk(O0[4 * g + 2] * inv, O0[4 * g + 3] * inv);
        *(LAS v2u*)(ot + r * 144 + (8 * g + 4 * h) * 2) = o;
        o.x = cvtpk(O1[4 * g] * inv, O1[4 * g + 1] * inv); o.y = cvtpk(O1[4 * g + 2] * inv, O1[4 * g + 3] * inv);
        *(LAS v2u*)(ot + r * 144 + (32 + 8 * g + 4 * h) * 2) = o;
    }
    LDS_WAIT(); asm volatile("" ::: "memory");
    bf16* op = Yo + (size_t)(qrow - r) * 512 + head * 64;
#pragma unroll
    for (int k = 0; k < 4; ++k) { const int p = lane + 64 * k, row = p >> 3, chk = p & 7;
        *(GAS v4u*)(op + (size_t)row * 512 + 8 * chk) = *(const LAS v4u*)(ot + row * 144 + chk * 16); }
    LDS_WAIT(); asm volatile("" ::: "memory");
}

template <int N>
__device__ __forceinline__ void conv_taps(const bf16* src, int t, int L, float w0, float w1, float w2, float bs, float (&out)[N]) {
    float x[N + 2];
    if constexpr (N == 8) { const v4u q = *(const v4u*)(src + t); x[1] = pg8::bf_lo(q.x); x[2] = pg8::bf_hi(q.x); x[3] = pg8::bf_lo(q.y); x[4] = pg8::bf_hi(q.y); x[5] = pg8::bf_lo(q.z); x[6] = pg8::bf_hi(q.z); x[7] = pg8::bf_lo(q.w); x[8] = pg8::bf_hi(q.w); }
    else { const v2u q = *(const v2u*)(src + t); x[1] = pg8::bf_lo(q.x); x[2] = pg8::bf_hi(q.x); x[3] = pg8::bf_lo(q.y); x[4] = pg8::bf_hi(q.y); }
    x[0] = t > 0 ? bf2f(src[t - 1]) : 0.f;
    x[N + 1] = (t + N < L) ? bf2f(src[t + N]) : 0.f;
#pragma unroll
    for (int e = 0; e < N; ++e) out[e] = w0 * x[e] + w1 * x[e + 1] + w2 * x[e + 2] + bs;
}

template <int L, int VAR = 0>
__device__ __forceinline__ void hyena_unit(Frame& F, int c, const bf16* CINT, bf16* DST, const bf16* Gf, const float* convw, const float* convb, const float* hybias) {
    constexpr int UP = (L + 8) * 2, TPW = L / 256, CPB = L / 8;
    LAS unsigned char* U = F.lds; LAS unsigned short* Gs = (LAS unsigned short*)(F.lds + 32 * UP);
    const int lane = F.lane, r = lane & 31, h = lane >> 5, T0 = F.wave * TPW * 32;
    const bf16* vsrc = CINT + (size_t)c * NROW + (L == SEQ ? 0 : NTOK);
    bf16* ydst = DST + (size_t)c * NROW + (L == SEQ ? 0 : NTOK);
    __syncthreads();
    if (!(VAR & 8)) {
        const float w0 = convw[c], w1 = convw[CINC + c], w2 = convw[2 * CINC + c], bs = convb[c];
        static_assert(CPB % 32 == 0, "a wave's 64 lanes hold consecutive chunks of at most two rows, split at lane 32");
#pragma unroll 4
        for (int q = F.tid; q < 32 * CPB; q += NTHREADS) { const int b = q / CPB, t = (q % CPB) * 8;
            const bf16* src = vsrc + (size_t)b * L;
            const v4u ch = *(const v4u*)(src + t);
            float x[10];
            x[1] = pg8::bf_lo(ch.x); x[2] = pg8::bf_hi(ch.x); x[3] = pg8::bf_lo(ch.y); x[4] = pg8::bf_hi(ch.y); x[5] = pg8::bf_lo(ch.z); x[6] = pg8::bf_hi(ch.z); x[7] = pg8::bf_lo(ch.w); x[8] = pg8::bf_hi(ch.w);
            const float up = __shfl_up(x[8], 1), dn = __shfl_down(x[1], 1);
            const int lr = lane & 31;
            x[0] = (lr == 0) ? (t > 0 ? bf2f(src[t - 1]) : 0.f) : up;
            x[9] = (lr == 31) ? (t + 8 < L ? bf2f(src[t + 8]) : 0.f) : dn;
            float o[8];
#pragma unroll
            for (int e = 0; e < 8; ++e) o[e] = w0 * x[e] + w1 * x[e + 1] + w2 * x[e + 2] + bs;
            v4u pk; pk.x = pk2(o[0], o[1]); pk.y = pk2(o[2], o[3]); pk.z = pk2(o[4], o[5]); pk.w = pk2(o[6], o[7]);
            *(LAS v4u*)(U + b * UP + t * 2) = pk; }
    }
#pragma unroll 1
    for (int ord = 0; ord < 2; ++ord) {
        {
            const v4u* gsrc = (const v4u*)(Gf + ((size_t)ord * 512 + c) * (2 * L));
            for (int q = F.tid; q < L / 4; q += NTHREADS) *(LAS v4u*)((LAS unsigned char*)Gs + q * 16) = gsrc[q];
        }
        __syncthreads();
        f32x16 acc[TPW];
#pragma unroll
        for (int i = 0; i < TPW; ++i)
#pragma unroll
            for (int e = 0; e < 16; ++e) acc[i][e] = 0.f;
        const int gbase = T0 + r - 8 * h + L;
#define HY_AF(dst, sgi, ti) do { const int gi_ = gbase + 32 * (ti) - 16 * (sgi); _Pragma("unroll") for (int j_ = 0; j_ < 8; ++j_) dst[j_] = (short)Gs[gi_ - j_]; } while (0)
#define HY_BF(sgi) (*(const LAS bf16x8*)(U + r * UP + (16 * (sgi) + 8 * h) * 2))
        if constexpr (TPW == 8 && !(VAR & 2)) {
            constexpr int NS = L / 16;
#pragma unroll 1
            for (int p = 0; p < 2; ++p) {
                bf16x8 W[8];
#pragma unroll
                for (int i = 1; i < 8; ++i) HY_AF(W[i], p, i);
                bf16x8 nf, nb; HY_AF(nf, p, 0); nb = HY_BF(p);
#pragma unroll 1
                for (int sb = p; sb < NS; sb += 16) {
#pragma unroll
                    for (int k = 0; k < 8; ++k) {
                        const int sg = sb + 2 * k; const bf16x8 cb = nb; W[(8 - k) & 7] = nf;
                        const int sn = sg + 2 < NS ? sg + 2 : sg;
                        HY_AF(nf, sn, 0); nb = HY_BF(sn);
#pragma unroll
                        for (int i = 0; i < 8; ++i) acc[i] = MFMA32(W[(i - k) & 7], cb, acc[i]);
                    }
                }
            }
        } else if constexpr (!(VAR & 2)) {
#pragma unroll 1
            for (int sg = 0; sg < L / 16; ++sg) { bf16x8 af; HY_AF(af, sg, 0); acc[0] = MFMA32(af, HY_BF(sg), acc[0]); }
        }
#undef HY_AF
#undef HY_BF
        const int comp = 1 + ord;
        const float w0 = convw[comp * 512 + c], w1 = convw[CINC + comp * 512 + c], w2 = convw[2 * CINC + comp * 512 + c], bs = convb[comp * 512 + c], hb = hybias[ord * 512 + c];
        const bf16* gsrc = CINT + ((size_t)comp * 512 + c) * NROW + (L == SEQ ? 0 : NTOK) + (size_t)r * L;
        __syncthreads();
        {
            constexpr int NCH = TPW * 4, BS = NCH < 8 ? NCH : 8;
#pragma unroll
            for (int bt = 0; bt < NCH / BS; ++bt) {
                const int tb = T0 + 8 * BS * bt;
                v4u ch[BS];
#pragma unroll
                for (int k = 0; k < BS; ++k) { if constexpr (VAR & 4) ch[k] = (v4u){0u, 0u, 0u, 0u}; else ch[k] = *(const v4u*)(gsrc + tb + 8 * k); }
                float xl = 0.f, xr = 0.f;
                if constexpr (!(VAR & 4)) { if (tb > 0) xl = bf2f(gsrc[tb - 1]); if (tb + 8 * BS < L) xr = bf2f(gsrc[tb + 8 * BS]); }
#pragma unroll
                for (int k = 0; k < BS; ++k) {
                    const int kk = BS * bt + k, i = kk >> 2, g = kk & 3, t = T0 + 32 * i + 8 * g + 4 * h;
                    float xs[10];
                    xs[0] = k == 0 ? xl : pg8::bf_hi(ch[k > 0 ? k - 1 : 0].w);
                    xs[1] = pg8::bf_lo(ch[k].x); xs[2] = pg8::bf_hi(ch[k].x); xs[3] = pg8::bf_lo(ch[k].y); xs[4] = pg8::bf_hi(ch[k].y); xs[5] = pg8::bf_lo(ch[k].z); xs[6] = pg8::bf_hi(ch[k].z); xs[7] = pg8::bf_lo(ch[k].w); xs[8] = pg8::bf_hi(ch[k].w);
                    xs[9] = k == BS - 1 ? xr : pg8::bf_lo(ch[k < BS - 1 ? k + 1 : k].x);
                    float gt[4];
#pragma unroll
                    for (int e2 = 0; e2 < 4; ++e2) { const float lo = w0 * xs[e2] + w1 * xs[e2 + 1] + w2 * xs[e2 + 2] + bs, hi = w0 * xs[e2 + 4] + w1 * xs[e2 + 5] + w2 * xs[e2 + 6] + bs; gt[e2] = h ? hi : lo; }
                    LAS v2u* up = (LAS v2u*)(U + r * UP + t * 2);
                    const v2u uu = *up;
                    const float u0 = pg8::bf_lo(uu.x), u1 = pg8::bf_hi(uu.x), u2 = pg8::bf_lo(uu.y), u3 = pg8::bf_hi(uu.y);
                    const float z0 = gt[0] * (acc[i][4 * g] + hb * u0), z1 = gt[1] * (acc[i][4 * g + 1] + hb * u1), z2 = gt[2] * (acc[i][4 * g + 2] + hb * u2), z3 = gt[3] * (acc[i][4 * g + 3] + hb * u3);
                    v2u zz; zz.x = pk2(z0, z1); zz.y = pk2(z2, z3);
                    *up = zz;
                }
                asm volatile("" ::: "memory");
            }
        }
        __syncthreads();
    }
    if (!(VAR & 1)) for (int q = F.tid; q < 32 * CPB; q += NTHREADS) { const int b = q / CPB, t = (q % CPB) * 8; *(GAS v4u*)(ydst + (size_t)b * L + t) = *(const LAS v4u*)(U + b * UP + t * 2); }
}

__device__ __forceinline__ void transpose_yc(Frame& F, const bf16* CT, bf16* Yc, int nrows) {
    const int gw = F.vcu * NWAVES + F.wave, NGW = F.G * NWAVES, lane = F.lane;
    LAS unsigned short* T = (LAS unsigned short*)(F.lds + F.wave * 16384);
    const int ntr = nrows / 64;
    for (int it = gw; it < 8 * ntr; it += NGW) {
        const int cb = it / ntr, rb = it % ntr, c0 = cb * 64, r0 = rb * 64;
#pragma unroll
        for (int k = 0; k < 8; ++k) { const int p = lane + 64 * k, cc = p >> 3, ch = p & 7;
            const v4u q = *(const v4u*)(CT + (size_t)(c0 + cc) * NROW + r0 + 8 * ch);
            LAS unsigned* d = (LAS unsigned*)(T + cc * 66 + 8 * ch); d[0] = q.x; d[1] = q.y; d[2] = q.z; d[3] = q.w; }
        LDS_WAIT(); asm volatile("" ::: "memory");
#pragma unroll
        for (int k = 0; k < 8; ++k) { const int p = lane + 64 * k, rr = p >> 3, ch = p & 7;
            unsigned short e[8];
#pragma unroll
            for (int j = 0; j < 8; ++j) e[j] = T[(8 * ch + j) * 66 + rr];
            v4u o; o.x = e[0] | ((unsigned)e[1] << 16); o.y = e[2] | ((unsigned)e[3] << 16); o.z = e[4] | ((unsigned)e[5] << 16); o.w = e[6] | ((unsigned)e[7] << 16);
            *(GAS v4u*)(Yc + (size_t)(r0 + rr) * 512 + c0 + 8 * ch) = o; }
        LDS_WAIT(); asm volatile("" ::: "memory");
    }
}

struct RowVecs { f32x4 gA[4], gt[4], gB[4], sc1[4], sh[4]; };
__device__ __forceinline__ float ssq16(const f32x4 (&v)[4]) { float s = 0.f;
#pragma unroll
    for (int j = 0; j < 4; ++j) s += (v[j].x * v[j].x + v[j].y * v[j].y) + (v[j].z * v[j].z + v[j].w * v[j].w);
    return s; }
__device__ __forceinline__ void ld_mod(const Frame& F, int l, int b, int part, int lane, f32x4 (&v)[4], float add) {
    ld_row_f32((const float*)(F.ws + WS_MODV) + ((size_t)l * 33 + b) * 6144 + part * 1024, lane, v);
#pragma unroll
    for (int j = 0; j < 4; ++j) v[j] = v[j] + add;
}
__device__ __forceinline__ void row_pair(const RowVecs& V, const f32x4 (&y0)[4], const f32x4 (&y1)[4], f32x4 (&x0)[4], f32x4 (&x1)[4], bool has_y, bool has_next, f32x4 (&h0)[4], f32x4 (&h1)[4]) {
    if (has_y) {
        float a0 = ssq16(y0), a1 = ssq16(y1);
#pragma unroll
        for (int o = 1; o < 64; o <<= 1) { a0 += __shfl_xor(a0, o); a1 += __shfl_xor(a1, o); }
        const float r0 = __builtin_amdgcn_rsqf(a0 * (1.0f / D) + EPS), r1 = __builtin_amdgcn_rsqf(a1 * (1.0f / D) + EPS);
#pragma unroll
        for (int j = 0; j < 4; ++j) { x0[j] = x0[j] + V.gt[j] * ((y0[j] * r0) * V.gA[j]); x1[j] = x1[j] + V.gt[j] * ((y1[j] * r1) * V.gA[j]); }
    }
    if (has_next) {
        float a0 = ssq16(x0), a1 = ssq16(x1);
#pragma unroll
        for (int o = 1; o < 64; o <<= 1) { a0 += __shfl_xor(a0, o); a1 += __shfl_xor(a1, o); }
        const float r0 = __builtin_amdgcn_rsqf(a0 * (1.0f / D) + EPS), r1 = __builtin_amdgcn_rsqf(a1 * (1.0f / D) + EPS);
#pragma unroll
        for (int j = 0; j < 4; ++j) { h0[j] = (x0[j] * r0) * V.gB[j] * V.sc1[j] + V.sh[j]; h1[j] = (x1[j] * r1) * V.gB[j] * V.sc1[j] + V.sh[j]; }
    }
}
template <bool XB16>
__device__ __forceinline__ void rows_phase(Frame& F, const Args& a, int mode, int l, int sub, const bf16* Y, int nrows) {
    const int gw = F.vcu * NWAVES + F.wave, NGW = F.G * NWAVES;
    const int R = (((nrows + NGW - 1) / NGW) + 1) & ~1, r0 = gw * R, r1 = (r0 + R) < nrows ? (r0 + R) : nrows;
    const bool has_y = mode == 1, has_next = (mode == 0) || !(l == 1 && sub == 1);
    const int ln = (mode == 0) ? 0 : (sub == 0 ? l : l + 1);
    const bool next_is_ffn = (mode == 1 && sub == 0);
    RowVecs V;
    if (has_y) ld_row_f32(a.in[sub == 0 ? I_GMIXPOST : I_GFFNPOST] + l * D, F.lane, V.gA);
    if (has_next) ld_row_f32(a.in[next_is_ffn ? I_GFFNPRE : I_GMIXPRE] + ln * D, F.lane, V.gB);
    int bcur = -2;
    bf16* const Hb = F.hb; bf16* const XB = (bf16*)(F.ws + WS_XB);
    f32x4 nx0[4], nx1[4]; v2u nxr0[4], nxr1[4], ny0[4], ny1[4];
#define ROWS_ISSUE(row_) do { const int rr_ = (row_); \
        if (has_y) { ld_raw_bf16_nt(Y + (size_t)rr_ * D, F.lane, ny0); ld_raw_bf16_nt(Y + (size_t)(rr_ + 1) * D, F.lane, ny1); } \
        if (XB16) { ld_raw_bf16_nt(XB + (size_t)rr_ * D, F.lane, nxr0); ld_raw_bf16_nt(XB + (size_t)(rr_ + 1) * D, F.lane, nxr1); } \
        else { const float* xs_ = rr_ < NTOK ? a.in[I_X] + (size_t)rr_ * D : a.in[I_CTX] + (size_t)(rr_ - NTOK) * D; ld_row_f32_nt(xs_, F.lane, nx0); ld_row_f32_nt(xs_ + D, F.lane, nx1); } } while (0)
    if (r0 < r1) ROWS_ISSUE(r0);
#pragma unroll 1
    for (int row = r0; row < r1; row += 2) {
        const int b = row < NTOK ? (row >> 11) : 32;
        if (b != bcur) { bcur = b;
            if (has_y) ld_mod(F, l, b, sub == 0 ? 2 : 5, F.lane, V.gt, 0.f);
            if (has_next) { ld_mod(F, ln, b, next_is_ffn ? 4 : 1, F.lane, V.sc1, 1.0f); ld_mod(F, ln, b, next_is_ffn ? 3 : 0, F.lane, V.sh, 0.f); } }
        f32x4 y0[4], y1[4], x0[4], x1[4], h0[4], h1[4];
#pragma unroll
        for (int j = 0; j < 4; ++j) { if (XB16) { x0[j] = cvt_raw_bf16(nxr0[j]); x1[j] = cvt_raw_bf16(nxr1[j]); } else { x0[j] = nx0[j]; x1[j] = nx1[j]; }
            if (has_y) { y0[j] = cvt_raw_bf16(ny0[j]); y1[j] = cvt_raw_bf16(ny1[j]); } }
        if (row + 2 < r1) ROWS_ISSUE(row + 2);
        row_pair(V, y0, y1, x0, x1, has_y, has_next, h0, h1);
        if (has_y) { st_row_bf16(XB + (size_t)row * D, F.lane, x0); st_row_bf16(XB + (size_t)(row + 1) * D, F.lane, x1); }
        if (has_next) { st_row_bf16(Hb + (size_t)row * D, F.lane, h0); st_row_bf16(Hb + (size_t)(row + 1) * D, F.lane, h1);
            if (!next_is_ffn) { GAS unsigned* q = (GAS unsigned*)(F.ws + WS_H8 + (size_t)row * D) + F.lane;
#pragma unroll
                for (int j = 0; j < 4; ++j) { q[64 * j] = pg8::pack_fp8x4(h0[j].x, h0[j].y, h0[j].z, h0[j].w); q[256 + 64 * j] = pg8::pack_fp8x4(h1[j].x, h1[j].y, h1[j].z, h1[j].w); } } }
    }
#undef ROWS_ISSUE
}

__device__ __forceinline__ void route_row(const f32x4 (&h)[4], const LAS float* rl, int lane, int& e0, int& e1, float& w0, float& w1) {
    float lg[8];
#pragma unroll
    for (int e = 0; e < 8; ++e) lg[e] = 0.f;
#pragma unroll
    for (int j = 0; j < 4; ++j)
#pragma unroll
        for (int i = 0; i < 4; ++i) { const LAS f32x4* rp = (const LAS f32x4*)(rl + ((j * 4 + i) * 64 + lane) * 8); const f32x4 q0 = rp[0], q1 = rp[1]; const float hv = h[j][i];
            lg[0] += hv * q0.x; lg[1] += hv * q0.y; lg[2] += hv * q0.z; lg[3] += hv * q0.w; lg[4] += hv * q1.x; lg[5] += hv * q1.y; lg[6] += hv * q1.z; lg[7] += hv * q1.w; }
#pragma unroll
    for (int o = 1; o < 64; o <<= 1)
#pragma unroll
        for (int e = 0; e < 8; ++e) lg[e] += __shfl_xor(lg[e], o);
    e0 = 0; float v0 = lg[0];
#pragma unroll
    for (int e = 1; e < 8; ++e) if (lg[e] > v0) { v0 = lg[e]; e0 = e; }
    e1 = -1; float v1 = -3.0e38f;
#pragma unroll
    for (int e = 0; e < 8; ++e) if (e != e0 && lg[e] > v1) { v1 = lg[e]; e1 = e; }
    w0 = 1.0f / (1.0f + __expf(v1 - v0)); w1 = 1.0f - w0;
}
__device__ __forceinline__ void post_route_phase(Frame& F, const Args& a, const bf16* Y) {
    LAS int* se = (LAS int*)F.lds;
    LAS int* sbase = se + 512;
    LAS float* rl = (LAS float*)(F.lds + 4096);
    const int l = 1;
    __syncthreads();
    for (int i = F.tid; i < 1024 * 8; i += NTHREADS) { const int k = i >> 3, e = i & 7, jj = k >> 8, ln = (k & 255) >> 2, ii = k & 3; rl[((jj * 4 + ii) * 64 + ln) * 8 + e] = a.in[I_ROUTER][i]; }
    __syncthreads();
    RowVecs V;
    ld_row_f32(a.in[I_GMIXPOST] + l * D, F.lane, V.gA); ld_row_f32(a.in[I_GFFNPRE] + l * D, F.lane, V.gB);
    bf16* const Hb = F.hb; bf16* const XB = (bf16*)(F.ws + WS_XB);
    for (int blk = F.vcu; blk < NTOK / 256; blk += F.G) {
        const int b = blk >> 3;
        ld_mod(F, l, b, 2, F.lane, V.gt, 0.f); ld_mod(F, l, b, 4, F.lane, V.sc1, 1.0f); ld_mod(F, l, b, 3, F.lane, V.sh, 0.f);
#pragma unroll 1
        for (int k = 0; k < 32; ++k) {
            const int lr = F.wave * 32 + k, row = blk * 256 + lr;
            f32x4 y0[4], x0[4], h0[4];
            ld_row_bf16(Y + (size_t)row * D, F.lane, y0);
            bf16* xp = XB + (size_t)row * D; ld_row_bf16(xp, F.lane, x0);
            { const float r0 = __builtin_amdgcn_rsqf(wave_sum(ssq16(y0)) * (1.0f / D) + EPS);
#pragma unroll
              for (int j = 0; j < 4; ++j) x0[j] = x0[j] + V.gt[j] * ((y0[j] * r0) * V.gA[j]); }
            st_row_bf16(xp, F.lane, x0);
            { const float r0 = __builtin_amdgcn_rsqf(wave_sum(ssq16(x0)) * (1.0f / D) + EPS);
#pragma unroll
              for (int j = 0; j < 4; ++j) h0[j] = (x0[j] * r0) * V.gB[j] * V.sc1[j] + V.sh[j]; }
            { GAS unsigned* q = (GAS unsigned*)((unsigned char*)Hb + (size_t)row * D) + F.lane;
#pragma unroll
              for (int j = 0; j < 4; ++j) q[64 * j] = pg8::pack_fp8x4(h0[j].x, h0[j].y, h0[j].z, h0[j].w); }
            int e0, e1; float w0, w1;
            route_row(h0, rl, F.lane, e0, e1, w0, w1);
            if (F.lane == 0) { se[2 * lr] = e0; se[2 * lr + 1] = e1;
                int4 rr; rr.x = e0; rr.y = e1; rr.z = __builtin_bit_cast(int, w0); rr.w = __builtin_bit_cast(int, w1); ((int4*)(F.ws + WS_ROUTE))[row] = rr; }
        }
        __syncthreads();
        const int half = blk >> 7;
        if (F.tid < 8) { int n = 0; for (int i = 0; i < 512; ++i) n += (se[i] == F.tid) ? 1 : 0;
            sbase[F.tid] = (int)__hip_atomic_fetch_add((unsigned*)(F.ws + WS_CTL) + CW_CNT + half * 8 + F.tid, (unsigned)n, __ATOMIC_RELAXED, __HIP_MEMORY_SCOPE_AGENT); }
        __syncthreads();
        if (F.tid < 8) { int p = sbase[F.tid]; int* lst = (int*)(F.ws + WS_LIST) + ((size_t)half * 8 + F.tid) * 32768;
            for (int i = 0; i < 512; ++i) if (se[i] == F.tid) lst[p++] = ((blk * 256 + (i >> 1)) << 1) | (i & 1); }
        __syncthreads();
    }
}

__device__ __forceinline__ void moe_offsets(Frame& F, int half, int (&toff)[9], int (&cnt)[8]) {
    const unsigned* cw = (const unsigned*)(F.ws + WS_CTL) + CW_CNT + half * 8;
    toff[0] = 0;
#pragma unroll
    for (int e = 0; e < 8; ++e) { cnt[e] = __builtin_amdgcn_readfirstlane((int)__hip_atomic_load(cw + e, __ATOMIC_RELAXED, __HIP_MEMORY_SCOPE_AGENT)); toff[e + 1] = toff[e] + (cnt[e] + 255) / 256; }
}
__device__ __forceinline__ void moe_gather_phase(Frame& F, int half, int skip_first = 0) {
    if (skip_first < 0 || skip_first >= F.G) skip_first = 0;
    const int bxw = (int)blockIdx.x - skip_first; if (bxw < 0) return;
    const int gw = bxw * NWAVES + F.wave, NGW = (F.G - skip_first) * NWAVES;
    int toff[9], cnt[8]; moe_offsets(F, half, toff, cnt);
    const int P = toff[8] * 256;
    for (int p = gw; p < P; p += NGW) {
        const int tile = p >> 8; int e = 0;
#pragma unroll
        for (int k = 1; k < 8; ++k) e += (tile >= toff[k]) ? 1 : 0;
        const int idx = p - toff[e] * 256;
        unsigned char* dst = F.ws + BIG_AS + (size_t)p * D;
        v4u o = {0u, 0u, 0u, 0u};
        if (idx < cnt[e]) {
            const int ts = ((const int*)(F.ws + WS_LIST))[((size_t)half * 8 + e) * 32768 + idx], tok = ts >> 1, slot = ts & 1;
            o = *((const GAS v4u*)((const unsigned char*)F.hb + (size_t)tok * D) + F.lane);
            if (F.lane == 0) ((int*)(F.ws + WS_INV))[tok * 2 + slot] = p;
        }
        *((GAS v4u*)dst + F.lane) = o;
    }
}
__device__ __forceinline__ void moe_convert(Frame& F, const Args& a) {
    const int gw = F.vcu * NWAVES + F.wave, NGW = F.G * NWAVES;
    LAS float* scr = (LAS float*)(F.lds + F.wave * 16384);
    constexpr int I13 = 16 * 112, I2 = 56 * 32;
    for (int it = gw; it < 8 * (2 * I13 + I2); it += NGW) {
        const int e = it / (2 * I13 + I2); int r = it % (2 * I13 + I2);
        if (r < 2 * I13) {
            const int which = r / I13; r %= I13; const int kb = r / 112, nb = r % 112, n0 = 32 * nb;
            const float* W = (which ? a.in[I_MW3] : a.in[I_MW1]) + (size_t)e * D * DFFE;
            transpose_item_f8(W, DFFE, F.ws + WM_13 + (size_t)e * 2 * DFFE * D, D, 64 * kb, n0, (n0 / 128) * 256 + which * 128 + (n0 % 128), W13_SCALE, scr, F.lane);
        } else {
            r -= 2 * I13; const int kb = r / 32, nb = r % 32;
            transpose_item_f8(a.in[I_MW2] + (size_t)e * DFFE * D, D, F.ws + WM_2 + (size_t)e * D * DFFE, DFFE, 64 * kb, 32 * nb, 32 * nb, W2_SCALE, scr, F.lane);
        }
    }
}
__device__ __forceinline__ void moe_post_phase(Frame& F, const Args& a, int half) {
    const int gw = F.vcu * NWAVES + F.wave, NGW = F.G * NWAVES;
    const int R = (((32768 + NGW - 1) / NGW) + 1) & ~1, t0 = gw * R, t1 = (t0 + R) < 32768 ? (t0 + R) : 32768;
    RowVecs V; ld_row_f32(a.in[I_GFFNPOST] + D, F.lane, V.gA);
    int bcur = -2;
    const bf16* Y2 = (const bf16*)(F.ws + BIG_Y2S); const int* inv = (const int*)(F.ws + WS_INV); const int4* rt = (const int4*)(F.ws + WS_ROUTE);
    int4 ira, irb; int ip00, ip01, ip10, ip11;
    v2u nya[4], nyb[4], nyc[4], nyd[4], nxr0[4], nxr1[4]; const bf16* XB = (const bf16*)(F.ws + WS_XB); float nw0 = 0.f, nw1 = 0.f, nu0 = 0.f, nu1 = 0.f;
#define MP_IDX(t_) do { const int rw_ = half * 32768 + (t_); ira = rt[rw_]; irb = rt[rw_ + 1]; ip00 = inv[rw_ * 2]; ip01 = inv[rw_ * 2 + 1]; ip10 = inv[rw_ * 2 + 2]; ip11 = inv[rw_ * 2 + 3]; } while (0)
#define MP_DATA(t_) do { const int rw_ = half * 32768 + (t_); \
        ld_raw_bf16_nt(Y2 + (size_t)ip00 * D, F.lane, nya); ld_raw_bf16_nt(Y2 + (size_t)ip01 * D, F.lane, nyb); ld_raw_bf16_nt(Y2 + (size_t)ip10 * D, F.lane, nyc); ld_raw_bf16_nt(Y2 + (size_t)ip11 * D, F.lane, nyd); \
        const bf16* xq_ = XB + (size_t)rw_ * D; ld_raw_bf16_nt(xq_, F.lane, nxr0); ld_raw_bf16_nt(xq_ + D, F.lane, nxr1); \
        nw0 = __builtin_bit_cast(float, ira.z); nw1 = __builtin_bit_cast(float, ira.w); nu0 = __builtin_bit_cast(float, irb.z); nu1 = __builtin_bit_cast(float, irb.w); } while (0)
    if (t0 < t1) { MP_IDX(t0); MP_DATA(t0); if (t0 + 2 < t1) MP_IDX(t0 + 2); }
#pragma unroll 1
    for (int t = t0; t < t1; t += 2) {
        const int row = half * 32768 + t, b = row >> 11;
        if (b != bcur) { bcur = b; ld_mod(F, 1, b, 5, F.lane, V.gt, 0.f); }
        f32x4 y0[4], y1[4], x0[4], x1[4], h0[4], h1[4];
        float* xp = a.out + (size_t)row * D;
#pragma unroll
        for (int j = 0; j < 4; ++j) { x0[j] = cvt_raw_bf16(nxr0[j]); x1[j] = cvt_raw_bf16(nxr1[j]); y0[j] = cvt_raw_bf16(nya[j]) * nw0 + cvt_raw_bf16(nyb[j]) * nw1; y1[j] = cvt_raw_bf16(nyc[j]) * nu0 + cvt_raw_bf16(nyd[j]) * nu1; }
        if (t + 2 < t1) { MP_DATA(t + 2); if (t + 4 < t1) MP_IDX(t + 4); }
        row_pair(V, y0, y1, x0, x1, true, false, h0, h1);
        st_row_f32_nt(xp, F.lane, x0); st_row_f32_nt(xp + D, F.lane, x1);
    }
#undef MP_IDX
#undef MP_DATA
}

#ifndef MK_ONLY
#define MK_ONLY -1
#endif
#ifndef MK_SKIP
#define MK_SKIP -1
#endif
#define ON(k) ((MK_ONLY < 0 || MK_ONLY == (k)) && MK_SKIP != (k))
#ifndef MK_REPMASK
#define MK_REPMASK 0
#endif
#ifndef MK_REPSUB
#define MK_REPSUB 0
#endif
#ifndef MK_HYVAR
#define MK_HYVAR 0
#endif
#ifndef MK_PROBE
#define MK_PROBE -1
#endif
#ifndef MK_PROBE_END
#define MK_PROBE_END MK_PROBE
#endif
#ifndef MK_PROBE_DIV
#define MK_PROBE_DIV 10
#endif
#ifndef MK_MULTI
#define MK_MULTI 0
#endif
constexpr int NPHASES = 2 + 9 + 6 + 6;

typedef const __attribute__((address_space(4))) Args* ArgsP;
#define KARGS ((ArgsP)__builtin_amdgcn_kernarg_segment_ptr())
#define PH_ENTER \
    Frame F; const Args* ap_; { int t_ = threadIdx.x; asm volatile("" : "+v"(t_)); ArgsP q_ = KARGS; asm volatile("" : "+s"(q_)); ap_ = (const Args*)q_; \
      F.lds = (LAS unsigned char*)lds_raw; F.tid = t_; F.lane = t_ & 63; F.wave = __builtin_amdgcn_readfirstlane(t_ >> 6); \
      F.G = gridDim.x; { const int bx_ = blockIdx.x; F.vcu = (F.G % 8 == 0) ? (bx_ % 8) * (F.G / 8) + bx_ / 8 : bx_; } F.ws = q_->ws; F.hb = (bf16*)q_->out; } \
    const Args& a = *ap_; const int bx = (int)blockIdx.x; \
    bf16* const Hb = F.hb; bf16* const Y3 = (bf16*)(F.ws + WS_Y3); bf16* const QKV = (bf16*)(F.ws + BIG_QKV); bf16* const CINT = (bf16*)(F.ws + BIG_CINT); unsigned char* const GATE = F.ws + BIG_GATE; \
    (void)Hb; (void)Y3; (void)QKV; (void)CINT; (void)GATE; (void)bx; (void)a;

__global__ void __launch_bounds__(NTHREADS, 2) fwd_kernel(Args args) {
    extern __shared__ __attribute__((aligned(16))) unsigned char lds_raw[];
    {
        volatile LAS unsigned* MISC0 = (volatile LAS unsigned*)((LAS unsigned char*)lds_raw + MISC_OFF);
        for (int u = threadIdx.x; u < (LDS_BYTES - MISC_OFF) / 4; u += NTHREADS) MISC0[u] = 0u;
        __syncthreads();
    }
    if (!MK_MULTI) (void)xcd_barrier_post((unsigned*)(KARGS->ws + WS_CTL) + CW_BAR, (volatile LAS unsigned*)((LAS unsigned char*)lds_raw + MISC_OFF) + 8);
    int ph = 0;
#define PROBE_STAMP(which) do { if (MK_PROBE >= 0 && blockIdx.x == 0 && __builtin_amdgcn_readfirstlane((int)threadIdx.x) == 0) { volatile unsigned* pw_ = (volatile unsigned*)(KARGS->ws + WS_CTL) + 20000; const unsigned t_ = (unsigned)__builtin_amdgcn_s_memrealtime(); if ((which) == 0) pw_[0] = t_; else pw_[1] = t_ - pw_[0]; } } while (0)
    if (MK_PROBE == 0) PROBE_STAMP(0);
#define LO_ (KARGS->ph_lo)
#define HI_ (KARGS->ph_hi)
#define GRID_BAR do { XcdBarrier b_; b_.bar = (unsigned*)(KARGS->ws + WS_CTL) + CW_BAR; b_.x = xb_xcc_id(); b_.st = (volatile LAS unsigned*)((LAS unsigned char*)lds_raw + MISC_OFF) + 8; xcd_barrier(b_); } while (0)
#define RUN (LO_ <= ph && ph < HI_)
#define END_PHASE do { if (RUN && (ph + 1 < HI_)) { GRID_BAR; } if (MK_PROBE > 0 && ph + 1 == MK_PROBE) PROBE_STAMP(0); if (MK_PROBE >= 0 && ph == MK_PROBE_END) PROBE_STAMP(1); ++ph; } while (0)

    if (RUN && ON(0)) { PH_ENTER p0_prologue(F, a); } END_PHASE;
    if (RUN && ON(1)) { PH_ENTER p1_phase(F, a); rows_phase<false>(F, a, 0, 0, 0, nullptr, NROW); } END_PHASE;

#pragma unroll 1
    for (int l = 0; l < 2; ++l) {
        const int nrows = l == 0 ? NROW : NTOK;
        if (RUN && ON(2)) { PH_ENTER
            const bf16* Wq8 = (const bf16*)(F.ws + W_IN + (size_t)l * INC * D);
            { pg8::Gemm g{(const bf16*)(F.ws + WS_H8), Wq8, nrows, QKVC, D / 2}; pg8::StaticOrder S; S.init(nrows, QKVC, F.G, bx);
              pg8::EpiQKV E{QKV, (const float*)(F.ws + WS_ROPE), 0, QSCALE, 1.0f / W13_SCALE};
              pg8::gemm_phase<pg8::EpiQKV, pg8::StaticOrder, true, true, true>(F.lds, g, S, E, F.tid); }
            int tid2 = threadIdx.x; asm volatile("" : "+v"(tid2));
            if (l == 1) { pg8::Gemm g{(const bf16*)(F.ws + WS_H8 + (size_t)NTOK * D), Wq8, NCTX, 1280, D / 2}; pg8::StaticOrder S; S.init(NCTX, 1280, F.G, bx);
              pg8::EpiQKV E{QKV, (const float*)(F.ws + WS_ROPE), NTOK, QSCALE, 1.0f / W13_SCALE};
              pg8::gemm_phase<pg8::EpiQKV, pg8::StaticOrder, true, true, true>(F.lds, g, S, E, tid2); }
            int tid3 = threadIdx.x; asm volatile("" : "+v"(tid3));
            { pg8::Gemm g{(const bf16*)(F.ws + W_CB) + (size_t)l * CINC * D, Hb, CINC, nrows, D}; pg8::StaticOrder S; S.init(CINC, nrows, F.G, bx);
              pg8::EpiPlain E{CINT, NROW, 0, 0, 1.0f};
              pg8::gemm_phase<pg8::EpiPlain, pg8::StaticOrder, true, true>(F.lds, g, S, E, tid3); }
        } END_PHASE;
        if (RUN) {
            { PH_ENTER const float* sink = a.in[I_SINK] + l * 8; const float* rpb = a.in[I_RPB] + (size_t)l * 8 * 15 * 31; const int sm = a.sub_mask;
              if (ON(3) && (sm & 1)) { AttPre P; P.valid = 0; int th = -1; for (int u = F.vcu; u < 2048; u += F.G) attn_unit<0>(F, u, u + F.G < 2048 ? u + F.G : -1, QKV, Y3, sink, rpb, P, th, (sm >> 6) & 3); } }
            { PH_ENTER const float* sink = a.in[I_SINK] + l * 8; const float* rpb = a.in[I_RPB] + (size_t)l * 8 * 15 * 31; const int sm = a.sub_mask;
              if (ON(4) && (sm & 2)) { AttPre P; P.valid = 0; int th = -1; for (int u = F.vcu; u < 2048; u += F.G) attn_unit<1>(F, u, u + F.G < 2048 ? u + F.G : -1, QKV, Y3 + (size_t)NROW * 512, sink, rpb, P, th, (sm >> 6) & 3); } }
            { PH_ENTER const float* sink = a.in[I_SINK] + l * 8; const float* rpb = a.in[I_RPB] + (size_t)l * 8 * 15 * 31; const int sm = a.sub_mask;
              if (l == 0 && ON(5) && (sm & 4)) {
                { AttPre P; P.valid = 0; int th = -1; for (int u = F.vcu; u < 256; u += F.G) attn_unit<2>(F, u, -1, QKV, Y3, sink, rpb, P, th); }
                { AttPre P; P.valid = 0; int th = -1; for (int u = F.vcu; u < 256; u += F.G) attn_unit<3>(F, u, -1, QKV, Y3 + (size_t)NROW * 512, sink, rpb, P, th); }
              } }
            { PH_ENTER const int sm = a.sub_mask;
              const float* cw = a.in[I_CONVW] + l * 3 * CINC; const float* cb = a.in[I_CONVB] + l * CINC; const float* hb = a.in[I_HBIAS] + l * 1024;
#if MK_HYVAR
              if (ON(6) && (sm & 32)) for (int c = F.vcu; c < 512; c += F.G) hyena_unit<SEQ, MK_HYVAR>(F, c, CINT, CINT, (const bf16*)(F.ws + WS_GF) + (size_t)l * 2 * 512 * 2 * SEQ, cw, cb, hb);
#endif
              if (ON(6) && (sm & 8)) for (int c = F.vcu; c < 512; c += F.G) hyena_unit<SEQ>(F, c, CINT, CINT, (const bf16*)(F.ws + WS_GF) + (size_t)l * 2 * 512 * 2 * SEQ, cw, cb, hb);
              if (l == 0 && ON(7) && (sm & 16)) for (int c = F.vcu; c < 512; c += F.G) hyena_unit<LC>(F, c, CINT, CINT, (const bf16*)(F.ws + WS_GFC) + (size_t)l * 2 * 512 * 2 * LC, cw, cb, hb);
              __syncthreads(); }
        } END_PHASE;
        if (RUN && ON(8)) { PH_ENTER
            transpose_yc(F, CINT, (bf16*)(F.ws + BIG_YCT), nrows);
            __syncthreads();
            pg8::Gemm g{(const bf16*)(F.ws + WS_H8), (const bf16*)(F.ws + W_IN + (size_t)l * INC * D + (size_t)(QKVC + CINC) * D), nrows, GATEC, D / 2}; pg8::StaticOrder S; S.init(nrows, GATEC, F.G, bx);
            pg8::EpiSig E{GATE, GATEC, 1.0f / W13_SCALE};
            pg8::gemm_phase<pg8::EpiSig, pg8::StaticOrder, true, true, true>(F.lds, g, S, E, F.tid);
        } END_PHASE;
        if (RUN && ON(9)) { PH_ENTER
            constexpr int TB = 256 * 512 * 2;
            static_assert((WS_Y3 - BIG_YCT) % TB == 0, "merge tile offsets");
            constexpr int OA = (int)((WS_Y3 - BIG_YCT) / TB), OB = OA + NROW / 256;
            pg8::Gemm g{(const bf16*)(F.ws + BIG_YCT), (const bf16*)(F.ws + W_BR) + (size_t)l * 3 * D * 512, 3 * NROW, 3 * D, 512}; pg8::MergeOrder S{nrows / 256, F.G, bx, OA, OB, 0};
            pg8::EpiMerge E{Hb, GATE, OA, OB, 0};
            pg8::gemm_phase<pg8::EpiMerge, pg8::MergeOrder, true, true>(F.lds, g, S, E, F.tid);
        } END_PHASE;
        if (RUN && ON(10)) { PH_ENTER
            pg8::Gemm g{Hb, (const bf16*)(F.ws + W_OUT) + (size_t)l * D * D, nrows, D, D}; pg8::StaticOrder S; S.init(nrows, D, F.G, bx);
            pg8::EpiPlain E{Y3, D, 0, 0, 1.0f};
            pg8::gemm_phase<pg8::EpiPlain, pg8::StaticOrder, true, true>(F.lds, g, S, E, F.tid);
        } END_PHASE;
        if (RUN && ON(11)) { PH_ENTER if (l == 0) rows_phase<false>(F, a, 1, 0, 0, Y3, nrows); else post_route_phase(F, a, Y3); } END_PHASE;
        if (l == 0) {
            if (RUN && ON(12)) { PH_ENTER
                pg8::Gemm g{Hb, (const bf16*)(F.ws + W_F13), NROW, 2 * DFF, D}; pg8::StaticOrder S; S.init(NROW, 2 * DFF, F.G, bx);
                pg8::EpiSwiGLU E{(bf16*)(F.ws + BIG_HID), DFF, 0};
                pg8::gemm_phase<pg8::EpiSwiGLU, pg8::StaticOrder, true, true>(F.lds, g, S, E, F.tid);
            } END_PHASE;
            if (RUN && ON(13)) { PH_ENTER
                pg8::Gemm g{(const bf16*)(F.ws + BIG_HID), (const bf16*)(F.ws + W_F2), NROW, D, DFF}; pg8::StaticOrder S; S.init(NROW, D, F.G, bx);
                pg8::EpiPlain E{Y3, D, 0, 0, 1.0f};
                pg8::gemm_phase<pg8::EpiPlain, pg8::StaticOrder, true, true>(F.lds, g, S, E, F.tid);
            } END_PHASE;
            if (RUN && ON(14)) { PH_ENTER rows_phase<true>(F, a, 1, 0, 1, Y3, NROW); } END_PHASE;
        } else {
#pragma unroll 1
            for (int half = 0; half < 2; ++half) {
                if (half == 0) { if (RUN && ON(15)) { PH_ENTER moe_convert(F, a); moe_gather_phase(F, 0); } END_PHASE; }
                if (RUN && ON(16)) { PH_ENTER
                    int toff[9], cnt[8]; moe_offsets(F, half, toff, cnt);
                    pg8::GroupOrder S; S.nM = toff[8]; S.nN = 28; S.G = F.G; S.c = bx;
#pragma unroll
                    for (int k = 0; k < 9; ++k) S.toff[k] = toff[k];
                    pg8::Gemm g{(const bf16*)(F.ws + BIG_AS), (const bf16*)(F.ws + WM_13), PCAP, 8 * 2 * DFFE, D / 2};
                    pg8::EpiSwiGLU8 E{F.ws + BIG_MH, DFFE, 28, 1.0f / W13_SCALE, HID_SCALE};
                    pg8::gemm_phase<pg8::EpiSwiGLU8, pg8::GroupOrder, true, true, true>(F.lds, g, S, E, F.tid);
                    if (half == 1) moe_post_phase(F, a, 0);
                } END_PHASE;
                if (RUN && ON(17)) { PH_ENTER
                    int toff[9], cnt[8]; moe_offsets(F, half, toff, cnt);
                    pg8::GroupOrder S; S.nM = toff[8]; S.nN = 4; S.G = F.G; S.c = bx;
#pragma unroll
                    for (int k = 0; k < 9; ++k) S.toff[k] = toff[k];
                    pg8::Gemm g{(const bf16*)(F.ws + BIG_MH), (const bf16*)(F.ws + WM_2), PCAP, 8 * D, DFFE / 2};
                    pg8::EpiPlain E{(bf16*)(F.ws + BIG_Y2S), D, 4, 0, 1.0f / (HID_SCALE * W2_SCALE)};
                    pg8::gemm_phase<pg8::EpiPlain, pg8::GroupOrder, true, true, true>(F.lds, g, S, E, F.tid);
                    if (half == 0) moe_gather_phase(F, 1, toff[8] * 4 - 4 * F.G);
                } END_PHASE;
            }
            if (RUN && ON(18)) { PH_ENTER moe_post_phase(F, a, 1); } END_PHASE;
        }
    }
#undef RUN
#undef END_PHASE
    if (MK_PROBE >= 0 && blockIdx.x == 0 && threadIdx.x == 0) {
        volatile unsigned* pw_ = (volatile unsigned*)(KARGS->ws + WS_CTL) + 20000;
        volatile float* o_ = (volatile float*)KARGS->out;
        o_[0] = o_[0] + floorf((float)pw_[1] * (0.01f / MK_PROBE_DIV));
    }
}

extern "C" void kernel_launch(void* const* d_in, const int* in_sizes, int n_in, void* d_out, int out_size, void* d_ws, size_t ws_size, hipStream_t stream) {
    static int grid = 0;
    if (grid == 0) {
        if (n_in != 31 || in_sizes[0] != NTOK * D || out_size != NTOK * D || ws_size < WS_END) { fprintf(stderr, "kernel_launch: unexpected shapes (n_in %d, in0 %d, out %d, ws %zu)\n", n_in, n_in > 0 ? in_sizes[0] : -1, out_size, ws_size); grid = -1; return; }
        int dev = 0, cus = 0, per_cu = 0;
        if (hipGetDevice(&dev) != hipSuccess || hipDeviceGetAttribute(&cus, hipDeviceAttributeMultiprocessorCount, dev) != hipSuccess) { grid = -1; return; }
        if (hipFuncSetAttribute((const void*)fwd_kernel, hipFuncAttributeMaxDynamicSharedMemorySize, LDS_BYTES) != hipSuccess) { fprintf(stderr, "kernel_launch: hipFuncSetAttribute failed\n"); grid = -1; return; }
        if (hipOccupancyMaxActiveBlocksPerMultiprocessor(&per_cu, (const void*)fwd_kernel, NTHREADS, LDS_BYTES) != hipSuccess || per_cu < 1) { fprintf(stderr, "kernel_launch: occupancy query says %d\n", per_cu); }
        (void)hipGetLastError();
        grid = cus;
    }
    if (grid < 0) return;
    if (hipMemsetAsync((char*)d_ws + WS_CTL, 0, CTL_ZERO_BYTES, stream) != hipSuccess) return;
    Args a{};
    for (int i = 0; i < 31; ++i) a.in[i] = (const float*)d_in[i];
    a.out = (float*)d_out; a.ws = (unsigned char*)d_ws;
#if MK_MULTI
    for (int p = 0; p < NPHASES; ++p) { a.ph_lo = p; a.ph_hi = p + 1; a.sub_mask = 31;
        const bool mix = (p == 3 || p == 12);
        if (((MK_REPMASK >> p) & 1) && !mix) { a.sub_mask = 31 | MK_REPSUB; hipLaunchKernelGGL(fwd_kernel, dim3(grid), dim3(NTHREADS), LDS_BYTES, stream, a); a.sub_mask = 31; }
        if (((MK_REPMASK >> p) & 1) && mix) { a.sub_mask = MK_REPSUB; hipLaunchKernelGGL(fwd_kernel, dim3(grid), dim3(NTHREADS), LDS_BYTES, stream, a); a.sub_mask = 31; }
        hipLaunchKernelGGL(fwd_kernel, dim3(grid), dim3(NTHREADS), LDS_BYTES, stream, a); }
#else
    a.ph_lo = 0; a.ph_hi = NPHASES; a.sub_mask = 31;
    hipLaunchKernelGGL(fwd_kernel, dim3(grid), dim3(NTHREADS), LDS_BYTES, stream, a);
#endif
    const hipError_t le = hipPeekAtLastError();
    if (le != hipSuccess) fprintf(stderr, "kernel_launch: launch failed: %s\n", hipGetErrorName(le));
}
```

```cpp
#include <hip/hip_runtime.h>
#include <cstdio>
#include <cstdint>
namespace pg8 {
#define PG8_LAS __attribute__((address_space(3)))
typedef unsigned short bf16_t;
typedef short bf16x8 __attribute__((ext_vector_type(8)));
typedef float f32x4 __attribute__((ext_vector_type(4)));
typedef unsigned u32x4 __attribute__((ext_vector_type(4)));
constexpr int BM = 256, BK = 64, HALF = 128, HTB = HALF * BK * 2  , STAGE_BYTES = 8 * HTB, NXCD = 8, WGM = 8;

__host__ __device__ __forceinline__ int lds_byte(int r, int c) { const int st = (r >> 4) * 2 + (c >> 5), rr = r & 15, cc = c & 31, ob = rr * 64 + cc * 2; return st * 1024 + (ob ^ (((ob >> 9) & 1) << 5)); }
__host__ __device__ __forceinline__ void stage_rc(int b, int& R, int& C) { const int st = b / 1024, sb = b % 1024, swz = sb ^ (((sb >> 9) & 1) << 5); R = (st >> 1) * 16 + swz / 64; C = (st & 1) * 32 + (swz % 64) / 2; }
__host__ __device__ __forceinline__ int perm32(int rho) { const int n = rho >> 4, i = rho & 15; return 8 * (i >> 2) + 4 * n + (i & 3); }

struct Unit { int pm, pn; };
struct Gemm { const bf16_t* A; const bf16_t* Bt; int M, N, K; };

struct StaticOrder {
    int nM, nN, nwg, G, c;
    __host__ __device__ void init(int M, int N, int G_, int c_) { nM = M / BM; nN = N / BM; nwg = nM * nN; G = G_; c = c_; }
    __host__ __device__ bool next(int i, Unit& u) const {
        const long L = (long)i * G + c; if (L >= nwg) return false;
        int wgid = (int)L; { const int q = nwg / NXCD, r = nwg % NXCD, xcd = wgid % NXCD, off = wgid / NXCD; wgid = (xcd < r ? xcd * (q + 1) : r * (q + 1) + (xcd - r) * q) + off; }
        const int nig = WGM * nN, gid = wgid / nig, fm = gid * WGM, gsz = (nM - fm) < WGM ? (nM - fm) : WGM;
        u.pm = fm + ((wgid % nig) % gsz); u.pn = (wgid % nig) / gsz; return true;
    }
    __device__ __forceinline__ void a_ready(const Unit&) const {}
    __device__ __forceinline__ void done(const Unit&) const {}
};

typedef float f32x2_t __attribute__((ext_vector_type(2)));
typedef __bf16 bf16x2_t __attribute__((ext_vector_type(2)));
__device__ __forceinline__ unsigned cvt_pk_bf16(float lo, float hi) { const f32x2_t v = {lo, hi}; const bf16x2_t b = __builtin_convertvector(v, bf16x2_t); return __builtin_bit_cast(unsigned, b); }
__device__ __forceinline__ u32x4 pack8(f32x4 a, f32x4 b) { u32x4 w; w.x = cvt_pk_bf16(a[0], a[1]); w.y = cvt_pk_bf16(a[2], a[3]); w.z = cvt_pk_bf16(b[0], b[1]); w.w = cvt_pk_bf16(b[2], b[3]); return w; }
__device__ __forceinline__ float bf_lo(unsigned w) { return __builtin_bit_cast(float, w << 16); }
__device__ __forceinline__ float bf_hi(unsigned w) { return __builtin_bit_cast(float, w & 0xffff0000u); }
__device__ __forceinline__ void unpack8(u32x4 w, f32x4& a, f32x4& b) { a = (f32x4){bf_lo(w.x), bf_hi(w.x), bf_lo(w.y), bf_hi(w.y)}; b = (f32x4){bf_lo(w.z), bf_hi(w.z), bf_lo(w.w), bf_hi(w.w)}; }
__device__ __forceinline__ float fast_sigmoid(float x) { return __builtin_amdgcn_rcpf(1.0f + __builtin_amdgcn_exp2f(-1.4426950408889634f * x)); }

__device__ __forceinline__ f32x4 vexp2(f32x4 x) { return (f32x4){__builtin_amdgcn_exp2f(x[0]), __builtin_amdgcn_exp2f(x[1]), __builtin_amdgcn_exp2f(x[2]), __builtin_amdgcn_exp2f(x[3])}; }
__device__ __forceinline__ f32x4 vrcp(f32x4 x) { return (f32x4){__builtin_amdgcn_rcpf(x[0]), __builtin_amdgcn_rcpf(x[1]), __builtin_amdgcn_rcpf(x[2]), __builtin_amdgcn_rcpf(x[3])}; }
__device__ __forceinline__ f32x4 vsigmoid(f32x4 x, float k) { return vrcp(vexp2(x * k) + 1.0f); }
struct EpiPlain {
    static constexpr bool PERM = true, AFTER_DRAIN = false, INPLACE = false;
    bf16_t* O; int ldc; int pn_mod; int accum; float scale;
    __device__ __forceinline__ void operator()(const f32x4 (&acc)[2][2][4][2], const Unit& u, int wr, int wc, int fr, int fq) const {
        asm volatile("" : "+v"(fr), "+v"(fq));
        const int pn = pn_mod ? (u.pn % pn_mod) : u.pn;
        const int row0 = u.pm * BM + wr * 64 + fr, col0 = pn * BM + wc * 32 + 8 * fq;
#pragma unroll
        for (int ai = 0; ai < 2; ++ai)
#pragma unroll
            for (int m = 0; m < 4; ++m) { bf16_t* rowp = O + (size_t)(row0 + ai * HALF + m * 16) * ldc + col0;
#pragma unroll
                for (int bj = 0; bj < 2; ++bj) { f32x4 v0 = acc[ai][bj][m][0] * scale, v1 = acc[ai][bj][m][1] * scale;
                    if (accum) { f32x4 p0, p1; unpack8(*(const u32x4*)(rowp + bj * HALF), p0, p1); v0 = v0 + p0; v1 = v1 + p1; }
                    *(u32x4*)(rowp + bj * HALF) = pack8(v0, v1); } }
    }
};
__device__ __forceinline__ unsigned pack_u8x4(float a, float b, float c, float d) {
    unsigned w = 0; w = __builtin_amdgcn_cvt_pk_u8_f32(a, 0, w); w = __builtin_amdgcn_cvt_pk_u8_f32(b, 1, w); w = __builtin_amdgcn_cvt_pk_u8_f32(c, 2, w); w = __builtin_amdgcn_cvt_pk_u8_f32(d, 3, w); return w; }
struct EpiSig {
    static constexpr bool PERM = true, AFTER_DRAIN = false, INPLACE = false;
    unsigned char* O; int ldc; float in_scale;
    __device__ __forceinline__ void operator()(const f32x4 (&acc)[2][2][4][2], const Unit& u, int wr, int wc, int fr, int fq) const {
        const int t = ((wr * 4 + wc) * 4 + fq) * 16 + fr;
        unsigned char* tile = O + ((size_t)u.pm * (ldc / BM) + u.pn) * (BM * BM) + (size_t)t * 16;
        const float k = -1.4426950408889634f * in_scale;
#pragma unroll
        for (int ai = 0; ai < 2; ++ai)
#pragma unroll
            for (int m = 0; m < 4; ++m) { u32x4 w;
                { const f32x4 v0 = vsigmoid(acc[ai][0][m][0], k) * 255.0f, v1 = vsigmoid(acc[ai][0][m][1], k) * 255.0f;
                  w.x = pack_u8x4(fmaxf(v0[0], 1.f), fmaxf(v0[1], 1.f), fmaxf(v0[2], 1.f), fmaxf(v0[3], 1.f)); w.y = pack_u8x4(fmaxf(v1[0], 1.f), fmaxf(v1[1], 1.f), fmaxf(v1[2], 1.f), fmaxf(v1[3], 1.f)); }
                { const f32x4 v0 = vsigmoid(acc[ai][1][m][0], k) * 255.0f, v1 = vsigmoid(acc[ai][1][m][1], k) * 255.0f;
                  w.z = pack_u8x4(fmaxf(v0[0], 1.f), fmaxf(v0[1], 1.f), fmaxf(v0[2], 1.f), fmaxf(v0[3], 1.f)); w.w = pack_u8x4(fmaxf(v1[0], 1.f), fmaxf(v1[1], 1.f), fmaxf(v1[2], 1.f), fmaxf(v1[3], 1.f)); }
                *(u32x4*)(tile + (ai * 4 + m) * (512 * 16)) = w; }
    }
};
struct EpiSwiGLU {
    static constexpr bool PERM = true, AFTER_DRAIN = false, INPLACE = false;
    bf16_t* O; int ldc; int pn_mod;
    __device__ __forceinline__ void operator()(const f32x4 (&acc)[2][2][4][2], const Unit& u, int wr, int wc, int fr, int fq) const {
        const int pn = pn_mod ? (u.pn % pn_mod) : u.pn;
        const int row0 = u.pm * BM + wr * 64 + fr, col0 = pn * HALF + wc * 32 + 8 * fq;
#pragma unroll
        for (int ai = 0; ai < 2; ++ai)
#pragma unroll
            for (int m = 0; m < 4; ++m) { bf16_t* rowp = O + (size_t)(row0 + ai * HALF + m * 16) * ldc + col0;
                const f32x4 a0 = acc[ai][0][m][0], a1 = acc[ai][0][m][1], g0 = acc[ai][1][m][0], g1 = acc[ai][1][m][1];
                const f32x4 v0 = (a0 * g0) * vsigmoid(a0, -1.4426950408889634f), v1 = (a1 * g1) * vsigmoid(a1, -1.4426950408889634f);
                *(u32x4*)rowp = pack8(v0, v1); }
    }
};
__device__ __forceinline__ unsigned pack_fp8x4(float a, float b, float c, float d) {
    a = __builtin_amdgcn_fmed3f(a, -448.f, 448.f); b = __builtin_amdgcn_fmed3f(b, -448.f, 448.f); c = __builtin_amdgcn_fmed3f(c, -448.f, 448.f); d = __builtin_amdgcn_fmed3f(d, -448.f, 448.f);
    int w = 0; w = __builtin_amdgcn_cvt_pk_fp8_f32(a, b, w, false); w = __builtin_amdgcn_cvt_pk_fp8_f32(c, d, w, true); return (unsigned)w; }
struct EpiSwiGLU8 {
    static constexpr bool PERM = true, AFTER_DRAIN = false, INPLACE = false;
    unsigned char* O; int ldc; int pn_mod; float in_scale, out_scale;
    __device__ __forceinline__ void operator()(const f32x4 (&acc)[2][2][4][2], const Unit& u, int wr, int wc, int fr, int fq) const {
        asm volatile("" : "+v"(fr), "+v"(fq));
        const int pn = pn_mod ? (u.pn % pn_mod) : u.pn;
        const int row0 = u.pm * BM + wr * 64 + fr, col0 = pn * HALF + wc * 32 + 8 * fq;
#pragma unroll
        for (int ai = 0; ai < 2; ++ai)
#pragma unroll
            for (int m = 0; m < 4; ++m) { unsigned char* rowp = O + (size_t)(row0 + ai * HALF + m * 16) * ldc + col0;
                const f32x4 a0 = acc[ai][0][m][0], a1 = acc[ai][0][m][1], g0 = acc[ai][1][m][0], g1 = acc[ai][1][m][1];
                const float k1 = -1.4426950408889634f * in_scale, k2 = in_scale * in_scale * out_scale;
                const f32x4 v0 = ((a0 * g0) * vsigmoid(a0, k1)) * k2, v1 = ((a1 * g1) * vsigmoid(a1, k1)) * k2;
                typedef unsigned u32x2_ __attribute__((ext_vector_type(2)));
                u32x2_ w; w.x = pack_fp8x4(v0[0], v0[1], v0[2], v0[3]); w.y = pack_fp8x4(v1[0], v1[1], v1[2], v1[3]);
                *(u32x2_*)rowp = w; }
    }
};
struct EpiMerge {
    static constexpr bool PERM = true, AFTER_DRAIN = false, INPLACE = true;
    bf16_t* Mo; const unsigned char* Gt; int off0, off1, off2;
    __device__ __forceinline__ static void ub4(unsigned w, f32x4& v) { v = (f32x4){(float)(w & 0xffu), (float)((w >> 8) & 0xffu), (float)((w >> 16) & 0xffu), (float)(w >> 24)}; }
    __device__ __forceinline__ bool inplace(f32x4 (&acc)[2][2][4][2], const Unit& u, int wr, int wc, int fr, int fq) const {
        const int br = u.pn >> 2, pn = u.pn & 3, pm = u.pm - (br < 2 ? off0 + br * (off1 - off0) : off2);
        const int row0 = pm * BM + wr * 64 + fr, col0 = pn * BM + wc * 32 + 8 * fq;
        const int t = ((wr * 4 + wc) * 4 + fq) * 16 + fr;
        const unsigned char* gt = Gt + ((size_t)pm * 12 + br * 4 + pn) * (BM * BM) + (size_t)t * 16;
#pragma unroll
        for (int ai = 0; ai < 2; ++ai)
#pragma unroll
            for (int m = 0; m < 4; ++m) { const size_t row = (size_t)(row0 + ai * HALF + m * 16);
                const u32x4 gq = *(const u32x4*)(gt + (ai * 4 + m) * (512 * 16));
                if (br < 2) { const u32x4 nq = *(const u32x4*)(gt + 4 * (BM * BM) + (ai * 4 + m) * (512 * 16));
#pragma unroll
                    for (int bj = 0; bj < 2; ++bj) { f32x4 g0, g1, n0, n1; ub4(bj ? gq.z : gq.x, g0); ub4(bj ? gq.w : gq.y, g1); ub4(bj ? nq.z : nq.x, n0); ub4(bj ? nq.w : nq.y, n1);
#pragma unroll
                        for (int e = 0; e < 4; ++e) { g0[e] = g0[e] * __builtin_amdgcn_rcpf(n0[e]); g1[e] = g1[e] * __builtin_amdgcn_rcpf(n1[e]); }
                        acc[ai][bj][m][0] = acc[ai][bj][m][0] * g0; acc[ai][bj][m][1] = acc[ai][bj][m][1] * g1; }
                } else {
#pragma unroll
                    for (int bj = 0; bj < 2; ++bj) { f32x4 g0, g1; ub4(bj ? gq.z : gq.x, g0); ub4(bj ? gq.w : gq.y, g1);
                        *(u32x4*)(Mo + row * 1024 + col0 + bj * HALF) = pack8(acc[ai][bj][m][0] * (g0 * (1.0f / 255.0f)), acc[ai][bj][m][1] * (g1 * (1.0f / 255.0f))); }
                } }
        return br < 2;
    }
};
struct EpiQKV {
    static constexpr bool PERM = true, AFTER_DRAIN = false, INPLACE = false;
    bf16_t* O; const float* rope; int row_base; float qscale; float in_scale;
    __device__ __forceinline__ void operator()(const f32x4 (&acc)[2][2][4][2], const Unit& u, int wr, int wc, int fr, int fq) const {
        const int rowt = row_base + u.pm * BM;
        const bool latent = rowt < 65536;
        const int row0 = rowt + wr * 64 + fr, col0 = u.pn * BM + wc * 32 + 8 * fq;
#pragma unroll
        for (int bj = 0; bj < 2; ++bj) {
            const int cb = 2 * u.pn + bj;
            const bool do_rope = latent && (cb == 0 || (cb >= 10 && cb < 14));
            const float sc = (cb >= 10) ? qscale * in_scale : in_scale;
#pragma unroll
            for (int ai = 0; ai < 2; ++ai)
#pragma unroll
                for (int m = 0; m < 4; ++m) {
                    const int row = row0 + ai * HALF + m * 16;
                    f32x4 v0 = acc[ai][bj][m][0], v1 = acc[ai][bj][m][1];
                    if (do_rope) {
                        const int t = row & 2047, pos = (wc & 1) ? (t & 63) : (t >> 6);
                        const float* cp = rope + pos * 16 + 8 * (fq & 1);
                        const f32x4 c0 = *(const f32x4*)cp, c1 = *(const f32x4*)(cp + 4), s0 = *(const f32x4*)(cp + 1024), s1 = *(const f32x4*)(cp + 1028);
                        const float sg = (fq >= 2) ? 1.0f : -1.0f;
                        f32x4 o0, o1;
#pragma unroll
                        for (int e = 0; e < 4; ++e) { o0[e] = __shfl_xor(v0[e], 32); o1[e] = __shfl_xor(v1[e], 32); }
                        v0 = v0 * c0 + (o0 * sg) * s0; v1 = v1 * c1 + (o1 * sg) * s1;
                    }
                    v0 = v0 * sc; v1 = v1 * sc;
                    *(u32x4*)(O + (size_t)row * 2304 + col0 + bj * HALF) = pack8(v0, v1);
                }
        }
    }
};
__device__ __forceinline__ void tile_of(int L, int nM, int nN, int& pm, int& pn) {
    const int nwg = nM * nN; int wgid = L; { const int q = nwg / NXCD, r = nwg % NXCD, xcd = wgid % NXCD, off = wgid / NXCD; wgid = (xcd < r ? xcd * (q + 1) : r * (q + 1) + (xcd - r) * q) + off; }
    const int nig = WGM * nN, gid = wgid / nig, fm = gid * WGM, gsz = (nM - fm) < WGM ? (nM - fm) : WGM;
    pm = fm + ((wgid % nig) % gsz); pn = (wgid % nig) / gsz;
}
struct MergeOrder {
    int nM, G, c, off0, off1, off2;
    __device__ bool next(int i, Unit& u) const {
        const int t = i / 3, br = i - 3 * t; const long L = (long)t * G + c; if (L >= (long)nM * 4) return false;
        int pm, pn; tile_of((int)L, nM, 4, pm, pn); u.pm = (br < 2 ? off0 + br * (off1 - off0) : off2) + pm; u.pn = br * 4 + pn; return true;
    }
    __device__ __forceinline__ void a_ready(const Unit&) const {}
    __device__ __forceinline__ void done(const Unit&) const {}
};
struct GroupOrder {
    int nM, nN, G, c; int toff[9];
    __device__ bool next(int i, Unit& u) const {
        const long L = (long)i * G + c; if (L >= (long)nM * nN) return false;
        int pm, pn; tile_of((int)L, nM, nN, pm, pn); int e = 0;
#pragma unroll
        for (int k = 1; k < 8; ++k) e += (pm >= toff[k]) ? 1 : 0;
        u.pm = pm; u.pn = e * nN + pn; return true;
    }
    __device__ __forceinline__ void a_ready(const Unit&) const {}
    __device__ __forceinline__ void done(const Unit&) const {}
};
template <class Epi, class Sched, bool ALIGN_EPI = false, bool SP2 = false, bool F8 = false>
__device__ __forceinline__ void gemm_phase(PG8_LAS unsigned char* lds, const Gemm g, const Sched& S, const Epi& E, const int tid) {
    const int wid = __builtin_amdgcn_readfirstlane(tid >> 6), lane = tid & 63, wr = wid >> 2, wc = wid & 3, fr = lane & 15, fq = lane >> 4;
    const int K = g.K, nt = K / BK;
    unsigned voffA[2], voffB[2];
#pragma unroll
    for (int i = 0; i < 2; ++i) { int R, C; stage_rc(tid * 16 + i * 8192, R, C); const int Rb = Epi::PERM ? ((R & ~31) + perm32(R & 31)) : R;
        voffA[i] = (unsigned)(R * K + C) * 2u; voffB[i] = (unsigned)(Rb * K + C) * 2u; }
    const size_t kstep = (size_t)(BK * 2);
    const size_t hstep = (size_t)HALF * K * 2;
    const size_t tstep = 2 * hstep;
    const unsigned ldsw = (unsigned)wid * 1024u;
    const int aoff = lds_byte(wr * 64 + fr, fq * 8), boff = lds_byte(wc * 32 + fr, fq * 8);
#define PG8_SA(b, h) (((b) * 2 + (h)) * HTB)
#define PG8_SB(b, h) ((4 + (b) * 2 + (h)) * HTB)
#define PG8_STAGE(bufoff, gbase, voff) do { _Pragma("unroll") for (int _i = 0; _i < 2; ++_i) \
        __builtin_amdgcn_global_load_lds((const unsigned*)((const char*)(gbase) + (voff)[_i]), (PG8_LAS unsigned*)(lds + (bufoff) + ldsw + _i * 8192), 16, 0, 0); } while (0)
#define PG8_LDA(dst, b, h) do { _Pragma("unroll") for (int m = 0; m < 4; ++m) _Pragma("unroll") for (int k = 0; k < 2; ++k) dst[m][k] = *(const PG8_LAS bf16x8*)(lds + PG8_SA(b, h) + aoff + m * 2048 + k * 1024); } while (0)
#define PG8_LDB(dst, b, h) do { _Pragma("unroll") for (int n = 0; n < 2; ++n) _Pragma("unroll") for (int k = 0; k < 2; ++k) dst[n][k] = *(const PG8_LAS bf16x8*)(lds + PG8_SB(b, h) + boff + n * 2048 + k * 1024); } while (0)
#define PG8_MMA(ai, bj, At, Bt) do { __builtin_amdgcn_s_setprio(1); _Pragma("unroll") for (int m = 0; m < 4; ++m) _Pragma("unroll") for (int n = 0; n < 2; ++n) { \
        if constexpr (F8) { typedef int v8i_ __attribute__((ext_vector_type(8))); typedef int v4i_ __attribute__((ext_vector_type(4))); \
            const v4i_ b0_ = __builtin_bit_cast(v4i_, Bt[n][0]), b1_ = __builtin_bit_cast(v4i_, Bt[n][1]), a0_ = __builtin_bit_cast(v4i_, At[m][0]), a1_ = __builtin_bit_cast(v4i_, At[m][1]); \
            const v8i_ bb_ = __builtin_shufflevector(b0_, b1_, 0, 1, 2, 3, 4, 5, 6, 7), aa_ = __builtin_shufflevector(a0_, a1_, 0, 1, 2, 3, 4, 5, 6, 7); \
            asm volatile("v_mfma_scale_f32_16x16x128_f8f6f4 %0, %1, %2, %0, %3, %3 op_sel_hi:[0,0,0]" : "+v"(acc[ai][bj][m][n]) : "v"(bb_), "v"(aa_), "v"(f8_scale_)); } \
        else { _Pragma("unroll") for (int k = 0; k < 2; ++k) acc[ai][bj][m][n] = __builtin_amdgcn_mfma_f32_16x16x32_bf16(Bt[n][k], At[m][k], acc[ai][bj][m][n], 0, 0, 0); } } \
        __builtin_amdgcn_s_setprio(0); } while (0)
#define PG8_WAIT_V(n) asm volatile("s_waitcnt vmcnt(" #n ")" ::: "memory")
#define PG8_WAIT_L(n) asm volatile("s_waitcnt lgkmcnt(" #n ")" ::: "memory")
#define PG8_BAR __builtin_amdgcn_s_barrier()
#define PG8_SCHED __builtin_amdgcn_sched_barrier(0)
    int f8_scale_ = 0x7f7f7f7f; (void)f8_scale_;
    Unit cur, nxt; int ui = 0;
    if (!S.next(0, cur)) return;
    f32x4 acc[2][2][4][2];
#pragma unroll
    for (int a = 0; a < 2; ++a)
#pragma unroll
        for (int b = 0; b < 2; ++b)
#pragma unroll
            for (int m = 0; m < 4; ++m)
#pragma unroll
                for (int n = 0; n < 2; ++n) acc[a][b][m][n] = (f32x4){0.f, 0.f, 0.f, 0.f};
    bf16x8 At[4][2], B0[2][2], B1[2][2];
    const char* cA = (const char*)g.A + (size_t)cur.pm * tstep; const char* cB = (const char*)g.Bt + (size_t)cur.pn * tstep;
    S.a_ready(cur);
    if constexpr (SP2) {
        PG8_STAGE(PG8_SB(0, 0), cB, voffB); PG8_STAGE(PG8_SB(0, 1), cB + hstep, voffB); PG8_STAGE(PG8_SA(0, 0), cA, voffA); PG8_STAGE(PG8_SA(0, 1), cA + hstep, voffA);
        if (wr == 1) PG8_BAR;
        PG8_WAIT_V(2); PG8_BAR;
        PG8_STAGE(PG8_SB(1, 0), cB + kstep, voffB); PG8_STAGE(PG8_SA(1, 0), cA + kstep, voffA); PG8_STAGE(PG8_SB(1, 1), cB + hstep + kstep, voffB);
        PG8_WAIT_V(6); PG8_BAR;
    } else {
        PG8_STAGE(PG8_SB(0, 0), cB, voffB); PG8_STAGE(PG8_SA(0, 0), cA, voffA); PG8_STAGE(PG8_SB(0, 1), cB + hstep, voffB); PG8_STAGE(PG8_SA(0, 1), cA + hstep, voffA);
        if (wr == 1) PG8_BAR;
        PG8_WAIT_V(4); PG8_BAR;
        PG8_STAGE(PG8_SB(1, 0), cB + kstep, voffB); PG8_STAGE(PG8_SA(1, 0), cA + kstep, voffA); PG8_STAGE(PG8_SB(1, 1), cB + hstep + kstep, voffB);
        PG8_WAIT_V(6); PG8_BAR;
    }
    for (;;) {
        const bool has_next = S.next(ui + 1, nxt);
        const char* nA = has_next ? (const char*)g.A + (size_t)nxt.pm * tstep : cA; const char* nB = has_next ? (const char*)g.Bt + (size_t)nxt.pn * tstep : cB;
#pragma unroll 1
        for (int t = 0; t < nt; t += 2) {
            const bool last = (t == nt - 2);
            const char* a1 = cA + (size_t)(t + 1) * kstep;
            const char* a2 = last ? nA : cA + (size_t)(t + 2) * kstep; const char* b2 = last ? nB : cB + (size_t)(t + 2) * kstep;
            const char* a3 = a2 + kstep; const char* b3 = b2 + kstep;
            if (last && has_next) S.a_ready(nxt);
            if constexpr (SP2) {
            PG8_LDB(B0, 0, 0); PG8_LDB(B1, 0, 1); PG8_SCHED; PG8_LDA(At, 0, 0); PG8_STAGE(PG8_SA(1, 1), a1 + hstep, voffA);
            PG8_WAIT_V(8); PG8_WAIT_L(0); PG8_BAR; PG8_MMA(0, 0, At, B0); PG8_MMA(0, 1, At, B1); PG8_BAR; PG8_SCHED;
            PG8_LDA(At, 0, 1); PG8_STAGE(PG8_SB(0, 0), b2, voffB); PG8_STAGE(PG8_SB(0, 1), b2 + hstep, voffB); PG8_STAGE(PG8_SA(0, 0), a2, voffA);
            PG8_WAIT_V(8); PG8_WAIT_L(0); PG8_BAR; PG8_MMA(1, 0, At, B0); PG8_MMA(1, 1, At, B1); PG8_BAR; PG8_SCHED;
            PG8_LDB(B0, 1, 0); PG8_LDB(B1, 1, 1); PG8_SCHED; PG8_LDA(At, 1, 0); PG8_STAGE(PG8_SA(0, 1), a2 + hstep, voffA);
            PG8_WAIT_V(8); PG8_WAIT_L(0); PG8_BAR; PG8_MMA(0, 0, At, B0); PG8_MMA(0, 1, At, B1); PG8_BAR; PG8_SCHED;
            PG8_LDA(At, 1, 1); PG8_STAGE(PG8_SB(1, 0), b3, voffB); PG8_STAGE(PG8_SB(1, 1), b3 + hstep, voffB); PG8_STAGE(PG8_SA(1, 0), a3, voffA);
            PG8_WAIT_V(8); PG8_WAIT_L(0); PG8_BAR; PG8_MMA(1, 0, At, B0); PG8_MMA(1, 1, At, B1); PG8_BAR; PG8_SCHED;
            } else {
            PG8_LDB(B0, 0, 0); PG8_SCHED; PG8_LDA(At, 0, 0); PG8_STAGE(PG8_SA(1, 1), a1 + hstep, voffA);
            PG8_WAIT_L(8); PG8_BAR; PG8_WAIT_L(0); PG8_MMA(0, 0, At, B0); PG8_BAR; PG8_SCHED;
            PG8_LDB(B1, 0, 1); PG8_STAGE(PG8_SB(0, 0), b2, voffB);
            PG8_BAR; PG8_WAIT_L(0); PG8_MMA(0, 1, At, B1); PG8_BAR;
            PG8_LDA(At, 0, 1); PG8_STAGE(PG8_SA(0, 0), a2, voffA);
            PG8_BAR; PG8_WAIT_L(0); PG8_MMA(1, 0, At, B0); PG8_BAR; PG8_SCHED;
            PG8_STAGE(PG8_SB(0, 1), b2 + hstep, voffB);
            PG8_WAIT_V(6); PG8_BAR; PG8_MMA(1, 1, At, B1); PG8_BAR;
            PG8_LDB(B0, 1, 0); PG8_SCHED; PG8_LDA(At, 1, 0); PG8_STAGE(PG8_SA(0, 1), a2 + hstep, voffA);
            PG8_WAIT_L(8); PG8_BAR; PG8_WAIT_L(0); PG8_MMA(0, 0, At, B0); PG8_BAR; PG8_SCHED;
            PG8_LDB(B1, 1, 1); PG8_STAGE(PG8_SB(1, 0), b3, voffB);
            PG8_BAR; PG8_WAIT_L(0); PG8_MMA(0, 1, At, B1); PG8_BAR;
            PG8_LDA(At, 1, 1); PG8_STAGE(PG8_SA(1, 0), a3, voffA);
            PG8_BAR; PG8_WAIT_L(0); PG8_MMA(1, 0, At, B0); PG8_BAR; PG8_SCHED;
            PG8_STAGE(PG8_SB(1, 1), b3 + hstep, voffB);
            PG8_WAIT_V(6); PG8_BAR; PG8_MMA(1, 1, At, B1); PG8_BAR;
            }
        }
        if constexpr (ALIGN_EPI) { if (wr == 0) PG8_BAR; }
        if constexpr (F8) asm volatile("s_nop 15\n\ts_nop 15" ::: "memory");
        bool keep_acc = false;
        if constexpr (Epi::INPLACE) { keep_acc = E.inplace(acc, cur, wr, wc, fr, fq); S.done(cur); }
        else if constexpr (!Epi::AFTER_DRAIN) { E(acc, cur, wr, wc, fr, fq); S.done(cur); }
        if (!has_next) break;
        if (!keep_acc)
#pragma unroll
        for (int a = 0; a < 2; ++a)
#pragma unroll
            for (int b = 0; b < 2; ++b)
#pragma unroll
                for (int m = 0; m < 4; ++m)
#pragma unroll
                    for (int n = 0; n < 2; ++n) acc[a][b][m][n] = (f32x4){0.f, 0.f, 0.f, 0.f};
        cur = nxt; cA = nA; cB = nB; ++ui;
        if constexpr (ALIGN_EPI) { if (wr == 1) PG8_BAR; }
    }
    PG8_WAIT_V(0);
    if constexpr (!ALIGN_EPI) { if (wr == 0) PG8_BAR; }
    PG8_BAR;
    if constexpr (Epi::AFTER_DRAIN) { E.fused(acc, cur, wr, wc, fr, fq, lds, wid, lane); S.done(cur); }
#undef PG8_SA
#undef PG8_SB
#undef PG8_STAGE
#undef PG8_LDA
#undef PG8_LDB
#undef PG8_MMA
#undef PG8_WAIT_V
#undef PG8_WAIT_L
#undef PG8_BAR
#undef PG8_SCHED
}
}
#define GAS __attribute__((address_space(1)))
#define LAS __attribute__((address_space(3)))
typedef unsigned short bf16;
typedef unsigned v4u __attribute__((ext_vector_type(4)));
typedef float f32x4 __attribute__((ext_vector_type(4)));
typedef short bf16x8 __attribute__((ext_vector_type(8)));
typedef GAS unsigned gu32;
typedef GAS unsigned long long gu64;
#define RLX_AGENT __ATOMIC_RELAXED, __HIP_MEMORY_SCOPE_AGENT
#define LDS_WAIT() asm volatile("s_waitcnt lgkmcnt(0)" ::: "memory")
#define VM_WAIT() asm volatile("s_waitcnt vmcnt(0)" ::: "memory")
__device__ __forceinline__ unsigned long long rt() { return __builtin_amdgcn_s_memrealtime(); }
__device__ __forceinline__ unsigned f2bf(float f) { unsigned u = __builtin_bit_cast(unsigned, f); return (u + 0x7fffu + ((u >> 16) & 1u)) >> 16; }
__device__ __forceinline__ unsigned pk2(float lo, float hi) { return pg8::cvt_pk_bf16(lo, hi); }

#define XB_TMO      128
#define XB_XCNT(j)  (256  + 64 * (j))
#define XB_XSUB(j)  (1280 + 64 * (j))
#define XB_XGEN(j)  (2304 + 64 * (j))
#define XB_TOP      3328
#define XB_TOPGEN   3392
#define XCD_BAR_WORDS 3456
#define XB_SPIN_CAP (1u << 18)

__device__ __forceinline__ unsigned xb_ld(unsigned* p)              { return __hip_atomic_load(p, __ATOMIC_RELAXED, __HIP_MEMORY_SCOPE_AGENT); }
__device__ __forceinline__ unsigned xb_add(unsigned* p, unsigned v) { return __hip_atomic_fetch_add(p, v, __ATOMIC_RELAXED, __HIP_MEMORY_SCOPE_AGENT); }
__device__ __forceinline__ unsigned xb_xcc_id() { return (unsigned)__builtin_amdgcn_s_getreg((3 << 11) | 20) & 0xFu; }
#define XB_SPIN(cond, bar) do { unsigned _sp = 0; while (cond) { __builtin_amdgcn_s_sleep(1); \
    if ((++_sp & 255u) == 0u) { if (xb_ld(&(bar)[XB_TMO])) break; if (_sp > XB_SPIN_CAP) { atomicAdd(&(bar)[XB_TMO], 1u); break; } } } } while (0)

struct XcdBarrier {
    unsigned* bar; unsigned x;
    volatile LAS unsigned* st;
};

__device__ __forceinline__ XcdBarrier xcd_barrier_post(unsigned* bar, volatile LAS unsigned* st) {
    XcdBarrier b; b.bar = bar; b.x = xb_xcc_id(); b.st = st;
    if (threadIdx.x == 0) (void)xb_add(&bar[XB_XCNT(b.x)], 1u);
    return b;
}
__device__ __forceinline__ void xcd_barrier_complete(unsigned* bar, unsigned x, unsigned& nloc, unsigned& nx) {
    const unsigned G = gridDim.x * gridDim.y * gridDim.z;
    unsigned sum, cnt, mine, sp = 0u;
    for (;;) {
        sum = 0u; cnt = 0u; mine = 0u;
#pragma unroll
        for (unsigned j = 0; j < 16; ++j) { const unsigned c = xb_ld(&bar[XB_XCNT(j)]); sum += c; cnt += (c > 0u) ? 1u : 0u; mine = (j == x) ? c : mine; }
        if (sum == G) break;
        __builtin_amdgcn_s_sleep(1);
        if ((++sp & 255u) == 0u) { if (xb_ld(&bar[XB_TMO])) break; if (sp > XB_SPIN_CAP) { atomicAdd(&bar[XB_TMO], 1u); break; } }
    }
    nloc = mine > 0u ? mine : 1u; nx = cnt > 0u ? cnt : 1u;
}

__device__ __forceinline__ void xcd_barrier(const XcdBarrier& b) {
    asm volatile("s_waitcnt vmcnt(0)" ::: "memory");
    __syncthreads();
    if (threadIdx.x == 0) {
        unsigned* bar = b.bar;
        __builtin_amdgcn_s_waitcnt(0);
        unsigned nloc = b.st[0], nx = b.st[1];
        if (nloc == 0u) { xcd_barrier_complete(bar, b.x, nloc, nx); b.st[0] = nloc; b.st[1] = nx; }
        const unsigned old = xb_add(&bar[XB_XSUB(b.x)], 1u);
        const unsigned gen = old / nloc;
        if (old + 1u == (gen + 1u) * nloc) {
            __builtin_amdgcn_fence(__ATOMIC_RELEASE, "agent");
            asm volatile("s_waitcnt vmcnt(0)" ::: "memory");
            const unsigned og = xb_add(&bar[XB_TOP], 1u);
            const unsigned tg = og / nx;
            if (og + 1u == (tg + 1u) * nx) xb_add(&bar[XB_TOPGEN], 1u);
            else XB_SPIN(xb_ld(&bar[XB_TOPGEN]) == tg, bar);
            __builtin_amdgcn_fence(__ATOMIC_ACQUIRE, "agent");
            xb_add(&bar[XB_XGEN(b.x)], 1u);
            asm volatile("s_waitcnt vmcnt(0)" ::: "memory");
        } else {
            XB_SPIN(xb_ld(&bar[XB_XGEN(b.x)]) == gen, bar);
            __builtin_amdgcn_fence(__ATOMIC_ACQUIRE, "agent");
            asm volatile("s_waitcnt vmcnt(0)" ::: "memory");
        }
    }
    __syncthreads();
}

typedef float f32x16 __attribute__((ext_vector_type(16)));
typedef short s16x4 __attribute__((ext_vector_type(4)));
typedef unsigned v2u __attribute__((ext_vector_type(2)));
#define MFMA32(a, b, c) __builtin_amdgcn_mfma_f32_32x32x16_bf16((a), (b), (c), 0, 0, 0)

constexpr int NWAVES = 8, NTHREADS = 512;
constexpr int D = 1024, NB = 32, SEQ = 2048, LC = 256, NTOK = NB * SEQ, NCTX = NB * LC, NROW = NTOK + NCTX;
constexpr int INC = 6912, QKVC = 2304, CINC = 1536, GATEC = 3072, DFF = 2816, NEXP = 8, DFFE = 3584, FCH = 1792;
constexpr float W13_SCALE = 32.f, W2_SCALE = 64.f, HID_SCALE = 4.f;
constexpr float LOG2E = 1.4426950408889634f, QSCALE = 0.125f * LOG2E, EPS = 1e-6f;
constexpr int PCAP = 32768 * 2 + 8 * 256;

constexpr size_t MiB = 1u << 20;
constexpr size_t WS_CTL = 0, CTL_ZERO_BYTES = 1 * MiB;
constexpr size_t WS_MODV = 1 * MiB;
constexpr size_t WS_ROPE = 3 * MiB;
constexpr size_t WS_ROUTE = 4 * MiB;
constexpr size_t WS_LIST = 5 * MiB;
constexpr size_t WS_INV = 7 * MiB;
constexpr size_t WS_GF = 8 * MiB;
constexpr size_t WS_GFC = 24 * MiB;
constexpr size_t WS_W = 26 * MiB;
constexpr size_t W_IN = WS_W;
constexpr size_t W_CB = W_IN + (size_t)2 * INC * D;
constexpr size_t W_BR = W_IN + (size_t)2 * INC * D * 2;
constexpr size_t W_OUT = W_BR + (size_t)2 * 3 * D * 512 * 2;
constexpr size_t W_F13 = W_OUT + (size_t)2 * D * D * 2;
constexpr size_t W_F2 = W_F13 + (size_t)2 * DFF * D * 2;
constexpr size_t W_END = W_F2 + (size_t)D * DFF * 2;
constexpr size_t WS_CTXRES = 80 * MiB;
constexpr size_t WS_XB = 112 * MiB;
constexpr size_t WS_BIG = 256 * MiB;
constexpr size_t BIG_CINT = WS_BIG;
constexpr size_t BIG_QKV = WS_BIG + 216 * MiB;
constexpr size_t BIG_GATE = WS_BIG + 72 * MiB;
constexpr size_t BIG_YCT = WS_BIG + 288 * MiB;
constexpr size_t BIG_HID = WS_BIG;
constexpr size_t BIG_RAW = WS_BIG;
constexpr size_t BIG_AS = WS_BIG;
constexpr size_t BIG_MH = WS_BIG + 68 * MiB;
constexpr size_t BIG_Y2S = WS_BIG + 300 * MiB;
constexpr size_t WS_Y3 = 796 * MiB;
constexpr size_t WM_13 = WS_Y3;
constexpr size_t WM_2 = WS_Y3 + 56 * MiB;
constexpr size_t WS_H8 = WS_Y3 + 144 * MiB;
constexpr size_t WS_END = 1012 * MiB;
static_assert(W_END <= WS_CTXRES && BIG_Y2S + (size_t)PCAP * D * 2 <= WS_Y3 && BIG_QKV + (size_t)NROW * QKVC * 2 <= WS_Y3 && BIG_GATE + (size_t)NROW * GATEC <= WS_Y3, "ws map");
static_assert(BIG_MH + (size_t)PCAP * DFFE <= BIG_Y2S && BIG_AS + (size_t)PCAP * D <= BIG_MH && WM_13 + (size_t)8 * 2 * DFFE * D <= WM_2 && WM_2 + (size_t)8 * D * DFFE <= WS_END, "ws map 2");

constexpr int CW_BAR = 4096;
constexpr int CW_CNT = 16384;

constexpr int LDS_BYTES = 150528, MISC_OFF = 147456;


struct Args {
    const float* in[31];
    float* out; unsigned char* ws;
    int ph_lo, ph_hi, sub_mask, pad;
};
enum { I_X = 0, I_C, I_CTX, I_CCTX, I_WMOD, I_BMOD, I_GMIXPRE, I_GMIXPOST, I_GFFNPRE, I_GFFNPOST, I_WIN, I_SINK, I_RPB, I_CONVW, I_CONVB, I_HW1, I_HB1, I_HW2, I_HB2, I_HW3,
       I_HFREQ, I_HBIAS, I_WBR, I_WOUT, I_FW1, I_FW3, I_FW2, I_ROUTER, I_MW1, I_MW3, I_MW2 };

struct Frame {
    LAS unsigned char* lds;
    int tid, lane, wave, vcu, G;
    unsigned char* ws;
    bf16* hb;
};

__device__ __forceinline__ float wave_sum(float v) {
#pragma unroll
    for (int o = 1; o < 64; o <<= 1) v += __shfl_xor(v, o);
    return v;
}
__device__ __forceinline__ float bf2f(bf16 b) { return __builtin_bit_cast(float, ((unsigned)b) << 16); }
__device__ __forceinline__ float silu_f(float x) { return x / (1.0f + __expf(-x)); }

__device__ __forceinline__ void transpose_item(const float* W, int N, bf16* WT, int Kp, int k0, int n0, int drow0, LAS float* scr, int lane) {
    { const int c4 = 4 * (lane & 7);
#pragma unroll
      for (int i = 0; i < 8; ++i) { const int kk = (lane >> 3) + 8 * i; const f32x4 v = *(const f32x4*)(W + (size_t)(k0 + kk) * N + n0 + c4); LAS float* d = scr + kk * 33 + c4; d[0] = v.x; d[1] = v.y; d[2] = v.z; d[3] = v.w; } }
    LDS_WAIT(); asm volatile("" ::: "memory");
    const int c = lane & 7;
#pragma unroll
    for (int j = 0; j < 4; ++j) { const int n = (lane >> 3) + 8 * j; const LAS float* s = scr + (8 * c) * 33 + n;
        v4u o; o.x = pk2(s[0 * 33], s[1 * 33]); o.y = pk2(s[2 * 33], s[3 * 33]); o.z = pk2(s[4 * 33], s[5 * 33]); o.w = pk2(s[6 * 33], s[7 * 33]);
        *(GAS v4u*)(WT + (size_t)(drow0 + n) * Kp + k0 + 8 * c) = o; }
    LDS_WAIT(); asm volatile("" ::: "memory");
}
__device__ __forceinline__ bool conv_job(int& r, const float* W, int K, int N, bf16* WT, int Kp, int rowoff, int mode, int which, LAS float* scr, int lane) {
    const int nblk = N / 32, items = (K / 64) * nblk;
    if (r >= items) { r -= items; return false; }
    const int kb = r / nblk, nb = r % nblk, n0 = 32 * nb;
    const int drow0 = mode ? rowoff + (n0 / 128) * 256 + which * 128 + (n0 % 128) : rowoff + n0;
    transpose_item(W, N, WT, Kp, 64 * kb, n0, drow0, scr, lane);
    return true;
}

__device__ __forceinline__ void transpose_item_f8(const float* W, int N, unsigned char* WT, int Kp, int k0, int n0, int drow0, float scale, LAS float* scr, int lane) {
    { const int c4 = 4 * (lane & 7);
#pragma unroll
      for (int i = 0; i < 8; ++i) { const int kk = (lane >> 3) + 8 * i; const f32x4 v = *(const f32x4*)(W + (size_t)(k0 + kk) * N + n0 + c4) * scale; LAS float* d = scr + kk * 33 + c4; d[0] = v.x; d[1] = v.y; d[2] = v.z; d[3] = v.w; } }
    LDS_WAIT(); asm volatile("" ::: "memory");
    const int c = lane & 7;
#pragma unroll
    for (int j = 0; j < 4; ++j) { const int n = (lane >> 3) + 8 * j; const LAS float* s = scr + (8 * c) * 33 + n;
        v2u o; o.x = pg8::pack_fp8x4(s[0 * 33], s[1 * 33], s[2 * 33], s[3 * 33]); o.y = pg8::pack_fp8x4(s[4 * 33], s[5 * 33], s[6 * 33], s[7 * 33]);
        *(GAS v2u*)(WT + (size_t)(drow0 + n) * Kp + k0 + 8 * c) = o; }
    LDS_WAIT(); asm volatile("" ::: "memory");
}
__device__ __forceinline__ bool conv_job_f8(int& r, const float* W, int K, int N, unsigned char* WT, int Kp, int mode, int which, float scale, LAS float* scr, int lane) {
    const int nblk = N / 32, items = (K / 64) * nblk;
    if (r >= items) { r -= items; return false; }
    const int kb = r / nblk, nb = r % nblk, n0 = 32 * nb;
    const int drow0 = mode ? (n0 / 128) * 256 + which * 128 + (n0 % 128) : n0;
    transpose_item_f8(W, N, WT, Kp, 64 * kb, n0, drow0, scale, scr, lane);
    return true;
}

__device__ __forceinline__ void ld_row_f32(const float* p, int lane, f32x4 (&v)[4]) {
    const GAS f32x4* q = (const GAS f32x4*)p + lane;
#pragma unroll
    for (int j = 0; j < 4; ++j) v[j] = q[64 * j];
}
__device__ __forceinline__ void st_row_f32(float* p, int lane, const f32x4 (&v)[4]) {
    GAS f32x4* q = (GAS f32x4*)p + lane;
#pragma unroll
    for (int j = 0; j < 4; ++j) q[64 * j] = v[j];
}
__device__ __forceinline__ void ld_row_bf16(const bf16* p, int lane, f32x4 (&v)[4]) {
    const GAS v2u* q = (const GAS v2u*)p + lane;
#pragma unroll
    for (int j = 0; j < 4; ++j) { const v2u w = q[64 * j]; v[j] = (f32x4){pg8::bf_lo(w.x), pg8::bf_hi(w.x), pg8::bf_lo(w.y), pg8::bf_hi(w.y)}; }
}
__device__ __forceinline__ void ld_row_f32_nt(const float* p, int lane, f32x4 (&v)[4]) {
    const GAS f32x4* q = (const GAS f32x4*)p + lane;
#pragma unroll
    for (int j = 0; j < 4; ++j) v[j] = __builtin_nontemporal_load(q + 64 * j);
}
__device__ __forceinline__ void st_row_f32_nt(float* p, int lane, const f32x4 (&v)[4]) {
    GAS f32x4* q = (GAS f32x4*)p + lane;
#pragma unroll
    for (int j = 0; j < 4; ++j) __builtin_nontemporal_store(v[j], q + 64 * j);
}
__device__ __forceinline__ void ld_raw_bf16_nt(const bf16* p, int lane, v2u (&v)[4]) {
    const GAS v2u* q = (const GAS v2u*)p + lane;
#pragma unroll
    for (int j = 0; j < 4; ++j) v[j] = __builtin_nontemporal_load(q + 64 * j);
}
__device__ __forceinline__ void ld_raw_bf16(const bf16* p, int lane, v2u (&v)[4]) {
    const GAS v2u* q = (const GAS v2u*)p + lane;
#pragma unroll
    for (int j = 0; j < 4; ++j) v[j] = q[64 * j];
}
__device__ __forceinline__ f32x4 cvt_raw_bf16(v2u w) { return (f32x4){pg8::bf_lo(w.x), pg8::bf_hi(w.x), pg8::bf_lo(w.y), pg8::bf_hi(w.y)}; }
__device__ __forceinline__ void st_row_bf16(bf16* p, int lane, const f32x4 (&v)[4]) {
    GAS v2u* q = (GAS v2u*)p + lane;
#pragma unroll
    for (int j = 0; j < 4; ++j) { v2u w; w.x = pk2(v[j].x, v[j].y); w.y = pk2(v[j].z, v[j].w); q[64 * j] = w; }
}
__device__ __forceinline__ float row_rms_scale(const f32x4 (&v)[4]) {
    float s = 0.f;
#pragma unroll
    for (int j = 0; j < 4; ++j) s += (v[j].x * v[j].x + v[j].y * v[j].y) + (v[j].z * v[j].z + v[j].w * v[j].w);
    return __builtin_amdgcn_rsqf(wave_sum(s) * (1.0f / D) + EPS);
}
__device__ __forceinline__ void norm_mod(const f32x4 (&x)[4], const float* g, const float* sc, const float* sh, int lane, f32x4 (&h)[4]) {
    const float rs = row_rms_scale(x);
    f32x4 gv[4], scv[4], shv[4]; ld_row_f32(g, lane, gv); ld_row_f32(sc, lane, scv); ld_row_f32(sh, lane, shv);
#pragma unroll
    for (int j = 0; j < 4; ++j) h[j] = (x[j] * rs) * gv[j] * (scv[j] + 1.0f) + shv[j];
}
__device__ __forceinline__ void resid_update(f32x4 (&x)[4], const f32x4 (&y)[4], const float* g, const float* gt, int lane) {
    const float rs = row_rms_scale(y);
    f32x4 gv[4], gtv[4]; ld_row_f32(g, lane, gv); ld_row_f32(gt, lane, gtv);
#pragma unroll
    for (int j = 0; j < 4; ++j) x[j] = x[j] + gtv[j] * ((y[j] * rs) * gv[j]);
}
__device__ __forceinline__ const float* modv(const Frame& F, int l, int row, int part) {
    const int r = row < NTOK ? (row >> 11) : 32;
    return (const float*)(F.ws + WS_MODV) + ((size_t)l * 33 + r) * 6144 + part * 1024;
}

__device__ __forceinline__ void p0_prologue(Frame& F, const Args& a) {
    const int gw = F.vcu * NWAVES + F.wave, NGW = F.G * NWAVES;
    if (F.vcu < 192) {
        LAS float* sl = (LAS float*)F.lds;
        for (int i = F.tid; i < 33 * 1024; i += NTHREADS) { const int r = i >> 10, k = i & 1023; const float cv = r < 32 ? a.in[I_C][r * 1024 + k] : a.in[I_CCTX][k]; sl[k * 33 + r] = silu_f(cv); }
        __syncthreads();
        const int col = F.vcu * 64 + F.lane, l = col / 6144, n = col % 6144, k0 = F.wave * 128;
        const float* w = a.in[I_WMOD] + ((size_t)l * 1024 + k0) * 6144 + n;
        float acc[33];
#pragma unroll
        for (int r = 0; r < 33; ++r) acc[r] = 0.f;
#pragma unroll 4
        for (int k = 0; k < 128; ++k) { const float wv = w[(size_t)k * 6144]; const LAS float* sr = sl + (k0 + k) * 33;
#pragma unroll
            for (int r = 0; r < 33; ++r) acc[r] += sr[r] * wv; }
        __syncthreads();
#pragma unroll
        for (int r = 0; r < 33; ++r) sl[(F.wave * 33 + r) * 64 + F.lane] = acc[r];
        __syncthreads();
        const float* bmod = a.in[I_BMOD]; float* mo = (float*)(F.ws + WS_MODV);
        for (int o = F.tid; o < 33 * 64; o += NTHREADS) { const int r = o >> 6, j = o & 63; float s = 0.f;
#pragma unroll
            for (int wv = 0; wv < 8; ++wv) s += sl[(wv * 33 + r) * 64 + j];
            const int cc = F.vcu * 64 + j, ll = cc / 6144, nn = cc % 6144; mo[((size_t)ll * 33 + r) * 6144 + nn] = s + bmod[ll * 6144 + nn]; }
        __syncthreads();
    }
    if (F.vcu == 200) {
        float* rp = (float*)(F.ws + WS_ROPE);
        for (int i = F.tid; i < 1024; i += NTHREADS) { const int pos = i >> 4, k = i & 15; const float inv = powf(10000.0f, -(float)k / 16.0f); const float ang = (float)pos * inv; rp[i] = cosf(ang); rp[1024 + i] = sinf(ang); }
    }
    for (int it = F.vcu; it < 512; it += F.G) {
        const int lv = it >> 8, l = lv ? 0 : ((it >> 7) & 1), L = lv ? LC : SEQ, pos0 = lv ? (it & 255) : 16 * (it & 127), npos = lv ? 1 : 16;
        LAS float* z = (LAS float*)F.lds; LAS float* h1 = z + 16 * 33; LAS float* h2 = h1 + 16 * 64;
        __syncthreads();
        for (int i = F.tid; i < 16 * 33; i += NTHREADS) { const int p = i / 33, k = i % 33; const int pos = pos0 + p; float v;
            const float om = 6.283185307179586f * (float)pos / (float)L;
            if (k == 0) v = (float)pos / (float)(L - 1);
            else { const int m = (k - 1) & 15; const float f = 1e-4f + (15.0f - 1e-4f) * (float)m / 15.0f; v = (k <= 16) ? cosf(f * om) : -sinf(f * om); }
            z[i] = v; }
        __syncthreads();
        const float* w1 = a.in[I_HW1] + l * 33 * 64; const float* b1 = a.in[I_HB1] + l * 64; const float* w2 = a.in[I_HW2] + l * 64 * 64; const float* b2 = a.in[I_HB2] + l * 64;
        const float* fr = a.in[I_HFREQ] + l * 64; const float* w3 = a.in[I_HW3] + (size_t)l * 64 * 2048;
        for (int o = F.tid; o < 1024; o += NTHREADS) { const int p = o >> 6, j = o & 63; float s = b1[j];
            for (int k = 0; k < 33; ++k) s += z[p * 33 + k] * w1[k * 64 + j];
            h1[o] = sinf(fr[j] * s); }
        __syncthreads();
        for (int o = F.tid; o < 1024; o += NTHREADS) { const int p = o >> 6, j = o & 63; float s = b2[j];
            for (int k = 0; k < 64; ++k) s += h1[p * 64 + k] * w2[k * 64 + j];
            h2[o] = sinf(fr[j] * s); }
        __syncthreads();
        float* raw = (float*)(F.ws + BIG_RAW) + (size_t)l * (2048 * (SEQ + LC)) + (lv ? (size_t)2048 * SEQ : 0);
        {
            const int col0 = 4 * F.tid;
            float acc[4][16];
#pragma unroll
            for (int c4 = 0; c4 < 4; ++c4)
#pragma unroll
                for (int p = 0; p < 16; ++p) acc[c4][p] = 0.f;
#pragma unroll 4
            for (int k = 0; k < 64; ++k) { const f32x4 wv = *(const f32x4*)(w3 + k * 2048 + col0);
#pragma unroll
                for (int p = 0; p < 16; ++p) { const float hv = h2[p * 64 + k]; acc[0][p] += hv * wv.x; acc[1][p] += hv * wv.y; acc[2][p] += hv * wv.z; acc[3][p] += hv * wv.w; } }
            const float da = -3.0701134573253945f, db = -15.350567286626973f;
#pragma unroll
            for (int c4 = 0; c4 < 4; ++c4) { const int col = col0 + c4, cch = col & 511;
                const float delta = fabsf(da + (db - da) * (float)cch / 511.0f);
#pragma unroll
                for (int p = 0; p < 16; ++p) if (p < npos) { const float t = (float)(pos0 + p) / (float)(L - 1); raw[(size_t)col * L + pos0 + p] = acc[c4][p] * __expf(-t * delta); } }
        }
    }
    __syncthreads();
    LAS float* scr = (LAS float*)(F.lds + F.wave * 16384);
    constexpr int PER_LAYER = 16 * 216 + 16 * 48 + 3 * 256 + 512, NITEMS = 2 * PER_LAYER + 3 * 1408;
    for (int it = gw; it < NITEMS; it += NGW) {
        int r = it;
        bool dn = false;
#pragma unroll 1
        for (int l = 0; l < 2; ++l) {
            if (!dn) dn = conv_job_f8(r, a.in[I_WIN] + (size_t)l * D * INC, D, INC, F.ws + W_IN + (size_t)l * INC * D, D, 0, 0, W13_SCALE, scr, F.lane);
            if (!dn) { const int items = 16 * 48;
                if (r < items) { const int kb = r / 48, nb = r % 48; transpose_item(a.in[I_WIN] + (size_t)l * D * INC + QKVC, INC, (bf16*)(F.ws + W_CB) + (size_t)l * CINC * D, D, 64 * kb, 32 * nb, 32 * nb, scr, F.lane); dn = true; } else r -= items; }
#pragma unroll 1
            for (int br = 0; br < 3; ++br)
                if (!dn) dn = conv_job(r, a.in[I_WBR] + (size_t)(l * 3 + br) * 512 * D, 512, D, (bf16*)(F.ws + W_BR) + (size_t)(l * 3 + br) * D * 512, 512, 0, 0, 0, scr, F.lane);
            if (!dn) dn = conv_job(r, a.in[I_WOUT] + (size_t)l * D * D, D, D, (bf16*)(F.ws + W_OUT) + (size_t)l * D * D, D, 0, 0, 0, scr, F.lane);
        }
        if (!dn) dn = conv_job(r, a.in[I_FW1], D, DFF, (bf16*)(F.ws + W_F13), D, 0, 1, 0, scr, F.lane);
        if (!dn) dn = conv_job(r, a.in[I_FW3], D, DFF, (bf16*)(F.ws + W_F13), D, 0, 1, 1, scr, F.lane);
        if (!dn) dn = conv_job(r, a.in[I_FW2], DFF, D, (bf16*)(F.ws + W_F2), DFF, 0, 0, 0, scr, F.lane);
    }
}

__device__ __forceinline__ void p1_phase(Frame& F, const Args& a) {
    const int gw = F.vcu * NWAVES + F.wave, NGW = F.G * NWAVES;
    for (int u = gw; u < 2 * 2 * 1024; u += NGW) {
        const int l = u >> 11, lv = (u >> 10) & 1, o = (u >> 9) & 1, c = u & 511, L = lv ? LC : SEQ;
        if (l == 1 && lv == 1) continue;
        const float* raw = (const float*)(F.ws + BIG_RAW) + (size_t)l * (2048 * (SEQ + LC)) + (lv ? (size_t)2048 * SEQ : 0);
        const float* rf = raw + (size_t)(o * 512 + c) * L; const float* rb = raw + (size_t)(1024 + o * 512 + c) * L;
        float sf = 0.f, sb = 0.f;
        for (int t = F.lane; t < L; t += 64) { const float x = rf[t], y = rb[t]; sf += x * x; sb += y * y; }
        const float nf = 1.0f / sqrtf(wave_sum(sf) + EPS), nb = 1.0f / sqrtf(wave_sum(sb) + EPS);
        bf16* g = lv ? (bf16*)(F.ws + WS_GFC) + ((size_t)(l * 2 + o) * 512 + c) * (2 * LC) : (bf16*)(F.ws + WS_GF) + ((size_t)(l * 2 + o) * 512 + c) * (2 * SEQ);
        for (int i = F.lane; i < 2 * L; i += 64) { const int d = i - L; float v;
            if (i == 0) v = 0.f; else if (d > 0) v = rf[d] * nf; else if (d < 0) v = rb[-d] * nb; else v = rf[0] * nf + rb[0] * nb;
            g[i] = (bf16)f2bf(v); }
    }
}

constexpr float ATT_THR = 8.0f;
constexpr int ATT_KP = 144, ATT_VP = 136;
constexpr int ATT_K_OFF = 0, ATT_V_OFF = 64 * ATT_KP, ATT_BUF = 17920, ATT_RPB_OFF = 36864;
constexpr int ATT_T0_BYTES = 15 * 128 * 4, ATT_E_OFF = ATT_RPB_OFF + ATT_T0_BYTES, ATT_TBL_FLOATS = 15 * 128 + 15 * 15 * 64;
__device__ __forceinline__ int crow(int reg, int h) { return (reg & 3) + 8 * (reg >> 2) + 4 * h; }
__device__ __forceinline__ int rs_of(int r) { const int v = r - 4; return v < 0 ? 0 : (v > 24 ? 24 : v); }
__device__ __forceinline__ unsigned cvtpk(float lo, float hi) { return pk2(lo, hi); }

template <int MODE, int SUB>
__device__ __forceinline__ void att_tile(LAS unsigned char* lds, int boff, const bf16x8 (&qf)[4], f32x16& negm, f32x16& O0, f32x16& O1, float& m_run, float& l_run,
                                         bool is_local, bool edge_mask, int kbase, int qt, int kr, int gr, int tb_base, int tb_pitch, int r, int h) {
#define A0(i) (SUB != 2 || (i) >= 12)
#define A1(i) (SUB != 1 || (i) < 4)
    f32x16 s0 = negm, s1 = negm;
#pragma unroll
    for (int s = 0; s < 4; ++s) {
        const bf16x8 k0 = *(const LAS bf16x8*)(lds + boff + ATT_K_OFF + r * ATT_KP + (16 * s + 8 * h) * 2);
        const bf16x8 k1 = *(const LAS bf16x8*)(lds + boff + ATT_K_OFF + (32 + r) * ATT_KP + (16 * s + 8 * h) * 2);
        s0 = MFMA32(k0, qf[s], s0); s1 = MFMA32(k1, qf[s], s1);
    }
    if (MODE == 0 && edge_mask) {
#pragma unroll
        for (int i = 0; i < 16; ++i) { const int j0 = kbase + crow(i, h), d0 = qt - j0, d1 = d0 - 32;
            if (d0 > 128 || d0 < -128) s0[i] = -1e30f;
            if (d1 > 128 || d1 < -128) s1[i] = -1e30f; }
    }
    if (MODE == 1 && is_local) {
        const LAS float* tb = (const LAS float*)(lds + tb_base + (kr - gr + 7) * tb_pitch);
        float b0[16], b1[16];
#pragma unroll
        for (int i = 0; i < 16; ++i) { const int c = (i & 3) + 8 * (i >> 2); b0[i] = tb[c]; b1[i] = tb[c + 32]; }
#pragma unroll
        for (int i = 0; i < 16; ++i) { s0[i] += b0[i]; s1[i] += b1[i]; }
    }
    float mx = -1e30f;
#pragma unroll
    for (int i = 0; i < 16; ++i) { if (A0(i)) mx = fmaxf(mx, s0[i]); if (A1(i)) mx = fmaxf(mx, s1[i]); }
    mx = fmaxf(mx, __shfl_xor(mx, 32));
    if (!__all(mx <= ATT_THR)) {
        const float delta = fmaxf(mx, 0.f), alpha = __builtin_amdgcn_exp2f(-delta);
        m_run += delta; l_run *= alpha;
#pragma unroll
        for (int i = 0; i < 16; ++i) { O0[i] *= alpha; O1[i] *= alpha; s0[i] -= delta; s1[i] -= delta; negm[i] = -m_run; }
    }
    float ls = 0.f;
#pragma unroll
    for (int i = 0; i < 16; ++i) { if (A0(i)) { s0[i] = __builtin_amdgcn_exp2f(s0[i]); ls += s0[i]; } else s0[i] = 0.f;
                                   if (A1(i)) { s1[i] = __builtin_amdgcn_exp2f(s1[i]); ls += s1[i]; } else s1[i] = 0.f; }
    l_run += ls;
    bf16x8 pf[2][2];
    { v4u t;
      t.x = cvtpk(s0[0], s0[1]); t.y = cvtpk(s0[2], s0[3]); t.z = cvtpk(s0[4], s0[5]); t.w = cvtpk(s0[6], s0[7]); pf[0][0] = __builtin_bit_cast(bf16x8, t);
      t.x = cvtpk(s0[8], s0[9]); t.y = cvtpk(s0[10], s0[11]); t.z = cvtpk(s0[12], s0[13]); t.w = cvtpk(s0[14], s0[15]); pf[0][1] = __builtin_bit_cast(bf16x8, t);
      t.x = cvtpk(s1[0], s1[1]); t.y = cvtpk(s1[2], s1[3]); t.z = cvtpk(s1[4], s1[5]); t.w = cvtpk(s1[6], s1[7]); pf[1][0] = __builtin_bit_cast(bf16x8, t);
      t.x = cvtpk(s1[8], s1[9]); t.y = cvtpk(s1[10], s1[11]); t.z = cvtpk(s1[12], s1[13]); t.w = cvtpk(s1[14], s1[15]); pf[1][1] = __builtin_bit_cast(bf16x8, t); }
#pragma unroll
    for (int i = 0; i < 2; ++i)
#pragma unroll
        for (int sp = 0; sp < 2; ++sp) {
            if ((SUB == 1 && i == 1 && sp == 1) || (SUB == 2 && i == 0 && sp == 0)) continue;
            const int koff = (32 * i + 16 * sp + 4 * h) * 2;
            const v2u a0 = *(const LAS v2u*)(lds + boff + ATT_V_OFF + r * ATT_VP + koff), a1 = *(const LAS v2u*)(lds + boff + ATT_V_OFF + r * ATT_VP + koff + 16);
            const v2u c0 = *(const LAS v2u*)(lds + boff + ATT_V_OFF + (32 + r) * ATT_VP + koff), c1 = *(const LAS v2u*)(lds + boff + ATT_V_OFF + (32 + r) * ATT_VP + koff + 16);
            const v4u va = (v4u){a0.x, a0.y, a1.x, a1.y}, vc = (v4u){c0.x, c0.y, c1.x, c1.y};
            O0 = MFMA32(__builtin_bit_cast(bf16x8, va), pf[i][sp], O0);
            O1 = MFMA32(__builtin_bit_cast(bf16x8, vc), pf[i][sp], O1);
        }
#undef A0
#undef A1
}

struct AttPre { v4u k, v; int valid; };
template <int MODE>
__device__ __forceinline__ void att_start(int u, int w, int r, int& qrow, int& qcol, int& kcol, int& vcol, int& trow0) {
    int b, head, kvh, q0 = 0, R = 0;
    if (MODE == 0) { b = u >> 6; kvh = (u >> 5) & 1; q0 = (u & 31) * 64; head = 4 * kvh + (w >> 1); }
    else if (MODE == 1) { b = u >> 6; head = (u >> 3) & 7; kvh = head; R = u & 7; }
    else if (MODE == 2) { b = u >> 3; kvh = (u >> 2) & 1; q0 = (u & 3) * 64; head = 4 * kvh + (w >> 1); }
    else { b = u >> 3; head = u & 7; kvh = head; }
    if (MODE == 0) qrow = b * SEQ + q0 + 32 * (w & 1) + r;
    else if (MODE == 1) qrow = b * SEQ + (4 * R + (w >> 1)) * 64 + 32 * (w & 1) + r;
    else if (MODE == 2) qrow = NTOK + b * LC + q0 + 32 * (w & 1) + r;
    else qrow = NTOK + b * LC + 32 * w + r;
    qcol = (MODE == 0 || MODE == 2) ? 1280 + head * 64 : 1792 + head * 64;
    kcol = (MODE == 0 || MODE == 2) ? kvh * 64 : 256 + head * 64;
    vcol = (MODE == 0 || MODE == 2) ? 128 + kvh * 64 : 768 + head * 64;
    if (MODE == 0) { const int lo = q0 < 128 ? (128 - q0) / 64 : 0; trow0 = b * SEQ + q0 - 128 + 64 * lo; }
    else if (MODE == 1) trow0 = b * SEQ + rs_of(4 * R) * 64;
    else trow0 = NTOK + b * LC;
}
template <int MODE>
__device__ __forceinline__ void attn_unit(Frame& F, int u, int u_next, const bf16* __restrict__ QKV, bf16* __restrict__ Yo, const float* sink, const float* rpb, AttPre& P, int& tbl_head, int var = 0) {
    const int w = F.wave, lane = F.lane, r = lane & 31, h = lane >> 5;
    LAS unsigned char* lds = F.lds;
    int b, head, kvh, q0 = 0, R = 0;
    if (MODE == 0) { b = u >> 6; kvh = (u >> 5) & 1; q0 = (u & 31) * 64; head = 4 * kvh + (w >> 1); }
    else if (MODE == 1) { b = u >> 6; head = (u >> 3) & 7; kvh = head; R = u & 7; }
    else if (MODE == 2) { b = u >> 3; kvh = (u >> 2) & 1; q0 = (u & 3) * 64; head = 4 * kvh + (w >> 1); }
    else { b = u >> 3; head = u & 7; kvh = head; }
    int qt, qrow, gr = 0, qc = 0;
    if (MODE == 0) { qt = q0 + 32 * (w & 1) + r; qrow = b * SEQ + qt; }
    else if (MODE == 1) { gr = 4 * R + (w >> 1); qc = 32 * (w & 1) + r; qt = gr * 64 + qc; qrow = b * SEQ + qt; }
    else if (MODE == 2) { qt = q0 + 32 * (w & 1) + r; qrow = NTOK + b * LC + qt; }
    else { qt = 32 * w + r; qrow = NTOK + b * LC + qt; }
    const int qcol = (MODE == 0 || MODE == 2) ? 1280 + head * 64 : 1792 + head * 64;
    const int kcol = (MODE == 0 || MODE == 2) ? kvh * 64 : 256 + head * 64;
    const int vcol = (MODE == 0 || MODE == 2) ? 128 + kvh * 64 : 768 + head * 64;
    bf16x8 qf[4];
#pragma unroll
    for (int s = 0; s < 4; ++s) qf[s] = *(const bf16x8*)(QKV + (size_t)qrow * QKVC + qcol + 16 * s + 8 * h);
    f32x16 O0, O1;
#pragma unroll
    for (int i = 0; i < 16; ++i) { O0[i] = 0.f; O1[i] = 0.f; }
    float m_run, l_run;
    if (MODE == 0 || MODE == 2) { m_run = sink[head] * LOG2E; l_run = (h == 0) ? 1.0f : 0.0f; } else { m_run = 0.f; l_run = 0.f; }
    f32x16 negm;
#pragma unroll
    for (int i = 0; i < 16; ++i) negm[i] = -m_run;
    int lo = 0, ntl = 0, kr_lo = 0;
    if (MODE == 0) { lo = q0 < 128 ? (128 - q0) / 64 : 0; const int hi = (SEQ - q0 + 128) / 64 < 5 ? (SEQ - q0 + 128) / 64 : 5; ntl = hi - lo; }
    if (MODE == 1) { kr_lo = rs_of(4 * R); ntl = rs_of(4 * R + 3) + 8 - kr_lo; }
    const int my_rs = rs_of(gr), my_cs = (qc - 8) < 0 ? 0 : ((qc - 8) > 48 ? 48 : (qc - 8));
    const int ntiles = ntl + 4;
    int tb_base = 0, tb_pitch = 0;
    if (MODE == 1) { const bool edge = qc < 8 || qc > 56; const int ev = qc < 8 ? qc : qc - 49;
        tb_base = edge ? ATT_E_OFF + ev * (15 * 256) + 16 * h : ATT_RPB_OFF + 4 * (63 - qc + 4 * h); tb_pitch = edge ? 256 : 512; }
    const int skey = F.tid >> 3, sch = F.tid & 7, vkey = F.tid & 63, vch = F.tid >> 6;
#define ATT_TROW(tt) ((tt) < ntl ? (MODE == 0 ? b * SEQ + q0 - 128 + 64 * (lo + (tt)) : b * SEQ + (kr_lo + (tt)) * 64) : NTOK + b * LC + 64 * ((tt) - ntl))
#define ATT_LOAD(tt) do { const int tr_ = ATT_TROW(tt); kreg = *(const v4u*)(QKV + (size_t)(tr_ + skey) * QKVC + kcol + 8 * sch); vreg = *(const v4u*)(QKV + (size_t)(tr_ + vkey) * QKVC + vcol + 8 * vch); } while (0)
#define ATT_STORE(bufoff) do { *(LAS v4u*)(lds + (bufoff) + ATT_K_OFF + skey * ATT_KP + sch * 16) = kreg; \
        LAS unsigned short* vt_ = (LAS unsigned short*)(lds + (bufoff) + ATT_V_OFF + (8 * vch) * ATT_VP + vkey * 2); \
        vt_[0 * (ATT_VP / 2)] = (unsigned short)(vreg.x & 0xffff); vt_[1 * (ATT_VP / 2)] = (unsigned short)(vreg.x >> 16); vt_[2 * (ATT_VP / 2)] = (unsigned short)(vreg.y & 0xffff); vt_[3 * (ATT_VP / 2)] = (unsigned short)(vreg.y >> 16); \
        vt_[4 * (ATT_VP / 2)] = (unsigned short)(vreg.z & 0xffff); vt_[5 * (ATT_VP / 2)] = (unsigned short)(vreg.z >> 16); vt_[6 * (ATT_VP / 2)] = (unsigned short)(vreg.w & 0xffff); vt_[7 * (ATT_VP / 2)] = (unsigned short)(vreg.w >> 16); } while (0)
    v4u& kreg = P.k; v4u& vreg = P.v;
    if (!P.valid) ATT_LOAD(0);
    P.valid = 0;
    __syncthreads();
    if (MODE == 1 && head != tbl_head) {
        tbl_head = head;
        LAS float* tb = (LAS float*)(lds + ATT_RPB_OFF);
        for (int i = F.tid; i < ATT_TBL_FLOATS; i += NTHREADS) {
            int dr, off; bool ok;
            if (i < 15 * 128) { dr = i >> 7; off = (i & 127) - 63; ok = off >= -8 && off <= 7; }
            else { const int j = i - 15 * 128, ev = j / (15 * 64), dr_ = (j >> 6) % 15, kc = j & 63, q = ev < 8 ? ev : ev + 49; dr = dr_; off = kc - q; ok = ev < 8 ? kc < 16 : kc >= 48; }
            tb[i] = ok ? rpb[(head * 15 + dr) * 31 + off + 15] * LOG2E : -1e30f;
        }
    }
    ATT_STORE(0);
    __syncthreads();
#pragma unroll 1
    for (int tt = 0; tt < ntiles; ++tt) {
        const bool is_local = tt < ntl;
        const int kbase = q0 - 128 + 64 * (lo + tt), kr = kr_lo + tt;
        const int boff = (tt & 1) * ATT_BUF;
        if (tt + 1 < ntiles) { if (!(var & 2)) ATT_LOAD(tt + 1); }
        else if (u_next >= 0) {
            int nq, nqc, nkc, nvc, ntr; att_start<MODE>(u_next, w, r, nq, nqc, nkc, nvc, ntr);
            kreg = *(const v4u*)(QKV + (size_t)(ntr + skey) * QKVC + nkc + 8 * sch); vreg = *(const v4u*)(QKV + (size_t)(ntr + vkey) * QKVC + nvc + 8 * vch);
            P.valid = 1;
        }
        if (!(var & 1) && !(MODE == 1 && is_local && !(kr >= my_rs && kr < my_rs + 8))) {
            att_tile<MODE, 0>(lds, boff, qf, negm, O0, O1, m_run, l_run, is_local, MODE == 0 && is_local && (lo + tt == 0 || lo + tt == 4), kbase, qt, kr, gr, tb_base, tb_pitch, r, h);
        }
        if (tt + 1 < ntiles && !(var & 2)) ATT_STORE(((tt + 1) & 1) * ATT_BUF);
        __syncthreads();
    }
#undef ATT_TROW
#undef ATT_LOAD
#undef ATT_STORE
    const float lt = l_run + __shfl_xor(l_run, 32), inv = 1.0f / lt;
    LAS unsigned char* ot = lds + w * 4608;
#pragma unroll
    for (int g = 0; g < 4; ++g) {
        v2u o; o.x = cvtpk(O0[4 * g] * inv, O0[4 * g + 1] * inv); o.y = cvtpk(O0[4 * g + 2] * inv, O0[4 * g + 3] * inv);
        *(LAS v2u*)(ot + r * 144 + (8 * g + 4 * h) * 2) = o;
        o.x = cvtpk(O1[4 * g] * inv, O1[4 * g + 1] * inv); o.y = cvtpk(O1[4 * g + 2] * inv, O1[4 * g + 3] * inv);
        *(LAS v2u*)(ot + r * 144 + (32 + 8 * g + 4 * h) * 2) = o;
    }
    LDS_WAIT(); asm volatile("" ::: "memory");
    bf16* op = Yo + (size_t)(qrow - r) * 512 + head * 64;
#pragma unroll
    for (int k = 0; k < 4; ++k) { const int p = lane + 64 * k, row = p >> 3, chk = p & 7;
        *(GAS v4u*)(op + (size_t)row * 512 + 8 * chk) = *(const LAS v4u*)(ot + row * 144 + chk * 16); }
    LDS_WAIT(); asm volatile("" ::: "memory");
}

template <int N>
__device__ __forceinline__ void conv_taps(const bf16* src, int t, int L, float w0, float w1, float w2, float bs, float (&out)[N]) {
    float x[N + 2];
    if constexpr (N == 8) { const v4u q = *(const v4u*)(src + t); x[1] = pg8::bf_lo(q.x); x[2] = pg8::bf_hi(q.x); x[3] = pg8::bf_lo(q.y); x[4] = pg8::bf_hi(q.y); x[5] = pg8::bf_lo(q.z); x[6] = pg8::bf_hi(q.z); x[7] = pg8::bf_lo(q.w); x[8] = pg8::bf_hi(q.w); }
    else { const v2u q = *(const v2u*)(src + t); x[1] = pg8::bf_lo(q.x); x[2] = pg8::bf_hi(q.x); x[3] = pg8::bf_lo(q.y); x[4] = pg8::bf_hi(q.y); }
    x[0] = t > 0 ? bf2f(src[t - 1]) : 0.f;
    x[N + 1] = (t + N < L) ? bf2f(src[t + N]) : 0.f;
#pragma unroll
    for (int e = 0; e < N; ++e) out[e] = w0 * x[e] + w1 * x[e + 1] + w2 * x[e + 2] + bs;
}

template <int L, int VAR = 0>
__device__ __forceinline__ void hyena_unit(Frame& F, int c, const bf16* CINT, bf16* DST, const bf16* Gf, const float* convw, const float* convb, const float* hybias) {
    constexpr int UP = (L + 8) * 2, TPW = L / 256, CPB = L / 8;
    LAS unsigned char* U = F.lds; LAS unsigned short* Gs = (LAS unsigned short*)(F.lds + 32 * UP);
    const int lane = F.lane, r = lane & 31, h = lane >> 5, T0 = F.wave * TPW * 32;
    const bf16* vsrc = CINT + (size_t)c * NROW + (L == SEQ ? 0 : NTOK);
    bf16* ydst = DST + (size_t)c * NROW + (L == SEQ ? 0 : NTOK);
    __syncthreads();
    if (!(VAR & 8)) {
        const float w0 = convw[c], w1 = convw[CINC + c], w2 = convw[2 * CINC + c], bs = convb[c];
        static_assert(CPB % 32 == 0, "a wave's 64 lanes hold consecutive chunks of at most two rows, split at lane 32");
#pragma unroll 4
        for (int q = F.tid; q < 32 * CPB; q += NTHREADS) { const int b = q / CPB, t = (q % CPB) * 8;
            const bf16* src = vsrc + (size_t)b * L;
            const v4u ch = *(const v4u*)(src + t);
            float x[10];
            x[1] = pg8::bf_lo(ch.x); x[2] = pg8::bf_hi(ch.x); x[3] = pg8::bf_lo(ch.y); x[4] = pg8::bf_hi(ch.y); x[5] = pg8::bf_lo(ch.z); x[6] = pg8::bf_hi(ch.z); x[7] = pg8::bf_lo(ch.w); x[8] = pg8::bf_hi(ch.w);
            const float up = __shfl_up(x[8], 1), dn = __shfl_down(x[1], 1);
            const int lr = lane & 31;
            x[0] = (lr == 0) ? (t > 0 ? bf2f(src[t - 1]) : 0.f) : up;
            x[9] = (lr == 31) ? (t + 8 < L ? bf2f(src[t + 8]) : 0.f) : dn;
            float o[8];
#pragma unroll
            for (int e = 0; e < 8; ++e) o[e] = w0 * x[e] + w1 * x[e + 1] + w2 * x[e + 2] + bs;
            v4u pk; pk.x = pk2(o[0], o[1]); pk.y = pk2(o[2], o[3]); pk.z = pk2(o[4], o[5]); pk.w = pk2(o[6], o[7]);
            *(LAS v4u*)(U + b * UP + t * 2) = pk; }
    }
#pragma unroll 1
    for (int ord = 0; ord < 2; ++ord) {
        {
            const v4u* gsrc = (const v4u*)(Gf + ((size_t)ord * 512 + c) * (2 * L));
            for (int q = F.tid; q < L / 4; q += NTHREADS) *(LAS v4u*)((LAS unsigned char*)Gs + q * 16) = gsrc[q];
        }
        __syncthreads();
        f32x16 acc[TPW];
#pragma unroll
        for (int i = 0; i < TPW; ++i)
#pragma unroll
            for (int e = 0; e < 16; ++e) acc[i][e] = 0.f;
        const int gbase = T0 + r - 8 * h + L;
#define HY_AF(dst, sgi, ti) do { const int gi_ = gbase + 32 * (ti) - 16 * (sgi); _Pragma("unroll") for (int j_ = 0; j_ < 8; ++j_) dst[j_] = (short)Gs[gi_ - j_]; } while (0)
#define HY_BF(sgi) (*(const LAS bf16x8*)(U + r * UP + (16 * (sgi) + 8 * h) * 2))
        if constexpr (TPW == 8 && !(VAR & 2)) {
            constexpr int NS = L / 16;
#pragma unroll 1
            for (int p = 0; p < 2; ++p) {
                bf16x8 W[8];
#pragma unroll
                for (int i = 1; i < 8; ++i) HY_AF(W[i], p, i);
                bf16x8 nf, nb; HY_AF(nf, p, 0); nb = HY_BF(p);
#pragma unroll 1
                for (int sb = p; sb < NS; sb += 16) {
#pragma unroll
                    for (int k = 0; k < 8; ++k) {
                        const int sg = sb + 2 * k; const bf16x8 cb = nb; W[(8 - k) & 7] = nf;
                        const int sn = sg + 2 < NS ? sg + 2 : sg;
                        HY_AF(nf, sn, 0); nb = HY_BF(sn);
#pragma unroll
                        for (int i = 0; i < 8; ++i) acc[i] = MFMA32(W[(i - k) & 7], cb, acc[i]);
                    }
                }
            }
        } else if constexpr (!(VAR & 2)) {
#pragma unroll 1
            for (int sg = 0; sg < L / 16; ++sg) { bf16x8 af; HY_AF(af, sg, 0); acc[0] = MFMA32(af, HY_BF(sg), acc[0]); }
        }
#undef HY_AF
#undef HY_BF
        const int comp = 1 + ord;
        const float w0 = convw[comp * 512 + c], w1 = convw[CINC + comp * 512 + c], w2 = convw[2 * CINC + comp * 512 + c], bs = convb[comp * 512 + c], hb = hybias[ord * 512 + c];
        const bf16* gsrc = CINT + ((size_t)comp * 512 + c) * NROW + (L == SEQ ? 0 : NTOK) + (size_t)r * L;
        __syncthreads();
        {
            constexpr int NCH = TPW * 4, BS = NCH < 8 ? NCH : 8;
#pragma unroll
            for (int bt = 0; bt < NCH / BS; ++bt) {
                const int tb = T0 + 8 * BS * bt;
                v4u ch[BS];
#pragma unroll
                for (int k = 0; k < BS; ++k) { if constexpr (VAR & 4) ch[k] = (v4u){0u, 0u, 0u, 0u}; else ch[k] = *(const v4u*)(gsrc + tb + 8 * k); }
                float xl = 0.f, xr = 0.f;
                if constexpr (!(VAR & 4)) { if (tb > 0) xl = bf2f(gsrc[tb - 1]); if (tb + 8 * BS < L) xr = bf2f(gsrc[tb + 8 * BS]); }
#pragma unroll
                for (int k = 0; k < BS; ++k) {
                    const int kk = BS * bt + k, i = kk >> 2, g = kk & 3, t = T0 + 32 * i + 8 * g + 4 * h;
                    float xs[10];
                    xs[0] = k == 0 ? xl : pg8::bf_hi(ch[k > 0 ? k - 1 : 0].w);
                    xs[1] = pg8::bf_lo(ch[k].x); xs[2] = pg8::bf_hi(ch[k].x); xs[3] = pg8::bf_lo(ch[k].y); xs[4] = pg8::bf_hi(ch[k].y); xs[5] = pg8::bf_lo(ch[k].z); xs[6] = pg8::bf_hi(ch[k].z); xs[7] = pg8::bf_lo(ch[k].w); xs[8] = pg8::bf_hi(ch[k].w);
                    xs[9] = k == BS - 1 ? xr : pg8::bf_lo(ch[k < BS - 1 ? k + 1 : k].x);
                    float gt[4];
#pragma unroll
                    for (int e2 = 0; e2 < 4; ++e2) { const float lo = w0 * xs[e2] + w1 * xs[e2 + 1] + w2 * xs[e2 + 2] + bs, hi = w0 * xs[e2 + 4] + w1 * xs[e2 + 5] + w2 * xs[e2 + 6] + bs; gt[e2] = h ? hi : lo; }
                    LAS v2u* up = (LAS v2u*)(U + r * UP + t * 2);
                    const v2u uu = *up;
                    const float u0 = pg8::bf_lo(uu.x), u1 = pg8::bf_hi(uu.x), u2 = pg8::bf_lo(uu.y), u3 = pg8::bf_hi(uu.y);
                    const float z0 = gt[0] * (acc[i][4 * g] + hb * u0), z1 = gt[1] * (acc[i][4 * g + 1] + hb * u1), z2 = gt[2] * (acc[i][4 * g + 2] + hb * u2), z3 = gt[3] * (acc[i][4 * g + 3] + hb * u3);
                    v2u zz; zz.x = pk2(z0, z1); zz.y = pk2(z2, z3);
                    *up = zz;
                }
                asm volatile("" ::: "memory");
            }
        }
        __syncthreads();
    }
    if (!(VAR & 1)) for (int q = F.tid; q < 32 * CPB; q += NTHREADS) { const int b = q / CPB, t = (q % CPB) * 8; *(GAS v4u*)(ydst + (size_t)b * L + t) = *(const LAS v4u*)(U + b * UP + t * 2); }
}

__device__ __forceinline__ void transpose_yc(Frame& F, const bf16* CT, bf16* Yc, int nrows) {
    const int gw = F.vcu * NWAVES + F.wave, NGW = F.G * NWAVES, lane = F.lane;
    LAS unsigned short* T = (LAS unsigned short*)(F.lds + F.wave * 16384);
    const int ntr = nrows / 64;
    for (int it = gw; it < 8 * ntr; it += NGW) {
        const int cb = it / ntr, rb = it % ntr, c0 = cb * 64, r0 = rb * 64;
#pragma unroll
        for (int k = 0; k < 8; ++k) { const int p = lane + 64 * k, cc = p >> 3, ch = p & 7;
            const v4u q = *(const v4u*)(CT + (size_t)(c0 + cc) * NROW + r0 + 8 * ch);
            LAS unsigned* d = (LAS unsigned*)(T + cc * 66 + 8 * ch); d[0] = q.x; d[1] = q.y; d[2] = q.z; d[3] = q.w; }
        LDS_WAIT(); asm volatile("" ::: "memory");
#pragma unroll
        for (int k = 0; k < 8; ++k) { const int p = lane + 64 * k, rr = p >> 3, ch = p & 7;
            unsigned short e[8];
#pragma unroll
            for (int j = 0; j < 8; ++j) e[j] = T[(8 * ch + j) * 66 + rr];
            v4u o; o.x = e[0] | ((unsigned)e[1] << 16); o.y = e[2] | ((unsigned)e[3] << 16); o.z = e[4] | ((unsigned)e[5] << 16); o.w = e[6] | ((unsigned)e[7] << 16);
            *(GAS v4u*)(Yc + (size_t)(r0 + rr) * 512 + c0 + 8 * ch) = o; }
        LDS_WAIT(); asm volatile("" ::: "memory");
    }
}

struct RowVecs { f32x4 gA[4], gt[4], gB[4], sc1[4], sh[4]; };
__device__ __forceinline__ float ssq16(const f32x4 (&v)[4]) { float s = 0.f;
#pragma unroll
    for (int j = 0; j < 4; ++j) s += (v[j].x * v[j].x + v[j].y * v[j].y) + (v[j].z * v[j].z + v[j].w * v[j].w);
    return s; }
__device__ __forceinline__ void ld_mod(const Frame& F, int l, int b, int part, int lane, f32x4 (&v)[4], float add) {
    ld_row_f32((const float*)(F.ws + WS_MODV) + ((size_t)l * 33 + b) * 6144 + part * 1024, lane, v);
#pragma unroll
    for (int j = 0; j < 4; ++j) v[j] = v[j] + add;
}
__device__ __forceinline__ void row_pair(const RowVecs& V, const f32x4 (&y0)[4], const f32x4 (&y1)[4], f32x4 (&x0)[4], f32x4 (&x1)[4], bool has_y, bool has_next, f32x4 (&h0)[4], f32x4 (&h1)[4]) {
    if (has_y) {
        float a0 = ssq16(y0), a1 = ssq16(y1);
#pragma unroll
        for (int o = 1; o < 64; o <<= 1) { a0 += __shfl_xor(a0, o); a1 += __shfl_xor(a1, o); }
        const float r0 = __builtin_amdgcn_rsqf(a0 * (1.0f / D) + EPS), r1 = __builtin_amdgcn_rsqf(a1 * (1.0f / D) + EPS);
#pragma unroll
        for (int j = 0; j < 4; ++j) { x0[j] = x0[j] + V.gt[j] * ((y0[j] * r0) * V.gA[j]); x1[j] = x1[j] + V.gt[j] * ((y1[j] * r1) * V.gA[j]); }
    }
    if (has_next) {
        float a0 = ssq16(x0), a1 = ssq16(x1);
#pragma unroll
        for (int o = 1; o < 64; o <<= 1) { a0 += __shfl_xor(a0, o); a1 += __shfl_xor(a1, o); }
        const float r0 = __builtin_amdgcn_rsqf(a0 * (1.0f / D) + EPS), r1 = __builtin_amdgcn_rsqf(a1 * (1.0f / D) + EPS);
#pragma unroll
        for (int j = 0; j < 4; ++j) { h0[j] = (x0[j] * r0) * V.gB[j] * V.sc1[j] + V.sh[j]; h1[j] = (x1[j] * r1) * V.gB[j] * V.sc1[j] + V.sh[j]; }
    }
}
template <bool XB16>
__device__ __forceinline__ void rows_phase(Frame& F, const Args& a, int mode, int l, int sub, const bf16* Y, int nrows) {
    const int gw = F.vcu * NWAVES + F.wave, NGW = F.G * NWAVES;
    const int R = (((nrows + NGW - 1) / NGW) + 1) & ~1, r0 = gw * R, r1 = (r0 + R) < nrows ? (r0 + R) : nrows;
    const bool has_y = mode == 1, has_next = (mode == 0) || !(l == 1 && sub == 1);
    const int ln = (mode == 0) ? 0 : (sub == 0 ? l : l + 1);
    const bool next_is_ffn = (mode == 1 && sub == 0);
    RowVecs V;
    if (has_y) ld_row_f32(a.in[sub == 0 ? I_GMIXPOST : I_GFFNPOST] + l * D, F.lane, V.gA);
    if (has_next) ld_row_f32(a.in[next_is_ffn ? I_GFFNPRE : I_GMIXPRE] + ln * D, F.lane, V.gB);
    int bcur = -2;
    bf16* const Hb = F.hb; bf16* const XB = (bf16*)(F.ws + WS_XB);
    f32x4 nx0[4], nx1[4]; v2u nxr0[4], nxr1[4], ny0[4], ny1[4];
#define ROWS_ISSUE(row_) do { const int rr_ = (row_); \
        if (has_y) { ld_raw_bf16_nt(Y + (size_t)rr_ * D, F.lane, ny0); ld_raw_bf16_nt(Y + (size_t)(rr_ + 1) * D, F.lane, ny1); } \
        if (XB16) { ld_raw_bf16_nt(XB + (size_t)rr_ * D, F.lane, nxr0); ld_raw_bf16_nt(XB + (size_t)(rr_ + 1) * D, F.lane, nxr1); } \
        else { const float* xs_ = rr_ < NTOK ? a.in[I_X] + (size_t)rr_ * D : a.in[I_CTX] + (size_t)(rr_ - NTOK) * D; ld_row_f32_nt(xs_, F.lane, nx0); ld_row_f32_nt(xs_ + D, F.lane, nx1); } } while (0)
    if (r0 < r1) ROWS_ISSUE(r0);
#pragma unroll 1
    for (int row = r0; row < r1; row += 2) {
        const int b = row < NTOK ? (row >> 11) : 32;
        if (b != bcur) { bcur = b;
            if (has_y) ld_mod(F, l, b, sub == 0 ? 2 : 5, F.lane, V.gt, 0.f);
            if (has_next) { ld_mod(F, ln, b, next_is_ffn ? 4 : 1, F.lane, V.sc1, 1.0f); ld_mod(F, ln, b, next_is_ffn ? 3 : 0, F.lane, V.sh, 0.f); } }
        f32x4 y0[4], y1[4], x0[4], x1[4], h0[4], h1[4];
#pragma unroll
        for (int j = 0; j < 4; ++j) { if (XB16) { x0[j] = cvt_raw_bf16(nxr0[j]); x1[j] = cvt_raw_bf16(nxr1[j]); } else { x0[j] = nx0[j]; x1[j] = nx1[j]; }
            if (has_y) { y0[j] = cvt_raw_bf16(ny0[j]); y1[j] = cvt_raw_bf16(ny1[j]); } }
        if (row + 2 < r1) ROWS_ISSUE(row + 2);
        row_pair(V, y0, y1, x0, x1, has_y, has_next, h0, h1);
        if (has_y) { st_row_bf16(XB + (size_t)row * D, F.lane, x0); st_row_bf16(XB + (size_t)(row + 1) * D, F.lane, x1); }
        if (has_next) { st_row_bf16(Hb + (size_t)row * D, F.lane, h0); st_row_bf16(Hb + (size_t)(row + 1) * D, F.lane, h1);
            if (!next_is_ffn) { GAS unsigned* q = (GAS unsigned*)(F.ws + WS_H8 + (size_t)row * D) + F.lane;
#pragma unroll
                for (int j = 0; j < 4; ++j) { q[64 * j] = pg8::pack_fp8x4(h0[j].x, h0[j].y, h0[j].z, h0[j].w); q[256 + 64 * j] = pg8::pack_fp8x4(h1[j].x, h1[j].y, h1[j].z, h1[j].w); } } }
    }
#undef ROWS_ISSUE
}

__device__ __forceinline__ void route_row(const f32x4 (&h)[4], const LAS float* rl, int lane, int& e0, int& e1, float& w0, float& w1) {
    float lg[8];
#pragma unroll
    for (int e = 0; e < 8; ++e) lg[e] = 0.f;
#pragma unroll
    for (int j = 0; j < 4; ++j)
#pragma unroll
        for (int i = 0; i < 4; ++i) { const LAS f32x4* rp = (const LAS f32x4*)(rl + ((j * 4 + i) * 64 + lane) * 8); const f32x4 q0 = rp[0], q1 = rp[1]; const float hv = h[j][i];
            lg[0] += hv * q0.x; lg[1] += hv * q0.y; lg[2] += hv * q0.z; lg[3] += hv * q0.w; lg[4] += hv * q1.x; lg[5] += hv * q1.y; lg[6] += hv * q1.z; lg[7] += hv * q1.w; }
#pragma unroll
    for (int o = 1; o < 64; o <<= 1)
#pragma unroll
        for (int e = 0; e < 8; ++e) lg[e] += __shfl_xor(lg[e], o);
    e0 = 0; float v0 = lg[0];
#pragma unroll
    for (int e = 1; e < 8; ++e) if (lg[e] > v0) { v0 = lg[e]; e0 = e; }
    e1 = -1; float v1 = -3.0e38f;
#pragma unroll
    for (int e = 0; e < 8; ++e) if (e != e0 && lg[e] > v1) { v1 = lg[e]; e1 = e; }
    w0 = 1.0f / (1.0f + __expf(v1 - v0)); w1 = 1.0f - w0;
}
__device__ __forceinline__ void post_route_phase(Frame& F, const Args& a, const bf16* Y) {
    LAS int* se = (LAS int*)F.lds;
    LAS int* sbase = se + 512;
    LAS float* rl = (LAS float*)(F.lds + 4096);
    const int l = 1;
    __syncthreads();
    for (int i = F.tid; i < 1024 * 8; i += NTHREADS) { const int k = i >> 3, e = i & 7, jj = k >> 8, ln = (k & 255) >> 2, ii = k & 3; rl[((jj * 4 + ii) * 64 + ln) * 8 + e] = a.in[I_ROUTER][i]; }
    __syncthreads();
    RowVecs V;
    ld_row_f32(a.in[I_GMIXPOST] + l * D, F.lane, V.gA); ld_row_f32(a.in[I_GFFNPRE] + l * D, F.lane, V.gB);
    bf16* const Hb = F.hb; bf16* const XB = (bf16*)(F.ws + WS_XB);
    for (int blk = F.vcu; blk < NTOK / 256; blk += F.G) {
        const int b = blk >> 3;
        ld_mod(F, l, b, 2, F.lane, V.gt, 0.f); ld_mod(F, l, b, 4, F.lane, V.sc1, 1.0f); ld_mod(F, l, b, 3, F.lane, V.sh, 0.f);
#pragma unroll 1
        for (int k = 0; k < 32; ++k) {
            const int lr = F.wave * 32 + k, row = blk * 256 + lr;
            f32x4 y0[4], x0[4], h0[4];
            ld_row_bf16(Y + (size_t)row * D, F.lane, y0);
            bf16* xp = XB + (size_t)row * D; ld_row_bf16(xp, F.lane, x0);
            { const float r0 = __builtin_amdgcn_rsqf(wave_sum(ssq16(y0)) * (1.0f / D) + EPS);
#pragma unroll
              for (int j = 0; j < 4; ++j) x0[j] = x0[j] + V.gt[j] * ((y0[j] * r0) * V.gA[j]); }
            st_row_bf16(xp, F.lane, x0);
            { const float r0 = __builtin_amdgcn_rsqf(wave_sum(ssq16(x0)) * (1.0f / D) + EPS);
#pragma unroll
              for (int j = 0; j < 4; ++j) h0[j] = (x0[j] * r0) * V.gB[j] * V.sc1[j] + V.sh[j]; }
            { GAS unsigned* q = (GAS unsigned*)((unsigned char*)Hb + (size_t)row * D) + F.lane;
#pragma unroll
              for (int j = 0; j < 4; ++j) q[64 * j] = pg8::pack_fp8x4(h0[j].x, h0[j].y, h0[j].z, h0[j].w); }
            int e0, e1; float w0, w1;
            route_row(h0, rl, F.lane, e0, e1, w0, w1);
            if (F.lane == 0) { se[2 * lr] = e0; se[2 * lr + 1] = e1;
                int4 rr; rr.x = e0; rr.y = e1; rr.z = __builtin_bit_cast(int, w0); rr.w = __builtin_bit_cast(int, w1); ((int4*)(F.ws + WS_ROUTE))[row] = rr; }
        }
        __syncthreads();
        const int half = blk >> 7;
        if (F.tid < 8) { int n = 0; for (int i = 0; i < 512; ++i) n += (se[i] == F.tid) ? 1 : 0;
            sbase[F.tid] = (int)__hip_atomic_fetch_add((unsigned*)(F.ws + WS_CTL) + CW_CNT + half * 8 + F.tid, (unsigned)n, __ATOMIC_RELAXED, __HIP_MEMORY_SCOPE_AGENT); }
        __syncthreads();
        if (F.tid < 8) { int p = sbase[F.tid]; int* lst = (int*)(F.ws + WS_LIST) + ((size_t)half * 8 + F.tid) * 32768;
            for (int i = 0; i < 512; ++i) if (se[i] == F.tid) lst[p++] = ((blk * 256 + (i >> 1)) << 1) | (i & 1); }
        __syncthreads();
    }
}

__device__ __forceinline__ void moe_offsets(Frame& F, int half, int (&toff)[9], int (&cnt)[8]) {
    const unsigned* cw = (const unsigned*)(F.ws + WS_CTL) + CW_CNT + half * 8;
    toff[0] = 0;
#pragma unroll
    for (int e = 0; e < 8; ++e) { cnt[e] = __builtin_amdgcn_readfirstlane((int)__hip_atomic_load(cw + e, __ATOMIC_RELAXED, __HIP_MEMORY_SCOPE_AGENT)); toff[e + 1] = toff[e] + (cnt[e] + 255) / 256; }
}
__device__ __forceinline__ void moe_gather_phase(Frame& F, int half, int skip_first = 0) {
    if (skip_first < 0 || skip_first >= F.G) skip_first = 0;
    const int bxw = (int)blockIdx.x - skip_first; if (bxw < 0) return;
    const int gw = bxw * NWAVES + F.wave, NGW = (F.G - skip_first) * NWAVES;
    int toff[9], cnt[8]; moe_offsets(F, half, toff, cnt);
    const int P = toff[8] * 256;
    for (int p = gw; p < P; p += NGW) {
        const int tile = p >> 8; int e = 0;
#pragma unroll
        for (int k = 1; k < 8; ++k) e += (tile >= toff[k]) ? 1 : 0;
        const int idx = p - toff[e] * 256;
        unsigned char* dst = F.ws + BIG_AS + (size_t)p * D;
        v4u o = {0u, 0u, 0u, 0u};
        if (idx < cnt[e]) {
            const int ts = ((const int*)(F.ws + WS_LIST))[((size_t)half * 8 + e) * 32768 + idx], tok = ts >> 1, slot = ts & 1;
            o = *((const GAS v4u*)((const unsigned char*)F.hb + (size_t)tok * D) + F.lane);
            if (F.lane == 0) ((int*)(F.ws + WS_INV))[tok * 2 + slot] = p;
        }
        *((GAS v4u*)dst + F.lane) = o;
    }
}
__device__ __forceinline__ void moe_convert(Frame& F, const Args& a) {
    const int gw = F.vcu * NWAVES + F.wave, NGW = F.G * NWAVES;
    LAS float* scr = (LAS float*)(F.lds + F.wave * 16384);
    constexpr int I13 = 16 * 112, I2 = 56 * 32;
    for (int it = gw; it < 8 * (2 * I13 + I2); it += NGW) {
        const int e = it / (2 * I13 + I2); int r = it % (2 * I13 + I2);
        if (r < 2 * I13) {
            const int which = r / I13; r %= I13; const int kb = r / 112, nb = r % 112, n0 = 32 * nb;
            const float* W = (which ? a.in[I_MW3] : a.in[I_MW1]) + (size_t)e * D * DFFE;
            transpose_item_f8(W, DFFE, F.ws + WM_13 + (size_t)e * 2 * DFFE * D, D, 64 * kb, n0, (n0 / 128) * 256 + which * 128 + (n0 % 128), W13_SCALE, scr, F.lane);
        } else {
            r -= 2 * I13; const int kb = r / 32, nb = r % 32;
            transpose_item_f8(a.in[I_MW2] + (size_t)e * DFFE * D, D, F.ws + WM_2 + (size_t)e * D * DFFE, DFFE, 64 * kb, 32 * nb, 32 * nb, W2_SCALE, scr, F.lane);
        }
    }
}
__device__ __forceinline__ void moe_post_phase(Frame& F, const Args& a, int half) {
    const int gw = F.vcu * NWAVES + F.wave, NGW = F.G * NWAVES;
    const int R = (((32768 + NGW - 1) / NGW) + 1) & ~1, t0 = gw * R, t1 = (t0 + R) < 32768 ? (t0 + R) : 32768;
    RowVecs V; ld_row_f32(a.in[I_GFFNPOST] + D, F.lane, V.gA);
    int bcur = -2;
    const bf16* Y2 = (const bf16*)(F.ws + BIG_Y2S); const int* inv = (const int*)(F.ws + WS_INV); const int4* rt = (const int4*)(F.ws + WS_ROUTE);
    int4 ira, irb; int ip00, ip01, ip10, ip11;
    v2u nya[4], nyb[4], nyc[4], nyd[4], nxr0[4], nxr1[4]; const bf16* XB = (const bf16*)(F.ws + WS_XB); float nw0 = 0.f, nw1 = 0.f, nu0 = 0.f, nu1 = 0.f;
#define MP_IDX(t_) do { const int rw_ = half * 32768 + (t_); ira = rt[rw_]; irb = rt[rw_ + 1]; ip00 = inv[rw_ * 2]; ip01 = inv[rw_ * 2 + 1]; ip10 = inv[rw_ * 2 + 2]; ip11 = inv[rw_ * 2 + 3]; } while (0)
#define MP_DATA(t_) do { const int rw_ = half * 32768 + (t_); \
        ld_raw_bf16_nt(Y2 + (size_t)ip00 * D, F.lane, nya); ld_raw_bf16_nt(Y2 + (size_t)ip01 * D, F.lane, nyb); ld_raw_bf16_nt(Y2 + (size_t)ip10 * D, F.lane, nyc); ld_raw_bf16_nt(Y2 + (size_t)ip11 * D, F.lane, nyd); \
        const bf16* xq_ = XB + (size_t)rw_ * D; ld_raw_bf16_nt(xq_, F.lane, nxr0); ld_raw_bf16_nt(xq_ + D, F.lane, nxr1); \
        nw0 = __builtin_bit_cast(float, ira.z); nw1 = __builtin_bit_cast(float, ira.w); nu0 = __builtin_bit_cast(float, irb.z); nu1 = __builtin_bit_cast(float, irb.w); } while (0)
    if (t0 < t1) { MP_IDX(t0); MP_DATA(t0); if (t0 + 2 < t1) MP_IDX(t0 + 2); }
#pragma unroll 1
    for (int t = t0; t < t1; t += 2) {
        const int row = half * 32768 + t, b = row >> 11;
        if (b != bcur) { bcur = b; ld_mod(F, 1, b, 5, F.lane, V.gt, 0.f); }
        f32x4 y0[4], y1[4], x0[4], x1[4], h0[4], h1[4];
        float* xp = a.out + (size_t)row * D;
#pragma unroll
        for (int j = 0; j < 4; ++j) { x0[j] = cvt_raw_bf16(nxr0[j]); x1[j] = cvt_raw_bf16(nxr1[j]); y0[j] = cvt_raw_bf16(nya[j]) * nw0 + cvt_raw_bf16(nyb[j]) * nw1; y1[j] = cvt_raw_bf16(nyc[j]) * nu0 + cvt_raw_bf16(nyd[j]) * nu1; }
        if (t + 2 < t1) { MP_DATA(t + 2); if (t + 4 < t1) MP_IDX(t + 4); }
        row_pair(V, y0, y1, x0, x1, true, false, h0, h1);
        st_row_f32_nt(xp, F.lane, x0); st_row_f32_nt(xp + D, F.lane, x1);
    }
#undef MP_IDX
#undef MP_DATA
}

#ifndef MK_ONLY
#define MK_ONLY -1
#endif
#ifndef MK_SKIP
#define MK_SKIP -1
#endif
#define ON(k) ((MK_ONLY < 0 || MK_ONLY == (k)) && MK_SKIP != (k))
#ifndef MK_REPMASK
#define MK_REPMASK 0
#endif
#ifndef MK_REPSUB
#define MK_REPSUB 0
#endif
#ifndef MK_HYVAR
#define MK_HYVAR 0
#endif
#ifndef MK_PROBE
#define MK_PROBE -1
#endif
#ifndef MK_PROBE_END
#define MK_PROBE_END MK_PROBE
#endif
#ifndef MK_PROBE_DIV
#define MK_PROBE_DIV 10
#endif
#ifndef MK_MULTI
#define MK_MULTI 0
#endif
constexpr int NPHASES = 2 + 9 + 6 + 6;

typedef const __attribute__((address_space(4))) Args* ArgsP;
#define KARGS ((ArgsP)__builtin_amdgcn_kernarg_segment_ptr())
#define PH_ENTER \
    Frame F; const Args* ap_; { int t_ = threadIdx.x; asm volatile("" : "+v"(t_)); ArgsP q_ = KARGS; asm volatile("" : "+s"(q_)); ap_ = (const Args*)q_; \
      F.lds = (LAS unsigned char*)lds_raw; F.tid = t_; F.lane = t_ & 63; F.wave = __builtin_amdgcn_readfirstlane(t_ >> 6); \
      F.G = gridDim.x; { const int bx_ = blockIdx.x; F.vcu = (F.G % 8 == 0) ? (bx_ % 8) * (F.G / 8) + bx_ / 8 : bx_; } F.ws = q_->ws; F.hb = (bf16*)q_->out; } \
    const Args& a = *ap_; const int bx = (int)blockIdx.x; \
    bf16* const Hb = F.hb; bf16* const Y3 = (bf16*)(F.ws + WS_Y3); bf16* const QKV = (bf16*)(F.ws + BIG_QKV); bf16* const CINT = (bf16*)(F.ws + BIG_CINT); unsigned char* const GATE = F.ws + BIG_GATE; \
    (void)Hb; (void)Y3; (void)QKV; (void)CINT; (void)GATE; (void)bx; (void)a;

__global__ void __launch_bounds__(NTHREADS, 2) fwd_kernel(Args args) {
    extern __shared__ __attribute__((aligned(16))) unsigned char lds_raw[];
    {
        volatile LAS unsigned* MISC0 = (volatile LAS unsigned*)((LAS unsigned char*)lds_raw + MISC_OFF);
        for (int u = threadIdx.x; u < (LDS_BYTES - MISC_OFF) / 4; u += NTHREADS) MISC0[u] = 0u;
        __syncthreads();
    }
    if (!MK_MULTI) (void)xcd_barrier_post((unsigned*)(KARGS->ws + WS_CTL) + CW_BAR, (volatile LAS unsigned*)((LAS unsigned char*)lds_raw + MISC_OFF) + 8);
    int ph = 0;
#define PROBE_STAMP(which) do { if (MK_PROBE >= 0 && blockIdx.x == 0 && __builtin_amdgcn_readfirstlane((int)threadIdx.x) == 0) { volatile unsigned* pw_ = (volatile unsigned*)(KARGS->ws + WS_CTL) + 20000; const unsigned t_ = (unsigned)__builtin_amdgcn_s_memrealtime(); if ((which) == 0) pw_[0] = t_; else pw_[1] = t_ - pw_[0]; } } while (0)
    if (MK_PROBE == 0) PROBE_STAMP(0);
#define LO_ (KARGS->ph_lo)
#define HI_ (KARGS->ph_hi)
#define GRID_BAR do { XcdBarrier b_; b_.bar = (unsigned*)(KARGS->ws + WS_CTL) + CW_BAR; b_.x = xb_xcc_id(); b_.st = (volatile LAS unsigned*)((LAS unsigned char*)lds_raw + MISC_OFF) + 8; xcd_barrier(b_); } while (0)
#define RUN (LO_ <= ph && ph < HI_)
#define END_PHASE do { if (RUN && (ph + 1 < HI_)) { GRID_BAR; } if (MK_PROBE > 0 && ph + 1 == MK_PROBE) PROBE_STAMP(0); if (MK_PROBE >= 0 && ph == MK_PROBE_END) PROBE_STAMP(1); ++ph; } while (0)

    if (RUN && ON(0)) { PH_ENTER p0_prologue(F, a); } END_PHASE;
    if (RUN && ON(1)) { PH_ENTER p1_phase(F, a); rows_phase<false>(F, a, 0, 0, 0, nullptr, NROW); } END_PHASE;

#pragma unroll 1
    for (int l = 0; l < 2; ++l) {
        const int nrows = l == 0 ? NROW : NTOK;
        if (RUN && ON(2)) { PH_ENTER
            const bf16* Wq8 = (const bf16*)(F.ws + W_IN + (size_t)l * INC * D);
            { pg8::Gemm g{(const bf16*)(F.ws + WS_H8), Wq8, nrows, QKVC, D / 2}; pg8::StaticOrder S; S.init(nrows, QKVC, F.G, bx);
              pg8::EpiQKV E{QKV, (const float*)(F.ws + WS_ROPE), 0, QSCALE, 1.0f / W13_SCALE};
              pg8::gemm_phase<pg8::EpiQKV, pg8::StaticOrder, true, true, true>(F.lds, g, S, E, F.tid); }
            int tid2 = threadIdx.x; asm volatile("" : "+v"(tid2));
            if (l == 1) { pg8::Gemm g{(const bf16*)(F.ws + WS_H8 + (size_t)NTOK * D), Wq8, NCTX, 1280, D / 2}; pg8::StaticOrder S; S.init(NCTX, 1280, F.G, bx);
              pg8::EpiQKV E{QKV, (const float*)(F.ws + WS_ROPE), NTOK, QSCALE, 1.0f / W13_SCALE};
              pg8::gemm_phase<pg8::EpiQKV, pg8::StaticOrder, true, true, true>(F.lds, g, S, E, tid2); }
            int tid3 = threadIdx.x; asm volatile("" : "+v"(tid3));
            { pg8::Gemm g{(const bf16*)(F.ws + W_CB) + (size_t)l * CINC * D, Hb, CINC, nrows, D}; pg8::StaticOrder S; S.init(CINC, nrows, F.G, bx);
              pg8::EpiPlain E{CINT, NROW, 0, 0, 1.0f};
              pg8::gemm_phase<pg8::EpiPlain, pg8::StaticOrder, true, true>(F.lds, g, S, E, tid3); }
        } END_PHASE;
        if (RUN) {
            { PH_ENTER const float* sink = a.in[I_SINK] + l * 8; const float* rpb = a.in[I_RPB] + (size_t)l * 8 * 15 * 31; const int sm = a.sub_mask;
              if (ON(3) && (sm & 1)) { AttPre P; P.valid = 0; int th = -1; for (int u = F.vcu; u < 2048; u += F.G) attn_unit<0>(F, u, u + F.G < 2048 ? u + F.G : -1, QKV, Y3, sink, rpb, P, th, (sm >> 6) & 3); } }
            { PH_ENTER const float* sink = a.in[I_SINK] + l * 8; const float* rpb = a.in[I_RPB] + (size_t)l * 8 * 15 * 31; const int sm = a.sub_mask;
              if (ON(4) && (sm & 2)) { AttPre P; P.valid = 0; int th = -1; for (int u = F.vcu; u < 2048; u += F.G) attn_unit<1>(F, u, u + F.G < 2048 ? u + F.G : -1, QKV, Y3 + (size_t)NROW * 512, sink, rpb, P, th, (sm >> 6) & 3); } }
            { PH_ENTER const float* sink = a.in[I_SINK] + l * 8; const float* rpb = a.in[I_RPB] + (size_t)l * 8 * 15 * 31; const int sm = a.sub_mask;
              if (l == 0 && ON(5) && (sm & 4)) {
                { AttPre P; P.valid = 0; int th = -1; for (int u = F.vcu; u < 256; u += F.G) attn_unit<2>(F, u, -1, QKV, Y3, sink, rpb, P, th); }
                { AttPre P; P.valid = 0; int th = -1; for (int u = F.vcu; u < 256; u += F.G) attn_unit<3>(F, u, -1, QKV, Y3 + (size_t)NROW * 512, sink, rpb, P, th); }
              } }
            { PH_ENTER const int sm = a.sub_mask;
              const float* cw = a.in[I_CONVW] + l * 3 * CINC; const float* cb = a.in[I_CONVB] + l * CINC; const float* hb = a.in[I_HBIAS] + l * 1024;
#if MK_HYVAR
              if (ON(6) && (sm & 32)) for (int c = F.vcu; c < 512; c += F.G) hyena_unit<SEQ, MK_HYVAR>(F, c, CINT, CINT, (const bf16*)(F.ws + WS_GF) + (size_t)l * 2 * 512 * 2 * SEQ, cw, cb, hb);
#endif
              if (ON(6) && (sm & 8)) for (int c = F.vcu; c < 512; c += F.G) hyena_unit<SEQ>(F, c, CINT, CINT, (const bf16*)(F.ws + WS_GF) + (size_t)l * 2 * 512 * 2 * SEQ, cw, cb, hb);
              if (l == 0 && ON(7) && (sm & 16)) for (int c = F.vcu; c < 512; c += F.G) hyena_unit<LC>(F, c, CINT, CINT, (const bf16*)(F.ws + WS_GFC) + (size_t)l * 2 * 512 * 2 * LC, cw, cb, hb);
              __syncthreads(); }
        } END_PHASE;
        if (RUN && ON(8)) { PH_ENTER
            transpose_yc(F, CINT, (bf16*)(F.ws + BIG_YCT), nrows);
            __syncthreads();
            pg8::Gemm g{(const bf16*)(F.ws + WS_H8), (const bf16*)(F.ws + W_IN + (size_t)l * INC * D + (size_t)(QKVC + CINC) * D), nrows, GATEC, D / 2}; pg8::StaticOrder S; S.init(nrows, GATEC, F.G, bx);
            pg8::EpiSig E{GATE, GATEC, 1.0f / W13_SCALE};
            pg8::gemm_phase<pg8::EpiSig, pg8::StaticOrder, true, true, true>(F.lds, g, S, E, F.tid);
        } END_PHASE;
        if (RUN && ON(9)) { PH_ENTER
            constexpr int TB = 256 * 512 * 2;
            static_assert((WS_Y3 - BIG_YCT) % TB == 0, "merge tile offsets");
            constexpr int OA = (int)((WS_Y3 - BIG_YCT) / TB), OB = OA + NROW / 256;
            pg8::Gemm g{(const bf16*)(F.ws + BIG_YCT), (const bf16*)(F.ws + W_BR) + (size_t)l * 3 * D * 512, 3 * NROW, 3 * D, 512}; pg8::MergeOrder S{nrows / 256, F.G, bx, OA, OB, 0};
            pg8::EpiMerge E{Hb, GATE, OA, OB, 0};
            pg8::gemm_phase<pg8::EpiMerge, pg8::MergeOrder, true, true>(F.lds, g, S, E, F.tid);
        } END_PHASE;
        if (RUN && ON(10)) { PH_ENTER
            pg8::Gemm g{Hb, (const bf16*)(F.ws + W_OUT) + (size_t)l * D * D, nrows, D, D}; pg8::StaticOrder S; S.init(nrows, D, F.G, bx);
            pg8::EpiPlain E{Y3, D, 0, 0, 1.0f};
            pg8::gemm_phase<pg8::EpiPlain, pg8::StaticOrder, true, true>(F.lds, g, S, E, F.tid);
        } END_PHASE;
        if (RUN && ON(11)) { PH_ENTER if (l == 0) rows_phase<false>(F, a, 1, 0, 0, Y3, nrows); else post_route_phase(F, a, Y3); } END_PHASE;
        if (l == 0) {
            if (RUN && ON(12)) { PH_ENTER
                pg8::Gemm g{Hb, (const bf16*)(F.ws + W_F13), NROW, 2 * DFF, D}; pg8::StaticOrder S; S.init(NROW, 2 * DFF, F.G, bx);
                pg8::EpiSwiGLU E{(bf16*)(F.ws + BIG_HID), DFF, 0};
                pg8::gemm_phase<pg8::EpiSwiGLU, pg8::StaticOrder, true, true>(F.lds, g, S, E, F.tid);
            } END_PHASE;
            if (RUN && ON(13)) { PH_ENTER
                pg8::Gemm g{(const bf16*)(F.ws + BIG_HID), (const bf16*)(F.ws + W_F2), NROW, D, DFF}; pg8::StaticOrder S; S.init(NROW, D, F.G, bx);
                pg8::EpiPlain E{Y3, D, 0, 0, 1.0f};
                pg8::gemm_phase<pg8::EpiPlain, pg8::StaticOrder, true, true>(F.lds, g, S, E, F.tid);
            } END_PHASE;
            if (RUN && ON(14)) { PH_ENTER rows_phase<true>(F, a, 1, 0, 1, Y3, NROW); } END_PHASE;
        } else {
#pragma unroll 1
            for (int half = 0; half < 2; ++half) {
                if (half == 0) { if (RUN && ON(15)) { PH_ENTER moe_convert(F, a); moe_gather_phase(F, 0); } END_PHASE; }
                if (RUN && ON(16)) { PH_ENTER
                    int toff[9], cnt[8]; moe_offsets(F, half, toff, cnt);
                    pg8::GroupOrder S; S.nM = toff[8]; S.nN = 28; S.G = F.G; S.c = bx;
#pragma unroll
                    for (int k = 0; k < 9; ++k) S.toff[k] = toff[k];
                    pg8::Gemm g{(const bf16*)(F.ws + BIG_AS), (const bf16*)(F.ws + WM_13), PCAP, 8 * 2 * DFFE, D / 2};
                    pg8::EpiSwiGLU8 E{F.ws + BIG_MH, DFFE, 28, 1.0f / W13_SCALE, HID_SCALE};
                    pg8::gemm_phase<pg8::EpiSwiGLU8, pg8::GroupOrder, true, true, true>(F.lds, g, S, E, F.tid);
                    if (half == 1) moe_post_phase(F, a, 0);
                } END_PHASE;
                if (RUN && ON(17)) { PH_ENTER
                    int toff[9], cnt[8]; moe_offsets(F, half, toff, cnt);
                    pg8::GroupOrder S; S.nM = toff[8]; S.nN = 4; S.G = F.G; S.c = bx;
#pragma unroll
                    for (int k = 0; k < 9; ++k) S.toff[k] = toff[k];
                    pg8::Gemm g{(const bf16*)(F.ws + BIG_MH), (const bf16*)(F.ws + WM_2), PCAP, 8 * D, DFFE / 2};
                    pg8::EpiPlain E{(bf16*)(F.ws + BIG_Y2S), D, 4, 0, 1.0f / (HID_SCALE * W2_SCALE)};
                    pg8::gemm_phase<pg8::EpiPlain, pg8::GroupOrder, true, true, true>(F.lds, g, S, E, F.tid);
                    if (half == 0) moe_gather_phase(F, 1, toff[8] * 4 - 4 * F.G);
                } END_PHASE;
            }
            if (RUN && ON(18)) { PH_ENTER moe_post_phase(F, a, 1); } END_PHASE;
        }
    }
#undef RUN
#undef END_PHASE
    if (MK_PROBE >= 0 && blockIdx.x == 0 && threadIdx.x == 0) {
        volatile unsigned* pw_ = (volatile unsigned*)(KARGS->ws + WS_CTL) + 20000;
        volatile float* o_ = (volatile float*)KARGS->out;
        o_[0] = o_[0] + floorf((float)pw_[1] * (0.01f / MK_PROBE_DIV));
    }
}

extern "C" void kernel_launch(void* const* d_in, const int* in_sizes, int n_in, void* d_out, int out_size, void* d_ws, size_t ws_size, hipStream_t stream) {
    static int grid = 0;
    if (grid == 0) {
        if (n_in != 31 || in_sizes[0] != NTOK * D || out_size != NTOK * D || ws_size < WS_END) { fprintf(stderr, "kernel_launch: unexpected shapes (n_in %d, in0 %d, out %d, ws %zu)\n", n_in, n_in > 0 ? in_sizes[0] : -1, out_size, ws_size); grid = -1; return; }
        int dev = 0, cus = 0, per_cu = 0;
        if (hipGetDevice(&dev) != hipSuccess || hipDeviceGetAttribute(&cus, hipDeviceAttributeMultiprocessorCount, dev) != hipSuccess) { grid = -1; return; }
        if (hipFuncSetAttribute((const void*)fwd_kernel, hipFuncAttributeMaxDynamicSharedMemorySize, LDS_BYTES) != hipSuccess) { fprintf(stderr, "kernel_launch: hipFuncSetAttribute failed\n"); grid = -1; return; }
        if (hipOccupancyMaxActiveBlocksPerMultiprocessor(&per_cu, (const void*)fwd_kernel, NTHREADS, LDS_BYTES) != hipSuccess || per_cu < 1) { fprintf(stderr, "kernel_launch: occupancy query says %d\n", per_cu); }
        (void)hipGetLastError();
        grid = cus;
    }
    if (grid < 0) return;
    if (hipMemsetAsync((char*)d_ws + WS_CTL, 0, CTL_ZERO_BYTES, stream) != hipSuccess) return;
    Args a{};
    for (int i = 0; i < 31; ++i) a.in[i] = (const float*)d_in[i];
    a.out = (float*)d_out; a.ws = (unsigned char*)d_ws;
#if MK_MULTI
    for (int p = 0; p < NPHASES; ++p) { a.ph_lo = p; a.ph_hi = p + 1; a.sub_mask = 31;
        const bool mix = (p == 3 || p == 12);
        if (((MK_REPMASK >> p) & 1) && !mix) { a.sub_mask = 31 | MK_REPSUB; hipLaunchKernelGGL(fwd_kernel, dim3(grid), dim3(NTHREADS), LDS_BYTES, stream, a); a.sub_mask = 31; }
        if (((MK_REPMASK >> p) & 1) && mix) { a.sub_mask = MK_REPSUB; hipLaunchKernelGGL(fwd_kernel, dim3(grid), dim3(NTHREADS), LDS_BYTES, stream, a); a.sub_mask = 31; }
        hipLaunchKernelGGL(fwd_kernel, dim3(grid), dim3(NTHREADS), LDS_BYTES, stream, a); }
#else
    a.ph_lo = 0; a.ph_hi = NPHASES; a.sub_mask = 31;
    hipLaunchKernelGGL(fwd_kernel, dim3(grid), dim3(NTHREADS), LDS_BYTES, stream, a);
#endif
    const hipError_t le = hipPeekAtLastError();
    if (le != hipSuccess) fprintf(stderr, "kernel_launch: launch failed: %s\n", hipGetErrorName(le));
}
```

```cpp
#include <hip/hip_runtime.h>
#include <cstdio>
#include <cstdint>
namespace pg8 {
#define PG8_LAS __attribute__((address_space(3)))
typedef unsigned short bf16_t;
typedef short bf16x8 __attribute__((ext_vector_type(8)));
typedef float f32x4 __attribute__((ext_vector_type(4)));
typedef unsigned u32x4 __attribute__((ext_vector_type(4)));
constexpr int BM = 256, BK = 64, HALF = 128, HTB = HALF * BK * 2  , STAGE_BYTES = 8 * HTB, NXCD = 8, WGM = 8;

__host__ __device__ __forceinline__ int lds_byte(int r, int c) { const int st = (r >> 4) * 2 + (c >> 5), rr = r & 15, cc = c & 31, ob = rr * 64 + cc * 2; return st * 1024 + (ob ^ (((ob >> 9) & 1) << 5)); }
__host__ __device__ __forceinline__ void stage_rc(int b, int& R, int& C) { const int st = b / 1024, sb = b % 1024, swz = sb ^ (((sb >> 9) & 1) << 5); R = (st >> 1) * 16 + swz / 64; C = (st & 1) * 32 + (swz % 64) / 2; }
__host__ __device__ __forceinline__ int perm32(int rho) { const int n = rho >> 4, i = rho & 15; return 8 * (i >> 2) + 4 * n + (i & 3); }

struct Unit { int pm, pn; };
struct Gemm { const bf16_t* A; const bf16_t* Bt; int M, N, K; };

struct StaticOrder {
    int nM, nN, nwg, G, c;
    __host__ __device__ void init(int M, int N, int G_, int c_) { nM = M / BM; nN = N / BM; nwg = nM * nN; G = G_; c = c_; }
    __host__ __device__ bool next(int i, Unit& u) const {
        const long L = (long)i * G + c; if (L >= nwg) return false;
        int wgid = (int)L; { const int q = nwg / NXCD, r = nwg % NXCD, xcd = wgid % NXCD, off = wgid / NXCD; wgid = (xcd < r ? xcd * (q + 1) : r * (q + 1) + (xcd - r) * q) + off; }
        const int nig = WGM * nN, gid = wgid / nig, fm = gid * WGM, gsz = (nM - fm) < WGM ? (nM - fm) : WGM;
        u.pm = fm + ((wgid % nig) % gsz); u.pn = (wgid % nig) / gsz; return true;
    }
    __device__ __forceinline__ void a_ready(const Unit&) const {}
    __device__ __forceinline__ void done(const Unit&) const {}
};

typedef float f32x2_t __attribute__((ext_vector_type(2)));
typedef __bf16 bf16x2_t __attribute__((ext_vector_type(2)));
__device__ __forceinline__ unsigned cvt_pk_bf16(float lo, float hi) { const f32x2_t v = {lo, hi}; const bf16x2_t b = __builtin_convertvector(v, bf16x2_t); return __builtin_bit_cast(unsigned, b); }
__device__ __forceinline__ u32x4 pack8(f32x4 a, f32x4 b) { u32x4 w; w.x = cvt_pk_bf16(a[0], a[1]); w.y = cvt_pk_bf16(a[2], a[3]); w.z = cvt_pk_bf16(b[0], b[1]); w.w = cvt_pk_bf16(b[2], b[3]); return w; }
__device__ __forceinline__ float bf_lo(unsigned w) { return __builtin_bit_cast(float, w << 16); }
__device__ __forceinline__ float bf_hi(unsigned w) { return __builtin_bit_cast(float, w & 0xffff0000u); }
__device__ __forceinline__ void unpack8(u32x4 w, f32x4& a, f32x4& b) { a = (f32x4){bf_lo(w.x), bf_hi(w.x), bf_lo(w.y), bf_hi(w.y)}; b = (f32x4){bf_lo(w.z), bf_hi(w.z), bf_lo(w.w), bf_hi(w.w)}; }
__device__ __forceinline__ float fast_sigmoid(float x) { return __builtin_amdgcn_rcpf(1.0f + __builtin_amdgcn_exp2f(-1.4426950408889634f * x)); }

__device__ __forceinline__ f32x4 vexp2(f32x4 x) { return (f32x4){__builtin_amdgcn_exp2f(x[0]), __builtin_amdgcn_exp2f(x[1]), __builtin_amdgcn_exp2f(x[2]), __builtin_amdgcn_exp2f(x[3])}; }
__device__ __forceinline__ f32x4 vrcp(f32x4 x) { return (f32x4){__builtin_amdgcn_rcpf(x[0]), __builtin_amdgcn_rcpf(x[1]), __builtin_amdgcn_rcpf(x[2]), __builtin_amdgcn_rcpf(x[3])}; }
__device__ __forceinline__ f32x4 vsigmoid(f32x4 x, float k) { return vrcp(vexp2(x * k) + 1.0f); }
struct EpiPlain {
    static constexpr bool PERM = true, AFTER_DRAIN = false, INPLACE = false;
    bf16_t* O; int ldc; int pn_mod; int accum; float scale;
    __device__ __forceinline__ void operator()(const f32x4 (&acc)[2][2][4][2], const Unit& u, int wr, int wc, int fr, int fq) const {
        asm volatile("" : "+v"(fr), "+v"(fq));
        const int pn = pn_mod ? (u.pn % pn_mod) : u.pn;
        const int row0 = u.pm * BM + wr * 64 + fr, col0 = pn * BM + wc * 32 + 8 * fq;
#pragma unroll
        for (int ai = 0; ai < 2; ++ai)
#pragma unroll
            for (int m = 0; m < 4; ++m) { bf16_t* rowp = O + (size_t)(row0 + ai * HALF + m * 16) * ldc + col0;
#pragma unroll
                for (int bj = 0; bj < 2; ++bj) { f32x4 v0 = acc[ai][bj][m][0] * scale, v1 = acc[ai][bj][m][1] * scale;
                    if (accum) { f32x4 p0, p1; unpack8(*(const u32x4*)(rowp + bj * HALF), p0, p1); v0 = v0 + p0; v1 = v1 + p1; }
                    *(u32x4*)(rowp + bj * HALF) = pack8(v0, v1); } }
    }
};
__device__ __forceinline__ unsigned pack_u8x4(float a, float b, float c, float d) {
    unsigned w = 0; w = __builtin_amdgcn_cvt_pk_u8_f32(a, 0, w); w = __builtin_amdgcn_cvt_pk_u8_f32(b, 1, w); w = __builtin_amdgcn_cvt_pk_u8_f32(c, 2, w); w = __builtin_amdgcn_cvt_pk_u8_f32(d, 3, w); return w; }
struct EpiSig {
    static constexpr bool PERM = true, AFTER_DRAIN = false, INPLACE = false;
    unsigned char* O; int ldc; float in_scale;
    __device__ __forceinline__ void operator()(const f32x4 (&acc)[2][2][4][2], const Unit& u, int wr, int wc, int fr, int fq) const {
        const int t = ((wr * 4 + wc) * 4 + fq) * 16 + fr;
        unsigned char* tile = O + ((size_t)u.pm * (ldc / BM) + u.pn) * (BM * BM) + (size_t)t * 16;
        const float k = -1.4426950408889634f * in_scale;
#pragma unroll
        for (int ai = 0; ai < 2; ++ai)
#pragma unroll
            for (int m = 0; m < 4; ++m) { u32x4 w;
                { const f32x4 v0 = vsigmoid(acc[ai][0][m][0], k) * 255.0f, v1 = vsigmoid(acc[ai][0][m][1], k) * 255.0f;
                  w.x = pack_u8x4(fmaxf(v0[0], 1.f), fmaxf(v0[1], 1.f), fmaxf(v0[2], 1.f), fmaxf(v0[3], 1.f)); w.y = pack_u8x4(fmaxf(v1[0], 1.f), fmaxf(v1[1], 1.f), fmaxf(v1[2], 1.f), fmaxf(v1[3], 1.f)); }
                { const f32x4 v0 = vsigmoid(acc[ai][1][m][0], k) * 255.0f, v1 = vsigmoid(acc[ai][1][m][1], k) * 255.0f;
                  w.z = pack_u8x4(fmaxf(v0[0], 1.f), fmaxf(v0[1], 1.f), fmaxf(v0[2], 1.f), fmaxf(v0[3], 1.f)); w.w = pack_u8x4(fmaxf(v1[0], 1.f), fmaxf(v1[1], 1.f), fmaxf(v1[2], 1.f), fmaxf(v1[3], 1.f)); }
                *(u32x4*)(tile + (ai * 4 + m) * (512 * 16)) = w; }
    }
};
struct EpiSwiGLU {
    static constexpr bool PERM = true, AFTER_DRAIN = false, INPLACE = false;
    bf16_t* O; int ldc; int pn_mod;
    __device__ __forceinline__ void operator()(const f32x4 (&acc)[2][2][4][2], const Unit& u, int wr, int wc, int fr, int fq) const {
        const int pn = pn_mod ? (u.pn % pn_mod) : u.pn;
        const int row0 = u.pm * BM + wr * 64 + fr, col0 = pn * HALF + wc * 32 + 8 * fq;
#pragma unroll
        for (int ai = 0; ai < 2; ++ai)
#pragma unroll
            for (int m = 0; m < 4; ++m) { bf16_t* rowp = O + (size_t)(row0 + ai * HALF + m * 16) * ldc + col0;
                const f32x4 a0 = acc[ai][0][m][0], a1 = acc[ai][0][m][1], g0 = acc[ai][1][m][0], g1 = acc[ai][1][m][1];
                const f32x4 v0 = (a0 * g0) * vsigmoid(a0, -1.4426950408889634f), v1 = (a1 * g1) * vsigmoid(a1, -1.4426950408889634f);
                *(u32x4*)rowp = pack8(v0, v1); }
    }
};
__device__ __forceinline__ unsigned pack_fp8x4(float a, float b, float c, float d) {
    a = __builtin_amdgcn_fmed3f(a, -448.f, 448.f); b = __builtin_amdgcn_fmed3f(b, -448.f, 448.f); c = __builtin_amdgcn_fmed3f(c, -448.f, 448.f); d = __builtin_amdgcn_fmed3f(d, -448.f, 448.f);
    int w = 0; w = __builtin_amdgcn_cvt_pk_fp8_f32(a, b, w, false); w = __builtin_amdgcn_cvt_pk_fp8_f32(c, d, w, true); return (unsigned)w; }
struct EpiSwiGLU8 {
    static constexpr bool PERM = true, AFTER_DRAIN = false, INPLACE = false;
    unsigned char* O; int ldc; int pn_mod; float in_scale, out_scale;
    __device__ __forceinline__ void operator()(const f32x4 (&acc)[2][2][4][2], const Unit& u, int wr, int wc, int fr, int fq) const {
        asm volatile("" : "+v"(fr), "+v"(fq));
        const int pn = pn_mod ? (u.pn % pn_mod) : u.pn;
        const int row0 = u.pm * BM + wr * 64 + fr, col0 = pn * HALF + wc * 32 + 8 * fq;
#pragma unroll
        for (int ai = 0; ai < 2; ++ai)
#pragma unroll
            for (int m = 0; m < 4; ++m) { unsigned char* rowp = O + (size_t)(row0 + ai * HALF + m * 16) * ldc + col0;
                const f32x4 a0 = acc[ai][0][m][0], a1 = acc[ai][0][m][1], g0 = acc[ai][1][m][0], g1 = acc[ai][1][m][1];
                const float k1 = -1.4426950408889634f * in_scale, k2 = in_scale * in_scale * out_scale;
                const f32x4 v0 = ((a0 * g0) * vsigmoid(a0, k1)) * k2, v1 = ((a1 * g1) * vsigmoid(a1, k1)) * k2;
                typedef unsigned u32x2_ __attribute__((ext_vector_type(2)));
                u32x2_ w; w.x = pack_fp8x4(v0[0], v0[1], v0[2], v0[3]); w.y = pack_fp8x4(v1[0], v1[1], v1[2], v1[3]);
                *(u32x2_*)rowp = w; }
    }
};
struct EpiMerge {
    static constexpr bool PERM = true, AFTER_DRAIN = false, INPLACE = true;
    bf16_t* Mo; const unsigned char* Gt; int off0, off1, off2;
    __device__ __forceinline__ static void ub4(unsigned w, f32x4& v) { v = (f32x4){(float)(w & 0xffu), (float)((w >> 8) & 0xffu), (float)((w >> 16) & 0xffu), (float)(w >> 24)}; }
    __device__ __forceinline__ bool inplace(f32x4 (&acc)[2][2][4][2], const Unit& u, int wr, int wc, int fr, int fq) const {
        const int br = u.pn >> 2, pn = u.pn & 3, pm = u.pm - (br < 2 ? off0 + br * (off1 - off0) : off2);
        const int row0 = pm * BM + wr * 64 + fr, col0 = pn * BM + wc * 32 + 8 * fq;
        const int t = ((wr * 4 + wc) * 4 + fq) * 16 + fr;
        const unsigned char* gt = Gt + ((size_t)pm * 12 + br * 4 + pn) * (BM * BM) + (size_t)t * 16;
#pragma unroll
        for (int ai = 0; ai < 2; ++ai)
#pragma unroll
            for (int m = 0; m < 4; ++m) { const size_t row = (size_t)(row0 + ai * HALF + m * 16);
                const u32x4 gq = *(const u32x4*)(gt + (ai * 4 + m) * (512 * 16));
                if (br < 2) { const u32x4 nq = *(const u32x4*)(gt + 4 * (BM * BM) + (ai * 4 + m) * (512 * 16));
#pragma unroll
                    for (int bj = 0; bj < 2; ++bj) { f32x4 g0, g1, n0, n1; ub4(bj ? gq.z : gq.x, g0); ub4(bj ? gq.w : gq.y, g1); ub4(bj ? nq.z : nq.x, n0); ub4(bj ? nq.w : nq.y, n1);
#pragma unroll
                        for (int e = 0; e < 4; ++e) { g0[e] = g0[e] * __builtin_amdgcn_rcpf(n0[e]); g1[e] = g1[e] * __builtin_amdgcn_rcpf(n1[e]); }
                        acc[ai][bj][m][0] = acc[ai][bj][m][0] * g0; acc[ai][bj][m][1] = acc[ai][bj][m][1] * g1; }
                } else {
#pragma unroll
                    for (int bj = 0; bj < 2; ++bj) { f32x4 g0, g1; ub4(bj ? gq.z : gq.x, g0); ub4(bj ? gq.w : gq.y, g1);
                        *(u32x4*)(Mo + row * 1024 + col0 + bj * HALF) = pack8(acc[ai][bj][m][0] * (g0 * (1.0f / 255.0f)), acc[ai][bj][m][1] * (g1 * (1.0f / 255.0f))); }
                } }
        return br < 2;
    }
};
struct EpiQKV {
    static constexpr bool PERM = true, AFTER_DRAIN = false, INPLACE = false;
    bf16_t* O; const float* rope; int row_base; float qscale; float in_scale;
    __device__ __forceinline__ void operator()(const f32x4 (&acc)[2][2][4][2], const Unit& u, int wr, int wc, int fr, int fq) const {
        const int rowt = row_base + u.pm * BM;
        const bool latent = rowt < 65536;
        const int row0 = rowt + wr * 64 + fr, col0 = u.pn * BM + wc * 32 + 8 * fq;
#pragma unroll
        for (int bj = 0; bj < 2; ++bj) {
            const int cb = 2 * u.pn + bj;
            const bool do_rope = latent && (cb == 0 || (cb >= 10 && cb < 14));
            const float sc = (cb >= 10) ? qscale * in_scale : in_scale;
#pragma unroll
            for (int ai = 0; ai < 2; ++ai)
#pragma unroll
                for (int m = 0; m < 4; ++m) {
                    const int row = row0 + ai * HALF + m * 16;
                    f32x4 v0 = acc[ai][bj][m][0], v1 = acc[ai][bj][m][1];
                    if (do_rope) {
                        const int t = row & 2047, pos = (wc & 1) ? (t & 63) : (t >> 6);
                        const float* cp = rope + pos * 16 + 8 * (fq & 1);
                        const f32x4 c0 = *(const f32x4*)cp, c1 = *(const f32x4*)(cp + 4), s0 = *(const f32x4*)(cp + 1024), s1 = *(const f32x4*)(cp + 1028);
                        const float sg = (fq >= 2) ? 1.0f : -1.0f;
                        f32x4 o0, o1;
#pragma unroll
                        for (int e = 0; e < 4; ++e) { o0[e] = __shfl_xor(v0[e], 32); o1[e] = __shfl_xor(v1[e], 32); }
                        v0 = v0 * c0 + (o0 * sg) * s0; v1 = v1 * c1 + (o1 * sg) * s1;
                    }
                    v0 = v0 * sc; v1 = v1 * sc;
                    *(u32x4*)(O + (size_t)row * 2304 + col0 + bj * HALF) = pack8(v0, v1);
                }
        }
    }
};
__device__ __forceinline__ void tile_of(int L, int nM, int nN, int& pm, int& pn) {
    const int nwg = nM * nN; int wgid = L; { const int q = nwg / NXCD, r = nwg % NXCD, xcd = wgid % NXCD, off = wgid / NXCD; wgid = (xcd < r ? xcd * (q + 1) : r * (q + 1) + (xcd - r) * q) + off; }
    const int nig = WGM * nN, gid = wgid / nig, fm = gid * WGM, gsz = (nM - fm) < WGM ? (nM - fm) : WGM;
    pm = fm + ((wgid % nig) % gsz); pn = (wgid % nig) / gsz;
}
struct MergeOrder {
    int nM, G, c, off0, off1, off2;
    __device__ bool next(int i, Unit& u) const {
        const int t = i / 3, br = i - 3 * t; const long L = (long)t * G + c; if (L >= (long)nM * 4) return false;
        int pm, pn; tile_of((int)L, nM, 4, pm, pn); u.pm = (br < 2 ? off0 + br * (off1 - off0) : off2) + pm; u.pn = br * 4 + pn; return true;
    }
    __device__ __forceinline__ void a_ready(const Unit&) const {}
    __device__ __forceinline__ void done(const Unit&) const {}
};
struct GroupOrder {
    int nM, nN, G, c; int toff[9];
    __device__ bool next(int i, Unit& u) const {
        const long L = (long)i * G + c; if (L >= (long)nM * nN) return false;
        int pm, pn; tile_of((int)L, nM, nN, pm, pn); int e = 0;
#pragma unroll
        for (int k = 1; k < 8; ++k) e += (pm >= toff[k]) ? 1 : 0;
        u.pm = pm; u.pn = e * nN + pn; return true;
    }
    __device__ __forceinline__ void a_ready(const Unit&) const {}
    __device__ __forceinline__ void done(const Unit&) const {}
};
template <class Epi, class Sched, bool ALIGN_EPI = false, bool SP2 = false, bool F8 = false>
__device__ __forceinline__ void gemm_phase(PG8_LAS unsigned char* lds, const Gemm g, const Sched& S, const Epi& E, const int tid) {
    const int wid = __builtin_amdgcn_readfirstlane(tid >> 6), lane = tid & 63, wr = wid >> 2, wc = wid & 3, fr = lane & 15, fq = lane >> 4;
    const int K = g.K, nt = K / BK;
    unsigned voffA[2], voffB[2];
#pragma unroll
    for (int i = 0; i < 2; ++i) { int R, C; stage_rc(tid * 16 + i * 8192, R, C); const int Rb = Epi::PERM ? ((R & ~31) + perm32(R & 31)) : R;
        voffA[i] = (unsigned)(R * K + C) * 2u; voffB[i] = (unsigned)(Rb * K + C) * 2u; }
    const size_t kstep = (size_t)(BK * 2);
    const size_t hstep = (size_t)HALF * K * 2;
    const size_t tstep = 2 * hstep;
    const unsigned ldsw = (unsigned)wid * 1024u;
    const int aoff = lds_byte(wr * 64 + fr, fq * 8), boff = lds_byte(wc * 32 + fr, fq * 8);
#define PG8_SA(b, h) (((b) * 2 + (h)) * HTB)
#define PG8_SB(b, h) ((4 + (b) * 2 + (h)) * HTB)
#define PG8_STAGE(bufoff, gbase, voff) do { _Pragma("unroll") for (int _i = 0; _i < 2; ++_i) \
        __builtin_amdgcn_global_load_lds((const unsigned*)((const char*)(gbase) + (voff)[_i]), (PG8_LAS unsigned*)(lds + (bufoff) + ldsw + _i * 8192), 16, 0, 0); } while (0)
#define PG8_LDA(dst, b, h) do { _Pragma("unroll") for (int m = 0; m < 4; ++m) _Pragma("unroll") for (int k = 0; k < 2; ++k) dst[m][k] = *(const PG8_LAS bf16x8*)(lds + PG8_SA(b, h) + aoff + m * 2048 + k * 1024); } while (0)
#define PG8_LDB(dst, b, h) do { _Pragma("unroll") for (int n = 0; n < 2; ++n) _Pragma("unroll") for (int k = 0; k < 2; ++k) dst[n][k] = *(const PG8_LAS bf16x8*)(lds + PG8_SB(b, h) + boff + n * 2048 + k * 1024); } while (0)
#define PG8_MMA(ai, bj, At, Bt) do { __builtin_amdgcn_s_setprio(1); _Pragma("unroll") for (int m = 0; m < 4; ++m) _Pragma("unroll") for (int n = 0; n < 2; ++n) { \
        if constexpr (F8) { typedef int v8i_ __attribute__((ext_vector_type(8))); typedef int v4i_ __attribute__((ext_vector_type(4))); \
            const v4i_ b0_ = __builtin_bit_cast(v4i_, Bt[n][0]), b1_ = __builtin_bit_cast(v4i_, Bt[n][1]), a0_ = __builtin_bit_cast(v4i_, At[m][0]), a1_ = __builtin_bit_cast(v4i_, At[m][1]); \
            const v8i_ bb_ = __builtin_shufflevector(b0_, b1_, 0, 1, 2, 3, 4, 5, 6, 7), aa_ = __builtin_shufflevector(a0_, a1_, 0, 1, 2, 3, 4, 5, 6, 7); \
            asm volatile("v_mfma_scale_f32_16x16x128_f8f6f4 %0, %1, %2, %0, %3, %3 op_sel_hi:[0,0,0]" : "+v"(acc[ai][bj][m][n]) : "v"(bb_), "v"(aa_), "v"(f8_scale_)); } \
        else { _Pragma("unroll") for (int k = 0; k < 2; ++k) acc[ai][bj][m][n] = __builtin_amdgcn_mfma_f32_16x16x32_bf16(Bt[n][k], At[m][k], acc[ai][bj][m][n], 0, 0, 0); } } \
        __builtin_amdgcn_s_setprio(0); } while (0)
#define PG8_WAIT_V(n) asm volatile("s_waitcnt vmcnt(" #n ")" ::: "memory")
#define PG8_WAIT_L(n) asm volatile("s_waitcnt lgkmcnt(" #n ")" ::: "memory")
#define PG8_BAR __builtin_amdgcn_s_barrier()
#define PG8_SCHED __builtin_amdgcn_sched_barrier(0)
    int f8_scale_ = 0x7f7f7f7f; (void)f8_scale_;
    Unit cur, nxt; int ui = 0;
    if (!S.next(0, cur)) return;
    f32x4 acc[2][2][4][2];
#pragma unroll
    for (int a = 0; a < 2; ++a)
#pragma unroll
        for (int b = 0; b < 2; ++b)
#pragma unroll
            for (int m = 0; m < 4; ++m)
#pragma unroll
                for (int n = 0; n < 2; ++n) acc[a][b][m][n] = (f32x4){0.f, 0.f, 0.f, 0.f};
    bf16x8 At[4][2], B0[2][2], B1[2][2];
    const char* cA = (const char*)g.A + (size_t)cur.pm * tstep; const char* cB = (const char*)g.Bt + (size_t)cur.pn * tstep;
    S.a_ready(cur);
    if constexpr (SP2) {
        PG8_STAGE(PG8_SB(0, 0), cB, voffB); PG8_STAGE(PG8_SB(0, 1), cB + hstep, voffB); PG8_STAGE(PG8_SA(0, 0), cA, voffA); PG8_STAGE(PG8_SA(0, 1), cA + hstep, voffA);
        if (wr == 1) PG8_BAR;
        PG8_WAIT_V(2); PG8_BAR;
        PG8_STAGE(PG8_SB(1, 0), cB + kstep, voffB); PG8_STAGE(PG8_SA(1, 0), cA + kstep, voffA); PG8_STAGE(PG8_SB(1, 1), cB + hstep + kstep, voffB);
        PG8_WAIT_V(6); PG8_BAR;
    } else {
        PG8_STAGE(PG8_SB(0, 0), cB, voffB); PG8_STAGE(PG8_SA(0, 0), cA, voffA); PG8_STAGE(PG8_SB(0, 1), cB + hstep, voffB); PG8_STAGE(PG8_SA(0, 1), cA + hstep, voffA);
        if (wr == 1) PG8_BAR;
        PG8_WAIT_V(4); PG8_BAR;
        PG8_STAGE(PG8_SB(1, 0), cB + kstep, voffB); PG8_STAGE(PG8_SA(1, 0), cA + kstep, voffA); PG8_STAGE(PG8_SB(1, 1), cB + hstep + kstep, voffB);
        PG8_WAIT_V(6); PG8_BAR;
    }
    for (;;) {
        const bool has_next = S.next(ui + 1, nxt);
        const char* nA = has_next ? (const char*)g.A + (size_t)nxt.pm * tstep : cA; const char* nB = has_next ? (const char*)g.Bt + (size_t)nxt.pn * tstep : cB;
#pragma unroll 1
        for (int t = 0; t < nt; t += 2) {
            const bool last = (t == nt - 2);
            const char* a1 = cA + (size_t)(t + 1) * kstep;
            const char* a2 = last ? nA : cA + (size_t)(t + 2) * kstep; const char* b2 = last ? nB : cB + (size_t)(t + 2) * kstep;
            const char* a3 = a2 + kstep; const char* b3 = b2 + kstep;
            if (last && has_next) S.a_ready(nxt);
            if constexpr (SP2) {
            PG8_LDB(B0, 0, 0); PG8_LDB(B1, 0, 1); PG8_SCHED; PG8_LDA(At, 0, 0); PG8_STAGE(PG8_SA(1, 1), a1 + hstep, voffA);
            PG8_WAIT_V(8); PG8_WAIT_L(0); PG8_BAR; PG8_MMA(0, 0, At, B0); PG8_MMA(0, 1, At, B1); PG8_BAR; PG8_SCHED;
            PG8_LDA(At, 0, 1); PG8_STAGE(PG8_SB(0, 0), b2, voffB); PG8_STAGE(PG8_SB(0, 1), b2 + hstep, voffB); PG8_STAGE(PG8_SA(0, 0), a2, voffA);
            PG8_WAIT_V(8); PG8_WAIT_L(0); PG8_BAR; PG8_MMA(1, 0, At, B0); PG8_MMA(1, 1, At, B1); PG8_BAR; PG8_SCHED;
            PG8_LDB(B0, 1, 0); PG8_LDB(B1, 1, 1); PG8_SCHED; PG8_LDA(At, 1, 0); PG8_STAGE(PG8_SA(0, 1), a2 + hstep, voffA);
            PG8_WAIT_V(8); PG8_WAIT_L(0); PG8_BAR; PG8_MMA(0, 0, At, B0); PG8_MMA(0, 1, At, B1); PG8_BAR; PG8_SCHED;
            PG8_LDA(At, 1, 1); PG8_STAGE(PG8_SB(1, 0), b3, voffB); PG8_STAGE(PG8_SB(1, 1), b3 + hstep, voffB); PG8_STAGE(PG8_SA(1, 0), a3, voffA);
            PG8_WAIT_V(8); PG8_WAIT_L(0); PG8_BAR; PG8_MMA(1, 0, At, B0); PG8_MMA(1, 1, At, B1); PG8_BAR; PG8_SCHED;
            } else {
            PG8_LDB(B0, 0, 0); PG8_SCHED; PG8_LDA(At, 0, 0); PG8_STAGE(PG8_SA(1, 1), a1 + hstep, voffA);
            PG8_WAIT_L(8); PG8_BAR; PG8_WAIT_L(0); PG8_MMA(0, 0, At, B0); PG8_BAR; PG8_SCHED;
            PG8_LDB(B1, 0, 1); PG8_STAGE(PG8_SB(0, 0), b2, voffB);
            PG8_BAR; PG8_WAIT_L(0); PG8_MMA(0, 1, At, B1); PG8_BAR;
            PG8_LDA(At, 0, 1); PG8_STAGE(PG8_SA(0, 0), a2, voffA);
            PG8_BAR; PG8_WAIT_L(0); PG8_MMA(1, 0, At, B0); PG8_BAR; PG8_SCHED;
            PG8_STAGE(PG8_SB(0, 1), b2 + hstep, voffB);
            PG8_WAIT_V(6); PG8_BAR; PG8_MMA(1, 1, At, B1); PG8_BAR;
            PG8_LDB(B0, 1, 0); PG8_SCHED; PG8_LDA(At, 1, 0); PG8_STAGE(PG8_SA(0, 1), a2 + hstep, voffA);
            PG8_WAIT_L(8); PG8_BAR; PG8_WAIT_L(0); PG8_MMA(0, 0, At, B0); PG8_BAR; PG8_SCHED;
            PG8_LDB(B1, 1, 1); PG8_STAGE(PG8_SB(1, 0), b3, voffB);
            PG8_BAR; PG8_WAIT_L(0); PG8_MMA(0, 1, At, B1); PG8_BAR;
            PG8_LDA(At, 1, 1); PG8_STAGE(PG8_SA(1, 0), a3, voffA);
            PG8_BAR; PG8_WAIT_L(0); PG8_MMA(1, 0, At, B0); PG8_BAR; PG8_SCHED;
            PG8_STAGE(PG8_SB(1, 1), b3 + hstep, voffB);
            PG8_WAIT_V(6); PG8_BAR; PG8_MMA(1, 1, At, B1); PG8_BAR;
            }
        }
        if constexpr (ALIGN_EPI) { if (wr == 0) PG8_BAR; }
        if constexpr (F8) asm volatile("s_nop 15\n\ts_nop 15" ::: "memory");
        bool keep_acc = false;
        if constexpr (Epi::INPLACE) { keep_acc = E.inplace(acc, cur, wr, wc, fr, fq); S.done(cur); }
        else if constexpr (!Epi::AFTER_DRAIN) { E(acc, cur, wr, wc, fr, fq); S.done(cur); }
        if (!has_next) break;
        if (!keep_acc)
#pragma unroll
        for (int a = 0; a < 2; ++a)
#pragma unroll
            for (int b = 0; b < 2; ++b)
#pragma unroll
                for (int m = 0; m < 4; ++m)
#pragma unroll
                    for (int n = 0; n < 2; ++n) acc[a][b][m][n] = (f32x4){0.f, 0.f, 0.f, 0.f};
        cur = nxt; cA = nA; cB = nB; ++ui;
        if constexpr (ALIGN_EPI) { if (wr == 1) PG8_BAR; }
    }
    PG8_WAIT_V(0);
    if constexpr (!ALIGN_EPI) { if (wr == 0) PG8_BAR; }
    PG8_BAR;
    if constexpr (Epi::AFTER_DRAIN) { E.fused(acc, cur, wr, wc, fr, fq, lds, wid, lane); S.done(cur); }
#undef PG8_SA
#undef PG8_SB
#undef PG8_STAGE
#undef PG8_LDA
#undef PG8_LDB
#undef PG8_MMA
#undef PG8_WAIT_V
#undef PG8_WAIT_L
#undef PG8_BAR
#undef PG8_SCHED
}
}
#define GAS __attribute__((address_space(1)))
#define LAS __attribute__((address_space(3)))
typedef unsigned short bf16;
typedef unsigned v4u __attribute__((ext_vector_type(4)));
typedef float f32x4 __attribute__((ext_vector_type(4)));
typedef short bf16x8 __attribute__((ext_vector_type(8)));
typedef GAS unsigned gu32;
typedef GAS unsigned long long gu64;
#define RLX_AGENT __ATOMIC_RELAXED, __HIP_MEMORY_SCOPE_AGENT
#define LDS_WAIT() asm volatile("s_waitcnt lgkmcnt(0)" ::: "memory")
#define VM_WAIT() asm volatile("s_waitcnt vmcnt(0)" ::: "memory")
__device__ __forceinline__ unsigned long long rt() { return __builtin_amdgcn_s_memrealtime(); }
__device__ __forceinline__ unsigned f2bf(float f) { unsigned u = __builtin_bit_cast(unsigned, f); return (u + 0x7fffu + ((u >> 16) & 1u)) >> 16; }
__device__ __forceinline__ unsigned pk2(float lo, float hi) { return pg8::cvt_pk_bf16(lo, hi); }

#define XB_TMO      128
#define XB_XCNT(j)  (256  + 64 * (j))
#define XB_XSUB(j)  (1280 + 64 * (j))
#define XB_XGEN(j)  (2304 + 64 * (j))
#define XB_TOP      3328
#define XB_TOPGEN   3392
#define XCD_BAR_WORDS 3456
#define XB_SPIN_CAP (1u << 18)

__device__ __forceinline__ unsigned xb_ld(unsigned* p)              { return __hip_atomic_load(p, __ATOMIC_RELAXED, __HIP_MEMORY_SCOPE_AGENT); }
__device__ __forceinline__ unsigned xb_add(unsigned* p, unsigned v) { return __hip_atomic_fetch_add(p, v, __ATOMIC_RELAXED, __HIP_MEMORY_SCOPE_AGENT); }
__device__ __forceinline__ unsigned xb_xcc_id() { return (unsigned)__builtin_amdgcn_s_getreg((3 << 11) | 20) & 0xFu; }
#define XB_SPIN(cond, bar) do { unsigned _sp = 0; while (cond) { __builtin_amdgcn_s_sleep(1); \
    if ((++_sp & 255u) == 0u) { if (xb_ld(&(bar)[XB_TMO])) break; if (_sp > XB_SPIN_CAP) { atomicAdd(&(bar)[XB_TMO], 1u); break; } } } } while (0)

struct XcdBarrier {
    unsigned* bar; unsigned x;
    volatile LAS unsigned* st;
};

__device__ __forceinline__ XcdBarrier xcd_barrier_post(unsigned* bar, volatile LAS unsigned* st) {
    XcdBarrier b; b.bar = bar; b.x = xb_xcc_id(); b.st = st;
    if (threadIdx.x == 0) (void)xb_add(&bar[XB_XCNT(b.x)], 1u);
    return b;
}
__device__ __forceinline__ void xcd_barrier_complete(unsigned* bar, unsigned x, unsigned& nloc, unsigned& nx) {
    const unsigned G = gridDim.x * gridDim.y * gridDim.z;
    unsigned sum, cnt, mine, sp = 0u;
    for (;;) {
        sum = 0u; cnt = 0u; mine = 0u;
#pragma unroll
        for (unsigned j = 0; j < 16; ++j) { const unsigned c = xb_ld(&bar[XB_XCNT(j)]); sum += c; cnt += (c > 0u) ? 1u : 0u; mine = (j == x) ? c : mine; }
        if (sum == G) break;
        __builtin_amdgcn_s_sleep(1);
        if ((++sp & 255u) == 0u) { if (xb_ld(&bar[XB_TMO])) break; if (sp > XB_SPIN_CAP) { atomicAdd(&bar[XB_TMO], 1u); break; } }
    }
    nloc = mine > 0u ? mine : 1u; nx = cnt > 0u ? cnt : 1u;
}

__device__ __forceinline__ void xcd_barrier(const XcdBarrier& b) {
    asm volatile("s_waitcnt vmcnt(0)" ::: "memory");
    __syncthreads();
    if (threadIdx.x == 0) {
        unsigned* bar = b.bar;
        __builtin_amdgcn_s_waitcnt(0);
        unsigned nloc = b.st[0], nx = b.st[1];
        if (nloc == 0u) { xcd_barrier_complete(bar, b.x, nloc, nx); b.st[0] = nloc; b.st[1] = nx; }
        const unsigned old = xb_add(&bar[XB_XSUB(b.x)], 1u);
        const unsigned gen = old / nloc;
        if (old + 1u == (gen + 1u) * nloc) {
            __builtin_amdgcn_fence(__ATOMIC_RELEASE, "agent");
            asm volatile("s_waitcnt vmcnt(0)" ::: "memory");
            const unsigned og = xb_add(&bar[XB_TOP], 1u);
            const unsigned tg = og / nx;
            if (og + 1u == (tg + 1u) * nx) xb_add(&bar[XB_TOPGEN], 1u);
            else XB_SPIN(xb_ld(&bar[XB_TOPGEN]) == tg, bar);
            __builtin_amdgcn_fence(__ATOMIC_ACQUIRE, "agent");
            xb_add(&bar[XB_XGEN(b.x)], 1u);
            asm volatile("s_waitcnt vmcnt(0)" ::: "memory");
        } else {
            XB_SPIN(xb_ld(&bar[XB_XGEN(b.x)]) == gen, bar);
            __builtin_amdgcn_fence(__ATOMIC_ACQUIRE, "agent");
            asm volatile("s_waitcnt vmcnt(0)" ::: "memory");
        }
    }
    __syncthreads();
}

typedef float f32x16 __attribute__((ext_vector_type(16)));
typedef short s16x4 __attribute__((ext_vector_type(4)));
typedef unsigned v2u __attribute__((ext_vector_type(2)));
#define MFMA32(a, b, c) __builtin_amdgcn_mfma_f32_32x32x16_bf16((a), (b), (c), 0, 0, 0)

constexpr int NWAVES = 8, NTHREADS = 512;
constexpr int D = 1024, NB = 32, SEQ = 2048, LC = 256, NTOK = NB * SEQ, NCTX = NB * LC, NROW = NTOK + NCTX;
constexpr int INC = 6912, QKVC = 2304, CINC = 1536, GATEC = 3072, DFF = 2816, NEXP = 8, DFFE = 3584, FCH = 1792;
constexpr float W13_SCALE = 32.f, W2_SCALE = 64.f, HID_SCALE = 4.f;
constexpr float LOG2E = 1.4426950408889634f, QSCALE = 0.125f * LOG2E, EPS = 1e-6f;
constexpr int PCAP = 32768 * 2 + 8 * 256;

constexpr size_t MiB = 1u << 20;
constexpr size_t WS_CTL = 0, CTL_ZERO_BYTES = 1 * MiB;
constexpr size_t WS_MODV = 1 * MiB;
constexpr size_t WS_ROPE = 3 * MiB;
constexpr size_t WS_ROUTE = 4 * MiB;
constexpr size_t WS_LIST = 5 * MiB;
constexpr size_t WS_INV = 7 * MiB;
constexpr size_t WS_GF = 8 * MiB;
constexpr size_t WS_GFC = 24 * MiB;
constexpr size_t WS_W = 26 * MiB;
constexpr size_t W_IN = WS_W;
constexpr size_t W_CB = W_IN + (size_t)2 * INC * D;
constexpr size_t W_BR = W_IN + (size_t)2 * INC * D * 2;
constexpr size_t W_OUT = W_BR + (size_t)2 * 3 * D * 512 * 2;
constexpr size_t W_F13 = W_OUT + (size_t)2 * D * D * 2;
constexpr size_t W_F2 = W_F13 + (size_t)2 * DFF * D * 2;
constexpr size_t W_END = W_F2 + (size_t)D * DFF * 2;
constexpr size_t WS_CTXRES = 80 * MiB;
constexpr size_t WS_XB = 112 * MiB;
constexpr size_t WS_BIG = 256 * MiB;
constexpr size_t BIG_CINT = WS_BIG;
constexpr size_t BIG_QKV = WS_BIG + 216 * MiB;
constexpr size_t BIG_GATE = WS_BIG + 72 * MiB;
constexpr size_t BIG_YCT = WS_BIG + 288 * MiB;
constexpr size_t BIG_HID = WS_BIG;
constexpr size_t BIG_RAW = WS_BIG;
constexpr size_t BIG_AS = WS_BIG;
constexpr size_t BIG_MH = WS_BIG + 68 * MiB;
constexpr size_t BIG_Y2S = WS_BIG + 300 * MiB;
constexpr size_t WS_Y3 = 796 * MiB;
constexpr size_t WM_13 = WS_Y3;
constexpr size_t WM_2 = WS_Y3 + 56 * MiB;
constexpr size_t WS_H8 = WS_Y3 + 144 * MiB;
constexpr size_t WS_END = 1012 * MiB;
static_assert(W_END <= WS_CTXRES && BIG_Y2S + (size_t)PCAP * D * 2 <= WS_Y3 && BIG_QKV + (size_t)NROW * QKVC * 2 <= WS_Y3 && BIG_GATE + (size_t)NROW * GATEC <= WS_Y3, "ws map");
static_assert(BIG_MH + (size_t)PCAP * DFFE <= BIG_Y2S && BIG_AS + (size_t)PCAP * D <= BIG_MH && WM_13 + (size_t)8 * 2 * DFFE * D <= WM_2 && WM_2 + (size_t)8 * D * DFFE <= WS_END, "ws map 2");

constexpr int CW_BAR = 4096;
constexpr int CW_CNT = 16384;

constexpr int LDS_BYTES = 150528, MISC_OFF = 147456;


struct Args {
    const float* in[31];
    float* out; unsigned char* ws;
    int ph_lo, ph_hi, sub_mask, pad;
};
enum { I_X = 0, I_C, I_CTX, I_CCTX, I_WMOD, I_BMOD, I_GMIXPRE, I_GMIXPOST, I_GFFNPRE, I_GFFNPOST, I_WIN, I_SINK, I_RPB, I_CONVW, I_CONVB, I_HW1, I_HB1, I_HW2, I_HB2, I_HW3,
       I_HFREQ, I_HBIAS, I_WBR, I_WOUT, I_FW1, I_FW3, I_FW2, I_ROUTER, I_MW1, I_MW3, I_MW2 };

struct Frame {
    LAS unsigned char* lds;
    int tid, lane, wave, vcu, G;
    unsigned char* ws;
    bf16* hb;
};

__device__ __forceinline__ float wave_sum(float v) {
#pragma unroll
    for (int o = 1; o < 64; o <<= 1) v += __shfl_xor(v, o);
    return v;
}
__device__ __forceinline__ float bf2f(bf16 b) { return __builtin_bit_cast(float, ((unsigned)b) << 16); }
__device__ __forceinline__ float silu_f(float x) { return x / (1.0f + __expf(-x)); }

__device__ __forceinline__ void transpose_item(const float* W, int N, bf16* WT, int Kp, int k0, int n0, int drow0, LAS float* scr, int lane) {
    { const int c4 = 4 * (lane & 7);
#pragma unroll
      for (int i = 0; i < 8; ++i) { const int kk = (lane >> 3) + 8 * i; const f32x4 v = *(const f32x4*)(W + (size_t)(k0 + kk) * N + n0 + c4); LAS float* d = scr + kk * 33 + c4; d[0] = v.x; d[1] = v.y; d[2] = v.z; d[3] = v.w; } }
    LDS_WAIT(); asm volatile("" ::: "memory");
    const int c = lane & 7;
#pragma unroll
    for (int j = 0; j < 4; ++j) { const int n = (lane >> 3) + 8 * j; const LAS float* s = scr + (8 * c) * 33 + n;
        v4u o; o.x = pk2(s[0 * 33], s[1 * 33]); o.y = pk2(s[2 * 33], s[3 * 33]); o.z = pk2(s[4 * 33], s[5 * 33]); o.w = pk2(s[6 * 33], s[7 * 33]);
        *(GAS v4u*)(WT + (size_t)(drow0 + n) * Kp + k0 + 8 * c) = o; }
    LDS_WAIT(); asm volatile("" ::: "memory");
}
__device__ __forceinline__ bool conv_job(int& r, const float* W, int K, int N, bf16* WT, int Kp, int rowoff, int mode, int which, LAS float* scr, int lane) {
    const int nblk = N / 32, items = (K / 64) * nblk;
    if (r >= items) { r -= items; return false; }
    const int kb = r / nblk, nb = r % nblk, n0 = 32 * nb;
    const int drow0 = mode ? rowoff + (n0 / 128) * 256 + which * 128 + (n0 % 128) : rowoff + n0;
    transpose_item(W, N, WT, Kp, 64 * kb, n0, drow0, scr, lane);
    return true;
}

__device__ __forceinline__ void transpose_item_f8(const float* W, int N, unsigned char* WT, int Kp, int k0, int n0, int drow0, float scale, LAS float* scr, int lane) {
    { const int c4 = 4 * (lane & 7);
#pragma unroll
      for (int i = 0; i < 8; ++i) { const int kk = (lane >> 3) + 8 * i; const f32x4 v = *(const f32x4*)(W + (size_t)(k0 + kk) * N + n0 + c4) * scale; LAS float* d = scr + kk * 33 + c4; d[0] = v.x; d[1] = v.y; d[2] = v.z; d[3] = v.w; } }
    LDS_WAIT(); asm volatile("" ::: "memory");
    const int c = lane & 7;
#pragma unroll
    for (int j = 0; j < 4; ++j) { const int n = (lane >> 3) + 8 * j; const LAS float* s = scr + (8 * c) * 33 + n;
        v2u o; o.x = pg8::pack_fp8x4(s[0 * 33], s[1 * 33], s[2 * 33], s[3 * 33]); o.y = pg8::pack_fp8x4(s[4 * 33], s[5 * 33], s[6 * 33], s[7 * 33]);
        *(GAS v2u*)(WT + (size_t)(drow0 + n) * Kp + k0 + 8 * c) = o; }
    LDS_WAIT(); asm volatile("" ::: "memory");
}
__device__ __forceinline__ bool conv_job_f8(int& r, const float* W, int K, int N, unsigned char* WT, int Kp, int mode, int which, float scale, LAS float* scr, int lane) {
    const int nblk = N / 32, items = (K / 64) * nblk;
    if (r >= items) { r -= items; return false; }
    const int kb = r / nblk, nb = r % nblk, n0 = 32 * nb;
    const int drow0 = mode ? (n0 / 128) * 256 + which * 128 + (n0 % 128) : n0;
    transpose_item_f8(W, N, WT, Kp, 64 * kb, n0, drow0, scale, scr, lane);
    return true;
}

__device__ __forceinline__ void ld_row_f32(const float* p, int lane, f32x4 (&v)[4]) {
    const GAS f32x4* q = (const GAS f32x4*)p + lane;
#pragma unroll
    for (int j = 0; j < 4; ++j) v[j] = q[64 * j];
}
__device__ __forceinline__ void st_row_f32(float* p, int lane, const f32x4 (&v)[4]) {
    GAS f32x4* q = (GAS f32x4*)p + lane;
#pragma unroll
    for (int j = 0; j < 4; ++j) q[64 * j] = v[j];
}
__device__ __forceinline__ void ld_row_bf16(const bf16* p, int lane, f32x4 (&v)[4]) {
    const GAS v2u* q = (const GAS v2u*)p + lane;
#pragma unroll
    for (int j = 0; j < 4; ++j) { const v2u w = q[64 * j]; v[j] = (f32x4){pg8::bf_lo(w.x), pg8::bf_hi(w.x), pg8::bf_lo(w.y), pg8::bf_hi(w.y)}; }
}
__device__ __forceinline__ void ld_row_f32_nt(const float* p, int lane, f32x4 (&v)[4]) {
    const GAS f32x4* q = (const GAS f32x4*)p + lane;
#pragma unroll
    for (int j = 0; j < 4; ++j) v[j] = __builtin_nontemporal_load(q + 64 * j);
}
__device__ __forceinline__ void st_row_f32_nt(float* p, int lane, const f32x4 (&v)[4]) {
    GAS f32x4* q = (GAS f32x4*)p + lane;
#pragma unroll
    for (int j = 0; j < 4; ++j) __builtin_nontemporal_store(v[j], q + 64 * j);
}
__device__ __forceinline__ void ld_raw_bf16_nt(const bf16* p, int lane, v2u (&v)[4]) {
    const GAS v2u* q = (const GAS v2u*)p + lane;
#pragma unroll
    for (int j = 0; j < 4; ++j) v[j] = __builtin_nontemporal_load(q + 64 * j);
}
__device__ __forceinline__ void ld_raw_bf16(const bf16* p, int lane, v2u (&v)[4]) {
    const GAS v2u* q = (const GAS v2u*)p + lane;
#pragma unroll
    for (int j = 0; j < 4; ++j) v[j] = q[64 * j];
}
__device__ __forceinline__ f32x4 cvt_raw_bf16(v2u w) { return (f32x4){pg8::bf_lo(w.x), pg8::bf_hi(w.x), pg8::bf_lo(w.y), pg8::bf_hi(w.y)}; }
__device__ __forceinline__ void st_row_bf16(bf16* p, int lane, const f32x4 (&v)[4]) {
    GAS v2u* q = (GAS v2u*)p + lane;
#pragma unroll
    for (int j = 0; j < 4; ++j) { v2u w; w.x = pk2(v[j].x, v[j].y); w.y = pk2(v[j].z, v[j].w); q[64 * j] = w; }
}
__device__ __forceinline__ float row_rms_scale(const f32x4 (&v)[4]) {
    float s = 0.f;
#pragma unroll
    for (int j = 0; j < 4; ++j) s += (v[j].x * v[j].x + v[j].y * v[j].y) + (v[j].z * v[j].z + v[j].w * v[j].w);
    return __builtin_amdgcn_rsqf(wave_sum(s) * (1.0f / D) + EPS);
}
__device__ __forceinline__ void norm_mod(const f32x4 (&x)[4], const float* g, const float* sc, const float* sh, int lane, f32x4 (&h)[4]) {
    const float rs = row_rms_scale(x);
    f32x4 gv[4], scv[4], shv[4]; ld_row_f32(g, lane, gv); ld_row_f32(sc, lane, scv); ld_row_f32(sh, lane, shv);
#pragma unroll
    for (int j = 0; j < 4; ++j) h[j] = (x[j] * rs) * gv[j] * (scv[j] + 1.0f) + shv[j];
}
__device__ __forceinline__ void resid_update(f32x4 (&x)[4], const f32x4 (&y)[4], const float* g, const float* gt, int lane) {
    const float rs = row_rms_scale(y);
    f32x4 gv[4], gtv[4]; ld_row_f32(g, lane, gv); ld_row_f32(gt, lane, gtv);
#pragma unroll
    for (int j = 0; j < 4; ++j) x[j] = x[j] + gtv[j] * ((y[j] * rs) * gv[j]);
}
__device__ __forceinline__ const float* modv(const Frame& F, int l, int row, int part) {
    const int r = row < NTOK ? (row >> 11) : 32;
    return (const float*)(F.ws + WS_MODV) + ((size_t)l * 33 + r) * 6144 + part * 1024;
}

__device__ __forceinline__ void p0_prologue(Frame& F, const Args& a) {
    const int gw = F.vcu * NWAVES + F.wave, NGW = F.G * NWAVES;
    if (F.vcu < 192) {
        LAS float* sl = (LAS float*)F.lds;
        for (int i = F.tid; i < 33 * 1024; i += NTHREADS) { const int r = i >> 10, k = i & 1023; const float cv = r < 32 ? a.in[I_C][r * 1024 + k] : a.in[I_CCTX][k]; sl[k * 33 + r] = silu_f(cv); }
        __syncthreads();
        const int col = F.vcu * 64 + F.lane, l = col / 6144, n = col % 6144, k0 = F.wave * 128;
        const float* w = a.in[I_WMOD] + ((size_t)l * 1024 + k0) * 6144 + n;
        float acc[33];
#pragma unroll
        for (int r = 0; r < 33; ++r) acc[r] = 0.f;
#pragma unroll 4
        for (int k = 0; k < 128; ++k) { const float wv = w[(size_t)k * 6144]; const LAS float* sr = sl + (k0 + k) * 33;
#pragma unroll
            for (int r = 0; r < 33; ++r) acc[r] += sr[r] * wv; }
        __syncthreads();
#pragma unroll
        for (int r = 0; r < 33; ++r) sl[(F.wave * 33 + r) * 64 + F.lane] = acc[r];
        __syncthreads();
        const float* bmod = a.in[I_BMOD]; float* mo = (float*)(F.ws + WS_MODV);
        for (int o = F.tid; o < 33 * 64; o += NTHREADS) { const int r = o >> 6, j = o & 63; float s = 0.f;
#pragma unroll
            for (int wv = 0; wv < 8; ++wv) s += sl[(wv * 33 + r) * 64 + j];
            const int cc = F.vcu * 64 + j, ll = cc / 6144, nn = cc % 6144; mo[((size_t)ll * 33 + r) * 6144 + nn] = s + bmod[ll * 6144 + nn]; }
        __syncthreads();
    }
    if (F.vcu == 200) {
        float* rp = (float*)(F.ws + WS_ROPE);
        for (int i = F.tid; i < 1024; i += NTHREADS) { const int pos = i >> 4, k = i & 15; const float inv = powf(10000.0f, -(float)k / 16.0f); const float ang = (float)pos * inv; rp[i] = cosf(ang); rp[1024 + i] = sinf(ang); }
    }
    for (int it = F.vcu; it < 512; it += F.G) {
        const int lv = it >> 8, l = lv ? 0 : ((it >> 7) & 1), L = lv ? LC : SEQ, pos0 = lv ? (it & 255) : 16 * (it & 127), npos = lv ? 1 : 16;
        LAS float* z = (LAS float*)F.lds; LAS float* h1 = z + 16 * 33; LAS float* h2 = h1 + 16 * 64;
        __syncthreads();
        for (int i = F.tid; i < 16 * 33; i += NTHREADS) { const int p = i / 33, k = i % 33; const int pos = pos0 + p; float v;
            const float om = 6.283185307179586f * (float)pos / (float)L;
            if (k == 0) v = (float)pos / (float)(L - 1);
            else { const int m = (k - 1) & 15; const float f = 1e-4f + (15.0f - 1e-4f) * (float)m / 15.0f; v = (k <= 16) ? cosf(f * om) : -sinf(f * om); }
            z[i] = v; }
        __syncthreads();
        const float* w1 = a.in[I_HW1] + l * 33 * 64; const float* b1 = a.in[I_HB1] + l * 64; const float* w2 = a.in[I_HW2] + l * 64 * 64; const float* b2 = a.in[I_HB2] + l * 64;
        const float* fr = a.in[I_HFREQ] + l * 64; const float* w3 = a.in[I_HW3] + (size_t)l * 64 * 2048;
        for (int o = F.tid; o < 1024; o += NTHREADS) { const int p = o >> 6, j = o & 63; float s = b1[j];
            for (int k = 0; k < 33; ++k) s += z[p * 33 + k] * w1[k * 64 + j];
            h1[o] = sinf(fr[j] * s); }
        __syncthreads();
        for (int o = F.tid; o < 1024; o += NTHREADS) { const int p = o >> 6, j = o & 63; float s = b2[j];
            for (int k = 0; k < 64; ++k) s += h1[p * 64 + k] * w2[k * 64 + j];
            h2[o] = sinf(fr[j] * s); }
        __syncthreads();
        float* raw = (float*)(F.ws + BIG_RAW) + (size_t)l * (2048 * (SEQ + LC)) + (lv ? (size_t)2048 * SEQ : 0);
        {
            const int col0 = 4 * F.tid;
            float acc[4][16];
#pragma unroll
            for (int c4 = 0; c4 < 4; ++c4)
#pragma unroll
                for (int p = 0; p < 16; ++p) acc[c4][p] = 0.f;
#pragma unroll 4
            for (int k = 0; k < 64; ++k) { const f32x4 wv = *(const f32x4*)(w3 + k * 2048 + col0);
#pragma unroll
                for (int p = 0; p < 16; ++p) { const float hv = h2[p * 64 + k]; acc[0][p] += hv * wv.x; acc[1][p] += hv * wv.y; acc[2][p] += hv * wv.z; acc[3][p] += hv * wv.w; } }
            const float da = -3.0701134573253945f, db = -15.350567286626973f;
#pragma unroll
            for (int c4 = 0; c4 < 4; ++c4) { const int col = col0 + c4, cch = col & 511;
                const float delta = fabsf(da + (db - da) * (float)cch / 511.0f);
#pragma unroll
                for (int p = 0; p < 16; ++p) if (p < npos) { const float t = (float)(pos0 + p) / (float)(L - 1); raw[(size_t)col * L + pos0 + p] = acc[c4][p] * __expf(-t * delta); } }
        }
    }
    __syncthreads();
    LAS float* scr = (LAS float*)(F.lds + F.wave * 16384);
    constexpr int PER_LAYER = 16 * 216 + 16 * 48 + 3 * 256 + 512, NITEMS = 2 * PER_LAYER + 3 * 1408;
    for (int it = gw; it < NITEMS; it += NGW) {
        int r = it;
        bool dn = false;
#pragma unroll 1
        for (int l = 0; l < 2; ++l) {
            if (!dn) dn = conv_job_f8(r, a.in[I_WIN] + (size_t)l * D * INC, D, INC, F.ws + W_IN + (size_t)l * INC * D, D, 0, 0, W13_SCALE, scr, F.lane);
            if (!dn) { const int items = 16 * 48;
                if (r < items) { const int kb = r / 48, nb = r % 48; transpose_item(a.in[I_WIN] + (size_t)l * D * INC + QKVC, INC, (bf16*)(F.ws + W_CB) + (size_t)l * CINC * D, D, 64 * kb, 32 * nb, 32 * nb, scr, F.lane); dn = true; } else r -= items; }
#pragma unroll 1
            for (int br = 0; br < 3; ++br)
                if (!dn) dn = conv_job(r, a.in[I_WBR] + (size_t)(l * 3 + br) * 512 * D, 512, D, (bf16*)(F.ws + W_BR) + (size_t)(l * 3 + br) * D * 512, 512, 0, 0, 0, scr, F.lane);
            if (!dn) dn = conv_job(r, a.in[I_WOUT] + (size_t)l * D * D, D, D, (bf16*)(F.ws + W_OUT) + (size_t)l * D * D, D, 0, 0, 0, scr, F.lane);
        }
        if (!dn) dn = conv_job(r, a.in[I_FW1], D, DFF, (bf16*)(F.ws + W_F13), D, 0, 1, 0, scr, F.lane);
        if (!dn) dn = conv_job(r, a.in[I_FW3], D, DFF, (bf16*)(F.ws + W_F13), D, 0, 1, 1, scr, F.lane);
        if (!dn) dn = conv_job(r, a.in[I_FW2], DFF, D, (bf16*)(F.ws + W_F2), DFF, 0, 0, 0, scr, F.lane);
    }
}

__device__ __forceinline__ void p1_phase(Frame& F, const Args& a) {
    const int gw = F.vcu * NWAVES + F.wave, NGW = F.G * NWAVES;
    for (int u = gw; u < 2 * 2 * 1024; u += NGW) {
        const int l = u >> 11, lv = (u >> 10) & 1, o = (u >> 9) & 1, c = u & 511, L = lv ? LC : SEQ;
        if (l == 1 && lv == 1) continue;
        const float* raw = (const float*)(F.ws + BIG_RAW) + (size_t)l * (2048 * (SEQ + LC)) + (lv ? (size_t)2048 * SEQ : 0);
        const float* rf = raw + (size_t)(o * 512 + c) * L; const float* rb = raw + (size_t)(1024 + o * 512 + c) * L;
        float sf = 0.f, sb = 0.f;
        for (int t = F.lane; t < L; t += 64) { const float x = rf[t], y = rb[t]; sf += x * x; sb += y * y; }
        const float nf = 1.0f / sqrtf(wave_sum(sf) + EPS), nb = 1.0f / sqrtf(wave_sum(sb) + EPS);
        bf16* g = lv ? (bf16*)(F.ws + WS_GFC) + ((size_t)(l * 2 + o) * 512 + c) * (2 * LC) : (bf16*)(F.ws + WS_GF) + ((size_t)(l * 2 + o) * 512 + c) * (2 * SEQ);
        for (int i = F.lane; i < 2 * L; i += 64) { const int d = i - L; float v;
            if (i == 0) v = 0.f; else if (d > 0) v = rf[d] * nf; else if (d < 0) v = rb[-d] * nb; else v = rf[0] * nf + rb[0] * nb;
            g[i] = (bf16)f2bf(v); }
    }
}

constexpr float ATT_THR = 8.0f;
constexpr int ATT_KP = 144, ATT_VP = 136;
constexpr int ATT_K_OFF = 0, ATT_V_OFF = 64 * ATT_KP, ATT_BUF = 17920, ATT_RPB_OFF = 36864;
constexpr int ATT_T0_BYTES = 15 * 128 * 4, ATT_E_OFF = ATT_RPB_OFF + ATT_T0_BYTES, ATT_TBL_FLOATS = 15 * 128 + 15 * 15 * 64;
__device__ __forceinline__ int crow(int reg, int h) { return (reg & 3) + 8 * (reg >> 2) + 4 * h; }
__device__ __forceinline__ int rs_of(int r) { const int v = r - 4; return v < 0 ? 0 : (v > 24 ? 24 : v); }
__device__ __forceinline__ unsigned cvtpk(float lo, float hi) { return pk2(lo, hi); }

template <int MODE, int SUB>
__device__ __forceinline__ void att_tile(LAS unsigned char* lds, int boff, const bf16x8 (&qf)[4], f32x16& negm, f32x16& O0, f32x16& O1, float& m_run, float& l_run,
                                         bool is_local, bool edge_mask, int kbase, int qt, int kr, int gr, int tb_base, int tb_pitch, int r, int h) {
#define A0(i) (SUB != 2 || (i) >= 12)
#define A1(i) (SUB != 1 || (i) < 4)
    f32x16 s0 = negm, s1 = negm;
#pragma unroll
    for (int s = 0; s < 4; ++s) {
        const bf16x8 k0 = *(const LAS bf16x8*)(lds + boff + ATT_K_OFF + r * ATT_KP + (16 * s + 8 * h) * 2);
        const bf16x8 k1 = *(const LAS bf16x8*)(lds + boff + ATT_K_OFF + (32 + r) * ATT_KP + (16 * s + 8 * h) * 2);
        s0 = MFMA32(k0, qf[s], s0); s1 = MFMA32(k1, qf[s], s1);
    }
    if (MODE == 0 && edge_mask) {
#pragma unroll
        for (int i = 0; i < 16; ++i) { const int j0 = kbase + crow(i, h), d0 = qt - j0, d1 = d0 - 32;
            if (d0 > 128 || d0 < -128) s0[i] = -1e30f;
            if (d1 > 128 || d1 < -128) s1[i] = -1e30f; }
    }
    if (MODE == 1 && is_local) {
        const LAS float* tb = (const LAS float*)(lds + tb_base + (kr - gr + 7) * tb_pitch);
        float b0[16], b1[16];
#pragma unroll
        for (int i = 0; i < 16; ++i) { const int c = (i & 3) + 8 * (i >> 2); b0[i] = tb[c]; b1[i] = tb[c + 32]; }
#pragma unroll
        for (int i = 0; i < 16; ++i) { s0[i] += b0[i]; s1[i] += b1[i]; }
    }
    float mx = -1e30f;
#pragma unroll
    for (int i = 0; i < 16; ++i) { if (A0(i)) mx = fmaxf(mx, s0[i]); if (A1(i)) mx = fmaxf(mx, s1[i]); }
    mx = fmaxf(mx, __shfl_xor(mx, 32));
    if (!__all(mx <= ATT_THR)) {
        const float delta = fmaxf(mx, 0.f), alpha = __builtin_amdgcn_exp2f(-delta);
        m_run += delta; l_run *= alpha;
#pragma unroll
        for (int i = 0; i < 16; ++i) { O0[i] *= alpha; O1[i] *= alpha; s0[i] -= delta; s1[i] -= delta; negm[i] = -m_run; }
    }
    float ls = 0.f;
#pragma unroll
    for (int i = 0; i < 16; ++i) { if (A0(i)) { s0[i] = __builtin_amdgcn_exp2f(s0[i]); ls += s0[i]; } else s0[i] = 0.f;
                                   if (A1(i)) { s1[i] = __builtin_amdgcn_exp2f(s1[i]); ls += s1[i]; } else s1[i] = 0.f; }
    l_run += ls;
    bf16x8 pf[2][2];
    { v4u t;
      t.x = cvtpk(s0[0], s0[1]); t.y = cvtpk(s0[2], s0[3]); t.z = cvtpk(s0[4], s0[5]); t.w = cvtpk(s0[6], s0[7]); pf[0][0] = __builtin_bit_cast(bf16x8, t);
      t.x = cvtpk(s0[8], s0[9]); t.y = cvtpk(s0[10], s0[11]); t.z = cvtpk(s0[12], s0[13]); t.w = cvtpk(s0[14], s0[15]); pf[0][1] = __builtin_bit_cast(bf16x8, t);
      t.x = cvtpk(s1[0], s1[1]); t.y = cvtpk(s1[2], s1[3]); t.z = cvtpk(s1[4], s1[5]); t.w = cvtpk(s1[6], s1[7]); pf[1][0] = __builtin_bit_cast(bf16x8, t);
      t.x = cvtpk(s1[8], s1[9]); t.y = cvtpk(s1[10], s1[11]); t.z = cvtpk(s1[12], s1[13]); t.w = cvtpk(s1[14], s1[15]); pf[1][1] = __builtin_bit_cast(bf16x8, t); }
#pragma unroll
    for (int i = 0; i < 2; ++i)
#pragma unroll
        for (int sp = 0; sp < 2; ++sp) {
            if ((SUB == 1 && i == 1 && sp == 1) || (SUB == 2 && i == 0 && sp == 0)) continue;
            const int koff = (32 * i + 16 * sp + 4 * h) * 2;
            const v2u a0 = *(const LAS v2u*)(lds + boff + ATT_V_OFF + r * ATT_VP + koff), a1 = *(const LAS v2u*)(lds + boff + ATT_V_OFF + r * ATT_VP + koff + 16);
            const v2u c0 = *(const LAS v2u*)(lds + boff + ATT_V_OFF + (32 + r) * ATT_VP + koff), c1 = *(const LAS v2u*)(lds + boff + ATT_V_OFF + (32 + r) * ATT_VP + koff + 16);
            const v4u va = (v4u){a0.x, a0.y, a1.x, a1.y}, vc = (v4u){c0.x, c0.y, c1.x, c1.y};
            O0 = MFMA32(__builtin_bit_cast(bf16x8, va), pf[i][sp], O0);
            O1 = MFMA32(__builtin_bit_cast(bf16x8, vc), pf[i][sp], O1);
        }
#undef A0
#undef A1
}

struct AttPre { v4u k, v; int valid; };
template <int MODE>
__device__ __forceinline__ void att_start(int u, int w, int r, int& qrow, int& qcol, int& kcol, int& vcol, int& trow0) {
    int b, head, kvh, q0 = 0, R = 0;
    if (MODE == 0) { b = u >> 6; kvh = (u >> 5) & 1; q0 = (u & 31) * 64; head = 4 * kvh + (w >> 1); }
    else if (MODE == 1) { b = u >> 6; head = (u >> 3) & 7; kvh = head; R = u & 7; }
    else if (MODE == 2) { b = u >> 3; kvh = (u >> 2) & 1; q0 = (u & 3) * 64; head = 4 * kvh + (w >> 1); }
    else { b = u >> 3; head = u & 7; kvh = head; }
    if (MODE == 0) qrow = b * SEQ + q0 + 32 * (w & 1) + r;
    else if (MODE == 1) qrow = b * SEQ + (4 * R + (w >> 1)) * 64 + 32 * (w & 1) + r;
    else if (MODE == 2) qrow = NTOK + b * LC + q0 + 32 * (w & 1) + r;
    else qrow = NTOK + b * LC + 32 * w + r;
    qcol = (MODE == 0 || MODE == 2) ? 1280 + head * 64 : 1792 + head * 64;
    kcol = (MODE == 0 || MODE == 2) ? kvh * 64 : 256 + head * 64;
    vcol = (MODE == 0 || MODE == 2) ? 128 + kvh * 64 : 768 + head * 64;
    if (MODE == 0) { const int lo = q0 < 128 ? (128 - q0) / 64 : 0; trow0 = b * SEQ + q0 - 128 + 64 * lo; }
    else if (MODE == 1) trow0 = b * SEQ + rs_of(4 * R) * 64;
    else trow0 = NTOK + b * LC;
}
template <int MODE>
__device__ __forceinline__ void attn_unit(Frame& F, int u, int u_next, const bf16* __restrict__ QKV, bf16* __restrict__ Yo, const float* sink, const float* rpb, AttPre& P, int& tbl_head, int var = 0) {
    const int w = F.wave, lane = F.lane, r = lane & 31, h = lane >> 5;
    LAS unsigned char* lds = F.lds;
    int b, head, kvh, q0 = 0, R = 0;
    if (MODE == 0) { b = u >> 6; kvh = (u >> 5) & 1; q0 = (u & 31) * 64; head = 4 * kvh + (w >> 1); }
    else if (MODE == 1) { b = u >> 6; head = (u >> 3) & 7; kvh = head; R = u & 7; }
    else if (MODE == 2) { b = u >> 3; kvh = (u >> 2) & 1; q0 = (u & 3) * 64; head = 4 * kvh + (w >> 1); }
    else { b = u >> 3; head = u & 7; kvh = head; }
    int qt, qrow, gr = 0, qc = 0;
    if (MODE == 0) { qt = q0 + 32 * (w & 1) + r; qrow = b * SEQ + qt; }
    else if (MODE == 1) { gr = 4 * R + (w >> 1); qc = 32 * (w & 1) + r; qt = gr * 64 + qc; qrow = b * SEQ + qt; }
    else if (MODE == 2) { qt = q0 + 32 * (w & 1) + r; qrow = NTOK + b * LC + qt; }
    else { qt = 32 * w + r; qrow = NTOK + b * LC + qt; }
    const int qcol = (MODE == 0 || MODE == 2) ? 1280 + head * 64 : 1792 + head * 64;
    const int kcol = (MODE == 0 || MODE == 2) ? kvh * 64 : 256 + head * 64;
    const int vcol = (MODE == 0 || MODE == 2) ? 128 + kvh * 64 : 768 + head * 64;
    bf16x8 qf[4];
#pragma unroll
    for (int s = 0; s < 4; ++s) qf[s] = *(const bf16x8*)(QKV + (size_t)qrow * QKVC + qcol + 16 * s + 8 * h);
    f32x16 O0, O1;
#pragma unroll
    for (int i = 0; i < 16; ++i) { O0[i] = 0.f; O1[i] = 0.f; }
    float m_run, l_run;
    if (MODE == 0 || MODE == 2) { m_run = sink[head] * LOG2E; l_run = (h == 0) ? 1.0f : 0.0f; } else { m_run = 0.f; l_run = 0.f; }
    f32x16 negm;
#pragma unroll
    for (int i = 0; i < 16; ++i) negm[i] = -m_run;
    int lo = 0, ntl = 0, kr_lo = 0;
    if (MODE == 0) { lo = q0 < 128 ? (128 - q0) / 64 : 0; const int hi = (SEQ - q0 + 128) / 64 < 5 ? (SEQ - q0 + 128) / 64 : 5; ntl = hi - lo; }
    if (MODE == 1) { kr_lo = rs_of(4 * R); ntl = rs_of(4 * R + 3) + 8 - kr_lo; }
    const int my_rs = rs_of(gr), my_cs = (qc - 8) < 0 ? 0 : ((qc - 8) > 48 ? 48 : (qc - 8));
    const int ntiles = ntl + 4;
    int tb_base = 0, tb_pitch = 0;
    if (MODE == 1) { const bool edge = qc < 8 || qc > 56; const int ev = qc < 8 ? qc : qc - 49;
        tb_base = edge ? ATT_E_OFF + ev * (15 * 256) + 16 * h : ATT_RPB_OFF + 4 * (63 - qc + 4 * h); tb_pitch = edge ? 256 : 512; }
    const int skey = F.tid >> 3, sch = F.tid & 7, vkey = F.tid & 63, vch = F.tid >> 6;
#define ATT_TROW(tt) ((tt) < ntl ? (MODE == 0 ? b * SEQ + q0 - 128 + 64 * (lo + (tt)) : b * SEQ + (kr_lo + (tt)) * 64) : NTOK + b * LC + 64 * ((tt) - ntl))
#define ATT_LOAD(tt) do { const int tr_ = ATT_TROW(tt); kreg = *(const v4u*)(QKV + (size_t)(tr_ + skey) * QKVC + kcol + 8 * sch); vreg = *(const v4u*)(QKV + (size_t)(tr_ + vkey) * QKVC + vcol + 8 * vch); } while (0)
#define ATT_STORE(bufoff) do { *(LAS v4u*)(lds + (bufoff) + ATT_K_OFF + skey * ATT_KP + sch * 16) = kreg; \
        LAS unsigned short* vt_ = (LAS unsigned short*)(lds + (bufoff) + ATT_V_OFF + (8 * vch) * ATT_VP + vkey * 2); \
        vt_[0 * (ATT_VP / 2)] = (unsigned short)(vreg.x & 0xffff); vt_[1 * (ATT_VP / 2)] = (unsigned short)(vreg.x >> 16); vt_[2 * (ATT_VP / 2)] = (unsigned short)(vreg.y & 0xffff); vt_[3 * (ATT_VP / 2)] = (unsigned short)(vreg.y >> 16); \
        vt_[4 * (ATT_VP / 2)] = (unsigned short)(vreg.z & 0xffff); vt_[5 * (ATT_VP / 2)] = (unsigned short)(vreg.z >> 16); vt_[6 * (ATT_VP / 2)] = (unsigned short)(vreg.w & 0xffff); vt_[7 * (ATT_VP / 2)] = (unsigned short)(vreg.w >> 16); } while (0)
    v4u& kreg = P.k; v4u& vreg = P.v;
    if (!P.valid) ATT_LOAD(0);
    P.valid = 0;
    __syncthreads();
    if (MODE == 1 && head != tbl_head) {
        tbl_head = head;
        LAS float* tb = (LAS float*)(lds + ATT_RPB_OFF);
        for (int i = F.tid; i < ATT_TBL_FLOATS; i += NTHREADS) {
            int dr, off; bool ok;
            if (i < 15 * 128) { dr = i >> 7; off = (i & 127) - 63; ok = off >= -8 && off <= 7; }
            else { const int j = i - 15 * 128, ev = j / (15 * 64), dr_ = (j >> 6) % 15, kc = j & 63, q = ev < 8 ? ev : ev + 49; dr = dr_; off = kc - q; ok = ev < 8 ? kc < 16 : kc >= 48; }
            tb[i] = ok ? rpb[(head * 15 + dr) * 31 + off + 15] * LOG2E : -1e30f;
        }
    }
    ATT_STORE(0);
    __syncthreads();
#pragma unroll 1
    for (int tt = 0; tt < ntiles; ++tt) {
        const bool is_local = tt < ntl;
        const int kbase = q0 - 128 + 64 * (lo + tt), kr = kr_lo + tt;
        const int boff = (tt & 1) * ATT_BUF;
        if (tt + 1 < ntiles) { if (!(var & 2)) ATT_LOAD(tt + 1); }
        else if (u_next >= 0) {
            int nq, nqc, nkc, nvc, ntr; att_start<MODE>(u_next, w, r, nq, nqc, nkc, nvc, ntr);
            kreg = *(const v4u*)(QKV + (size_t)(ntr + skey) * QKVC + nkc + 8 * sch); vreg = *(const v4u*)(QKV + (size_t)(ntr + vkey) * QKVC + nvc + 8 * vch);
            P.valid = 1;
        }
        if (!(var & 1) && !(MODE == 1 && is_local && !(kr >= my_rs && kr < my_rs + 8))) {
            att_tile<MODE, 0>(lds, boff, qf, negm, O0, O1, m_run, l_run, is_local, MODE == 0 && is_local && (lo + tt == 0 || lo + tt == 4), kbase, qt, kr, gr, tb_base, tb_pitch, r, h);
        }
        if (tt + 1 < ntiles && !(var & 2)) ATT_STORE(((tt + 1) & 1) * ATT_BUF);
        __syncthreads();
    }
#undef ATT_TROW
#undef ATT_LOAD
#undef ATT_STORE
    const float lt = l_run + __shfl_xor(l_run, 32), inv = 1.0f / lt;
    LAS unsigned char* ot = lds + w * 4608;
#pragma unroll
    for (int g = 0; g < 4; ++g) {
        v2u o; o.x = cvtpk(O0[4 * g] * inv, O0[4 * g + 1] * inv); o.y = cvtpk(O0[4 * g + 2] * inv, O0[4 * g + 3] * inv);
        *(LAS v2u*)(ot + r * 144 + (8 * g + 4 * h) * 2) = o;
        o.x = cvtpk(O1[4 * g] * inv, O1[4 * g + 1] * inv); o.y = cvtpk(O1[4 * g + 2] * inv, O1[4 * g + 3] * inv);
        *(LAS v2u*)(ot + r * 144 + (32 + 8 * g + 4 * h) * 2) = o;
    }
    LDS_WAIT(); asm volatile("" ::: "memory");
    bf16* op = Yo + (size_t)(qrow - r) * 512 + head * 64;
#pragma unroll
    for (int k = 0; k < 4; ++k) { const int p = lane + 64 * k, row = p >> 3, chk = p & 7;
        *(GAS v4u*)(op + (size_t)row * 512 + 8 * chk) = *(const LAS v4u*)(ot + row * 144 + chk * 16); }
    LDS_WAIT(); asm volatile("" ::: "memory");
}

template <int N>
__device__ __forceinline__ void conv_taps(const bf16* src, int t, int L, float w0, float w1, float w2, float bs, float (&out)[N]) {
    float x[N + 2];
    if constexpr (N == 8) { const v4u q = *(const v4u*)(src + t); x[1] = pg8::bf_lo(q.x); x[2] = pg8::bf_hi(q.x); x[3] = pg8::bf_lo(q.y); x[4] = pg8::bf_hi(q.y); x[5] = pg8::bf_lo(q.z); x[6] = pg8::bf_hi(q.z); x[7] = pg8::bf_lo(q.w); x[8] = pg8::bf_hi(q.w); }
    else { const v2u q = *(const v2u*)(src + t); x[1] = pg8::bf_lo(q.x); x[2] = pg8::bf_hi(q.x); x[3] = pg8::bf_lo(q.y); x[4] = pg8::bf_hi(q.y); }
    x[0] = t > 0 ? bf2f(src[t - 1]) : 0.f;
    x[N + 1] = (t + N < L) ? bf2f(src[t + N]) : 0.f;
#pragma unroll
    for (int e = 0; e < N; ++e) out[e] = w0 * x[e] + w1 * x[e + 1] + w2 * x[e + 2] + bs;
}

template <int L, int VAR = 0>
__device__ __forceinline__ void hyena_unit(Frame& F, int c, const bf16* CINT, bf16* DST, const bf16* Gf, const float* convw, const float* convb, const float* hybias) {
    constexpr int UP = (L + 8) * 2, TPW = L / 256, CPB = L / 8;
    LAS unsigned char* U = F.lds; LAS unsigned short* Gs = (LAS unsigned short*)(F.lds + 32 * UP);
    const int lane = F.lane, r = lane & 31, h = lane >> 5, T0 = F.wave * TPW * 32;
    const bf16* vsrc = CINT + (size_t)c * NROW + (L == SEQ ? 0 : NTOK);
    bf16* ydst = DST + (size_t)c * NROW + (L == SEQ ? 0 : NTOK);
    __syncthreads();
    if (!(VAR & 8)) {
        const float w0 = convw[c], w1 = convw[CINC + c], w2 = convw[2 * CINC + c], bs = convb[c];
        static_assert(CPB % 32 == 0, "a wave's 64 lanes hold consecutive chunks of at most two rows, split at lane 32");
#pragma unroll 4
        for (int q = F.tid; q < 32 * CPB; q += NTHREADS) { const int b = q / CPB, t = (q % CPB) * 8;
            const bf16* src = vsrc + (size_t)b * L;
            const v4u ch = *(const v4u*)(src + t);
            float x[10];
            x[1] = pg8::bf_lo(ch.x); x[2] = pg8::bf_hi(ch.x); x[3] = pg8::bf_lo(ch.y); x[4] = pg8::bf_hi(ch.y); x[5] = pg8::bf_lo(ch.z); x[6] = pg8::bf_hi(ch.z); x[7] = pg8::bf_lo(ch.w); x[8] = pg8::bf_hi(ch.w);
            const float up = __shfl_up(x[8], 1), dn = __shfl_down(x[1], 1);
            const int lr = lane & 31;
            x[0] = (lr == 0) ? (t > 0 ? bf2f(src[t - 1]) : 0.f) : up;
            x[9] = (lr == 31) ? (t + 8 < L ? bf2f(src[t + 8]) : 0.f) : dn;
            float o[8];
#pragma unroll
            for (int e = 0; e < 8; ++e) o[e] = w0 * x[e] + w1 * x[e + 1] + w2 * x[e + 2] + bs;
            v4u pk; pk.x = pk2(o[0], o[1]); pk.y = pk2(o[2], o[3]); pk.z = pk2(o[4], o[5]); pk.w = pk2(o[6], o[7]);
            *(LAS v4u*)(U + b * UP + t * 2) = pk; }
    }
#pragma unroll 1
    for (int ord = 0; ord < 2; ++ord) {
        {
            const v4u* gsrc = (const v4u*)(Gf + ((size_t)ord * 512 + c) * (2 * L));
            for (int q = F.tid; q < L / 4; q += NTHREADS) *(LAS v4u*)((LAS unsigned char*)Gs + q * 16) = gsrc[q];
        }
        __syncthreads();
        f32x16 acc[TPW];
#pragma unroll
        for (int i = 0; i < TPW; ++i)
#pragma unroll
            for (int e = 0; e < 16; ++e) acc[i][e] = 0.f;
        const int gbase = T0 + r - 8 * h + L;
#define HY_AF(dst, sgi, ti) do { const int gi_ = gbase + 32 * (ti) - 16 * (sgi); _Pragma("unroll") for (int j_ = 0; j_ < 8; ++j_) dst[j_] = (short)Gs[gi_ - j_]; } while (0)
#define HY_BF(sgi) (*(const LAS bf16x8*)(U + r * UP + (16 * (sgi) + 8 * h) * 2))
        if constexpr (TPW == 8 && !(VAR & 2)) {
            constexpr int NS = L / 16;
#pragma unroll 1
            for (int p = 0; p < 2; ++p) {
                bf16x8 W[8];
#pragma unroll
                for (int i = 1; i < 8; ++i) HY_AF(W[i], p, i);
                bf16x8 nf, nb; HY_AF(nf, p, 0); nb = HY_BF(p);
#pragma unroll 1
                for (int sb = p; sb < NS; sb += 16) {
#pragma unroll
                    for (int k = 0; k < 8; ++k) {
                        const int sg = sb + 2 * k; const bf16x8 cb = nb; W[(8 - k) & 7] = nf;
                        const int sn = sg + 2 < NS ? sg + 2 : sg;
                        HY_AF(nf, sn, 0); nb = HY_BF(sn);
#pragma unroll
                        for (int i = 0; i < 8; ++i) acc[i] = MFMA32(W[(i - k) & 7], cb, acc[i]);
                    }
                }
            }
        } else if constexpr (!(VAR & 2)) {
#pragma unroll 1
            for (int sg = 0; sg < L / 16; ++sg) { bf16x8 af; HY_AF(af, sg, 0); acc[0] = MFMA32(af, HY_BF(sg), acc[0]); }
        }
#undef HY_AF
#undef HY_BF
        const int comp = 1 + ord;
        const float w0 = convw[comp * 512 + c], w1 = convw[CINC + comp * 512 + c], w2 = convw[2 * CINC + comp * 512 + c], bs = convb[comp * 512 + c], hb = hybias[ord * 512 + c];
        const bf16* gsrc = CINT + ((size_t)comp * 512 + c) * NROW + (L == SEQ ? 0 : NTOK) + (size_t)r * L;
        __syncthreads();
        {
            constexpr int NCH = TPW * 4, BS = NCH < 8 ? NCH : 8;
#pragma unroll
            for (int bt = 0; bt < NCH / BS; ++bt) {
                const int tb = T0 + 8 * BS * bt;
                v4u ch[BS];
#pragma unroll
                for (int k = 0; k < BS; ++k) { if constexpr (VAR & 4) ch[k] = (v4u){0u, 0u, 0u, 0u}; else ch[k] = *(const v4u*)(gsrc + tb + 8 * k); }
                float xl = 0.f, xr = 0.f;
                if constexpr (!(VAR & 4)) { if (tb > 0) xl = bf2f(gsrc[tb - 1]); if (tb + 8 * BS < L) xr = bf2f(gsrc[tb + 8 * BS]); }
#pragma unroll
                for (int k = 0; k < BS; ++k) {
                    const int kk = BS * bt + k, i = kk >> 2, g = kk & 3, t = T0 + 32 * i + 8 * g + 4 * h;
                    float xs[10];
                    xs[0] = k == 0 ? xl : pg8::bf_hi(ch[k > 0 ? k - 1 : 0].w);
                    xs[1] = pg8::bf_lo(ch[k].x); xs[2] = pg8::bf_hi(ch[k].x); xs[3] = pg8::bf_lo(ch[k].y); xs[4] = pg8::bf_hi(ch[k].y); xs[5] = pg8::bf_lo(ch[k].z); xs[6] = pg8::bf_hi(ch[k].z); xs[7] = pg8::bf_lo(ch[k].w); xs[8] = pg8::bf_hi(ch[k].w);
                    xs[9] = k == BS - 1 ? xr : pg8::bf_lo(ch[k < BS - 1 ? k + 1 : k].x);
                    float gt[4];
#pragma unroll
                    for (int e2 = 0; e2 < 4; ++e2) { const float lo = w0 * xs[e2] + w1 * xs[e2 + 1] + w2 * xs[e2 + 2] + bs, hi = w0 * xs[e2 + 4] + w1 * xs[e2 + 5] + w2 * xs[e2 + 6] + bs; gt[e2] = h ? hi : lo; }
                    LAS v2u* up = (LAS v2u*)(U + r * UP + t * 2);
                    const v2u uu = *up;
                    const float u0 = pg8::bf_lo(uu.x), u1 = pg8::bf_hi(uu.x), u2 = pg8::bf_lo(uu.y), u3 = pg8::bf_hi(uu.y);
                    const float z0 = gt[0] * (acc[i][4 * g] + hb * u0), z1 = gt[1] * (acc[i][4 * g + 1] + hb * u1), z2 = gt[2] * (acc[i][4 * g + 2] + hb * u2), z3 = gt[3] * (acc[i][4 * g + 3] + hb * u3);
                    v2u zz; zz.x = pk2(z0, z1); zz.y = pk2(z2, z3);
                    *up = zz;
                }
                asm volatile("" ::: "memory");
            }
        }
        __syncthreads();
    }
    if (!(VAR & 1)) for (int q = F.tid; q < 32 * CPB; q += NTHREADS) { const int b = q / CPB, t = (q % CPB) * 8; *(GAS v4u*)(ydst + (size_t)b * L + t) = *(const LAS v4u*)(U + b * UP + t * 2); }
}

__device__ __forceinline__ void transpose_yc(Frame& F, const bf16* CT, bf16* Yc, int nrows) {
    const int gw = F.vcu * NWAVES + F.wave, NGW = F.G * NWAVES, lane = F.lane;
    LAS unsigned short* T = (LAS unsigned short*)(F.lds + F.wave * 16384);
    const int ntr = nrows / 64;
    for (int it = gw; it < 8 * ntr; it += NGW) {
        const int cb = it / ntr, rb = it % ntr, c0 = cb * 64, r0 = rb * 64;
#pragma unroll
        for (int k = 0; k < 8; ++k) { const int p = lane + 64 * k, cc = p >> 3, ch = p & 7;
            const v4u q = *(const v4u*)(CT + (size_t)(c0 + cc) * NROW + r0 + 8 * ch);
            LAS unsigned* d = (LAS unsigned*)(T + cc * 66 + 8 * ch); d[0] = q.x; d[1] = q.y; d[2] = q.z; d[3] = q.w; }
        LDS_WAIT(); asm volatile("" ::: "memory");
#pragma unroll
        for (int k = 0; k < 8; ++k) { const int p = lane + 64 * k, rr = p >> 3, ch = p & 7;
            unsigned short e[8];
#pragma unroll
            for (int j = 0; j < 8; ++j) e[j] = T[(8 * ch + j) * 66 + rr];
            v4u o; o.x = e[0] | ((unsigned)e[1] << 16); o.y = e[2] | ((unsigned)e[3] << 16); o.z = e[4] | ((unsigned)e[5] << 16); o.w = e[6] | ((unsigned)e[7] << 16);
            *(GAS v4u*)(Yc + (size_t)(r0 + rr) * 512 + c0 + 8 * ch) = o; }
        LDS_WAIT(); asm volatile("" ::: "memory");
    }
}

struct RowVecs { f32x4 gA[4], gt[4], gB[4], sc1[4], sh[4]; };
__device__ __forceinline__ float ssq16(const f32x4 (&v)[4]) { float s = 0.f;
#pragma unroll
    for (int j = 0; j < 4; ++j) s += (v[j].x * v[j].x + v[j].y * v[j].y) + (v[j].z * v[j].z + v[j].w * v[j].w);
    return s; }
__device__ __forceinline__ void ld_mod(const Frame& F, int l, int b, int part, int lane, f32x4 (&v)[4], float add) {
    ld_row_f32((const float*)(F.ws + WS_MODV) + ((size_t)l * 33 + b) * 6144 + part * 1024, lane, v);
#pragma unroll
    for (int j = 0; j < 4; ++j) v[j] = v[j] + add;
}
__device__ __forceinline__ void row_pair(const RowVecs& V, const f32x4 (&y0)[4], const f32x4 (&y1)[4], f32x4 (&x0)[4], f32x4 (&x1)[4], bool has_y, bool has_next, f32x4 (&h0)[4], f32x4 (&h1)[4]) {
    if (has_y) {
        float a0 = ssq16(y0), a1 = ssq16(y1);
#pragma unroll
        for (int o = 1; o < 64; o <<= 1) { a0 += __shfl_xor(a0, o); a1 += __shfl_xor(a1, o); }
        const float r0 = __builtin_amdgcn_rsqf(a0 * (1.0f / D) + EPS), r1 = __builtin_amdgcn_rsqf(a1 * (1.0f / D) + EPS);
#pragma unroll
        for (int j = 0; j < 4; ++j) { x0[j] = x0[j] + V.gt[j] * ((y0[j] * r0) * V.gA[j]); x1[j] = x1[j] + V.gt[j] * ((y1[j] * r1) * V.gA[j]); }
    }
    if (has_next) {
        float a0 = ssq16(x0), a1 = ssq16(x1);
#pragma unroll
        for (int o = 1; o < 64; o <<= 1) { a0 += __shfl_xor(a0, o); a1 += __shfl_xor(a1, o); }
        const float r0 = __builtin_amdgcn_rsqf(a0 * (1.0f / D) + EPS), r1 = __builtin_amdgcn_rsqf(a1 * (1.0f / D) + EPS);
#pragma unroll
        for (int j = 0; j < 4; ++j) { h0[j] = (x0[j] * r0) * V.gB[j] * V.sc1[j] + V.sh[j]; h1[j] = (x1[j] * r1) * V.gB[j] * V.sc1[j] + V.sh[j]; }
    }
}
template <bool XB16>
__device__ __forceinline__ void rows_phase(Frame& F, const Args& a, int mode, int l, int sub, const bf16* Y, int nrows) {
    const int gw = F.vcu * NWAVES + F.wave, NGW = F.G * NWAVES;
    const int R = (((nrows + NGW - 1) / NGW) + 1) & ~1, r0 = gw * R, r1 = (r0 + R) < nrows ? (r0 + R) : nrows;
    const bool has_y = mode == 1, has_next = (mode == 0) || !(l == 1 && sub == 1);
    const int ln = (mode == 0) ? 0 : (sub == 0 ? l : l + 1);
    const bool next_is_ffn = (mode == 1 && sub == 0);
    RowVecs V;
    if (has_y) ld_row_f32(a.in[sub == 0 ? I_GMIXPOST : I_GFFNPOST] + l * D, F.lane, V.gA);
    if (has_next) ld_row_f32(a.in[next_is_ffn ? I_GFFNPRE : I_GMIXPRE] + ln * D, F.lane, V.gB);
    int bcur = -2;
    bf16* const Hb = F.hb; bf16* const XB = (bf16*)(F.ws + WS_XB);
    f32x4 nx0[4], nx1[4]; v2u nxr0[4], nxr1[4], ny0[4], ny1[4];
#define ROWS_ISSUE(row_) do { const int rr_ = (row_); \
        if (has_y) { ld_raw_bf16_nt(Y + (size_t)rr_ * D, F.lane, ny0); ld_raw_bf16_nt(Y + (size_t)(rr_ + 1) * D, F.lane, ny1); } \
        if (XB16) { ld_raw_bf16_nt(XB + (size_t)rr_ * D, F.lane, nxr0); ld_raw_bf16_nt(XB + (size_t)(rr_ + 1) * D, F.lane, nxr1); } \
        else { const float* xs_ = rr_ < NTOK ? a.in[I_X] + (size_t)rr_ * D : a.in[I_CTX] + (size_t)(rr_ - NTOK) * D; ld_row_f32_nt(xs_, F.lane, nx0); ld_row_f32_nt(xs_ + D, F.lane, nx1); } } while (0)
    if (r0 < r1) ROWS_ISSUE(r0);
#pragma unroll 1
    for (int row = r0; row < r1; row += 2) {
        const int b = row < NTOK ? (row >> 11) : 32;
        if (b != bcur) { bcur = b;
            if (has_y) ld_mod(F, l, b, sub == 0 ? 2 : 5, F.lane, V.gt, 0.f);
            if (has_next) { ld_mod(F, ln, b, next_is_ffn ? 4 : 1, F.lane, V.sc1, 1.0f); ld_mod(F, ln, b, next_is_ffn ? 3 : 0, F.lane, V.sh, 0.f); } }
        f32x4 y0[4], y1[4], x0[4], x1[4], h0[4], h1[4];
#pragma unroll
        for (int j = 0; j < 4; ++j) { if (XB16) { x0[j] = cvt_raw_bf16(nxr0[j]); x1[j] = cvt_raw_bf16(nxr1[j]); } else { x0[j] = nx0[j]; x1[j] = nx1[j]; }
            if (has_y) { y0[j] = cvt_raw_bf16(ny0[j]); y1[j] = cvt_raw_bf16(ny1[j]); } }
        if (row + 2 < r1) ROWS_ISSUE(row + 2);
        row_pair(V, y0, y1, x0, x1, has_y, has_next, h0, h1);
        if (has_y) { st_row_bf16(XB + (size_t)row * D, F.lane, x0); st_row_bf16(XB + (size_t)(row + 1) * D, F.lane, x1); }
        if (has_next) { st_row_bf16(Hb + (size_t)row * D, F.lane, h0); st_row_bf16(Hb + (size_t)(row + 1) * D, F.lane, h1);
            if (!next_is_ffn) { GAS unsigned* q = (GAS unsigned*)(F.ws + WS_H8 + (size_t)row * D) + F.lane;
#pragma unroll
                for (int j = 0; j < 4; ++j) { q[64 * j] = pg8::pack_fp8x4(h0[j].x, h0[j].y, h0[j].z, h0[j].w); q[256 + 64 * j] = pg8::pack_fp8x4(h1[j].x, h1[j].y, h1[j].z, h1[j].w); } } }
    }
#undef ROWS_ISSUE
}

__device__ __forceinline__ void route_row(const f32x4 (&h)[4], const LAS float* rl, int lane, int& e0, int& e1, float& w0, float& w1) {
    float lg[8];
#pragma unroll
    for (int e = 0; e < 8; ++e) lg[e] = 0.f;
#pragma unroll
    for (int j = 0; j < 4; ++j)
#pragma unroll
        for (int i = 0; i < 4; ++i) { const LAS f32x4* rp = (const LAS f32x4*)(rl + ((j * 4 + i) * 64 + lane) * 8); const f32x4 q0 = rp[0], q1 = rp[1]; const float hv = h[j][i];
            lg[0] += hv * q0.x; lg[1] += hv * q0.y; lg[2] += hv * q0.z; lg[3] += hv * q0.w; lg[4] += hv * q1.x; lg[5] += hv * q1.y; lg[6] += hv * q1.z; lg[7] += hv * q1.w; }
    { const bool b5 = (lane & 32) != 0, b4 = (lane & 16) != 0, b3 = (lane & 8) != 0;
      float v4[4], v2[2], v1;
#pragma unroll
      for (int k = 0; k < 4; ++k) { const float snd = b5 ? lg[k] : lg[k + 4], kp = b5 ? lg[k + 4] : lg[k]; v4[k] = kp + __shfl_xor(snd, 32); }
#pragma unroll
      for (int k = 0; k < 2; ++k) { const float snd = b4 ? v4[k] : v4[k + 2], kp = b4 ? v4[k + 2] : v4[k]; v2[k] = kp + __shfl_xor(snd, 16); }
      { const float snd = b3 ? v2[0] : v2[1], kp = b3 ? v2[1] : v2[0]; v1 = kp + __shfl_xor(snd, 8); }
      v1 += __shfl_xor(v1, 4); v1 += __shfl_xor(v1, 2); v1 += __shfl_xor(v1, 1);
#pragma unroll
      for (int e = 0; e < 8; ++e) lg[e] = __builtin_bit_cast(float, __builtin_amdgcn_readlane(__builtin_bit_cast(int, v1), 8 * e)); }
    e0 = 0; float v0 = lg[0];
#pragma unroll
    for (int e = 1; e < 8; ++e) if (lg[e] > v0) { v0 = lg[e]; e0 = e; }
    e1 = -1; float v1 = -3.0e38f;
#pragma unroll
    for (int e = 0; e < 8; ++e) if (e != e0 && lg[e] > v1) { v1 = lg[e]; e1 = e; }
    w0 = 1.0f / (1.0f + __expf(v1 - v0)); w1 = 1.0f - w0;
}
__device__ __forceinline__ void post_route_phase(Frame& F, const Args& a, const bf16* Y) {
    LAS int* se = (LAS int*)F.lds;
    LAS int* sbase = se + 512;
    LAS float* rl = (LAS float*)(F.lds + 4096);
    const int l = 1;
    __syncthreads();
    for (int i = F.tid; i < 1024 * 8; i += NTHREADS) { const int k = i >> 3, e = i & 7, jj = k >> 8, ln = (k & 255) >> 2, ii = k & 3; rl[((jj * 4 + ii) * 64 + ln) * 8 + e] = a.in[I_ROUTER][i]; }
    __syncthreads();
    RowVecs V;
    ld_row_f32(a.in[I_GMIXPOST] + l * D, F.lane, V.gA); ld_row_f32(a.in[I_GFFNPRE] + l * D, F.lane, V.gB);
    bf16* const Hb = F.hb; bf16* const XB = (bf16*)(F.ws + WS_XB);
    for (int blk = F.vcu; blk < NTOK / 256; blk += F.G) {
        const int b = blk >> 3;
        ld_mod(F, l, b, 2, F.lane, V.gt, 0.f); ld_mod(F, l, b, 4, F.lane, V.sc1, 1.0f); ld_mod(F, l, b, 3, F.lane, V.sh, 0.f);
        v2u nyr[4], nxr[4];
        { const int row_ = blk * 256 + F.wave * 32; ld_raw_bf16_nt(Y + (size_t)row_ * D, F.lane, nyr); ld_raw_bf16_nt(XB + (size_t)row_ * D, F.lane, nxr); }
#pragma unroll 1
        for (int k = 0; k < 32; ++k) {
            const int lr = F.wave * 32 + k, row = blk * 256 + lr;
            f32x4 y0[4], x0[4], h0[4];
#pragma unroll
            for (int j = 0; j < 4; ++j) { y0[j] = cvt_raw_bf16(nyr[j]); x0[j] = cvt_raw_bf16(nxr[j]); }
            if (k + 1 < 32) { ld_raw_bf16_nt(Y + (size_t)(row + 1) * D, F.lane, nyr); ld_raw_bf16_nt(XB + (size_t)(row + 1) * D, F.lane, nxr); }
            bf16* xp = XB + (size_t)row * D;
            { const float r0 = __builtin_amdgcn_rsqf(wave_sum(ssq16(y0)) * (1.0f / D) + EPS);
#pragma unroll
              for (int j = 0; j < 4; ++j) x0[j] = x0[j] + V.gt[j] * ((y0[j] * r0) * V.gA[j]); }
            st_row_bf16(xp, F.lane, x0);
            { const float r0 = __builtin_amdgcn_rsqf(wave_sum(ssq16(x0)) * (1.0f / D) + EPS);
#pragma unroll
              for (int j = 0; j < 4; ++j) h0[j] = (x0[j] * r0) * V.gB[j] * V.sc1[j] + V.sh[j]; }
            { GAS unsigned* q = (GAS unsigned*)((unsigned char*)Hb + (size_t)row * D) + F.lane;
#pragma unroll
              for (int j = 0; j < 4; ++j) q[64 * j] = pg8::pack_fp8x4(h0[j].x, h0[j].y, h0[j].z, h0[j].w); }
            int e0, e1; float w0, w1;
            route_row(h0, rl, F.lane, e0, e1, w0, w1);
            if (F.lane == 0) { se[2 * lr] = e0; se[2 * lr + 1] = e1;
                int4 rr; rr.x = e0; rr.y = e1; rr.z = __builtin_bit_cast(int, w0); rr.w = __builtin_bit_cast(int, w1); ((int4*)(F.ws + WS_ROUTE))[row] = rr; }
        }
        __syncthreads();
        const int half = blk >> 7;
        if (F.tid < 8) { int n = 0; for (int i = 0; i < 512; ++i) n += (se[i] == F.tid) ? 1 : 0;
            sbase[F.tid] = (int)__hip_atomic_fetch_add((unsigned*)(F.ws + WS_CTL) + CW_CNT + half * 8 + F.tid, (unsigned)n, __ATOMIC_RELAXED, __HIP_MEMORY_SCOPE_AGENT); }
        __syncthreads();
        if (F.tid < 8) { int p = sbase[F.tid]; int* lst = (int*)(F.ws + WS_LIST) + ((size_t)half * 8 + F.tid) * 32768;
            for (int i = 0; i < 512; ++i) if (se[i] == F.tid) lst[p++] = ((blk * 256 + (i >> 1)) << 1) | (i & 1); }
        __syncthreads();
    }
}

__device__ __forceinline__ void moe_offsets(Frame& F, int half, int (&toff)[9], int (&cnt)[8]) {
    const unsigned* cw = (const unsigned*)(F.ws + WS_CTL) + CW_CNT + half * 8;
    toff[0] = 0;
#pragma unroll
    for (int e = 0; e < 8; ++e) { cnt[e] = __builtin_amdgcn_readfirstlane((int)__hip_atomic_load(cw + e, __ATOMIC_RELAXED, __HIP_MEMORY_SCOPE_AGENT)); toff[e + 1] = toff[e] + (cnt[e] + 255) / 256; }
}
__device__ __forceinline__ void moe_gather_phase(Frame& F, int half, int skip_first = 0) {
    if (skip_first < 0 || skip_first >= F.G) skip_first = 0;
    const int bxw = (int)blockIdx.x - skip_first; if (bxw < 0) return;
    const int gw = bxw * NWAVES + F.wave, NGW = (F.G - skip_first) * NWAVES;
    int toff[9], cnt[8]; moe_offsets(F, half, toff, cnt);
    const int P = toff[8] * 256;
#pragma unroll 1
    for (int pb = gw; pb < P; pb += 4 * NGW) {
        int ts[4]; bool ok[4];
#pragma unroll
        for (int j = 0; j < 4; ++j) { const int p = pb + j * NGW; ok[j] = false; ts[j] = 0;
            if (p < P) { const int tile = p >> 8; int e = 0;
#pragma unroll
                for (int k = 1; k < 8; ++k) e += (tile >= toff[k]) ? 1 : 0;
                int te = 0, ce = 0;
#pragma unroll
                for (int k = 0; k < 8; ++k) { te = (e == k) ? toff[k] : te; ce = (e == k) ? cnt[k] : ce; }
                const int idx = p - te * 256;
                if (idx < ce) { ok[j] = true; ts[j] = ((const int*)(F.ws + WS_LIST))[((size_t)half * 8 + e) * 32768 + idx]; } } }
        v4u o[4];
#pragma unroll
        for (int j = 0; j < 4; ++j) { o[j] = (v4u){0u, 0u, 0u, 0u};
            if (ok[j]) o[j] = *((const GAS v4u*)((const unsigned char*)F.hb + (size_t)(ts[j] >> 1) * D) + F.lane); }
#pragma unroll
        for (int j = 0; j < 4; ++j) { const int p = pb + j * NGW;
            if (p < P) { *((GAS v4u*)(F.ws + BIG_AS + (size_t)p * D) + F.lane) = o[j];
                if (ok[j] && F.lane == 0) ((int*)(F.ws + WS_INV))[(ts[j] >> 1) * 2 + (ts[j] & 1)] = p; } }
    }
}
struct ConvItem { const float* W; unsigned char* WT; int N, Kp, k0, n0, drow0; float scale; };
__device__ __forceinline__ void moe_conv_decode(const Frame& F, const Args& a, int it, ConvItem& c) {
    constexpr int I13 = 16 * 112, I2 = 56 * 32;
    const int e = it / (2 * I13 + I2); int r = it % (2 * I13 + I2);
    if (r < 2 * I13) {
        const int which = r / I13; r %= I13; const int kb = r / 112, nb = r % 112, n0 = 32 * nb;
        c.W = (which ? a.in[I_MW3] : a.in[I_MW1]) + (size_t)e * D * DFFE; c.N = DFFE; c.WT = F.ws + WM_13 + (size_t)e * 2 * DFFE * D; c.Kp = D; c.k0 = 64 * kb; c.n0 = n0;
        c.drow0 = (n0 / 128) * 256 + which * 128 + (n0 % 128); c.scale = W13_SCALE;
    } else {
        r -= 2 * I13; const int kb = r / 32, nb = r % 32;
        c.W = a.in[I_MW2] + (size_t)e * DFFE * D; c.N = D; c.WT = F.ws + WM_2 + (size_t)e * D * DFFE; c.Kp = DFFE; c.k0 = 64 * kb; c.n0 = 32 * nb; c.drow0 = 32 * nb; c.scale = W2_SCALE;
    }
}
__device__ __forceinline__ void moe_conv_load(const ConvItem& c, int lane, f32x4 (&v)[8]) {
    const int c4 = 4 * (lane & 7);
#pragma unroll
    for (int i = 0; i < 8; ++i) { const int kk = (lane >> 3) + 8 * i; v[i] = __builtin_nontemporal_load((const GAS f32x4*)(c.W + (size_t)(c.k0 + kk) * c.N + c.n0 + c4)); }
}
__device__ __forceinline__ void moe_convert(Frame& F, const Args& a) {
    const int gw = F.vcu * NWAVES + F.wave, NGW = F.G * NWAVES, lane = F.lane;
    LAS float* scr = (LAS float*)(F.lds + F.wave * 16384);
    constexpr int NIT = 8 * (2 * 16 * 112 + 56 * 32);
    if (gw >= NIT) return;
    ConvItem cur; f32x4 v[8];
    moe_conv_decode(F, a, gw, cur); moe_conv_load(cur, lane, v);
#pragma unroll 1
    for (int it = gw; it < NIT; it += NGW) {
        { const int c4 = 4 * (lane & 7);
#pragma unroll
          for (int i = 0; i < 8; ++i) { const int kk = (lane >> 3) + 8 * i; const f32x4 w = v[i] * cur.scale; LAS float* d = scr + kk * 33 + c4; d[0] = w.x; d[1] = w.y; d[2] = w.z; d[3] = w.w; } }
        ConvItem nxt = cur;
        if (it + NGW < NIT) { moe_conv_decode(F, a, it + NGW, nxt); moe_conv_load(nxt, lane, v); }
        LDS_WAIT(); asm volatile("" ::: "memory");
        const int c = lane & 7;
#pragma unroll
        for (int j = 0; j < 4; ++j) { const int n = (lane >> 3) + 8 * j; const LAS float* s = scr + (8 * c) * 33 + n;
            v2u o; o.x = pg8::pack_fp8x4(s[0 * 33], s[1 * 33], s[2 * 33], s[3 * 33]); o.y = pg8::pack_fp8x4(s[4 * 33], s[5 * 33], s[6 * 33], s[7 * 33]);
            *(GAS v2u*)(cur.WT + (size_t)(cur.drow0 + n) * cur.Kp + cur.k0 + 8 * c) = o; }
        LDS_WAIT(); asm volatile("" ::: "memory");
        cur = nxt;
    }
}
__device__ __forceinline__ void moe_post_phase(Frame& F, const Args& a, int half) {
    const int gw = F.vcu * NWAVES + F.wave, NGW = F.G * NWAVES;
    const int R = (((32768 + NGW - 1) / NGW) + 1) & ~1, t0 = gw * R, t1 = (t0 + R) < 32768 ? (t0 + R) : 32768;
    RowVecs V; ld_row_f32(a.in[I_GFFNPOST] + D, F.lane, V.gA);
    int bcur = -2;
    const bf16* Y2 = (const bf16*)(F.ws + BIG_Y2S); const int* inv = (const int*)(F.ws + WS_INV); const int4* rt = (const int4*)(F.ws + WS_ROUTE);
    int4 ira, irb; int ip00, ip01, ip10, ip11;
    v2u nya[4], nyb[4], nyc[4], nyd[4], nxr0[4], nxr1[4]; const bf16* XB = (const bf16*)(F.ws + WS_XB); float nw0 = 0.f, nw1 = 0.f, nu0 = 0.f, nu1 = 0.f;
#define MP_IDX(t_) do { const int rw_ = half * 32768 + (t_); ira = rt[rw_]; irb = rt[rw_ + 1]; ip00 = inv[rw_ * 2]; ip01 = inv[rw_ * 2 + 1]; ip10 = inv[rw_ * 2 + 2]; ip11 = inv[rw_ * 2 + 3]; } while (0)
#define MP_DATA(t_) do { const int rw_ = half * 32768 + (t_); \
        ld_raw_bf16_nt(Y2 + (size_t)ip00 * D, F.lane, nya); ld_raw_bf16_nt(Y2 + (size_t)ip01 * D, F.lane, nyb); ld_raw_bf16_nt(Y2 + (size_t)ip10 * D, F.lane, nyc); ld_raw_bf16_nt(Y2 + (size_t)ip11 * D, F.lane, nyd); \
        const bf16* xq_ = XB + (size_t)rw_ * D; ld_raw_bf16_nt(xq_, F.lane, nxr0); ld_raw_bf16_nt(xq_ + D, F.lane, nxr1); \
        nw0 = __builtin_bit_cast(float, ira.z); nw1 = __builtin_bit_cast(float, ira.w); nu0 = __builtin_bit_cast(float, irb.z); nu1 = __builtin_bit_cast(float, irb.w); } while (0)
    if (t0 < t1) { MP_IDX(t0); MP_DATA(t0); if (t0 + 2 < t1) MP_IDX(t0 + 2); }
#pragma unroll 1
    for (int t = t0; t < t1; t += 2) {
        const int row = half * 32768 + t, b = row >> 11;
        if (b != bcur) { bcur = b; ld_mod(F, 1, b, 5, F.lane, V.gt, 0.f); }
        f32x4 y0[4], y1[4], x0[4], x1[4], h0[4], h1[4];
        float* xp = a.out + (size_t)row * D;
#pragma unroll
        for (int j = 0; j < 4; ++j) { x0[j] = cvt_raw_bf16(nxr0[j]); x1[j] = cvt_raw_bf16(nxr1[j]); y0[j] = cvt_raw_bf16(nya[j]) * nw0 + cvt_raw_bf16(nyb[j]) * nw1; y1[j] = cvt_raw_bf16(nyc[j]) * nu0 + cvt_raw_bf16(nyd[j]) * nu1; }
        if (t + 2 < t1) { MP_DATA(t + 2); if (t + 4 < t1) MP_IDX(t + 4); }
        row_pair(V, y0, y1, x0, x1, true, false, h0, h1);
        st_row_f32_nt(xp, F.lane, x0); st_row_f32_nt(xp + D, F.lane, x1);
    }
#undef MP_IDX
#undef MP_DATA
}

#ifndef MK_ONLY
#define MK_ONLY -1
#endif
#ifndef MK_SKIP
#define MK_SKIP -1
#endif
#define ON(k) ((MK_ONLY < 0 || MK_ONLY == (k)) && MK_SKIP != (k))
#ifndef MK_REPMASK
#define MK_REPMASK 0
#endif
#ifndef MK_REPSUB
#define MK_REPSUB 0
#endif
#ifndef MK_HYVAR
#define MK_HYVAR 0
#endif
#ifndef MK_PROBE
#define MK_PROBE -1
#endif
#ifndef MK_PROBE_END
#define MK_PROBE_END MK_PROBE
#endif
#ifndef MK_PROBE_DIV
#define MK_PROBE_DIV 10
#endif
#ifndef MK_MULTI
#define MK_MULTI 0
#endif
constexpr int NPHASES = 2 + 9 + 6 + 6;

typedef const __attribute__((address_space(4))) Args* ArgsP;
#define KARGS ((ArgsP)__builtin_amdgcn_kernarg_segment_ptr())
#define PH_ENTER \
    Frame F; const Args* ap_; { int t_ = threadIdx.x; asm volatile("" : "+v"(t_)); ArgsP q_ = KARGS; asm volatile("" : "+s"(q_)); ap_ = (const Args*)q_; \
      F.lds = (LAS unsigned char*)lds_raw; F.tid = t_; F.lane = t_ & 63; F.wave = __builtin_amdgcn_readfirstlane(t_ >> 6); \
      F.G = gridDim.x; { const int bx_ = blockIdx.x; F.vcu = (F.G % 8 == 0) ? (bx_ % 8) * (F.G / 8) + bx_ / 8 : bx_; } F.ws = q_->ws; F.hb = (bf16*)q_->out; } \
    const Args& a = *ap_; const int bx = (int)blockIdx.x; \
    bf16* const Hb = F.hb; bf16* const Y3 = (bf16*)(F.ws + WS_Y3); bf16* const QKV = (bf16*)(F.ws + BIG_QKV); bf16* const CINT = (bf16*)(F.ws + BIG_CINT); unsigned char* const GATE = F.ws + BIG_GATE; \
    (void)Hb; (void)Y3; (void)QKV; (void)CINT; (void)GATE; (void)bx; (void)a;

__global__ void __launch_bounds__(NTHREADS, 2) fwd_kernel(Args args) {
    extern __shared__ __attribute__((aligned(16))) unsigned char lds_raw[];
    {
        volatile LAS unsigned* MISC0 = (volatile LAS unsigned*)((LAS unsigned char*)lds_raw + MISC_OFF);
        for (int u = threadIdx.x; u < (LDS_BYTES - MISC_OFF) / 4; u += NTHREADS) MISC0[u] = 0u;
        __syncthreads();
    }
    if (!MK_MULTI) (void)xcd_barrier_post((unsigned*)(KARGS->ws + WS_CTL) + CW_BAR, (volatile LAS unsigned*)((LAS unsigned char*)lds_raw + MISC_OFF) + 8);
    int ph = 0;
#define PROBE_STAMP(which) do { if (MK_PROBE >= 0 && blockIdx.x == 0 && __builtin_amdgcn_readfirstlane((int)threadIdx.x) == 0) { volatile unsigned* pw_ = (volatile unsigned*)(KARGS->ws + WS_CTL) + 20000; const unsigned t_ = (unsigned)__builtin_amdgcn_s_memrealtime(); if ((which) == 0) pw_[0] = t_; else pw_[1] = t_ - pw_[0]; } } while (0)
    if (MK_PROBE == 0) PROBE_STAMP(0);
#define LO_ (KARGS->ph_lo)
#define HI_ (KARGS->ph_hi)
#define GRID_BAR do { XcdBarrier b_; b_.bar = (unsigned*)(KARGS->ws + WS_CTL) + CW_BAR; b_.x = xb_xcc_id(); b_.st = (volatile LAS unsigned*)((LAS unsigned char*)lds_raw + MISC_OFF) + 8; xcd_barrier(b_); } while (0)
#define RUN (LO_ <= ph && ph < HI_)
#define END_PHASE do { if (RUN && (ph + 1 < HI_)) { GRID_BAR; } if (MK_PROBE > 0 && ph + 1 == MK_PROBE) PROBE_STAMP(0); if (MK_PROBE >= 0 && ph == MK_PROBE_END) PROBE_STAMP(1); ++ph; } while (0)

    if (RUN && ON(0)) { PH_ENTER p0_prologue(F, a); } END_PHASE;
    if (RUN && ON(1)) { PH_ENTER p1_phase(F, a); rows_phase<false>(F, a, 0, 0, 0, nullptr, NROW); } END_PHASE;

#pragma unroll 1
    for (int l = 0; l < 2; ++l) {
        const int nrows = l == 0 ? NROW : NTOK;
        if (RUN && ON(2)) { PH_ENTER
            const bf16* Wq8 = (const bf16*)(F.ws + W_IN + (size_t)l * INC * D);
            { pg8::Gemm g{(const bf16*)(F.ws + WS_H8), Wq8, nrows, QKVC, D / 2}; pg8::StaticOrder S; S.init(nrows, QKVC, F.G, bx);
              pg8::EpiQKV E{QKV, (const float*)(F.ws + WS_ROPE), 0, QSCALE, 1.0f / W13_SCALE};
              pg8::gemm_phase<pg8::EpiQKV, pg8::StaticOrder, true, true, true>(F.lds, g, S, E, F.tid); }
            int tid2 = threadIdx.x; asm volatile("" : "+v"(tid2));
            if (l == 1) { pg8::Gemm g{(const bf16*)(F.ws + WS_H8 + (size_t)NTOK * D), Wq8, NCTX, 1280, D / 2}; pg8::StaticOrder S; S.init(NCTX, 1280, F.G, bx);
              pg8::EpiQKV E{QKV, (const float*)(F.ws + WS_ROPE), NTOK, QSCALE, 1.0f / W13_SCALE};
              pg8::gemm_phase<pg8::EpiQKV, pg8::StaticOrder, true, true, true>(F.lds, g, S, E, tid2); }
            int tid3 = threadIdx.x; asm volatile("" : "+v"(tid3));
            { pg8::Gemm g{(const bf16*)(F.ws + W_CB) + (size_t)l * CINC * D, Hb, CINC, nrows, D}; pg8::StaticOrder S; S.init(CINC, nrows, F.G, bx);
              pg8::EpiPlain E{CINT, NROW, 0, 0, 1.0f};
              pg8::gemm_phase<pg8::EpiPlain, pg8::StaticOrder, true, true>(F.lds, g, S, E, tid3); }
        } END_PHASE;
        if (RUN) {
            { PH_ENTER const float* sink = a.in[I_SINK] + l * 8; const float* rpb = a.in[I_RPB] + (size_t)l * 8 * 15 * 31; const int sm = a.sub_mask;
              if (ON(3) && (sm & 1)) { AttPre P; P.valid = 0; int th = -1; for (int u = F.vcu; u < 2048; u += F.G) attn_unit<0>(F, u, u + F.G < 2048 ? u + F.G : -1, QKV, Y3, sink, rpb, P, th, (sm >> 6) & 3); } }
            { PH_ENTER const float* sink = a.in[I_SINK] + l * 8; const float* rpb = a.in[I_RPB] + (size_t)l * 8 * 15 * 31; const int sm = a.sub_mask;
              if (ON(4) && (sm & 2)) { AttPre P; P.valid = 0; int th = -1; for (int u = F.vcu; u < 2048; u += F.G) attn_unit<1>(F, u, u + F.G < 2048 ? u + F.G : -1, QKV, Y3 + (size_t)NROW * 512, sink, rpb, P, th, (sm >> 6) & 3); } }
            { PH_ENTER const float* sink = a.in[I_SINK] + l * 8; const float* rpb = a.in[I_RPB] + (size_t)l * 8 * 15 * 31; const int sm = a.sub_mask;
              if (l == 0 && ON(5) && (sm & 4)) {
                { AttPre P; P.valid = 0; int th = -1; for (int u = F.vcu; u < 256; u += F.G) attn_unit<2>(F, u, -1, QKV, Y3, sink, rpb, P, th); }
                { AttPre P; P.valid = 0; int th = -1; for (int u = F.vcu; u < 256; u += F.G) attn_unit<3>(F, u, -1, QKV, Y3 + (size_t)NROW * 512, sink, rpb, P, th); }
              } }
            { PH_ENTER const int sm = a.sub_mask;
              const float* cw = a.in[I_CONVW] + l * 3 * CINC; const float* cb = a.in[I_CONVB] + l * CINC; const float* hb = a.in[I_HBIAS] + l * 1024;
#if MK_HYVAR
              if (ON(6) && (sm & 32)) for (int c = F.vcu; c < 512; c += F.G) hyena_unit<SEQ, MK_HYVAR>(F, c, CINT, CINT, (const bf16*)(F.ws + WS_GF) + (size_t)l * 2 * 512 * 2 * SEQ, cw, cb, hb);
#endif
              if (ON(6) && (sm & 8)) for (int c = F.vcu; c < 512; c += F.G) hyena_unit<SEQ>(F, c, CINT, CINT, (const bf16*)(F.ws + WS_GF) + (size_t)l * 2 * 512 * 2 * SEQ, cw, cb, hb);
              if (l == 0 && ON(7) && (sm & 16)) for (int c = F.vcu; c < 512; c += F.G) hyena_unit<LC>(F, c, CINT, CINT, (const bf16*)(F.ws + WS_GFC) + (size_t)l * 2 * 512 * 2 * LC, cw, cb, hb);
              __syncthreads(); }
        } END_PHASE;
        if (RUN && ON(8)) { PH_ENTER
            transpose_yc(F, CINT, (bf16*)(F.ws + BIG_YCT), nrows);
            __syncthreads();
            pg8::Gemm g{(const bf16*)(F.ws + WS_H8), (const bf16*)(F.ws + W_IN + (size_t)l * INC * D + (size_t)(QKVC + CINC) * D), nrows, GATEC, D / 2}; pg8::StaticOrder S; S.init(nrows, GATEC, F.G, bx);
            pg8::EpiSig E{GATE, GATEC, 1.0f / W13_SCALE};
            pg8::gemm_phase<pg8::EpiSig, pg8::StaticOrder, true, true, true>(F.lds, g, S, E, F.tid);
        } END_PHASE;
        if (RUN && ON(9)) { PH_ENTER
            constexpr int TB = 256 * 512 * 2;
            static_assert((WS_Y3 - BIG_YCT) % TB == 0, "merge tile offsets");
            constexpr int OA = (int)((WS_Y3 - BIG_YCT) / TB), OB = OA + NROW / 256;
            pg8::Gemm g{(const bf16*)(F.ws + BIG_YCT), (const bf16*)(F.ws + W_BR) + (size_t)l * 3 * D * 512, 3 * NROW, 3 * D, 512}; pg8::MergeOrder S{nrows / 256, F.G, bx, OA, OB, 0};
            pg8::EpiMerge E{Hb, GATE, OA, OB, 0};
            pg8::gemm_phase<pg8::EpiMerge, pg8::MergeOrder, true, true>(F.lds, g, S, E, F.tid);
        } END_PHASE;
        if (RUN && ON(10)) { PH_ENTER
            pg8::Gemm g{Hb, (const bf16*)(F.ws + W_OUT) + (size_t)l * D * D, nrows, D, D}; pg8::StaticOrder S; S.init(nrows, D, F.G, bx);
            pg8::EpiPlain E{Y3, D, 0, 0, 1.0f};
            pg8::gemm_phase<pg8::EpiPlain, pg8::StaticOrder, true, true>(F.lds, g, S, E, F.tid);
        } END_PHASE;
        if (RUN && ON(11)) { PH_ENTER if (l == 0) rows_phase<false>(F, a, 1, 0, 0, Y3, nrows); else post_route_phase(F, a, Y3); } END_PHASE;
        if (l == 0) {
            if (RUN && ON(12)) { PH_ENTER
                pg8::Gemm g{Hb, (const bf16*)(F.ws + W_F13), NROW, 2 * DFF, D}; pg8::StaticOrder S; S.init(NROW, 2 * DFF, F.G, bx);
                pg8::EpiSwiGLU E{(bf16*)(F.ws + BIG_HID), DFF, 0};
                pg8::gemm_phase<pg8::EpiSwiGLU, pg8::StaticOrder, true, true>(F.lds, g, S, E, F.tid);
            } END_PHASE;
            if (RUN && ON(13)) { PH_ENTER
                pg8::Gemm g{(const bf16*)(F.ws + BIG_HID), (const bf16*)(F.ws + W_F2), NROW, D, DFF}; pg8::StaticOrder S; S.init(NROW, D, F.G, bx);
                pg8::EpiPlain E{Y3, D, 0, 0, 1.0f};
                pg8::gemm_phase<pg8::EpiPlain, pg8::StaticOrder, true, true>(F.lds, g, S, E, F.tid);
            } END_PHASE;
            if (RUN && ON(14)) { PH_ENTER rows_phase<true>(F, a, 1, 0, 1, Y3, NROW); } END_PHASE;
        } else {
#pragma unroll 1
            for (int half = 0; half < 2; ++half) {
                if (half == 0) { if (RUN && ON(15)) { PH_ENTER moe_convert(F, a); moe_gather_phase(F, 0); } END_PHASE; }
                if (RUN && ON(16)) { PH_ENTER
                    int toff[9], cnt[8]; moe_offsets(F, half, toff, cnt);
                    pg8::GroupOrder S; S.nM = toff[8]; S.nN = 28; S.G = F.G; S.c = bx;
#pragma unroll
                    for (int k = 0; k < 9; ++k) S.toff[k] = toff[k];
                    pg8::Gemm g{(const bf16*)(F.ws + BIG_AS), (const bf16*)(F.ws + WM_13), PCAP, 8 * 2 * DFFE, D / 2};
                    pg8::EpiSwiGLU8 E{F.ws + BIG_MH, DFFE, 28, 1.0f / W13_SCALE, HID_SCALE};
                    pg8::gemm_phase<pg8::EpiSwiGLU8, pg8::GroupOrder, true, true, true>(F.lds, g, S, E, F.tid);
                    if (half == 1) moe_post_phase(F, a, 0);
                } END_PHASE;
                if (RUN && ON(17)) { PH_ENTER
                    int toff[9], cnt[8]; moe_offsets(F, half, toff, cnt);
                    pg8::GroupOrder S; S.nM = toff[8]; S.nN = 4; S.G = F.G; S.c = bx;
#pragma unroll
                    for (int k = 0; k < 9; ++k) S.toff[k] = toff[k];
                    pg8::Gemm g{(const bf16*)(F.ws + BIG_MH), (const bf16*)(F.ws + WM_2), PCAP, 8 * D, DFFE / 2};
                    pg8::EpiPlain E{(bf16*)(F.ws + BIG_Y2S), D, 4, 0, 1.0f / (HID_SCALE * W2_SCALE)};
                    pg8::gemm_phase<pg8::EpiPlain, pg8::GroupOrder, true, true, true>(F.lds, g, S, E, F.tid);
                    if (half == 0) moe_gather_phase(F, 1, toff[8] * 4 - 4 * F.G);
                } END_PHASE;
            }
            if (RUN && ON(18)) { PH_ENTER moe_post_phase(F, a, 1); } END_PHASE;
        }
    }
#undef RUN
#undef END_PHASE
    if (MK_PROBE >= 0 && blockIdx.x == 0 && threadIdx.x == 0) {
        volatile unsigned* pw_ = (volatile unsigned*)(KARGS->ws + WS_CTL) + 20000;
        volatile float* o_ = (volatile float*)KARGS->out;
        o_[0] = o_[0] + floorf((float)pw_[1] * (0.01f / MK_PROBE_DIV));
    }
}

extern "C" void kernel_launch(void* const* d_in, const int* in_sizes, int n_in, void* d_out, int out_size, void* d_ws, size_t ws_size, hipStream_t stream) {
    static int grid = 0;
    if (grid == 0) {
        if (n_in != 31 || in_sizes[0] != NTOK * D || out_size != NTOK * D || ws_size < WS_END) { fprintf(stderr, "kernel_launch: unexpected shapes (n_in %d, in0 %d, out %d, ws %zu)\n", n_in, n_in > 0 ? in_sizes[0] : -1, out_size, ws_size); grid = -1; return; }
        int dev = 0, cus = 0, per_cu = 0;
        if (hipGetDevice(&dev) != hipSuccess || hipDeviceGetAttribute(&cus, hipDeviceAttributeMultiprocessorCount, dev) != hipSuccess) { grid = -1; return; }
        if (hipFuncSetAttribute((const void*)fwd_kernel, hipFuncAttributeMaxDynamicSharedMemorySize, LDS_BYTES) != hipSuccess) { fprintf(stderr, "kernel_launch: hipFuncSetAttribute failed\n"); grid = -1; return; }
        if (hipOccupancyMaxActiveBlocksPerMultiprocessor(&per_cu, (const void*)fwd_kernel, NTHREADS, LDS_BYTES) != hipSuccess || per_cu < 1) { fprintf(stderr, "kernel_launch: occupancy query says %d\n", per_cu); }
        (void)hipGetLastError();
        grid = cus;
    }
    if (grid < 0) return;
    if (hipMemsetAsync((char*)d_ws + WS_CTL, 0, CTL_ZERO_BYTES, stream) != hipSuccess) return;
    Args a{};
    for (int i = 0; i < 31; ++i) a.in[i] = (const float*)d_in[i];
    a.out = (float*)d_out; a.ws = (unsigned char*)d_ws;
#if MK_MULTI
    for (int p = 0; p < NPHASES; ++p) { a.ph_lo = p; a.ph_hi = p + 1; a.sub_mask = 31;
        const bool mix = (p == 3 || p == 12);
        if (((MK_REPMASK >> p) & 1) && !mix) { a.sub_mask = 31 | MK_REPSUB; hipLaunchKernelGGL(fwd_kernel, dim3(grid), dim3(NTHREADS), LDS_BYTES, stream, a); a.sub_mask = 31; }
        if (((MK_REPMASK >> p) & 1) && mix) { a.sub_mask = MK_REPSUB; hipLaunchKernelGGL(fwd_kernel, dim3(grid), dim3(NTHREADS), LDS_BYTES, stream, a); a.sub_mask = 31; }
        hipLaunchKernelGGL(fwd_kernel, dim3(grid), dim3(NTHREADS), LDS_BYTES, stream, a); }
#else
    a.ph_lo = 0; a.ph_hi = NPHASES; a.sub_mask = 31;
    hipLaunchKernelGGL(fwd_kernel, dim3(grid), dim3(NTHREADS), LDS_BYTES, stream, a);
#endif
    const hipError_t le = hipPeekAtLastError();
    if (le != hipSuccess) fprintf(stderr, "kernel_launch: launch failed: %s\n", hipGetErrorName(le));
}
```

```cpp
#include <hip/hip_runtime.h>
#include <cstdio>
#include <cstdint>
namespace pg8 {
#define PG8_LAS __attribute__((address_space(3)))
typedef unsigned short bf16_t;
typedef short bf16x8 __attribute__((ext_vector_type(8)));
typedef float f32x4 __attribute__((ext_vector_type(4)));
typedef unsigned u32x4 __attribute__((ext_vector_type(4)));
constexpr int BM = 256, BK = 64, HALF = 128, HTB = HALF * BK * 2  , STAGE_BYTES = 8 * HTB, NXCD = 8, WGM = 8;

__host__ __device__ __forceinline__ int lds_byte(int r, int c) { const int st = (r >> 4) * 2 + (c >> 5), rr = r & 15, cc = c & 31, ob = rr * 64 + cc * 2; return st * 1024 + (ob ^ (((ob >> 9) & 1) << 5)); }
__host__ __device__ __forceinline__ void stage_rc(int b, int& R, int& C) { const int st = b / 1024, sb = b % 1024, swz = sb ^ (((sb >> 9) & 1) << 5); R = (st >> 1) * 16 + swz / 64; C = (st & 1) * 32 + (swz % 64) / 2; }
__host__ __device__ __forceinline__ int perm32(int rho) { const int n = rho >> 4, i = rho & 15; return 8 * (i >> 2) + 4 * n + (i & 3); }

struct Unit { int pm, pn; };
struct Gemm { const bf16_t* A; const bf16_t* Bt; int M, N, K; };

struct StaticOrder {
    int nM, nN, nwg, G, c;
    __host__ __device__ void init(int M, int N, int G_, int c_) { nM = M / BM; nN = N / BM; nwg = nM * nN; G = G_; c = c_; }
    __host__ __device__ bool next(int i, Unit& u) const {
        const long L = (long)i * G + c; if (L >= nwg) return false;
        int wgid = (int)L; { const int q = nwg / NXCD, r = nwg % NXCD, xcd = wgid % NXCD, off = wgid / NXCD; wgid = (xcd < r ? xcd * (q + 1) : r * (q + 1) + (xcd - r) * q) + off; }
        const int nig = WGM * nN, gid = wgid / nig, fm = gid * WGM, gsz = (nM - fm) < WGM ? (nM - fm) : WGM;
        u.pm = fm + ((wgid % nig) % gsz); u.pn = (wgid % nig) / gsz; return true;
    }
    __device__ __forceinline__ void a_ready(const Unit&) const {}
    __device__ __forceinline__ void done(const Unit&) const {}
};

typedef float f32x2_t __attribute__((ext_vector_type(2)));
typedef __bf16 bf16x2_t __attribute__((ext_vector_type(2)));
__device__ __forceinline__ unsigned cvt_pk_bf16(float lo, float hi) { const f32x2_t v = {lo, hi}; const bf16x2_t b = __builtin_convertvector(v, bf16x2_t); return __builtin_bit_cast(unsigned, b); }
__device__ __forceinline__ u32x4 pack8(f32x4 a, f32x4 b) { u32x4 w; w.x = cvt_pk_bf16(a[0], a[1]); w.y = cvt_pk_bf16(a[2], a[3]); w.z = cvt_pk_bf16(b[0], b[1]); w.w = cvt_pk_bf16(b[2], b[3]); return w; }
__device__ __forceinline__ float bf_lo(unsigned w) { return __builtin_bit_cast(float, w << 16); }
__device__ __forceinline__ float bf_hi(unsigned w) { return __builtin_bit_cast(float, w & 0xffff0000u); }
__device__ __forceinline__ void unpack8(u32x4 w, f32x4& a, f32x4& b) { a = (f32x4){bf_lo(w.x), bf_hi(w.x), bf_lo(w.y), bf_hi(w.y)}; b = (f32x4){bf_lo(w.z), bf_hi(w.z), bf_lo(w.w), bf_hi(w.w)}; }
__device__ __forceinline__ float fast_sigmoid(float x) { return __builtin_amdgcn_rcpf(1.0f + __builtin_amdgcn_exp2f(-1.4426950408889634f * x)); }

__device__ __forceinline__ f32x4 vexp2(f32x4 x) { return (f32x4){__builtin_amdgcn_exp2f(x[0]), __builtin_amdgcn_exp2f(x[1]), __builtin_amdgcn_exp2f(x[2]), __builtin_amdgcn_exp2f(x[3])}; }
__device__ __forceinline__ f32x4 vrcp(f32x4 x) { return (f32x4){__builtin_amdgcn_rcpf(x[0]), __builtin_amdgcn_rcpf(x[1]), __builtin_amdgcn_rcpf(x[2]), __builtin_amdgcn_rcpf(x[3])}; }
__device__ __forceinline__ f32x4 vsigmoid(f32x4 x, float k) { return vrcp(vexp2(x * k) + 1.0f); }
struct EpiPlain {
    static constexpr bool PERM = true, AFTER_DRAIN = false, INPLACE = false;
    bf16_t* O; int ldc; int pn_mod; int accum; float scale;
    __device__ __forceinline__ void operator()(const f32x4 (&acc)[2][2][4][2], const Unit& u, int wr, int wc, int fr, int fq) const {
        asm volatile("" : "+v"(fr), "+v"(fq));
        const int pn = pn_mod ? (u.pn % pn_mod) : u.pn;
        const int row0 = u.pm * BM + wr * 64 + fr, col0 = pn * BM + wc * 32 + 8 * fq;
#pragma unroll
        for (int ai = 0; ai < 2; ++ai)
#pragma unroll
            for (int m = 0; m < 4; ++m) { bf16_t* rowp = O + (size_t)(row0 + ai * HALF + m * 16) * ldc + col0;
#pragma unroll
                for (int bj = 0; bj < 2; ++bj) { f32x4 v0 = acc[ai][bj][m][0] * scale, v1 = acc[ai][bj][m][1] * scale;
                    if (accum) { f32x4 p0, p1; unpack8(*(const u32x4*)(rowp + bj * HALF), p0, p1); v0 = v0 + p0; v1 = v1 + p1; }
                    *(u32x4*)(rowp + bj * HALF) = pack8(v0, v1); } }
    }
};
__device__ __forceinline__ unsigned pack_u8x4(float a, float b, float c, float d) {
    unsigned w = 0; w = __builtin_amdgcn_cvt_pk_u8_f32(a, 0, w); w = __builtin_amdgcn_cvt_pk_u8_f32(b, 1, w); w = __builtin_amdgcn_cvt_pk_u8_f32(c, 2, w); w = __builtin_amdgcn_cvt_pk_u8_f32(d, 3, w); return w; }
struct EpiSig {
    static constexpr bool PERM = true, AFTER_DRAIN = false, INPLACE = false;
    unsigned char* O; int ldc; float in_scale;
    __device__ __forceinline__ void operator()(const f32x4 (&acc)[2][2][4][2], const Unit& u, int wr, int wc, int fr, int fq) const {
        const int t = ((wr * 4 + wc) * 4 + fq) * 16 + fr;
        unsigned char* tile = O + ((size_t)u.pm * (ldc / BM) + u.pn) * (BM * BM) + (size_t)t * 16;
        const float k = -1.4426950408889634f * in_scale;
#pragma unroll
        for (int ai = 0; ai < 2; ++ai)
#pragma unroll
            for (int m = 0; m < 4; ++m) { u32x4 w;
                { const f32x4 v0 = vsigmoid(acc[ai][0][m][0], k) * 255.0f, v1 = vsigmoid(acc[ai][0][m][1], k) * 255.0f;
                  w.x = pack_u8x4(fmaxf(v0[0], 1.f), fmaxf(v0[1], 1.f), fmaxf(v0[2], 1.f), fmaxf(v0[3], 1.f)); w.y = pack_u8x4(fmaxf(v1[0], 1.f), fmaxf(v1[1], 1.f), fmaxf(v1[2], 1.f), fmaxf(v1[3], 1.f)); }
                { const f32x4 v0 = vsigmoid(acc[ai][1][m][0], k) * 255.0f, v1 = vsigmoid(acc[ai][1][m][1], k) * 255.0f;
                  w.z = pack_u8x4(fmaxf(v0[0], 1.f), fmaxf(v0[1], 1.f), fmaxf(v0[2], 1.f), fmaxf(v0[3], 1.f)); w.w = pack_u8x4(fmaxf(v1[0], 1.f), fmaxf(v1[1], 1.f), fmaxf(v1[2], 1.f), fmaxf(v1[3], 1.f)); }
                *(u32x4*)(tile + (ai * 4 + m) * (512 * 16)) = w; }
    }
};
struct EpiSwiGLU {
    static constexpr bool PERM = true, AFTER_DRAIN = false, INPLACE = false;
    bf16_t* O; int ldc; int pn_mod;
    __device__ __forceinline__ void operator()(const f32x4 (&acc)[2][2][4][2], const Unit& u, int wr, int wc, int fr, int fq) const {
        const int pn = pn_mod ? (u.pn % pn_mod) : u.pn;
        const int row0 = u.pm * BM + wr * 64 + fr, col0 = pn * HALF + wc * 32 + 8 * fq;
#pragma unroll
        for (int ai = 0; ai < 2; ++ai)
#pragma unroll
            for (int m = 0; m < 4; ++m) { bf16_t* rowp = O + (size_t)(row0 + ai * HALF + m * 16) * ldc + col0;
                const f32x4 a0 = acc[ai][0][m][0], a1 = acc[ai][0][m][1], g0 = acc[ai][1][m][0], g1 = acc[ai][1][m][1];
                const f32x4 v0 = (a0 * g0) * vsigmoid(a0, -1.4426950408889634f), v1 = (a1 * g1) * vsigmoid(a1, -1.4426950408889634f);
                *(u32x4*)rowp = pack8(v0, v1); }
    }
};
__device__ __forceinline__ unsigned pack_fp8x4(float a, float b, float c, float d) {
    a = __builtin_amdgcn_fmed3f(a, -448.f, 448.f); b = __builtin_amdgcn_fmed3f(b, -448.f, 448.f); c = __builtin_amdgcn_fmed3f(c, -448.f, 448.f); d = __builtin_amdgcn_fmed3f(d, -448.f, 448.f);
    int w = 0; w = __builtin_amdgcn_cvt_pk_fp8_f32(a, b, w, false); w = __builtin_amdgcn_cvt_pk_fp8_f32(c, d, w, true); return (unsigned)w; }
struct EpiSwiGLU8 {
    static constexpr bool PERM = true, AFTER_DRAIN = false, INPLACE = false;
    unsigned char* O; int ldc; int pn_mod; float in_scale, out_scale;
    __device__ __forceinline__ void operator()(const f32x4 (&acc)[2][2][4][2], const Unit& u, int wr, int wc, int fr, int fq) const {
        asm volatile("" : "+v"(fr), "+v"(fq));
        const int pn = pn_mod ? (u.pn % pn_mod) : u.pn;
        const int row0 = u.pm * BM + wr * 64 + fr, col0 = pn * HALF + wc * 32 + 8 * fq;
#pragma unroll
        for (int ai = 0; ai < 2; ++ai)
#pragma unroll
            for (int m = 0; m < 4; ++m) { unsigned char* rowp = O + (size_t)(row0 + ai * HALF + m * 16) * ldc + col0;
                const f32x4 a0 = acc[ai][0][m][0], a1 = acc[ai][0][m][1], g0 = acc[ai][1][m][0], g1 = acc[ai][1][m][1];
                const float k1 = -1.4426950408889634f * in_scale, k2 = in_scale * in_scale * out_scale;
                const f32x4 v0 = ((a0 * g0) * vsigmoid(a0, k1)) * k2, v1 = ((a1 * g1) * vsigmoid(a1, k1)) * k2;
                typedef unsigned u32x2_ __attribute__((ext_vector_type(2)));
                u32x2_ w; w.x = pack_fp8x4(v0[0], v0[1], v0[2], v0[3]); w.y = pack_fp8x4(v1[0], v1[1], v1[2], v1[3]);
                *(u32x2_*)rowp = w; }
    }
};
struct EpiMerge {
    static constexpr bool PERM = true, AFTER_DRAIN = false, INPLACE = true;
    bf16_t* Mo; const unsigned char* Gt; int off0, off1, off2;
    __device__ __forceinline__ static void ub4(unsigned w, f32x4& v) { v = (f32x4){(float)(w & 0xffu), (float)((w >> 8) & 0xffu), (float)((w >> 16) & 0xffu), (float)(w >> 24)}; }
    __device__ __forceinline__ bool inplace(f32x4 (&acc)[2][2][4][2], const Unit& u, int wr, int wc, int fr, int fq) const {
        const int br = u.pn >> 2, pn = u.pn & 3, pm = u.pm - (br < 2 ? off0 + br * (off1 - off0) : off2);
        const int row0 = pm * BM + wr * 64 + fr, col0 = pn * BM + wc * 32 + 8 * fq;
        const int t = ((wr * 4 + wc) * 4 + fq) * 16 + fr;
        const unsigned char* gt = Gt + ((size_t)pm * 12 + br * 4 + pn) * (BM * BM) + (size_t)t * 16;
#pragma unroll
        for (int ai = 0; ai < 2; ++ai)
#pragma unroll
            for (int m = 0; m < 4; ++m) { const size_t row = (size_t)(row0 + ai * HALF + m * 16);
                const u32x4 gq = *(const u32x4*)(gt + (ai * 4 + m) * (512 * 16));
                if (br < 2) { const u32x4 nq = *(const u32x4*)(gt + 4 * (BM * BM) + (ai * 4 + m) * (512 * 16));
#pragma unroll
                    for (int bj = 0; bj < 2; ++bj) { f32x4 g0, g1, n0, n1; ub4(bj ? gq.z : gq.x, g0); ub4(bj ? gq.w : gq.y, g1); ub4(bj ? nq.z : nq.x, n0); ub4(bj ? nq.w : nq.y, n1);
#pragma unroll
                        for (int e = 0; e < 4; ++e) { g0[e] = g0[e] * __builtin_amdgcn_rcpf(n0[e]); g1[e] = g1[e] * __builtin_amdgcn_rcpf(n1[e]); }
                        acc[ai][bj][m][0] = acc[ai][bj][m][0] * g0; acc[ai][bj][m][1] = acc[ai][bj][m][1] * g1; }
                } else {
#pragma unroll
                    for (int bj = 0; bj < 2; ++bj) { f32x4 g0, g1; ub4(bj ? gq.z : gq.x, g0); ub4(bj ? gq.w : gq.y, g1);
                        *(u32x4*)(Mo + row * 1024 + col0 + bj * HALF) = pack8(acc[ai][bj][m][0] * (g0 * (1.0f / 255.0f)), acc[ai][bj][m][1] * (g1 * (1.0f / 255.0f))); }
                } }
        return br < 2;
    }
};
struct EpiQKV {
    static constexpr bool PERM = true, AFTER_DRAIN = false, INPLACE = false;
    bf16_t* O; const float* rope; int row_base; float qscale; float in_scale;
    __device__ __forceinline__ void operator()(const f32x4 (&acc)[2][2][4][2], const Unit& u, int wr, int wc, int fr, int fq) const {
        const int rowt = row_base + u.pm * BM;
        const bool latent = rowt < 65536;
        const int row0 = rowt + wr * 64 + fr, col0 = u.pn * BM + wc * 32 + 8 * fq;
#pragma unroll
        for (int bj = 0; bj < 2; ++bj) {
            const int cb = 2 * u.pn + bj;
            const bool do_rope = latent && (cb == 0 || (cb >= 10 && cb < 14));
            const float sc = (cb >= 10) ? qscale * in_scale : in_scale;
#pragma unroll
            for (int ai = 0; ai < 2; ++ai)
#pragma unroll
                for (int m = 0; m < 4; ++m) {
                    const int row = row0 + ai * HALF + m * 16;
                    f32x4 v0 = acc[ai][bj][m][0], v1 = acc[ai][bj][m][1];
                    if (do_rope) {
                        const int t = row & 2047, pos = (wc & 1) ? (t & 63) : (t >> 6);
                        const float* cp = rope + pos * 16 + 8 * (fq & 1);
                        const f32x4 c0 = *(const f32x4*)cp, c1 = *(const f32x4*)(cp + 4), s0 = *(const f32x4*)(cp + 1024), s1 = *(const f32x4*)(cp + 1028);
                        const float sg = (fq >= 2) ? 1.0f : -1.0f;
                        f32x4 o0, o1;
#pragma unroll
                        for (int e = 0; e < 4; ++e) { o0[e] = __shfl_xor(v0[e], 32); o1[e] = __shfl_xor(v1[e], 32); }
                        v0 = v0 * c0 + (o0 * sg) * s0; v1 = v1 * c1 + (o1 * sg) * s1;
                    }
                    v0 = v0 * sc; v1 = v1 * sc;
                    *(u32x4*)(O + (size_t)row * 2304 + col0 + bj * HALF) = pack8(v0, v1);
                }
        }
    }
};
__device__ __forceinline__ void tile_of(int L, int nM, int nN, int& pm, int& pn) {
    const int nwg = nM * nN; int wgid = L; { const int q = nwg / NXCD, r = nwg % NXCD, xcd = wgid % NXCD, off = wgid / NXCD; wgid = (xcd < r ? xcd * (q + 1) : r * (q + 1) + (xcd - r) * q) + off; }
    const int nig = WGM * nN, gid = wgid / nig, fm = gid * WGM, gsz = (nM - fm) < WGM ? (nM - fm) : WGM;
    pm = fm + ((wgid % nig) % gsz); pn = (wgid % nig) / gsz;
}
struct MergeOrder {
    int nM, G, c, off0, off1, off2;
    __device__ bool next(int i, Unit& u) const {
        const int t = i / 3, br = i - 3 * t; const long L = (long)t * G + c; if (L >= (long)nM * 4) return false;
        int pm, pn; tile_of((int)L, nM, 4, pm, pn); u.pm = (br < 2 ? off0 + br * (off1 - off0) : off2) + pm; u.pn = br * 4 + pn; return true;
    }
    __device__ __forceinline__ void a_ready(const Unit&) const {}
    __device__ __forceinline__ void done(const Unit&) const {}
};
struct GroupOrder {
    int nM, nN, G, c; int toff[9];
    __device__ bool next(int i, Unit& u) const {
        const long L = (long)i * G + c; if (L >= (long)nM * nN) return false;
        int pm, pn; tile_of((int)L, nM, nN, pm, pn); int e = 0;
#pragma unroll
        for (int k = 1; k < 8; ++k) e += (pm >= toff[k]) ? 1 : 0;
        u.pm = pm; u.pn = e * nN + pn; return true;
    }
    __device__ __forceinline__ void a_ready(const Unit&) const {}
    __device__ __forceinline__ void done(const Unit&) const {}
};
template <class Epi, class Sched, bool ALIGN_EPI = false, bool SP2 = false, bool F8 = false>
__device__ __forceinline__ void gemm_phase(PG8_LAS unsigned char* lds, const Gemm g, const Sched& S, const Epi& E, const int tid) {
    const int wid = __builtin_amdgcn_readfirstlane(tid >> 6), lane = tid & 63, wr = wid >> 2, wc = wid & 3, fr = lane & 15, fq = lane >> 4;
    const int K = g.K, nt = K / BK;
    unsigned voffA[2], voffB[2];
#pragma unroll
    for (int i = 0; i < 2; ++i) { int R, C; stage_rc(tid * 16 + i * 8192, R, C); const int Rb = Epi::PERM ? ((R & ~31) + perm32(R & 31)) : R;
        voffA[i] = (unsigned)(R * K + C) * 2u; voffB[i] = (unsigned)(Rb * K + C) * 2u; }
    const size_t kstep = (size_t)(BK * 2);
    const size_t hstep = (size_t)HALF * K * 2;
    const size_t tstep = 2 * hstep;
    const unsigned ldsw = (unsigned)wid * 1024u;
    const int aoff = lds_byte(wr * 64 + fr, fq * 8), boff = lds_byte(wc * 32 + fr, fq * 8);
#define PG8_SA(b, h) (((b) * 2 + (h)) * HTB)
#define PG8_SB(b, h) ((4 + (b) * 2 + (h)) * HTB)
#define PG8_STAGE(bufoff, gbase, voff) do { _Pragma("unroll") for (int _i = 0; _i < 2; ++_i) \
        __builtin_amdgcn_global_load_lds((const unsigned*)((const char*)(gbase) + (voff)[_i]), (PG8_LAS unsigned*)(lds + (bufoff) + ldsw + _i * 8192), 16, 0, 0); } while (0)
#define PG8_LDA(dst, b, h) do { _Pragma("unroll") for (int m = 0; m < 4; ++m) _Pragma("unroll") for (int k = 0; k < 2; ++k) dst[m][k] = *(const PG8_LAS bf16x8*)(lds + PG8_SA(b, h) + aoff + m * 2048 + k * 1024); } while (0)
#define PG8_LDB(dst, b, h) do { _Pragma("unroll") for (int n = 0; n < 2; ++n) _Pragma("unroll") for (int k = 0; k < 2; ++k) dst[n][k] = *(const PG8_LAS bf16x8*)(lds + PG8_SB(b, h) + boff + n * 2048 + k * 1024); } while (0)
#define PG8_MMA(ai, bj, At, Bt) do { __builtin_amdgcn_s_setprio(1); _Pragma("unroll") for (int m = 0; m < 4; ++m) _Pragma("unroll") for (int n = 0; n < 2; ++n) { \
        if constexpr (F8) { typedef int v8i_ __attribute__((ext_vector_type(8))); typedef int v4i_ __attribute__((ext_vector_type(4))); \
            const v4i_ b0_ = __builtin_bit_cast(v4i_, Bt[n][0]), b1_ = __builtin_bit_cast(v4i_, Bt[n][1]), a0_ = __builtin_bit_cast(v4i_, At[m][0]), a1_ = __builtin_bit_cast(v4i_, At[m][1]); \
            const v8i_ bb_ = __builtin_shufflevector(b0_, b1_, 0, 1, 2, 3, 4, 5, 6, 7), aa_ = __builtin_shufflevector(a0_, a1_, 0, 1, 2, 3, 4, 5, 6, 7); \
            asm volatile("v_mfma_scale_f32_16x16x128_f8f6f4 %0, %1, %2, %0, %3, %3 op_sel_hi:[0,0,0]" : "+v"(acc[ai][bj][m][n]) : "v"(bb_), "v"(aa_), "v"(f8_scale_)); } \
        else { _Pragma("unroll") for (int k = 0; k < 2; ++k) acc[ai][bj][m][n] = __builtin_amdgcn_mfma_f32_16x16x32_bf16(Bt[n][k], At[m][k], acc[ai][bj][m][n], 0, 0, 0); } } \
        __builtin_amdgcn_s_setprio(0); } while (0)
#define PG8_WAIT_V(n) asm volatile("s_waitcnt vmcnt(" #n ")" ::: "memory")
#define PG8_WAIT_L(n) asm volatile("s_waitcnt lgkmcnt(" #n ")" ::: "memory")
#define PG8_BAR __builtin_amdgcn_s_barrier()
#define PG8_SCHED __builtin_amdgcn_sched_barrier(0)
    int f8_scale_ = 0x7f7f7f7f; (void)f8_scale_;
    Unit cur, nxt; int ui = 0;
    if (!S.next(0, cur)) return;
    f32x4 acc[2][2][4][2];
#pragma unroll
    for (int a = 0; a < 2; ++a)
#pragma unroll
        for (int b = 0; b < 2; ++b)
#pragma unroll
            for (int m = 0; m < 4; ++m)
#pragma unroll
                for (int n = 0; n < 2; ++n) acc[a][b][m][n] = (f32x4){0.f, 0.f, 0.f, 0.f};
    bf16x8 At[4][2], B0[2][2], B1[2][2];
    const char* cA = (const char*)g.A + (size_t)cur.pm * tstep; const char* cB = (const char*)g.Bt + (size_t)cur.pn * tstep;
    S.a_ready(cur);
    if constexpr (SP2) {
        PG8_STAGE(PG8_SB(0, 0), cB, voffB); PG8_STAGE(PG8_SB(0, 1), cB + hstep, voffB); PG8_STAGE(PG8_SA(0, 0), cA, voffA); PG8_STAGE(PG8_SA(0, 1), cA + hstep, voffA);
        if (wr == 1) PG8_BAR;
        PG8_WAIT_V(2); PG8_BAR;
        PG8_STAGE(PG8_SB(1, 0), cB + kstep, voffB); PG8_STAGE(PG8_SA(1, 0), cA + kstep, voffA); PG8_STAGE(PG8_SB(1, 1), cB + hstep + kstep, voffB);
        PG8_WAIT_V(6); PG8_BAR;
    } else {
        PG8_STAGE(PG8_SB(0, 0), cB, voffB); PG8_STAGE(PG8_SA(0, 0), cA, voffA); PG8_STAGE(PG8_SB(0, 1), cB + hstep, voffB); PG8_STAGE(PG8_SA(0, 1), cA + hstep, voffA);
        if (wr == 1) PG8_BAR;
        PG8_WAIT_V(4); PG8_BAR;
        PG8_STAGE(PG8_SB(1, 0), cB + kstep, voffB); PG8_STAGE(PG8_SA(1, 0), cA + kstep, voffA); PG8_STAGE(PG8_SB(1, 1), cB + hstep + kstep, voffB);
        PG8_WAIT_V(6); PG8_BAR;
    }
    for (;;) {
        const bool has_next = S.next(ui + 1, nxt);
        const char* nA = has_next ? (const char*)g.A + (size_t)nxt.pm * tstep : cA; const char* nB = has_next ? (const char*)g.Bt + (size_t)nxt.pn * tstep : cB;
#pragma unroll 1
        for (int t = 0; t < nt; t += 2) {
            const bool last = (t == nt - 2);
            const char* a1 = cA + (size_t)(t + 1) * kstep;
            const char* a2 = last ? nA : cA + (size_t)(t + 2) * kstep; const char* b2 = last ? nB : cB + (size_t)(t + 2) * kstep;
            const char* a3 = a2 + kstep; const char* b3 = b2 + kstep;
            if (last && has_next) S.a_ready(nxt);
            if constexpr (SP2) {
            PG8_LDB(B0, 0, 0); PG8_LDB(B1, 0, 1); PG8_SCHED; PG8_LDA(At, 0, 0); PG8_STAGE(PG8_SA(1, 1), a1 + hstep, voffA);
            PG8_WAIT_V(8); PG8_WAIT_L(0); PG8_BAR; PG8_MMA(0, 0, At, B0); PG8_MMA(0, 1, At, B1); PG8_BAR; PG8_SCHED;
            PG8_LDA(At, 0, 1); PG8_STAGE(PG8_SB(0, 0), b2, voffB); PG8_STAGE(PG8_SB(0, 1), b2 + hstep, voffB); PG8_STAGE(PG8_SA(0, 0), a2, voffA);
            PG8_WAIT_V(8); PG8_WAIT_L(0); PG8_BAR; PG8_MMA(1, 0, At, B0); PG8_MMA(1, 1, At, B1); PG8_BAR; PG8_SCHED;
            PG8_LDB(B0, 1, 0); PG8_LDB(B1, 1, 1); PG8_SCHED; PG8_LDA(At, 1, 0); PG8_STAGE(PG8_SA(0, 1), a2 + hstep, voffA);
            PG8_WAIT_V(8); PG8_WAIT_L(0); PG8_BAR; PG8_MMA(0, 0, At, B0); PG8_MMA(0, 1, At, B1); PG8_BAR; PG8_SCHED;
            PG8_LDA(At, 1, 1); PG8_STAGE(PG8_SB(1, 0), b3, voffB); PG8_STAGE(PG8_SB(1, 1), b3 + hstep, voffB); PG8_STAGE(PG8_SA(1, 0), a3, voffA);
            PG8_WAIT_V(8); PG8_WAIT_L(0); PG8_BAR; PG8_MMA(1, 0, At, B0); PG8_MMA(1, 1, At, B1); PG8_BAR; PG8_SCHED;
            } else {
            PG8_LDB(B0, 0, 0); PG8_SCHED; PG8_LDA(At, 0, 0); PG8_STAGE(PG8_SA(1, 1), a1 + hstep, voffA);
            PG8_WAIT_L(8); PG8_BAR; PG8_WAIT_L(0); PG8_MMA(0, 0, At, B0); PG8_BAR; PG8_SCHED;
            PG8_LDB(B1, 0, 1); PG8_STAGE(PG8_SB(0, 0), b2, voffB);
            PG8_BAR; PG8_WAIT_L(0); PG8_MMA(0, 1, At, B1); PG8_BAR;
            PG8_LDA(At, 0, 1); PG8_STAGE(PG8_SA(0, 0), a2, voffA);
            PG8_BAR; PG8_WAIT_L(0); PG8_MMA(1, 0, At, B0); PG8_BAR; PG8_SCHED;
            PG8_STAGE(PG8_SB(0, 1), b2 + hstep, voffB);
            PG8_WAIT_V(6); PG8_BAR; PG8_MMA(1, 1, At, B1); PG8_BAR;
            PG8_LDB(B0, 1, 0); PG8_SCHED; PG8_LDA(At, 1, 0); PG8_STAGE(PG8_SA(0, 1), a2 + hstep, voffA);
            PG8_WAIT_L(8); PG8_BAR; PG8_WAIT_L(0); PG8_MMA(0, 0, At, B0); PG8_BAR; PG8_SCHED;
            PG8_LDB(B1, 1, 1); PG8_STAGE(PG8_SB(1, 0), b3, voffB);
            PG8_BAR; PG8_WAIT_L(0); PG8_MMA(0, 1, At, B1); PG8_BAR;
            PG8_LDA(At, 1, 1); PG8_STAGE(PG8_SA(1, 0), a3, voffA);
            PG8_BAR; PG8_WAIT_L(0); PG8_MMA(1, 0, At, B0); PG8_BAR; PG8_SCHED;
            PG8_STAGE(PG8_SB(1, 1), b3 + hstep, voffB);
            PG8_WAIT_V(6); PG8_BAR; PG8_MMA(1, 1, At, B1); PG8_BAR;
            }
        }
        if constexpr (ALIGN_EPI) { if (wr == 0) PG8_BAR; }
        if constexpr (F8) asm volatile("s_nop 15\n\ts_nop 15" ::: "memory");
        bool keep_acc = false;
        if constexpr (Epi::INPLACE) { keep_acc = E.inplace(acc, cur, wr, wc, fr, fq); S.done(cur); }
        else if constexpr (!Epi::AFTER_DRAIN) { E(acc, cur, wr, wc, fr, fq); S.done(cur); }
        if (!has_next) break;
        if (!keep_acc)
#pragma unroll
        for (int a = 0; a < 2; ++a)
#pragma unroll
            for (int b = 0; b < 2; ++b)
#pragma unroll
                for (int m = 0; m < 4; ++m)
#pragma unroll
                    for (int n = 0; n < 2; ++n) acc[a][b][m][n] = (f32x4){0.f, 0.f, 0.f, 0.f};
        cur = nxt; cA = nA; cB = nB; ++ui;
        if constexpr (ALIGN_EPI) { if (wr == 1) PG8_BAR; }
    }
    PG8_WAIT_V(0);
    if constexpr (!ALIGN_EPI) { if (wr == 0) PG8_BAR; }
    PG8_BAR;
    if constexpr (Epi::AFTER_DRAIN) { E.fused(acc, cur, wr, wc, fr, fq, lds, wid, lane); S.done(cur); }
#undef PG8_SA
#undef PG8_SB
#undef PG8_STAGE
#undef PG8_LDA
#undef PG8_LDB
#undef PG8_MMA
#undef PG8_WAIT_V
#undef PG8_WAIT_L
#undef PG8_BAR
#undef PG8_SCHED
}
}
#define GAS __attribute__((address_space(1)))
#define LAS __attribute__((address_space(3)))
typedef unsigned short bf16;
typedef unsigned v4u __attribute__((ext_vector_type(4)));
typedef float f32x4 __attribute__((ext_vector_type(4)));
typedef short bf16x8 __attribute__((ext_vector_type(8)));
typedef GAS unsigned gu32;
typedef GAS unsigned long long gu64;
#define RLX_AGENT __ATOMIC_RELAXED, __HIP_MEMORY_SCOPE_AGENT
#define LDS_WAIT() asm volatile("s_waitcnt lgkmcnt(0)" ::: "memory")
#define VM_WAIT() asm volatile("s_waitcnt vmcnt(0)" ::: "memory")
__device__ __forceinline__ unsigned long long rt() { return __builtin_amdgcn_s_memrealtime(); }
__device__ __forceinline__ unsigned f2bf(float f) { unsigned u = __builtin_bit_cast(unsigned, f); return (u + 0x7fffu + ((u >> 16) & 1u)) >> 16; }
__device__ __forceinline__ unsigned pk2(float lo, float hi) { return pg8::cvt_pk_bf16(lo, hi); }

#define XB_TMO      128
#define XB_XCNT(j)  (256  + 64 * (j))
#define XB_XSUB(j)  (1280 + 64 * (j))
#define XB_XGEN(j)  (2304 + 64 * (j))
#define XB_TOP      3328
#define XB_TOPGEN   3392
#define XCD_BAR_WORDS 3456
#define XB_SPIN_CAP (1u << 18)

__device__ __forceinline__ unsigned xb_ld(unsigned* p)              { return __hip_atomic_load(p, __ATOMIC_RELAXED, __HIP_MEMORY_SCOPE_AGENT); }
__device__ __forceinline__ unsigned xb_add(unsigned* p, unsigned v) { return __hip_atomic_fetch_add(p, v, __ATOMIC_RELAXED, __HIP_MEMORY_SCOPE_AGENT); }
__device__ __forceinline__ unsigned xb_xcc_id() { return (unsigned)__builtin_amdgcn_s_getreg((3 << 11) | 20) & 0xFu; }
#define XB_SPIN(cond, bar) do { unsigned _sp = 0; while (cond) { __builtin_amdgcn_s_sleep(1); \
    if ((++_sp & 255u) == 0u) { if (xb_ld(&(bar)[XB_TMO])) break; if (_sp > XB_SPIN_CAP) { atomicAdd(&(bar)[XB_TMO], 1u); break; } } } } while (0)

struct XcdBarrier {
    unsigned* bar; unsigned x;
    volatile LAS unsigned* st;
};

__device__ __forceinline__ XcdBarrier xcd_barrier_post(unsigned* bar, volatile LAS unsigned* st) {
    XcdBarrier b; b.bar = bar; b.x = xb_xcc_id(); b.st = st;
    if (threadIdx.x == 0) (void)xb_add(&bar[XB_XCNT(b.x)], 1u);
    return b;
}
__device__ __forceinline__ void xcd_barrier_complete(unsigned* bar, unsigned x, unsigned& nloc, unsigned& nx) {
    const unsigned G = gridDim.x * gridDim.y * gridDim.z;
    unsigned sum, cnt, mine, sp = 0u;
    for (;;) {
        sum = 0u; cnt = 0u; mine = 0u;
#pragma unroll
        for (unsigned j = 0; j < 16; ++j) { const unsigned c = xb_ld(&bar[XB_XCNT(j)]); sum += c; cnt += (c > 0u) ? 1u : 0u; mine = (j == x) ? c : mine; }
        if (sum == G) break;
        __builtin_amdgcn_s_sleep(1);
        if ((++sp & 255u) == 0u) { if (xb_ld(&bar[XB_TMO])) break; if (sp > XB_SPIN_CAP) { atomicAdd(&bar[XB_TMO], 1u); break; } }
    }
    nloc = mine > 0u ? mine : 1u; nx = cnt > 0u ? cnt : 1u;
}

__device__ __forceinline__ void xcd_barrier(const XcdBarrier& b) {
    asm volatile("s_waitcnt vmcnt(0)" ::: "memory");
    __syncthreads();
    if (threadIdx.x == 0) {
        unsigned* bar = b.bar;
        __builtin_amdgcn_s_waitcnt(0);
        unsigned nloc = b.st[0], nx = b.st[1];
        if (nloc == 0u) { xcd_barrier_complete(bar, b.x, nloc, nx); b.st[0] = nloc; b.st[1] = nx; }
        const unsigned old = xb_add(&bar[XB_XSUB(b.x)], 1u);
        const unsigned gen = old / nloc;
        if (old + 1u == (gen + 1u) * nloc) {
            __builtin_amdgcn_fence(__ATOMIC_RELEASE, "agent");
            asm volatile("s_waitcnt vmcnt(0)" ::: "memory");
            const unsigned og = xb_add(&bar[XB_TOP], 1u);
            const unsigned tg = og / nx;
            if (og + 1u == (tg + 1u) * nx) xb_add(&bar[XB_TOPGEN], 1u);
            else XB_SPIN(xb_ld(&bar[XB_TOPGEN]) == tg, bar);
            __builtin_amdgcn_fence(__ATOMIC_ACQUIRE, "agent");
            xb_add(&bar[XB_XGEN(b.x)], 1u);
            asm volatile("s_waitcnt vmcnt(0)" ::: "memory");
        } else {
            XB_SPIN(xb_ld(&bar[XB_XGEN(b.x)]) == gen, bar);
            __builtin_amdgcn_fence(__ATOMIC_ACQUIRE, "agent");
            asm volatile("s_waitcnt vmcnt(0)" ::: "memory");
        }
    }
    __syncthreads();
}

typedef float f32x16 __attribute__((ext_vector_type(16)));
typedef short s16x4 __attribute__((ext_vector_type(4)));
typedef unsigned v2u __attribute__((ext_vector_type(2)));
#define MFMA32(a, b, c) __builtin_amdgcn_mfma_f32_32x32x16_bf16((a), (b), (c), 0, 0, 0)

constexpr int NWAVES = 8, NTHREADS = 512;
constexpr int D = 1024, NB = 32, SEQ = 2048, LC = 256, NTOK = NB * SEQ, NCTX = NB * LC, NROW = NTOK + NCTX;
constexpr int INC = 6912, QKVC = 2304, CINC = 1536, GATEC = 3072, DFF = 2816, NEXP = 8, DFFE = 3584, FCH = 1792;
constexpr float W13_SCALE = 32.f, W2_SCALE = 64.f, HID_SCALE = 4.f;
constexpr float LOG2E = 1.4426950408889634f, QSCALE = 0.125f * LOG2E, EPS = 1e-6f;
constexpr int PCAP = 32768 * 2 + 8 * 256;

constexpr size_t MiB = 1u << 20;
constexpr size_t WS_CTL = 0, CTL_ZERO_BYTES = 1 * MiB;
constexpr size_t WS_MODV = 1 * MiB;
constexpr size_t WS_ROPE = 3 * MiB;
constexpr size_t WS_ROUTE = 4 * MiB;
constexpr size_t WS_LIST = 5 * MiB;
constexpr size_t WS_INV = 7 * MiB;
constexpr size_t WS_GF = 8 * MiB;
constexpr size_t WS_GFC = 24 * MiB;
constexpr size_t WS_W = 26 * MiB;
constexpr size_t W_IN = WS_W;
constexpr size_t W_CB = W_IN + (size_t)2 * INC * D;
constexpr size_t W_BR = W_IN + (size_t)2 * INC * D * 2;
constexpr size_t W_OUT = W_BR + (size_t)2 * 3 * D * 512 * 2;
constexpr size_t W_F13 = W_OUT + (size_t)2 * D * D * 2;
constexpr size_t W_F2 = W_F13 + (size_t)2 * DFF * D * 2;
constexpr size_t W_END = W_F2 + (size_t)D * DFF * 2;
constexpr size_t WS_CTXRES = 80 * MiB;
constexpr size_t WS_XB = 112 * MiB;
constexpr size_t WS_BIG = 256 * MiB;
constexpr size_t BIG_CINT = WS_BIG;
constexpr size_t BIG_QKV = WS_BIG + 216 * MiB;
constexpr size_t BIG_GATE = WS_BIG + 72 * MiB;
constexpr size_t BIG_YCT = WS_BIG + 288 * MiB;
constexpr size_t BIG_HID = WS_BIG;
constexpr size_t BIG_RAW = WS_BIG;
constexpr size_t BIG_AS = WS_BIG;
constexpr size_t BIG_MH = WS_BIG + 68 * MiB;
constexpr size_t BIG_Y2S = WS_BIG + 300 * MiB;
constexpr size_t WS_Y3 = 796 * MiB;
constexpr size_t WM_13 = WS_Y3;
constexpr size_t WM_2 = WS_Y3 + 56 * MiB;
constexpr size_t WS_H8 = WS_Y3 + 144 * MiB;
constexpr size_t WS_END = 1012 * MiB;
static_assert(W_END <= WS_CTXRES && BIG_Y2S + (size_t)PCAP * D * 2 <= WS_Y3 && BIG_QKV + (size_t)NROW * QKVC * 2 <= WS_Y3 && BIG_GATE + (size_t)NROW * GATEC <= WS_Y3, "ws map");
static_assert(BIG_MH + (size_t)PCAP * DFFE <= BIG_Y2S && BIG_AS + (size_t)PCAP * D <= BIG_MH && WM_13 + (size_t)8 * 2 * DFFE * D <= WM_2 && WM_2 + (size_t)8 * D * DFFE <= WS_END, "ws map 2");

constexpr int CW_BAR = 4096;
constexpr int CW_CNT = 16384;

constexpr int LDS_BYTES = 150528, MISC_OFF = 147456;


struct Args {
    const float* in[31];
    float* out; unsigned char* ws;
    int ph_lo, ph_hi, sub_mask, pad;
};
enum { I_X = 0, I_C, I_CTX, I_CCTX, I_WMOD, I_BMOD, I_GMIXPRE, I_GMIXPOST, I_GFFNPRE, I_GFFNPOST, I_WIN, I_SINK, I_RPB, I_CONVW, I_CONVB, I_HW1, I_HB1, I_HW2, I_HB2, I_HW3,
       I_HFREQ, I_HBIAS, I_WBR, I_WOUT, I_FW1, I_FW3, I_FW2, I_ROUTER, I_MW1, I_MW3, I_MW2 };

struct Frame {
    LAS unsigned char* lds;
    int tid, lane, wave, vcu, G;
    unsigned char* ws;
    bf16* hb;
};

__device__ __forceinline__ float wave_sum(float v) {
#pragma unroll
    for (int o = 1; o < 64; o <<= 1) v += __shfl_xor(v, o);
    return v;
}
__device__ __forceinline__ float bf2f(bf16 b) { return __builtin_bit_cast(float, ((unsigned)b) << 16); }
__device__ __forceinline__ float silu_f(float x) { return x / (1.0f + __expf(-x)); }

__device__ __forceinline__ void transpose_item(const float* W, int N, bf16* WT, int Kp, int k0, int n0, int drow0, LAS float* scr, int lane) {
    { const int c4 = 4 * (lane & 7);
#pragma unroll
      for (int i = 0; i < 8; ++i) { const int kk = (lane >> 3) + 8 * i; const f32x4 v = *(const f32x4*)(W + (size_t)(k0 + kk) * N + n0 + c4); LAS float* d = scr + kk * 33 + c4; d[0] = v.x; d[1] = v.y; d[2] = v.z; d[3] = v.w; } }
    LDS_WAIT(); asm volatile("" ::: "memory");
    const int c = lane & 7;
#pragma unroll
    for (int j = 0; j < 4; ++j) { const int n = (lane >> 3) + 8 * j; const LAS float* s = scr + (8 * c) * 33 + n;
        v4u o; o.x = pk2(s[0 * 33], s[1 * 33]); o.y = pk2(s[2 * 33], s[3 * 33]); o.z = pk2(s[4 * 33], s[5 * 33]); o.w = pk2(s[6 * 33], s[7 * 33]);
        *(GAS v4u*)(WT + (size_t)(drow0 + n) * Kp + k0 + 8 * c) = o; }
    LDS_WAIT(); asm volatile("" ::: "memory");
}
__device__ __forceinline__ bool conv_job(int& r, const float* W, int K, int N, bf16* WT, int Kp, int rowoff, int mode, int which, LAS float* scr, int lane) {
    const int nblk = N / 32, items = (K / 64) * nblk;
    if (r >= items) { r -= items; return false; }
    const int kb = r / nblk, nb = r % nblk, n0 = 32 * nb;
    const int drow0 = mode ? rowoff + (n0 / 128) * 256 + which * 128 + (n0 % 128) : rowoff + n0;
    transpose_item(W, N, WT, Kp, 64 * kb, n0, drow0, scr, lane);
    return true;
}

__device__ __forceinline__ void transpose_item_f8(const float* W, int N, unsigned char* WT, int Kp, int k0, int n0, int drow0, float scale, LAS float* scr, int lane) {
    { const int c4 = 4 * (lane & 7);
#pragma unroll
      for (int i = 0; i < 8; ++i) { const int kk = (lane >> 3) + 8 * i; const f32x4 v = *(const f32x4*)(W + (size_t)(k0 + kk) * N + n0 + c4) * scale; LAS float* d = scr + kk * 33 + c4; d[0] = v.x; d[1] = v.y; d[2] = v.z; d[3] = v.w; } }
    LDS_WAIT(); asm volatile("" ::: "memory");
    const int c = lane & 7;
#pragma unroll
    for (int j = 0; j < 4; ++j) { const int n = (lane >> 3) + 8 * j; const LAS float* s = scr + (8 * c) * 33 + n;
        v2u o; o.x = pg8::pack_fp8x4(s[0 * 33], s[1 * 33], s[2 * 33], s[3 * 33]); o.y = pg8::pack_fp8x4(s[4 * 33], s[5 * 33], s[6 * 33], s[7 * 33]);
        *(GAS v2u*)(WT + (size_t)(drow0 + n) * Kp + k0 + 8 * c) = o; }
    LDS_WAIT(); asm volatile("" ::: "memory");
}
__device__ __forceinline__ bool conv_job_f8(int& r, const float* W, int K, int N, unsigned char* WT, int Kp, int mode, int which, float scale, LAS float* scr, int lane) {
    const int nblk = N / 32, items = (K / 64) * nblk;
    if (r >= items) { r -= items; return false; }
    const int kb = r / nblk, nb = r % nblk, n0 = 32 * nb;
    const int drow0 = mode ? (n0 / 128) * 256 + which * 128 + (n0 % 128) : n0;
    transpose_item_f8(W, N, WT, Kp, 64 * kb, n0, drow0, scale, scr, lane);
    return true;
}

__device__ __forceinline__ void ld_row_f32(const float* p, int lane, f32x4 (&v)[4]) {
    const GAS f32x4* q = (const GAS f32x4*)p + lane;
#pragma unroll
    for (int j = 0; j < 4; ++j) v[j] = q[64 * j];
}
__device__ __forceinline__ void st_row_f32(float* p, int lane, const f32x4 (&v)[4]) {
    GAS f32x4* q = (GAS f32x4*)p + lane;
#pragma unroll
    for (int j = 0; j < 4; ++j) q[64 * j] = v[j];
}
__device__ __forceinline__ void ld_row_bf16(const bf16* p, int lane, f32x4 (&v)[4]) {
    const GAS v2u* q = (const GAS v2u*)p + lane;
#pragma unroll
    for (int j = 0; j < 4; ++j) { const v2u w = q[64 * j]; v[j] = (f32x4){pg8::bf_lo(w.x), pg8::bf_hi(w.x), pg8::bf_lo(w.y), pg8::bf_hi(w.y)}; }
}
__device__ __forceinline__ void ld_row_f32_nt(const float* p, int lane, f32x4 (&v)[4]) {
    const GAS f32x4* q = (const GAS f32x4*)p + lane;
#pragma unroll
    for (int j = 0; j < 4; ++j) v[j] = __builtin_nontemporal_load(q + 64 * j);
}
__device__ __forceinline__ void st_row_f32_nt(float* p, int lane, const f32x4 (&v)[4]) {
    GAS f32x4* q = (GAS f32x4*)p + lane;
#pragma unroll
    for (int j = 0; j < 4; ++j) __builtin_nontemporal_store(v[j], q + 64 * j);
}
__device__ __forceinline__ void ld_raw_bf16_nt(const bf16* p, int lane, v2u (&v)[4]) {
    const GAS v2u* q = (const GAS v2u*)p + lane;
#pragma unroll
    for (int j = 0; j < 4; ++j) v[j] = __builtin_nontemporal_load(q + 64 * j);
}
__device__ __forceinline__ void ld_raw_bf16(const bf16* p, int lane, v2u (&v)[4]) {
    const GAS v2u* q = (const GAS v2u*)p + lane;
#pragma unroll
    for (int j = 0; j < 4; ++j) v[j] = q[64 * j];
}
__device__ __forceinline__ f32x4 cvt_raw_bf16(v2u w) { return (f32x4){pg8::bf_lo(w.x), pg8::bf_hi(w.x), pg8::bf_lo(w.y), pg8::bf_hi(w.y)}; }
__device__ __forceinline__ void st_row_bf16(bf16* p, int lane, const f32x4 (&v)[4]) {
    GAS v2u* q = (GAS v2u*)p + lane;
#pragma unroll
    for (int j = 0; j < 4; ++j) { v2u w; w.x = pk2(v[j].x, v[j].y); w.y = pk2(v[j].z, v[j].w); q[64 * j] = w; }
}
__device__ __forceinline__ float row_rms_scale(const f32x4 (&v)[4]) {
    float s = 0.f;
#pragma unroll
    for (int j = 0; j < 4; ++j) s += (v[j].x * v[j].x + v[j].y * v[j].y) + (v[j].z * v[j].z + v[j].w * v[j].w);
    return __builtin_amdgcn_rsqf(wave_sum(s) * (1.0f / D) + EPS);
}
__device__ __forceinline__ void norm_mod(const f32x4 (&x)[4], const float* g, const float* sc, const float* sh, int lane, f32x4 (&h)[4]) {
    const float rs = row_rms_scale(x);
    f32x4 gv[4], scv[4], shv[4]; ld_row_f32(g, lane, gv); ld_row_f32(sc, lane, scv); ld_row_f32(sh, lane, shv);
#pragma unroll
    for (int j = 0; j < 4; ++j) h[j] = (x[j] * rs) * gv[j] * (scv[j] + 1.0f) + shv[j];
}
__device__ __forceinline__ void resid_update(f32x4 (&x)[4], const f32x4 (&y)[4], const float* g, const float* gt, int lane) {
    const float rs = row_rms_scale(y);
    f32x4 gv[4], gtv[4]; ld_row_f32(g, lane, gv); ld_row_f32(gt, lane, gtv);
#pragma unroll
    for (int j = 0; j < 4; ++j) x[j] = x[j] + gtv[j] * ((y[j] * rs) * gv[j]);
}
__device__ __forceinline__ const float* modv(const Frame& F, int l, int row, int part) {
    const int r = row < NTOK ? (row >> 11) : 32;
    return (const float*)(F.ws + WS_MODV) + ((size_t)l * 33 + r) * 6144 + part * 1024;
}

__device__ __forceinline__ void p0_prologue(Frame& F, const Args& a) {
    const int gw = F.vcu * NWAVES + F.wave, NGW = F.G * NWAVES;
    if (F.vcu < 192) {
        LAS float* sl = (LAS float*)F.lds;
        for (int i = F.tid; i < 33 * 1024; i += NTHREADS) { const int r = i >> 10, k = i & 1023; const float cv = r < 32 ? a.in[I_C][r * 1024 + k] : a.in[I_CCTX][k]; sl[k * 33 + r] = silu_f(cv); }
        __syncthreads();
        const int col = F.vcu * 64 + F.lane, l = col / 6144, n = col % 6144, k0 = F.wave * 128;
        const float* w = a.in[I_WMOD] + ((size_t)l * 1024 + k0) * 6144 + n;
        float acc[33];
#pragma unroll
        for (int r = 0; r < 33; ++r) acc[r] = 0.f;
#pragma unroll 4
        for (int k = 0; k < 128; ++k) { const float wv = w[(size_t)k * 6144]; const LAS float* sr = sl + (k0 + k) * 33;
#pragma unroll
            for (int r = 0; r < 33; ++r) acc[r] += sr[r] * wv; }
        __syncthreads();
#pragma unroll
        for (int r = 0; r < 33; ++r) sl[(F.wave * 33 + r) * 64 + F.lane] = acc[r];
        __syncthreads();
        const float* bmod = a.in[I_BMOD]; float* mo = (float*)(F.ws + WS_MODV);
        for (int o = F.tid; o < 33 * 64; o += NTHREADS) { const int r = o >> 6, j = o & 63; float s = 0.f;
#pragma unroll
            for (int wv = 0; wv < 8; ++wv) s += sl[(wv * 33 + r) * 64 + j];
            const int cc = F.vcu * 64 + j, ll = cc / 6144, nn = cc % 6144; mo[((size_t)ll * 33 + r) * 6144 + nn] = s + bmod[ll * 6144 + nn]; }
        __syncthreads();
    }
    if (F.vcu == 200) {
        float* rp = (float*)(F.ws + WS_ROPE);
        for (int i = F.tid; i < 1024; i += NTHREADS) { const int pos = i >> 4, k = i & 15; const float inv = powf(10000.0f, -(float)k / 16.0f); const float ang = (float)pos * inv; rp[i] = cosf(ang); rp[1024 + i] = sinf(ang); }
    }
    for (int it = F.vcu; it < 512; it += F.G) {
        const int lv = it >> 8, l = lv ? 0 : ((it >> 7) & 1), L = lv ? LC : SEQ, pos0 = lv ? (it & 255) : 16 * (it & 127), npos = lv ? 1 : 16;
        LAS float* z = (LAS float*)F.lds; LAS float* h1 = z + 16 * 33; LAS float* h2 = h1 + 16 * 64;
        __syncthreads();
        for (int i = F.tid; i < 16 * 33; i += NTHREADS) { const int p = i / 33, k = i % 33; const int pos = pos0 + p; float v;
            const float om = 6.283185307179586f * (float)pos / (float)L;
            if (k == 0) v = (float)pos / (float)(L - 1);
            else { const int m = (k - 1) & 15; const float f = 1e-4f + (15.0f - 1e-4f) * (float)m / 15.0f; v = (k <= 16) ? cosf(f * om) : -sinf(f * om); }
            z[i] = v; }
        __syncthreads();
        const float* w1 = a.in[I_HW1] + l * 33 * 64; const float* b1 = a.in[I_HB1] + l * 64; const float* w2 = a.in[I_HW2] + l * 64 * 64; const float* b2 = a.in[I_HB2] + l * 64;
        const float* fr = a.in[I_HFREQ] + l * 64; const float* w3 = a.in[I_HW3] + (size_t)l * 64 * 2048;
        for (int o = F.tid; o < 1024; o += NTHREADS) { const int p = o >> 6, j = o & 63; float s = b1[j];
            for (int k = 0; k < 33; ++k) s += z[p * 33 + k] * w1[k * 64 + j];
            h1[o] = sinf(fr[j] * s); }
        __syncthreads();
        for (int o = F.tid; o < 1024; o += NTHREADS) { const int p = o >> 6, j = o & 63; float s = b2[j];
            for (int k = 0; k < 64; ++k) s += h1[p * 64 + k] * w2[k * 64 + j];
            h2[o] = sinf(fr[j] * s); }
        __syncthreads();
        float* raw = (float*)(F.ws + BIG_RAW) + (size_t)l * (2048 * (SEQ + LC)) + (lv ? (size_t)2048 * SEQ : 0);
        {
            const int col0 = 4 * F.tid;
            float acc[4][16];
#pragma unroll
            for (int c4 = 0; c4 < 4; ++c4)
#pragma unroll
                for (int p = 0; p < 16; ++p) acc[c4][p] = 0.f;
#pragma unroll 4
            for (int k = 0; k < 64; ++k) { const f32x4 wv = *(const f32x4*)(w3 + k * 2048 + col0);
#pragma unroll
                for (int p = 0; p < 16; ++p) { const float hv = h2[p * 64 + k]; acc[0][p] += hv * wv.x; acc[1][p] += hv * wv.y; acc[2][p] += hv * wv.z; acc[3][p] += hv * wv.w; } }
            const float da = -3.0701134573253945f, db = -15.350567286626973f;
#pragma unroll
            for (int c4 = 0; c4 < 4; ++c4) { const int col = col0 + c4, cch = col & 511;
                const float delta = fabsf(da + (db - da) * (float)cch / 511.0f);
#pragma unroll
                for (int p = 0; p < 16; ++p) if (p < npos) { const float t = (float)(pos0 + p) / (float)(L - 1); raw[(size_t)col * L + pos0 + p] = acc[c4][p] * __expf(-t * delta); } }
        }
    }
    __syncthreads();
    LAS float* scr = (LAS float*)(F.lds + F.wave * 16384);
    constexpr int PER_LAYER = 16 * 216 + 16 * 48 + 3 * 256 + 512, NITEMS = 2 * PER_LAYER + 3 * 1408;
    for (int it = gw; it < NITEMS; it += NGW) {
        int r = it;
        bool dn = false;
#pragma unroll 1
        for (int l = 0; l < 2; ++l) {
            if (!dn) dn = conv_job_f8(r, a.in[I_WIN] + (size_t)l * D * INC, D, INC, F.ws + W_IN + (size_t)l * INC * D, D, 0, 0, W13_SCALE, scr, F.lane);
            if (!dn) { const int items = 16 * 48;
                if (r < items) { const int kb = r / 48, nb = r % 48; transpose_item(a.in[I_WIN] + (size_t)l * D * INC + QKVC, INC, (bf16*)(F.ws + W_CB) + (size_t)l * CINC * D, D, 64 * kb, 32 * nb, 32 * nb, scr, F.lane); dn = true; } else r -= items; }
#pragma unroll 1
            for (int br = 0; br < 3; ++br)
                if (!dn) dn = conv_job(r, a.in[I_WBR] + (size_t)(l * 3 + br) * 512 * D, 512, D, (bf16*)(F.ws + W_BR) + (size_t)(l * 3 + br) * D * 512, 512, 0, 0, 0, scr, F.lane);
            if (!dn) dn = conv_job(r, a.in[I_WOUT] + (size_t)l * D * D, D, D, (bf16*)(F.ws + W_OUT) + (size_t)l * D * D, D, 0, 0, 0, scr, F.lane);
        }
        if (!dn) dn = conv_job(r, a.in[I_FW1], D, DFF, (bf16*)(F.ws + W_F13), D, 0, 1, 0, scr, F.lane);
        if (!dn) dn = conv_job(r, a.in[I_FW3], D, DFF, (bf16*)(F.ws + W_F13), D, 0, 1, 1, scr, F.lane);
        if (!dn) dn = conv_job(r, a.in[I_FW2], DFF, D, (bf16*)(F.ws + W_F2), DFF, 0, 0, 0, scr, F.lane);
    }
}

__device__ __forceinline__ void p1_phase(Frame& F, const Args& a) {
    const int gw = F.vcu * NWAVES + F.wave, NGW = F.G * NWAVES;
    for (int u = gw; u < 2 * 2 * 1024; u += NGW) {
        const int l = u >> 11, lv = (u >> 10) & 1, o = (u >> 9) & 1, c = u & 511, L = lv ? LC : SEQ;
        if (l == 1 && lv == 1) continue;
        const float* raw = (const float*)(F.ws + BIG_RAW) + (size_t)l * (2048 * (SEQ + LC)) + (lv ? (size_t)2048 * SEQ : 0);
        const float* rf = raw + (size_t)(o * 512 + c) * L; const float* rb = raw + (size_t)(1024 + o * 512 + c) * L;
        float sf = 0.f, sb = 0.f;
        for (int t = F.lane; t < L; t += 64) { const float x = rf[t], y = rb[t]; sf += x * x; sb += y * y; }
        const float nf = 1.0f / sqrtf(wave_sum(sf) + EPS), nb = 1.0f / sqrtf(wave_sum(sb) + EPS);
        bf16* g = lv ? (bf16*)(F.ws + WS_GFC) + ((size_t)(l * 2 + o) * 512 + c) * (2 * LC) : (bf16*)(F.ws + WS_GF) + ((size_t)(l * 2 + o) * 512 + c) * (2 * SEQ);
        for (int i = F.lane; i < 2 * L; i += 64) { const int d = i - L; float v;
            if (i == 0) v = 0.f; else if (d > 0) v = rf[d] * nf; else if (d < 0) v = rb[-d] * nb; else v = rf[0] * nf + rb[0] * nb;
            g[i] = (bf16)f2bf(v); }
    }
}

constexpr float ATT_THR = 8.0f;
constexpr int ATT_KP = 144, ATT_VP = 136;
constexpr int ATT_K_OFF = 0, ATT_V_OFF = 64 * ATT_KP, ATT_BUF = 17920, ATT_RPB_OFF = 36864;
constexpr int ATT_T0_BYTES = 15 * 128 * 4, ATT_E_OFF = ATT_RPB_OFF + ATT_T0_BYTES, ATT_TBL_FLOATS = 15 * 128 + 15 * 15 * 64;
__device__ __forceinline__ int crow(int reg, int h) { return (reg & 3) + 8 * (reg >> 2) + 4 * h; }
__device__ __forceinline__ int rs_of(int r) { const int v = r - 4; return v < 0 ? 0 : (v > 24 ? 24 : v); }
__device__ __forceinline__ unsigned cvtpk(float lo, float hi) { return pk2(lo, hi); }

template <int MODE, int SUB>
__device__ __forceinline__ void att_tile(LAS unsigned char* lds, int boff, const bf16x8 (&qf)[4], f32x16& negm, f32x16& O0, f32x16& O1, float& m_run, float& l_run,
                                         bool is_local, bool edge_mask, int kbase, int qt, int kr, int gr, int tb_base, int tb_pitch, int r, int h) {
#define A0(i) (SUB != 2 || (i) >= 12)
#define A1(i) (SUB != 1 || (i) < 4)
    f32x16 s0 = negm, s1 = negm;
#pragma unroll
    for (int s = 0; s < 4; ++s) {
        const bf16x8 k0 = *(const LAS bf16x8*)(lds + boff + ATT_K_OFF + r * ATT_KP + (16 * s + 8 * h) * 2);
        const bf16x8 k1 = *(const LAS bf16x8*)(lds + boff + ATT_K_OFF + (32 + r) * ATT_KP + (16 * s + 8 * h) * 2);
        s0 = MFMA32(k0, qf[s], s0); s1 = MFMA32(k1, qf[s], s1);
    }
    if (MODE == 0 && edge_mask) {
#pragma unroll
        for (int i = 0; i < 16; ++i) { const int j0 = kbase + crow(i, h), d0 = qt - j0, d1 = d0 - 32;
            if (d0 > 128 || d0 < -128) s0[i] = -1e30f;
            if (d1 > 128 || d1 < -128) s1[i] = -1e30f; }
    }
    if (MODE == 1 && is_local) {
        const LAS float* tb = (const LAS float*)(lds + tb_base + (kr - gr + 7) * tb_pitch);
        float b0[16], b1[16];
#pragma unroll
        for (int i = 0; i < 16; ++i) { const int c = (i & 3) + 8 * (i >> 2); if (A0(i)) b0[i] = tb[c]; if (A1(i)) b1[i] = tb[c + 32]; }
#pragma unroll
        for (int i = 0; i < 16; ++i) { if (A0(i)) s0[i] += b0[i]; if (A1(i)) s1[i] += b1[i]; }
    }
    float mx = -1e30f;
#pragma unroll
    for (int i = 0; i < 16; ++i) { if (A0(i)) mx = fmaxf(mx, s0[i]); if (A1(i)) mx = fmaxf(mx, s1[i]); }
    mx = fmaxf(mx, __shfl_xor(mx, 32));
    if (!__all(mx <= ATT_THR)) {
        const float delta = fmaxf(mx, 0.f), alpha = __builtin_amdgcn_exp2f(-delta);
        m_run += delta; l_run *= alpha;
#pragma unroll
        for (int i = 0; i < 16; ++i) { O0[i] *= alpha; O1[i] *= alpha; s0[i] -= delta; s1[i] -= delta; negm[i] = -m_run; }
    }
    float ls = 0.f;
#pragma unroll
    for (int i = 0; i < 16; ++i) { if (A0(i)) { s0[i] = __builtin_amdgcn_exp2f(s0[i]); ls += s0[i]; } else s0[i] = 0.f;
                                   if (A1(i)) { s1[i] = __builtin_amdgcn_exp2f(s1[i]); ls += s1[i]; } else s1[i] = 0.f; }
    l_run += ls;
    bf16x8 pf[2][2];
    { v4u t;
      t.x = cvtpk(s0[0], s0[1]); t.y = cvtpk(s0[2], s0[3]); t.z = cvtpk(s0[4], s0[5]); t.w = cvtpk(s0[6], s0[7]); pf[0][0] = __builtin_bit_cast(bf16x8, t);
      t.x = cvtpk(s0[8], s0[9]); t.y = cvtpk(s0[10], s0[11]); t.z = cvtpk(s0[12], s0[13]); t.w = cvtpk(s0[14], s0[15]); pf[0][1] = __builtin_bit_cast(bf16x8, t);
      t.x = cvtpk(s1[0], s1[1]); t.y = cvtpk(s1[2], s1[3]); t.z = cvtpk(s1[4], s1[5]); t.w = cvtpk(s1[6], s1[7]); pf[1][0] = __builtin_bit_cast(bf16x8, t);
      t.x = cvtpk(s1[8], s1[9]); t.y = cvtpk(s1[10], s1[11]); t.z = cvtpk(s1[12], s1[13]); t.w = cvtpk(s1[14], s1[15]); pf[1][1] = __builtin_bit_cast(bf16x8, t); }
#pragma unroll
    for (int i = 0; i < 2; ++i)
#pragma unroll
        for (int sp = 0; sp < 2; ++sp) {
            if ((SUB == 1 && i == 1 && sp == 1) || (SUB == 2 && i == 0 && sp == 0)) continue;
            const int koff = (32 * i + 16 * sp + 4 * h) * 2;
            const v2u a0 = *(const LAS v2u*)(lds + boff + ATT_V_OFF + r * ATT_VP + koff), a1 = *(const LAS v2u*)(lds + boff + ATT_V_OFF + r * ATT_VP + koff + 16);
            const v2u c0 = *(const LAS v2u*)(lds + boff + ATT_V_OFF + (32 + r) * ATT_VP + koff), c1 = *(const LAS v2u*)(lds + boff + ATT_V_OFF + (32 + r) * ATT_VP + koff + 16);
            const v4u va = (v4u){a0.x, a0.y, a1.x, a1.y}, vc = (v4u){c0.x, c0.y, c1.x, c1.y};
            O0 = MFMA32(__builtin_bit_cast(bf16x8, va), pf[i][sp], O0);
            O1 = MFMA32(__builtin_bit_cast(bf16x8, vc), pf[i][sp], O1);
        }
#undef A0
#undef A1
}

struct AttPre { v4u k, v; int valid; };
template <int MODE>
__device__ __forceinline__ void att_start(int u, int w, int r, int& qrow, int& qcol, int& kcol, int& vcol, int& trow0) {
    int b, head, kvh, q0 = 0, R = 0;
    if (MODE == 0) { b = u >> 6; kvh = (u >> 5) & 1; q0 = (u & 31) * 64; head = 4 * kvh + (w >> 1); }
    else if (MODE == 1) { b = u >> 6; head = (u >> 3) & 7; kvh = head; R = u & 7; }
    else if (MODE == 2) { b = u >> 3; kvh = (u >> 2) & 1; q0 = (u & 3) * 64; head = 4 * kvh + (w >> 1); }
    else { b = u >> 3; head = u & 7; kvh = head; }
    if (MODE == 0) qrow = b * SEQ + q0 + 32 * (w & 1) + r;
    else if (MODE == 1) qrow = b * SEQ + (4 * R + (w >> 1)) * 64 + 32 * (w & 1) + r;
    else if (MODE == 2) qrow = NTOK + b * LC + q0 + 32 * (w & 1) + r;
    else qrow = NTOK + b * LC + 32 * w + r;
    qcol = (MODE == 0 || MODE == 2) ? 1280 + head * 64 : 1792 + head * 64;
    kcol = (MODE == 0 || MODE == 2) ? kvh * 64 : 256 + head * 64;
    vcol = (MODE == 0 || MODE == 2) ? 128 + kvh * 64 : 768 + head * 64;
    if (MODE == 0) { const int lo = q0 < 128 ? (128 - q0) / 64 : 0; trow0 = b * SEQ + q0 - 128 + 64 * lo; }
    else if (MODE == 1) trow0 = b * SEQ + rs_of(4 * R) * 64;
    else trow0 = NTOK + b * LC;
}
template <int MODE>
__device__ __forceinline__ void attn_unit(Frame& F, int u, int u_next, const bf16* __restrict__ QKV, bf16* __restrict__ Yo, const float* sink, const float* rpb, AttPre& P, int& tbl_head, int var = 0) {
    const int w = F.wave, lane = F.lane, r = lane & 31, h = lane >> 5;
    LAS unsigned char* lds = F.lds;
    int b, head, kvh, q0 = 0, R = 0;
    if (MODE == 0) { b = u >> 6; kvh = (u >> 5) & 1; q0 = (u & 31) * 64; head = 4 * kvh + (w >> 1); }
    else if (MODE == 1) { b = u >> 6; head = (u >> 3) & 7; kvh = head; R = u & 7; }
    else if (MODE == 2) { b = u >> 3; kvh = (u >> 2) & 1; q0 = (u & 3) * 64; head = 4 * kvh + (w >> 1); }
    else { b = u >> 3; head = u & 7; kvh = head; }
    int qt, qrow, gr = 0, qc = 0;
    if (MODE == 0) { qt = q0 + 32 * (w & 1) + r; qrow = b * SEQ + qt; }
    else if (MODE == 1) { gr = 4 * R + (w >> 1); qc = 32 * (w & 1) + r; qt = gr * 64 + qc; qrow = b * SEQ + qt; }
    else if (MODE == 2) { qt = q0 + 32 * (w & 1) + r; qrow = NTOK + b * LC + qt; }
    else { qt = 32 * w + r; qrow = NTOK + b * LC + qt; }
    const int qcol = (MODE == 0 || MODE == 2) ? 1280 + head * 64 : 1792 + head * 64;
    const int kcol = (MODE == 0 || MODE == 2) ? kvh * 64 : 256 + head * 64;
    const int vcol = (MODE == 0 || MODE == 2) ? 128 + kvh * 64 : 768 + head * 64;
    bf16x8 qf[4];
#pragma unroll
    for (int s = 0; s < 4; ++s) qf[s] = *(const bf16x8*)(QKV + (size_t)qrow * QKVC + qcol + 16 * s + 8 * h);
    f32x16 O0, O1;
#pragma unroll
    for (int i = 0; i < 16; ++i) { O0[i] = 0.f; O1[i] = 0.f; }
    float m_run, l_run;
    if (MODE == 0 || MODE == 2) { m_run = sink[head] * LOG2E; l_run = (h == 0) ? 1.0f : 0.0f; } else { m_run = 0.f; l_run = 0.f; }
    f32x16 negm;
#pragma unroll
    for (int i = 0; i < 16; ++i) negm[i] = -m_run;
    int lo = 0, ntl = 0, kr_lo = 0;
    if (MODE == 0) { lo = q0 < 128 ? (128 - q0) / 64 : 0; const int hi = (SEQ - q0 + 128) / 64 < 5 ? (SEQ - q0 + 128) / 64 : 5; ntl = hi - lo; }
    if (MODE == 1) { kr_lo = rs_of(4 * R); ntl = rs_of(4 * R + 3) + 8 - kr_lo; }
    const int my_rs = rs_of(gr), my_cs = (qc - 8) < 0 ? 0 : ((qc - 8) > 48 ? 48 : (qc - 8));
    const int ntiles = ntl + 4;
    int tb_base = 0, tb_pitch = 0;
    if (MODE == 1) { const bool edge = qc < 8 || qc > 56; const int ev = qc < 8 ? qc : qc - 49;
        tb_base = edge ? ATT_E_OFF + ev * (15 * 256) + 16 * h : ATT_RPB_OFF + 4 * (63 - qc + 4 * h); tb_pitch = edge ? 256 : 512; }
    const int skey = F.tid >> 3, sch = F.tid & 7, vkey = F.tid & 63, vch = F.tid >> 6;
#define ATT_TROW(tt) ((tt) < ntl ? (MODE == 0 ? b * SEQ + q0 - 128 + 64 * (lo + (tt)) : b * SEQ + (kr_lo + (tt)) * 64) : NTOK + b * LC + 64 * ((tt) - ntl))
#define ATT_LOAD(tt) do { const int tr_ = ATT_TROW(tt); kreg = *(const v4u*)(QKV + (size_t)(tr_ + skey) * QKVC + kcol + 8 * sch); vreg = *(const v4u*)(QKV + (size_t)(tr_ + vkey) * QKVC + vcol + 8 * vch); } while (0)
#define ATT_STORE(bufoff) do { *(LAS v4u*)(lds + (bufoff) + ATT_K_OFF + skey * ATT_KP + sch * 16) = kreg; \
        LAS unsigned short* vt_ = (LAS unsigned short*)(lds + (bufoff) + ATT_V_OFF + (8 * vch) * ATT_VP + vkey * 2); \
        vt_[0 * (ATT_VP / 2)] = (unsigned short)(vreg.x & 0xffff); vt_[1 * (ATT_VP / 2)] = (unsigned short)(vreg.x >> 16); vt_[2 * (ATT_VP / 2)] = (unsigned short)(vreg.y & 0xffff); vt_[3 * (ATT_VP / 2)] = (unsigned short)(vreg.y >> 16); \
        vt_[4 * (ATT_VP / 2)] = (unsigned short)(vreg.z & 0xffff); vt_[5 * (ATT_VP / 2)] = (unsigned short)(vreg.z >> 16); vt_[6 * (ATT_VP / 2)] = (unsigned short)(vreg.w & 0xffff); vt_[7 * (ATT_VP / 2)] = (unsigned short)(vreg.w >> 16); } while (0)
    v4u& kreg = P.k; v4u& vreg = P.v;
    if (!P.valid) ATT_LOAD(0);
    P.valid = 0;
    __syncthreads();
    if (MODE == 1 && head != tbl_head) {
        tbl_head = head;
        LAS float* tb = (LAS float*)(lds + ATT_RPB_OFF);
        for (int i = F.tid; i < ATT_TBL_FLOATS; i += NTHREADS) {
            int dr, off; bool ok;
            if (i < 15 * 128) { dr = i >> 7; off = (i & 127) - 63; ok = off >= -8 && off <= 7; }
            else { const int j = i - 15 * 128, ev = j / (15 * 64), dr_ = (j >> 6) % 15, kc = j & 63, q = ev < 8 ? ev : ev + 49; dr = dr_; off = kc - q; ok = ev < 8 ? kc < 16 : kc >= 48; }
            tb[i] = ok ? rpb[(head * 15 + dr) * 31 + off + 15] * LOG2E : -1e30f;
        }
    }
    ATT_STORE(0);
    __syncthreads();
#pragma unroll 1
    for (int tt = 0; tt < ntiles; ++tt) {
        const bool is_local = tt < ntl;
        const int kbase = q0 - 128 + 64 * (lo + tt), kr = kr_lo + tt;
        const int boff = (tt & 1) * ATT_BUF;
        if (tt + 1 < ntiles) { if (!(var & 2)) ATT_LOAD(tt + 1); }
        else if (u_next >= 0) {
            int nq, nqc, nkc, nvc, ntr; att_start<MODE>(u_next, w, r, nq, nqc, nkc, nvc, ntr);
            kreg = *(const v4u*)(QKV + (size_t)(ntr + skey) * QKVC + nkc + 8 * sch); vreg = *(const v4u*)(QKV + (size_t)(ntr + vkey) * QKVC + nvc + 8 * vch);
            P.valid = 1;
        }
        if (!(var & 1) && !(MODE == 1 && is_local && !(kr >= my_rs && kr < my_rs + 8))) {
            if (MODE == 1 && is_local) {
                if (w & 1) att_tile<MODE, 2>(lds, boff, qf, negm, O0, O1, m_run, l_run, true, false, kbase, qt, kr, gr, tb_base, tb_pitch, r, h);
                else att_tile<MODE, 1>(lds, boff, qf, negm, O0, O1, m_run, l_run, true, false, kbase, qt, kr, gr, tb_base, tb_pitch, r, h);
            } else att_tile<MODE, 0>(lds, boff, qf, negm, O0, O1, m_run, l_run, is_local, MODE == 0 && is_local && (lo + tt == 0 || lo + tt == 4), kbase, qt, kr, gr, tb_base, tb_pitch, r, h);
        }
        if (tt + 1 < ntiles && !(var & 2)) ATT_STORE(((tt + 1) & 1) * ATT_BUF);
        __syncthreads();
    }
#undef ATT_TROW
#undef ATT_LOAD
#undef ATT_STORE
    const float lt = l_run + __shfl_xor(l_run, 32), inv = 1.0f / lt;
    LAS unsigned char* ot = lds + w * 4608;
#pragma unroll
    for (int g = 0; g < 4; ++g) {
        v2u o; o.x = cvtpk(O0[4 * g] * inv, O0[4 * g + 1] * inv); o.y = cvtpk(O0[4 * g + 2] * inv, O0[4 * g + 3] * inv);
        *(LAS v2u*)(ot + r * 144 + (8 * g + 4 * h) * 2) = o;
        o.x = cvtpk(O1[4 * g] * inv, O1[4 * g + 1] * inv); o.y = cvtpk(O1[4 * g + 2] * inv, O1[4 * g + 3] * inv);
        *(LAS v2u*)(ot + r * 144 + (32 + 8 * g + 4 * h) * 2) = o;
    }
    LDS_WAIT(); asm volatile("" ::: "memory");
    bf16* op = Yo + (size_t)(qrow - r) * 512 + head * 64;
#pragma unroll
    for (int k = 0; k < 4; ++k) { const int p = lane + 64 * k, row = p >> 3, chk = p & 7;
        *(GAS v4u*)(op + (size_t)row * 512 + 8 * chk) = *(const LAS v4u*)(ot + row * 144 + chk * 16); }
    LDS_WAIT(); asm volatile("" ::: "memory");
}

template <int N>
__device__ __forceinline__ void conv_taps(const bf16* src, int t, int L, float w0, float w1, float w2, float bs, float (&out)[N]) {
    float x[N + 2];
    if constexpr (N == 8) { const v4u q = *(const v4u*)(src + t); x[1] = pg8::bf_lo(q.x); x[2] = pg8::bf_hi(q.x); x[3] = pg8::bf_lo(q.y); x[4] = pg8::bf_hi(q.y); x[5] = pg8::bf_lo(q.z); x[6] = pg8::bf_hi(q.z); x[7] = pg8::bf_lo(q.w); x[8] = pg8::bf_hi(q.w); }
    else { const v2u q = *(const v2u*)(src + t); x[1] = pg8::bf_lo(q.x); x[2] = pg8::bf_hi(q.x); x[3] = pg8::bf_lo(q.y); x[4] = pg8::bf_hi(q.y); }
    x[0] = t > 0 ? bf2f(src[t - 1]) : 0.f;
    x[N + 1] = (t + N < L) ? bf2f(src[t + N]) : 0.f;
#pragma unroll
    for (int e = 0; e < N; ++e) out[e] = w0 * x[e] + w1 * x[e + 1] + w2 * x[e + 2] + bs;
}

template <int L, int VAR = 0>
__device__ __forceinline__ void hyena_unit(Frame& F, int c, const bf16* CINT, bf16* DST, const bf16* Gf, const float* convw, const float* convb, const float* hybias) {
    constexpr int UP = (L + 8) * 2, TPW = L / 256, CPB = L / 8;
    LAS unsigned char* U = F.lds; LAS unsigned short* Gs = (LAS unsigned short*)(F.lds + 32 * UP);
    const int lane = F.lane, r = lane & 31, h = lane >> 5, T0 = F.wave * TPW * 32;
    const bf16* vsrc = CINT + (size_t)c * NROW + (L == SEQ ? 0 : NTOK);
    bf16* ydst = DST + (size_t)c * NROW + (L == SEQ ? 0 : NTOK);
    __syncthreads();
    if (!(VAR & 8)) {
        const float w0 = convw[c], w1 = convw[CINC + c], w2 = convw[2 * CINC + c], bs = convb[c];
        static_assert(CPB % 32 == 0, "a wave's 64 lanes hold consecutive chunks of at most two rows, split at lane 32");
#pragma unroll 4
        for (int q = F.tid; q < 32 * CPB; q += NTHREADS) { const int b = q / CPB, t = (q % CPB) * 8;
            const bf16* src = vsrc + (size_t)b * L;
            const v4u ch = *(const v4u*)(src + t);
            float x[10];
            x[1] = pg8::bf_lo(ch.x); x[2] = pg8::bf_hi(ch.x); x[3] = pg8::bf_lo(ch.y); x[4] = pg8::bf_hi(ch.y); x[5] = pg8::bf_lo(ch.z); x[6] = pg8::bf_hi(ch.z); x[7] = pg8::bf_lo(ch.w); x[8] = pg8::bf_hi(ch.w);
            const float up = __shfl_up(x[8], 1), dn = __shfl_down(x[1], 1);
            const int lr = lane & 31;
            x[0] = (lr == 0) ? (t > 0 ? bf2f(src[t - 1]) : 0.f) : up;
            x[9] = (lr == 31) ? (t + 8 < L ? bf2f(src[t + 8]) : 0.f) : dn;
            float o[8];
#pragma unroll
            for (int e = 0; e < 8; ++e) o[e] = w0 * x[e] + w1 * x[e + 1] + w2 * x[e + 2] + bs;
            v4u pk; pk.x = pk2(o[0], o[1]); pk.y = pk2(o[2], o[3]); pk.z = pk2(o[4], o[5]); pk.w = pk2(o[6], o[7]);
            *(LAS v4u*)(U + b * UP + t * 2) = pk; }
    }
#pragma unroll 1
    for (int ord = 0; ord < 2; ++ord) {
        {
            const v4u* gsrc = (const v4u*)(Gf + ((size_t)ord * 512 + c) * (2 * L));
            for (int q = F.tid; q < L / 4; q += NTHREADS) *(LAS v4u*)((LAS unsigned char*)Gs + q * 16) = gsrc[q];
        }
        __syncthreads();
        f32x16 acc[TPW];
#pragma unroll
        for (int i = 0; i < TPW; ++i)
#pragma unroll
            for (int e = 0; e < 16; ++e) acc[i][e] = 0.f;
        const int gbase = T0 + r - 8 * h + L;
#define HY_AF(dst, sgi, ti) do { const int gi_ = gbase + 32 * (ti) - 16 * (sgi); _Pragma("unroll") for (int j_ = 0; j_ < 8; ++j_) dst[j_] = (short)Gs[gi_ - j_]; } while (0)
#define HY_BF(sgi) (*(const LAS bf16x8*)(U + r * UP + (16 * (sgi) + 8 * h) * 2))
        if constexpr (TPW == 8 && !(VAR & 2)) {
            constexpr int NS = L / 16;
#pragma unroll 1
            for (int p = 0; p < 2; ++p) {
                bf16x8 W[8];
#pragma unroll
                for (int i = 1; i < 8; ++i) HY_AF(W[i], p, i);
                bf16x8 nf, nb; HY_AF(nf, p, 0); nb = HY_BF(p);
#pragma unroll 1
                for (int sb = p; sb < NS; sb += 16) {
#pragma unroll
                    for (int k = 0; k < 8; ++k) {
                        const int sg = sb + 2 * k; const bf16x8 cb = nb; W[(8 - k) & 7] = nf;
                        const int sn = sg + 2 < NS ? sg + 2 : sg;
                        HY_AF(nf, sn, 0); nb = HY_BF(sn);
#pragma unroll
                        for (int i = 0; i < 8; ++i) acc[i] = MFMA32(W[(i - k) & 7], cb, acc[i]);
                    }
                }
            }
        } else if constexpr (!(VAR & 2)) {
#pragma unroll 1
            for (int sg = 0; sg < L / 16; ++sg) { bf16x8 af; HY_AF(af, sg, 0); acc[0] = MFMA32(af, HY_BF(sg), acc[0]); }
        }
#undef HY_AF
#undef HY_BF
        const int comp = 1 + ord;
        const float w0 = convw[comp * 512 + c], w1 = convw[CINC + comp * 512 + c], w2 = convw[2 * CINC + comp * 512 + c], bs = convb[comp * 512 + c], hb = hybias[ord * 512 + c];
        const bf16* gsrc = CINT + ((size_t)comp * 512 + c) * NROW + (L == SEQ ? 0 : NTOK) + (size_t)r * L;
        __syncthreads();
        {
            constexpr int NCH = TPW * 4, BS = NCH < 8 ? NCH : 8;
#pragma unroll
            for (int bt = 0; bt < NCH / BS; ++bt) {
                const int tb = T0 + 8 * BS * bt;
                v4u ch[BS];
#pragma unroll
                for (int k = 0; k < BS; ++k) { if constexpr (VAR & 4) ch[k] = (v4u){0u, 0u, 0u, 0u}; else ch[k] = *(const v4u*)(gsrc + tb + 8 * k); }
                float xl = 0.f, xr = 0.f;
                if constexpr (!(VAR & 4)) { if (tb > 0) xl = bf2f(gsrc[tb - 1]); if (tb + 8 * BS < L) xr = bf2f(gsrc[tb + 8 * BS]); }
#pragma unroll
                for (int k = 0; k < BS; ++k) {
                    const int kk = BS * bt + k, i = kk >> 2, g = kk & 3, t = T0 + 32 * i + 8 * g + 4 * h;
                    float xs[10];
                    xs[0] = k == 0 ? xl : pg8::bf_hi(ch[k > 0 ? k - 1 : 0].w);
                    xs[1] = pg8::bf_lo(ch[k].x); xs[2] = pg8::bf_hi(ch[k].x); xs[3] = pg8::bf_lo(ch[k].y); xs[4] = pg8::bf_hi(ch[k].y); xs[5] = pg8::bf_lo(ch[k].z); xs[6] = pg8::bf_hi(ch[k].z); xs[7] = pg8::bf_lo(ch[k].w); xs[8] = pg8::bf_hi(ch[k].w);
                    xs[9] = k == BS - 1 ? xr : pg8::bf_lo(ch[k < BS - 1 ? k + 1 : k].x);
                    float gt[4];
#pragma unroll
                    for (int e2 = 0; e2 < 4; ++e2) { const float lo = w0 * xs[e2] + w1 * xs[e2 + 1] + w2 * xs[e2 + 2] + bs, hi = w0 * xs[e2 + 4] + w1 * xs[e2 + 5] + w2 * xs[e2 + 6] + bs; gt[e2] = h ? hi : lo; }
                    LAS v2u* up = (LAS v2u*)(U + r * UP + t * 2);
                    const v2u uu = *up;
                    const float u0 = pg8::bf_lo(uu.x), u1 = pg8::bf_hi(uu.x), u2 = pg8::bf_lo(uu.y), u3 = pg8::bf_hi(uu.y);
                    const float z0 = gt[0] * (acc[i][4 * g] + hb * u0), z1 = gt[1] * (acc[i][4 * g + 1] + hb * u1), z2 = gt[2] * (acc[i][4 * g + 2] + hb * u2), z3 = gt[3] * (acc[i][4 * g + 3] + hb * u3);
                    v2u zz; zz.x = pk2(z0, z1); zz.y = pk2(z2, z3);
                    *up = zz;
                }
                asm volatile("" ::: "memory");
            }
        }
        __syncthreads();
    }
    if (!(VAR & 1)) for (int q = F.tid; q < 32 * CPB; q += NTHREADS) { const int b = q / CPB, t = (q % CPB) * 8; *(GAS v4u*)(ydst + (size_t)b * L + t) = *(const LAS v4u*)(U + b * UP + t * 2); }
}

__device__ __forceinline__ void transpose_yc(Frame& F, const bf16* CT, bf16* Yc, int nrows) {
    const int gw = F.vcu * NWAVES + F.wave, NGW = F.G * NWAVES, lane = F.lane;
    LAS unsigned short* T = (LAS unsigned short*)(F.lds + F.wave * 16384);
    const int ntr = nrows / 64;
    for (int it = gw; it < 8 * ntr; it += NGW) {
        const int cb = it / ntr, rb = it % ntr, c0 = cb * 64, r0 = rb * 64;
#pragma unroll
        for (int k = 0; k < 8; ++k) { const int p = lane + 64 * k, cc = p >> 3, ch = p & 7;
            const v4u q = *(const v4u*)(CT + (size_t)(c0 + cc) * NROW + r0 + 8 * ch);
            LAS unsigned* d = (LAS unsigned*)(T + cc * 66 + 8 * ch); d[0] = q.x; d[1] = q.y; d[2] = q.z; d[3] = q.w; }
        LDS_WAIT(); asm volatile("" ::: "memory");
#pragma unroll
        for (int k = 0; k < 8; ++k) { const int p = lane + 64 * k, rr = p >> 3, ch = p & 7;
            unsigned short e[8];
#pragma unroll
            for (int j = 0; j < 8; ++j) e[j] = T[(8 * ch + j) * 66 + rr];
            v4u o; o.x = e[0] | ((unsigned)e[1] << 16); o.y = e[2] | ((unsigned)e[3] << 16); o.z = e[4] | ((unsigned)e[5] << 16); o.w = e[6] | ((unsigned)e[7] << 16);
            *(GAS v4u*)(Yc + (size_t)(r0 + rr) * 512 + c0 + 8 * ch) = o; }
        LDS_WAIT(); asm volatile("" ::: "memory");
    }
}

struct RowVecs { f32x4 gA[4], gt[4], gB[4], sc1[4], sh[4]; };
__device__ __forceinline__ float ssq16(const f32x4 (&v)[4]) { float s = 0.f;
#pragma unroll
    for (int j = 0; j < 4; ++j) s += (v[j].x * v[j].x + v[j].y * v[j].y) + (v[j].z * v[j].z + v[j].w * v[j].w);
    return s; }
__device__ __forceinline__ void ld_mod(const Frame& F, int l, int b, int part, int lane, f32x4 (&v)[4], float add) {
    ld_row_f32((const float*)(F.ws + WS_MODV) + ((size_t)l * 33 + b) * 6144 + part * 1024, lane, v);
#pragma unroll
    for (int j = 0; j < 4; ++j) v[j] = v[j] + add;
}
__device__ __forceinline__ void row_pair(const RowVecs& V, const f32x4 (&y0)[4], const f32x4 (&y1)[4], f32x4 (&x0)[4], f32x4 (&x1)[4], bool has_y, bool has_next, f32x4 (&h0)[4], f32x4 (&h1)[4]) {
    if (has_y) {
        float a0 = ssq16(y0), a1 = ssq16(y1);
#pragma unroll
        for (int o = 1; o < 64; o <<= 1) { a0 += __shfl_xor(a0, o); a1 += __shfl_xor(a1, o); }
        const float r0 = __builtin_amdgcn_rsqf(a0 * (1.0f / D) + EPS), r1 = __builtin_amdgcn_rsqf(a1 * (1.0f / D) + EPS);
#pragma unroll
        for (int j = 0; j < 4; ++j) { x0[j] = x0[j] + V.gt[j] * ((y0[j] * r0) * V.gA[j]); x1[j] = x1[j] + V.gt[j] * ((y1[j] * r1) * V.gA[j]); }
    }
    if (has_next) {
        float a0 = ssq16(x0), a1 = ssq16(x1);
#pragma unroll
        for (int o = 1; o < 64; o <<= 1) { a0 += __shfl_xor(a0, o); a1 += __shfl_xor(a1, o); }
        const float r0 = __builtin_amdgcn_rsqf(a0 * (1.0f / D) + EPS), r1 = __builtin_amdgcn_rsqf(a1 * (1.0f / D) + EPS);
#pragma unroll
        for (int j = 0; j < 4; ++j) { h0[j] = (x0[j] * r0) * V.gB[j] * V.sc1[j] + V.sh[j]; h1[j] = (x1[j] * r1) * V.gB[j] * V.sc1[j] + V.sh[j]; }
    }
}
template <bool XB16>
__device__ __forceinline__ void rows_phase(Frame& F, const Args& a, int mode, int l, int sub, const bf16* Y, int nrows) {
    const int gw = F.vcu * NWAVES + F.wave, NGW = F.G * NWAVES;
    const int R = (((nrows + NGW - 1) / NGW) + 1) & ~1, r0 = gw * R, r1 = (r0 + R) < nrows ? (r0 + R) : nrows;
    const bool has_y = mode == 1, has_next = (mode == 0) || !(l == 1 && sub == 1);
    const int ln = (mode == 0) ? 0 : (sub == 0 ? l : l + 1);
    const bool next_is_ffn = (mode == 1 && sub == 0);
    RowVecs V;
    if (has_y) ld_row_f32(a.in[sub == 0 ? I_GMIXPOST : I_GFFNPOST] + l * D, F.lane, V.gA);
    if (has_next) ld_row_f32(a.in[next_is_ffn ? I_GFFNPRE : I_GMIXPRE] + ln * D, F.lane, V.gB);
    int bcur = -2;
    bf16* const Hb = F.hb; bf16* const XB = (bf16*)(F.ws + WS_XB);
    f32x4 nx0[4], nx1[4]; v2u nxr0[4], nxr1[4], ny0[4], ny1[4];
#define ROWS_ISSUE(row_) do { const int rr_ = (row_); \
        if (has_y) { ld_raw_bf16_nt(Y + (size_t)rr_ * D, F.lane, ny0); ld_raw_bf16_nt(Y + (size_t)(rr_ + 1) * D, F.lane, ny1); } \
        if (XB16) { ld_raw_bf16_nt(XB + (size_t)rr_ * D, F.lane, nxr0); ld_raw_bf16_nt(XB + (size_t)(rr_ + 1) * D, F.lane, nxr1); } \
        else { const float* xs_ = rr_ < NTOK ? a.in[I_X] + (size_t)rr_ * D : a.in[I_CTX] + (size_t)(rr_ - NTOK) * D; ld_row_f32_nt(xs_, F.lane, nx0); ld_row_f32_nt(xs_ + D, F.lane, nx1); } } while (0)
    if (r0 < r1) ROWS_ISSUE(r0);
#pragma unroll 1
    for (int row = r0; row < r1; row += 2) {
        const int b = row < NTOK ? (row >> 11) : 32;
        if (b != bcur) { bcur = b;
            if (has_y) ld_mod(F, l, b, sub == 0 ? 2 : 5, F.lane, V.gt, 0.f);
            if (has_next) { ld_mod(F, ln, b, next_is_ffn ? 4 : 1, F.lane, V.sc1, 1.0f); ld_mod(F, ln, b, next_is_ffn ? 3 : 0, F.lane, V.sh, 0.f); } }
        f32x4 y0[4], y1[4], x0[4], x1[4], h0[4], h1[4];
#pragma unroll
        for (int j = 0; j < 4; ++j) { if (XB16) { x0[j] = cvt_raw_bf16(nxr0[j]); x1[j] = cvt_raw_bf16(nxr1[j]); } else { x0[j] = nx0[j]; x1[j] = nx1[j]; }
            if (has_y) { y0[j] = cvt_raw_bf16(ny0[j]); y1[j] = cvt_raw_bf16(ny1[j]); } }
        if (row + 2 < r1) ROWS_ISSUE(row + 2);
        row_pair(V, y0, y1, x0, x1, has_y, has_next, h0, h1);
        if (has_y) { st_row_bf16(XB + (size_t)row * D, F.lane, x0); st_row_bf16(XB + (size_t)(row + 1) * D, F.lane, x1); }
        if (has_next) { st_row_bf16(Hb + (size_t)row * D, F.lane, h0); st_row_bf16(Hb + (size_t)(row + 1) * D, F.lane, h1);
            if (!next_is_ffn) { GAS unsigned* q = (GAS unsigned*)(F.ws + WS_H8 + (size_t)row * D) + F.lane;
#pragma unroll
                for (int j = 0; j < 4; ++j) { q[64 * j] = pg8::pack_fp8x4(h0[j].x, h0[j].y, h0[j].z, h0[j].w); q[256 + 64 * j] = pg8::pack_fp8x4(h1[j].x, h1[j].y, h1[j].z, h1[j].w); } } }
    }
#undef ROWS_ISSUE
}

__device__ __forceinline__ void route_row(const f32x4 (&h)[4], const LAS float* rl, int lane, int& e0, int& e1, float& w0, float& w1) {
    float lg[8];
#pragma unroll
    for (int e = 0; e < 8; ++e) lg[e] = 0.f;
#pragma unroll
    for (int j = 0; j < 4; ++j)
#pragma unroll
        for (int i = 0; i < 4; ++i) { const LAS f32x4* rp = (const LAS f32x4*)(rl + ((j * 4 + i) * 64 + lane) * 8); const f32x4 q0 = rp[0], q1 = rp[1]; const float hv = h[j][i];
            lg[0] += hv * q0.x; lg[1] += hv * q0.y; lg[2] += hv * q0.z; lg[3] += hv * q0.w; lg[4] += hv * q1.x; lg[5] += hv * q1.y; lg[6] += hv * q1.z; lg[7] += hv * q1.w; }
    { const bool b5 = (lane & 32) != 0, b4 = (lane & 16) != 0, b3 = (lane & 8) != 0;
      float v4[4], v2[2], v1;
#pragma unroll
      for (int k = 0; k < 4; ++k) { const float snd = b5 ? lg[k] : lg[k + 4], kp = b5 ? lg[k + 4] : lg[k]; v4[k] = kp + __shfl_xor(snd, 32); }
#pragma unroll
      for (int k = 0; k < 2; ++k) { const float snd = b4 ? v4[k] : v4[k + 2], kp = b4 ? v4[k + 2] : v4[k]; v2[k] = kp + __shfl_xor(snd, 16); }
      { const float snd = b3 ? v2[0] : v2[1], kp = b3 ? v2[1] : v2[0]; v1 = kp + __shfl_xor(snd, 8); }
      v1 += __shfl_xor(v1, 4); v1 += __shfl_xor(v1, 2); v1 += __shfl_xor(v1, 1);
#pragma unroll
      for (int e = 0; e < 8; ++e) lg[e] = __builtin_bit_cast(float, __builtin_amdgcn_readlane(__builtin_bit_cast(int, v1), 8 * e)); }
    e0 = 0; float v0 = lg[0];
#pragma unroll
    for (int e = 1; e < 8; ++e) if (lg[e] > v0) { v0 = lg[e]; e0 = e; }
    e1 = -1; float v1 = -3.0e38f;
#pragma unroll
    for (int e = 0; e < 8; ++e) if (e != e0 && lg[e] > v1) { v1 = lg[e]; e1 = e; }
    w0 = 1.0f / (1.0f + __expf(v1 - v0)); w1 = 1.0f - w0;
}
__device__ __forceinline__ void post_route_phase(Frame& F, const Args& a, const bf16* Y) {
    LAS int* se = (LAS int*)F.lds;
    LAS int* sbase = se + 512;
    LAS float* rl = (LAS float*)(F.lds + 4096);
    const int l = 1;
    __syncthreads();
    for (int i = F.tid; i < 1024 * 8; i += NTHREADS) { const int k = i >> 3, e = i & 7, jj = k >> 8, ln = (k & 255) >> 2, ii = k & 3; rl[((jj * 4 + ii) * 64 + ln) * 8 + e] = a.in[I_ROUTER][i]; }
    __syncthreads();
    RowVecs V;
    ld_row_f32(a.in[I_GMIXPOST] + l * D, F.lane, V.gA); ld_row_f32(a.in[I_GFFNPRE] + l * D, F.lane, V.gB);
    bf16* const Hb = F.hb; bf16* const XB = (bf16*)(F.ws + WS_XB);
    for (int blk = F.vcu; blk < NTOK / 256; blk += F.G) {
        const int b = blk >> 3;
        ld_mod(F, l, b, 2, F.lane, V.gt, 0.f); ld_mod(F, l, b, 4, F.lane, V.sc1, 1.0f); ld_mod(F, l, b, 3, F.lane, V.sh, 0.f);
        v2u nyr[4], nxr[4];
        { const int row_ = blk * 256 + F.wave * 32; ld_raw_bf16_nt(Y + (size_t)row_ * D, F.lane, nyr); ld_raw_bf16_nt(XB + (size_t)row_ * D, F.lane, nxr); }
#pragma unroll 1
        for (int k = 0; k < 32; ++k) {
            const int lr = F.wave * 32 + k, row = blk * 256 + lr;
            f32x4 y0[4], x0[4], h0[4];
#pragma unroll
            for (int j = 0; j < 4; ++j) { y0[j] = cvt_raw_bf16(nyr[j]); x0[j] = cvt_raw_bf16(nxr[j]); }
            if (k + 1 < 32) { ld_raw_bf16_nt(Y + (size_t)(row + 1) * D, F.lane, nyr); ld_raw_bf16_nt(XB + (size_t)(row + 1) * D, F.lane, nxr); }
            bf16* xp = XB + (size_t)row * D;
            { const float r0 = __builtin_amdgcn_rsqf(wave_sum(ssq16(y0)) * (1.0f / D) + EPS);
#pragma unroll
              for (int j = 0; j < 4; ++j) x0[j] = x0[j] + V.gt[j] * ((y0[j] * r0) * V.gA[j]); }
            st_row_bf16(xp, F.lane, x0);
            { const float r0 = __builtin_amdgcn_rsqf(wave_sum(ssq16(x0)) * (1.0f / D) + EPS);
#pragma unroll
              for (int j = 0; j < 4; ++j) h0[j] = (x0[j] * r0) * V.gB[j] * V.sc1[j] + V.sh[j]; }
            { GAS unsigned* q = (GAS unsigned*)((unsigned char*)Hb + (size_t)row * D) + F.lane;
#pragma unroll
              for (int j = 0; j < 4; ++j) q[64 * j] = pg8::pack_fp8x4(h0[j].x, h0[j].y, h0[j].z, h0[j].w); }
            int e0, e1; float w0, w1;
            route_row(h0, rl, F.lane, e0, e1, w0, w1);
            if (F.lane == 0) { se[2 * lr] = e0; se[2 * lr + 1] = e1;
                int4 rr; rr.x = e0; rr.y = e1; rr.z = __builtin_bit_cast(int, w0); rr.w = __builtin_bit_cast(int, w1); ((int4*)(F.ws + WS_ROUTE))[row] = rr; }
        }
        __syncthreads();
        const int half = blk >> 7;
        if (F.tid < 8) { int n = 0; for (int i = 0; i < 512; ++i) n += (se[i] == F.tid) ? 1 : 0;
            sbase[F.tid] = (int)__hip_atomic_fetch_add((unsigned*)(F.ws + WS_CTL) + CW_CNT + half * 8 + F.tid, (unsigned)n, __ATOMIC_RELAXED, __HIP_MEMORY_SCOPE_AGENT); }
        __syncthreads();
        if (F.tid < 8) { int p = sbase[F.tid]; int* lst = (int*)(F.ws + WS_LIST) + ((size_t)half * 8 + F.tid) * 32768;
            for (int i = 0; i < 512; ++i) if (se[i] == F.tid) lst[p++] = ((blk * 256 + (i >> 1)) << 1) | (i & 1); }
        __syncthreads();
    }
}

__device__ __forceinline__ void moe_offsets(Frame& F, int half, int (&toff)[9], int (&cnt)[8]) {
    const unsigned* cw = (const unsigned*)(F.ws + WS_CTL) + CW_CNT + half * 8;
    toff[0] = 0;
#pragma unroll
    for (int e = 0; e < 8; ++e) { cnt[e] = __builtin_amdgcn_readfirstlane((int)__hip_atomic_load(cw + e, __ATOMIC_RELAXED, __HIP_MEMORY_SCOPE_AGENT)); toff[e + 1] = toff[e] + (cnt[e] + 255) / 256; }
}
__device__ __forceinline__ void moe_gather_phase(Frame& F, int half, int skip_first = 0) {
    if (skip_first < 0 || skip_first >= F.G) skip_first = 0;
    const int bxw = (int)blockIdx.x - skip_first; if (bxw < 0) return;
    const int gw = bxw * NWAVES + F.wave, NGW = (F.G - skip_first) * NWAVES;
    int toff[9], cnt[8]; moe_offsets(F, half, toff, cnt);
    const int P = toff[8] * 256;
#pragma unroll 1
    for (int pb = gw; pb < P; pb += 4 * NGW) {
        int ts[4]; bool ok[4];
#pragma unroll
        for (int j = 0; j < 4; ++j) { const int p = pb + j * NGW; ok[j] = false; ts[j] = 0;
            if (p < P) { const int tile = p >> 8; int e = 0;
#pragma unroll
                for (int k = 1; k < 8; ++k) e += (tile >= toff[k]) ? 1 : 0;
                int te = 0, ce = 0;
#pragma unroll
                for (int k = 0; k < 8; ++k) { te = (e == k) ? toff[k] : te; ce = (e == k) ? cnt[k] : ce; }
                const int idx = p - te * 256;
                if (idx < ce) { ok[j] = true; ts[j] = ((const int*)(F.ws + WS_LIST))[((size_t)half * 8 + e) * 32768 + idx]; } } }
        v4u o[4];
#pragma unroll
        for (int j = 0; j < 4; ++j) { o[j] = (v4u){0u, 0u, 0u, 0u};
            if (ok[j]) o[j] = *((const GAS v4u*)((const unsigned char*)F.hb + (size_t)(ts[j] >> 1) * D) + F.lane); }
#pragma unroll
        for (int j = 0; j < 4; ++j) { const int p = pb + j * NGW;
            if (p < P) { *((GAS v4u*)(F.ws + BIG_AS + (size_t)p * D) + F.lane) = o[j];
                if (ok[j] && F.lane == 0) ((int*)(F.ws + WS_INV))[(ts[j] >> 1) * 2 + (ts[j] & 1)] = p; } }
    }
}
struct ConvItem { const float* W; unsigned char* WT; int N, Kp, k0, n0, drow0; float scale; };
__device__ __forceinline__ void moe_conv_decode(const Frame& F, const Args& a, int it, ConvItem& c) {
    constexpr int I13 = 16 * 112, I2 = 56 * 32;
    const int e = it / (2 * I13 + I2); int r = it % (2 * I13 + I2);
    if (r < 2 * I13) {
        const int which = r / I13; r %= I13; const int kb = r / 112, nb = r % 112, n0 = 32 * nb;
        c.W = (which ? a.in[I_MW3] : a.in[I_MW1]) + (size_t)e * D * DFFE; c.N = DFFE; c.WT = F.ws + WM_13 + (size_t)e * 2 * DFFE * D; c.Kp = D; c.k0 = 64 * kb; c.n0 = n0;
        c.drow0 = (n0 / 128) * 256 + which * 128 + (n0 % 128); c.scale = W13_SCALE;
    } else {
        r -= 2 * I13; const int kb = r / 32, nb = r % 32;
        c.W = a.in[I_MW2] + (size_t)e * DFFE * D; c.N = D; c.WT = F.ws + WM_2 + (size_t)e * D * DFFE; c.Kp = DFFE; c.k0 = 64 * kb; c.n0 = 32 * nb; c.drow0 = 32 * nb; c.scale = W2_SCALE;
    }
}
__device__ __forceinline__ void moe_conv_load(const ConvItem& c, int lane, f32x4 (&v)[8]) {
    const int c4 = 4 * (lane & 7);
#pragma unroll
    for (int i = 0; i < 8; ++i) { const int kk = (lane >> 3) + 8 * i; v[i] = __builtin_nontemporal_load((const GAS f32x4*)(c.W + (size_t)(c.k0 + kk) * c.N + c.n0 + c4)); }
}
__device__ __forceinline__ void moe_convert(Frame& F, const Args& a) {
    const int gw = F.vcu * NWAVES + F.wave, NGW = F.G * NWAVES, lane = F.lane;
    LAS float* scr = (LAS float*)(F.lds + F.wave * 16384);
    constexpr int NIT = 8 * (2 * 16 * 112 + 56 * 32);
    if (gw >= NIT) return;
    ConvItem cur; f32x4 v[8];
    moe_conv_decode(F, a, gw, cur); moe_conv_load(cur, lane, v);
#pragma unroll 1
    for (int it = gw; it < NIT; it += NGW) {
        { const int c4 = 4 * (lane & 7);
#pragma unroll
          for (int i = 0; i < 8; ++i) { const int kk = (lane >> 3) + 8 * i; const f32x4 w = v[i] * cur.scale; LAS float* d = scr + kk * 33 + c4; d[0] = w.x; d[1] = w.y; d[2] = w.z; d[3] = w.w; } }
        ConvItem nxt = cur;
        if (it + NGW < NIT) { moe_conv_decode(F, a, it + NGW, nxt); moe_conv_load(nxt, lane, v); }
        LDS_WAIT(); asm volatile("" ::: "memory");
        const int c = lane & 7;
#pragma unroll
        for (int j = 0; j < 4; ++j) { const int n = (lane >> 3) + 8 * j; const LAS float* s = scr + (8 * c) * 33 + n;
            v2u o; o.x = pg8::pack_fp8x4(s[0 * 33], s[1 * 33], s[2 * 33], s[3 * 33]); o.y = pg8::pack_fp8x4(s[4 * 33], s[5 * 33], s[6 * 33], s[7 * 33]);
            *(GAS v2u*)(cur.WT + (size_t)(cur.drow0 + n) * cur.Kp + cur.k0 + 8 * c) = o; }
        LDS_WAIT(); asm volatile("" ::: "memory");
        cur = nxt;
    }
}
__device__ __forceinline__ void moe_post_phase(Frame& F, const Args& a, int half) {
    const int gw = F.vcu * NWAVES + F.wave, NGW = F.G * NWAVES;
    const int R = (((32768 + NGW - 1) / NGW) + 1) & ~1, t0 = gw * R, t1 = (t0 + R) < 32768 ? (t0 + R) : 32768;
    RowVecs V; ld_row_f32(a.in[I_GFFNPOST] + D, F.lane, V.gA);
    int bcur = -2;
    const bf16* Y2 = (const bf16*)(F.ws + BIG_Y2S); const int* inv = (const int*)(F.ws + WS_INV); const int4* rt = (const int4*)(F.ws + WS_ROUTE);
    int4 ira, irb; int ip00, ip01, ip10, ip11;
    v2u nya[4], nyb[4], nyc[4], nyd[4], nxr0[4], nxr1[4]; const bf16* XB = (const bf16*)(F.ws + WS_XB); float nw0 = 0.f, nw1 = 0.f, nu0 = 0.f, nu1 = 0.f;
#define MP_IDX(t_) do { const int rw_ = half * 32768 + (t_); ira = rt[rw_]; irb = rt[rw_ + 1]; ip00 = inv[rw_ * 2]; ip01 = inv[rw_ * 2 + 1]; ip10 = inv[rw_ * 2 + 2]; ip11 = inv[rw_ * 2 + 3]; } while (0)
#define MP_DATA(t_) do { const int rw_ = half * 32768 + (t_); \
        ld_raw_bf16_nt(Y2 + (size_t)ip00 * D, F.lane, nya); ld_raw_bf16_nt(Y2 + (size_t)ip01 * D, F.lane, nyb); ld_raw_bf16_nt(Y2 + (size_t)ip10 * D, F.lane, nyc); ld_raw_bf16_nt(Y2 + (size_t)ip11 * D, F.lane, nyd); \
        const bf16* xq_ = XB + (size_t)rw_ * D; ld_raw_bf16_nt(xq_, F.lane, nxr0); ld_raw_bf16_nt(xq_ + D, F.lane, nxr1); \
        nw0 = __builtin_bit_cast(float, ira.z); nw1 = __builtin_bit_cast(float, ira.w); nu0 = __builtin_bit_cast(float, irb.z); nu1 = __builtin_bit_cast(float, irb.w); } while (0)
    if (t0 < t1) { MP_IDX(t0); MP_DATA(t0); if (t0 + 2 < t1) MP_IDX(t0 + 2); }
#pragma unroll 1
    for (int t = t0; t < t1; t += 2) {
        const int row = half * 32768 + t, b = row >> 11;
        if (b != bcur) { bcur = b; ld_mod(F, 1, b, 5, F.lane, V.gt, 0.f); }
        f32x4 y0[4], y1[4], x0[4], x1[4], h0[4], h1[4];
        float* xp = a.out + (size_t)row * D;
#pragma unroll
        for (int j = 0; j < 4; ++j) { x0[j] = cvt_raw_bf16(nxr0[j]); x1[j] = cvt_raw_bf16(nxr1[j]); y0[j] = cvt_raw_bf16(nya[j]) * nw0 + cvt_raw_bf16(nyb[j]) * nw1; y1[j] = cvt_raw_bf16(nyc[j]) * nu0 + cvt_raw_bf16(nyd[j]) * nu1; }
        if (t + 2 < t1) { MP_DATA(t + 2); if (t + 4 < t1) MP_IDX(t + 4); }
        row_pair(V, y0, y1, x0, x1, true, false, h0, h1);
        st_row_f32_nt(xp, F.lane, x0); st_row_f32_nt(xp + D, F.lane, x1);
    }
#undef MP_IDX
#undef MP_DATA
}

#ifndef MK_ONLY
#define MK_ONLY -1
#endif
#ifndef MK_SKIP
#define MK_SKIP -1
#endif
#define ON(k) ((MK_ONLY < 0 || MK_ONLY == (k)) && MK_SKIP != (k))
#ifndef MK_REPMASK
#define MK_REPMASK 0
#endif
#ifndef MK_REPSUB
#define MK_REPSUB 0
#endif
#ifndef MK_HYVAR
#define MK_HYVAR 0
#endif
#ifndef MK_PROBE
#define MK_PROBE -1
#endif
#ifndef MK_PROBE_END
#define MK_PROBE_END MK_PROBE
#endif
#ifndef MK_PROBE_DIV
#define MK_PROBE_DIV 10
#endif
#ifndef MK_PROBE_SUB
#define MK_PROBE_SUB -1
#endif
#define PSUB(k, which) do { if (MK_PROBE >= 100 && MK_PROBE_SUB == (k) && l == MK_PROBE - 100) PROBE_STAMP(which); } while (0)
#ifndef MK_MULTI
#define MK_MULTI 0
#endif
constexpr int NPHASES = 2 + 9 + 6 + 6;

typedef const __attribute__((address_space(4))) Args* ArgsP;
#define KARGS ((ArgsP)__builtin_amdgcn_kernarg_segment_ptr())
#define PH_ENTER \
    Frame F; const Args* ap_; { int t_ = threadIdx.x; asm volatile("" : "+v"(t_)); ArgsP q_ = KARGS; asm volatile("" : "+s"(q_)); ap_ = (const Args*)q_; \
      F.lds = (LAS unsigned char*)lds_raw; F.tid = t_; F.lane = t_ & 63; F.wave = __builtin_amdgcn_readfirstlane(t_ >> 6); \
      F.G = gridDim.x; { const int bx_ = blockIdx.x; F.vcu = (F.G % 8 == 0) ? (bx_ % 8) * (F.G / 8) + bx_ / 8 : bx_; } F.ws = q_->ws; F.hb = (bf16*)q_->out; } \
    const Args& a = *ap_; const int bx = (int)blockIdx.x; \
    bf16* const Hb = F.hb; bf16* const Y3 = (bf16*)(F.ws + WS_Y3); bf16* const QKV = (bf16*)(F.ws + BIG_QKV); bf16* const CINT = (bf16*)(F.ws + BIG_CINT); unsigned char* const GATE = F.ws + BIG_GATE; \
    (void)Hb; (void)Y3; (void)QKV; (void)CINT; (void)GATE; (void)bx; (void)a;

__global__ void __launch_bounds__(NTHREADS, 2) fwd_kernel(Args args) {
    extern __shared__ __attribute__((aligned(16))) unsigned char lds_raw[];
    {
        volatile LAS unsigned* MISC0 = (volatile LAS unsigned*)((LAS unsigned char*)lds_raw + MISC_OFF);
        for (int u = threadIdx.x; u < (LDS_BYTES - MISC_OFF) / 4; u += NTHREADS) MISC0[u] = 0u;
        __syncthreads();
    }
    if (!MK_MULTI) (void)xcd_barrier_post((unsigned*)(KARGS->ws + WS_CTL) + CW_BAR, (volatile LAS unsigned*)((LAS unsigned char*)lds_raw + MISC_OFF) + 8);
    int ph = 0;
#define PROBE_STAMP(which) do { if (MK_PROBE >= 0 && blockIdx.x == 0 && __builtin_amdgcn_readfirstlane((int)threadIdx.x) == 0) { volatile unsigned* pw_ = (volatile unsigned*)(KARGS->ws + WS_CTL) + 20000; const unsigned t_ = (unsigned)__builtin_amdgcn_s_memrealtime(); if ((which) == 0) pw_[0] = t_; else pw_[1] = t_ - pw_[0]; } } while (0)
    if (MK_PROBE == 0) PROBE_STAMP(0);
#define LO_ (KARGS->ph_lo)
#define HI_ (KARGS->ph_hi)
#define GRID_BAR do { XcdBarrier b_; b_.bar = (unsigned*)(KARGS->ws + WS_CTL) + CW_BAR; b_.x = xb_xcc_id(); b_.st = (volatile LAS unsigned*)((LAS unsigned char*)lds_raw + MISC_OFF) + 8; xcd_barrier(b_); } while (0)
#define RUN (LO_ <= ph && ph < HI_)
#define END_PHASE do { if (RUN && (ph + 1 < HI_)) { GRID_BAR; } if (MK_PROBE > 0 && ph + 1 == MK_PROBE) PROBE_STAMP(0); if (MK_PROBE >= 0 && ph == MK_PROBE_END) PROBE_STAMP(1); ++ph; } while (0)

    if (RUN && ON(0)) { PH_ENTER p0_prologue(F, a); } END_PHASE;
    if (RUN && ON(1)) { PH_ENTER p1_phase(F, a); rows_phase<false>(F, a, 0, 0, 0, nullptr, NROW); } END_PHASE;

#pragma unroll 1
    for (int l = 0; l < 2; ++l) {
        const int nrows = l == 0 ? NROW : NTOK;
        if (RUN && ON(2)) { PH_ENTER
            const bf16* Wq8 = (const bf16*)(F.ws + W_IN + (size_t)l * INC * D);
            { pg8::Gemm g{(const bf16*)(F.ws + WS_H8), Wq8, nrows, QKVC, D / 2}; pg8::StaticOrder S; S.init(nrows, QKVC, F.G, bx);
              pg8::EpiQKV E{QKV, (const float*)(F.ws + WS_ROPE), 0, QSCALE, 1.0f / W13_SCALE};
              pg8::gemm_phase<pg8::EpiQKV, pg8::StaticOrder, true, true, true>(F.lds, g, S, E, F.tid); }
            int tid2 = threadIdx.x; asm volatile("" : "+v"(tid2));
            if (l == 1) { pg8::Gemm g{(const bf16*)(F.ws + WS_H8 + (size_t)NTOK * D), Wq8, NCTX, 1280, D / 2}; pg8::StaticOrder S; S.init(NCTX, 1280, F.G, bx);
              pg8::EpiQKV E{QKV, (const float*)(F.ws + WS_ROPE), NTOK, QSCALE, 1.0f / W13_SCALE};
              pg8::gemm_phase<pg8::EpiQKV, pg8::StaticOrder, true, true, true>(F.lds, g, S, E, tid2); }
            int tid3 = threadIdx.x; asm volatile("" : "+v"(tid3));
            { pg8::Gemm g{(const bf16*)(F.ws + W_CB) + (size_t)l * CINC * D, Hb, CINC, nrows, D}; pg8::StaticOrder S; S.init(CINC, nrows, F.G, bx);
              pg8::EpiPlain E{CINT, NROW, 0, 0, 1.0f};
              pg8::gemm_phase<pg8::EpiPlain, pg8::StaticOrder, true, true>(F.lds, g, S, E, tid3); }
        } END_PHASE;
        if (RUN) {
            PSUB(0, 0);
            { PH_ENTER const float* sink = a.in[I_SINK] + l * 8; const float* rpb = a.in[I_RPB] + (size_t)l * 8 * 15 * 31; const int sm = a.sub_mask;
              if (ON(3) && (sm & 1)) { AttPre P; P.valid = 0; int th = -1; for (int u = F.vcu; u < 2048; u += F.G) attn_unit<0>(F, u, u + F.G < 2048 ? u + F.G : -1, QKV, Y3, sink, rpb, P, th, (sm >> 6) & 3); } }
            PSUB(0, 1); PSUB(1, 0);
            { PH_ENTER const float* sink = a.in[I_SINK] + l * 8; const float* rpb = a.in[I_RPB] + (size_t)l * 8 * 15 * 31; const int sm = a.sub_mask;
              if (ON(4) && (sm & 2)) { AttPre P; P.valid = 0; int th = -1; for (int u = F.vcu; u < 2048; u += F.G) attn_unit<1>(F, u, u + F.G < 2048 ? u + F.G : -1, QKV, Y3 + (size_t)NROW * 512, sink, rpb, P, th, (sm >> 6) & 3); } }
            PSUB(1, 1); PSUB(2, 0);
            { PH_ENTER const float* sink = a.in[I_SINK] + l * 8; const float* rpb = a.in[I_RPB] + (size_t)l * 8 * 15 * 31; const int sm = a.sub_mask;
              if (l == 0 && ON(5) && (sm & 4)) {
                { AttPre P; P.valid = 0; int th = -1; for (int u = F.vcu; u < 256; u += F.G) attn_unit<2>(F, u, -1, QKV, Y3, sink, rpb, P, th); }
                { AttPre P; P.valid = 0; int th = -1; for (int u = F.vcu; u < 256; u += F.G) attn_unit<3>(F, u, -1, QKV, Y3 + (size_t)NROW * 512, sink, rpb, P, th); }
              } }
            PSUB(2, 1); PSUB(3, 0);
            { PH_ENTER const int sm = a.sub_mask;
              const float* cw = a.in[I_CONVW] + l * 3 * CINC; const float* cb = a.in[I_CONVB] + l * CINC; const float* hb = a.in[I_HBIAS] + l * 1024;
#if MK_HYVAR
              if (ON(6) && (sm & 32)) for (int c = F.vcu; c < 512; c += F.G) hyena_unit<SEQ, MK_HYVAR>(F, c, CINT, CINT, (const bf16*)(F.ws + WS_GF) + (size_t)l * 2 * 512 * 2 * SEQ, cw, cb, hb);
#endif
              if (ON(6) && (sm & 8)) for (int c = F.vcu; c < 512; c += F.G) hyena_unit<SEQ>(F, c, CINT, CINT, (const bf16*)(F.ws + WS_GF) + (size_t)l * 2 * 512 * 2 * SEQ, cw, cb, hb);
              if (l == 0 && ON(7) && (sm & 16)) for (int c = F.vcu; c < 512; c += F.G) hyena_unit<LC>(F, c, CINT, CINT, (const bf16*)(F.ws + WS_GFC) + (size_t)l * 2 * 512 * 2 * LC, cw, cb, hb);
              __syncthreads(); }
            PSUB(3, 1);
        } END_PHASE;
        if (RUN && ON(8)) { PH_ENTER
            transpose_yc(F, CINT, (bf16*)(F.ws + BIG_YCT), nrows);
            __syncthreads();
            pg8::Gemm g{(const bf16*)(F.ws + WS_H8), (const bf16*)(F.ws + W_IN + (size_t)l * INC * D + (size_t)(QKVC + CINC) * D), nrows, GATEC, D / 2}; pg8::StaticOrder S; S.init(nrows, GATEC, F.G, bx);
            pg8::EpiSig E{GATE, GATEC, 1.0f / W13_SCALE};
            pg8::gemm_phase<pg8::EpiSig, pg8::StaticOrder, true, true, true>(F.lds, g, S, E, F.tid);
        } END_PHASE;
        if (RUN && ON(9)) { PH_ENTER
            constexpr int TB = 256 * 512 * 2;
            static_assert((WS_Y3 - BIG_YCT) % TB == 0, "merge tile offsets");
            constexpr int OA = (int)((WS_Y3 - BIG_YCT) / TB), OB = OA + NROW / 256;
            pg8::Gemm g{(const bf16*)(F.ws + BIG_YCT), (const bf16*)(F.ws + W_BR) + (size_t)l * 3 * D * 512, 3 * NROW, 3 * D, 512}; pg8::MergeOrder S{nrows / 256, F.G, bx, OA, OB, 0};
            pg8::EpiMerge E{Hb, GATE, OA, OB, 0};
            pg8::gemm_phase<pg8::EpiMerge, pg8::MergeOrder, true, true>(F.lds, g, S, E, F.tid);
        } END_PHASE;
        if (RUN && ON(10)) { PH_ENTER
            pg8::Gemm g{Hb, (const bf16*)(F.ws + W_OUT) + (size_t)l * D * D, nrows, D, D}; pg8::StaticOrder S; S.init(nrows, D, F.G, bx);
            pg8::EpiPlain E{Y3, D, 0, 0, 1.0f};
            pg8::gemm_phase<pg8::EpiPlain, pg8::StaticOrder, true, true>(F.lds, g, S, E, F.tid);
        } END_PHASE;
        if (RUN && ON(11)) { PH_ENTER if (l == 0) rows_phase<false>(F, a, 1, 0, 0, Y3, nrows); else post_route_phase(F, a, Y3); } END_PHASE;
        if (l == 0) {
            if (RUN && ON(12)) { PH_ENTER
                pg8::Gemm g{Hb, (const bf16*)(F.ws + W_F13), NROW, 2 * DFF, D}; pg8::StaticOrder S; S.init(NROW, 2 * DFF, F.G, bx);
                pg8::EpiSwiGLU E{(bf16*)(F.ws + BIG_HID), DFF, 0};
                pg8::gemm_phase<pg8::EpiSwiGLU, pg8::StaticOrder, true, true>(F.lds, g, S, E, F.tid);
            } END_PHASE;
            if (RUN && ON(13)) { PH_ENTER
                pg8::Gemm g{(const bf16*)(F.ws + BIG_HID), (const bf16*)(F.ws + W_F2), NROW, D, DFF}; pg8::StaticOrder S; S.init(NROW, D, F.G, bx);
                pg8::EpiPlain E{Y3, D, 0, 0, 1.0f};
                pg8::gemm_phase<pg8::EpiPlain, pg8::StaticOrder, true, true>(F.lds, g, S, E, F.tid);
            } END_PHASE;
            if (RUN && ON(14)) { PH_ENTER rows_phase<true>(F, a, 1, 0, 1, Y3, NROW); } END_PHASE;
        } else {
#pragma unroll 1
            for (int half = 0; half < 2; ++half) {
                if (half == 0) { if (RUN && ON(15)) { PH_ENTER moe_convert(F, a); moe_gather_phase(F, 0); } END_PHASE; }
                if (RUN && ON(16)) { PH_ENTER
                    int toff[9], cnt[8]; moe_offsets(F, half, toff, cnt);
                    pg8::GroupOrder S; S.nM = toff[8]; S.nN = 28; S.G = F.G; S.c = bx;
#pragma unroll
                    for (int k = 0; k < 9; ++k) S.toff[k] = toff[k];
                    pg8::Gemm g{(const bf16*)(F.ws + BIG_AS), (const bf16*)(F.ws + WM_13), PCAP, 8 * 2 * DFFE, D / 2};
                    pg8::EpiSwiGLU8 E{F.ws + BIG_MH, DFFE, 28, 1.0f / W13_SCALE, HID_SCALE};
                    pg8::gemm_phase<pg8::EpiSwiGLU8, pg8::GroupOrder, true, true, true>(F.lds, g, S, E, F.tid);
                    if (half == 1) moe_post_phase(F, a, 0);
                } END_PHASE;
                if (RUN && ON(17)) { PH_ENTER
                    int toff[9], cnt[8]; moe_offsets(F, half, toff, cnt);
                    pg8::GroupOrder S; S.nM = toff[8]; S.nN = 4; S.G = F.G; S.c = bx;
#pragma unroll
                    for (int k = 0; k < 9; ++k) S.toff[k] = toff[k];
                    pg8::Gemm g{(const bf16*)(F.ws + BIG_MH), (const bf16*)(F.ws + WM_2), PCAP, 8 * D, DFFE / 2};
                    pg8::EpiPlain E{(bf16*)(F.ws + BIG_Y2S), D, 4, 0, 1.0f / (HID_SCALE * W2_SCALE)};
                    pg8::gemm_phase<pg8::EpiPlain, pg8::GroupOrder, true, true, true>(F.lds, g, S, E, F.tid);
                    if (half == 0) moe_gather_phase(F, 1, toff[8] * 4 - 4 * F.G);
                } END_PHASE;
            }
            if (RUN && ON(18)) { PH_ENTER moe_post_phase(F, a, 1); } END_PHASE;
        }
    }
#undef RUN
#undef END_PHASE
    if (MK_PROBE >= 0 && blockIdx.x == 0 && threadIdx.x == 0) {
        volatile unsigned* pw_ = (volatile unsigned*)(KARGS->ws + WS_CTL) + 20000;
        volatile float* o_ = (volatile float*)KARGS->out;
        o_[0] = o_[0] + floorf((float)pw_[1] * (0.01f / MK_PROBE_DIV));
    }
}

extern "C" void kernel_launch(void* const* d_in, const int* in_sizes, int n_in, void* d_out, int out_size, void* d_ws, size_t ws_size, hipStream_t stream) {
    static int grid = 0;
    if (grid == 0) {
        if (n_in != 31 || in_sizes[0] != NTOK * D || out_size != NTOK * D || ws_size < WS_END) { fprintf(stderr, "kernel_launch: unexpected shapes (n_in %d, in0 %d, out %d, ws %zu)\n", n_in, n_in > 0 ? in_sizes[0] : -1, out_size, ws_size); grid = -1; return; }
        int dev = 0, cus = 0, per_cu = 0;
        if (hipGetDevice(&dev) != hipSuccess || hipDeviceGetAttribute(&cus, hipDeviceAttributeMultiprocessorCount, dev) != hipSuccess) { grid = -1; return; }
        if (hipFuncSetAttribute((const void*)fwd_kernel, hipFuncAttributeMaxDynamicSharedMemorySize, LDS_BYTES) != hipSuccess) { fprintf(stderr, "kernel_launch: hipFuncSetAttribute failed\n"); grid = -1; return; }
        if (hipOccupancyMaxActiveBlocksPerMultiprocessor(&per_cu, (const void*)fwd_kernel, NTHREADS, LDS_BYTES) != hipSuccess || per_cu < 1) { fprintf(stderr, "kernel_launch: occupancy query says %d\n", per_cu); }
        (void)hipGetLastError();
        grid = cus;
    }
    if (grid < 0) return;
    if (hipMemsetAsync((char*)d_ws + WS_CTL, 0, CTL_ZERO_BYTES, stream) != hipSuccess) return;
    Args a{};
    for (int i = 0; i < 31; ++i) a.in[i] = (const float*)d_in[i];
    a.out = (float*)d_out; a.ws = (unsigned char*)d_ws;
#if MK_MULTI
    for (int p = 0; p < NPHASES; ++p) { a.ph_lo = p; a.ph_hi = p + 1; a.sub_mask = 31;
        const bool mix = (p == 3 || p == 12);
        if (((MK_REPMASK >> p) & 1) && !mix) { a.sub_mask = 31 | MK_REPSUB; hipLaunchKernelGGL(fwd_kernel, dim3(grid), dim3(NTHREADS), LDS_BYTES, stream, a); a.sub_mask = 31; }
        if (((MK_REPMASK >> p) & 1) && mix) { a.sub_mask = MK_REPSUB; hipLaunchKernelGGL(fwd_kernel, dim3(grid), dim3(NTHREADS), LDS_BYTES, stream, a); a.sub_mask = 31; }
        hipLaunchKernelGGL(fwd_kernel, dim3(grid), dim3(NTHREADS), LDS_BYTES, stream, a); }
#else
    a.ph_lo = 0; a.ph_hi = NPHASES; a.sub_mask = 31;
    hipLaunchKernelGGL(fwd_kernel, dim3(grid), dim3(NTHREADS), LDS_BYTES, stream, a);
#endif
    const hipError_t le = hipPeekAtLastError();
    if (le != hipSuccess) fprintf(stderr, "kernel_launch: launch failed: %s\n", hipGetErrorName(le));
}
```

```cpp
#include <hip/hip_runtime.h>
#include <cstdio>
#include <cstdint>
namespace pg8 {
#define PG8_LAS __attribute__((address_space(3)))
typedef unsigned short bf16_t;
typedef short bf16x8 __attribute__((ext_vector_type(8)));
typedef float f32x4 __attribute__((ext_vector_type(4)));
typedef unsigned u32x4 __attribute__((ext_vector_type(4)));
constexpr int BM = 256, BK = 64, HALF = 128, HTB = HALF * BK * 2  , STAGE_BYTES = 8 * HTB, NXCD = 8, WGM = 8;

__host__ __device__ __forceinline__ int lds_byte(int r, int c) { const int st = (r >> 4) * 2 + (c >> 5), rr = r & 15, cc = c & 31, ob = rr * 64 + cc * 2; return st * 1024 + (ob ^ (((ob >> 9) & 1) << 5)); }
__host__ __device__ __forceinline__ void stage_rc(int b, int& R, int& C) { const int st = b / 1024, sb = b % 1024, swz = sb ^ (((sb >> 9) & 1) << 5); R = (st >> 1) * 16 + swz / 64; C = (st & 1) * 32 + (swz % 64) / 2; }
__host__ __device__ __forceinline__ int perm32(int rho) { const int n = rho >> 4, i = rho & 15; return 8 * (i >> 2) + 4 * n + (i & 3); }

struct Unit { int pm, pn; };
struct Gemm { const bf16_t* A; const bf16_t* Bt; int M, N, K; };

struct StaticOrder {
    int nM, nN, nwg, G, c;
    __host__ __device__ void init(int M, int N, int G_, int c_) { nM = M / BM; nN = N / BM; nwg = nM * nN; G = G_; c = c_; }
    __host__ __device__ bool next(int i, Unit& u) const {
        const long L = (long)i * G + c; if (L >= nwg) return false;
        int wgid = (int)L; { const int q = nwg / NXCD, r = nwg % NXCD, xcd = wgid % NXCD, off = wgid / NXCD; wgid = (xcd < r ? xcd * (q + 1) : r * (q + 1) + (xcd - r) * q) + off; }
        const int nig = WGM * nN, gid = wgid / nig, fm = gid * WGM, gsz = (nM - fm) < WGM ? (nM - fm) : WGM;
        u.pm = fm + ((wgid % nig) % gsz); u.pn = (wgid % nig) / gsz; return true;
    }
    __device__ __forceinline__ void a_ready(const Unit&) const {}
    __device__ __forceinline__ void done(const Unit&) const {}
};

typedef float f32x2_t __attribute__((ext_vector_type(2)));
typedef __bf16 bf16x2_t __attribute__((ext_vector_type(2)));
__device__ __forceinline__ unsigned cvt_pk_bf16(float lo, float hi) { const f32x2_t v = {lo, hi}; const bf16x2_t b = __builtin_convertvector(v, bf16x2_t); return __builtin_bit_cast(unsigned, b); }
__device__ __forceinline__ u32x4 pack8(f32x4 a, f32x4 b) { u32x4 w; w.x = cvt_pk_bf16(a[0], a[1]); w.y = cvt_pk_bf16(a[2], a[3]); w.z = cvt_pk_bf16(b[0], b[1]); w.w = cvt_pk_bf16(b[2], b[3]); return w; }
__device__ __forceinline__ float bf_lo(unsigned w) { return __builtin_bit_cast(float, w << 16); }
__device__ __forceinline__ float bf_hi(unsigned w) { return __builtin_bit_cast(float, w & 0xffff0000u); }
__device__ __forceinline__ void unpack8(u32x4 w, f32x4& a, f32x4& b) { a = (f32x4){bf_lo(w.x), bf_hi(w.x), bf_lo(w.y), bf_hi(w.y)}; b = (f32x4){bf_lo(w.z), bf_hi(w.z), bf_lo(w.w), bf_hi(w.w)}; }
__device__ __forceinline__ float fast_sigmoid(float x) { return __builtin_amdgcn_rcpf(1.0f + __builtin_amdgcn_exp2f(-1.4426950408889634f * x)); }

__device__ __forceinline__ f32x4 vexp2(f32x4 x) { return (f32x4){__builtin_amdgcn_exp2f(x[0]), __builtin_amdgcn_exp2f(x[1]), __builtin_amdgcn_exp2f(x[2]), __builtin_amdgcn_exp2f(x[3])}; }
__device__ __forceinline__ f32x4 vrcp(f32x4 x) { return (f32x4){__builtin_amdgcn_rcpf(x[0]), __builtin_amdgcn_rcpf(x[1]), __builtin_amdgcn_rcpf(x[2]), __builtin_amdgcn_rcpf(x[3])}; }
__device__ __forceinline__ f32x4 vsigmoid(f32x4 x, float k) { return vrcp(vexp2(x * k) + 1.0f); }
struct EpiPlain {
    static constexpr bool PERM = true, AFTER_DRAIN = false, INPLACE = false;
    bf16_t* O; int ldc; int pn_mod; int accum; float scale;
    __device__ __forceinline__ void operator()(const f32x4 (&acc)[2][2][4][2], const Unit& u, int wr, int wc, int fr, int fq) const {
        asm volatile("" : "+v"(fr), "+v"(fq));
        const int pn = pn_mod ? (u.pn % pn_mod) : u.pn;
        const int row0 = u.pm * BM + wr * 64 + fr, col0 = pn * BM + wc * 32 + 8 * fq;
#pragma unroll
        for (int ai = 0; ai < 2; ++ai)
#pragma unroll
            for (int m = 0; m < 4; ++m) { bf16_t* rowp = O + (size_t)(row0 + ai * HALF + m * 16) * ldc + col0;
#pragma unroll
                for (int bj = 0; bj < 2; ++bj) { f32x4 v0 = acc[ai][bj][m][0] * scale, v1 = acc[ai][bj][m][1] * scale;
                    if (accum) { f32x4 p0, p1; unpack8(*(const u32x4*)(rowp + bj * HALF), p0, p1); v0 = v0 + p0; v1 = v1 + p1; }
                    *(u32x4*)(rowp + bj * HALF) = pack8(v0, v1); } }
    }
};
__device__ __forceinline__ unsigned pack_u8x4(float a, float b, float c, float d) {
    unsigned w = 0; w = __builtin_amdgcn_cvt_pk_u8_f32(a, 0, w); w = __builtin_amdgcn_cvt_pk_u8_f32(b, 1, w); w = __builtin_amdgcn_cvt_pk_u8_f32(c, 2, w); w = __builtin_amdgcn_cvt_pk_u8_f32(d, 3, w); return w; }
struct EpiSig {
    static constexpr bool PERM = true, AFTER_DRAIN = false, INPLACE = false;
    unsigned char* O; int ldc; float in_scale;
    __device__ __forceinline__ void operator()(const f32x4 (&acc)[2][2][4][2], const Unit& u, int wr, int wc, int fr, int fq) const {
        const int t = ((wr * 4 + wc) * 4 + fq) * 16 + fr;
        unsigned char* tile = O + ((size_t)u.pm * (ldc / BM) + u.pn) * (BM * BM) + (size_t)t * 16;
        const float k = -1.4426950408889634f * in_scale;
#pragma unroll
        for (int ai = 0; ai < 2; ++ai)
#pragma unroll
            for (int m = 0; m < 4; ++m) { u32x4 w;
                { const f32x4 v0 = vsigmoid(acc[ai][0][m][0], k) * 255.0f, v1 = vsigmoid(acc[ai][0][m][1], k) * 255.0f;
                  w.x = pack_u8x4(fmaxf(v0[0], 1.f), fmaxf(v0[1], 1.f), fmaxf(v0[2], 1.f), fmaxf(v0[3], 1.f)); w.y = pack_u8x4(fmaxf(v1[0], 1.f), fmaxf(v1[1], 1.f), fmaxf(v1[2], 1.f), fmaxf(v1[3], 1.f)); }
                { const f32x4 v0 = vsigmoid(acc[ai][1][m][0], k) * 255.0f, v1 = vsigmoid(acc[ai][1][m][1], k) * 255.0f;
                  w.z = pack_u8x4(fmaxf(v0[0], 1.f), fmaxf(v0[1], 1.f), fmaxf(v0[2], 1.f), fmaxf(v0[3], 1.f)); w.w = pack_u8x4(fmaxf(v1[0], 1.f), fmaxf(v1[1], 1.f), fmaxf(v1[2], 1.f), fmaxf(v1[3], 1.f)); }
                *(u32x4*)(tile + (ai * 4 + m) * (512 * 16)) = w; }
    }
};
struct EpiSwiGLU {
    static constexpr bool PERM = true, AFTER_DRAIN = false, INPLACE = false;
    bf16_t* O; int ldc; int pn_mod; float in_scale = 1.0f;
    __device__ __forceinline__ void operator()(const f32x4 (&acc)[2][2][4][2], const Unit& u, int wr, int wc, int fr, int fq) const {
        const int pn = pn_mod ? (u.pn % pn_mod) : u.pn;
        const int row0 = u.pm * BM + wr * 64 + fr, col0 = pn * HALF + wc * 32 + 8 * fq;
        const float k1 = -1.4426950408889634f * in_scale, k2 = in_scale * in_scale;
#pragma unroll
        for (int ai = 0; ai < 2; ++ai)
#pragma unroll
            for (int m = 0; m < 4; ++m) { bf16_t* rowp = O + (size_t)(row0 + ai * HALF + m * 16) * ldc + col0;
                const f32x4 a0 = acc[ai][0][m][0], a1 = acc[ai][0][m][1], g0 = acc[ai][1][m][0], g1 = acc[ai][1][m][1];
                const f32x4 v0 = ((a0 * g0) * vsigmoid(a0, k1)) * k2, v1 = ((a1 * g1) * vsigmoid(a1, k1)) * k2;
                *(u32x4*)rowp = pack8(v0, v1); }
    }
};
__device__ __forceinline__ unsigned pack_fp8x4(float a, float b, float c, float d) {
    a = __builtin_amdgcn_fmed3f(a, -448.f, 448.f); b = __builtin_amdgcn_fmed3f(b, -448.f, 448.f); c = __builtin_amdgcn_fmed3f(c, -448.f, 448.f); d = __builtin_amdgcn_fmed3f(d, -448.f, 448.f);
    int w = 0; w = __builtin_amdgcn_cvt_pk_fp8_f32(a, b, w, false); w = __builtin_amdgcn_cvt_pk_fp8_f32(c, d, w, true); return (unsigned)w; }
struct EpiSwiGLU8 {
    static constexpr bool PERM = true, AFTER_DRAIN = false, INPLACE = false;
    unsigned char* O; int ldc; int pn_mod; float in_scale, out_scale;
    __device__ __forceinline__ void operator()(const f32x4 (&acc)[2][2][4][2], const Unit& u, int wr, int wc, int fr, int fq) const {
        asm volatile("" : "+v"(fr), "+v"(fq));
        const int pn = pn_mod ? (u.pn % pn_mod) : u.pn;
        const int row0 = u.pm * BM + wr * 64 + fr, col0 = pn * HALF + wc * 32 + 8 * fq;
#pragma unroll
        for (int ai = 0; ai < 2; ++ai)
#pragma unroll
            for (int m = 0; m < 4; ++m) { unsigned char* rowp = O + (size_t)(row0 + ai * HALF + m * 16) * ldc + col0;
                const f32x4 a0 = acc[ai][0][m][0], a1 = acc[ai][0][m][1], g0 = acc[ai][1][m][0], g1 = acc[ai][1][m][1];
                const float k1 = -1.4426950408889634f * in_scale, k2 = in_scale * in_scale * out_scale;
                const f32x4 v0 = ((a0 * g0) * vsigmoid(a0, k1)) * k2, v1 = ((a1 * g1) * vsigmoid(a1, k1)) * k2;
                typedef unsigned u32x2_ __attribute__((ext_vector_type(2)));
                u32x2_ w; w.x = pack_fp8x4(v0[0], v0[1], v0[2], v0[3]); w.y = pack_fp8x4(v1[0], v1[1], v1[2], v1[3]);
                *(u32x2_*)rowp = w; }
    }
};
struct EpiMerge {
    static constexpr bool PERM = true, AFTER_DRAIN = false, INPLACE = true;
    bf16_t* Mo; const unsigned char* Gt; int off0, off1, off2;
    __device__ __forceinline__ static void ub4(unsigned w, f32x4& v) { v = (f32x4){(float)(w & 0xffu), (float)((w >> 8) & 0xffu), (float)((w >> 16) & 0xffu), (float)(w >> 24)}; }
    __device__ __forceinline__ bool inplace(f32x4 (&acc)[2][2][4][2], const Unit& u, int wr, int wc, int fr, int fq) const {
        const int br = u.pn >> 2, pn = u.pn & 3, pm = u.pm - (br < 2 ? off0 + br * (off1 - off0) : off2);
        const int row0 = pm * BM + wr * 64 + fr, col0 = pn * BM + wc * 32 + 8 * fq;
        const int t = ((wr * 4 + wc) * 4 + fq) * 16 + fr;
        const unsigned char* gt = Gt + ((size_t)pm * 12 + br * 4 + pn) * (BM * BM) + (size_t)t * 16;
#pragma unroll
        for (int ai = 0; ai < 2; ++ai)
#pragma unroll
            for (int m = 0; m < 4; ++m) { const size_t row = (size_t)(row0 + ai * HALF + m * 16);
                const u32x4 gq = *(const u32x4*)(gt + (ai * 4 + m) * (512 * 16));
                if (br < 2) { const u32x4 nq = *(const u32x4*)(gt + 4 * (BM * BM) + (ai * 4 + m) * (512 * 16));
#pragma unroll
                    for (int bj = 0; bj < 2; ++bj) { f32x4 g0, g1, n0, n1; ub4(bj ? gq.z : gq.x, g0); ub4(bj ? gq.w : gq.y, g1); ub4(bj ? nq.z : nq.x, n0); ub4(bj ? nq.w : nq.y, n1);
#pragma unroll
                        for (int e = 0; e < 4; ++e) { g0[e] = g0[e] * __builtin_amdgcn_rcpf(n0[e]); g1[e] = g1[e] * __builtin_amdgcn_rcpf(n1[e]); }
                        acc[ai][bj][m][0] = acc[ai][bj][m][0] * g0; acc[ai][bj][m][1] = acc[ai][bj][m][1] * g1; }
                } else {
#pragma unroll
                    for (int bj = 0; bj < 2; ++bj) { f32x4 g0, g1; ub4(bj ? gq.z : gq.x, g0); ub4(bj ? gq.w : gq.y, g1);
                        *(u32x4*)(Mo + row * 1024 + col0 + bj * HALF) = pack8(acc[ai][bj][m][0] * (g0 * (1.0f / 255.0f)), acc[ai][bj][m][1] * (g1 * (1.0f / 255.0f))); }
                } }
        return br < 2;
    }
};
struct EpiQKV {
    static constexpr bool PERM = true, AFTER_DRAIN = false, INPLACE = false;
    bf16_t* O; const float* rope; int row_base; float qscale; float in_scale;
    __device__ __forceinline__ void operator()(const f32x4 (&acc)[2][2][4][2], const Unit& u, int wr, int wc, int fr, int fq) const {
        const int rowt = row_base + u.pm * BM;
        const bool latent = rowt < 65536;
        const int row0 = rowt + wr * 64 + fr, col0 = u.pn * BM + wc * 32 + 8 * fq;
#pragma unroll
        for (int bj = 0; bj < 2; ++bj) {
            const int cb = 2 * u.pn + bj;
            const bool do_rope = latent && (cb == 0 || (cb >= 10 && cb < 14));
            const float sc = (cb >= 10) ? qscale * in_scale : in_scale;
#pragma unroll
            for (int ai = 0; ai < 2; ++ai)
#pragma unroll
                for (int m = 0; m < 4; ++m) {
                    const int row = row0 + ai * HALF + m * 16;
                    f32x4 v0 = acc[ai][bj][m][0], v1 = acc[ai][bj][m][1];
                    if (do_rope) {
                        const int t = row & 2047, pos = (wc & 1) ? (t & 63) : (t >> 6);
                        const float* cp = rope + pos * 16 + 8 * (fq & 1);
                        const f32x4 c0 = *(const f32x4*)cp, c1 = *(const f32x4*)(cp + 4), s0 = *(const f32x4*)(cp + 1024), s1 = *(const f32x4*)(cp + 1028);
                        const float sg = (fq >= 2) ? 1.0f : -1.0f;
                        f32x4 o0, o1;
#pragma unroll
                        for (int e = 0; e < 4; ++e) { o0[e] = __shfl_xor(v0[e], 32); o1[e] = __shfl_xor(v1[e], 32); }
                        v0 = v0 * c0 + (o0 * sg) * s0; v1 = v1 * c1 + (o1 * sg) * s1;
                    }
                    v0 = v0 * sc; v1 = v1 * sc;
                    *(u32x4*)(O + (size_t)row * 2304 + col0 + bj * HALF) = pack8(v0, v1);
                }
        }
    }
};
__device__ __forceinline__ void tile_of(int L, int nM, int nN, int& pm, int& pn) {
    const int nwg = nM * nN; int wgid = L; { const int q = nwg / NXCD, r = nwg % NXCD, xcd = wgid % NXCD, off = wgid / NXCD; wgid = (xcd < r ? xcd * (q + 1) : r * (q + 1) + (xcd - r) * q) + off; }
    const int nig = WGM * nN, gid = wgid / nig, fm = gid * WGM, gsz = (nM - fm) < WGM ? (nM - fm) : WGM;
    pm = fm + ((wgid % nig) % gsz); pn = (wgid % nig) / gsz;
}
struct MergeOrder {
    int nM, G, c, off0, off1, off2;
    __device__ bool next(int i, Unit& u) const {
        const int t = i / 3, br = i - 3 * t; const long L = (long)t * G + c; if (L >= (long)nM * 4) return false;
        int pm, pn; tile_of((int)L, nM, 4, pm, pn); u.pm = (br < 2 ? off0 + br * (off1 - off0) : off2) + pm; u.pn = br * 4 + pn; return true;
    }
    __device__ __forceinline__ void a_ready(const Unit&) const {}
    __device__ __forceinline__ void done(const Unit&) const {}
};
struct GroupOrder {
    int nM, nN, G, c; int toff[9];
    __device__ bool next(int i, Unit& u) const {
        const long L = (long)i * G + c; if (L >= (long)nM * nN) return false;
        int pm, pn; tile_of((int)L, nM, nN, pm, pn); int e = 0;
#pragma unroll
        for (int k = 1; k < 8; ++k) e += (pm >= toff[k]) ? 1 : 0;
        u.pm = pm; u.pn = e * nN + pn; return true;
    }
    __device__ __forceinline__ void a_ready(const Unit&) const {}
    __device__ __forceinline__ void done(const Unit&) const {}
};
template <class Epi, class Sched, bool ALIGN_EPI = false, bool SP2 = false, bool F8 = false>
__device__ __forceinline__ void gemm_phase(PG8_LAS unsigned char* lds, const Gemm g, const Sched& S, const Epi& E, const int tid) {
    const int wid = __builtin_amdgcn_readfirstlane(tid >> 6), lane = tid & 63, wr = wid >> 2, wc = wid & 3, fr = lane & 15, fq = lane >> 4;
    const int K = g.K, nt = K / BK;
    unsigned voffA[2], voffB[2];
#pragma unroll
    for (int i = 0; i < 2; ++i) { int R, C; stage_rc(tid * 16 + i * 8192, R, C); const int Rb = Epi::PERM ? ((R & ~31) + perm32(R & 31)) : R;
        voffA[i] = (unsigned)(R * K + C) * 2u; voffB[i] = (unsigned)(Rb * K + C) * 2u; }
    const size_t kstep = (size_t)(BK * 2);
    const size_t hstep = (size_t)HALF * K * 2;
    const size_t tstep = 2 * hstep;
    const unsigned ldsw = (unsigned)wid * 1024u;
    const int aoff = lds_byte(wr * 64 + fr, fq * 8), boff = lds_byte(wc * 32 + fr, fq * 8);
#define PG8_SA(b, h) (((b) * 2 + (h)) * HTB)
#define PG8_SB(b, h) ((4 + (b) * 2 + (h)) * HTB)
#define PG8_STAGE(bufoff, gbase, voff) do { _Pragma("unroll") for (int _i = 0; _i < 2; ++_i) \
        __builtin_amdgcn_global_load_lds((const unsigned*)((const char*)(gbase) + (voff)[_i]), (PG8_LAS unsigned*)(lds + (bufoff) + ldsw + _i * 8192), 16, 0, 0); } while (0)
#define PG8_LDA(dst, b, h) do { _Pragma("unroll") for (int m = 0; m < 4; ++m) _Pragma("unroll") for (int k = 0; k < 2; ++k) dst[m][k] = *(const PG8_LAS bf16x8*)(lds + PG8_SA(b, h) + aoff + m * 2048 + k * 1024); } while (0)
#define PG8_LDB(dst, b, h) do { _Pragma("unroll") for (int n = 0; n < 2; ++n) _Pragma("unroll") for (int k = 0; k < 2; ++k) dst[n][k] = *(const PG8_LAS bf16x8*)(lds + PG8_SB(b, h) + boff + n * 2048 + k * 1024); } while (0)
#define PG8_MMA(ai, bj, At, Bt) do { __builtin_amdgcn_s_setprio(1); _Pragma("unroll") for (int m = 0; m < 4; ++m) _Pragma("unroll") for (int n = 0; n < 2; ++n) { \
        if constexpr (F8) { typedef int v8i_ __attribute__((ext_vector_type(8))); typedef int v4i_ __attribute__((ext_vector_type(4))); \
            const v4i_ b0_ = __builtin_bit_cast(v4i_, Bt[n][0]), b1_ = __builtin_bit_cast(v4i_, Bt[n][1]), a0_ = __builtin_bit_cast(v4i_, At[m][0]), a1_ = __builtin_bit_cast(v4i_, At[m][1]); \
            const v8i_ bb_ = __builtin_shufflevector(b0_, b1_, 0, 1, 2, 3, 4, 5, 6, 7), aa_ = __builtin_shufflevector(a0_, a1_, 0, 1, 2, 3, 4, 5, 6, 7); \
            asm volatile("v_mfma_scale_f32_16x16x128_f8f6f4 %0, %1, %2, %0, %3, %3 op_sel_hi:[0,0,0]" : "+v"(acc[ai][bj][m][n]) : "v"(bb_), "v"(aa_), "v"(f8_scale_)); } \
        else { _Pragma("unroll") for (int k = 0; k < 2; ++k) acc[ai][bj][m][n] = __builtin_amdgcn_mfma_f32_16x16x32_bf16(Bt[n][k], At[m][k], acc[ai][bj][m][n], 0, 0, 0); } } \
        __builtin_amdgcn_s_setprio(0); } while (0)
#define PG8_WAIT_V(n) asm volatile("s_waitcnt vmcnt(" #n ")" ::: "memory")
#define PG8_WAIT_L(n) asm volatile("s_waitcnt lgkmcnt(" #n ")" ::: "memory")
#define PG8_BAR __builtin_amdgcn_s_barrier()
#define PG8_SCHED __builtin_amdgcn_sched_barrier(0)
    int f8_scale_ = 0x7f7f7f7f; (void)f8_scale_;
    Unit cur, nxt; int ui = 0;
    if (!S.next(0, cur)) return;
    f32x4 acc[2][2][4][2];
#pragma unroll
    for (int a = 0; a < 2; ++a)
#pragma unroll
        for (int b = 0; b < 2; ++b)
#pragma unroll
            for (int m = 0; m < 4; ++m)
#pragma unroll
                for (int n = 0; n < 2; ++n) acc[a][b][m][n] = (f32x4){0.f, 0.f, 0.f, 0.f};
    bf16x8 At[4][2], B0[2][2], B1[2][2];
    const char* cA = (const char*)g.A + (size_t)cur.pm * tstep; const char* cB = (const char*)g.Bt + (size_t)cur.pn * tstep;
    S.a_ready(cur);
    if constexpr (SP2) {
        PG8_STAGE(PG8_SB(0, 0), cB, voffB); PG8_STAGE(PG8_SB(0, 1), cB + hstep, voffB); PG8_STAGE(PG8_SA(0, 0), cA, voffA); PG8_STAGE(PG8_SA(0, 1), cA + hstep, voffA);
        if (wr == 1) PG8_BAR;
        PG8_WAIT_V(2); PG8_BAR;
        PG8_STAGE(PG8_SB(1, 0), cB + kstep, voffB); PG8_STAGE(PG8_SA(1, 0), cA + kstep, voffA); PG8_STAGE(PG8_SB(1, 1), cB + hstep + kstep, voffB);
        PG8_WAIT_V(6); PG8_BAR;
    } else {
        PG8_STAGE(PG8_SB(0, 0), cB, voffB); PG8_STAGE(PG8_SA(0, 0), cA, voffA); PG8_STAGE(PG8_SB(0, 1), cB + hstep, voffB); PG8_STAGE(PG8_SA(0, 1), cA + hstep, voffA);
        if (wr == 1) PG8_BAR;
        PG8_WAIT_V(4); PG8_BAR;
        PG8_STAGE(PG8_SB(1, 0), cB + kstep, voffB); PG8_STAGE(PG8_SA(1, 0), cA + kstep, voffA); PG8_STAGE(PG8_SB(1, 1), cB + hstep + kstep, voffB);
        PG8_WAIT_V(6); PG8_BAR;
    }
    for (;;) {
        const bool has_next = S.next(ui + 1, nxt);
        const char* nA = has_next ? (const char*)g.A + (size_t)nxt.pm * tstep : cA; const char* nB = has_next ? (const char*)g.Bt + (size_t)nxt.pn * tstep : cB;
#pragma unroll 1
        for (int t = 0; t < nt; t += 2) {
            const bool last = (t == nt - 2);
            const char* a1 = cA + (size_t)(t + 1) * kstep;
            const char* a2 = last ? nA : cA + (size_t)(t + 2) * kstep; const char* b2 = last ? nB : cB + (size_t)(t + 2) * kstep;
            const char* a3 = a2 + kstep; const char* b3 = b2 + kstep;
            if (last && has_next) S.a_ready(nxt);
            if constexpr (SP2) {
            PG8_LDB(B0, 0, 0); PG8_LDB(B1, 0, 1); PG8_SCHED; PG8_LDA(At, 0, 0); PG8_STAGE(PG8_SA(1, 1), a1 + hstep, voffA);
            PG8_WAIT_V(8); PG8_WAIT_L(0); PG8_BAR; PG8_MMA(0, 0, At, B0); PG8_MMA(0, 1, At, B1); PG8_BAR; PG8_SCHED;
            PG8_LDA(At, 0, 1); PG8_STAGE(PG8_SB(0, 0), b2, voffB); PG8_STAGE(PG8_SB(0, 1), b2 + hstep, voffB); PG8_STAGE(PG8_SA(0, 0), a2, voffA);
            PG8_WAIT_V(8); PG8_WAIT_L(0); PG8_BAR; PG8_MMA(1, 0, At, B0); PG8_MMA(1, 1, At, B1); PG8_BAR; PG8_SCHED;
            PG8_LDB(B0, 1, 0); PG8_LDB(B1, 1, 1); PG8_SCHED; PG8_LDA(At, 1, 0); PG8_STAGE(PG8_SA(0, 1), a2 + hstep, voffA);
            PG8_WAIT_V(8); PG8_WAIT_L(0); PG8_BAR; PG8_MMA(0, 0, At, B0); PG8_MMA(0, 1, At, B1); PG8_BAR; PG8_SCHED;
            PG8_LDA(At, 1, 1); PG8_STAGE(PG8_SB(1, 0), b3, voffB); PG8_STAGE(PG8_SB(1, 1), b3 + hstep, voffB); PG8_STAGE(PG8_SA(1, 0), a3, voffA);
            PG8_WAIT_V(8); PG8_WAIT_L(0); PG8_BAR; PG8_MMA(1, 0, At, B0); PG8_MMA(1, 1, At, B1); PG8_BAR; PG8_SCHED;
            } else {
            PG8_LDB(B0, 0, 0); PG8_SCHED; PG8_LDA(At, 0, 0); PG8_STAGE(PG8_SA(1, 1), a1 + hstep, voffA);
            PG8_WAIT_L(8); PG8_BAR; PG8_WAIT_L(0); PG8_MMA(0, 0, At, B0); PG8_BAR; PG8_SCHED;
            PG8_LDB(B1, 0, 1); PG8_STAGE(PG8_SB(0, 0), b2, voffB);
            PG8_BAR; PG8_WAIT_L(0); PG8_MMA(0, 1, At, B1); PG8_BAR;
            PG8_LDA(At, 0, 1); PG8_STAGE(PG8_SA(0, 0), a2, voffA);
            PG8_BAR; PG8_WAIT_L(0); PG8_MMA(1, 0, At, B0); PG8_BAR; PG8_SCHED;
            PG8_STAGE(PG8_SB(0, 1), b2 + hstep, voffB);
            PG8_WAIT_V(6); PG8_BAR; PG8_MMA(1, 1, At, B1); PG8_BAR;
            PG8_LDB(B0, 1, 0); PG8_SCHED; PG8_LDA(At, 1, 0); PG8_STAGE(PG8_SA(0, 1), a2 + hstep, voffA);
            PG8_WAIT_L(8); PG8_BAR; PG8_WAIT_L(0); PG8_MMA(0, 0, At, B0); PG8_BAR; PG8_SCHED;
            PG8_LDB(B1, 1, 1); PG8_STAGE(PG8_SB(1, 0), b3, voffB);
            PG8_BAR; PG8_WAIT_L(0); PG8_MMA(0, 1, At, B1); PG8_BAR;
            PG8_LDA(At, 1, 1); PG8_STAGE(PG8_SA(1, 0), a3, voffA);
            PG8_BAR; PG8_WAIT_L(0); PG8_MMA(1, 0, At, B0); PG8_BAR; PG8_SCHED;
            PG8_STAGE(PG8_SB(1, 1), b3 + hstep, voffB);
            PG8_WAIT_V(6); PG8_BAR; PG8_MMA(1, 1, At, B1); PG8_BAR;
            }
        }
        if constexpr (ALIGN_EPI) { if (wr == 0) PG8_BAR; }
        if constexpr (F8) asm volatile("s_nop 15\n\ts_nop 15" ::: "memory");
        bool keep_acc = false;
        if constexpr (Epi::INPLACE) { keep_acc = E.inplace(acc, cur, wr, wc, fr, fq); S.done(cur); }
        else if constexpr (!Epi::AFTER_DRAIN) { E(acc, cur, wr, wc, fr, fq); S.done(cur); }
        if (!has_next) break;
        if (!keep_acc)
#pragma unroll
        for (int a = 0; a < 2; ++a)
#pragma unroll
            for (int b = 0; b < 2; ++b)
#pragma unroll
                for (int m = 0; m < 4; ++m)
#pragma unroll
                    for (int n = 0; n < 2; ++n) acc[a][b][m][n] = (f32x4){0.f, 0.f, 0.f, 0.f};
        cur = nxt; cA = nA; cB = nB; ++ui;
        if constexpr (ALIGN_EPI) { if (wr == 1) PG8_BAR; }
    }
    PG8_WAIT_V(0);
    if constexpr (!ALIGN_EPI) { if (wr == 0) PG8_BAR; }
    PG8_BAR;
    if constexpr (Epi::AFTER_DRAIN) { E.fused(acc, cur, wr, wc, fr, fq, lds, wid, lane); S.done(cur); }
#undef PG8_SA
#undef PG8_SB
#undef PG8_STAGE
#undef PG8_LDA
#undef PG8_LDB
#undef PG8_MMA
#undef PG8_WAIT_V
#undef PG8_WAIT_L
#undef PG8_BAR
#undef PG8_SCHED
}
}
#define GAS __attribute__((address_space(1)))
#define LAS __attribute__((address_space(3)))
typedef unsigned short bf16;
typedef unsigned v4u __attribute__((ext_vector_type(4)));
typedef float f32x4 __attribute__((ext_vector_type(4)));
typedef short bf16x8 __attribute__((ext_vector_type(8)));
typedef GAS unsigned gu32;
typedef GAS unsigned long long gu64;
#define RLX_AGENT __ATOMIC_RELAXED, __HIP_MEMORY_SCOPE_AGENT
#define LDS_WAIT() asm volatile("s_waitcnt lgkmcnt(0)" ::: "memory")
#define VM_WAIT() asm volatile("s_waitcnt vmcnt(0)" ::: "memory")
__device__ __forceinline__ unsigned long long rt() { return __builtin_amdgcn_s_memrealtime(); }
__device__ __forceinline__ unsigned f2bf(float f) { unsigned u = __builtin_bit_cast(unsigned, f); return (u + 0x7fffu + ((u >> 16) & 1u)) >> 16; }
__device__ __forceinline__ unsigned pk2(float lo, float hi) { return pg8::cvt_pk_bf16(lo, hi); }

#define XB_TMO      128
#define XB_XCNT(j)  (256  + 64 * (j))
#define XB_XSUB(j)  (1280 + 64 * (j))
#define XB_XGEN(j)  (2304 + 64 * (j))
#define XB_TOP      3328
#define XB_TOPGEN   3392
#define XCD_BAR_WORDS 3456
#define XB_SPIN_CAP (1u << 18)

__device__ __forceinline__ unsigned xb_ld(unsigned* p)              { return __hip_atomic_load(p, __ATOMIC_RELAXED, __HIP_MEMORY_SCOPE_AGENT); }
__device__ __forceinline__ unsigned xb_add(unsigned* p, unsigned v) { return __hip_atomic_fetch_add(p, v, __ATOMIC_RELAXED, __HIP_MEMORY_SCOPE_AGENT); }
__device__ __forceinline__ unsigned xb_xcc_id() { return (unsigned)__builtin_amdgcn_s_getreg((3 << 11) | 20) & 0xFu; }
#define XB_SPIN(cond, bar) do { unsigned _sp = 0; while (cond) { __builtin_amdgcn_s_sleep(1); \
    if ((++_sp & 255u) == 0u) { if (xb_ld(&(bar)[XB_TMO])) break; if (_sp > XB_SPIN_CAP) { atomicAdd(&(bar)[XB_TMO], 1u); break; } } } } while (0)

struct XcdBarrier {
    unsigned* bar; unsigned x;
    volatile LAS unsigned* st;
};

__device__ __forceinline__ XcdBarrier xcd_barrier_post(unsigned* bar, volatile LAS unsigned* st) {
    XcdBarrier b; b.bar = bar; b.x = xb_xcc_id(); b.st = st;
    if (threadIdx.x == 0) (void)xb_add(&bar[XB_XCNT(b.x)], 1u);
    return b;
}
__device__ __forceinline__ void xcd_barrier_complete(unsigned* bar, unsigned x, unsigned& nloc, unsigned& nx) {
    const unsigned G = gridDim.x * gridDim.y * gridDim.z;
    unsigned sum, cnt, mine, sp = 0u;
    for (;;) {
        sum = 0u; cnt = 0u; mine = 0u;
#pragma unroll
        for (unsigned j = 0; j < 16; ++j) { const unsigned c = xb_ld(&bar[XB_XCNT(j)]); sum += c; cnt += (c > 0u) ? 1u : 0u; mine = (j == x) ? c : mine; }
        if (sum == G) break;
        __builtin_amdgcn_s_sleep(1);
        if ((++sp & 255u) == 0u) { if (xb_ld(&bar[XB_TMO])) break; if (sp > XB_SPIN_CAP) { atomicAdd(&bar[XB_TMO], 1u); break; } }
    }
    nloc = mine > 0u ? mine : 1u; nx = cnt > 0u ? cnt : 1u;
}

__device__ __forceinline__ void xcd_barrier(const XcdBarrier& b) {
    asm volatile("s_waitcnt vmcnt(0)" ::: "memory");
    __syncthreads();
    if (threadIdx.x == 0) {
        unsigned* bar = b.bar;
        __builtin_amdgcn_s_waitcnt(0);
        unsigned nloc = b.st[0], nx = b.st[1];
        if (nloc == 0u) { xcd_barrier_complete(bar, b.x, nloc, nx); b.st[0] = nloc; b.st[1] = nx; }
        const unsigned old = xb_add(&bar[XB_XSUB(b.x)], 1u);
        const unsigned gen = old / nloc;
        if (old + 1u == (gen + 1u) * nloc) {
            __builtin_amdgcn_fence(__ATOMIC_RELEASE, "agent");
            asm volatile("s_waitcnt vmcnt(0)" ::: "memory");
            const unsigned og = xb_add(&bar[XB_TOP], 1u);
            const unsigned tg = og / nx;
            if (og + 1u == (tg + 1u) * nx) xb_add(&bar[XB_TOPGEN], 1u);
            else XB_SPIN(xb_ld(&bar[XB_TOPGEN]) == tg, bar);
            __builtin_amdgcn_fence(__ATOMIC_ACQUIRE, "agent");
            xb_add(&bar[XB_XGEN(b.x)], 1u);
            asm volatile("s_waitcnt vmcnt(0)" ::: "memory");
        } else {
            XB_SPIN(xb_ld(&bar[XB_XGEN(b.x)]) == gen, bar);
            __builtin_amdgcn_fence(__ATOMIC_ACQUIRE, "agent");
            asm volatile("s_waitcnt vmcnt(0)" ::: "memory");
        }
    }
    __syncthreads();
}

typedef float f32x16 __attribute__((ext_vector_type(16)));
typedef short s16x4 __attribute__((ext_vector_type(4)));
typedef unsigned v2u __attribute__((ext_vector_type(2)));
#define MFMA32(a, b, c) __builtin_amdgcn_mfma_f32_32x32x16_bf16((a), (b), (c), 0, 0, 0)

constexpr int NWAVES = 8, NTHREADS = 512;
constexpr int D = 1024, NB = 32, SEQ = 2048, LC = 256, NTOK = NB * SEQ, NCTX = NB * LC, NROW = NTOK + NCTX;
constexpr int INC = 6912, QKVC = 2304, CINC = 1536, GATEC = 3072, DFF = 2816, NEXP = 8, DFFE = 3584, FCH = 1792;
#ifndef MK_FFN2_F8
#define MK_FFN2_F8 1
#endif
constexpr float W13_SCALE = 32.f, W2_SCALE = 64.f, HID_SCALE = 4.f;
constexpr float LOG2E = 1.4426950408889634f, QSCALE = 0.125f * LOG2E, EPS = 1e-6f;
constexpr int HALF0_TOK = 33792, HALF1_TOK = NTOK - HALF0_TOK;
constexpr int LCAP = HALF0_TOK;
constexpr int PCAP = HALF0_TOK * 2 + 8 * 256;

constexpr size_t MiB = 1u << 20;
constexpr size_t WS_CTL = 0, CTL_ZERO_BYTES = 1 * MiB;
constexpr size_t WS_MODV = 1 * MiB;
constexpr size_t WS_ROPE = 3 * MiB;
constexpr size_t WS_ROUTE = 4 * MiB;
constexpr size_t WS_LIST = 5 * MiB;
constexpr size_t WS_INV = 7 * MiB + 256 * 1024;
constexpr size_t WS_GF = 8 * MiB;
constexpr size_t WS_GFC = 24 * MiB;
constexpr size_t WS_W = 26 * MiB;
constexpr size_t W_IN = WS_W;
constexpr size_t W_CB = W_IN + (size_t)2 * INC * D;
constexpr size_t W_BR = W_IN + (size_t)2 * INC * D * 2;
constexpr size_t W_OUT = W_BR + (size_t)2 * 3 * D * 512 * 2;
constexpr size_t W_F13 = W_OUT + (size_t)2 * D * D * 2;
constexpr size_t W_F2 = W_F13 + (size_t)2 * DFF * D * 2;
constexpr size_t W_END = W_F2 + (size_t)D * DFF * 2;
constexpr size_t WS_CTXRES = 80 * MiB;
constexpr size_t WS_XB = 112 * MiB;
constexpr size_t WS_BIG = 256 * MiB;
constexpr size_t BIG_CINT = WS_BIG;
constexpr size_t BIG_QKV = WS_BIG + 216 * MiB;
constexpr size_t BIG_GATE = WS_BIG + 72 * MiB;
constexpr size_t BIG_YCT = WS_BIG + 288 * MiB;
constexpr size_t BIG_HID = WS_BIG;
constexpr size_t BIG_RAW = WS_BIG;
constexpr size_t BIG_AS = WS_BIG;
constexpr size_t BIG_MH = WS_BIG + 68 * MiB;
constexpr size_t BIG_Y2S = WS_BIG + 308 * MiB;
constexpr size_t WS_Y3 = 796 * MiB;
constexpr size_t WM_13 = WS_Y3;
constexpr size_t WM_2 = WS_Y3 + 56 * MiB;
constexpr size_t WS_H8 = WS_Y3 + 144 * MiB;
constexpr size_t WS_END = 1012 * MiB;
static_assert(W_END <= WS_CTXRES && BIG_Y2S + (size_t)PCAP * D * 2 <= WS_Y3 && BIG_QKV + (size_t)NROW * QKVC * 2 <= WS_Y3 && BIG_GATE + (size_t)NROW * GATEC <= WS_Y3, "ws map");
static_assert(WS_LIST + (size_t)2 * 8 * LCAP * 4 <= WS_INV && HALF0_TOK % 256 == 0 && HALF1_TOK % 256 == 0 && HALF1_TOK * 2 + 8 * 256 <= 65536, "MoE halves");
static_assert(BIG_MH + (size_t)PCAP * DFFE <= BIG_Y2S && BIG_AS + (size_t)PCAP * D <= BIG_MH && WM_13 + (size_t)8 * 2 * DFFE * D <= WM_2 && WM_2 + (size_t)8 * D * DFFE <= WS_END, "ws map 2");

constexpr int CW_BAR = 4096;
constexpr int CW_CNT = 16384;

constexpr int LDS_BYTES = 150528, MISC_OFF = 147456;


struct Args {
    const float* in[31];
    float* out; unsigned char* ws;
    int ph_lo, ph_hi, sub_mask, pad;
};
enum { I_X = 0, I_C, I_CTX, I_CCTX, I_WMOD, I_BMOD, I_GMIXPRE, I_GMIXPOST, I_GFFNPRE, I_GFFNPOST, I_WIN, I_SINK, I_RPB, I_CONVW, I_CONVB, I_HW1, I_HB1, I_HW2, I_HB2, I_HW3,
       I_HFREQ, I_HBIAS, I_WBR, I_WOUT, I_FW1, I_FW3, I_FW2, I_ROUTER, I_MW1, I_MW3, I_MW2 };

struct Frame {
    LAS unsigned char* lds;
    int tid, lane, wave, vcu, G;
    unsigned char* ws;
    bf16* hb;
};

__device__ __forceinline__ float wave_sum(float v) {
#define WS_DPP(ctrl, rmask, bc) v += __builtin_bit_cast(float, __builtin_amdgcn_update_dpp(0, __builtin_bit_cast(int, v), ctrl, rmask, 0xf, bc))
    WS_DPP(0x111, 0xf, true); WS_DPP(0x112, 0xf, true); WS_DPP(0x114, 0xf, true); WS_DPP(0x118, 0xf, true);
    WS_DPP(0x142, 0xa, false); WS_DPP(0x143, 0xc, false);
#undef WS_DPP
    return __builtin_bit_cast(float, __builtin_amdgcn_readlane(__builtin_bit_cast(int, v), 63));
}
__device__ __forceinline__ float bf2f(bf16 b) { return __builtin_bit_cast(float, ((unsigned)b) << 16); }
__device__ __forceinline__ float silu_f(float x) { return x / (1.0f + __expf(-x)); }

__device__ __forceinline__ void transpose_item(const float* W, int N, bf16* WT, int Kp, int k0, int n0, int drow0, LAS float* scr, int lane) {
    { const int c4 = 4 * (lane & 7);
#pragma unroll
      for (int i = 0; i < 8; ++i) { const int kk = (lane >> 3) + 8 * i; const f32x4 v = *(const f32x4*)(W + (size_t)(k0 + kk) * N + n0 + c4); LAS float* d = scr + kk * 33 + c4; d[0] = v.x; d[1] = v.y; d[2] = v.z; d[3] = v.w; } }
    LDS_WAIT(); asm volatile("" ::: "memory");
    const int c = lane & 7;
#pragma unroll
    for (int j = 0; j < 4; ++j) { const int n = (lane >> 3) + 8 * j; const LAS float* s = scr + (8 * c) * 33 + n;
        v4u o; o.x = pk2(s[0 * 33], s[1 * 33]); o.y = pk2(s[2 * 33], s[3 * 33]); o.z = pk2(s[4 * 33], s[5 * 33]); o.w = pk2(s[6 * 33], s[7 * 33]);
        *(GAS v4u*)(WT + (size_t)(drow0 + n) * Kp + k0 + 8 * c) = o; }
    LDS_WAIT(); asm volatile("" ::: "memory");
}
__device__ __forceinline__ bool conv_job(int& r, const float* W, int K, int N, bf16* WT, int Kp, int rowoff, int mode, int which, LAS float* scr, int lane) {
    const int nblk = N / 32, items = (K / 64) * nblk;
    if (r >= items) { r -= items; return false; }
    const int kb = r / nblk, nb = r % nblk, n0 = 32 * nb;
    const int drow0 = mode ? rowoff + (n0 / 128) * 256 + which * 128 + (n0 % 128) : rowoff + n0;
    transpose_item(W, N, WT, Kp, 64 * kb, n0, drow0, scr, lane);
    return true;
}

__device__ __forceinline__ void transpose_item_f8(const float* W, int N, unsigned char* WT, int Kp, int k0, int n0, int drow0, float scale, LAS float* scr, int lane) {
    { const int c4 = 4 * (lane & 7);
#pragma unroll
      for (int i = 0; i < 8; ++i) { const int kk = (lane >> 3) + 8 * i; const f32x4 v = *(const f32x4*)(W + (size_t)(k0 + kk) * N + n0 + c4) * scale; LAS float* d = scr + kk * 33 + c4; d[0] = v.x; d[1] = v.y; d[2] = v.z; d[3] = v.w; } }
    LDS_WAIT(); asm volatile("" ::: "memory");
    const int c = lane & 7;
#pragma unroll
    for (int j = 0; j < 4; ++j) { const int n = (lane >> 3) + 8 * j; const LAS float* s = scr + (8 * c) * 33 + n;
        v2u o; o.x = pg8::pack_fp8x4(s[0 * 33], s[1 * 33], s[2 * 33], s[3 * 33]); o.y = pg8::pack_fp8x4(s[4 * 33], s[5 * 33], s[6 * 33], s[7 * 33]);
        *(GAS v2u*)(WT + (size_t)(drow0 + n) * Kp + k0 + 8 * c) = o; }
    LDS_WAIT(); asm volatile("" ::: "memory");
}
__device__ __forceinline__ bool conv_job_f8(int& r, const float* W, int K, int N, unsigned char* WT, int Kp, int mode, int which, float scale, LAS float* scr, int lane) {
    const int nblk = N / 32, items = (K / 64) * nblk;
    if (r >= items) { r -= items; return false; }
    const int kb = r / nblk, nb = r % nblk, n0 = 32 * nb;
    const int drow0 = mode ? (n0 / 128) * 256 + which * 128 + (n0 % 128) : n0;
    transpose_item_f8(W, N, WT, Kp, 64 * kb, n0, drow0, scale, scr, lane);
    return true;
}

__device__ __forceinline__ void ld_row_f32(const float* p, int lane, f32x4 (&v)[4]) {
    const GAS f32x4* q = (const GAS f32x4*)p + lane;
#pragma unroll
    for (int j = 0; j < 4; ++j) v[j] = q[64 * j];
}
__device__ __forceinline__ void st_row_f32(float* p, int lane, const f32x4 (&v)[4]) {
    GAS f32x4* q = (GAS f32x4*)p + lane;
#pragma unroll
    for (int j = 0; j < 4; ++j) q[64 * j] = v[j];
}
__device__ __forceinline__ void ld_row_bf16(const bf16* p, int lane, f32x4 (&v)[4]) {
    const GAS v2u* q = (const GAS v2u*)p + lane;
#pragma unroll
    for (int j = 0; j < 4; ++j) { const v2u w = q[64 * j]; v[j] = (f32x4){pg8::bf_lo(w.x), pg8::bf_hi(w.x), pg8::bf_lo(w.y), pg8::bf_hi(w.y)}; }
}
__device__ __forceinline__ void ld_row_f32_nt(const float* p, int lane, f32x4 (&v)[4]) {
    const GAS f32x4* q = (const GAS f32x4*)p + lane;
#pragma unroll
    for (int j = 0; j < 4; ++j) v[j] = __builtin_nontemporal_load(q + 64 * j);
}
__device__ __forceinline__ void st_row_f32_nt(float* p, int lane, const f32x4 (&v)[4]) {
    GAS f32x4* q = (GAS f32x4*)p + lane;
#pragma unroll
    for (int j = 0; j < 4; ++j) __builtin_nontemporal_store(v[j], q + 64 * j);
}
__device__ __forceinline__ void ld_raw_bf16_nt(const bf16* p, int lane, v2u (&v)[4]) {
    const GAS v2u* q = (const GAS v2u*)p + lane;
#pragma unroll
    for (int j = 0; j < 4; ++j) v[j] = __builtin_nontemporal_load(q + 64 * j);
}
__device__ __forceinline__ void ld_raw_bf16(const bf16* p, int lane, v2u (&v)[4]) {
    const GAS v2u* q = (const GAS v2u*)p + lane;
#pragma unroll
    for (int j = 0; j < 4; ++j) v[j] = q[64 * j];
}
__device__ __forceinline__ f32x4 cvt_raw_bf16(v2u w) { return (f32x4){pg8::bf_lo(w.x), pg8::bf_hi(w.x), pg8::bf_lo(w.y), pg8::bf_hi(w.y)}; }
__device__ __forceinline__ void st_row_bf16(bf16* p, int lane, const f32x4 (&v)[4]) {
    GAS v2u* q = (GAS v2u*)p + lane;
#pragma unroll
    for (int j = 0; j < 4; ++j) { v2u w; w.x = pk2(v[j].x, v[j].y); w.y = pk2(v[j].z, v[j].w); q[64 * j] = w; }
}
__device__ __forceinline__ float row_rms_scale(const f32x4 (&v)[4]) {
    float s = 0.f;
#pragma unroll
    for (int j = 0; j < 4; ++j) s += (v[j].x * v[j].x + v[j].y * v[j].y) + (v[j].z * v[j].z + v[j].w * v[j].w);
    return __builtin_amdgcn_rsqf(wave_sum(s) * (1.0f / D) + EPS);
}
__device__ __forceinline__ void norm_mod(const f32x4 (&x)[4], const float* g, const float* sc, const float* sh, int lane, f32x4 (&h)[4]) {
    const float rs = row_rms_scale(x);
    f32x4 gv[4], scv[4], shv[4]; ld_row_f32(g, lane, gv); ld_row_f32(sc, lane, scv); ld_row_f32(sh, lane, shv);
#pragma unroll
    for (int j = 0; j < 4; ++j) h[j] = (x[j] * rs) * gv[j] * (scv[j] + 1.0f) + shv[j];
}
__device__ __forceinline__ void resid_update(f32x4 (&x)[4], const f32x4 (&y)[4], const float* g, const float* gt, int lane) {
    const float rs = row_rms_scale(y);
    f32x4 gv[4], gtv[4]; ld_row_f32(g, lane, gv); ld_row_f32(gt, lane, gtv);
#pragma unroll
    for (int j = 0; j < 4; ++j) x[j] = x[j] + gtv[j] * ((y[j] * rs) * gv[j]);
}
__device__ __forceinline__ const float* modv(const Frame& F, int l, int row, int part) {
    const int r = row < NTOK ? (row >> 11) : 32;
    return (const float*)(F.ws + WS_MODV) + ((size_t)l * 33 + r) * 6144 + part * 1024;
}

__device__ __forceinline__ void p0_prologue(Frame& F, const Args& a) {
    const int gw = F.vcu * NWAVES + F.wave, NGW = F.G * NWAVES;
    if (F.vcu < 192) {
        LAS float* sl = (LAS float*)F.lds;
#pragma unroll 11
        for (int i = F.tid; i < 33 * 1024; i += NTHREADS) { const int r = i >> 10, k = i & 1023; const float cv = r < 32 ? a.in[I_C][r * 1024 + k] : a.in[I_CCTX][k]; sl[k * 33 + r] = silu_f(cv); }
        __syncthreads();
        const int col = F.vcu * 64 + F.lane, l = col / 6144, n = col % 6144, k0 = F.wave * 128;
        const float* w = a.in[I_WMOD] + ((size_t)l * 1024 + k0) * 6144 + n;
        float acc[33];
#pragma unroll
        for (int r = 0; r < 33; ++r) acc[r] = 0.f;
#pragma unroll 1
        for (int kb = 0; kb < 128; kb += 8) {
            float wv[8];
#pragma unroll
            for (int k = 0; k < 8; ++k) wv[k] = w[(size_t)(kb + k) * 6144];
#pragma unroll
            for (int k = 0; k < 8; ++k) { const LAS float* sr = sl + (k0 + kb + k) * 33;
#pragma unroll
                for (int r = 0; r < 33; ++r) acc[r] += sr[r] * wv[k]; } }
        __syncthreads();
#pragma unroll
        for (int r = 0; r < 33; ++r) sl[(F.wave * 33 + r) * 64 + F.lane] = acc[r];
        __syncthreads();
        const float* bmod = a.in[I_BMOD]; float* mo = (float*)(F.ws + WS_MODV);
        for (int o = F.tid; o < 33 * 64; o += NTHREADS) { const int r = o >> 6, j = o & 63; float s = 0.f;
#pragma unroll
            for (int wv = 0; wv < 8; ++wv) s += sl[(wv * 33 + r) * 64 + j];
            const int cc = F.vcu * 64 + j, ll = cc / 6144, nn = cc % 6144; mo[((size_t)ll * 33 + r) * 6144 + nn] = s + bmod[ll * 6144 + nn]; }
        __syncthreads();
    }
    if (F.vcu == 200) {
        float* rp = (float*)(F.ws + WS_ROPE);
        for (int i = F.tid; i < 1024; i += NTHREADS) { const int pos = i >> 4, k = i & 15; const float inv = powf(10000.0f, -(float)k / 16.0f); const float ang = (float)pos * inv; rp[i] = cosf(ang); rp[1024 + i] = sinf(ang); }
    }
    for (int it = F.vcu; it < 512; it += F.G) {
        const int lv = it >> 8, l = lv ? 0 : ((it >> 7) & 1), L = lv ? LC : SEQ, pos0 = lv ? (it & 255) : 16 * (it & 127), npos = lv ? 1 : 16;
        LAS float* z = (LAS float*)F.lds; LAS float* h1 = z + 16 * 33; LAS float* h2 = h1 + 16 * 64;
        __syncthreads();
        for (int i = F.tid; i < 16 * 33; i += NTHREADS) { const int p = i / 33, k = i % 33; const int pos = pos0 + p; float v;
            const float om = 6.283185307179586f * (float)pos / (float)L;
            if (k == 0) v = (float)pos / (float)(L - 1);
            else { const int m = (k - 1) & 15; const float f = 1e-4f + (15.0f - 1e-4f) * (float)m / 15.0f; v = (k <= 16) ? cosf(f * om) : -sinf(f * om); }
            z[i] = v; }
        __syncthreads();
        const float* w1 = a.in[I_HW1] + l * 33 * 64; const float* b1 = a.in[I_HB1] + l * 64; const float* w2 = a.in[I_HW2] + l * 64 * 64; const float* b2 = a.in[I_HB2] + l * 64;
        const float* fr = a.in[I_HFREQ] + l * 64; const float* w3 = a.in[I_HW3] + (size_t)l * 64 * 2048;
        for (int o = F.tid; o < 1024; o += NTHREADS) { const int p = o >> 6, j = o & 63; float s = b1[j];
#pragma unroll
            for (int k = 0; k < 33; ++k) s += z[p * 33 + k] * w1[k * 64 + j];
            h1[o] = sinf(fr[j] * s); }
        __syncthreads();
        for (int o = F.tid; o < 1024; o += NTHREADS) { const int p = o >> 6, j = o & 63; float s = b2[j];
#pragma unroll 16
            for (int k = 0; k < 64; ++k) s += h1[p * 64 + k] * w2[k * 64 + j];
            h2[o] = sinf(fr[j] * s); }
        __syncthreads();
        float* raw = (float*)(F.ws + BIG_RAW) + (size_t)l * (2048 * (SEQ + LC)) + (lv ? (size_t)2048 * SEQ : 0);
        {
            const int col0 = 4 * F.tid;
            float acc[4][16];
#pragma unroll
            for (int c4 = 0; c4 < 4; ++c4)
#pragma unroll
                for (int p = 0; p < 16; ++p) acc[c4][p] = 0.f;
#pragma unroll 4
            for (int k = 0; k < 64; ++k) { const f32x4 wv = *(const f32x4*)(w3 + k * 2048 + col0);
#pragma unroll
                for (int p = 0; p < 16; ++p) { const float hv = h2[p * 64 + k]; acc[0][p] += hv * wv.x; acc[1][p] += hv * wv.y; acc[2][p] += hv * wv.z; acc[3][p] += hv * wv.w; } }
            const float da = -3.0701134573253945f, db = -15.350567286626973f;
#pragma unroll
            for (int c4 = 0; c4 < 4; ++c4) { const int col = col0 + c4, cch = col & 511;
                const float delta = fabsf(da + (db - da) * (float)cch / 511.0f);
#pragma unroll
                for (int p = 0; p < 16; ++p) if (p < npos) { const float t = (float)(pos0 + p) / (float)(L - 1); raw[(size_t)col * L + pos0 + p] = acc[c4][p] * __expf(-t * delta); } }
        }
    }
    __syncthreads();
    LAS float* scr = (LAS float*)(F.lds + F.wave * 16384);
    constexpr int PER_LAYER = 16 * 216 + 16 * 48 + 3 * 256 + 512, NITEMS = 2 * PER_LAYER + 3 * 1408;
    for (int it = gw; it < NITEMS; it += NGW) {
        int r = it;
        bool dn = false;
#pragma unroll 1
        for (int l = 0; l < 2; ++l) {
            if (!dn) dn = conv_job_f8(r, a.in[I_WIN] + (size_t)l * D * INC, D, INC, F.ws + W_IN + (size_t)l * INC * D, D, 0, 0, W13_SCALE, scr, F.lane);
            if (!dn) { const int items = 16 * 48;
                if (r < items) { const int kb = r / 48, nb = r % 48; transpose_item(a.in[I_WIN] + (size_t)l * D * INC + QKVC, INC, (bf16*)(F.ws + W_CB) + (size_t)l * CINC * D, D, 64 * kb, 32 * nb, 32 * nb, scr, F.lane); dn = true; } else r -= items; }
#pragma unroll 1
            for (int br = 0; br < 3; ++br)
                if (!dn) dn = conv_job(r, a.in[I_WBR] + (size_t)(l * 3 + br) * 512 * D, 512, D, (bf16*)(F.ws + W_BR) + (size_t)(l * 3 + br) * D * 512, 512, 0, 0, 0, scr, F.lane);
            if (!dn) dn = conv_job(r, a.in[I_WOUT] + (size_t)l * D * D, D, D, (bf16*)(F.ws + W_OUT) + (size_t)l * D * D, D, 0, 0, 0, scr, F.lane);
        }
        if (!dn) dn = conv_job_f8(r, a.in[I_FW1], D, DFF, F.ws + W_F13, D, 1, 0, W13_SCALE, scr, F.lane);
        if (!dn) dn = conv_job_f8(r, a.in[I_FW3], D, DFF, F.ws + W_F13, D, 1, 1, W13_SCALE, scr, F.lane);
#if MK_FFN2_F8
        if (!dn) dn = conv_job_f8(r, a.in[I_FW2], DFF, D, F.ws + W_F2, DFF, 0, 0, W2_SCALE, scr, F.lane);
#else
        if (!dn) dn = conv_job(r, a.in[I_FW2], DFF, D, (bf16*)(F.ws + W_F2), DFF, 0, 0, 0, scr, F.lane);
#endif
    }
}

__device__ __forceinline__ void p1_phase(Frame& F, const Args& a) {
    const int gw = F.vcu * NWAVES + F.wave, NGW = F.G * NWAVES;
    for (int u = gw; u < 2 * 2 * 1024; u += NGW) {
        const int l = u >> 11, lv = (u >> 10) & 1, o = (u >> 9) & 1, c = u & 511, L = lv ? LC : SEQ;
        if (l == 1 && lv == 1) continue;
        const float* raw = (const float*)(F.ws + BIG_RAW) + (size_t)l * (2048 * (SEQ + LC)) + (lv ? (size_t)2048 * SEQ : 0);
        const float* rf = raw + (size_t)(o * 512 + c) * L; const float* rb = raw + (size_t)(1024 + o * 512 + c) * L;
        float sf = 0.f, sb = 0.f;
#pragma unroll 8
        for (int t = F.lane; t < L; t += 64) { const float x = rf[t], y = rb[t]; sf += x * x; sb += y * y; }
        const float nf = 1.0f / sqrtf(wave_sum(sf) + EPS), nb = 1.0f / sqrtf(wave_sum(sb) + EPS);
        bf16* g = lv ? (bf16*)(F.ws + WS_GFC) + ((size_t)(l * 2 + o) * 512 + c) * (2 * LC) : (bf16*)(F.ws + WS_GF) + ((size_t)(l * 2 + o) * 512 + c) * (2 * SEQ);
#pragma unroll 8
        for (int i = F.lane; i < 2 * L; i += 64) { const int d = i - L; float v;
            if (i == 0) v = 0.f; else if (d > 0) v = rf[d] * nf; else if (d < 0) v = rb[-d] * nb; else v = rf[0] * nf + rb[0] * nb;
            g[i] = (bf16)f2bf(v); }
    }
}

constexpr float ATT_THR = 8.0f;
constexpr int ATT_KP = 144, ATT_VP = 136;
constexpr int ATT_K_OFF = 0, ATT_V_OFF = 64 * ATT_KP, ATT_BUF = 17920, ATT_RPB_OFF = 36864;
constexpr int ATT_T0_BYTES = 15 * 128 * 4, ATT_E_OFF = ATT_RPB_OFF + ATT_T0_BYTES, ATT_TBL_FLOATS = 15 * 128 + 15 * 15 * 64;
__device__ __forceinline__ int crow(int reg, int h) { return (reg & 3) + 8 * (reg >> 2) + 4 * h; }
__device__ __forceinline__ int rs_of(int r) { const int v = r - 4; return v < 0 ? 0 : (v > 24 ? 24 : v); }
__device__ __forceinline__ unsigned cvtpk(float lo, float hi) { return pk2(lo, hi); }

template <int MODE, int SUB>
__device__ __forceinline__ void att_tile(LAS unsigned char* lds, int boff, const bf16x8 (&qf)[4], f32x16& negm, f32x16& O0, f32x16& O1, float& m_run, float& l_run,
                                         bool is_local, bool edge_mask, int kbase, int qt, int kr, int gr, int tb_base, int tb_pitch, int r, int h) {
#define A0(i) (SUB != 2 || (i) >= 12)
#define A1(i) (SUB != 1 || (i) < 4)
    f32x16 s0 = negm, s1 = negm;
#pragma unroll
    for (int s = 0; s < 4; ++s) {
        const bf16x8 k0 = *(const LAS bf16x8*)(lds + boff + ATT_K_OFF + r * ATT_KP + (16 * s + 8 * h) * 2);
        const bf16x8 k1 = *(const LAS bf16x8*)(lds + boff + ATT_K_OFF + (32 + r) * ATT_KP + (16 * s + 8 * h) * 2);
        s0 = MFMA32(k0, qf[s], s0); s1 = MFMA32(k1, qf[s], s1);
    }
    if (MODE == 0 && edge_mask) {
#pragma unroll
        for (int i = 0; i < 16; ++i) { const int j0 = kbase + crow(i, h), d0 = qt - j0, d1 = d0 - 32;
            if (d0 > 128 || d0 < -128) s0[i] = -1e30f;
            if (d1 > 128 || d1 < -128) s1[i] = -1e30f; }
    }
    if (MODE == 1 && is_local) {
        const LAS float* tb = (const LAS float*)(lds + tb_base + (kr - gr + 7) * tb_pitch);
        float b0[16], b1[16];
#pragma unroll
        for (int i = 0; i < 16; ++i) { const int c = (i & 3) + 8 * (i >> 2); if (A0(i)) b0[i] = tb[c]; if (A1(i)) b1[i] = tb[c + 32]; }
#pragma unroll
        for (int i = 0; i < 16; ++i) { if (A0(i)) s0[i] += b0[i]; if (A1(i)) s1[i] += b1[i]; }
    }
    float mx = -1e30f;
#pragma unroll
    for (int i = 0; i < 16; ++i) { if (A0(i)) mx = fmaxf(mx, s0[i]); if (A1(i)) mx = fmaxf(mx, s1[i]); }
    mx = fmaxf(mx, __shfl_xor(mx, 32));
    if (!__all(mx <= ATT_THR)) {
        const float delta = fmaxf(mx, 0.f), alpha = __builtin_amdgcn_exp2f(-delta);
        m_run += delta; l_run *= alpha;
#pragma unroll
        for (int i = 0; i < 16; ++i) { O0[i] *= alpha; O1[i] *= alpha; s0[i] -= delta; s1[i] -= delta; negm[i] = -m_run; }
    }
    float ls = 0.f;
#pragma unroll
    for (int i = 0; i < 16; ++i) { if (A0(i)) { s0[i] = __builtin_amdgcn_exp2f(s0[i]); ls += s0[i]; } else s0[i] = 0.f;
                                   if (A1(i)) { s1[i] = __builtin_amdgcn_exp2f(s1[i]); ls += s1[i]; } else s1[i] = 0.f; }
    l_run += ls;
    bf16x8 pf[2][2];
    { v4u t;
      t.x = cvtpk(s0[0], s0[1]); t.y = cvtpk(s0[2], s0[3]); t.z = cvtpk(s0[4], s0[5]); t.w = cvtpk(s0[6], s0[7]); pf[0][0] = __builtin_bit_cast(bf16x8, t);
      t.x = cvtpk(s0[8], s0[9]); t.y = cvtpk(s0[10], s0[11]); t.z = cvtpk(s0[12], s0[13]); t.w = cvtpk(s0[14], s0[15]); pf[0][1] = __builtin_bit_cast(bf16x8, t);
      t.x = cvtpk(s1[0], s1[1]); t.y = cvtpk(s1[2], s1[3]); t.z = cvtpk(s1[4], s1[5]); t.w = cvtpk(s1[6], s1[7]); pf[1][0] = __builtin_bit_cast(bf16x8, t);
      t.x = cvtpk(s1[8], s1[9]); t.y = cvtpk(s1[10], s1[11]); t.z = cvtpk(s1[12], s1[13]); t.w = cvtpk(s1[14], s1[15]); pf[1][1] = __builtin_bit_cast(bf16x8, t); }
#pragma unroll
    for (int i = 0; i < 2; ++i)
#pragma unroll
        for (int sp = 0; sp < 2; ++sp) {
            if ((SUB == 1 && i == 1 && sp == 1) || (SUB == 2 && i == 0 && sp == 0)) continue;
            const int koff = (32 * i + 16 * sp + 4 * h) * 2;
            const v2u a0 = *(const LAS v2u*)(lds + boff + ATT_V_OFF + r * ATT_VP + koff), a1 = *(const LAS v2u*)(lds + boff + ATT_V_OFF + r * ATT_VP + koff + 16);
            const v2u c0 = *(const LAS v2u*)(lds + boff + ATT_V_OFF + (32 + r) * ATT_VP + koff), c1 = *(const LAS v2u*)(lds + boff + ATT_V_OFF + (32 + r) * ATT_VP + koff + 16);
            const v4u va = (v4u){a0.x, a0.y, a1.x, a1.y}, vc = (v4u){c0.x, c0.y, c1.x, c1.y};
            O0 = MFMA32(__builtin_bit_cast(bf16x8, va), pf[i][sp], O0);
            O1 = MFMA32(__builtin_bit_cast(bf16x8, vc), pf[i][sp], O1);
        }
#undef A0
#undef A1
}

struct AttPre { v4u k, v; int valid; };
template <int MODE>
__device__ __forceinline__ void att_start(int u, int w, int r, int& qrow, int& qcol, int& kcol, int& vcol, int& trow0) {
    int b, head, kvh, q0 = 0, R = 0;
    if (MODE == 0) { b = u >> 6; kvh = (u >> 5) & 1; q0 = (u & 31) * 64; head = 4 * kvh + (w >> 1); }
    else if (MODE == 1) { b = u >> 6; head = (u >> 3) & 7; kvh = head; R = u & 7; }
    else if (MODE == 2) { b = u >> 3; kvh = (u >> 2) & 1; q0 = (u & 3) * 64; head = 4 * kvh + (w >> 1); }
    else { b = u >> 3; head = u & 7; kvh = head; }
    if (MODE == 0) qrow = b * SEQ + q0 + 32 * (w & 1) + r;
    else if (MODE == 1) qrow = b * SEQ + (4 * R + (w >> 1)) * 64 + 32 * (w & 1) + r;
    else if (MODE == 2) qrow = NTOK + b * LC + q0 + 32 * (w & 1) + r;
    else qrow = NTOK + b * LC + 32 * w + r;
    qcol = (MODE == 0 || MODE == 2) ? 1280 + head * 64 : 1792 + head * 64;
    kcol = (MODE == 0 || MODE == 2) ? kvh * 64 : 256 + head * 64;
    vcol = (MODE == 0 || MODE == 2) ? 128 + kvh * 64 : 768 + head * 64;
    if (MODE == 0) { const int lo = q0 < 128 ? (128 - q0) / 64 : 0; trow0 = b * SEQ + q0 - 128 + 64 * lo; }
    else if (MODE == 1) trow0 = b * SEQ + rs_of(4 * R) * 64;
    else trow0 = NTOK + b * LC;
}
template <int MODE>
__device__ __forceinline__ void attn_unit(Frame& F, int u, int u_next, const bf16* __restrict__ QKV, bf16* __restrict__ Yo, const float* sink, const float* rpb, AttPre& P, int& tbl_head, int var = 0) {
    const int w = F.wave, lane = F.lane, r = lane & 31, h = lane >> 5;
    LAS unsigned char* lds = F.lds;
    int b, head, kvh, q0 = 0, R = 0;
    if (MODE == 0) { b = u >> 6; kvh = (u >> 5) & 1; q0 = (u & 31) * 64; head = 4 * kvh + (w >> 1); }
    else if (MODE == 1) { b = u >> 6; head = (u >> 3) & 7; kvh = head; R = u & 7; }
    else if (MODE == 2) { b = u >> 3; kvh = (u >> 2) & 1; q0 = (u & 3) * 64; head = 4 * kvh + (w >> 1); }
    else { b = u >> 3; head = u & 7; kvh = head; }
    int qt, qrow, gr = 0, qc = 0;
    if (MODE == 0) { qt = q0 + 32 * (w & 1) + r; qrow = b * SEQ + qt; }
    else if (MODE == 1) { gr = 4 * R + (w >> 1); qc = 32 * (w & 1) + r; qt = gr * 64 + qc; qrow = b * SEQ + qt; }
    else if (MODE == 2) { qt = q0 + 32 * (w & 1) + r; qrow = NTOK + b * LC + qt; }
    else { qt = 32 * w + r; qrow = NTOK + b * LC + qt; }
    const int qcol = (MODE == 0 || MODE == 2) ? 1280 + head * 64 : 1792 + head * 64;
    const int kcol = (MODE == 0 || MODE == 2) ? kvh * 64 : 256 + head * 64;
    const int vcol = (MODE == 0 || MODE == 2) ? 128 + kvh * 64 : 768 + head * 64;
    bf16x8 qf[4];
#pragma unroll
    for (int s = 0; s < 4; ++s) qf[s] = *(const bf16x8*)(QKV + (size_t)qrow * QKVC + qcol + 16 * s + 8 * h);
    f32x16 O0, O1;
#pragma unroll
    for (int i = 0; i < 16; ++i) { O0[i] = 0.f; O1[i] = 0.f; }
    float m_run, l_run;
    if (MODE == 0 || MODE == 2) { m_run = sink[head] * LOG2E; l_run = (h == 0) ? 1.0f : 0.0f; } else { m_run = 0.f; l_run = 0.f; }
    f32x16 negm;
#pragma unroll
    for (int i = 0; i < 16; ++i) negm[i] = -m_run;
    int lo = 0, ntl = 0, kr_lo = 0;
    if (MODE == 0) { lo = q0 < 128 ? (128 - q0) / 64 : 0; const int hi = (SEQ - q0 + 128) / 64 < 5 ? (SEQ - q0 + 128) / 64 : 5; ntl = hi - lo; }
    if (MODE == 1) { kr_lo = rs_of(4 * R); ntl = rs_of(4 * R + 3) + 8 - kr_lo; }
    const int my_rs = rs_of(gr), my_cs = (qc - 8) < 0 ? 0 : ((qc - 8) > 48 ? 48 : (qc - 8));
    const int ntiles = ntl + 4;
    int tb_base = 0, tb_pitch = 0;
    if (MODE == 1) { const bool edge = qc < 8 || qc > 56; const int ev = qc < 8 ? qc : qc - 49;
        tb_base = edge ? ATT_E_OFF + ev * (15 * 256) + 16 * h : ATT_RPB_OFF + 4 * (63 - qc + 4 * h); tb_pitch = edge ? 256 : 512; }
    const int skey = F.tid >> 3, sch = F.tid & 7, vkey = F.tid & 63, vch = F.tid >> 6;
#define ATT_TROW(tt) ((tt) < ntl ? (MODE == 0 ? b * SEQ + q0 - 128 + 64 * (lo + (tt)) : b * SEQ + (kr_lo + (tt)) * 64) : NTOK + b * LC + 64 * ((tt) - ntl))
#define ATT_LOAD(tt) do { const int tr_ = ATT_TROW(tt); kreg = *(const v4u*)(QKV + (size_t)(tr_ + skey) * QKVC + kcol + 8 * sch); vreg = *(const v4u*)(QKV + (size_t)(tr_ + vkey) * QKVC + vcol + 8 * vch); } while (0)
#define ATT_STORE(bufoff) do { *(LAS v4u*)(lds + (bufoff) + ATT_K_OFF + skey * ATT_KP + sch * 16) = kreg; \
        LAS unsigned short* vt_ = (LAS unsigned short*)(lds + (bufoff) + ATT_V_OFF + (8 * vch) * ATT_VP + vkey * 2); \
        vt_[0 * (ATT_VP / 2)] = (unsigned short)(vreg.x & 0xffff); vt_[1 * (ATT_VP / 2)] = (unsigned short)(vreg.x >> 16); vt_[2 * (ATT_VP / 2)] = (unsigned short)(vreg.y & 0xffff); vt_[3 * (ATT_VP / 2)] = (unsigned short)(vreg.y >> 16); \
        vt_[4 * (ATT_VP / 2)] = (unsigned short)(vreg.z & 0xffff); vt_[5 * (ATT_VP / 2)] = (unsigned short)(vreg.z >> 16); vt_[6 * (ATT_VP / 2)] = (unsigned short)(vreg.w & 0xffff); vt_[7 * (ATT_VP / 2)] = (unsigned short)(vreg.w >> 16); } while (0)
    v4u& kreg = P.k; v4u& vreg = P.v;
    if (!P.valid) ATT_LOAD(0);
    P.valid = 0;
    __syncthreads();
    if (MODE == 1 && head != tbl_head) {
        tbl_head = head;
        LAS float* tb = (LAS float*)(lds + ATT_RPB_OFF);
        for (int i = F.tid; i < ATT_TBL_FLOATS; i += NTHREADS) {
            int dr, off; bool ok;
            if (i < 15 * 128) { dr = i >> 7; off = (i & 127) - 63; ok = off >= -8 && off <= 7; }
            else { const int j = i - 15 * 128, ev = j / (15 * 64), dr_ = (j >> 6) % 15, kc = j & 63, q = ev < 8 ? ev : ev + 49; dr = dr_; off = kc - q; ok = ev < 8 ? kc < 16 : kc >= 48; }
            tb[i] = ok ? rpb[(head * 15 + dr) * 31 + off + 15] * LOG2E : -1e30f;
        }
    }
    ATT_STORE(0);
    __syncthreads();
#pragma unroll 1
    for (int tt = 0; tt < ntiles; ++tt) {
        const bool is_local = tt < ntl;
        const int kbase = q0 - 128 + 64 * (lo + tt), kr = kr_lo + tt;
        const int boff = (tt & 1) * ATT_BUF;
        if (tt + 1 < ntiles) { if (!(var & 2)) ATT_LOAD(tt + 1); }
        else if (u_next >= 0) {
            int nq, nqc, nkc, nvc, ntr; att_start<MODE>(u_next, w, r, nq, nqc, nkc, nvc, ntr);
            kreg = *(const v4u*)(QKV + (size_t)(ntr + skey) * QKVC + nkc + 8 * sch); vreg = *(const v4u*)(QKV + (size_t)(ntr + vkey) * QKVC + nvc + 8 * vch);
            P.valid = 1;
        }
        if (!(var & 1) && !(MODE == 1 && is_local && !(kr >= my_rs && kr < my_rs + 8))) {
            if (MODE == 1 && is_local) {
                if (w & 1) att_tile<MODE, 2>(lds, boff, qf, negm, O0, O1, m_run, l_run, true, false, kbase, qt, kr, gr, tb_base, tb_pitch, r, h);
                else att_tile<MODE, 1>(lds, boff, qf, negm, O0, O1, m_run, l_run, true, false, kbase, qt, kr, gr, tb_base, tb_pitch, r, h);
            } else att_tile<MODE, 0>(lds, boff, qf, negm, O0, O1, m_run, l_run, is_local, MODE == 0 && is_local && (lo + tt == 0 || lo + tt == 4), kbase, qt, kr, gr, tb_base, tb_pitch, r, h);
        }
        if (tt + 1 < ntiles && !(var & 2)) ATT_STORE(((tt + 1) & 1) * ATT_BUF);
        __syncthreads();
    }
#undef ATT_TROW
#undef ATT_LOAD
#undef ATT_STORE
    const float lt = l_run + __shfl_xor(l_run, 32), inv = 1.0f / lt;
    LAS unsigned char* ot = lds + w * 4608;
#pragma unroll
    for (int g = 0; g < 4; ++g) {
        v2u o; o.x = cvtpk(O0[4 * g] * inv, O0[4 * g + 1] * inv); o.y = cvtpk(O0[4 * g + 2] * inv, O0[4 * g + 3] * inv);
        *(LAS v2u*)(ot + r * 144 + (8 * g + 4 * h) * 2) = o;
        o.x = cvtpk(O1[4 * g] * inv, O1[4 * g + 1] * inv); o.y = cvtpk(O1[4 * g + 2] * inv, O1[4 * g + 3] * inv);
        *(LAS v2u*)(ot + r * 144 + (32 + 8 * g + 4 * h) * 2) = o;
    }
    LDS_WAIT(); asm volatile("" ::: "memory");
    bf16* op = Yo + (size_t)(qrow - r) * 512 + head * 64;
#pragma unroll
    for (int k = 0; k < 4; ++k) { const int p = lane + 64 * k, row = p >> 3, chk = p & 7;
        *(GAS v4u*)(op + (size_t)row * 512 + 8 * chk) = *(const LAS v4u*)(ot + row * 144 + chk * 16); }
    LDS_WAIT(); asm volatile("" ::: "memory");
}

template <int N>
__device__ __forceinline__ void conv_taps(const bf16* src, int t, int L, float w0, float w1, float w2, float bs, float (&out)[N]) {
    float x[N + 2];
    if constexpr (N == 8) { const v4u q = *(const v4u*)(src + t); x[1] = pg8::bf_lo(q.x); x[2] = pg8::bf_hi(q.x); x[3] = pg8::bf_lo(q.y); x[4] = pg8::bf_hi(q.y); x[5] = pg8::bf_lo(q.z); x[6] = pg8::bf_hi(q.z); x[7] = pg8::bf_lo(q.w); x[8] = pg8::bf_hi(q.w); }
    else { const v2u q = *(const v2u*)(src + t); x[1] = pg8::bf_lo(q.x); x[2] = pg8::bf_hi(q.x); x[3] = pg8::bf_lo(q.y); x[4] = pg8::bf_hi(q.y); }
    x[0] = t > 0 ? bf2f(src[t - 1]) : 0.f;
    x[N + 1] = (t + N < L) ? bf2f(src[t + N]) : 0.f;
#pragma unroll
    for (int e = 0; e < N; ++e) out[e] = w0 * x[e] + w1 * x[e + 1] + w2 * x[e + 2] + bs;
}

template <int L, int VAR = 0>
__device__ __forceinline__ void hyena_unit(Frame& F, int c, const bf16* CINT, bf16* DST, const bf16* Gf, const float* convw, const float* convb, const float* hybias) {
    constexpr int UP = (L + 8) * 2, TPW = L / 256, CPB = L / 8;
    LAS unsigned char* U = F.lds; LAS unsigned short* Gs = (LAS unsigned short*)(F.lds + 32 * UP);
    const int lane = F.lane, r = lane & 31, h = lane >> 5, T0 = F.wave * TPW * 32;
    const bf16* vsrc = CINT + (size_t)c * NROW + (L == SEQ ? 0 : NTOK);
    bf16* ydst = DST + (size_t)c * NROW + (L == SEQ ? 0 : NTOK);
    __syncthreads();
    if (!(VAR & 8)) {
        const float w0 = convw[c], w1 = convw[CINC + c], w2 = convw[2 * CINC + c], bs = convb[c];
        static_assert(CPB % 32 == 0, "a wave's 64 lanes hold consecutive chunks of at most two rows, split at lane 32");
#pragma unroll 4
        for (int q = F.tid; q < 32 * CPB; q += NTHREADS) { const int b = q / CPB, t = (q % CPB) * 8;
            const bf16* src = vsrc + (size_t)b * L;
            const v4u ch = *(const v4u*)(src + t);
            float x[10];
            x[1] = pg8::bf_lo(ch.x); x[2] = pg8::bf_hi(ch.x); x[3] = pg8::bf_lo(ch.y); x[4] = pg8::bf_hi(ch.y); x[5] = pg8::bf_lo(ch.z); x[6] = pg8::bf_hi(ch.z); x[7] = pg8::bf_lo(ch.w); x[8] = pg8::bf_hi(ch.w);
            const float up = __shfl_up(x[8], 1), dn = __shfl_down(x[1], 1);
            const int lr = lane & 31;
            x[0] = (lr == 0) ? (t > 0 ? bf2f(src[t - 1]) : 0.f) : up;
            x[9] = (lr == 31) ? (t + 8 < L ? bf2f(src[t + 8]) : 0.f) : dn;
            float o[8];
#pragma unroll
            for (int e = 0; e < 8; ++e) o[e] = w0 * x[e] + w1 * x[e + 1] + w2 * x[e + 2] + bs;
            v4u pk; pk.x = pk2(o[0], o[1]); pk.y = pk2(o[2], o[3]); pk.z = pk2(o[4], o[5]); pk.w = pk2(o[6], o[7]);
            *(LAS v4u*)(U + b * UP + t * 2) = pk; }
    }
#pragma unroll 1
    for (int ord = 0; ord < 2; ++ord) {
        {
            const v4u* gsrc = (const v4u*)(Gf + ((size_t)ord * 512 + c) * (2 * L));
            for (int q = F.tid; q < L / 4; q += NTHREADS) *(LAS v4u*)((LAS unsigned char*)Gs + q * 16) = gsrc[q];
        }
        __syncthreads();
        f32x16 acc[TPW];
#pragma unroll
        for (int i = 0; i < TPW; ++i)
#pragma unroll
            for (int e = 0; e < 16; ++e) acc[i][e] = 0.f;
        const int gbase = T0 + r - 8 * h + L;
#define HY_AF(dst, sgi, ti) do { const int gi_ = gbase + 32 * (ti) - 16 * (sgi); _Pragma("unroll") for (int j_ = 0; j_ < 8; ++j_) dst[j_] = (short)Gs[gi_ - j_]; } while (0)
#define HY_BF(sgi) (*(const LAS bf16x8*)(U + r * UP + (16 * (sgi) + 8 * h) * 2))
        if constexpr (TPW == 8 && !(VAR & 2)) {
            constexpr int NS = L / 16;
#pragma unroll 1
            for (int p = 0; p < 2; ++p) {
                bf16x8 W[8];
#pragma unroll
                for (int i = 1; i < 8; ++i) HY_AF(W[i], p, i);
                bf16x8 nf, nb; HY_AF(nf, p, 0); nb = HY_BF(p);
#pragma unroll 1
                for (int sb = p; sb < NS; sb += 16) {
#pragma unroll
                    for (int k = 0; k < 8; ++k) {
                        const int sg = sb + 2 * k; const bf16x8 cb = nb; W[(8 - k) & 7] = nf;
                        const int sn = sg + 2 < NS ? sg + 2 : sg;
                        HY_AF(nf, sn, 0); nb = HY_BF(sn);
#pragma unroll
                        for (int i = 0; i < 8; ++i) acc[i] = MFMA32(W[(i - k) & 7], cb, acc[i]);
                    }
                }
            }
        } else if constexpr (!(VAR & 2)) {
#pragma unroll 1
            for (int sg = 0; sg < L / 16; ++sg) { bf16x8 af; HY_AF(af, sg, 0); acc[0] = MFMA32(af, HY_BF(sg), acc[0]); }
        }
#undef HY_AF
#undef HY_BF
        const int comp = 1 + ord;
        const float w0 = convw[comp * 512 + c], w1 = convw[CINC + comp * 512 + c], w2 = convw[2 * CINC + comp * 512 + c], bs = convb[comp * 512 + c], hb = hybias[ord * 512 + c];
        const bf16* gsrc = CINT + ((size_t)comp * 512 + c) * NROW + (L == SEQ ? 0 : NTOK) + (size_t)r * L;
        __syncthreads();
        {
            constexpr int NCH = TPW * 4, BS = NCH < 8 ? NCH : 8;
#pragma unroll
            for (int bt = 0; bt < NCH / BS; ++bt) {
                const int tb = T0 + 8 * BS * bt;
                v4u ch[BS];
#pragma unroll
                for (int k = 0; k < BS; ++k) { if constexpr (VAR & 4) ch[k] = (v4u){0u, 0u, 0u, 0u}; else ch[k] = *(const v4u*)(gsrc + tb + 8 * k); }
                float xl = 0.f, xr = 0.f;
                if constexpr (!(VAR & 4)) { if (tb > 0) xl = bf2f(gsrc[tb - 1]); if (tb + 8 * BS < L) xr = bf2f(gsrc[tb + 8 * BS]); }
#pragma unroll
                for (int k = 0; k < BS; ++k) {
                    const int kk = BS * bt + k, i = kk >> 2, g = kk & 3, t = T0 + 32 * i + 8 * g + 4 * h;
                    float xs[10];
                    xs[0] = k == 0 ? xl : pg8::bf_hi(ch[k > 0 ? k - 1 : 0].w);
                    xs[1] = pg8::bf_lo(ch[k].x); xs[2] = pg8::bf_hi(ch[k].x); xs[3] = pg8::bf_lo(ch[k].y); xs[4] = pg8::bf_hi(ch[k].y); xs[5] = pg8::bf_lo(ch[k].z); xs[6] = pg8::bf_hi(ch[k].z); xs[7] = pg8::bf_lo(ch[k].w); xs[8] = pg8::bf_hi(ch[k].w);
                    xs[9] = k == BS - 1 ? xr : pg8::bf_lo(ch[k < BS - 1 ? k + 1 : k].x);
                    float gt[4];
#pragma unroll
                    for (int e2 = 0; e2 < 4; ++e2) { const float lo = w0 * xs[e2] + w1 * xs[e2 + 1] + w2 * xs[e2 + 2] + bs, hi = w0 * xs[e2 + 4] + w1 * xs[e2 + 5] + w2 * xs[e2 + 6] + bs; gt[e2] = h ? hi : lo; }
                    LAS v2u* up = (LAS v2u*)(U + r * UP + t * 2);
                    const v2u uu = *up;
                    const float u0 = pg8::bf_lo(uu.x), u1 = pg8::bf_hi(uu.x), u2 = pg8::bf_lo(uu.y), u3 = pg8::bf_hi(uu.y);
                    const float z0 = gt[0] * (acc[i][4 * g] + hb * u0), z1 = gt[1] * (acc[i][4 * g + 1] + hb * u1), z2 = gt[2] * (acc[i][4 * g + 2] + hb * u2), z3 = gt[3] * (acc[i][4 * g + 3] + hb * u3);
                    v2u zz; zz.x = pk2(z0, z1); zz.y = pk2(z2, z3);
                    *up = zz;
                }
                asm volatile("" ::: "memory");
            }
        }
        __syncthreads();
    }
    if (!(VAR & 1)) for (int q = F.tid; q < 32 * CPB; q += NTHREADS) { const int b = q / CPB, t = (q % CPB) * 8; *(GAS v4u*)(ydst + (size_t)b * L + t) = *(const LAS v4u*)(U + b * UP + t * 2); }
}

__device__ __forceinline__ void transpose_yc(Frame& F, const bf16* CT, bf16* Yc, int nrows) {
    const int gw = F.vcu * NWAVES + F.wave, NGW = F.G * NWAVES, lane = F.lane;
    LAS unsigned short* T = (LAS unsigned short*)(F.lds + F.wave * 16384);
    const int ntr = nrows / 64, nit = 8 * ntr;
    if (gw >= nit) return;
    v4u q[8];
#define TY_LOAD(it_) do { const int cb_ = (it_) / ntr, rb_ = (it_) % ntr; _Pragma("unroll") for (int k = 0; k < 8; ++k) { const int p = lane + 64 * k, cc = p >> 3, ch = p & 7; \
        q[k] = *(const v4u*)(CT + (size_t)(cb_ * 64 + cc) * NROW + rb_ * 64 + 8 * ch); } } while (0)
    TY_LOAD(gw);
#pragma unroll 1
    for (int it = gw; it < nit; it += NGW) {
        const int cb = it / ntr, rb = it % ntr, c0 = cb * 64, r0 = rb * 64;
#pragma unroll
        for (int k = 0; k < 8; ++k) { const int p = lane + 64 * k, cc = p >> 3, ch = p & 7;
            LAS unsigned* d = (LAS unsigned*)(T + cc * 66 + 8 * ch); d[0] = q[k].x; d[1] = q[k].y; d[2] = q[k].z; d[3] = q[k].w; }
        if (it + NGW < nit) TY_LOAD(it + NGW);
        LDS_WAIT(); asm volatile("" ::: "memory");
#pragma unroll
        for (int k = 0; k < 8; ++k) { const int p = lane + 64 * k, rr = p >> 3, ch = p & 7;
            unsigned short e[8];
#pragma unroll
            for (int j = 0; j < 8; ++j) e[j] = T[(8 * ch + j) * 66 + rr];
            v4u o; o.x = e[0] | ((unsigned)e[1] << 16); o.y = e[2] | ((unsigned)e[3] << 16); o.z = e[4] | ((unsigned)e[5] << 16); o.w = e[6] | ((unsigned)e[7] << 16);
            *(GAS v4u*)(Yc + (size_t)(r0 + rr) * 512 + c0 + 8 * ch) = o; }
        LDS_WAIT(); asm volatile("" ::: "memory");
    }
#undef TY_LOAD
}

struct RowVecs { f32x4 gA[4], gt[4], gB[4], sc1[4], sh[4]; };
__device__ __forceinline__ float ssq16(const f32x4 (&v)[4]) { float s = 0.f;
#pragma unroll
    for (int j = 0; j < 4; ++j) s += (v[j].x * v[j].x + v[j].y * v[j].y) + (v[j].z * v[j].z + v[j].w * v[j].w);
    return s; }
__device__ __forceinline__ void ld_mod(const Frame& F, int l, int b, int part, int lane, f32x4 (&v)[4], float add) {
    ld_row_f32((const float*)(F.ws + WS_MODV) + ((size_t)l * 33 + b) * 6144 + part * 1024, lane, v);
#pragma unroll
    for (int j = 0; j < 4; ++j) v[j] = v[j] + add;
}
__device__ __forceinline__ void row_pair(const RowVecs& V, const f32x4 (&y0)[4], const f32x4 (&y1)[4], f32x4 (&x0)[4], f32x4 (&x1)[4], bool has_y, bool has_next, f32x4 (&h0)[4], f32x4 (&h1)[4]) {
    if (has_y) {
        const float a0 = wave_sum(ssq16(y0)), a1 = wave_sum(ssq16(y1));
        const float r0 = __builtin_amdgcn_rsqf(a0 * (1.0f / D) + EPS), r1 = __builtin_amdgcn_rsqf(a1 * (1.0f / D) + EPS);
#pragma unroll
        for (int j = 0; j < 4; ++j) { x0[j] = x0[j] + V.gt[j] * ((y0[j] * r0) * V.gA[j]); x1[j] = x1[j] + V.gt[j] * ((y1[j] * r1) * V.gA[j]); }
    }
    if (has_next) {
        const float a0 = wave_sum(ssq16(x0)), a1 = wave_sum(ssq16(x1));
        const float r0 = __builtin_amdgcn_rsqf(a0 * (1.0f / D) + EPS), r1 = __builtin_amdgcn_rsqf(a1 * (1.0f / D) + EPS);
#pragma unroll
        for (int j = 0; j < 4; ++j) { h0[j] = (x0[j] * r0) * V.gB[j] * V.sc1[j] + V.sh[j]; h1[j] = (x1[j] * r1) * V.gB[j] * V.sc1[j] + V.sh[j]; }
    }
}
template <bool XB16>
__device__ __forceinline__ void rows_phase(Frame& F, const Args& a, int mode, int l, int sub, const bf16* Y, int nrows) {
    const int gw = F.vcu * NWAVES + F.wave, NGW = F.G * NWAVES;
    const int R = (((nrows + NGW - 1) / NGW) + 1) & ~1, r0 = gw * R, r1 = (r0 + R) < nrows ? (r0 + R) : nrows;
    const bool has_y = mode == 1, has_next = (mode == 0) || !(l == 1 && sub == 1);
    const int ln = (mode == 0) ? 0 : (sub == 0 ? l : l + 1);
    const bool next_is_ffn = (mode == 1 && sub == 0);
    RowVecs V;
    if (has_y) ld_row_f32(a.in[sub == 0 ? I_GMIXPOST : I_GFFNPOST] + l * D, F.lane, V.gA);
    if (has_next) ld_row_f32(a.in[next_is_ffn ? I_GFFNPRE : I_GMIXPRE] + ln * D, F.lane, V.gB);
    int bcur = -2;
    bf16* const Hb = F.hb; bf16* const XB = (bf16*)(F.ws + WS_XB);
    f32x4 nx0[4], nx1[4]; v2u nxr0[4], nxr1[4], ny0[4], ny1[4];
#define ROWS_ISSUE(row_) do { const int rr_ = (row_); \
        if (has_y) { ld_raw_bf16_nt(Y + (size_t)rr_ * D, F.lane, ny0); ld_raw_bf16_nt(Y + (size_t)(rr_ + 1) * D, F.lane, ny1); } \
        if (XB16) { ld_raw_bf16_nt(XB + (size_t)rr_ * D, F.lane, nxr0); ld_raw_bf16_nt(XB + (size_t)(rr_ + 1) * D, F.lane, nxr1); } \
        else { const float* xs_ = rr_ < NTOK ? a.in[I_X] + (size_t)rr_ * D : a.in[I_CTX] + (size_t)(rr_ - NTOK) * D; ld_row_f32_nt(xs_, F.lane, nx0); ld_row_f32_nt(xs_ + D, F.lane, nx1); } } while (0)
    if (r0 < r1) ROWS_ISSUE(r0);
#pragma unroll 1
    for (int row = r0; row < r1; row += 2) {
        const int b = row < NTOK ? (row >> 11) : 32;
        if (b != bcur) { bcur = b;
            if (has_y) ld_mod(F, l, b, sub == 0 ? 2 : 5, F.lane, V.gt, 0.f);
            if (has_next) { ld_mod(F, ln, b, next_is_ffn ? 4 : 1, F.lane, V.sc1, 1.0f); ld_mod(F, ln, b, next_is_ffn ? 3 : 0, F.lane, V.sh, 0.f); } }
        f32x4 y0[4], y1[4], x0[4], x1[4], h0[4], h1[4];
#pragma unroll
        for (int j = 0; j < 4; ++j) { if (XB16) { x0[j] = cvt_raw_bf16(nxr0[j]); x1[j] = cvt_raw_bf16(nxr1[j]); } else { x0[j] = nx0[j]; x1[j] = nx1[j]; }
            if (has_y) { y0[j] = cvt_raw_bf16(ny0[j]); y1[j] = cvt_raw_bf16(ny1[j]); } }
        if (row + 2 < r1) ROWS_ISSUE(row + 2);
        row_pair(V, y0, y1, x0, x1, has_y, has_next, h0, h1);
        if (has_y) { st_row_bf16(XB + (size_t)row * D, F.lane, x0); st_row_bf16(XB + (size_t)(row + 1) * D, F.lane, x1); }
        if (has_next) { if (!next_is_ffn) { st_row_bf16(Hb + (size_t)row * D, F.lane, h0); st_row_bf16(Hb + (size_t)(row + 1) * D, F.lane, h1); }
            { GAS unsigned* q = (GAS unsigned*)(F.ws + WS_H8 + (size_t)row * D) + F.lane;
#pragma unroll
                for (int j = 0; j < 4; ++j) { q[64 * j] = pg8::pack_fp8x4(h0[j].x, h0[j].y, h0[j].z, h0[j].w); q[256 + 64 * j] = pg8::pack_fp8x4(h1[j].x, h1[j].y, h1[j].z, h1[j].w); } } }
    }
#undef ROWS_ISSUE
}

__device__ __forceinline__ void route_row(const f32x4 (&h)[4], const LAS float* rl, int lane, int& e0, int& e1, float& w0, float& w1) {
    float lg[8];
#pragma unroll
    for (int e = 0; e < 8; ++e) lg[e] = 0.f;
#pragma unroll
    for (int j = 0; j < 4; ++j)
#pragma unroll
        for (int i = 0; i < 4; ++i) { const LAS f32x4* rp = (const LAS f32x4*)(rl + ((j * 4 + i) * 64 + lane) * 8); const f32x4 q0 = rp[0], q1 = rp[1]; const float hv = h[j][i];
            lg[0] += hv * q0.x; lg[1] += hv * q0.y; lg[2] += hv * q0.z; lg[3] += hv * q0.w; lg[4] += hv * q1.x; lg[5] += hv * q1.y; lg[6] += hv * q1.z; lg[7] += hv * q1.w; }
    { const bool b5 = (lane & 32) != 0, b4 = (lane & 16) != 0, b3 = (lane & 8) != 0;
      float v4[4], v2[2], v1;
#pragma unroll
      for (int k = 0; k < 4; ++k) { const float snd = b5 ? lg[k] : lg[k + 4], kp = b5 ? lg[k + 4] : lg[k]; v4[k] = kp + __shfl_xor(snd, 32); }
#pragma unroll
      for (int k = 0; k < 2; ++k) { const float snd = b4 ? v4[k] : v4[k + 2], kp = b4 ? v4[k + 2] : v4[k]; v2[k] = kp + __shfl_xor(snd, 16); }
      { const float snd = b3 ? v2[0] : v2[1], kp = b3 ? v2[1] : v2[0]; v1 = kp + __shfl_xor(snd, 8); }
      v1 += __shfl_xor(v1, 4); v1 += __shfl_xor(v1, 2); v1 += __shfl_xor(v1, 1);
#pragma unroll
      for (int e = 0; e < 8; ++e) lg[e] = __builtin_bit_cast(float, __builtin_amdgcn_readlane(__builtin_bit_cast(int, v1), 8 * e)); }
    e0 = 0; float v0 = lg[0];
#pragma unroll
    for (int e = 1; e < 8; ++e) if (lg[e] > v0) { v0 = lg[e]; e0 = e; }
    e1 = -1; float v1 = -3.0e38f;
#pragma unroll
    for (int e = 0; e < 8; ++e) if (e != e0 && lg[e] > v1) { v1 = lg[e]; e1 = e; }
    w0 = 1.0f / (1.0f + __expf(v1 - v0)); w1 = 1.0f - w0;
}
__device__ __forceinline__ void post_route_phase(Frame& F, const Args& a, const bf16* Y) {
    LAS int* se = (LAS int*)F.lds;
    LAS int* sbase = se + 512;
    LAS float* rl = (LAS float*)(F.lds + 4096);
    const int l = 1;
    __syncthreads();
    for (int i = F.tid; i < 1024 * 8; i += NTHREADS) { const int k = i >> 3, e = i & 7, jj = k >> 8, ln = (k & 255) >> 2, ii = k & 3; rl[((jj * 4 + ii) * 64 + ln) * 8 + e] = a.in[I_ROUTER][i]; }
    __syncthreads();
    RowVecs V;
    ld_row_f32(a.in[I_GMIXPOST] + l * D, F.lane, V.gA); ld_row_f32(a.in[I_GFFNPRE] + l * D, F.lane, V.gB);
    bf16* const Hb = F.hb; bf16* const XB = (bf16*)(F.ws + WS_XB);
    for (int blk = F.vcu; blk < NTOK / 256; blk += F.G) {
        const int b = blk >> 3;
        ld_mod(F, l, b, 2, F.lane, V.gt, 0.f); ld_mod(F, l, b, 4, F.lane, V.sc1, 1.0f); ld_mod(F, l, b, 3, F.lane, V.sh, 0.f);
        v2u nyr[4], nxr[4];
        { const int row_ = blk * 256 + F.wave * 32; ld_raw_bf16_nt(Y + (size_t)row_ * D, F.lane, nyr); ld_raw_bf16_nt(XB + (size_t)row_ * D, F.lane, nxr); }
#pragma unroll 1
        for (int k = 0; k < 32; ++k) {
            const int lr = F.wave * 32 + k, row = blk * 256 + lr;
            f32x4 y0[4], x0[4], h0[4];
#pragma unroll
            for (int j = 0; j < 4; ++j) { y0[j] = cvt_raw_bf16(nyr[j]); x0[j] = cvt_raw_bf16(nxr[j]); }
            if (k + 1 < 32) { ld_raw_bf16_nt(Y + (size_t)(row + 1) * D, F.lane, nyr); ld_raw_bf16_nt(XB + (size_t)(row + 1) * D, F.lane, nxr); }
            bf16* xp = XB + (size_t)row * D;
            { const float r0 = __builtin_amdgcn_rsqf(wave_sum(ssq16(y0)) * (1.0f / D) + EPS);
#pragma unroll
              for (int j = 0; j < 4; ++j) x0[j] = x0[j] + V.gt[j] * ((y0[j] * r0) * V.gA[j]); }
            st_row_bf16(xp, F.lane, x0);
            { const float r0 = __builtin_amdgcn_rsqf(wave_sum(ssq16(x0)) * (1.0f / D) + EPS);
#pragma unroll
              for (int j = 0; j < 4; ++j) h0[j] = (x0[j] * r0) * V.gB[j] * V.sc1[j] + V.sh[j]; }
            { GAS unsigned* q = (GAS unsigned*)((unsigned char*)Hb + (size_t)row * D) + F.lane;
#pragma unroll
              for (int j = 0; j < 4; ++j) q[64 * j] = pg8::pack_fp8x4(h0[j].x, h0[j].y, h0[j].z, h0[j].w); }
            int e0, e1; float w0, w1;
            route_row(h0, rl, F.lane, e0, e1, w0, w1);
            if (F.lane == 0) { se[2 * lr] = e0; se[2 * lr + 1] = e1;
                int4 rr; rr.x = e0; rr.y = e1; rr.z = __builtin_bit_cast(int, w0); rr.w = __builtin_bit_cast(int, w1); ((int4*)(F.ws + WS_ROUTE))[row] = rr; }
        }
        __syncthreads();
        const int half = blk >= HALF0_TOK / 256 ? 1 : 0;
        {
            const int ex = F.wave; int v[8]; int n = 0;
#pragma unroll
            for (int c = 0; c < 8; ++c) { v[c] = se[c * 64 + F.lane]; n += __builtin_popcountll(__ballot(v[c] == ex)); }
            int base = 0;
            if (F.lane == 0) base = (int)__hip_atomic_fetch_add((unsigned*)(F.ws + WS_CTL) + CW_CNT + half * 8 + ex, (unsigned)n, __ATOMIC_RELAXED, __HIP_MEMORY_SCOPE_AGENT);
            base = __shfl(base, 0);
            int* lst = (int*)(F.ws + WS_LIST) + ((size_t)half * 8 + ex) * LCAP;
#pragma unroll
            for (int c = 0; c < 8; ++c) { const unsigned long long mk = __ballot(v[c] == ex); const int i = c * 64 + F.lane;
                if (v[c] == ex) lst[base + __builtin_popcountll(mk & ((1ull << F.lane) - 1ull))] = ((blk * 256 + (i >> 1)) << 1) | (i & 1);
                base += __builtin_popcountll(mk); }
        }
        __syncthreads();
    }
}

__device__ __forceinline__ void moe_offsets(Frame& F, int half, int (&toff)[9], int (&cnt)[8]) {
    const unsigned* cw = (const unsigned*)(F.ws + WS_CTL) + CW_CNT + half * 8;
    toff[0] = 0;
#pragma unroll
    for (int e = 0; e < 8; ++e) { cnt[e] = __builtin_amdgcn_readfirstlane((int)__hip_atomic_load(cw + e, __ATOMIC_RELAXED, __HIP_MEMORY_SCOPE_AGENT)); toff[e + 1] = toff[e] + (cnt[e] + 255) / 256; }
}
__device__ __forceinline__ void moe_gather_phase(Frame& F, int half, int skip_first = 0) {
    if (skip_first < 0 || skip_first >= F.G) skip_first = 0;
    const int bxw = (int)blockIdx.x - skip_first; if (bxw < 0) return;
    const int gw = bxw * NWAVES + F.wave, NGW = (F.G - skip_first) * NWAVES;
    int toff[9], cnt[8]; moe_offsets(F, half, toff, cnt);
    const int P = toff[8] * 256;
#pragma unroll 1
    for (int pb = gw; pb < P; pb += 4 * NGW) {
        int ts[4]; bool ok[4];
#pragma unroll
        for (int j = 0; j < 4; ++j) { const int p = pb + j * NGW; ok[j] = false; ts[j] = 0;
            if (p < P) { const int tile = p >> 8; int e = 0;
#pragma unroll
                for (int k = 1; k < 8; ++k) e += (tile >= toff[k]) ? 1 : 0;
                int te = 0, ce = 0;
#pragma unroll
                for (int k = 0; k < 8; ++k) { te = (e == k) ? toff[k] : te; ce = (e == k) ? cnt[k] : ce; }
                const int idx = p - te * 256;
                if (idx < ce) { ok[j] = true; ts[j] = ((const int*)(F.ws + WS_LIST))[((size_t)half * 8 + e) * LCAP + idx]; } } }
        v4u o[4];
#pragma unroll
        for (int j = 0; j < 4; ++j) { o[j] = (v4u){0u, 0u, 0u, 0u};
            if (ok[j]) o[j] = *((const GAS v4u*)((const unsigned char*)F.hb + (size_t)(ts[j] >> 1) * D) + F.lane); }
#pragma unroll
        for (int j = 0; j < 4; ++j) { const int p = pb + j * NGW;
            if (p < P) { *((GAS v4u*)(F.ws + BIG_AS + (size_t)p * D) + F.lane) = o[j];
                if (ok[j] && F.lane == 0) ((int*)(F.ws + WS_INV))[(ts[j] >> 1) * 2 + (ts[j] & 1)] = p; } }
    }
}
struct ConvItem { const float* W; unsigned char* WT; int N, Kp, k0, n0, drow0; float scale; };
__device__ __forceinline__ void moe_conv_decode(const Frame& F, const Args& a, int part, int it, ConvItem& c) {
    constexpr int I13 = 16 * 112, I2 = 56 * 32;
    if (part == 0) {
        const int e = it / (2 * I13); int r = it % (2 * I13);
        const int which = r / I13; r %= I13; const int kb = r / 112, nb = r % 112, n0 = 32 * nb;
        c.W = (which ? a.in[I_MW3] : a.in[I_MW1]) + (size_t)e * D * DFFE; c.N = DFFE; c.WT = F.ws + WM_13 + (size_t)e * 2 * DFFE * D; c.Kp = D; c.k0 = 64 * kb; c.n0 = n0;
        c.drow0 = (n0 / 128) * 256 + which * 128 + (n0 % 128); c.scale = W13_SCALE;
    } else {
        const int e = it / I2, r = it % I2, kb = r / 32, nb = r % 32;
        c.W = a.in[I_MW2] + (size_t)e * DFFE * D; c.N = D; c.WT = F.ws + WM_2 + (size_t)e * D * DFFE; c.Kp = DFFE; c.k0 = 64 * kb; c.n0 = 32 * nb; c.drow0 = 32 * nb; c.scale = W2_SCALE;
    }
}
__device__ __forceinline__ void moe_conv_load(const ConvItem& c, int lane, f32x4 (&v)[8]) {
    const int c4 = 4 * (lane & 7);
#pragma unroll
    for (int i = 0; i < 8; ++i) { const int kk = (lane >> 3) + 8 * i; v[i] = __builtin_nontemporal_load((const GAS f32x4*)(c.W + (size_t)(c.k0 + kk) * c.N + c.n0 + c4)); }
}
__device__ __forceinline__ void moe_convert(Frame& F, const Args& a, int part) {
    const int gw = F.vcu * NWAVES + F.wave, NGW = F.G * NWAVES, lane = F.lane;
    LAS float* scr = (LAS float*)(F.lds + F.wave * 16384);
    const int NIT = part == 0 ? 8 * 2 * 16 * 112 : 8 * 56 * 32;
    if (gw >= NIT) return;
    ConvItem cur; f32x4 v[8];
    moe_conv_decode(F, a, part, gw, cur); moe_conv_load(cur, lane, v);
#pragma unroll 1
    for (int it = gw; it < NIT; it += NGW) {
        { const int c4 = 4 * (lane & 7);
#pragma unroll
          for (int i = 0; i < 8; ++i) { const int kk = (lane >> 3) + 8 * i; const f32x4 w = v[i] * cur.scale; LAS float* d = scr + kk * 33 + c4; d[0] = w.x; d[1] = w.y; d[2] = w.z; d[3] = w.w; } }
        ConvItem nxt = cur;
        if (it + NGW < NIT) { moe_conv_decode(F, a, part, it + NGW, nxt); moe_conv_load(nxt, lane, v); }
        LDS_WAIT(); asm volatile("" ::: "memory");
        const int c = lane & 7;
#pragma unroll
        for (int j = 0; j < 4; ++j) { const int n = (lane >> 3) + 8 * j; const LAS float* s = scr + (8 * c) * 33 + n;
            v2u o; o.x = pg8::pack_fp8x4(s[0 * 33], s[1 * 33], s[2 * 33], s[3 * 33]); o.y = pg8::pack_fp8x4(s[4 * 33], s[5 * 33], s[6 * 33], s[7 * 33]);
            *(GAS v2u*)(cur.WT + (size_t)(cur.drow0 + n) * cur.Kp + cur.k0 + 8 * c) = o; }
        LDS_WAIT(); asm volatile("" ::: "memory");
        cur = nxt;
    }
}
__device__ __forceinline__ void moe_post_phase(Frame& F, const Args& a, int half) {
    const int gw = F.vcu * NWAVES + F.wave, NGW = F.G * NWAVES;
    const int ntok = half ? HALF1_TOK : HALF0_TOK, tbase = half ? HALF0_TOK : 0;
    const int R = (((ntok + NGW - 1) / NGW) + 1) & ~1, t0 = gw * R, t1 = (t0 + R) < ntok ? (t0 + R) : ntok;
    RowVecs V; ld_row_f32(a.in[I_GFFNPOST] + D, F.lane, V.gA);
    int bcur = -2;
    const bf16* Y2 = (const bf16*)(F.ws + BIG_Y2S); const int* inv = (const int*)(F.ws + WS_INV); const int4* rt = (const int4*)(F.ws + WS_ROUTE);
    int4 ira, irb; int ip00, ip01, ip10, ip11;
    v2u nya[4], nyb[4], nyc[4], nyd[4], nxr0[4], nxr1[4]; const bf16* XB = (const bf16*)(F.ws + WS_XB); float nw0 = 0.f, nw1 = 0.f, nu0 = 0.f, nu1 = 0.f;
#define MP_IDX(t_) do { const int rw_ = tbase + (t_); ira = rt[rw_]; irb = rt[rw_ + 1]; ip00 = inv[rw_ * 2]; ip01 = inv[rw_ * 2 + 1]; ip10 = inv[rw_ * 2 + 2]; ip11 = inv[rw_ * 2 + 3]; } while (0)
#define MP_DATA(t_) do { const int rw_ = tbase + (t_); \
        ld_raw_bf16_nt(Y2 + (size_t)ip00 * D, F.lane, nya); ld_raw_bf16_nt(Y2 + (size_t)ip01 * D, F.lane, nyb); ld_raw_bf16_nt(Y2 + (size_t)ip10 * D, F.lane, nyc); ld_raw_bf16_nt(Y2 + (size_t)ip11 * D, F.lane, nyd); \
        const bf16* xq_ = XB + (size_t)rw_ * D; ld_raw_bf16_nt(xq_, F.lane, nxr0); ld_raw_bf16_nt(xq_ + D, F.lane, nxr1); \
        nw0 = __builtin_bit_cast(float, ira.z); nw1 = __builtin_bit_cast(float, ira.w); nu0 = __builtin_bit_cast(float, irb.z); nu1 = __builtin_bit_cast(float, irb.w); } while (0)
    if (t0 < t1) { MP_IDX(t0); MP_DATA(t0); if (t0 + 2 < t1) MP_IDX(t0 + 2); }
#pragma unroll 1
    for (int t = t0; t < t1; t += 2) {
        const int row = tbase + t, b = row >> 11;
        if (b != bcur) { bcur = b; ld_mod(F, 1, b, 5, F.lane, V.gt, 0.f); }
        f32x4 y0[4], y1[4], x0[4], x1[4], h0[4], h1[4];
        float* xp = a.out + (size_t)row * D;
#pragma unroll
        for (int j = 0; j < 4; ++j) { x0[j] = cvt_raw_bf16(nxr0[j]); x1[j] = cvt_raw_bf16(nxr1[j]); y0[j] = cvt_raw_bf16(nya[j]) * nw0 + cvt_raw_bf16(nyb[j]) * nw1; y1[j] = cvt_raw_bf16(nyc[j]) * nu0 + cvt_raw_bf16(nyd[j]) * nu1; }
        if (t + 2 < t1) { MP_DATA(t + 2); if (t + 4 < t1) MP_IDX(t + 4); }
        row_pair(V, y0, y1, x0, x1, true, false, h0, h1);
        st_row_f32_nt(xp, F.lane, x0); st_row_f32_nt(xp + D, F.lane, x1);
    }
#undef MP_IDX
#undef MP_DATA
}

#ifndef MK_ONLY
#define MK_ONLY -1
#endif
#ifndef MK_SKIP
#define MK_SKIP -1
#endif
#define ON(k) ((MK_ONLY < 0 || MK_ONLY == (k)) && MK_SKIP != (k))
#ifndef MK_REPMASK
#define MK_REPMASK 0
#endif
#ifndef MK_REPSUB
#define MK_REPSUB 0
#endif
#ifndef MK_HYVAR
#define MK_HYVAR 0
#endif
#ifndef MK_MULTI
#define MK_MULTI 0
#endif
constexpr int NPHASES = 2 + 9 + 6 + 6;

typedef const __attribute__((address_space(4))) Args* ArgsP;
#define KARGS ((ArgsP)__builtin_amdgcn_kernarg_segment_ptr())
#define PH_ENTER \
    Frame F; const Args* ap_; { int t_ = threadIdx.x; asm volatile("" : "+v"(t_)); ArgsP q_ = KARGS; asm volatile("" : "+s"(q_)); ap_ = (const Args*)q_; \
      F.lds = (LAS unsigned char*)lds_raw; F.tid = t_; F.lane = t_ & 63; F.wave = __builtin_amdgcn_readfirstlane(t_ >> 6); \
      F.G = gridDim.x; { const int bx_ = blockIdx.x; F.vcu = (F.G % 8 == 0) ? (bx_ % 8) * (F.G / 8) + bx_ / 8 : bx_; } F.ws = q_->ws; F.hb = (bf16*)q_->out; } \
    const Args& a = *ap_; const int bx = (int)blockIdx.x; \
    bf16* const Hb = F.hb; bf16* const Y3 = (bf16*)(F.ws + WS_Y3); bf16* const QKV = (bf16*)(F.ws + BIG_QKV); bf16* const CINT = (bf16*)(F.ws + BIG_CINT); unsigned char* const GATE = F.ws + BIG_GATE; \
    (void)Hb; (void)Y3; (void)QKV; (void)CINT; (void)GATE; (void)bx; (void)a;

__global__ void __launch_bounds__(NTHREADS, 2) fwd_kernel(Args args) {
    extern __shared__ __attribute__((aligned(16))) unsigned char lds_raw[];
    {
        volatile LAS unsigned* MISC0 = (volatile LAS unsigned*)((LAS unsigned char*)lds_raw + MISC_OFF);
        for (int u = threadIdx.x; u < (LDS_BYTES - MISC_OFF) / 4; u += NTHREADS) MISC0[u] = 0u;
        __syncthreads();
    }
    if (!MK_MULTI) (void)xcd_barrier_post((unsigned*)(KARGS->ws + WS_CTL) + CW_BAR, (volatile LAS unsigned*)((LAS unsigned char*)lds_raw + MISC_OFF) + 8);
    int ph = 0;
#define LO_ (KARGS->ph_lo)
#define HI_ (KARGS->ph_hi)
#define GRID_BAR do { XcdBarrier b_; b_.bar = (unsigned*)(KARGS->ws + WS_CTL) + CW_BAR; b_.x = xb_xcc_id(); b_.st = (volatile LAS unsigned*)((LAS unsigned char*)lds_raw + MISC_OFF) + 8; xcd_barrier(b_); } while (0)
#define RUN (LO_ <= ph && ph < HI_)
#define END_PHASE do { if (RUN && (ph + 1 < HI_)) { GRID_BAR; } ++ph; } while (0)

    if (RUN && ON(0)) { PH_ENTER p0_prologue(F, a); } END_PHASE;
    if (RUN && ON(1)) { PH_ENTER   for (int st = 0; st < 2; ++st) { if ((st ^ (bx & 1)) == 0) p1_phase(F, a); else rows_phase<false>(F, a, 0, 0, 0, nullptr, NROW); } } END_PHASE;

#pragma unroll 1
    for (int l = 0; l < 2; ++l) {
        const int nrows = l == 0 ? NROW : NTOK;
        if (RUN && ON(2)) { PH_ENTER
            const bf16* Wq8 = (const bf16*)(F.ws + W_IN + (size_t)l * INC * D);
            { pg8::Gemm g{(const bf16*)(F.ws + WS_H8), Wq8, nrows, QKVC, D / 2}; pg8::StaticOrder S; S.init(nrows, QKVC, F.G, bx);
              pg8::EpiQKV E{QKV, (const float*)(F.ws + WS_ROPE), 0, QSCALE, 1.0f / W13_SCALE};
              pg8::gemm_phase<pg8::EpiQKV, pg8::StaticOrder, true, true, true>(F.lds, g, S, E, F.tid); }
            int tid2 = threadIdx.x; asm volatile("" : "+v"(tid2));
            if (l == 1) { pg8::Gemm g{(const bf16*)(F.ws + WS_H8 + (size_t)NTOK * D), Wq8, NCTX, 1280, D / 2}; pg8::StaticOrder S; S.init(NCTX, 1280, F.G, bx);
              pg8::EpiQKV E{QKV, (const float*)(F.ws + WS_ROPE), NTOK, QSCALE, 1.0f / W13_SCALE};
              pg8::gemm_phase<pg8::EpiQKV, pg8::StaticOrder, true, true, true>(F.lds, g, S, E, tid2); }
            int tid3 = threadIdx.x; asm volatile("" : "+v"(tid3));
            { pg8::Gemm g{(const bf16*)(F.ws + W_CB) + (size_t)l * CINC * D, Hb, CINC, nrows, D}; pg8::StaticOrder S; S.init(CINC, nrows, F.G, bx);
              pg8::EpiPlain E{CINT, NROW, 0, 0, 1.0f};
              pg8::gemm_phase<pg8::EpiPlain, pg8::StaticOrder, true, true>(F.lds, g, S, E, tid3); }
        } END_PHASE;
        if (RUN) {
            { PH_ENTER const float* sink = a.in[I_SINK] + l * 8; const float* rpb = a.in[I_RPB] + (size_t)l * 8 * 15 * 31; const int sm = a.sub_mask;
              if (ON(3) && (sm & 1)) { AttPre P; P.valid = 0; int th = -1; for (int u = F.vcu; u < 2048; u += F.G) attn_unit<0>(F, u, u + F.G < 2048 ? u + F.G : -1, QKV, Y3, sink, rpb, P, th, (sm >> 6) & 3); } }
            { PH_ENTER const float* sink = a.in[I_SINK] + l * 8; const float* rpb = a.in[I_RPB] + (size_t)l * 8 * 15 * 31; const int sm = a.sub_mask;
              if (ON(4) && (sm & 2)) { AttPre P; P.valid = 0; int th = -1; for (int u = F.vcu; u < 2048; u += F.G) attn_unit<1>(F, u, u + F.G < 2048 ? u + F.G : -1, QKV, Y3 + (size_t)NROW * 512, sink, rpb, P, th, (sm >> 6) & 3); } }
            { PH_ENTER const float* sink = a.in[I_SINK] + l * 8; const float* rpb = a.in[I_RPB] + (size_t)l * 8 * 15 * 31; const int sm = a.sub_mask;
              if (l == 0 && ON(5) && (sm & 4)) {
                { AttPre P; P.valid = 0; int th = -1; for (int u = F.vcu; u < 256; u += F.G) attn_unit<2>(F, u, -1, QKV, Y3, sink, rpb, P, th); }
                { AttPre P; P.valid = 0; int th = -1; for (int u = F.vcu; u < 256; u += F.G) attn_unit<3>(F, u, -1, QKV, Y3 + (size_t)NROW * 512, sink, rpb, P, th); }
              } }
            { PH_ENTER const int sm = a.sub_mask;
              const float* cw = a.in[I_CONVW] + l * 3 * CINC; const float* cb = a.in[I_CONVB] + l * CINC; const float* hb = a.in[I_HBIAS] + l * 1024;
#if MK_HYVAR
              if (ON(6) && (sm & 32)) for (int c = F.vcu; c < 512; c += F.G) hyena_unit<SEQ, MK_HYVAR>(F, c, CINT, CINT, (const bf16*)(F.ws + WS_GF) + (size_t)l * 2 * 512 * 2 * SEQ, cw, cb, hb);
#endif
              if (ON(6) && (sm & 8)) for (int c = F.vcu; c < 512; c += F.G) hyena_unit<SEQ>(F, c, CINT, CINT, (const bf16*)(F.ws + WS_GF) + (size_t)l * 2 * 512 * 2 * SEQ, cw, cb, hb);
              if (l == 0 && ON(7) && (sm & 16)) for (int c = F.vcu; c < 512; c += F.G) hyena_unit<LC>(F, c, CINT, CINT, (const bf16*)(F.ws + WS_GFC) + (size_t)l * 2 * 512 * 2 * LC, cw, cb, hb);
              __syncthreads(); }
        } END_PHASE;
        if (RUN && ON(8)) { PH_ENTER
            transpose_yc(F, CINT, (bf16*)(F.ws + BIG_YCT), nrows);
            __syncthreads();
            pg8::Gemm g{(const bf16*)(F.ws + WS_H8), (const bf16*)(F.ws + W_IN + (size_t)l * INC * D + (size_t)(QKVC + CINC) * D), nrows, GATEC, D / 2}; pg8::StaticOrder S; S.init(nrows, GATEC, F.G, bx);
            pg8::EpiSig E{GATE, GATEC, 1.0f / W13_SCALE};
            pg8::gemm_phase<pg8::EpiSig, pg8::StaticOrder, true, true, true>(F.lds, g, S, E, F.tid);
        } END_PHASE;
        if (RUN && ON(9)) { PH_ENTER
            constexpr int TB = 256 * 512 * 2;
            static_assert((WS_Y3 - BIG_YCT) % TB == 0, "merge tile offsets");
            constexpr int OA = (int)((WS_Y3 - BIG_YCT) / TB), OB = OA + NROW / 256;
            pg8::Gemm g{(const bf16*)(F.ws + BIG_YCT), (const bf16*)(F.ws + W_BR) + (size_t)l * 3 * D * 512, 3 * NROW, 3 * D, 512}; pg8::MergeOrder S{nrows / 256, F.G, bx, OA, OB, 0};
            pg8::EpiMerge E{Hb, GATE, OA, OB, 0};
            pg8::gemm_phase<pg8::EpiMerge, pg8::MergeOrder, true, true>(F.lds, g, S, E, F.tid);
        } END_PHASE;
        if (RUN && ON(10)) { PH_ENTER
            pg8::Gemm g{Hb, (const bf16*)(F.ws + W_OUT) + (size_t)l * D * D, nrows, D, D}; pg8::StaticOrder S; S.init(nrows, D, F.G, bx);
            pg8::EpiPlain E{Y3, D, 0, 0, 1.0f};
            pg8::gemm_phase<pg8::EpiPlain, pg8::StaticOrder, true, true>(F.lds, g, S, E, F.tid);
        } END_PHASE;
        if (RUN && ON(11)) { PH_ENTER if (l == 0) rows_phase<false>(F, a, 1, 0, 0, Y3, nrows); else post_route_phase(F, a, Y3); } END_PHASE;
        if (l == 0) {
            if (RUN && ON(12)) { PH_ENTER
                pg8::Gemm g{(const bf16*)(F.ws + WS_H8), (const bf16*)(F.ws + W_F13), NROW, 2 * DFF, D / 2}; pg8::StaticOrder S; S.init(NROW, 2 * DFF, F.G, bx);
#if MK_FFN2_F8
                pg8::EpiSwiGLU8 E{F.ws + BIG_HID, DFF, 0, 1.0f / W13_SCALE, HID_SCALE};
                pg8::gemm_phase<pg8::EpiSwiGLU8, pg8::StaticOrder, true, true, true>(F.lds, g, S, E, F.tid);
#else
                pg8::EpiSwiGLU E{(bf16*)(F.ws + BIG_HID), DFF, 0, 1.0f / W13_SCALE};
                pg8::gemm_phase<pg8::EpiSwiGLU, pg8::StaticOrder, true, true, true>(F.lds, g, S, E, F.tid);
#endif
            } END_PHASE;
            if (RUN && ON(13)) { PH_ENTER
#if MK_FFN2_F8
                pg8::Gemm g{(const bf16*)(F.ws + BIG_HID), (const bf16*)(F.ws + W_F2), NROW, D, DFF / 2}; pg8::StaticOrder S; S.init(NROW, D, F.G, bx);
                pg8::EpiPlain E{Y3, D, 0, 0, 1.0f / (HID_SCALE * W2_SCALE)};
                pg8::gemm_phase<pg8::EpiPlain, pg8::StaticOrder, true, true, true>(F.lds, g, S, E, F.tid);
#else
                pg8::Gemm g{(const bf16*)(F.ws + BIG_HID), (const bf16*)(F.ws + W_F2), NROW, D, DFF}; pg8::StaticOrder S; S.init(NROW, D, F.G, bx);
                pg8::EpiPlain E{Y3, D, 0, 0, 1.0f};
                pg8::gemm_phase<pg8::EpiPlain, pg8::StaticOrder, true, true>(F.lds, g, S, E, F.tid);
#endif
            } END_PHASE;
            if (RUN && ON(14)) { PH_ENTER rows_phase<true>(F, a, 1, 0, 1, Y3, NROW); } END_PHASE;
        } else {
#pragma unroll 1
            for (int half = 0; half < 2; ++half) {
                if (half == 0) { if (RUN && ON(15)) { PH_ENTER moe_convert(F, a, 0); moe_gather_phase(F, 0); } END_PHASE; }
                if (RUN && ON(16)) { PH_ENTER
                    int toff[9], cnt[8]; moe_offsets(F, half, toff, cnt);
                    pg8::GroupOrder S; S.nM = toff[8]; S.nN = 28; S.G = F.G; S.c = bx;
#pragma unroll
                    for (int k = 0; k < 9; ++k) S.toff[k] = toff[k];
                    pg8::Gemm g{(const bf16*)(F.ws + BIG_AS), (const bf16*)(F.ws + WM_13), PCAP, 8 * 2 * DFFE, D / 2};
                    pg8::EpiSwiGLU8 E{F.ws + BIG_MH, DFFE, 28, 1.0f / W13_SCALE, HID_SCALE};
                    if (half == 1 && (bx & 1)) moe_post_phase(F, a, 0);
                    if (half == 0 && (bx & 1)) { moe_convert(F, a, 1); __syncthreads(); }
                    int tidg = threadIdx.x; asm volatile("" : "+v"(tidg));
                    pg8::gemm_phase<pg8::EpiSwiGLU8, pg8::GroupOrder, true, true, true>(F.lds, g, S, E, tidg);
                    if (half == 1 && !(bx & 1)) moe_post_phase(F, a, 0);
                    if (half == 0 && !(bx & 1)) { __syncthreads(); moe_convert(F, a, 1); }
                } END_PHASE;
                if (RUN && ON(17)) { PH_ENTER
                    int toff[9], cnt[8]; moe_offsets(F, half, toff, cnt);
                    pg8::GroupOrder S; S.nM = toff[8]; S.nN = 4; S.G = F.G; S.c = bx;
#pragma unroll
                    for (int k = 0; k < 9; ++k) S.toff[k] = toff[k];
                    pg8::Gemm g{(const bf16*)(F.ws + BIG_MH), (const bf16*)(F.ws + WM_2), PCAP, 8 * D, DFFE / 2};
                    pg8::EpiPlain E{(bf16*)(F.ws + BIG_Y2S), D, 4, 0, 1.0f / (HID_SCALE * W2_SCALE)};
                    pg8::gemm_phase<pg8::EpiPlain, pg8::GroupOrder, true, true, true>(F.lds, g, S, E, F.tid);
                    if (half == 0) moe_gather_phase(F, 1, toff[8] * 4 - 4 * F.G);
                } END_PHASE;
            }
            if (RUN && ON(18)) { PH_ENTER moe_post_phase(F, a, 1); } END_PHASE;
        }
    }
#undef RUN
#undef END_PHASE
}

extern "C" void kernel_launch(void* const* d_in, const int* in_sizes, int n_in, void* d_out, int out_size, void* d_ws, size_t ws_size, hipStream_t stream) {
    static int grid = 0;
    if (grid == 0) {
        if (n_in != 31 || in_sizes[0] != NTOK * D || out_size != NTOK * D || ws_size < WS_END) { fprintf(stderr, "kernel_launch: unexpected shapes (n_in %d, in0 %d, out %d, ws %zu)\n", n_in, n_in > 0 ? in_sizes[0] : -1, out_size, ws_size); grid = -1; return; }
        int dev = 0, cus = 0, per_cu = 0;
        if (hipGetDevice(&dev) != hipSuccess || hipDeviceGetAttribute(&cus, hipDeviceAttributeMultiprocessorCount, dev) != hipSuccess) { grid = -1; return; }
        if (hipFuncSetAttribute((const void*)fwd_kernel, hipFuncAttributeMaxDynamicSharedMemorySize, LDS_BYTES) != hipSuccess) { fprintf(stderr, "kernel_launch: hipFuncSetAttribute failed\n"); grid = -1; return; }
        if (hipOccupancyMaxActiveBlocksPerMultiprocessor(&per_cu, (const void*)fwd_kernel, NTHREADS, LDS_BYTES) != hipSuccess || per_cu < 1) { fprintf(stderr, "kernel_launch: occupancy query says %d\n", per_cu); }
        (void)hipGetLastError();
        grid = cus;
    }
    if (grid < 0) return;
    if (hipMemsetAsync((char*)d_ws + WS_CTL, 0, CTL_ZERO_BYTES, stream) != hipSuccess) return;
    Args a{};
    for (int i = 0; i < 31; ++i) a.in[i] = (const float*)d_in[i];
    a.out = (float*)d_out; a.ws = (unsigned char*)d_ws;
#if MK_MULTI
    for (int p = 0; p < NPHASES; ++p) { a.ph_lo = p; a.ph_hi = p + 1; a.sub_mask = 31;
        const bool mix = (p == 3 || p == 12);
        if (((MK_REPMASK >> p) & 1) && !mix) { a.sub_mask = 31 | MK_REPSUB; hipLaunchKernelGGL(fwd_kernel, dim3(grid), dim3(NTHREADS), LDS_BYTES, stream, a); a.sub_mask = 31; }
        if (((MK_REPMASK >> p) & 1) && mix) { a.sub_mask = MK_REPSUB; hipLaunchKernelGGL(fwd_kernel, dim3(grid), dim3(NTHREADS), LDS_BYTES, stream, a); a.sub_mask = 31; }
        hipLaunchKernelGGL(fwd_kernel, dim3(grid), dim3(NTHREADS), LDS_BYTES, stream, a); }
#else
    a.ph_lo = 0; a.ph_hi = NPHASES; a.sub_mask = 31;
    hipLaunchKernelGGL(fwd_kernel, dim3(grid), dim3(NTHREADS), LDS_BYTES, stream, a);
#endif
    const hipError_t le = hipPeekAtLastError();
    if (le != hipSuccess) fprintf(stderr, "kernel_launch: launch failed: %s\n", hipGetErrorName(le));
}
```
